# Optimizing an MI355X kernel written in HIP

```python
import math
import functools
import numpy as np
import jax
import jax.numpy as jnp
from jax import lax

D_MODEL = 1024
BATCH = 4
SEQ = 4096
DEPTH = 4
DEC_BATCH = 32
DEC_SEQ = 1
PAST_LEN = 8192
PAGE_SIZE = 128

EPS = 1e-6
N_HYB = (DEPTH + 1) // 2
N_GDN = DEPTH // 2

A_HEADS = 8
A_HEAD_DIM = 64
A_WIDTH = A_HEADS * A_HEAD_DIM
A_PATTERNS = ((128, 1), (512, 4), (2048, 16))
A_WIN_MAX = 2048
A_QBLOCK = 128
REL_BUCKETS = 32
REL_MAX_DIST = 2048

SSM_D_INNER = 1024
SSM_HEAD_DIM = 64
SSM_HEADS = SSM_D_INNER // SSM_HEAD_DIM
SSM_GROUPS = 2
SSM_STATE = 128
SSM_CONV = 4
SSM_CHUNK = 128
SSM_XBC = SSM_D_INNER + 2 * SSM_GROUPS * SSM_STATE

HYB_IN = 3 * A_WIDTH + SSM_D_INNER + SSM_XBC + SSM_HEADS
HYB_MIX = A_WIDTH + SSM_D_INNER

GDN_QK_HEADS = 8
GDN_V_HEADS = 16
GDN_DK = 128
GDN_DV = 128
GDN_CONV = 4
GDN_CHUNK = 64
GDN_QK_W = GDN_QK_HEADS * GDN_DK
GDN_VW = GDN_V_HEADS * GDN_DV
GDN_QKV = 2 * GDN_QK_W + GDN_VW
GDN_IN = GDN_QKV + GDN_VW + 2 * GDN_V_HEADS

D_FF = -(-8 * D_MODEL // (3 * 256)) * 256

kernel_name = 'hybrid_dilated_ssd_gdn_decoder_step'


def rmsnorm(x, g):
    xf = x.astype(jnp.float32)
    y = xf * lax.rsqrt(jnp.mean(xf * xf, axis=-1, keepdims=True) + EPS)
    return (y * g.astype(jnp.float32)).astype(x.dtype)


def l2norm(x):
    return x * lax.rsqrt(jnp.sum(x * x, axis=-1, keepdims=True) + EPS)


def causal_conv(x, buf, w):
    k = w.shape[0]
    L = x.shape[1]
    xp = jnp.concatenate([buf.astype(x.dtype), x], axis=1)
    y = xp[:, 0:L] * w[0]
    for i in range(1, k):
        y = y + xp[:, i:i + L] * w[i]
    return y, xp[:, L:]


def rel_buckets(dist):
    max_exact = REL_BUCKETS // 2
    n = np.maximum(dist, 1).astype(np.float32)
    large = max_exact + (np.log(n / max_exact) / math.log(REL_MAX_DIST / max_exact)
                         * (REL_BUCKETS - max_exact)).astype(np.int32)
    large = np.minimum(large, REL_BUCKETS - 1)
    return np.where(dist < max_exact, dist, large).astype(np.int32)


def dilated_window_attention(q, k_all, v_all, prefix, rel_bias):
    bsz, S, H, dh = q.shape
    qb = A_QBLOCK if S % A_QBLOCK == 0 else S
    nb = S // qb
    scale = dh ** -0.5
    pats = []
    for (w, d) in A_PATTERNS:
        offs = (np.arange(w // d + 1) * d).astype(np.int32)
        bias = rel_bias[rel_buckets(offs)].astype(jnp.float32)
        pats.append((offs, bias.T[None, :, None, :]))
    qblocks = jnp.moveaxis(q.reshape(bsz, nb, qb, H, dh), 1, 0)

    def block(args):
        qblk, b0 = args
        rows = prefix + b0 * qb + jnp.arange(qb, dtype=jnp.int32)
        qf = qblk.astype(jnp.float32) * scale
        ms, ss, nums = [], [], []
        for offs, bias in pats:
            idx = rows[:, None] - offs[None, :]
            valid = idx >= 0
            idxc = jnp.maximum(idx, 0)
            kg = jnp.take(k_all, idxc, axis=1).astype(jnp.float32)
            vg = jnp.take(v_all, idxc, axis=1).astype(jnp.float32)
            logits = jnp.einsum('bqhd,bqjhd->bhqj', qf, kg) + bias
            logits = jnp.where(valid[None, None], logits, -1e30)
            m = jnp.max(logits, axis=-1, keepdims=True)
            p = jnp.exp(logits - m)
            ms.append(m)
            ss.append(jnp.sum(p, axis=-1, keepdims=True))
            nums.append(jnp.einsum('bhqj,bqjhd->bhqd', p, vg))
        m_all = functools.reduce(jnp.maximum, ms)
        wts = [jnp.exp(m - m_all) for m in ms]
        num = functools.reduce(jnp.add, [w * n for w, n in zip(wts, nums)])
        den = functools.reduce(jnp.add, [w * s for w, s in zip(wts, ss)])
        return jnp.swapaxes(num / den, 1, 2)

    out = lax.map(block, (qblocks, jnp.arange(nb, dtype=jnp.int32)))
    return jnp.moveaxis(out, 0, 1).reshape(bsz, S, H, dh).astype(q.dtype)


def ssd_scan(x, dt, bm, cm, a_neg, h0):
    f32 = jnp.float32
    bsz, L = x.shape[0], x.shape[1]
    ch = min(SSM_CHUNK, L)
    nc = -(-L // ch)
    pad = nc * ch - L

    def padl(a):
        return jnp.pad(a.astype(f32), [(0, 0), (0, pad)] + [(0, 0)] * (a.ndim - 2))

    G, HG, P, N = SSM_GROUPS, SSM_HEADS // SSM_GROUPS, SSM_HEAD_DIM, SSM_STATE
    xc = padl(x).reshape(bsz, nc, ch, G, HG, P)
    dtc = padl(dt).reshape(bsz, nc, ch, G, HG)
    bc = padl(bm).reshape(bsz, nc, ch, G, N)
    cc = padl(cm).reshape(bsz, nc, ch, G, N)
    cs = jnp.cumsum(dtc * a_neg.reshape(G, HG), axis=2)
    cst = jnp.moveaxis(cs, 2, -1)
    causal = np.tril(np.ones((ch, ch), dtype=bool))
    seg = jnp.exp(jnp.where(causal, cst[..., :, None] - cst[..., None, :], -jnp.inf))
    cb = jnp.einsum('bcign,bcjgn->bcgij', cc, bc)
    mix = cb[:, :, :, None] * seg * jnp.moveaxis(dtc, 2, -1)[..., None, :]
    y_intra = jnp.einsum('bcghij,bcjghp->bcighp', mix, xc)
    last = cs[:, :, -1]
    w_end = jnp.exp(last[:, :, None] - cs) * dtc
    st = jnp.einsum('bcjgh,bcjgn,bcjghp->bcghpn', w_end, bc, xc)

    def step(h, inp):
        dec, s = inp
        return h * dec[..., None, None] + s, h

    h_fin, h_start = lax.scan(step, h0.astype(f32).reshape(bsz, G, HG, P, N),
                              (jnp.moveaxis(jnp.exp(last), 1, 0), jnp.moveaxis(st, 1, 0)))
    h_start = jnp.moveaxis(h_start, 0, 1)
    y_inter = jnp.einsum('bcign,bcghpn->bcighp', cc, h_start) * jnp.exp(cs)[..., None]
    y = (y_intra + y_inter).reshape(bsz, nc * ch, SSM_HEADS, P)[:, :L]
    return y, h_fin.reshape(bsz, SSM_HEADS, P, N)


def gated_delta_rule(q, k, v, g, beta, s0):
    f32 = jnp.float32
    bsz, L, H = v.shape[0], v.shape[1], v.shape[2]
    dv = v.shape[-1]
    ch = min(GDN_CHUNK, L)
    nc = -(-L // ch)
    pad = nc * ch - L

    def chunks(a):
        a = jnp.pad(a.astype(f32), [(0, 0), (0, pad)] + [(0, 0)] * (a.ndim - 2))
        return jnp.moveaxis(a.reshape((bsz, nc, ch) + a.shape[2:]), 3, 1)

    qc, kc, vc, gc, bc = (chunks(a) for a in (q, k, v, g, beta))
    gcum = jnp.cumsum(gc, axis=-1)
    incl = np.tril(np.ones((ch, ch), dtype=bool))
    strict = np.tril(np.ones((ch, ch), dtype=bool), k=-1)
    dec_incl = jnp.exp(jnp.where(incl, gcum[..., :, None] - gcum[..., None, :], -jnp.inf))
    dec_strict = jnp.where(strict, dec_incl, 0.0)
    kb = kc * bc[..., None]
    a_mat = jnp.einsum('bhcid,bhcjd->bhcij', kb, kc) * dec_strict + jnp.eye(ch, dtype=f32)
    rhs = jnp.concatenate([vc * bc[..., None], kb * jnp.exp(gcum)[..., None]], axis=-1)
    sol = lax.linalg.triangular_solve(a_mat, rhs, left_side=True, lower=True, unit_diagonal=True)
    u0, kcd = sol[..., :dv], sol[..., dv:]
    attn = jnp.einsum('bhcid,bhcjd->bhcij', qc, kc) * dec_incl
    qg = qc * jnp.exp(gcum)[..., None]
    kdec = kc * jnp.exp(gcum[..., -1:] - gcum)[..., None]
    glast = jnp.exp(gcum[..., -1])

    def step(s, inp):
        u0_c, kcd_c, attn_c, qg_c, kdec_c, gl_c = inp
        u = u0_c - jnp.einsum('bhik,bhkv->bhiv', kcd_c, s)
        o = jnp.einsum('bhik,bhkv->bhiv', qg_c, s) + jnp.einsum('bhij,bhjv->bhiv', attn_c, u)
        s = s * gl_c[..., None, None] + jnp.einsum('bhjk,bhjv->bhkv', kdec_c, u)
        return s, o

    xs = tuple(jnp.moveaxis(a, 2, 0) for a in (u0, kcd, attn, qg, kdec, glast))
    s_fin, o = lax.scan(step, s0.astype(f32), xs)
    o = jnp.moveaxis(jnp.moveaxis(o, 0, 2), 1, 3).reshape(bsz, nc * ch, H, dv)[:, :L]
    return o, s_fin


def hybrid_mixer(h, k_pre, v_pre, conv_buf, h0, keep, rel_bias, w_in, conv_w, conv_b,
                 dt_bias, a_log, d_skip, norm_w, w_out):
    f32 = jnp.float32
    bsz, L, _ = h.shape
    proj = h @ w_in
    q, k, v, z, xbc, dt_raw = jnp.split(
        proj, [A_WIDTH, 2 * A_WIDTH, 3 * A_WIDTH, 3 * A_WIDTH + SSM_D_INNER,
               3 * A_WIDTH + SSM_D_INNER + SSM_XBC], axis=-1)
    shp = (bsz, L, A_HEADS, A_HEAD_DIM)
    k_all = jnp.concatenate([k_pre.astype(h.dtype), k.reshape(shp)], axis=1)
    v_all = jnp.concatenate([v_pre.astype(h.dtype), v.reshape(shp)], axis=1)
    o_attn = dilated_window_attention(q.reshape(shp), k_all, v_all, k_pre.shape[1], rel_bias)
    xbc, new_conv = causal_conv(xbc, conv_buf, conv_w)
    xbc = jax.nn.silu((xbc + conv_b).astype(f32))
    xs, bm, cm = jnp.split(xbc, [SSM_D_INNER, SSM_D_INNER + SSM_GROUPS * SSM_STATE], axis=-1)
    xs = xs.reshape(bsz, L, SSM_HEADS, SSM_HEAD_DIM)
    dt = jax.nn.softplus(dt_raw.astype(f32) + dt_bias.astype(f32))
    y, h_fin = ssd_scan(xs, dt, bm.reshape(bsz, L, SSM_GROUPS, SSM_STATE),
                        cm.reshape(bsz, L, SSM_GROUPS, SSM_STATE), -jnp.exp(a_log.astype(f32)), h0)
    y = (y + d_skip.astype(f32)[:, None] * xs).reshape(bsz, L, SSM_D_INNER) * jax.nn.silu(z.astype(f32))
    y = y.reshape(bsz, L, SSM_GROUPS, SSM_D_INNER // SSM_GROUPS)
    y = y * lax.rsqrt(jnp.mean(y * y, axis=-1, keepdims=True) + EPS)
    y = y.reshape(bsz, L, SSM_D_INNER) * norm_w.astype(f32)
    mixed = jnp.concatenate([o_attn.reshape(bsz, L, A_WIDTH), y.astype(h.dtype)], axis=-1)
    return mixed @ w_out, k_all[:, -keep:], v_all[:, -keep:], new_conv, h_fin


def gdn_mixer(h, conv_buf, s0, w_in, conv_w, dt_bias, a_log, norm_w, w_out):
    f32 = jnp.float32
    bsz, L, _ = h.shape
    proj = h @ w_in
    qkv, z, b_raw, a_raw = jnp.split(
        proj, [GDN_QKV, GDN_QKV + GDN_VW, GDN_QKV + GDN_VW + GDN_V_HEADS], axis=-1)
    qkv, new_conv = causal_conv(qkv, conv_buf, conv_w)
    qkv = jax.nn.silu(qkv.astype(f32))
    q, k, v = jnp.split(qkv, [GDN_QK_W, 2 * GDN_QK_W], axis=-1)
    rep = GDN_V_HEADS // GDN_QK_HEADS
    q = jnp.repeat(l2norm(q.reshape(bsz, L, GDN_QK_HEADS, GDN_DK)) * GDN_DK ** -0.5, rep, axis=2)
    k = jnp.repeat(l2norm(k.reshape(bsz, L, GDN_QK_HEADS, GDN_DK)), rep, axis=2)
    v = v.reshape(bsz, L, GDN_V_HEADS, GDN_DV)
    beta = jax.nn.sigmoid(b_raw.astype(f32))
    g = -jnp.exp(a_log.astype(f32)) * jax.nn.softplus(a_raw.astype(f32) + dt_bias.astype(f32))
    o, s_fin = gated_delta_rule(q, k, v, g, beta, s0)
    o = rmsnorm(o, norm_w) * jax.nn.silu(z.astype(f32).reshape(bsz, L, GDN_V_HEADS, GDN_DV))
    return o.reshape(bsz, L, GDN_VW).astype(h.dtype) @ w_out, new_conv, s_fin


def swiglu(h, w_gate, w_up, w_down):
    return (jax.nn.silu(h @ w_gate) * (h @ w_up)) @ w_down


def setup_inputs(seed: int = 0) -> dict:
    key = jax.random.key(seed)
    ks = jax.random.split(key, 40)
    f32 = jnp.float32
    win_buf = min(A_WIN_MAX, PAST_LEN)

    def nrm(k, shape, scale):
        return jax.random.normal(k, shape, f32) * scale

    def gain(k, shape):
        return 1.0 + 0.02 * jax.random.normal(k, shape, f32)

    def dt_bias_init(k, shape):
        dt = jnp.exp(jax.random.uniform(k, shape, f32, math.log(1e-3), math.log(1e-1)))
        return dt + jnp.log(-jnp.expm1(-dt))

    def a_log_init(k, shape):
        return jnp.log(jax.random.uniform(k, shape, f32, 1.0, 16.0))

    return {
        'x_prompt': nrm(ks[0], (BATCH, SEQ, D_MODEL), 1.0),
        'x_sample': nrm(ks[1], (DEC_BATCH, DEC_SEQ, D_MODEL), 1.0),
        'cache_attn_k': nrm(ks[2], (N_HYB, DEC_BATCH, win_buf, A_HEADS, A_HEAD_DIM), 1.0),
        'cache_attn_v': nrm(ks[3], (N_HYB, DEC_BATCH, win_buf, A_HEADS, A_HEAD_DIM), 1.0),
        'state_ssm_conv': nrm(ks[4], (N_HYB, DEC_BATCH, SSM_CONV - 1, SSM_XBC), 1.0),
        'state_ssm': nrm(ks[5], (N_HYB, DEC_BATCH, SSM_HEADS, SSM_HEAD_DIM, SSM_STATE), 0.1),
        'state_gdn_conv': nrm(ks[6], (N_GDN, DEC_BATCH, GDN_CONV - 1, GDN_QKV), 1.0),
        'state_gdn': nrm(ks[7], (N_GDN, DEC_BATCH, GDN_V_HEADS, GDN_DK, GDN_DV), 0.1),
        'rel_bias': nrm(ks[8], (REL_BUCKETS, A_HEADS), 0.5),
        'norm_mix_pre': gain(ks[9], (DEPTH, D_MODEL)),
        'norm_mix_post': gain(ks[10], (DEPTH, D_MODEL)),
        'norm_ffn_pre': gain(ks[11], (DEPTH, D_MODEL)),
        'norm_ffn_post': gain(ks[12], (DEPTH, D_MODEL)),
        'w_hyb_in': nrm(ks[13], (N_HYB, D_MODEL, HYB_IN), D_MODEL ** -0.5),
        'ssm_conv_w': nrm(ks[14], (N_HYB, SSM_CONV, SSM_XBC), SSM_CONV ** -0.5),
        'ssm_conv_b': nrm(ks[15], (N_HYB, SSM_XBC), 0.02),
        'ssm_dt_bias': dt_bias_init(ks[16], (N_HYB, SSM_HEADS)),
        'ssm_a_log': a_log_init(ks[17], (N_HYB, SSM_HEADS)),
        'ssm_d': 1.0 + 0.1 * jax.random.normal(ks[18], (N_HYB, SSM_HEADS), f32),
        'ssm_norm_w': gain(ks[19], (N_HYB, SSM_D_INNER)),
        'w_hyb_out': nrm(ks[20], (N_HYB, HYB_MIX, D_MODEL), HYB_MIX ** -0.5),
        'w_gdn_in': nrm(ks[21], (N_GDN, D_MODEL, GDN_IN), D_MODEL ** -0.5),
        'gdn_conv_w': nrm(ks[22], (N_GDN, GDN_CONV, GDN_QKV), GDN_CONV ** -0.5),
        'gdn_dt_bias': dt_bias_init(ks[23], (N_GDN, GDN_V_HEADS)),
        'gdn_a_log': a_log_init(ks[24], (N_GDN, GDN_V_HEADS)),
        'gdn_norm_w': gain(ks[25], (N_GDN, GDN_DV)),
        'w_gdn_out': nrm(ks[26], (N_GDN, GDN_VW, D_MODEL), GDN_VW ** -0.5),
        'w_ffn_gate': nrm(ks[27], (DEPTH, D_MODEL, D_FF), D_MODEL ** -0.5),
        'w_ffn_up': nrm(ks[28], (DEPTH, D_MODEL, D_FF), D_MODEL ** -0.5),
        'w_ffn_down': nrm(ks[29], (DEPTH, D_FF, D_MODEL), D_FF ** -0.5),
    }


def reference(x_prompt, x_sample, cache_attn_k, cache_attn_v, state_ssm_conv, state_ssm,
              state_gdn_conv, state_gdn, rel_bias, norm_mix_pre, norm_mix_post, norm_ffn_pre,
              norm_ffn_post, w_hyb_in, ssm_conv_w, ssm_conv_b, ssm_dt_bias, ssm_a_log, ssm_d,
              ssm_norm_w, w_hyb_out, w_gdn_in, gdn_conv_w, gdn_dt_bias, gdn_a_log, gdn_norm_w,
              w_gdn_out, w_ffn_gate, w_ffn_up, w_ffn_down):

    def trunk(x, k_pre, v_pre, sconv, sssm, gconv, gstate, keep):
        nk, nv, nsc, nss, ngc, ngs = [], [], [], [], [], []
        for l in range(DEPTH):
            i = l // 2
            h = rmsnorm(x, norm_mix_pre[l])
            if l % 2 == 0:
                m, k_new, v_new, c_new, s_new = hybrid_mixer(
                    h, k_pre[i], v_pre[i], sconv[i], sssm[i], keep, rel_bias, w_hyb_in[i],
                    ssm_conv_w[i], ssm_conv_b[i], ssm_dt_bias[i], ssm_a_log[i], ssm_d[i],
                    ssm_norm_w[i], w_hyb_out[i])
                nk.append(k_new)
                nv.append(v_new)
                nsc.append(c_new)
                nss.append(s_new)
            else:
                m, c_new, s_new = gdn_mixer(h, gconv[i], gstate[i], w_gdn_in[i], gdn_conv_w[i],
                                            gdn_dt_bias[i], gdn_a_log[i], gdn_norm_w[i], w_gdn_out[i])
                ngc.append(c_new)
                ngs.append(s_new)
            x = x + rmsnorm(m, norm_mix_post[l])
            f = swiglu(rmsnorm(x, norm_ffn_pre[l]), w_ffn_gate[l], w_ffn_up[l], w_ffn_down[l])
            x = x + rmsnorm(f, norm_ffn_post[l])
        return (x, jnp.stack(nk), jnp.stack(nv), jnp.stack(nsc), jnp.stack(nss),
                jnp.stack(ngc), jnp.stack(ngs))

    bsz, s_len = x_prompt.shape[0], x_prompt.shape[1]
    dt_p = x_prompt.dtype
    p_k0 = jnp.zeros((N_HYB, bsz, 0, A_HEADS, A_HEAD_DIM), dt_p)
    p_sc0 = jnp.zeros((N_HYB, bsz, SSM_CONV - 1, SSM_XBC), dt_p)
    p_ss0 = jnp.zeros((N_HYB, bsz, SSM_HEADS, SSM_HEAD_DIM, SSM_STATE), jnp.float32)
    p_gc0 = jnp.zeros((N_GDN, bsz, GDN_CONV - 1, GDN_QKV), dt_p)
    p_gs0 = jnp.zeros((N_GDN, bsz, GDN_V_HEADS, GDN_DK, GDN_DV), jnp.float32)
    y_prompt, pk, pv, psc, pss, pgc, pgs = trunk(
        x_prompt, p_k0, p_k0, p_sc0, p_ss0, p_gc0, p_gs0, min(A_WIN_MAX, s_len))
    y_sample, sk, sv, ssc, sss, sgc, sgs = trunk(
        x_sample, cache_attn_k, cache_attn_v, state_ssm_conv, state_ssm, state_gdn_conv,
        state_gdn, cache_attn_k.shape[2])
    return (y_prompt, y_sample, pk, pv, psc, pss, pgc, pgs, sk, sv, ssc, sss, sgc, sgs)
```

```cpp
#include <hip/hip_runtime.h>
#include <hip/hip_cooperative_groups.h>
#include <cstdio>
#include <cstdint>
namespace cg = cooperative_groups;

#define DI __device__ __forceinline__
#define LAS __attribute__((address_space(3)))
typedef unsigned short bf16_t;
typedef short bf16x8 __attribute__((ext_vector_type(8)));
typedef float f32x4 __attribute__((ext_vector_type(4)));
typedef unsigned u32x2 __attribute__((ext_vector_type(2)));
typedef unsigned u32x4 __attribute__((ext_vector_type(4)));

constexpr int D = 1024, NB = 4, SEQ = 4096, T = NB * SEQ, NS = 32, TT = T + NS, DEPTH = 4;
constexpr int AH = 8, AHD = 64, AW = 512, WIN = 2048;
constexpr int SH = 16, SP = 64, SN = 128, SG = 2, SDI = 1024, SXBC = 1536;
constexpr int HYB_IN = 4112, HYB_MAIN = 4096, HYB_MIX = 1536;
constexpr int GH = 16, GQH = 8, GDK = 128, GDV = 128, GQKV = 4096, GVW = 2048, GDN_IN = 6176, GDN_MAIN = 6144;
constexpr int FF = 2816;
constexpr float EPS = 1e-6f;
constexpr int NTHR = 512, NWAVE = 8, LDS_BYTES = 163840;

enum { I_XP = 0, I_XS, I_CK, I_CV, I_SCONV, I_SSM, I_GCONV, I_GST, I_RELB, I_NMPRE, I_NMPOST, I_NFPRE, I_NFPOST, I_WHIN, I_SCW, I_SCB, I_SDTB, I_SALOG, I_SD, I_SNW,
       I_WHOUT, I_WGIN, I_GCW, I_GDTB, I_GALOG, I_GNW, I_WGOUT, I_WFG, I_WFU, I_WFD };

constexpr size_t O_YP = 0;
constexpr size_t O_YS = O_YP + (size_t)T * D;
constexpr size_t O_PK = O_YS + (size_t)NS * D;
constexpr size_t O_PV = O_PK + (size_t)2 * NB * WIN * AW;
constexpr size_t O_PSC = O_PV + (size_t)2 * NB * WIN * AW;
constexpr size_t O_PSS = O_PSC + (size_t)2 * NB * 3 * SXBC;
constexpr size_t O_PGC = O_PSS + (size_t)2 * NB * SH * SP * SN;
constexpr size_t O_PGS = O_PGC + (size_t)2 * NB * 3 * GQKV;
constexpr size_t O_SK = O_PGS + (size_t)2 * NB * GH * GDK * GDV;
constexpr size_t O_SV = O_SK + (size_t)2 * NS * WIN * AW;
constexpr size_t O_SSC = O_SV + (size_t)2 * NS * WIN * AW;
constexpr size_t O_SSS = O_SSC + (size_t)2 * NS * 3 * SXBC;
constexpr size_t O_SGC = O_SSS + (size_t)2 * NS * SH * SP * SN;
constexpr size_t O_SGS = O_SGC + (size_t)2 * NS * 3 * GQKV;
constexpr size_t O_END = O_SGS + (size_t)2 * NS * GH * GDK * GDV;

constexpr size_t al256(size_t x) { return (x + 255) & ~(size_t)255; }
constexpr size_t W_CTL = 0;
constexpr size_t W_HIN = 65536;
constexpr size_t W_HOUT = al256(W_HIN + (size_t)2 * HYB_IN * D * 2);
constexpr size_t W_GIN = al256(W_HOUT + (size_t)2 * D * HYB_MIX * 2);
constexpr size_t W_GOUT = al256(W_GIN + (size_t)2 * GDN_IN * D * 2);
constexpr size_t W_GU = al256(W_GOUT + (size_t)2 * D * GVW * 2);
constexpr size_t W_DN = al256(W_GU + (size_t)4 * 2 * FF * D * 2);
constexpr size_t W_X = al256(W_DN + (size_t)4 * D * FF * 2);
constexpr size_t W_H = al256(W_X + (size_t)TT * D * 4);
constexpr size_t W_PROJ = al256(W_H + (size_t)TT * D * 2);
constexpr size_t W_EXTRA = al256(W_PROJ + (size_t)TT * GDN_MAIN * 2);
constexpr size_t W_MIXED = al256(W_EXTRA + (size_t)TT * 32 * 4);
constexpr size_t W_GO = al256(W_MIXED + (size_t)TT * GVW * 2);
constexpr size_t W_HID = al256(W_GO + (size_t)TT * D * 4);
constexpr size_t W_ACT = al256(W_HID + (size_t)TT * FF * 2);
constexpr size_t W_AUX = al256(W_ACT + (size_t)TT * 4096 * 4);
constexpr size_t W_Y = al256(W_AUX + (size_t)TT * 32 * 4);
constexpr size_t W_END = al256(W_Y + (size_t)TT * 2048 * 4);

struct Params { const float* in[30]; float* out; unsigned char* ws; int ph_lo, ph_hi; };

DI float bf2f(bf16_t b) { return __uint_as_float(((unsigned)b) << 16); }
DI bf16_t f2bf(float x) { unsigned u = __float_as_uint(x); u += 0x7fffu + ((u >> 16) & 1u); return (bf16_t)(u >> 16); }
DI unsigned pk2(float lo, float hi) { return (unsigned)f2bf(lo) | ((unsigned)f2bf(hi) << 16); }
DI float wave_sum(float v) {
#pragma unroll
    for (int o = 32; o >= 1; o >>= 1) v += __shfl_xor(v, o);
    return v;
}
DI float wave_max(float v) {
#pragma unroll
    for (int o = 32; o >= 1; o >>= 1) v = fmaxf(v, __shfl_xor(v, o));
    return v;
}
DI float siluf(float x) { return x / (1.f + __expf(-x)); }
DI float sigmoidf_(float x) { return 1.f / (1.f + __expf(-x)); }
DI float softplusf_(float x) { return fmaxf(x, 0.f) + log1pf(__expf(-fabsf(x))); }
#define LDS_WAIT() asm volatile("s_waitcnt lgkmcnt(0)" ::: "memory")

__device__ const unsigned char c_bucket[3][129] = {
 {0,1,2,3,4,5,6,7,8,9,10,11,12,13,14,15,16,16,16,16,16,16,17,17,17,17,17,17,17,17,18,18,18,18,18,18,18,18,18,18,19,19,19,19,19,19,19,19,19,19,19,19,19,19,20,20,20,20,20,20,20,20,20,20,20,20,20,20,20,20,20,20,20,21,21,21,21,21,21,21,21,21,21,21,21,21,21,21,21,21,21,21,21,21,21,21,21,21,21,22,22,22,22,22,22,22,22,22,22,22,22,22,22,22,22,22,22,22,22,22,22,22,22,22,22,22,22,22,22},
 {0,4,8,12,16,16,17,17,18,18,19,19,19,19,20,20,20,20,20,21,21,21,21,21,21,22,22,22,22,22,22,22,22,22,23,23,23,23,23,23,23,23,23,23,23,23,24,24,24,24,24,24,24,24,24,24,24,24,24,24,24,24,25,25,25,25,25,25,25,25,25,25,25,25,25,25,25,25,25,25,25,25,25,26,26,26,26,26,26,26,26,26,26,26,26,26,26,26,26,26,26,26,26,26,26,26,26,26,26,26,26,26,26,27,27,27,27,27,27,27,27,27,27,27,27,27,27,27,27},
 {0,16,18,19,20,21,21,22,22,23,23,23,24,24,24,24,25,25,25,25,25,26,26,26,26,26,26,26,26,27,27,27,27,27,27,27,27,27,27,28,28,28,28,28,28,28,28,28,28,28,28,28,29,29,29,29,29,29,29,29,29,29,29,29,29,29,29,29,29,29,30,30,30,30,30,30,30,30,30,30,30,30,30,30,30,30,30,30,30,30,30,30,30,30,30,31,31,31,31,31,31,31,31,31,31,31,31,31,31,31,31,31,31,31,31,31,31,31,31,31,31,31,31,31,31,31,31,31,31}};

typedef const Params __attribute__((address_space(4)))* KParams;
struct OutRef { float* out; DI float* operator+(size_t o) const { return out + o; } };
struct PRef { KParams kp; float* out; };
struct Ctx {
    PRef p; int tid, lane, wave, gw, ngw; LAS unsigned char* lds;
    DI const float* in(int i) const { return p.kp->in[i]; }
    template <class Tp> DI Tp* ws(size_t off) const { return (Tp*)(p.kp->ws + off); }
};

DI int rowmap(int n, int map) { return map == 0 ? n : (32 * (n >> 4) + (n & 15) + (map == 2 ? 16 : 0)); }
DI void transpose_item(const float* W, int K, int N, bf16_t* WT, int map, LAS float* scr, int item, int lane) {
    const int nblk = (N + 31) / 32, kb = item / nblk, nb = item % nblk, k0 = 64 * kb, n0 = 32 * nb;
#pragma unroll 8
    for (int i = 0; i < 32; ++i) { const int kk = 2 * i + (lane >> 5), n = n0 + (lane & 31); scr[kk * 33 + (lane & 31)] = n < N ? W[(size_t)(k0 + kk) * N + n] : 0.f; }
    LDS_WAIT();
    const int c = lane & 7;
#pragma unroll
    for (int j = 0; j < 4; ++j) {
        const int nn = (lane >> 3) + 8 * j, n = n0 + nn; const LAS float* s = scr + (8 * c) * 33 + nn;
        u32x4 o; o.x = pk2(s[0], s[33]); o.y = pk2(s[66], s[99]); o.z = pk2(s[132], s[165]); o.w = pk2(s[198], s[231]);
        if (n < N) *(u32x4*)(WT + (size_t)rowmap(n, map) * K + k0 + 8 * c) = o;
    }
    LDS_WAIT();
}
DI void transpose_mat(const Ctx& c, const float* W, int K, int N, bf16_t* WT, int map) {
    LAS float* scr = (LAS float*)(c.lds + c.wave * 8704);
    const int nit = (K / 64) * ((N + 31) / 32);
    for (int it = c.gw; it < nit; it += c.ngw) transpose_item(W, K, N, WT, map, scr, it, c.lane);
}

DI void rowpass_row(const float* xrow, const float* gorow, const float* gpost, const float* gnext, float* xdst, bf16_t* hrow, float* yout, int lane) {
    f32x4 x[4]; float ss = 0.f;
    if (gorow) {
        f32x4 g[4];
#pragma unroll
        for (int j = 0; j < 4; ++j) { g[j] = *(const f32x4*)(gorow + 4 * lane + 256 * j); ss += g[j].x * g[j].x + g[j].y * g[j].y + g[j].z * g[j].z + g[j].w * g[j].w; }
        const float r = rsqrtf(wave_sum(ss) * (1.f / D) + EPS);
#pragma unroll
        for (int j = 0; j < 4; ++j) { const f32x4 w = *(const f32x4*)(gpost + 4 * lane + 256 * j); x[j] = *(const f32x4*)(xrow + 4 * lane + 256 * j) + g[j] * r * w; }
    } else {
#pragma unroll
        for (int j = 0; j < 4; ++j) x[j] = *(const f32x4*)(xrow + 4 * lane + 256 * j);
    }
    if (xdst) {
#pragma unroll
        for (int j = 0; j < 4; ++j) *(f32x4*)(xdst + 4 * lane + 256 * j) = x[j];
    }
    if (yout) {
#pragma unroll
        for (int j = 0; j < 4; ++j) *(f32x4*)(yout + 4 * lane + 256 * j) = x[j];
    }
    if (hrow) {
        float s2 = 0.f;
#pragma unroll
        for (int j = 0; j < 4; ++j) s2 += x[j].x * x[j].x + x[j].y * x[j].y + x[j].z * x[j].z + x[j].w * x[j].w;
        const float r2 = rsqrtf(wave_sum(s2) * (1.f / D) + EPS);
#pragma unroll
        for (int j = 0; j < 4; ++j) { const f32x4 w = *(const f32x4*)(gnext + 4 * lane + 256 * j); const f32x4 h = x[j] * r2 * w;
            u32x2 o; o.x = pk2(h.x, h.y); o.y = pk2(h.z, h.w); *(u32x2*)(hrow + 4 * lane + 256 * j) = o; }
    }
}
DI void rowpass_phase(const Ctx& c, int mode, const float* gpost, const float* gnext, bool x_from_input) {
    float* X = c.ws<float>(W_X); const float* GO = c.ws<float>(W_GO); bf16_t* H = c.ws<bf16_t>(W_H);
    for (int row = c.gw; row < TT; row += c.ngw) {
        const float* xrow = x_from_input ? (row < T ? c.in(I_XP) + (size_t)row * D : c.in(I_XS) + (size_t)(row - T) * D) : X + (size_t)row * D;
        if (mode == 0) rowpass_row(xrow, nullptr, nullptr, gnext, nullptr, H + (size_t)row * D, nullptr, c.lane);
        else if (mode == 1) rowpass_row(xrow, GO + (size_t)row * D, gpost, gnext, X + (size_t)row * D, H + (size_t)row * D, nullptr, c.lane);
        else rowpass_row(xrow, GO + (size_t)row * D, gpost, nullptr, nullptr, nullptr, c.p.out + (row < T ? O_YP + (size_t)row * D : O_YS + (size_t)(row - T) * D), c.lane);
    }
}

struct Epi { int mode; bf16_t* ob; float* of; int ldo; int main_cols; };
DI void gemm_simple(const Ctx& c, const bf16_t* A, int lda, int M, const bf16_t* Bt, int ldb, int N, int K, const Epi e) {
    const int mblk = (M + 63) / 64, nblk = (N + 31) / 32, nit = mblk * nblk;
    const int fr = c.lane & 15, fq = c.lane >> 4;
    for (int it = c.gw; it < nit; it += c.ngw) {
        const int mb = it / nblk, nb = it % nblk, m0 = mb * 64, n0 = nb * 32;
        const bf16_t* ap[4]; const bf16_t* bp[2];
#pragma unroll
        for (int m = 0; m < 4; ++m) { int r = m0 + 16 * m + fr; r = r < M ? r : M - 1; ap[m] = A + (size_t)r * lda + 8 * fq; }
#pragma unroll
        for (int n = 0; n < 2; ++n) { int r = n0 + 16 * n + fr; r = r < N ? r : N - 1; bp[n] = Bt + (size_t)r * ldb + 8 * fq; }
        f32x4 acc[4][2];
#pragma unroll
        for (int m = 0; m < 4; ++m)
#pragma unroll
            for (int n = 0; n < 2; ++n) acc[m][n] = (f32x4){0.f, 0.f, 0.f, 0.f};
#pragma unroll 2
        for (int k0 = 0; k0 < K; k0 += 32) {
            bf16x8 a[4], b[2];
#pragma unroll
            for (int m = 0; m < 4; ++m) a[m] = *(const bf16x8*)(ap[m] + k0);
#pragma unroll
            for (int n = 0; n < 2; ++n) b[n] = *(const bf16x8*)(bp[n] + k0);
#pragma unroll
            for (int m = 0; m < 4; ++m)
#pragma unroll
                for (int n = 0; n < 2; ++n) acc[m][n] = __builtin_amdgcn_mfma_f32_16x16x32_bf16(b[n], a[m], acc[m][n], 0, 0, 0);
        }
#pragma unroll
        for (int m = 0; m < 4; ++m) {
            const int row = m0 + 16 * m + fr; if (row >= M) continue;
            if (e.mode == 2) {
                const f32x4 g = acc[m][0], u = acc[m][1]; u32x2 o;
                o.x = pk2(siluf(g.x) * u.x, siluf(g.y) * u.y); o.y = pk2(siluf(g.z) * u.z, siluf(g.w) * u.w);
                *(u32x2*)(e.ob + (size_t)row * e.ldo + 16 * nb + 4 * fq) = o;
            } else {
#pragma unroll
                for (int n = 0; n < 2; ++n) {
                    const int col = n0 + 16 * n + 4 * fq; if (col >= N) continue;
                    const f32x4 v = acc[m][n];
                    if (e.mode == 1) *(f32x4*)(e.of + (size_t)row * e.ldo + col) = v;
                    else if (col < e.main_cols) { u32x2 o; o.x = pk2(v.x, v.y); o.y = pk2(v.z, v.w); *(u32x2*)(e.ob + (size_t)row * e.ldo + col) = o; }
                    else *(f32x4*)(e.of + (size_t)row * 32 + (col - e.main_cols)) = v;
                }
            }
        }
    }
}

DI void attn_wave(const Ctx& c, int li, int tok, int h, LAS float* pl  ) {
    const bf16_t* PROJ = c.ws<bf16_t>(W_PROJ); bf16_t* MIX = c.ws<bf16_t>(W_MIXED);
    const int lane = c.lane; const bool smp = tok >= T;
    const int b = smp ? tok - T : tok / SEQ, s = smp ? WIN : tok % SEQ;
    const float* ck = c.in(I_CK) + ((size_t)(li * NS + b) * WIN) * AW + h * AHD;
    const float* cv = c.in(I_CV) + ((size_t)(li * NS + b) * WIN) * AW + h * AHD;
    const bf16_t* prow0 = smp ? PROJ + (size_t)tok * HYB_MAIN : PROJ + (size_t)(b * SEQ) * HYB_MAIN;
    float q[64];
    { const bf16_t* qp = PROJ + (size_t)tok * HYB_MAIN + h * AHD;
#pragma unroll
      for (int j = 0; j < 8; ++j) { const u32x4 v = *(const u32x4*)(qp + 8 * j);
          q[8*j+0] = bf2f((bf16_t)(v.x & 0xffff)) * 0.125f; q[8*j+1] = bf2f((bf16_t)(v.x >> 16)) * 0.125f; q[8*j+2] = bf2f((bf16_t)(v.y & 0xffff)) * 0.125f; q[8*j+3] = bf2f((bf16_t)(v.y >> 16)) * 0.125f;
          q[8*j+4] = bf2f((bf16_t)(v.z & 0xffff)) * 0.125f; q[8*j+5] = bf2f((bf16_t)(v.z >> 16)) * 0.125f; q[8*j+6] = bf2f((bf16_t)(v.w & 0xffff)) * 0.125f; q[8*j+7] = bf2f((bf16_t)(v.w >> 16)) * 0.125f; } }
    const float* relb = c.in(I_RELB);
    float mx = -1e30f;
#pragma unroll 1
    for (int pat = 0; pat < 3; ++pat) {
        const int d = pat == 0 ? 1 : (pat == 1 ? 4 : 16);
#pragma unroll 1
        for (int rnd = 0; rnd < 3; ++rnd) {
            const int j = rnd * 64 + lane; float lg = -1e30f;
            if (j <= 128) {
                const int R = s - j * d;
                if (R >= 0) {
                    float acc = 0.f;
                    if (smp && R < WIN) { const float* kp = ck + (size_t)R * AW;
#pragma unroll
                        for (int e = 0; e < 16; ++e) { const f32x4 v = *(const f32x4*)(kp + 4 * e); acc += q[4*e] * v.x + q[4*e+1] * v.y + q[4*e+2] * v.z + q[4*e+3] * v.w; }
                    } else { const bf16_t* kp = (smp ? prow0 : prow0 + (size_t)R * HYB_MAIN) + AW + h * AHD;
#pragma unroll
                        for (int e = 0; e < 8; ++e) { const u32x4 v = *(const u32x4*)(kp + 8 * e);
                            acc += q[8*e] * bf2f((bf16_t)(v.x & 0xffff)) + q[8*e+1] * bf2f((bf16_t)(v.x >> 16)) + q[8*e+2] * bf2f((bf16_t)(v.y & 0xffff)) + q[8*e+3] * bf2f((bf16_t)(v.y >> 16))
                                 + q[8*e+4] * bf2f((bf16_t)(v.z & 0xffff)) + q[8*e+5] * bf2f((bf16_t)(v.z >> 16)) + q[8*e+6] * bf2f((bf16_t)(v.w & 0xffff)) + q[8*e+7] * bf2f((bf16_t)(v.w >> 16)); }
                    }
                    lg = acc + relb[c_bucket[pat][j] * AH + h];
                }
                pl[pat * 132 + j] = lg;
            }
            mx = fmaxf(mx, lg);
        }
    }
    mx = wave_max(mx);
    LDS_WAIT();
    float ssum = 0.f;
#pragma unroll 1
    for (int i = lane; i < 396; i += 64) { const int pat = i / 132, j = i % 132; if (j <= 128) { const float lg = pl[i]; const float pv = lg > -1e29f ? __expf(lg - mx) : 0.f; pl[i] = pv; ssum += pv; } }
    ssum = wave_sum(ssum);
    LDS_WAIT();
    float o = 0.f;
#pragma unroll 1
    for (int pat = 0; pat < 3; ++pat) {
        const int d = pat == 0 ? 1 : (pat == 1 ? 4 : 16);
        int jmax = s / d; jmax = jmax > 128 ? 128 : jmax;
#pragma unroll 4
        for (int j = 0; j <= jmax; ++j) {
            const int R = s - j * d; const float pv = pl[pat * 132 + j];
            float vv;
            if (smp && R < WIN) vv = cv[(size_t)R * AW + lane];
            else vv = bf2f((smp ? prow0 : prow0 + (size_t)R * HYB_MAIN)[2 * AW + h * AHD + lane]);
            o += pv * vv;
        }
    }
    MIX[(size_t)tok * HYB_MIX + h * AHD + lane] = f2bf(o / ssum);
    LDS_WAIT();
}

DI void hyb_pre_token(const Ctx& c, int li, int tok) {
    const bf16_t* PROJ = c.ws<bf16_t>(W_PROJ); float* ACT = c.ws<float>(W_ACT); float* AUX = c.ws<float>(W_AUX); const float* EX = c.ws<float>(W_EXTRA);
    const int lane = c.lane; const bool smp = tok >= T; const int b = smp ? tok - T : tok / SEQ, s = smp ? 0 : tok % SEQ;
    const float* cw = c.in(I_SCW) + (size_t)li * 4 * SXBC; const float* cb = c.in(I_SCB) + (size_t)li * SXBC;
    const float* st = c.in(I_SCONV) + (size_t)(li * NS + b) * 3 * SXBC;
    const bf16_t* prow = PROJ + (size_t)tok * HYB_MAIN + 2560;
#pragma unroll 4
    for (int j = 0; j < 24; ++j) {
        const int ch = lane + 64 * j;
        const float x3 = bf2f(prow[ch]); float x0, x1, x2;
        if (smp) { x0 = st[ch]; x1 = st[SXBC + ch]; x2 = st[2 * SXBC + ch]; }
        else { x2 = s >= 1 ? bf2f(prow[ch - HYB_MAIN]) : 0.f; x1 = s >= 2 ? bf2f(prow[ch - 2 * HYB_MAIN]) : 0.f; x0 = s >= 3 ? bf2f(prow[ch - 3 * HYB_MAIN]) : 0.f; }
        const float y = x0 * cw[ch] + x1 * cw[SXBC + ch] + x2 * cw[2 * SXBC + ch] + x3 * cw[3 * SXBC + ch] + cb[ch];
        ACT[(size_t)tok * 4096 + ch] = siluf(y);
        if (smp) { float* o = c.p.out + O_SSC + (size_t)(li * NS + b) * 3 * SXBC; o[ch] = x1; o[SXBC + ch] = x2; o[2 * SXBC + ch] = x3; }
        else if (s >= SEQ - 3) c.p.out[O_PSC + ((size_t)(li * NB + b) * 3 + (s - (SEQ - 3))) * SXBC + ch] = x3;
    }
    if (lane < SH) AUX[(size_t)tok * 32 + lane] = softplusf_(EX[(size_t)tok * 32 + lane] + c.in(I_SDTB)[li * SH + lane]);
    if (smp || s >= SEQ - WIN) {
        float* ok = smp ? c.p.out + O_SK + ((size_t)(li * NS + b) * WIN + (WIN - 1)) * AW : c.p.out + O_PK + ((size_t)(li * NB + b) * WIN + (s - (SEQ - WIN))) * AW;
        float* ov = smp ? c.p.out + O_SV + ((size_t)(li * NS + b) * WIN + (WIN - 1)) * AW : c.p.out + O_PV + ((size_t)(li * NB + b) * WIN + (s - (SEQ - WIN))) * AW;
        const bf16_t* kr = PROJ + (size_t)tok * HYB_MAIN + AW;
#pragma unroll
        for (int j = 0; j < 8; ++j) { ok[lane + 64 * j] = bf2f(kr[lane + 64 * j]); ov[lane + 64 * j] = bf2f(kr[AW + lane + 64 * j]); }
    }
}

DI void ssd_wave(const Ctx& c, int li, int item) {
    const float* ACT = c.ws<float>(W_ACT); const float* AUX = c.ws<float>(W_AUX); float* Y = c.ws<float>(W_Y);
    const int lane = c.lane;
    const bool smp = item >= NB * SH * SP; const int it = smp ? item - NB * SH * SP : item;
    const int seq = it / (SH * SP), h = (it / SP) % SH, p = it % SP, g = h / (SH / SG);
    const int L = smp ? 1 : SEQ; const int tok0 = smp ? T + seq : seq * SEQ;
    const float Ah = -__expf(c.in(I_SALOG)[li * SH + h]), Dh = c.in(I_SD)[li * SH + h];
    float h0 = 0.f, h1 = 0.f;
    if (smp) { const float* s0 = c.in(I_SSM) + (((size_t)(li * NS + seq) * SH + h) * SP + p) * SN; h0 = s0[2 * lane]; h1 = s0[2 * lane + 1]; }
#pragma unroll 2
    for (int t = 0; t < L; ++t) {
        const float* a = ACT + (size_t)(tok0 + t) * 4096;
        const float dt = AUX[(size_t)(tok0 + t) * 32 + h], xv = a[h * SP + p];
        const float2 Bv = *(const float2*)(a + SDI + g * SN + 2 * lane), Cv = *(const float2*)(a + SDI + SG * SN + g * SN + 2 * lane);
        const float dec = __expf(dt * Ah), dx = dt * xv;
        h0 = h0 * dec + dx * Bv.x; h1 = h1 * dec + dx * Bv.y;
        const float y = wave_sum(h0 * Cv.x + h1 * Cv.y);
        if (lane == 0) Y[(size_t)(tok0 + t) * 2048 + h * SP + p] = y + Dh * xv;
    }
    float* so = smp ? c.p.out + O_SSS + (((size_t)(li * NS + seq) * SH + h) * SP + p) * SN : c.p.out + O_PSS + (((size_t)(li * NB + seq) * SH + h) * SP + p) * SN;
    *(float2*)(so + 2 * lane) = make_float2(h0, h1);
}
DI void hyb_post_token(const Ctx& c, int li, int tok) {
    const bf16_t* PROJ = c.ws<bf16_t>(W_PROJ); const float* Y = c.ws<float>(W_Y); bf16_t* MIX = c.ws<bf16_t>(W_MIXED);
    const float* nw = c.in(I_SNW) + (size_t)li * SDI; const int lane = c.lane;
    float v[16]; float ss0 = 0.f, ss1 = 0.f;
#pragma unroll
    for (int j = 0; j < 16; ++j) { const int ch = lane + 64 * j; const float z = bf2f(PROJ[(size_t)tok * HYB_MAIN + 1536 + ch]); v[j] = Y[(size_t)tok * 2048 + ch] * siluf(z); if (j < 8) ss0 += v[j] * v[j]; else ss1 += v[j] * v[j]; }
    const float r0 = rsqrtf(wave_sum(ss0) * (1.f / 512.f) + EPS), r1 = rsqrtf(wave_sum(ss1) * (1.f / 512.f) + EPS);
#pragma unroll
    for (int j = 0; j < 16; ++j) { const int ch = lane + 64 * j; MIX[(size_t)tok * HYB_MIX + AW + ch] = f2bf(v[j] * (j < 8 ? r0 : r1) * nw[ch]); }
}

DI void gdn_pre_token(const Ctx& c, int li, int tok) {
    const bf16_t* PROJ = c.ws<bf16_t>(W_PROJ); float* ACT = c.ws<float>(W_ACT); float* AUX = c.ws<float>(W_AUX); const float* EX = c.ws<float>(W_EXTRA);
    const int lane = c.lane; const bool smp = tok >= T; const int b = smp ? tok - T : tok / SEQ, s = smp ? 0 : tok % SEQ;
    const float* cw = c.in(I_GCW) + (size_t)li * 4 * GQKV;
    const float* st = c.in(I_GCONV) + (size_t)(li * NS + b) * 3 * GQKV;
    const bf16_t* prow = PROJ + (size_t)tok * GDN_MAIN;
    float* osc = c.p.out + O_SGC + (size_t)(li * NS + b) * 3 * GQKV;
#pragma unroll 1
    for (int hc = 0; hc < 32; ++hc) {
        float v[2];
#pragma unroll
        for (int e = 0; e < 2; ++e) {
            const int ch = hc * 128 + e * 64 + lane;
            const float x3 = bf2f(prow[ch]); float x0, x1, x2;
            if (smp) { x0 = st[ch]; x1 = st[GQKV + ch]; x2 = st[2 * GQKV + ch]; }
            else { x2 = s >= 1 ? bf2f(prow[ch - GDN_MAIN]) : 0.f; x1 = s >= 2 ? bf2f(prow[ch - 2 * GDN_MAIN]) : 0.f; x0 = s >= 3 ? bf2f(prow[ch - 3 * GDN_MAIN]) : 0.f; }
            v[e] = siluf(x0 * cw[ch] + x1 * cw[GQKV + ch] + x2 * cw[2 * GQKV + ch] + x3 * cw[3 * GQKV + ch]);
            if (smp) { osc[ch] = x1; osc[GQKV + ch] = x2; osc[2 * GQKV + ch] = x3; }
            else if (s >= SEQ - 3) c.p.out[O_PGC + ((size_t)(li * NB + b) * 3 + (s - (SEQ - 3))) * GQKV + ch] = x3;
        }
        if (hc < 16) {
            const float ss = wave_sum(v[0] * v[0] + v[1] * v[1]);
            const float r = rsqrtf(ss + EPS) * (hc < 8 ? 0.08838834764831845f : 1.f);
            v[0] *= r; v[1] *= r;
        }
        ACT[(size_t)tok * 4096 + hc * 128 + lane] = v[0]; ACT[(size_t)tok * 4096 + hc * 128 + 64 + lane] = v[1];
    }
    if (lane < GH) {
        AUX[(size_t)tok * 32 + lane] = sigmoidf_(EX[(size_t)tok * 32 + lane]);
        AUX[(size_t)tok * 32 + 16 + lane] = -__expf(c.in(I_GALOG)[li * GH + lane]) * softplusf_(EX[(size_t)tok * 32 + 16 + lane] + c.in(I_GDTB)[li * GH + lane]);
    }
}
DI void gdn_seq_phase(const Ctx& c, int li) {
    const float* ACT = c.ws<float>(W_ACT); const float* AUX = c.ws<float>(W_AUX); float* Y = c.ws<float>(W_Y);
    const int slot = c.tid >> 8, t8 = c.tid & 255, col = t8 >> 1, half = t8 & 1;
    LAS float* kq = (LAS float*)c.lds + slot * 512;
    const int nslot = gridDim.x * 2;
    for (int base = 0; base < NB * GH + NS * GH; base += nslot) {
        const int item = base + blockIdx.x * 2 + slot;
        const bool wg_prompt = (base + blockIdx.x * 2) < NB * GH;
        const int L = wg_prompt ? SEQ : 1;
        const bool valid = item < NB * GH + NS * GH;
        const bool smp = item >= NB * GH; const int it = smp ? item - NB * GH : item;
        const int seq = valid ? it / GH : 0, vh = valid ? it % GH : 0, hq = vh >> 1;
        const int tok0 = smp ? T + seq : seq * SEQ;
        float S[64];
        if (valid && smp) { const float* s0 = c.in(I_GST) + ((size_t)(li * NS + seq) * GH + vh) * GDK * GDV + (size_t)(64 * half) * GDV + col;
#pragma unroll
            for (int k = 0; k < 64; ++k) S[k] = s0[(size_t)k * GDV]; }
        else {
#pragma unroll
            for (int k = 0; k < 64; ++k) S[k] = 0.f; }
        __syncthreads();
        for (int t = 0; t < L; ++t) {
            LAS float* cur = kq + (t & 1) * 256;
            const float* a = ACT + (size_t)(tok0 + t) * 4096;
            cur[t8] = a[(t8 < 128 ? 1024 : -128) + hq * 128 + t8];
            const float vv = a[2048 + vh * 128 + col], beta = AUX[(size_t)(tok0 + t) * 32 + vh], eg = __expf(AUX[(size_t)(tok0 + t) * 32 + 16 + vh]);
            __syncthreads();
            const LAS float* kk = cur + 64 * half; const LAS float* qq = cur + 128 + 64 * half;
            float ks = 0.f;
#pragma unroll
            for (int k = 0; k < 64; k += 4) { const f32x4 kv = *(const LAS f32x4*)(kk + k); ks += kv.x * S[k] + kv.y * S[k + 1] + kv.z * S[k + 2] + kv.w * S[k + 3]; }
            ks += __shfl_xor(ks, 1);
            const float u = beta * (vv - eg * ks);
            asm volatile("" ::: "memory");
            float o = 0.f;
#pragma unroll
            for (int k = 0; k < 64; k += 4) { const f32x4 kv = *(const LAS f32x4*)(kk + k); const f32x4 qv = *(const LAS f32x4*)(qq + k);
                S[k] = eg * S[k] + kv.x * u; S[k + 1] = eg * S[k + 1] + kv.y * u; S[k + 2] = eg * S[k + 2] + kv.z * u; S[k + 3] = eg * S[k + 3] + kv.w * u;
                o += qv.x * S[k] + qv.y * S[k + 1] + qv.z * S[k + 2] + qv.w * S[k + 3]; }
            o += __shfl_xor(o, 1);
            if (valid && half == 0) Y[(size_t)(tok0 + t) * 2048 + vh * 128 + col] = o;
        }
        if (valid) { float* so = (smp ? c.p.out + O_SGS + ((size_t)(li * NS + seq) * GH + vh) * GDK * GDV : c.p.out + O_PGS + ((size_t)(li * NB + seq) * GH + vh) * GDK * GDV) + (size_t)(64 * half) * GDV + col;
#pragma unroll
            for (int k = 0; k < 64; ++k) so[(size_t)k * GDV] = S[k]; }
        __syncthreads();
    }
}
DI void gdn_post_token(const Ctx& c, int li, int tok) {
    const bf16_t* PROJ = c.ws<bf16_t>(W_PROJ); const float* Y = c.ws<float>(W_Y); bf16_t* MIX = c.ws<bf16_t>(W_MIXED);
    const float* nw = c.in(I_GNW) + (size_t)li * GDV; const int lane = c.lane;
#pragma unroll 4
    for (int vh = 0; vh < GH; ++vh) {
        const float o0 = Y[(size_t)tok * 2048 + vh * 128 + lane], o1 = Y[(size_t)tok * 2048 + vh * 128 + 64 + lane];
        const float r = rsqrtf(wave_sum(o0 * o0 + o1 * o1) * (1.f / 128.f) + EPS);
        const float z0 = bf2f(PROJ[(size_t)tok * GDN_MAIN + 4096 + vh * 128 + lane]), z1 = bf2f(PROJ[(size_t)tok * GDN_MAIN + 4096 + vh * 128 + 64 + lane]);
        MIX[(size_t)tok * GVW + vh * 128 + lane] = f2bf(o0 * r * nw[lane] * siluf(z0));
        MIX[(size_t)tok * GVW + vh * 128 + 64 + lane] = f2bf(o1 * r * nw[64 + lane] * siluf(z1));
    }
}

constexpr int PH_PER_LAYER = 10, N_PHASES = 1 + DEPTH * PH_PER_LAYER;
#ifndef ONLY
#define ONLY -1
#endif
#define EN(x) (ONLY < 0 || ONLY == (x))
DI void run_phase(const Ctx& c, int ph) {
    if (ph == 0) { if (!EN(0)) return;
        for (int i = 0; i < 2; ++i) {
            transpose_mat(c, c.in(I_WHIN) + (size_t)i * D * HYB_IN, D, HYB_IN, c.ws<bf16_t>(W_HIN) + (size_t)i * HYB_IN * D, 0);
            transpose_mat(c, c.in(I_WHOUT) + (size_t)i * HYB_MIX * D, HYB_MIX, D, c.ws<bf16_t>(W_HOUT) + (size_t)i * D * HYB_MIX, 0);
            transpose_mat(c, c.in(I_WGIN) + (size_t)i * D * GDN_IN, D, GDN_IN, c.ws<bf16_t>(W_GIN) + (size_t)i * GDN_IN * D, 0);
            transpose_mat(c, c.in(I_WGOUT) + (size_t)i * GVW * D, GVW, D, c.ws<bf16_t>(W_GOUT) + (size_t)i * D * GVW, 0);
        }
        for (int l = 0; l < 4; ++l) {
            transpose_mat(c, c.in(I_WFG) + (size_t)l * D * FF, D, FF, c.ws<bf16_t>(W_GU) + (size_t)l * 2 * FF * D, 1);
            transpose_mat(c, c.in(I_WFU) + (size_t)l * D * FF, D, FF, c.ws<bf16_t>(W_GU) + (size_t)l * 2 * FF * D, 2);
            transpose_mat(c, c.in(I_WFD) + (size_t)l * FF * D, FF, D, c.ws<bf16_t>(W_DN) + (size_t)l * D * FF, 0);
        }
        rowpass_phase(c, 0, nullptr, c.in(I_NMPRE), true);
        const size_t gt = (size_t)blockIdx.x * NTHR + c.tid, gn = (size_t)gridDim.x * NTHR;
        const size_t per = (size_t)(WIN - 1) * AW / 4, tot = (size_t)2 * NS * per;
        for (size_t i = gt; i < tot; i += gn) { const size_t sq = i / per, r = i % per;
            ((f32x4*)(c.p.out + O_SK + sq * WIN * AW))[r] = ((const f32x4*)(c.in(I_CK) + sq * WIN * AW + AW))[r];
            ((f32x4*)(c.p.out + O_SV + sq * WIN * AW))[r] = ((const f32x4*)(c.in(I_CV) + sq * WIN * AW + AW))[r]; }
        return;
    }
    const int l = (ph - 1) / PH_PER_LAYER, sp = (ph - 1) % PH_PER_LAYER, li = l >> 1; const bool hyb = (l & 1) == 0;
    bf16_t* H = c.ws<bf16_t>(W_H); bf16_t* PROJ = c.ws<bf16_t>(W_PROJ); bf16_t* MIX = c.ws<bf16_t>(W_MIXED); float* GO = c.ws<float>(W_GO); bf16_t* HID = c.ws<bf16_t>(W_HID);
    switch (sp) {
    case 0: {
        if (!EN(1)) break;
        if (hyb) { Epi e{0, PROJ, c.ws<float>(W_EXTRA), HYB_MAIN, HYB_MAIN}; gemm_simple(c, H, D, TT, c.ws<bf16_t>(W_HIN) + (size_t)li * HYB_IN * D, D, HYB_IN, D, e); }
        else { Epi e{0, PROJ, c.ws<float>(W_EXTRA), GDN_MAIN, GDN_MAIN}; gemm_simple(c, H, D, TT, c.ws<bf16_t>(W_GIN) + (size_t)li * GDN_IN * D, D, GDN_IN, D, e); }
    } break;
    case 1: {
        if (hyb) {
            if (EN(2)) for (int tok = c.gw; tok < TT; tok += c.ngw) hyb_pre_token(c, li, tok);
            LAS float* pl = (LAS float*)(c.lds + c.wave * 2048);
            if (EN(3)) for (int it = c.gw; it < TT * AH; it += c.ngw) attn_wave(c, li, it / AH, it % AH, pl);
        } else { if (EN(4)) for (int tok = c.gw; tok < TT; tok += c.ngw) gdn_pre_token(c, li, tok); }
    } break;
    case 2: {
        if (hyb) { if (EN(5)) for (int it = c.gw; it < (NB + NS) * SH * SP; it += c.ngw) ssd_wave(c, li, it); }
        else if (EN(6)) gdn_seq_phase(c, li);
    } break;
    case 3: {
        if (hyb) { if (EN(7)) for (int tok = c.gw; tok < TT; tok += c.ngw) hyb_post_token(c, li, tok); }
        else { if (EN(8)) for (int tok = c.gw; tok < TT; tok += c.ngw) gdn_post_token(c, li, tok); }
    } break;
    case 4: {
        if (!EN(9)) break;
        Epi e{1, nullptr, GO, D, 0};
        if (hyb) gemm_simple(c, MIX, HYB_MIX, TT, c.ws<bf16_t>(W_HOUT) + (size_t)li * D * HYB_MIX, HYB_MIX, D, HYB_MIX, e);
        else gemm_simple(c, MIX, GVW, TT, c.ws<bf16_t>(W_GOUT) + (size_t)li * D * GVW, GVW, D, GVW, e);
    } break;
    case 5: if (EN(10)) rowpass_phase(c, 1, c.in(I_NMPOST) + (size_t)l * D, c.in(I_NFPRE) + (size_t)l * D, l == 0); break;
    case 6: if (EN(11)) { Epi e{2, HID, nullptr, FF, 0}; gemm_simple(c, H, D, TT, c.ws<bf16_t>(W_GU) + (size_t)l * 2 * FF * D, D, 2 * FF, D, e); } break;
    case 7: if (EN(12)) { Epi e{1, nullptr, GO, D, 0}; gemm_simple(c, HID, FF, TT, c.ws<bf16_t>(W_DN) + (size_t)l * D * FF, FF, D, FF, e); } break;
    case 8: if (EN(13)) rowpass_phase(c, l == DEPTH - 1 ? 2 : 1, c.in(I_NFPOST) + (size_t)l * D, l == DEPTH - 1 ? nullptr : c.in(I_NMPRE) + (size_t)(l + 1) * D, false); break;
    default: break;
    }
}

extern __shared__ __attribute__((aligned(16))) unsigned char g_shm[];
__global__ void __launch_bounds__(NTHR, 2) mega(Params p) {
    cg::grid_group grid = cg::this_grid();
    Ctx c; c.p.kp = (KParams)__builtin_amdgcn_kernarg_segment_ptr(); c.p.out = p.out; c.tid = threadIdx.x; c.lane = threadIdx.x & 63; c.wave = __builtin_amdgcn_readfirstlane(threadIdx.x >> 6);
    c.gw = blockIdx.x * NWAVE + c.wave; c.ngw = gridDim.x * NWAVE; c.lds = (LAS unsigned char*)g_shm;
    for (int ph = p.ph_lo; ph < p.ph_hi; ++ph) {
        run_phase(c, ph);
        if (ph + 1 < p.ph_hi) grid.sync();
    }
}

extern "C" void kernel_launch(void* const* d_in, const int* in_sizes, int n_in, void* d_out, int out_size, void* d_ws, size_t ws_size, hipStream_t stream) {
    static int grid = 0;
    if (!grid) {
        int dev = 0, cus = 0, per = 0; hipGetDevice(&dev); hipDeviceGetAttribute(&cus, hipDeviceAttributeMultiprocessorCount, dev);
        hipFuncSetAttribute((const void*)mega, hipFuncAttributeMaxDynamicSharedMemorySize, LDS_BYTES);
        hipOccupancyMaxActiveBlocksPerMultiprocessor(&per, (const void*)mega, NTHR, LDS_BYTES);
        if (n_in != 30 || (size_t)out_size != O_END || ws_size < W_END) fprintf(stderr, "kernel_launch: unexpected shapes n_in %d out %d (want %zu) ws %zu (want %zu)\n", n_in, out_size, (size_t)O_END, ws_size, (size_t)W_END);
        if (per < 1) fprintf(stderr, "kernel_launch: occupancy query says %d blocks per CU\n", per);
        grid = cus;
    }
    Params p{}; for (int i = 0; i < 30; ++i) p.in[i] = (const float*)d_in[i];
    p.out = (float*)d_out; p.ws = (unsigned char*)d_ws; p.ph_lo = 0; p.ph_hi = N_PHASES;
    void* args[] = {&p};
    hipError_t e = hipLaunchCooperativeKernel((const void*)mega, dim3(grid), dim3(NTHR), args, LDS_BYTES, stream);
    if (e != hipSuccess) fprintf(stderr, "kernel_launch: cooperative launch failed: %s\n", hipGetErrorString(e));
}
```

```cpp
#include <hip/hip_runtime.h>
#include <hip/hip_cooperative_groups.h>
#include <cstdio>
#include <cstdint>
namespace cg = cooperative_groups;

#define DI __device__ __forceinline__
#define LAS __attribute__((address_space(3)))
typedef unsigned short bf16_t;
typedef short bf16x8 __attribute__((ext_vector_type(8)));
typedef float f32x4 __attribute__((ext_vector_type(4)));
typedef unsigned u32x2 __attribute__((ext_vector_type(2)));
typedef unsigned u32x4 __attribute__((ext_vector_type(4)));

constexpr int D = 1024, NB = 4, SEQ = 4096, T = NB * SEQ, NS = 32, TT = T + NS, DEPTH = 4;
constexpr int AH = 8, AHD = 64, AW = 512, WIN = 2048;
constexpr int SH = 16, SP = 64, SN = 128, SG = 2, SDI = 1024, SXBC = 1536;
constexpr int HYB_IN = 4112, HYB_MAIN = 4096, HYB_MIX = 1536;
constexpr int GH = 16, GQH = 8, GDK = 128, GDV = 128, GQKV = 4096, GVW = 2048, GDN_IN = 6176, GDN_MAIN = 6144;
constexpr int FF = 2816;
constexpr float EPS = 1e-6f;
constexpr int NTHR = 512, NWAVE = 8, LDS_BYTES = 163840;

enum { I_XP = 0, I_XS, I_CK, I_CV, I_SCONV, I_SSM, I_GCONV, I_GST, I_RELB, I_NMPRE, I_NMPOST, I_NFPRE, I_NFPOST, I_WHIN, I_SCW, I_SCB, I_SDTB, I_SALOG, I_SD, I_SNW,
       I_WHOUT, I_WGIN, I_GCW, I_GDTB, I_GALOG, I_GNW, I_WGOUT, I_WFG, I_WFU, I_WFD };

constexpr size_t O_YP = 0;
constexpr size_t O_YS = O_YP + (size_t)T * D;
constexpr size_t O_PK = O_YS + (size_t)NS * D;
constexpr size_t O_PV = O_PK + (size_t)2 * NB * WIN * AW;
constexpr size_t O_PSC = O_PV + (size_t)2 * NB * WIN * AW;
constexpr size_t O_PSS = O_PSC + (size_t)2 * NB * 3 * SXBC;
constexpr size_t O_PGC = O_PSS + (size_t)2 * NB * SH * SP * SN;
constexpr size_t O_PGS = O_PGC + (size_t)2 * NB * 3 * GQKV;
constexpr size_t O_SK = O_PGS + (size_t)2 * NB * GH * GDK * GDV;
constexpr size_t O_SV = O_SK + (size_t)2 * NS * WIN * AW;
constexpr size_t O_SSC = O_SV + (size_t)2 * NS * WIN * AW;
constexpr size_t O_SSS = O_SSC + (size_t)2 * NS * 3 * SXBC;
constexpr size_t O_SGC = O_SSS + (size_t)2 * NS * SH * SP * SN;
constexpr size_t O_SGS = O_SGC + (size_t)2 * NS * 3 * GQKV;
constexpr size_t O_END = O_SGS + (size_t)2 * NS * GH * GDK * GDV;

constexpr size_t al256(size_t x) { return (x + 255) & ~(size_t)255; }
constexpr size_t W_CTL = 0;
constexpr size_t W_HIN = 65536;
constexpr size_t W_HOUT = al256(W_HIN + (size_t)2 * HYB_IN * D * 2);
constexpr size_t W_GIN = al256(W_HOUT + (size_t)2 * D * HYB_MIX * 2);
constexpr size_t W_GOUT = al256(W_GIN + (size_t)2 * GDN_IN * D * 2);
constexpr size_t W_GU = al256(W_GOUT + (size_t)2 * D * GVW * 2);
constexpr size_t W_DN = al256(W_GU + (size_t)4 * 2 * FF * D * 2);
constexpr size_t W_X = al256(W_DN + (size_t)4 * D * FF * 2);
constexpr size_t W_H = al256(W_X + (size_t)TT * D * 4);
constexpr size_t W_PROJ = al256(W_H + (size_t)TT * D * 2);
constexpr size_t W_EXTRA = al256(W_PROJ + (size_t)TT * GDN_MAIN * 2);
constexpr size_t W_MIXED = al256(W_EXTRA + (size_t)TT * 32 * 4);
constexpr size_t W_GO = al256(W_MIXED + (size_t)TT * GVW * 2);
constexpr size_t W_HID = al256(W_GO + (size_t)TT * D * 4);
constexpr size_t W_ACT = al256(W_HID + (size_t)TT * FF * 2);
constexpr size_t W_AUX = al256(W_ACT + (size_t)TT * 4096 * 4);
constexpr size_t W_Y = al256(W_AUX + (size_t)TT * 32 * 4);
constexpr size_t W_END = al256(W_Y + (size_t)TT * 2048 * 4);

struct Params { const float* in[30]; float* out; unsigned char* ws; int ph_lo, ph_hi; };

DI float bf2f(bf16_t b) { return __uint_as_float(((unsigned)b) << 16); }
DI bf16_t f2bf(float x) { unsigned u = __float_as_uint(x); u += 0x7fffu + ((u >> 16) & 1u); return (bf16_t)(u >> 16); }
DI unsigned pk2(float lo, float hi) { return (unsigned)f2bf(lo) | ((unsigned)f2bf(hi) << 16); }
DI float wave_sum(float v) {
#pragma unroll
    for (int o = 32; o >= 1; o >>= 1) v += __shfl_xor(v, o);
    return v;
}
DI float wave_max(float v) {
#pragma unroll
    for (int o = 32; o >= 1; o >>= 1) v = fmaxf(v, __shfl_xor(v, o));
    return v;
}
DI float siluf(float x) { return x / (1.f + __expf(-x)); }
DI float sigmoidf_(float x) { return 1.f / (1.f + __expf(-x)); }
DI float softplusf_(float x) { return fmaxf(x, 0.f) + log1pf(__expf(-fabsf(x))); }
#define LDS_WAIT() asm volatile("s_waitcnt lgkmcnt(0)" ::: "memory")

__device__ const unsigned char c_bucket[3][129] = {
 {0,1,2,3,4,5,6,7,8,9,10,11,12,13,14,15,16,16,16,16,16,16,17,17,17,17,17,17,17,17,18,18,18,18,18,18,18,18,18,18,19,19,19,19,19,19,19,19,19,19,19,19,19,19,20,20,20,20,20,20,20,20,20,20,20,20,20,20,20,20,20,20,20,21,21,21,21,21,21,21,21,21,21,21,21,21,21,21,21,21,21,21,21,21,21,21,21,21,21,22,22,22,22,22,22,22,22,22,22,22,22,22,22,22,22,22,22,22,22,22,22,22,22,22,22,22,22,22,22},
 {0,4,8,12,16,16,17,17,18,18,19,19,19,19,20,20,20,20,20,21,21,21,21,21,21,22,22,22,22,22,22,22,22,22,23,23,23,23,23,23,23,23,23,23,23,23,24,24,24,24,24,24,24,24,24,24,24,24,24,24,24,24,25,25,25,25,25,25,25,25,25,25,25,25,25,25,25,25,25,25,25,25,25,26,26,26,26,26,26,26,26,26,26,26,26,26,26,26,26,26,26,26,26,26,26,26,26,26,26,26,26,26,26,27,27,27,27,27,27,27,27,27,27,27,27,27,27,27,27},
 {0,16,18,19,20,21,21,22,22,23,23,23,24,24,24,24,25,25,25,25,25,26,26,26,26,26,26,26,26,27,27,27,27,27,27,27,27,27,27,28,28,28,28,28,28,28,28,28,28,28,28,28,29,29,29,29,29,29,29,29,29,29,29,29,29,29,29,29,29,29,30,30,30,30,30,30,30,30,30,30,30,30,30,30,30,30,30,30,30,30,30,30,30,30,30,31,31,31,31,31,31,31,31,31,31,31,31,31,31,31,31,31,31,31,31,31,31,31,31,31,31,31,31,31,31,31,31,31,31}};

typedef const Params __attribute__((address_space(4)))* KParams;
struct OutRef { float* out; DI float* operator+(size_t o) const { return out + o; } };
struct PRef { KParams kp; float* out; };
struct Ctx {
    PRef p; int tid, lane, wave, gw, ngw; LAS unsigned char* lds;
    DI const float* in(int i) const { return p.kp->in[i]; }
    template <class Tp> DI Tp* ws(size_t off) const { return (Tp*)(p.kp->ws + off); }
};

DI int rowmap(int n, int map) { return map == 0 ? n : (32 * (n >> 4) + (n & 15) + (map == 2 ? 16 : 0)); }
DI void transpose_item(const float* W, int K, int N, bf16_t* WT, int map, LAS float* scr, int item, int lane) {
    const int nblk = (N + 31) / 32, kb = item / nblk, nb = item % nblk, k0 = 64 * kb, n0 = 32 * nb;
#pragma unroll 8
    for (int i = 0; i < 32; ++i) { const int kk = 2 * i + (lane >> 5), n = n0 + (lane & 31); scr[kk * 33 + (lane & 31)] = n < N ? W[(size_t)(k0 + kk) * N + n] : 0.f; }
    LDS_WAIT();
    const int c = lane & 7;
#pragma unroll
    for (int j = 0; j < 4; ++j) {
        const int nn = (lane >> 3) + 8 * j, n = n0 + nn; const LAS float* s = scr + (8 * c) * 33 + nn;
        u32x4 o; o.x = pk2(s[0], s[33]); o.y = pk2(s[66], s[99]); o.z = pk2(s[132], s[165]); o.w = pk2(s[198], s[231]);
        if (n < N) *(u32x4*)(WT + (size_t)rowmap(n, map) * K + k0 + 8 * c) = o;
    }
    LDS_WAIT();
}
DI void transpose_mat(const Ctx& c, const float* W, int K, int N, bf16_t* WT, int map) {
    LAS float* scr = (LAS float*)(c.lds + c.wave * 8704);
    const int nit = (K / 64) * ((N + 31) / 32);
    for (int it = c.gw; it < nit; it += c.ngw) transpose_item(W, K, N, WT, map, scr, it, c.lane);
}

DI void rowpass_row(const float* xrow, const float* gorow, const float* gpost, const float* gnext, float* xdst, bf16_t* hrow, float* yout, int lane) {
    f32x4 x[4]; float ss = 0.f;
    if (gorow) {
        f32x4 g[4];
#pragma unroll
        for (int j = 0; j < 4; ++j) { g[j] = *(const f32x4*)(gorow + 4 * lane + 256 * j); ss += g[j].x * g[j].x + g[j].y * g[j].y + g[j].z * g[j].z + g[j].w * g[j].w; }
        const float r = rsqrtf(wave_sum(ss) * (1.f / D) + EPS);
#pragma unroll
        for (int j = 0; j < 4; ++j) { const f32x4 w = *(const f32x4*)(gpost + 4 * lane + 256 * j); x[j] = *(const f32x4*)(xrow + 4 * lane + 256 * j) + g[j] * r * w; }
    } else {
#pragma unroll
        for (int j = 0; j < 4; ++j) x[j] = *(const f32x4*)(xrow + 4 * lane + 256 * j);
    }
    if (xdst) {
#pragma unroll
        for (int j = 0; j < 4; ++j) *(f32x4*)(xdst + 4 * lane + 256 * j) = x[j];
    }
    if (yout) {
#pragma unroll
        for (int j = 0; j < 4; ++j) *(f32x4*)(yout + 4 * lane + 256 * j) = x[j];
    }
    if (hrow) {
        float s2 = 0.f;
#pragma unroll
        for (int j = 0; j < 4; ++j) s2 += x[j].x * x[j].x + x[j].y * x[j].y + x[j].z * x[j].z + x[j].w * x[j].w;
        const float r2 = rsqrtf(wave_sum(s2) * (1.f / D) + EPS);
#pragma unroll
        for (int j = 0; j < 4; ++j) { const f32x4 w = *(const f32x4*)(gnext + 4 * lane + 256 * j); const f32x4 h = x[j] * r2 * w;
            u32x2 o; o.x = pk2(h.x, h.y); o.y = pk2(h.z, h.w); *(u32x2*)(hrow + 4 * lane + 256 * j) = o; }
    }
}
DI void rowpass_phase(const Ctx& c, int mode, const float* gpost, const float* gnext, bool x_from_input) {
    float* X = c.ws<float>(W_X); const float* GO = c.ws<float>(W_GO); bf16_t* H = c.ws<bf16_t>(W_H);
    for (int row = c.gw; row < TT; row += c.ngw) {
        const float* xrow = x_from_input ? (row < T ? c.in(I_XP) + (size_t)row * D : c.in(I_XS) + (size_t)(row - T) * D) : X + (size_t)row * D;
        if (mode == 0) rowpass_row(xrow, nullptr, nullptr, gnext, nullptr, H + (size_t)row * D, nullptr, c.lane);
        else if (mode == 1) rowpass_row(xrow, GO + (size_t)row * D, gpost, gnext, X + (size_t)row * D, H + (size_t)row * D, nullptr, c.lane);
        else rowpass_row(xrow, GO + (size_t)row * D, gpost, nullptr, nullptr, nullptr, c.p.out + (row < T ? O_YP + (size_t)row * D : O_YS + (size_t)(row - T) * D), c.lane);
    }
}

namespace pg8 {
#define PG8_LAS __attribute__((address_space(3)))
typedef unsigned short bf16_t;
typedef short bf16x8 __attribute__((ext_vector_type(8)));
typedef float f32x4 __attribute__((ext_vector_type(4)));
typedef unsigned u32x4 __attribute__((ext_vector_type(4)));
constexpr int BM = 256, BK = 64, HALF = 128, HTB = HALF * BK * 2  , STAGE_BYTES = 8 * HTB, NXCD = 8, WGM = 8;

__host__ __device__ __forceinline__ int lds_byte(int r, int c) { const int st = (r >> 4) * 2 + (c >> 5), rr = r & 15, cc = c & 31, ob = rr * 64 + cc * 2; return st * 1024 + (ob ^ (((ob >> 9) & 1) << 5)); }
__host__ __device__ __forceinline__ void stage_rc(int b, int& R, int& C) { const int st = b / 1024, sb = b % 1024, swz = sb ^ (((sb >> 9) & 1) << 5); R = (st >> 1) * 16 + swz / 64; C = (st & 1) * 32 + (swz % 64) / 2; }
__host__ __device__ __forceinline__ int perm32(int rho) { const int n = rho >> 4, i = rho & 15; return 8 * (i >> 2) + 4 * n + (i & 3); }

struct Unit { int pm, pn; };
struct Gemm { const bf16_t* A; const bf16_t* Bt; int M, N, K; };

struct StaticOrder {
    int nM, nN, nwg, G, c;
    __host__ __device__ void init(int M, int N, int G_, int c_) { nM = M / BM; nN = N / BM; nwg = nM * nN; G = G_; c = c_; }
    __host__ __device__ bool next(int i, Unit& u) const {
        const long L = (long)i * G + c; if (L >= nwg) return false;
        int wgid = (int)L; { const int q = nwg / NXCD, r = nwg % NXCD, xcd = wgid % NXCD, off = wgid / NXCD; wgid = (xcd < r ? xcd * (q + 1) : r * (q + 1) + (xcd - r) * q) + off; }
        const int nig = WGM * nN, gid = wgid / nig, fm = gid * WGM, gsz = (nM - fm) < WGM ? (nM - fm) : WGM;
        u.pm = fm + ((wgid % nig) % gsz); u.pn = (wgid % nig) / gsz; return true;
    }
    __device__ __forceinline__ void a_ready(const Unit&) const {}
    __device__ __forceinline__ void done(const Unit&) const {}
};
__device__ __forceinline__ unsigned cvt_pk_bf16(float lo, float hi) { unsigned r; asm volatile("v_cvt_pk_bf16_f32 %0, %1, %2" : "=v"(r) : "v"(lo), "v"(hi)); return r; }
typedef float f32x2 __attribute__((ext_vector_type(2)));
struct EpiF32 {
    static constexpr bool PERM = false, AFTER_DRAIN = false;
    float* C; int ldc; const float* bias;
    __device__ __forceinline__ void operator()(const f32x4 (&acc)[2][2][4][2], const Unit& u, int wr, int wc, int fr, int fq) const {
        const int row0 = u.pm * BM + wr * 64 + fr, col0 = u.pn * BM + wc * 32 + 4 * fq;
        f32x4 bv[2][2];
#pragma unroll
        for (int bj = 0; bj < 2; ++bj)
#pragma unroll
            for (int n = 0; n < 2; ++n) bv[bj][n] = bias ? *(const f32x4*)(bias + col0 + bj * HALF + n * 16) : (f32x4){0.f, 0.f, 0.f, 0.f};
#pragma unroll
        for (int ai = 0; ai < 2; ++ai)
#pragma unroll
            for (int m = 0; m < 4; ++m) { float* rowp = C + (size_t)(row0 + ai * HALF + m * 16) * ldc + col0;
#pragma unroll
                for (int bj = 0; bj < 2; ++bj)
#pragma unroll
                    for (int n = 0; n < 2; ++n) *(f32x4*)(rowp + bj * HALF + n * 16) = acc[ai][bj][m][n] + bv[bj][n]; }
    }
};
template <class Epi, class Sched, bool STAMP = false>
__device__ __forceinline__ void gemm_phase(PG8_LAS unsigned char* lds, const Gemm g, const Sched& S, const Epi& E, unsigned long long* stamps) {
    int tid_ = threadIdx.x; asm volatile("" : "+v"(tid_));
    const int tid = tid_, wid = __builtin_amdgcn_readfirstlane(tid >> 6), lane = tid & 63, wr = wid >> 2, wc = wid & 3, fr = lane & 15, fq = lane >> 4;
    const int K = g.K, nt = K / BK;
    int ts_lo = 0, ts_hi = 0, nts = 0; const unsigned long long rt_entry = STAMP ? (unsigned long long)wall_clock64() : 0ull;
#define PG8_STAMP() do { if (STAMP && wid == 0 && nts < 64) { const unsigned long long _c = (unsigned long long)clock64(); \
        ts_lo = (lane == nts) ? (int)(unsigned)_c : ts_lo; ts_hi = (lane == nts) ? (int)(unsigned)(_c >> 32) : ts_hi; ++nts; } } while (0)
    PG8_STAMP();
    unsigned voffA[2], voffB[2];
#pragma unroll
    for (int i = 0; i < 2; ++i) { int R, C; stage_rc(tid * 16 + i * 8192, R, C); const int Rb = Epi::PERM ? ((R & ~31) + perm32(R & 31)) : R;
        voffA[i] = (unsigned)(R * K + C) * 2u; voffB[i] = (unsigned)(Rb * K + C) * 2u; }
    const size_t kstep = (size_t)(BK * 2);
    const size_t hstep = (size_t)HALF * K * 2;
    const size_t tstep = 2 * hstep;
    const unsigned ldsw = (unsigned)wid * 1024u;
    const int aoff = lds_byte(wr * 64 + fr, fq * 8), boff = lds_byte(wc * 32 + fr, fq * 8);
#define PG8_SA(b, h) (((b) * 2 + (h)) * HTB)
#define PG8_SB(b, h) ((4 + (b) * 2 + (h)) * HTB)
#define PG8_STAGE(bufoff, gbase, voff) do { _Pragma("unroll") for (int _i = 0; _i < 2; ++_i) \
        __builtin_amdgcn_global_load_lds((const unsigned*)((const char*)(gbase) + (voff)[_i]), (PG8_LAS unsigned*)(lds + (bufoff) + ldsw + _i * 8192), 16, 0, 0); } while (0)
#define PG8_LDA(dst, b, h) do { _Pragma("unroll") for (int m = 0; m < 4; ++m) _Pragma("unroll") for (int k = 0; k < 2; ++k) dst[m][k] = *(const PG8_LAS bf16x8*)(lds + PG8_SA(b, h) + aoff + m * 2048 + k * 1024); } while (0)
#define PG8_LDB(dst, b, h) do { _Pragma("unroll") for (int n = 0; n < 2; ++n) _Pragma("unroll") for (int k = 0; k < 2; ++k) dst[n][k] = *(const PG8_LAS bf16x8*)(lds + PG8_SB(b, h) + boff + n * 2048 + k * 1024); } while (0)
#define PG8_MMA(ai, bj, At, Bt) do { __builtin_amdgcn_s_setprio(1); _Pragma("unroll") for (int m = 0; m < 4; ++m) _Pragma("unroll") for (int n = 0; n < 2; ++n) _Pragma("unroll") for (int k = 0; k < 2; ++k) \
        acc[ai][bj][m][n] = __builtin_amdgcn_mfma_f32_16x16x32_bf16(Bt[n][k], At[m][k], acc[ai][bj][m][n], 0, 0, 0); __builtin_amdgcn_s_setprio(0); } while (0)
#define PG8_WAIT_V(n) asm volatile("s_waitcnt vmcnt(" #n ")" ::: "memory")
#define PG8_WAIT_L(n) asm volatile("s_waitcnt lgkmcnt(" #n ")" ::: "memory")
#define PG8_BAR __builtin_amdgcn_s_barrier()
#define PG8_SCHED __builtin_amdgcn_sched_barrier(0)
    Unit cur, nxt; int ui = 0;
    if (!S.next(0, cur)) return;
    f32x4 acc[2][2][4][2];
#pragma unroll
    for (int a = 0; a < 2; ++a)
#pragma unroll
        for (int b = 0; b < 2; ++b)
#pragma unroll
            for (int m = 0; m < 4; ++m)
#pragma unroll
                for (int n = 0; n < 2; ++n) acc[a][b][m][n] = (f32x4){0.f, 0.f, 0.f, 0.f};
    bf16x8 At[4][2], B0[2][2], B1[2][2];
    const char* cA = (const char*)g.A + (size_t)cur.pm * tstep; const char* cB = (const char*)g.Bt + (size_t)cur.pn * tstep;
    S.a_ready(cur);
    PG8_STAGE(PG8_SB(0, 0), cB, voffB); PG8_STAGE(PG8_SA(0, 0), cA, voffA); PG8_STAGE(PG8_SB(0, 1), cB + hstep, voffB); PG8_STAGE(PG8_SA(0, 1), cA + hstep, voffA);
    if (wr == 1) PG8_BAR;
    PG8_WAIT_V(4); PG8_BAR;
    PG8_STAGE(PG8_SB(1, 0), cB + kstep, voffB); PG8_STAGE(PG8_SA(1, 0), cA + kstep, voffA); PG8_STAGE(PG8_SB(1, 1), cB + hstep + kstep, voffB);
    PG8_WAIT_V(6); PG8_BAR;
    PG8_STAMP();
    for (;;) {
        const bool has_next = S.next(ui + 1, nxt);
        const char* nA = has_next ? (const char*)g.A + (size_t)nxt.pm * tstep : cA; const char* nB = has_next ? (const char*)g.Bt + (size_t)nxt.pn * tstep : cB;
        for (int t = 0; t < nt; t += 2) {
            const bool last = (t == nt - 2);
            const char* a1 = cA + (size_t)(t + 1) * kstep;
            const char* a2 = last ? nA : cA + (size_t)(t + 2) * kstep; const char* b2 = last ? nB : cB + (size_t)(t + 2) * kstep;
            const char* a3 = a2 + kstep; const char* b3 = b2 + kstep;
            if (last && has_next) S.a_ready(nxt);
            PG8_LDB(B0, 0, 0); PG8_SCHED; PG8_LDA(At, 0, 0); PG8_STAGE(PG8_SA(1, 1), a1 + hstep, voffA);
            PG8_WAIT_L(8); PG8_BAR; PG8_WAIT_L(0); PG8_MMA(0, 0, At, B0); PG8_BAR; PG8_SCHED;
            PG8_LDB(B1, 0, 1); PG8_STAGE(PG8_SB(0, 0), b2, voffB);
            PG8_BAR; PG8_WAIT_L(0); PG8_MMA(0, 1, At, B1); PG8_BAR;
            PG8_LDA(At, 0, 1); PG8_STAGE(PG8_SA(0, 0), a2, voffA);
            PG8_BAR; PG8_WAIT_L(0); PG8_MMA(1, 0, At, B0); PG8_BAR; PG8_SCHED;
            PG8_STAGE(PG8_SB(0, 1), b2 + hstep, voffB);
            PG8_WAIT_V(6); PG8_BAR; PG8_MMA(1, 1, At, B1); PG8_BAR;
            PG8_LDB(B0, 1, 0); PG8_SCHED; PG8_LDA(At, 1, 0); PG8_STAGE(PG8_SA(0, 1), a2 + hstep, voffA);
            PG8_WAIT_L(8); PG8_BAR; PG8_WAIT_L(0); PG8_MMA(0, 0, At, B0); PG8_BAR; PG8_SCHED;
            PG8_LDB(B1, 1, 1); PG8_STAGE(PG8_SB(1, 0), b3, voffB);
            PG8_BAR; PG8_WAIT_L(0); PG8_MMA(0, 1, At, B1); PG8_BAR;
            PG8_LDA(At, 1, 1); PG8_STAGE(PG8_SA(1, 0), a3, voffA);
            PG8_BAR; PG8_WAIT_L(0); PG8_MMA(1, 0, At, B0); PG8_BAR; PG8_SCHED;
            PG8_STAGE(PG8_SB(1, 1), b3 + hstep, voffB);
            PG8_WAIT_V(6); PG8_BAR; PG8_MMA(1, 1, At, B1); PG8_BAR;
        }
        PG8_STAMP();
        if constexpr (!Epi::AFTER_DRAIN) { E(acc, cur, wr, wc, fr, fq); S.done(cur); }
        PG8_STAMP();
        if (!has_next) break;
#pragma unroll
        for (int a = 0; a < 2; ++a)
#pragma unroll
            for (int b = 0; b < 2; ++b)
#pragma unroll
                for (int m = 0; m < 4; ++m)
#pragma unroll
                    for (int n = 0; n < 2; ++n) acc[a][b][m][n] = (f32x4){0.f, 0.f, 0.f, 0.f};
        cur = nxt; cA = nA; cB = nB; ++ui;
    }
    PG8_WAIT_V(0);
    if (wr == 0) PG8_BAR;
    PG8_BAR;
    if constexpr (Epi::AFTER_DRAIN) { E.fused(acc, cur, wr, wc, fr, fq, lds, wid, lane); S.done(cur); }
    PG8_STAMP();
    if (STAMP && wid == 0) { stamps[lane] = lane < nts ? (((unsigned long long)(unsigned)ts_hi << 32) | (unsigned)ts_lo) : 0ull;
        if (lane == 62) stamps[62] = rt_entry; if (lane == 63) stamps[63] = (unsigned long long)wall_clock64(); }
#undef PG8_STAMP
#undef PG8_SA
#undef PG8_SB
#undef PG8_STAGE
#undef PG8_LDA
#undef PG8_LDB
#undef PG8_MMA
#undef PG8_WAIT_V
#undef PG8_WAIT_L
#undef PG8_BAR
#undef PG8_SCHED
}
}

namespace pg8 {
struct EpiBf16Plain {
    static constexpr bool PERM = false, AFTER_DRAIN = false;
    bf16_t* O; int ldc;
    __device__ __forceinline__ void operator()(const f32x4 (&acc)[2][2][4][2], const Unit& u, int wr, int wc, int fr, int fq) const {
        const int row0 = u.pm * BM + wr * 64 + fr, col0 = u.pn * BM + wc * 32 + 4 * fq;
#pragma unroll
        for (int ai = 0; ai < 2; ++ai)
#pragma unroll
            for (int m = 0; m < 4; ++m) { bf16_t* rowp = O + (size_t)(row0 + ai * HALF + m * 16) * ldc + col0;
#pragma unroll
                for (int bj = 0; bj < 2; ++bj)
#pragma unroll
                    for (int n = 0; n < 2; ++n) { const f32x4 v = acc[ai][bj][m][n]; unsigned long long w = (unsigned long long)cvt_pk_bf16(v[0], v[1]) | ((unsigned long long)cvt_pk_bf16(v[2], v[3]) << 32);
                        *(unsigned long long*)(rowp + bj * HALF + n * 16) = w; } }
    }
};
struct EpiSwiglu {
    static constexpr bool PERM = false, AFTER_DRAIN = false;
    bf16_t* O; int ldc;
    __device__ __forceinline__ void operator()(const f32x4 (&acc)[2][2][4][2], const Unit& u, int wr, int wc, int fr, int fq) const {
        const int row0 = u.pm * BM + wr * 64 + fr, col0 = u.pn * (BM / 2) + wc * 16 + 4 * fq;
#pragma unroll
        for (int ai = 0; ai < 2; ++ai)
#pragma unroll
            for (int m = 0; m < 4; ++m) { bf16_t* rowp = O + (size_t)(row0 + ai * HALF + m * 16) * ldc + col0;
#pragma unroll
                for (int bj = 0; bj < 2; ++bj) { const f32x4 g = acc[ai][bj][m][0], up = acc[ai][bj][m][1]; float h[4];
#pragma unroll
                    for (int e = 0; e < 4; ++e) h[e] = g[e] / (1.f + __expf(-g[e])) * up[e];
                    unsigned long long w = (unsigned long long)cvt_pk_bf16(h[0], h[1]) | ((unsigned long long)cvt_pk_bf16(h[2], h[3]) << 32);
                    *(unsigned long long*)(rowp + bj * (HALF / 2)) = w; } }
    }
};
}

struct Epi { int mode; bf16_t* ob; float* of; int ldo; int main_cols; };
DI void gemm_simple(const Ctx& c, const bf16_t* A, int lda, int M, const bf16_t* Bt, int ldb, int N, int K, const Epi e) {
    const int mblk = (M + 63) / 64, nblk = (N + 31) / 32, nit = mblk * nblk;
    const int fr = c.lane & 15, fq = c.lane >> 4;
    for (int it = c.gw; it < nit; it += c.ngw) {
        const int mb = it / nblk, nb = it % nblk, m0 = mb * 64, n0 = nb * 32;
        const bf16_t* ap[4]; const bf16_t* bp[2];
#pragma unroll
        for (int m = 0; m < 4; ++m) { int r = m0 + 16 * m + fr; r = r < M ? r : M - 1; ap[m] = A + (size_t)r * lda + 8 * fq; }
#pragma unroll
        for (int n = 0; n < 2; ++n) { int r = n0 + 16 * n + fr; r = r < N ? r : N - 1; bp[n] = Bt + (size_t)r * ldb + 8 * fq; }
        f32x4 acc[4][2];
#pragma unroll
        for (int m = 0; m < 4; ++m)
#pragma unroll
            for (int n = 0; n < 2; ++n) acc[m][n] = (f32x4){0.f, 0.f, 0.f, 0.f};
#pragma unroll 2
        for (int k0 = 0; k0 < K; k0 += 32) {
            bf16x8 a[4], b[2];
#pragma unroll
            for (int m = 0; m < 4; ++m) a[m] = *(const bf16x8*)(ap[m] + k0);
#pragma unroll
            for (int n = 0; n < 2; ++n) b[n] = *(const bf16x8*)(bp[n] + k0);
#pragma unroll
            for (int m = 0; m < 4; ++m)
#pragma unroll
                for (int n = 0; n < 2; ++n) acc[m][n] = __builtin_amdgcn_mfma_f32_16x16x32_bf16(b[n], a[m], acc[m][n], 0, 0, 0);
        }
#pragma unroll
        for (int m = 0; m < 4; ++m) {
            const int row = m0 + 16 * m + fr; if (row >= M) continue;
            if (e.mode == 2) {
                const f32x4 g = acc[m][0], u = acc[m][1]; u32x2 o;
                o.x = pk2(siluf(g.x) * u.x, siluf(g.y) * u.y); o.y = pk2(siluf(g.z) * u.z, siluf(g.w) * u.w);
                *(u32x2*)(e.ob + (size_t)row * e.ldo + 16 * nb + 4 * fq) = o;
            } else {
#pragma unroll
                for (int n = 0; n < 2; ++n) {
                    const int col = n0 + 16 * n + 4 * fq; if (col >= N) continue;
                    const f32x4 v = acc[m][n];
                    if (e.mode == 1) *(f32x4*)(e.of + (size_t)row * e.ldo + col) = v;
                    else if (col < e.main_cols) { u32x2 o; o.x = pk2(v.x, v.y); o.y = pk2(v.z, v.w); *(u32x2*)(e.ob + (size_t)row * e.ldo + col) = o; }
                    else *(f32x4*)(e.of + (size_t)row * 32 + (col - e.main_cols)) = v;
                }
            }
        }
    }
}

DI void attn_wave(const Ctx& c, int li, int tok, int h, LAS float* pl  ) {
    const bf16_t* PROJ = c.ws<bf16_t>(W_PROJ); bf16_t* MIX = c.ws<bf16_t>(W_MIXED);
    const int lane = c.lane; const bool smp = tok >= T;
    const int b = smp ? tok - T : tok / SEQ, s = smp ? WIN : tok % SEQ;
    const float* ck = c.in(I_CK) + ((size_t)(li * NS + b) * WIN) * AW + h * AHD;
    const float* cv = c.in(I_CV) + ((size_t)(li * NS + b) * WIN) * AW + h * AHD;
    const bf16_t* prow0 = smp ? PROJ + (size_t)tok * HYB_MAIN : PROJ + (size_t)(b * SEQ) * HYB_MAIN;
    float q[64];
    { const bf16_t* qp = PROJ + (size_t)tok * HYB_MAIN + h * AHD;
#pragma unroll
      for (int j = 0; j < 8; ++j) { const u32x4 v = *(const u32x4*)(qp + 8 * j);
          q[8*j+0] = bf2f((bf16_t)(v.x & 0xffff)) * 0.125f; q[8*j+1] = bf2f((bf16_t)(v.x >> 16)) * 0.125f; q[8*j+2] = bf2f((bf16_t)(v.y & 0xffff)) * 0.125f; q[8*j+3] = bf2f((bf16_t)(v.y >> 16)) * 0.125f;
          q[8*j+4] = bf2f((bf16_t)(v.z & 0xffff)) * 0.125f; q[8*j+5] = bf2f((bf16_t)(v.z >> 16)) * 0.125f; q[8*j+6] = bf2f((bf16_t)(v.w & 0xffff)) * 0.125f; q[8*j+7] = bf2f((bf16_t)(v.w >> 16)) * 0.125f; } }
    const float* relb = c.in(I_RELB);
    float mx = -1e30f;
#pragma unroll 1
    for (int pat = 0; pat < 3; ++pat) {
        const int d = pat == 0 ? 1 : (pat == 1 ? 4 : 16);
#pragma unroll 1
        for (int rnd = 0; rnd < 3; ++rnd) {
            const int j = rnd * 64 + lane; float lg = -1e30f;
            if (j <= 128) {
                const int R = s - j * d;
                if (R >= 0) {
                    float acc = 0.f;
                    if (smp && R < WIN) { const float* kp = ck + (size_t)R * AW;
#pragma unroll
                        for (int e = 0; e < 16; ++e) { const f32x4 v = *(const f32x4*)(kp + 4 * e); acc += q[4*e] * v.x + q[4*e+1] * v.y + q[4*e+2] * v.z + q[4*e+3] * v.w; }
                    } else { const bf16_t* kp = (smp ? prow0 : prow0 + (size_t)R * HYB_MAIN) + AW + h * AHD;
#pragma unroll
                        for (int e = 0; e < 8; ++e) { const u32x4 v = *(const u32x4*)(kp + 8 * e);
                            acc += q[8*e] * bf2f((bf16_t)(v.x & 0xffff)) + q[8*e+1] * bf2f((bf16_t)(v.x >> 16)) + q[8*e+2] * bf2f((bf16_t)(v.y & 0xffff)) + q[8*e+3] * bf2f((bf16_t)(v.y >> 16))
                                 + q[8*e+4] * bf2f((bf16_t)(v.z & 0xffff)) + q[8*e+5] * bf2f((bf16_t)(v.z >> 16)) + q[8*e+6] * bf2f((bf16_t)(v.w & 0xffff)) + q[8*e+7] * bf2f((bf16_t)(v.w >> 16)); }
                    }
                    lg = acc + relb[c_bucket[pat][j] * AH + h];
                }
                pl[pat * 132 + j] = lg;
            }
            mx = fmaxf(mx, lg);
        }
    }
    mx = wave_max(mx);
    LDS_WAIT();
    float ssum = 0.f;
#pragma unroll 1
    for (int i = lane; i < 396; i += 64) { const int pat = i / 132, j = i % 132; if (j <= 128) { const float lg = pl[i]; const float pv = lg > -1e29f ? __expf(lg - mx) : 0.f; pl[i] = pv; ssum += pv; } }
    ssum = wave_sum(ssum);
    LDS_WAIT();
    float o = 0.f;
#pragma unroll 1
    for (int pat = 0; pat < 3; ++pat) {
        const int d = pat == 0 ? 1 : (pat == 1 ? 4 : 16);
        int jmax = s / d; jmax = jmax > 128 ? 128 : jmax;
#pragma unroll 4
        for (int j = 0; j <= jmax; ++j) {
            const int R = s - j * d; const float pv = pl[pat * 132 + j];
            float vv;
            if (smp && R < WIN) vv = cv[(size_t)R * AW + lane];
            else vv = bf2f((smp ? prow0 : prow0 + (size_t)R * HYB_MAIN)[2 * AW + h * AHD + lane]);
            o += pv * vv;
        }
    }
    MIX[(size_t)tok * HYB_MIX + h * AHD + lane] = f2bf(o / ssum);
    LDS_WAIT();
}

DI void hyb_pre_token(const Ctx& c, int li, int tok) {
    const bf16_t* PROJ = c.ws<bf16_t>(W_PROJ); float* ACT = c.ws<float>(W_ACT); float* AUX = c.ws<float>(W_AUX); const float* EX = c.ws<float>(W_EXTRA);
    const int lane = c.lane; const bool smp = tok >= T; const int b = smp ? tok - T : tok / SEQ, s = smp ? 0 : tok % SEQ;
    const float* cw = c.in(I_SCW) + (size_t)li * 4 * SXBC; const float* cb = c.in(I_SCB) + (size_t)li * SXBC;
    const float* st = c.in(I_SCONV) + (size_t)(li * NS + b) * 3 * SXBC;
    const bf16_t* prow = PROJ + (size_t)tok * HYB_MAIN + 2560;
#pragma unroll 4
    for (int j = 0; j < 24; ++j) {
        const int ch = lane + 64 * j;
        const float x3 = bf2f(prow[ch]); float x0, x1, x2;
        if (smp) { x0 = st[ch]; x1 = st[SXBC + ch]; x2 = st[2 * SXBC + ch]; }
        else { x2 = s >= 1 ? bf2f(prow[ch - HYB_MAIN]) : 0.f; x1 = s >= 2 ? bf2f(prow[ch - 2 * HYB_MAIN]) : 0.f; x0 = s >= 3 ? bf2f(prow[ch - 3 * HYB_MAIN]) : 0.f; }
        const float y = x0 * cw[ch] + x1 * cw[SXBC + ch] + x2 * cw[2 * SXBC + ch] + x3 * cw[3 * SXBC + ch] + cb[ch];
        ACT[(size_t)tok * 4096 + ch] = siluf(y);
        if (smp) { float* o = c.p.out + O_SSC + (size_t)(li * NS + b) * 3 * SXBC; o[ch] = x1; o[SXBC + ch] = x2; o[2 * SXBC + ch] = x3; }
        else if (s >= SEQ - 3) c.p.out[O_PSC + ((size_t)(li * NB + b) * 3 + (s - (SEQ - 3))) * SXBC + ch] = x3;
    }
    if (lane < SH) AUX[(size_t)tok * 32 + lane] = softplusf_(EX[(size_t)tok * 32 + lane] + c.in(I_SDTB)[li * SH + lane]);
    if (smp || s >= SEQ - WIN) {
        float* ok = smp ? c.p.out + O_SK + ((size_t)(li * NS + b) * WIN + (WIN - 1)) * AW : c.p.out + O_PK + ((size_t)(li * NB + b) * WIN + (s - (SEQ - WIN))) * AW;
        float* ov = smp ? c.p.out + O_SV + ((size_t)(li * NS + b) * WIN + (WIN - 1)) * AW : c.p.out + O_PV + ((size_t)(li * NB + b) * WIN + (s - (SEQ - WIN))) * AW;
        const bf16_t* kr = PROJ + (size_t)tok * HYB_MAIN + AW;
#pragma unroll
        for (int j = 0; j < 8; ++j) { ok[lane + 64 * j] = bf2f(kr[lane + 64 * j]); ov[lane + 64 * j] = bf2f(kr[AW + lane + 64 * j]); }
    }
}

DI void ssd_wave(const Ctx& c, int li, int item) {
    const float* ACT = c.ws<float>(W_ACT); const float* AUX = c.ws<float>(W_AUX); float* Y = c.ws<float>(W_Y);
    const int lane = c.lane;
    const bool smp = item >= NB * SH * SP; const int it = smp ? item - NB * SH * SP : item;
    const int seq = it / (SH * SP), h = (it / SP) % SH, p = it % SP, g = h / (SH / SG);
    const int L = smp ? 1 : SEQ; const int tok0 = smp ? T + seq : seq * SEQ;
    const float Ah = -__expf(c.in(I_SALOG)[li * SH + h]), Dh = c.in(I_SD)[li * SH + h];
    float h0 = 0.f, h1 = 0.f;
    if (smp) { const float* s0 = c.in(I_SSM) + (((size_t)(li * NS + seq) * SH + h) * SP + p) * SN; h0 = s0[2 * lane]; h1 = s0[2 * lane + 1]; }
#pragma unroll 2
    for (int t = 0; t < L; ++t) {
        const float* a = ACT + (size_t)(tok0 + t) * 4096;
        const float dt = AUX[(size_t)(tok0 + t) * 32 + h], xv = a[h * SP + p];
        const float2 Bv = *(const float2*)(a + SDI + g * SN + 2 * lane), Cv = *(const float2*)(a + SDI + SG * SN + g * SN + 2 * lane);
        const float dec = __expf(dt * Ah), dx = dt * xv;
        h0 = h0 * dec + dx * Bv.x; h1 = h1 * dec + dx * Bv.y;
        const float y = wave_sum(h0 * Cv.x + h1 * Cv.y);
        if (lane == 0) Y[(size_t)(tok0 + t) * 2048 + h * SP + p] = y + Dh * xv;
    }
    float* so = smp ? c.p.out + O_SSS + (((size_t)(li * NS + seq) * SH + h) * SP + p) * SN : c.p.out + O_PSS + (((size_t)(li * NB + seq) * SH + h) * SP + p) * SN;
    *(float2*)(so + 2 * lane) = make_float2(h0, h1);
}
DI void hyb_post_token(const Ctx& c, int li, int tok) {
    const bf16_t* PROJ = c.ws<bf16_t>(W_PROJ); const float* Y = c.ws<float>(W_Y); bf16_t* MIX = c.ws<bf16_t>(W_MIXED);
    const float* nw = c.in(I_SNW) + (size_t)li * SDI; const int lane = c.lane;
    float v[16]; float ss0 = 0.f, ss1 = 0.f;
#pragma unroll
    for (int j = 0; j < 16; ++j) { const int ch = lane + 64 * j; const float z = bf2f(PROJ[(size_t)tok * HYB_MAIN + 1536 + ch]); v[j] = Y[(size_t)tok * 2048 + ch] * siluf(z); if (j < 8) ss0 += v[j] * v[j]; else ss1 += v[j] * v[j]; }
    const float r0 = rsqrtf(wave_sum(ss0) * (1.f / 512.f) + EPS), r1 = rsqrtf(wave_sum(ss1) * (1.f / 512.f) + EPS);
#pragma unroll
    for (int j = 0; j < 16; ++j) { const int ch = lane + 64 * j; MIX[(size_t)tok * HYB_MIX + AW + ch] = f2bf(v[j] * (j < 8 ? r0 : r1) * nw[ch]); }
}

DI void gdn_pre_token(const Ctx& c, int li, int tok) {
    const bf16_t* PROJ = c.ws<bf16_t>(W_PROJ); float* ACT = c.ws<float>(W_ACT); float* AUX = c.ws<float>(W_AUX); const float* EX = c.ws<float>(W_EXTRA);
    const int lane = c.lane; const bool smp = tok >= T; const int b = smp ? tok - T : tok / SEQ, s = smp ? 0 : tok % SEQ;
    const float* cw = c.in(I_GCW) + (size_t)li * 4 * GQKV;
    const float* st = c.in(I_GCONV) + (size_t)(li * NS + b) * 3 * GQKV;
    const bf16_t* prow = PROJ + (size_t)tok * GDN_MAIN;
    float* osc = c.p.out + O_SGC + (size_t)(li * NS + b) * 3 * GQKV;
#pragma unroll 1
    for (int hc = 0; hc < 32; ++hc) {
        float v[2];
#pragma unroll
        for (int e = 0; e < 2; ++e) {
            const int ch = hc * 128 + e * 64 + lane;
            const float x3 = bf2f(prow[ch]); float x0, x1, x2;
            if (smp) { x0 = st[ch]; x1 = st[GQKV + ch]; x2 = st[2 * GQKV + ch]; }
            else { x2 = s >= 1 ? bf2f(prow[ch - GDN_MAIN]) : 0.f; x1 = s >= 2 ? bf2f(prow[ch - 2 * GDN_MAIN]) : 0.f; x0 = s >= 3 ? bf2f(prow[ch - 3 * GDN_MAIN]) : 0.f; }
            v[e] = siluf(x0 * cw[ch] + x1 * cw[GQKV + ch] + x2 * cw[2 * GQKV + ch] + x3 * cw[3 * GQKV + ch]);
            if (smp) { osc[ch] = x1; osc[GQKV + ch] = x2; osc[2 * GQKV + ch] = x3; }
            else if (s >= SEQ - 3) c.p.out[O_PGC + ((size_t)(li * NB + b) * 3 + (s - (SEQ - 3))) * GQKV + ch] = x3;
        }
        if (hc < 16) {
            const float ss = wave_sum(v[0] * v[0] + v[1] * v[1]);
            const float r = rsqrtf(ss + EPS) * (hc < 8 ? 0.08838834764831845f : 1.f);
            v[0] *= r; v[1] *= r;
        }
        ACT[(size_t)tok * 4096 + hc * 128 + lane] = v[0]; ACT[(size_t)tok * 4096 + hc * 128 + 64 + lane] = v[1];
    }
    if (lane < GH) {
        AUX[(size_t)tok * 32 + lane] = sigmoidf_(EX[(size_t)tok * 32 + lane]);
        AUX[(size_t)tok * 32 + 16 + lane] = -__expf(c.in(I_GALOG)[li * GH + lane]) * softplusf_(EX[(size_t)tok * 32 + 16 + lane] + c.in(I_GDTB)[li * GH + lane]);
    }
}
DI void gdn_seq_phase(const Ctx& c, int li) {
    const float* ACT = c.ws<float>(W_ACT); const float* AUX = c.ws<float>(W_AUX); float* Y = c.ws<float>(W_Y);
    const int slot = c.tid >> 8, t8 = c.tid & 255, col = t8 >> 1, half = t8 & 1;
    LAS float* kq = (LAS float*)c.lds + slot * 512;
    const int nslot = gridDim.x * 2;
    for (int base = 0; base < NB * GH + NS * GH; base += nslot) {
        const int item = base + blockIdx.x * 2 + slot;
        const bool wg_prompt = (base + blockIdx.x * 2) < NB * GH;
        const int L = wg_prompt ? SEQ : 1;
        const bool valid = item < NB * GH + NS * GH;
        const bool smp = item >= NB * GH; const int it = smp ? item - NB * GH : item;
        const int seq = valid ? it / GH : 0, vh = valid ? it % GH : 0, hq = vh >> 1;
        const int tok0 = smp ? T + seq : seq * SEQ;
        float S[64];
        if (valid && smp) { const float* s0 = c.in(I_GST) + ((size_t)(li * NS + seq) * GH + vh) * GDK * GDV + (size_t)(64 * half) * GDV + col;
#pragma unroll
            for (int k = 0; k < 64; ++k) S[k] = s0[(size_t)k * GDV]; }
        else {
#pragma unroll
            for (int k = 0; k < 64; ++k) S[k] = 0.f; }
        __syncthreads();
        for (int t = 0; t < L; ++t) {
            LAS float* cur = kq + (t & 1) * 256;
            const float* a = ACT + (size_t)(tok0 + t) * 4096;
            cur[t8] = a[(t8 < 128 ? 1024 : -128) + hq * 128 + t8];
            const float vv = a[2048 + vh * 128 + col], beta = AUX[(size_t)(tok0 + t) * 32 + vh], eg = __expf(AUX[(size_t)(tok0 + t) * 32 + 16 + vh]);
            __syncthreads();
            const LAS float* kk = cur + 64 * half; const LAS float* qq = cur + 128 + 64 * half;
            float ks = 0.f;
#pragma unroll
            for (int k = 0; k < 64; k += 4) { const f32x4 kv = *(const LAS f32x4*)(kk + k); ks += kv.x * S[k] + kv.y * S[k + 1] + kv.z * S[k + 2] + kv.w * S[k + 3]; }
            ks += __shfl_xor(ks, 1);
            const float u = beta * (vv - eg * ks);
            asm volatile("" ::: "memory");
            float o = 0.f;
#pragma unroll
            for (int k = 0; k < 64; k += 4) { const f32x4 kv = *(const LAS f32x4*)(kk + k); const f32x4 qv = *(const LAS f32x4*)(qq + k);
                S[k] = eg * S[k] + kv.x * u; S[k + 1] = eg * S[k + 1] + kv.y * u; S[k + 2] = eg * S[k + 2] + kv.z * u; S[k + 3] = eg * S[k + 3] + kv.w * u;
                o += qv.x * S[k] + qv.y * S[k + 1] + qv.z * S[k + 2] + qv.w * S[k + 3]; }
            o += __shfl_xor(o, 1);
            if (valid && half == 0) Y[(size_t)(tok0 + t) * 2048 + vh * 128 + col] = o;
        }
        if (valid) { float* so = (smp ? c.p.out + O_SGS + ((size_t)(li * NS + seq) * GH + vh) * GDK * GDV : c.p.out + O_PGS + ((size_t)(li * NB + seq) * GH + vh) * GDK * GDV) + (size_t)(64 * half) * GDV + col;
#pragma unroll
            for (int k = 0; k < 64; ++k) so[(size_t)k * GDV] = S[k]; }
        __syncthreads();
    }
}
DI void gdn_post_token(const Ctx& c, int li, int tok) {
    const bf16_t* PROJ = c.ws<bf16_t>(W_PROJ); const float* Y = c.ws<float>(W_Y); bf16_t* MIX = c.ws<bf16_t>(W_MIXED);
    const float* nw = c.in(I_GNW) + (size_t)li * GDV; const int lane = c.lane;
#pragma unroll 4
    for (int vh = 0; vh < GH; ++vh) {
        const float o0 = Y[(size_t)tok * 2048 + vh * 128 + lane], o1 = Y[(size_t)tok * 2048 + vh * 128 + 64 + lane];
        const float r = rsqrtf(wave_sum(o0 * o0 + o1 * o1) * (1.f / 128.f) + EPS);
        const float z0 = bf2f(PROJ[(size_t)tok * GDN_MAIN + 4096 + vh * 128 + lane]), z1 = bf2f(PROJ[(size_t)tok * GDN_MAIN + 4096 + vh * 128 + 64 + lane]);
        MIX[(size_t)tok * GVW + vh * 128 + lane] = f2bf(o0 * r * nw[lane] * siluf(z0));
        MIX[(size_t)tok * GVW + vh * 128 + 64 + lane] = f2bf(o1 * r * nw[64 + lane] * siluf(z1));
    }
}

constexpr int PH_PER_LAYER = 10, N_PHASES = 1 + DEPTH * PH_PER_LAYER;
#ifndef ONLY
#define ONLY -1
#endif
#define EN(x) (ONLY < 0 || ONLY == (x))
DI void run_phase(const Ctx& c, int ph) {
    if (ph == 0) { if (!EN(0)) return;
        for (int i = 0; i < 2; ++i) {
            transpose_mat(c, c.in(I_WHIN) + (size_t)i * D * HYB_IN, D, HYB_IN, c.ws<bf16_t>(W_HIN) + (size_t)i * HYB_IN * D, 0);
            transpose_mat(c, c.in(I_WHOUT) + (size_t)i * HYB_MIX * D, HYB_MIX, D, c.ws<bf16_t>(W_HOUT) + (size_t)i * D * HYB_MIX, 0);
            transpose_mat(c, c.in(I_WGIN) + (size_t)i * D * GDN_IN, D, GDN_IN, c.ws<bf16_t>(W_GIN) + (size_t)i * GDN_IN * D, 0);
            transpose_mat(c, c.in(I_WGOUT) + (size_t)i * GVW * D, GVW, D, c.ws<bf16_t>(W_GOUT) + (size_t)i * D * GVW, 0);
        }
        for (int l = 0; l < 4; ++l) {
            transpose_mat(c, c.in(I_WFG) + (size_t)l * D * FF, D, FF, c.ws<bf16_t>(W_GU) + (size_t)l * 2 * FF * D, 1);
            transpose_mat(c, c.in(I_WFU) + (size_t)l * D * FF, D, FF, c.ws<bf16_t>(W_GU) + (size_t)l * 2 * FF * D, 2);
            transpose_mat(c, c.in(I_WFD) + (size_t)l * FF * D, FF, D, c.ws<bf16_t>(W_DN) + (size_t)l * D * FF, 0);
        }
        rowpass_phase(c, 0, nullptr, c.in(I_NMPRE), true);
        const size_t gt = (size_t)blockIdx.x * NTHR + c.tid, gn = (size_t)gridDim.x * NTHR;
        const size_t per = (size_t)(WIN - 1) * AW / 4, tot = (size_t)2 * NS * per;
        for (size_t i = gt; i < tot; i += gn) { const size_t sq = i / per, r = i % per;
            ((f32x4*)(c.p.out + O_SK + sq * WIN * AW))[r] = ((const f32x4*)(c.in(I_CK) + sq * WIN * AW + AW))[r];
            ((f32x4*)(c.p.out + O_SV + sq * WIN * AW))[r] = ((const f32x4*)(c.in(I_CV) + sq * WIN * AW + AW))[r]; }
        return;
    }
    const int l = (ph - 1) / PH_PER_LAYER, sp = (ph - 1) % PH_PER_LAYER, li = l >> 1; const bool hyb = (l & 1) == 0;
    bf16_t* H = c.ws<bf16_t>(W_H); bf16_t* PROJ = c.ws<bf16_t>(W_PROJ); bf16_t* MIX = c.ws<bf16_t>(W_MIXED); float* GO = c.ws<float>(W_GO); bf16_t* HID = c.ws<bf16_t>(W_HID);
    switch (sp) {
    case 0: {
        if (!EN(1)) break;
        const bf16_t* Wt = hyb ? c.ws<bf16_t>(W_HIN) + (size_t)li * HYB_IN * D : c.ws<bf16_t>(W_GIN) + (size_t)li * GDN_IN * D;
        const int nmain = hyb ? HYB_MAIN : GDN_MAIN, nall = hyb ? HYB_IN : GDN_IN;
        { pg8::Gemm g{H, Wt, T, nmain, D}; pg8::StaticOrder S; S.init(T, nmain, gridDim.x, blockIdx.x); pg8::EpiBf16Plain E{PROJ, nmain};
          pg8::gemm_phase<pg8::EpiBf16Plain, pg8::StaticOrder>(c.lds, g, S, E, nullptr); }
        { Epi e{0, PROJ, c.ws<float>(W_EXTRA), nmain, 0}; gemm_simple(c, H, D, T, Wt + (size_t)nmain * D, D, nall - nmain, D, e); }
        { Epi e{0, PROJ + (size_t)T * nmain, c.ws<float>(W_EXTRA) + (size_t)T * 32, nmain, nmain}; gemm_simple(c, H + (size_t)T * D, D, NS, Wt, D, nall, D, e); }
    } break;
    case 1: {
        if (hyb) {
            if (EN(2)) for (int tok = c.gw; tok < TT; tok += c.ngw) hyb_pre_token(c, li, tok);
            LAS float* pl = (LAS float*)(c.lds + c.wave * 2048);
            if (EN(3)) for (int it = c.gw; it < TT * AH; it += c.ngw) attn_wave(c, li, it / AH, it % AH, pl);
        } else { if (EN(4)) for (int tok = c.gw; tok < TT; tok += c.ngw) gdn_pre_token(c, li, tok); }
    } break;
    case 2: {
        if (hyb) { if (EN(5)) for (int it = c.gw; it < (NB + NS) * SH * SP; it += c.ngw) ssd_wave(c, li, it); }
        else if (EN(6)) gdn_seq_phase(c, li);
    } break;
    case 3: {
        if (hyb) { if (EN(7)) for (int tok = c.gw; tok < TT; tok += c.ngw) hyb_post_token(c, li, tok); }
        else { if (EN(8)) for (int tok = c.gw; tok < TT; tok += c.ngw) gdn_post_token(c, li, tok); }
    } break;
    case 4: {
        if (!EN(9)) break;
        const bf16_t* Wt = hyb ? c.ws<bf16_t>(W_HOUT) + (size_t)li * D * HYB_MIX : c.ws<bf16_t>(W_GOUT) + (size_t)li * D * GVW; const int kk = hyb ? HYB_MIX : GVW;
        { pg8::Gemm g{MIX, Wt, T, D, kk}; pg8::StaticOrder S; S.init(T, D, gridDim.x, blockIdx.x); pg8::EpiF32 E{GO, D, nullptr};
          pg8::gemm_phase<pg8::EpiF32, pg8::StaticOrder>(c.lds, g, S, E, nullptr); }
        { Epi e{1, nullptr, GO + (size_t)T * D, D, 0}; gemm_simple(c, MIX + (size_t)T * kk, kk, NS, Wt, kk, D, kk, e); }
    } break;
    case 5: if (EN(10)) rowpass_phase(c, 1, c.in(I_NMPOST) + (size_t)l * D, c.in(I_NFPRE) + (size_t)l * D, l == 0); break;
    case 6: if (EN(11)) { const bf16_t* Wt = c.ws<bf16_t>(W_GU) + (size_t)l * 2 * FF * D;
        { pg8::Gemm g{H, Wt, T, 2 * FF, D}; pg8::StaticOrder S; S.init(T, 2 * FF, gridDim.x, blockIdx.x); pg8::EpiSwiglu E{HID, FF};
          pg8::gemm_phase<pg8::EpiSwiglu, pg8::StaticOrder>(c.lds, g, S, E, nullptr); }
        { Epi e{2, HID + (size_t)T * FF, nullptr, FF, 0}; gemm_simple(c, H + (size_t)T * D, D, NS, Wt, D, 2 * FF, D, e); } } break;
    case 7: if (EN(12)) { const bf16_t* Wt = c.ws<bf16_t>(W_DN) + (size_t)l * D * FF;
        { pg8::Gemm g{HID, Wt, T, D, FF}; pg8::StaticOrder S; S.init(T, D, gridDim.x, blockIdx.x); pg8::EpiF32 E{GO, D, nullptr};
          pg8::gemm_phase<pg8::EpiF32, pg8::StaticOrder>(c.lds, g, S, E, nullptr); }
        { Epi e{1, nullptr, GO + (size_t)T * D, D, 0}; gemm_simple(c, HID + (size_t)T * FF, FF, NS, Wt, FF, D, FF, e); } } break;
    case 8: if (EN(13)) rowpass_phase(c, l == DEPTH - 1 ? 2 : 1, c.in(I_NFPOST) + (size_t)l * D, l == DEPTH - 1 ? nullptr : c.in(I_NMPRE) + (size_t)(l + 1) * D, false); break;
    default: break;
    }
}

extern __shared__ __attribute__((aligned(16))) unsigned char g_shm[];
__global__ void __launch_bounds__(NTHR, 2) mega(Params p) {
    cg::grid_group grid = cg::this_grid();
    for (int ph = p.ph_lo; ph < p.ph_hi; ++ph) {
        int tid_ = threadIdx.x; asm volatile("" : "+v"(tid_));
        Ctx c; c.p.kp = (KParams)__builtin_amdgcn_kernarg_segment_ptr(); c.p.out = c.p.kp->out; c.tid = tid_; c.lane = tid_ & 63; c.wave = __builtin_amdgcn_readfirstlane(tid_ >> 6);
        c.gw = blockIdx.x * NWAVE + c.wave; c.ngw = gridDim.x * NWAVE; c.lds = (LAS unsigned char*)g_shm;
        run_phase(c, ph);
        if (ph + 1 < p.ph_hi) grid.sync();
    }
}

extern "C" void kernel_launch(void* const* d_in, const int* in_sizes, int n_in, void* d_out, int out_size, void* d_ws, size_t ws_size, hipStream_t stream) {
    static int grid = 0;
    if (!grid) {
        int dev = 0, cus = 0, per = 0; hipGetDevice(&dev); hipDeviceGetAttribute(&cus, hipDeviceAttributeMultiprocessorCount, dev);
        hipFuncSetAttribute((const void*)mega, hipFuncAttributeMaxDynamicSharedMemorySize, LDS_BYTES);
        hipOccupancyMaxActiveBlocksPerMultiprocessor(&per, (const void*)mega, NTHR, LDS_BYTES);
        if (n_in != 30 || (size_t)out_size != O_END || ws_size < W_END) fprintf(stderr, "kernel_launch: unexpected shapes n_in %d out %d (want %zu) ws %zu (want %zu)\n", n_in, out_size, (size_t)O_END, ws_size, (size_t)W_END);
        if (per < 1) fprintf(stderr, "kernel_launch: occupancy query says %d blocks per CU\n", per);
        grid = cus;
    }
    Params p{}; for (int i = 0; i < 30; ++i) p.in[i] = (const float*)d_in[i];
    p.out = (float*)d_out; p.ws = (unsigned char*)d_ws; p.ph_lo = 0; p.ph_hi = N_PHASES;
    void* args[] = {&p};
    hipError_t e = hipLaunchCooperativeKernel((const void*)mega, dim3(grid), dim3(NTHR), args, LDS_BYTES, stream);
    if (e != hipSuccess) fprintf(stderr, "kernel_launch: cooperative launch failed: %s\n", hipGetErrorString(e));
}
```

```cpp
#include <hip/hip_runtime.h>
#include <hip/hip_cooperative_groups.h>
#include <cstdio>
#include <cstdint>
namespace cg = cooperative_groups;

#define DI __device__ __forceinline__
#define LAS __attribute__((address_space(3)))
typedef unsigned short bf16_t;
typedef short bf16x8 __attribute__((ext_vector_type(8)));
typedef float f32x4 __attribute__((ext_vector_type(4)));
typedef unsigned u32x2 __attribute__((ext_vector_type(2)));
typedef unsigned u32x4 __attribute__((ext_vector_type(4)));

constexpr int D = 1024, NB = 4, SEQ = 4096, T = NB * SEQ, NS = 32, TT = T + NS, DEPTH = 4;
constexpr int AH = 8, AHD = 64, AW = 512, WIN = 2048;
constexpr int SH = 16, SP = 64, SN = 128, SG = 2, SDI = 1024, SXBC = 1536;
constexpr int HYB_IN = 4112, HYB_MAIN = 4096, HYB_MIX = 1536;
constexpr int GH = 16, GQH = 8, GDK = 128, GDV = 128, GQKV = 4096, GVW = 2048, GDN_IN = 6176, GDN_MAIN = 6144;
constexpr int FF = 2816;
constexpr float EPS = 1e-6f;
constexpr int NTHR = 512, NWAVE = 8, LDS_BYTES = 163840;

enum { I_XP = 0, I_XS, I_CK, I_CV, I_SCONV, I_SSM, I_GCONV, I_GST, I_RELB, I_NMPRE, I_NMPOST, I_NFPRE, I_NFPOST, I_WHIN, I_SCW, I_SCB, I_SDTB, I_SALOG, I_SD, I_SNW,
       I_WHOUT, I_WGIN, I_GCW, I_GDTB, I_GALOG, I_GNW, I_WGOUT, I_WFG, I_WFU, I_WFD };

constexpr size_t O_YP = 0;
constexpr size_t O_YS = O_YP + (size_t)T * D;
constexpr size_t O_PK = O_YS + (size_t)NS * D;
constexpr size_t O_PV = O_PK + (size_t)2 * NB * WIN * AW;
constexpr size_t O_PSC = O_PV + (size_t)2 * NB * WIN * AW;
constexpr size_t O_PSS = O_PSC + (size_t)2 * NB * 3 * SXBC;
constexpr size_t O_PGC = O_PSS + (size_t)2 * NB * SH * SP * SN;
constexpr size_t O_PGS = O_PGC + (size_t)2 * NB * 3 * GQKV;
constexpr size_t O_SK = O_PGS + (size_t)2 * NB * GH * GDK * GDV;
constexpr size_t O_SV = O_SK + (size_t)2 * NS * WIN * AW;
constexpr size_t O_SSC = O_SV + (size_t)2 * NS * WIN * AW;
constexpr size_t O_SSS = O_SSC + (size_t)2 * NS * 3 * SXBC;
constexpr size_t O_SGC = O_SSS + (size_t)2 * NS * SH * SP * SN;
constexpr size_t O_SGS = O_SGC + (size_t)2 * NS * 3 * GQKV;
constexpr size_t O_END = O_SGS + (size_t)2 * NS * GH * GDK * GDV;

constexpr size_t al256(size_t x) { return (x + 255) & ~(size_t)255; }
constexpr size_t W_CTL = 0;
constexpr size_t W_HIN = 65536;
constexpr size_t W_HOUT = al256(W_HIN + (size_t)2 * HYB_IN * D * 2);
constexpr size_t W_GIN = al256(W_HOUT + (size_t)2 * D * HYB_MIX * 2);
constexpr size_t W_GOUT = al256(W_GIN + (size_t)2 * GDN_IN * D * 2);
constexpr size_t W_GU = al256(W_GOUT + (size_t)2 * D * GVW * 2);
constexpr size_t W_DN = al256(W_GU + (size_t)4 * 2 * FF * D * 2);
constexpr size_t W_X = al256(W_DN + (size_t)4 * D * FF * 2);
constexpr size_t W_H = al256(W_X + (size_t)TT * D * 4);
constexpr size_t W_PROJ = al256(W_H + (size_t)TT * D * 2);
constexpr size_t W_EXTRA = al256(W_PROJ + (size_t)TT * GDN_MAIN * 2);
constexpr size_t W_MIXED = al256(W_EXTRA + (size_t)TT * 32 * 4);
constexpr size_t W_GO = al256(W_MIXED + (size_t)TT * GVW * 2);
constexpr size_t W_HID = al256(W_GO + (size_t)TT * D * 4);
constexpr size_t W_ACT = al256(W_HID + (size_t)TT * FF * 2);
constexpr size_t W_AUX = al256(W_ACT + (size_t)TT * 4096 * 4);
constexpr size_t W_Y = al256(W_AUX + (size_t)TT * 32 * 4);
constexpr size_t W_END = al256(W_Y + (size_t)TT * 2048 * 4);

struct Params { const float* in[30]; float* out; unsigned char* ws; int ph_lo, ph_hi; };

DI float bf2f(bf16_t b) { return __uint_as_float(((unsigned)b) << 16); }
DI bf16_t f2bf(float x) { unsigned u = __float_as_uint(x); u += 0x7fffu + ((u >> 16) & 1u); return (bf16_t)(u >> 16); }
DI unsigned pk2(float lo, float hi) { return (unsigned)f2bf(lo) | ((unsigned)f2bf(hi) << 16); }
DI float wave_sum(float v) {
#pragma unroll
    for (int o = 32; o >= 1; o >>= 1) v += __shfl_xor(v, o);
    return v;
}
DI float wave_max(float v) {
#pragma unroll
    for (int o = 32; o >= 1; o >>= 1) v = fmaxf(v, __shfl_xor(v, o));
    return v;
}
DI float siluf(float x) { return x / (1.f + __expf(-x)); }
DI float sigmoidf_(float x) { return 1.f / (1.f + __expf(-x)); }
DI float softplusf_(float x) { return fmaxf(x, 0.f) + log1pf(__expf(-fabsf(x))); }
#define LDS_WAIT() asm volatile("s_waitcnt lgkmcnt(0)" ::: "memory")

__device__ const unsigned char c_bucket[3][129] = {
 {0,1,2,3,4,5,6,7,8,9,10,11,12,13,14,15,16,16,16,16,16,16,17,17,17,17,17,17,17,17,18,18,18,18,18,18,18,18,18,18,19,19,19,19,19,19,19,19,19,19,19,19,19,19,20,20,20,20,20,20,20,20,20,20,20,20,20,20,20,20,20,20,20,21,21,21,21,21,21,21,21,21,21,21,21,21,21,21,21,21,21,21,21,21,21,21,21,21,21,22,22,22,22,22,22,22,22,22,22,22,22,22,22,22,22,22,22,22,22,22,22,22,22,22,22,22,22,22,22},
 {0,4,8,12,16,16,17,17,18,18,19,19,19,19,20,20,20,20,20,21,21,21,21,21,21,22,22,22,22,22,22,22,22,22,23,23,23,23,23,23,23,23,23,23,23,23,24,24,24,24,24,24,24,24,24,24,24,24,24,24,24,24,25,25,25,25,25,25,25,25,25,25,25,25,25,25,25,25,25,25,25,25,25,26,26,26,26,26,26,26,26,26,26,26,26,26,26,26,26,26,26,26,26,26,26,26,26,26,26,26,26,26,26,27,27,27,27,27,27,27,27,27,27,27,27,27,27,27,27},
 {0,16,18,19,20,21,21,22,22,23,23,23,24,24,24,24,25,25,25,25,25,26,26,26,26,26,26,26,26,27,27,27,27,27,27,27,27,27,27,28,28,28,28,28,28,28,28,28,28,28,28,28,29,29,29,29,29,29,29,29,29,29,29,29,29,29,29,29,29,29,30,30,30,30,30,30,30,30,30,30,30,30,30,30,30,30,30,30,30,30,30,30,30,30,30,31,31,31,31,31,31,31,31,31,31,31,31,31,31,31,31,31,31,31,31,31,31,31,31,31,31,31,31,31,31,31,31,31,31}};

typedef const Params __attribute__((address_space(4)))* KParams;
struct OutRef { float* out; DI float* operator+(size_t o) const { return out + o; } };
struct PRef { KParams kp; float* out; };
struct Ctx {
    PRef p; int tid, lane, wave, gw, ngw; LAS unsigned char* lds;
    DI const float* in(int i) const { return p.kp->in[i]; }
    template <class Tp> DI Tp* ws(size_t off) const { return (Tp*)(p.kp->ws + off); }
};

DI int rowmap(int n, int map) { return map == 0 ? n : (32 * (n >> 4) + (n & 15) + (map == 2 ? 16 : 0)); }
DI void transpose_item(const float* W, int K, int N, bf16_t* WT, int map, LAS float* scr, int item, int lane) {
    const int nblk = (N + 31) / 32, kb = item / nblk, nb = item % nblk, k0 = 64 * kb, n0 = 32 * nb;
#pragma unroll 8
    for (int i = 0; i < 32; ++i) { const int kk = 2 * i + (lane >> 5), n = n0 + (lane & 31); scr[kk * 33 + (lane & 31)] = n < N ? W[(size_t)(k0 + kk) * N + n] : 0.f; }
    LDS_WAIT();
    const int c = lane & 7;
#pragma unroll
    for (int j = 0; j < 4; ++j) {
        const int nn = (lane >> 3) + 8 * j, n = n0 + nn; const LAS float* s = scr + (8 * c) * 33 + nn;
        u32x4 o; o.x = pk2(s[0], s[33]); o.y = pk2(s[66], s[99]); o.z = pk2(s[132], s[165]); o.w = pk2(s[198], s[231]);
        if (n < N) *(u32x4*)(WT + (size_t)rowmap(n, map) * K + k0 + 8 * c) = o;
    }
    LDS_WAIT();
}
DI void transpose_mat(const Ctx& c, const float* W, int K, int N, bf16_t* WT, int map) {
    LAS float* scr = (LAS float*)(c.lds + c.wave * 8704);
    const int nit = (K / 64) * ((N + 31) / 32);
    for (int it = c.gw; it < nit; it += c.ngw) transpose_item(W, K, N, WT, map, scr, it, c.lane);
}

DI void rowpass_row(const float* xrow, const float* gorow, const float* gpost, const float* gnext, float* xdst, bf16_t* hrow, float* yout, int lane) {
    f32x4 x[4]; float ss = 0.f;
    if (gorow) {
        f32x4 g[4];
#pragma unroll
        for (int j = 0; j < 4; ++j) { g[j] = *(const f32x4*)(gorow + 4 * lane + 256 * j); ss += g[j].x * g[j].x + g[j].y * g[j].y + g[j].z * g[j].z + g[j].w * g[j].w; }
        const float r = rsqrtf(wave_sum(ss) * (1.f / D) + EPS);
#pragma unroll
        for (int j = 0; j < 4; ++j) { const f32x4 w = *(const f32x4*)(gpost + 4 * lane + 256 * j); x[j] = *(const f32x4*)(xrow + 4 * lane + 256 * j) + g[j] * r * w; }
    } else {
#pragma unroll
        for (int j = 0; j < 4; ++j) x[j] = *(const f32x4*)(xrow + 4 * lane + 256 * j);
    }
    if (xdst) {
#pragma unroll
        for (int j = 0; j < 4; ++j) *(f32x4*)(xdst + 4 * lane + 256 * j) = x[j];
    }
    if (yout) {
#pragma unroll
        for (int j = 0; j < 4; ++j) *(f32x4*)(yout + 4 * lane + 256 * j) = x[j];
    }
    if (hrow) {
        float s2 = 0.f;
#pragma unroll
        for (int j = 0; j < 4; ++j) s2 += x[j].x * x[j].x + x[j].y * x[j].y + x[j].z * x[j].z + x[j].w * x[j].w;
        const float r2 = rsqrtf(wave_sum(s2) * (1.f / D) + EPS);
#pragma unroll
        for (int j = 0; j < 4; ++j) { const f32x4 w = *(const f32x4*)(gnext + 4 * lane + 256 * j); const f32x4 h = x[j] * r2 * w;
            u32x2 o; o.x = pk2(h.x, h.y); o.y = pk2(h.z, h.w); *(u32x2*)(hrow + 4 * lane + 256 * j) = o; }
    }
}
DI void rowpass_phase(const Ctx& c, int mode, const float* gpost, const float* gnext, bool x_from_input) {
    float* X = c.ws<float>(W_X); const float* GO = c.ws<float>(W_GO); bf16_t* H = c.ws<bf16_t>(W_H);
    for (int row = c.gw; row < TT; row += c.ngw) {
        const float* xrow = x_from_input ? (row < T ? c.in(I_XP) + (size_t)row * D : c.in(I_XS) + (size_t)(row - T) * D) : X + (size_t)row * D;
        if (mode == 0) rowpass_row(xrow, nullptr, nullptr, gnext, nullptr, H + (size_t)row * D, nullptr, c.lane);
        else if (mode == 1) rowpass_row(xrow, GO + (size_t)row * D, gpost, gnext, X + (size_t)row * D, H + (size_t)row * D, nullptr, c.lane);
        else rowpass_row(xrow, GO + (size_t)row * D, gpost, nullptr, nullptr, nullptr, c.p.out + (row < T ? O_YP + (size_t)row * D : O_YS + (size_t)(row - T) * D), c.lane);
    }
}

namespace pg8 {
#define PG8_LAS __attribute__((address_space(3)))
typedef unsigned short bf16_t;
typedef short bf16x8 __attribute__((ext_vector_type(8)));
typedef float f32x4 __attribute__((ext_vector_type(4)));
typedef unsigned u32x4 __attribute__((ext_vector_type(4)));
constexpr int BM = 256, BK = 64, HALF = 128, HTB = HALF * BK * 2  , STAGE_BYTES = 8 * HTB, NXCD = 8, WGM = 8;

__host__ __device__ __forceinline__ int lds_byte(int r, int c) { const int st = (r >> 4) * 2 + (c >> 5), rr = r & 15, cc = c & 31, ob = rr * 64 + cc * 2; return st * 1024 + (ob ^ (((ob >> 9) & 1) << 5)); }
__host__ __device__ __forceinline__ void stage_rc(int b, int& R, int& C) { const int st = b / 1024, sb = b % 1024, swz = sb ^ (((sb >> 9) & 1) << 5); R = (st >> 1) * 16 + swz / 64; C = (st & 1) * 32 + (swz % 64) / 2; }
__host__ __device__ __forceinline__ int perm32(int rho) { const int n = rho >> 4, i = rho & 15; return 8 * (i >> 2) + 4 * n + (i & 3); }

struct Unit { int pm, pn; };
struct Gemm { const bf16_t* A; const bf16_t* Bt; int M, N, K; };

struct StaticOrder {
    int nM, nN, nwg, G, c;
    __host__ __device__ void init(int M, int N, int G_, int c_) { nM = M / BM; nN = N / BM; nwg = nM * nN; G = G_; c = c_; }
    __host__ __device__ bool next(int i, Unit& u) const {
        const long L = (long)i * G + c; if (L >= nwg) return false;
        int wgid = (int)L; { const int q = nwg / NXCD, r = nwg % NXCD, xcd = wgid % NXCD, off = wgid / NXCD; wgid = (xcd < r ? xcd * (q + 1) : r * (q + 1) + (xcd - r) * q) + off; }
        const int nig = WGM * nN, gid = wgid / nig, fm = gid * WGM, gsz = (nM - fm) < WGM ? (nM - fm) : WGM;
        u.pm = fm + ((wgid % nig) % gsz); u.pn = (wgid % nig) / gsz; return true;
    }
    __device__ __forceinline__ void a_ready(const Unit&) const {}
    __device__ __forceinline__ void done(const Unit&) const {}
};
__device__ __forceinline__ unsigned cvt_pk_bf16(float lo, float hi) { unsigned r; asm volatile("v_cvt_pk_bf16_f32 %0, %1, %2" : "=v"(r) : "v"(lo), "v"(hi)); return r; }
typedef float f32x2 __attribute__((ext_vector_type(2)));
struct EpiF32 {
    static constexpr bool PERM = false, AFTER_DRAIN = false;
    float* C; int ldc; const float* bias;
    __device__ __forceinline__ void operator()(const f32x4 (&acc)[2][2][4][2], const Unit& u, int wr, int wc, int fr, int fq) const {
        const int row0 = u.pm * BM + wr * 64 + fr, col0 = u.pn * BM + wc * 32 + 4 * fq;
        f32x4 bv[2][2];
#pragma unroll
        for (int bj = 0; bj < 2; ++bj)
#pragma unroll
            for (int n = 0; n < 2; ++n) bv[bj][n] = bias ? *(const f32x4*)(bias + col0 + bj * HALF + n * 16) : (f32x4){0.f, 0.f, 0.f, 0.f};
#pragma unroll
        for (int ai = 0; ai < 2; ++ai)
#pragma unroll
            for (int m = 0; m < 4; ++m) { float* rowp = C + (size_t)(row0 + ai * HALF + m * 16) * ldc + col0;
#pragma unroll
                for (int bj = 0; bj < 2; ++bj)
#pragma unroll
                    for (int n = 0; n < 2; ++n) *(f32x4*)(rowp + bj * HALF + n * 16) = acc[ai][bj][m][n] + bv[bj][n]; }
    }
};
template <class Epi, class Sched, bool STAMP = false>
__device__ __forceinline__ void gemm_phase(PG8_LAS unsigned char* lds, const Gemm g, const Sched& S, const Epi& E, unsigned long long* stamps) {
    int tid_ = threadIdx.x; asm volatile("" : "+v"(tid_));
    const int tid = tid_, wid = __builtin_amdgcn_readfirstlane(tid >> 6), lane = tid & 63, wr = wid >> 2, wc = wid & 3, fr = lane & 15, fq = lane >> 4;
    const int K = g.K, nt = K / BK;
    int ts_lo = 0, ts_hi = 0, nts = 0; const unsigned long long rt_entry = STAMP ? (unsigned long long)wall_clock64() : 0ull;
#define PG8_STAMP() do { if (STAMP && wid == 0 && nts < 64) { const unsigned long long _c = (unsigned long long)clock64(); \
        ts_lo = (lane == nts) ? (int)(unsigned)_c : ts_lo; ts_hi = (lane == nts) ? (int)(unsigned)(_c >> 32) : ts_hi; ++nts; } } while (0)
    PG8_STAMP();
    unsigned voffA[2], voffB[2];
#pragma unroll
    for (int i = 0; i < 2; ++i) { int R, C; stage_rc(tid * 16 + i * 8192, R, C); const int Rb = Epi::PERM ? ((R & ~31) + perm32(R & 31)) : R;
        voffA[i] = (unsigned)(R * K + C) * 2u; voffB[i] = (unsigned)(Rb * K + C) * 2u; }
    const size_t kstep = (size_t)(BK * 2);
    const size_t hstep = (size_t)HALF * K * 2;
    const size_t tstep = 2 * hstep;
    const unsigned ldsw = (unsigned)wid * 1024u;
    const int aoff = lds_byte(wr * 64 + fr, fq * 8), boff = lds_byte(wc * 32 + fr, fq * 8);
#define PG8_SA(b, h) (((b) * 2 + (h)) * HTB)
#define PG8_SB(b, h) ((4 + (b) * 2 + (h)) * HTB)
#define PG8_STAGE(bufoff, gbase, voff) do { _Pragma("unroll") for (int _i = 0; _i < 2; ++_i) \
        __builtin_amdgcn_global_load_lds((const unsigned*)((const char*)(gbase) + (voff)[_i]), (PG8_LAS unsigned*)(lds + (bufoff) + ldsw + _i * 8192), 16, 0, 0); } while (0)
#define PG8_LDA(dst, b, h) do { _Pragma("unroll") for (int m = 0; m < 4; ++m) _Pragma("unroll") for (int k = 0; k < 2; ++k) dst[m][k] = *(const PG8_LAS bf16x8*)(lds + PG8_SA(b, h) + aoff + m * 2048 + k * 1024); } while (0)
#define PG8_LDB(dst, b, h) do { _Pragma("unroll") for (int n = 0; n < 2; ++n) _Pragma("unroll") for (int k = 0; k < 2; ++k) dst[n][k] = *(const PG8_LAS bf16x8*)(lds + PG8_SB(b, h) + boff + n * 2048 + k * 1024); } while (0)
#define PG8_MMA(ai, bj, At, Bt) do { __builtin_amdgcn_s_setprio(1); _Pragma("unroll") for (int m = 0; m < 4; ++m) _Pragma("unroll") for (int n = 0; n < 2; ++n) _Pragma("unroll") for (int k = 0; k < 2; ++k) \
        acc[ai][bj][m][n] = __builtin_amdgcn_mfma_f32_16x16x32_bf16(Bt[n][k], At[m][k], acc[ai][bj][m][n], 0, 0, 0); __builtin_amdgcn_s_setprio(0); } while (0)
#define PG8_WAIT_V(n) asm volatile("s_waitcnt vmcnt(" #n ")" ::: "memory")
#define PG8_WAIT_L(n) asm volatile("s_waitcnt lgkmcnt(" #n ")" ::: "memory")
#define PG8_BAR __builtin_amdgcn_s_barrier()
#define PG8_SCHED __builtin_amdgcn_sched_barrier(0)
    Unit cur, nxt; int ui = 0;
    if (!S.next(0, cur)) return;
    f32x4 acc[2][2][4][2];
#pragma unroll
    for (int a = 0; a < 2; ++a)
#pragma unroll
        for (int b = 0; b < 2; ++b)
#pragma unroll
            for (int m = 0; m < 4; ++m)
#pragma unroll
                for (int n = 0; n < 2; ++n) acc[a][b][m][n] = (f32x4){0.f, 0.f, 0.f, 0.f};
    bf16x8 At[4][2], B0[2][2], B1[2][2];
    const char* cA = (const char*)g.A + (size_t)cur.pm * tstep; const char* cB = (const char*)g.Bt + (size_t)cur.pn * tstep;
    S.a_ready(cur);
    PG8_STAGE(PG8_SB(0, 0), cB, voffB); PG8_STAGE(PG8_SA(0, 0), cA, voffA); PG8_STAGE(PG8_SB(0, 1), cB + hstep, voffB); PG8_STAGE(PG8_SA(0, 1), cA + hstep, voffA);
    if (wr == 1) PG8_BAR;
    PG8_WAIT_V(4); PG8_BAR;
    PG8_STAGE(PG8_SB(1, 0), cB + kstep, voffB); PG8_STAGE(PG8_SA(1, 0), cA + kstep, voffA); PG8_STAGE(PG8_SB(1, 1), cB + hstep + kstep, voffB);
    PG8_WAIT_V(6); PG8_BAR;
    PG8_STAMP();
    for (;;) {
        const bool has_next = S.next(ui + 1, nxt);
        const char* nA = has_next ? (const char*)g.A + (size_t)nxt.pm * tstep : cA; const char* nB = has_next ? (const char*)g.Bt + (size_t)nxt.pn * tstep : cB;
        for (int t = 0; t < nt; t += 2) {
            const bool last = (t == nt - 2);
            const char* a1 = cA + (size_t)(t + 1) * kstep;
            const char* a2 = last ? nA : cA + (size_t)(t + 2) * kstep; const char* b2 = last ? nB : cB + (size_t)(t + 2) * kstep;
            const char* a3 = a2 + kstep; const char* b3 = b2 + kstep;
            if (last && has_next) S.a_ready(nxt);
            PG8_LDB(B0, 0, 0); PG8_SCHED; PG8_LDA(At, 0, 0); PG8_STAGE(PG8_SA(1, 1), a1 + hstep, voffA);
            PG8_WAIT_L(8); PG8_BAR; PG8_WAIT_L(0); PG8_MMA(0, 0, At, B0); PG8_BAR; PG8_SCHED;
            PG8_LDB(B1, 0, 1); PG8_STAGE(PG8_SB(0, 0), b2, voffB);
            PG8_BAR; PG8_WAIT_L(0); PG8_MMA(0, 1, At, B1); PG8_BAR;
            PG8_LDA(At, 0, 1); PG8_STAGE(PG8_SA(0, 0), a2, voffA);
            PG8_BAR; PG8_WAIT_L(0); PG8_MMA(1, 0, At, B0); PG8_BAR; PG8_SCHED;
            PG8_STAGE(PG8_SB(0, 1), b2 + hstep, voffB);
            PG8_WAIT_V(6); PG8_BAR; PG8_MMA(1, 1, At, B1); PG8_BAR;
            PG8_LDB(B0, 1, 0); PG8_SCHED; PG8_LDA(At, 1, 0); PG8_STAGE(PG8_SA(0, 1), a2 + hstep, voffA);
            PG8_WAIT_L(8); PG8_BAR; PG8_WAIT_L(0); PG8_MMA(0, 0, At, B0); PG8_BAR; PG8_SCHED;
            PG8_LDB(B1, 1, 1); PG8_STAGE(PG8_SB(1, 0), b3, voffB);
            PG8_BAR; PG8_WAIT_L(0); PG8_MMA(0, 1, At, B1); PG8_BAR;
            PG8_LDA(At, 1, 1); PG8_STAGE(PG8_SA(1, 0), a3, voffA);
            PG8_BAR; PG8_WAIT_L(0); PG8_MMA(1, 0, At, B0); PG8_BAR; PG8_SCHED;
            PG8_STAGE(PG8_SB(1, 1), b3 + hstep, voffB);
            PG8_WAIT_V(6); PG8_BAR; PG8_MMA(1, 1, At, B1); PG8_BAR;
        }
        PG8_STAMP();
        if constexpr (!Epi::AFTER_DRAIN) { E(acc, cur, wr, wc, fr, fq); S.done(cur); }
        PG8_STAMP();
        if (!has_next) break;
#pragma unroll
        for (int a = 0; a < 2; ++a)
#pragma unroll
            for (int b = 0; b < 2; ++b)
#pragma unroll
                for (int m = 0; m < 4; ++m)
#pragma unroll
                    for (int n = 0; n < 2; ++n) acc[a][b][m][n] = (f32x4){0.f, 0.f, 0.f, 0.f};
        cur = nxt; cA = nA; cB = nB; ++ui;
    }
    PG8_WAIT_V(0);
    if (wr == 0) PG8_BAR;
    PG8_BAR;
    if constexpr (Epi::AFTER_DRAIN) { E.fused(acc, cur, wr, wc, fr, fq, lds, wid, lane); S.done(cur); }
    PG8_STAMP();
    if (STAMP && wid == 0) { stamps[lane] = lane < nts ? (((unsigned long long)(unsigned)ts_hi << 32) | (unsigned)ts_lo) : 0ull;
        if (lane == 62) stamps[62] = rt_entry; if (lane == 63) stamps[63] = (unsigned long long)wall_clock64(); }
#undef PG8_STAMP
#undef PG8_SA
#undef PG8_SB
#undef PG8_STAGE
#undef PG8_LDA
#undef PG8_LDB
#undef PG8_MMA
#undef PG8_WAIT_V
#undef PG8_WAIT_L
#undef PG8_BAR
#undef PG8_SCHED
}
}

namespace pg8 {
struct EpiBf16Plain {
    static constexpr bool PERM = false, AFTER_DRAIN = false;
    bf16_t* O; int ldc;
    __device__ __forceinline__ void operator()(const f32x4 (&acc)[2][2][4][2], const Unit& u, int wr, int wc, int fr, int fq) const {
        const int row0 = u.pm * BM + wr * 64 + fr, col0 = u.pn * BM + wc * 32 + 4 * fq;
#pragma unroll
        for (int ai = 0; ai < 2; ++ai)
#pragma unroll
            for (int m = 0; m < 4; ++m) { bf16_t* rowp = O + (size_t)(row0 + ai * HALF + m * 16) * ldc + col0;
#pragma unroll
                for (int bj = 0; bj < 2; ++bj)
#pragma unroll
                    for (int n = 0; n < 2; ++n) { const f32x4 v = acc[ai][bj][m][n]; unsigned long long w = (unsigned long long)cvt_pk_bf16(v[0], v[1]) | ((unsigned long long)cvt_pk_bf16(v[2], v[3]) << 32);
                        *(unsigned long long*)(rowp + bj * HALF + n * 16) = w; } }
    }
};
struct EpiSwiglu {
    static constexpr bool PERM = false, AFTER_DRAIN = false;
    bf16_t* O; int ldc;
    __device__ __forceinline__ void operator()(const f32x4 (&acc)[2][2][4][2], const Unit& u, int wr, int wc, int fr, int fq) const {
        const int row0 = u.pm * BM + wr * 64 + fr, col0 = u.pn * (BM / 2) + wc * 16 + 4 * fq;
#pragma unroll
        for (int ai = 0; ai < 2; ++ai)
#pragma unroll
            for (int m = 0; m < 4; ++m) { bf16_t* rowp = O + (size_t)(row0 + ai * HALF + m * 16) * ldc + col0;
#pragma unroll
                for (int bj = 0; bj < 2; ++bj) { const f32x4 g = acc[ai][bj][m][0], up = acc[ai][bj][m][1]; float h[4];
#pragma unroll
                    for (int e = 0; e < 4; ++e) h[e] = g[e] / (1.f + __expf(-g[e])) * up[e];
                    unsigned long long w = (unsigned long long)cvt_pk_bf16(h[0], h[1]) | ((unsigned long long)cvt_pk_bf16(h[2], h[3]) << 32);
                    *(unsigned long long*)(rowp + bj * (HALF / 2)) = w; } }
    }
};
}

struct Epi { int mode; bf16_t* ob; float* of; int ldo; int main_cols; };
DI void gemm_simple(const Ctx& c, const bf16_t* A, int lda, int M, const bf16_t* Bt, int ldb, int N, int K, const Epi e) {
    const int mblk = (M + 63) / 64, nblk = (N + 31) / 32, nit = mblk * nblk;
    const int fr = c.lane & 15, fq = c.lane >> 4;
    for (int it = c.gw; it < nit; it += c.ngw) {
        const int mb = it / nblk, nb = it % nblk, m0 = mb * 64, n0 = nb * 32;
        const bf16_t* ap[4]; const bf16_t* bp[2];
#pragma unroll
        for (int m = 0; m < 4; ++m) { int r = m0 + 16 * m + fr; r = r < M ? r : M - 1; ap[m] = A + (size_t)r * lda + 8 * fq; }
#pragma unroll
        for (int n = 0; n < 2; ++n) { int r = n0 + 16 * n + fr; r = r < N ? r : N - 1; bp[n] = Bt + (size_t)r * ldb + 8 * fq; }
        f32x4 acc[4][2];
#pragma unroll
        for (int m = 0; m < 4; ++m)
#pragma unroll
            for (int n = 0; n < 2; ++n) acc[m][n] = (f32x4){0.f, 0.f, 0.f, 0.f};
#pragma unroll 2
        for (int k0 = 0; k0 < K; k0 += 32) {
            bf16x8 a[4], b[2];
#pragma unroll
            for (int m = 0; m < 4; ++m) a[m] = *(const bf16x8*)(ap[m] + k0);
#pragma unroll
            for (int n = 0; n < 2; ++n) b[n] = *(const bf16x8*)(bp[n] + k0);
#pragma unroll
            for (int m = 0; m < 4; ++m)
#pragma unroll
                for (int n = 0; n < 2; ++n) acc[m][n] = __builtin_amdgcn_mfma_f32_16x16x32_bf16(b[n], a[m], acc[m][n], 0, 0, 0);
        }
#pragma unroll
        for (int m = 0; m < 4; ++m) {
            const int row = m0 + 16 * m + fr; if (row >= M) continue;
            if (e.mode == 2) {
                const f32x4 g = acc[m][0], u = acc[m][1]; u32x2 o;
                o.x = pk2(siluf(g.x) * u.x, siluf(g.y) * u.y); o.y = pk2(siluf(g.z) * u.z, siluf(g.w) * u.w);
                *(u32x2*)(e.ob + (size_t)row * e.ldo + 16 * nb + 4 * fq) = o;
            } else {
#pragma unroll
                for (int n = 0; n < 2; ++n) {
                    const int col = n0 + 16 * n + 4 * fq; if (col >= N) continue;
                    const f32x4 v = acc[m][n];
                    if (e.mode == 1) *(f32x4*)(e.of + (size_t)row * e.ldo + col) = v;
                    else if (col < e.main_cols) { u32x2 o; o.x = pk2(v.x, v.y); o.y = pk2(v.z, v.w); *(u32x2*)(e.ob + (size_t)row * e.ldo + col) = o; }
                    else *(f32x4*)(e.of + (size_t)row * 32 + (col - e.main_cols)) = v;
                }
            }
        }
    }
}

DI void attn_wave(const Ctx& c, int li, int tok, int h, LAS float* pl  ) {
    const bf16_t* PROJ = c.ws<bf16_t>(W_PROJ); bf16_t* MIX = c.ws<bf16_t>(W_MIXED);
    const int lane = c.lane; const bool smp = tok >= T;
    const int b = smp ? tok - T : tok / SEQ, s = smp ? WIN : tok % SEQ;
    const float* ck = c.in(I_CK) + ((size_t)(li * NS + b) * WIN) * AW + h * AHD;
    const float* cv = c.in(I_CV) + ((size_t)(li * NS + b) * WIN) * AW + h * AHD;
    const bf16_t* prow0 = smp ? PROJ + (size_t)tok * HYB_MAIN : PROJ + (size_t)(b * SEQ) * HYB_MAIN;
    float q[64];
    { const bf16_t* qp = PROJ + (size_t)tok * HYB_MAIN + h * AHD;
#pragma unroll
      for (int j = 0; j < 8; ++j) { const u32x4 v = *(const u32x4*)(qp + 8 * j);
          q[8*j+0] = bf2f((bf16_t)(v.x & 0xffff)) * 0.125f; q[8*j+1] = bf2f((bf16_t)(v.x >> 16)) * 0.125f; q[8*j+2] = bf2f((bf16_t)(v.y & 0xffff)) * 0.125f; q[8*j+3] = bf2f((bf16_t)(v.y >> 16)) * 0.125f;
          q[8*j+4] = bf2f((bf16_t)(v.z & 0xffff)) * 0.125f; q[8*j+5] = bf2f((bf16_t)(v.z >> 16)) * 0.125f; q[8*j+6] = bf2f((bf16_t)(v.w & 0xffff)) * 0.125f; q[8*j+7] = bf2f((bf16_t)(v.w >> 16)) * 0.125f; } }
    const float* relb = c.in(I_RELB);
    float mx = -1e30f;
#pragma unroll 1
    for (int pat = 0; pat < 3; ++pat) {
        const int d = pat == 0 ? 1 : (pat == 1 ? 4 : 16);
#pragma unroll 1
        for (int rnd = 0; rnd < 3; ++rnd) {
            const int j = rnd * 64 + lane; float lg = -1e30f;
            if (j <= 128) {
                const int R = s - j * d;
                if (R >= 0) {
                    float acc = 0.f;
                    if (smp && R < WIN) { const float* kp = ck + (size_t)R * AW;
#pragma unroll
                        for (int e = 0; e < 16; ++e) { const f32x4 v = *(const f32x4*)(kp + 4 * e); acc += q[4*e] * v.x + q[4*e+1] * v.y + q[4*e+2] * v.z + q[4*e+3] * v.w; }
                    } else { const bf16_t* kp = (smp ? prow0 : prow0 + (size_t)R * HYB_MAIN) + AW + h * AHD;
#pragma unroll
                        for (int e = 0; e < 8; ++e) { const u32x4 v = *(const u32x4*)(kp + 8 * e);
                            acc += q[8*e] * bf2f((bf16_t)(v.x & 0xffff)) + q[8*e+1] * bf2f((bf16_t)(v.x >> 16)) + q[8*e+2] * bf2f((bf16_t)(v.y & 0xffff)) + q[8*e+3] * bf2f((bf16_t)(v.y >> 16))
                                 + q[8*e+4] * bf2f((bf16_t)(v.z & 0xffff)) + q[8*e+5] * bf2f((bf16_t)(v.z >> 16)) + q[8*e+6] * bf2f((bf16_t)(v.w & 0xffff)) + q[8*e+7] * bf2f((bf16_t)(v.w >> 16)); }
                    }
                    lg = acc + relb[c_bucket[pat][j] * AH + h];
                }
                pl[pat * 132 + j] = lg;
            }
            mx = fmaxf(mx, lg);
        }
    }
    mx = wave_max(mx);
    LDS_WAIT();
    float ssum = 0.f;
#pragma unroll 1
    for (int i = lane; i < 396; i += 64) { const int pat = i / 132, j = i % 132; if (j <= 128) { const float lg = pl[i]; const float pv = lg > -1e29f ? __expf(lg - mx) : 0.f; pl[i] = pv; ssum += pv; } }
    ssum = wave_sum(ssum);
    LDS_WAIT();
    float o = 0.f;
#pragma unroll 1
    for (int pat = 0; pat < 3; ++pat) {
        const int d = pat == 0 ? 1 : (pat == 1 ? 4 : 16);
        int jmax = s / d; jmax = jmax > 128 ? 128 : jmax;
#pragma unroll 4
        for (int j = 0; j <= jmax; ++j) {
            const int R = s - j * d; const float pv = pl[pat * 132 + j];
            float vv;
            if (smp && R < WIN) vv = cv[(size_t)R * AW + lane];
            else vv = bf2f((smp ? prow0 : prow0 + (size_t)R * HYB_MAIN)[2 * AW + h * AHD + lane]);
            o += pv * vv;
        }
    }
    MIX[(size_t)tok * HYB_MIX + h * AHD + lane] = f2bf(o / ssum);
    LDS_WAIT();
}

DI void hyb_pre_token(const Ctx& c, int li, int tok) {
    const bf16_t* PROJ = c.ws<bf16_t>(W_PROJ); float* ACT = c.ws<float>(W_ACT); float* AUX = c.ws<float>(W_AUX); const float* EX = c.ws<float>(W_EXTRA);
    const int lane = c.lane; const bool smp = tok >= T; const int b = smp ? tok - T : tok / SEQ, s = smp ? 0 : tok % SEQ;
    const float* cw = c.in(I_SCW) + (size_t)li * 4 * SXBC; const float* cb = c.in(I_SCB) + (size_t)li * SXBC;
    const float* st = c.in(I_SCONV) + (size_t)(li * NS + b) * 3 * SXBC;
    const bf16_t* prow = PROJ + (size_t)tok * HYB_MAIN + 2560;
#pragma unroll 4
    for (int j = 0; j < 24; ++j) {
        const int ch = lane + 64 * j;
        const float x3 = bf2f(prow[ch]); float x0, x1, x2;
        if (smp) { x0 = st[ch]; x1 = st[SXBC + ch]; x2 = st[2 * SXBC + ch]; }
        else { x2 = s >= 1 ? bf2f(prow[ch - HYB_MAIN]) : 0.f; x1 = s >= 2 ? bf2f(prow[ch - 2 * HYB_MAIN]) : 0.f; x0 = s >= 3 ? bf2f(prow[ch - 3 * HYB_MAIN]) : 0.f; }
        const float y = x0 * cw[ch] + x1 * cw[SXBC + ch] + x2 * cw[2 * SXBC + ch] + x3 * cw[3 * SXBC + ch] + cb[ch];
        ACT[(size_t)tok * 4096 + ch] = siluf(y);
        if (smp) { float* o = c.p.out + O_SSC + (size_t)(li * NS + b) * 3 * SXBC; o[ch] = x1; o[SXBC + ch] = x2; o[2 * SXBC + ch] = x3; }
        else if (s >= SEQ - 3) c.p.out[O_PSC + ((size_t)(li * NB + b) * 3 + (s - (SEQ - 3))) * SXBC + ch] = x3;
    }
    if (lane < SH) AUX[(size_t)tok * 32 + lane] = softplusf_(EX[(size_t)tok * 32 + lane] + c.in(I_SDTB)[li * SH + lane]);
    if (smp || s >= SEQ - WIN) {
        float* ok = smp ? c.p.out + O_SK + ((size_t)(li * NS + b) * WIN + (WIN - 1)) * AW : c.p.out + O_PK + ((size_t)(li * NB + b) * WIN + (s - (SEQ - WIN))) * AW;
        float* ov = smp ? c.p.out + O_SV + ((size_t)(li * NS + b) * WIN + (WIN - 1)) * AW : c.p.out + O_PV + ((size_t)(li * NB + b) * WIN + (s - (SEQ - WIN))) * AW;
        const bf16_t* kr = PROJ + (size_t)tok * HYB_MAIN + AW;
#pragma unroll
        for (int j = 0; j < 8; ++j) { ok[lane + 64 * j] = bf2f(kr[lane + 64 * j]); ov[lane + 64 * j] = bf2f(kr[AW + lane + 64 * j]); }
    }
}

DI void ssd_wave(const Ctx& c, int li, int item) {
    const float* ACT = c.ws<float>(W_ACT); const float* AUX = c.ws<float>(W_AUX); float* Y = c.ws<float>(W_Y);
    const int lane = c.lane;
    const bool smp = item >= NB * SH * SP; const int it = smp ? item - NB * SH * SP : item;
    const int seq = it / (SH * SP), h = (it / SP) % SH, p = it % SP, g = h / (SH / SG);
    const int L = smp ? 1 : SEQ; const int tok0 = smp ? T + seq : seq * SEQ;
    const float Ah = -__expf(c.in(I_SALOG)[li * SH + h]), Dh = c.in(I_SD)[li * SH + h];
    float h0 = 0.f, h1 = 0.f;
    if (smp) { const float* s0 = c.in(I_SSM) + (((size_t)(li * NS + seq) * SH + h) * SP + p) * SN; h0 = s0[2 * lane]; h1 = s0[2 * lane + 1]; }
#pragma unroll 2
    for (int t = 0; t < L; ++t) {
        const float* a = ACT + (size_t)(tok0 + t) * 4096;
        const float dt = AUX[(size_t)(tok0 + t) * 32 + h], xv = a[h * SP + p];
        const float2 Bv = *(const float2*)(a + SDI + g * SN + 2 * lane), Cv = *(const float2*)(a + SDI + SG * SN + g * SN + 2 * lane);
        const float dec = __expf(dt * Ah), dx = dt * xv;
        h0 = h0 * dec + dx * Bv.x; h1 = h1 * dec + dx * Bv.y;
        const float y = wave_sum(h0 * Cv.x + h1 * Cv.y);
        if (lane == 0) Y[(size_t)(tok0 + t) * 2048 + h * SP + p] = y + Dh * xv;
    }
    float* so = smp ? c.p.out + O_SSS + (((size_t)(li * NS + seq) * SH + h) * SP + p) * SN : c.p.out + O_PSS + (((size_t)(li * NB + seq) * SH + h) * SP + p) * SN;
    *(float2*)(so + 2 * lane) = make_float2(h0, h1);
}
DI void hyb_post_token(const Ctx& c, int li, int tok) {
    const bf16_t* PROJ = c.ws<bf16_t>(W_PROJ); const float* Y = c.ws<float>(W_Y); bf16_t* MIX = c.ws<bf16_t>(W_MIXED);
    const float* nw = c.in(I_SNW) + (size_t)li * SDI; const int lane = c.lane;
    float v[16]; float ss0 = 0.f, ss1 = 0.f;
#pragma unroll
    for (int j = 0; j < 16; ++j) { const int ch = lane + 64 * j; const float z = bf2f(PROJ[(size_t)tok * HYB_MAIN + 1536 + ch]); v[j] = Y[(size_t)tok * 2048 + ch] * siluf(z); if (j < 8) ss0 += v[j] * v[j]; else ss1 += v[j] * v[j]; }
    const float r0 = rsqrtf(wave_sum(ss0) * (1.f / 512.f) + EPS), r1 = rsqrtf(wave_sum(ss1) * (1.f / 512.f) + EPS);
#pragma unroll
    for (int j = 0; j < 16; ++j) { const int ch = lane + 64 * j; MIX[(size_t)tok * HYB_MIX + AW + ch] = f2bf(v[j] * (j < 8 ? r0 : r1) * nw[ch]); }
}


constexpr int SLD = 136;
constexpr int L_C = 0, L_B = 34816, L_XT = 69632, L_HS = 87040, L_CS = 104448, L_DT = 108544;
constexpr size_t W_ST = W_HID;
constexpr size_t W_DEC = W_HID + (size_t)NB * 32 * SH * SP * SN * 4;
constexpr int NCH = SEQ / 128;

DI void ssd_chunk_scalars(const Ctx& c, int li, int tok0, int g) {
    const float* AUX = c.ws<float>(W_AUX); LAS float* csS = (LAS float*)(c.lds + L_CS); LAS float* dtS = (LAS float*)(c.lds + L_DT);
    const int hh = c.wave, lane = c.lane, h = 8 * g + hh;
    const float Ah = -__expf(c.in(I_SALOG)[li * SH + h]);
    const float d0 = AUX[(size_t)(tok0 + lane) * 32 + h], d1 = AUX[(size_t)(tok0 + 64 + lane) * 32 + h];
    float s0 = d0 * Ah, s1 = d1 * Ah;
#pragma unroll
    for (int o = 1; o < 64; o <<= 1) { const float t0 = __shfl_up(s0, o), t1 = __shfl_up(s1, o); if (lane >= o) { s0 += t0; s1 += t1; } }
    s1 += __shfl(s0, 63);
    csS[lane * 8 + hh] = s0; csS[(64 + lane) * 8 + hh] = s1; dtS[lane * 8 + hh] = d0; dtS[(64 + lane) * 8 + hh] = d1;
}
DI bf16x8 lds_frag(const LAS bf16_t* p) { return *(const LAS bf16x8*)p; }
DI bf16x8 lds_frag2(const LAS bf16_t* p0, const LAS bf16_t* p1) {
    const u32x2 a = *(const LAS u32x2*)p0, b = *(const LAS u32x2*)p1; u32x4 r; r.x = a.x; r.y = a.y; r.z = b.x; r.w = b.y; return __builtin_bit_cast(bf16x8, r);
}
DI void ssd_a_item(const Ctx& c, int li, int item) {
    const float* ACT = c.ws<float>(W_ACT); float* ST = c.ws<float>(W_ST); float* DEC = c.ws<float>(W_DEC);
    const int g = item & 1, ch = (item >> 1) % NCH, b = item / (2 * NCH), tok0 = b * SEQ + ch * 128;
    LAS bf16_t* BT = (LAS bf16_t*)(c.lds + L_B); LAS bf16_t* XT = (LAS bf16_t*)(c.lds + L_XT);
    const LAS float* csS = (const LAS float*)(c.lds + L_CS); const LAS float* dtS = (const LAS float*)(c.lds + L_DT);
    const int fr = c.lane & 15, fq = c.lane >> 4, w = c.wave;
    __syncthreads();
    ssd_chunk_scalars(c, li, tok0, g);
#pragma unroll 4
    for (int it = 0; it < 32; ++it) { const int idx = it * NTHR + c.tid, j = idx >> 7, n = idx & 127; BT[n * SLD + j] = f2bf(ACT[(size_t)(tok0 + j) * 4096 + SDI + g * SN + n]); }
    __syncthreads();
    if (c.tid < 8) DEC[(size_t)(b * NCH + ch) * SH + 8 * g + c.tid] = __expf(csS[127 * 8 + c.tid]);
    const int pt = w & 3, nt0 = (w >> 2) * 4;
#pragma unroll 1
    for (int hh = 0; hh < 8; ++hh) {
        const int h = 8 * g + hh; const float csl = csS[127 * 8 + hh];
#pragma unroll 4
        for (int it = 0; it < 16; ++it) { const int idx = it * NTHR + c.tid, j = idx >> 6, p = idx & 63;
            XT[p * SLD + j] = f2bf(ACT[(size_t)(tok0 + j) * 4096 + h * SP + p] * __expf(csl - csS[j * 8 + hh]) * dtS[j * 8 + hh]); }
        __syncthreads();
        f32x4 acc[4];
#pragma unroll
        for (int n = 0; n < 4; ++n) acc[n] = (f32x4){0.f, 0.f, 0.f, 0.f};
#pragma unroll
        for (int ks = 0; ks < 4; ++ks) {
            const bf16x8 a = lds_frag(XT + (16 * pt + fr) * SLD + 32 * ks + 8 * fq);
#pragma unroll
            for (int n = 0; n < 4; ++n) { const bf16x8 bb = lds_frag(BT + (16 * (nt0 + n) + fr) * SLD + 32 * ks + 8 * fq); acc[n] = __builtin_amdgcn_mfma_f32_16x16x32_bf16(bb, a, acc[n], 0, 0, 0); }
        }
        float* so = ST + ((((size_t)(b * NCH + ch) * SH + h) * SP + 16 * pt + fr) * SN);
#pragma unroll
        for (int n = 0; n < 4; ++n) *(f32x4*)(so + 16 * (nt0 + n) + 4 * fq) = acc[n];
        __syncthreads();
    }
}
DI void ssd_scan_phase(const Ctx& c, int li) {
    float* ST = c.ws<float>(W_ST); const float* DEC = c.ws<float>(W_DEC);
    for (int idx = blockIdx.x * NTHR + c.tid; idx < NB * SH * SP * SN / 4; idx += gridDim.x * NTHR) {
        const int n4 = idx & 31, p = (idx >> 5) & 63, h = (idx >> 11) & 15, b = idx >> 15;
        f32x4 hcur = (f32x4){0.f, 0.f, 0.f, 0.f};
#pragma unroll 8
        for (int ch = 0; ch < NCH; ++ch) {
            f32x4* a = (f32x4*)(ST + ((((size_t)(b * NCH + ch) * SH + h) * SP + p) * SN)) + n4;
            const f32x4 s = *a; const float d = DEC[(size_t)(b * NCH + ch) * SH + h];
            *a = hcur; hcur = hcur * d + s;
        }
        *((f32x4*)(c.p.out + O_PSS + ((((size_t)(li * NB + b) * SH + h) * SP + p) * SN)) + n4) = hcur;
    }
}
DI void ssd_b_item(const Ctx& c, int li, int item) {
    const float* ACT = c.ws<float>(W_ACT); const float* ST = c.ws<float>(W_ST); const bf16_t* PROJ = c.ws<bf16_t>(W_PROJ); bf16_t* MIX = c.ws<bf16_t>(W_MIXED);
    const int g = item & 1, ch = (item >> 1) % NCH, b = item / (2 * NCH), tok0 = b * SEQ + ch * 128;
    LAS bf16_t* CS_ = (LAS bf16_t*)(c.lds + L_C); LAS bf16_t* BS = (LAS bf16_t*)(c.lds + L_B); LAS bf16_t* XT = (LAS bf16_t*)(c.lds + L_XT); LAS bf16_t* HS = (LAS bf16_t*)(c.lds + L_HS);
    const LAS float* csS = (const LAS float*)(c.lds + L_CS); const LAS float* dtS = (const LAS float*)(c.lds + L_DT);
    const int fr = c.lane & 15, fq = c.lane >> 4, w = c.wave, irow = 16 * w + fr;
    __syncthreads();
    ssd_chunk_scalars(c, li, tok0, g);
#pragma unroll 4
    for (int it = 0; it < 8; ++it) { const int idx = it * NTHR + c.tid, i = idx >> 5, n4 = idx & 31;
        const f32x4 bv = *(const f32x4*)(ACT + (size_t)(tok0 + i) * 4096 + SDI + g * SN + 4 * n4), cv = *(const f32x4*)(ACT + (size_t)(tok0 + i) * 4096 + SDI + SG * SN + g * SN + 4 * n4);
        u32x2 o; o.x = pk2(bv.x, bv.y); o.y = pk2(bv.z, bv.w); *(LAS u32x2*)(BS + i * SLD + 4 * n4) = o;
        o.x = pk2(cv.x, cv.y); o.y = pk2(cv.z, cv.w); *(LAS u32x2*)(CS_ + i * SLD + 4 * n4) = o; }
    __syncthreads();
    f32x4 cb[8];
#pragma unroll
    for (int jt = 0; jt < 8; ++jt) cb[jt] = (f32x4){0.f, 0.f, 0.f, 0.f};
    bf16x8 cfrag[4];
#pragma unroll
    for (int ks = 0; ks < 4; ++ks) cfrag[ks] = lds_frag(CS_ + irow * SLD + 32 * ks + 8 * fq);
#pragma unroll
    for (int jt = 0; jt < 8; ++jt) if (jt <= w) {
#pragma unroll
        for (int ks = 0; ks < 4; ++ks) cb[jt] = __builtin_amdgcn_mfma_f32_16x16x32_bf16(lds_frag(BS + (16 * jt + fr) * SLD + 32 * ks + 8 * fq), cfrag[ks], cb[jt], 0, 0, 0);
    }
    float rowsq = 0.f;
#pragma unroll 1
    for (int hh = 0; hh < 8; ++hh) {
        const int h = 8 * g + hh; const float Dh = c.in(I_SD)[li * SH + h];
#pragma unroll 4
        for (int it = 0; it < 16; ++it) { const int idx = it * NTHR + c.tid, j = idx >> 6, p = idx & 63; XT[p * SLD + j] = f2bf(ACT[(size_t)(tok0 + j) * 4096 + h * SP + p]); }
#pragma unroll
        for (int it = 0; it < 4; ++it) { const int idx = it * NTHR + c.tid, p = idx >> 5, n4 = idx & 31;
            const f32x4 v = *((const f32x4*)(ST + ((((size_t)(b * NCH + ch) * SH + h) * SP + p) * SN)) + n4);
            u32x2 o; o.x = pk2(v.x, v.y); o.y = pk2(v.z, v.w); *(LAS u32x2*)(HS + p * SLD + 4 * n4) = o; }
        __syncthreads();
        const float csi = csS[irow * 8 + hh];
        f32x4 ay[4], ah[4];
#pragma unroll
        for (int pt = 0; pt < 4; ++pt) { ay[pt] = (f32x4){0.f, 0.f, 0.f, 0.f}; ah[pt] = (f32x4){0.f, 0.f, 0.f, 0.f}; }
#pragma unroll
        for (int ks = 0; ks < 4; ++ks) {
#pragma unroll
            for (int pt = 0; pt < 4; ++pt) ah[pt] = __builtin_amdgcn_mfma_f32_16x16x32_bf16(lds_frag(HS + (16 * pt + fr) * SLD + 32 * ks + 8 * fq), cfrag[ks], ah[pt], 0, 0, 0);
            if (2 * ks <= w) {
                float mv[8];
#pragma unroll
                for (int e = 0; e < 8; ++e) {
                    const int j = 32 * ks + (e < 4 ? 4 * fq + e : 16 + 4 * fq + (e - 4));
                    const float cbv = e < 4 ? cb[2 * ks][e] : cb[2 * ks + 1][e - 4];
                    mv[e] = j <= irow ? cbv * __expf(csi - csS[j * 8 + hh]) * dtS[j * 8 + hh] : 0.f;
                }
                u32x4 mp; mp.x = pk2(mv[0], mv[1]); mp.y = pk2(mv[2], mv[3]); mp.z = pk2(mv[4], mv[5]); mp.w = pk2(mv[6], mv[7]);
                const bf16x8 mfrag = __builtin_bit_cast(bf16x8, mp);
#pragma unroll
                for (int pt = 0; pt < 4; ++pt) ay[pt] = __builtin_amdgcn_mfma_f32_16x16x32_bf16(lds_frag2(XT + (16 * pt + fr) * SLD + 32 * ks + 4 * fq, XT + (16 * pt + fr) * SLD + 32 * ks + 16 + 4 * fq), mfrag, ay[pt], 0, 0, 0);
            }
        }
        const float ei = __expf(csi);
#pragma unroll
        for (int pt = 0; pt < 4; ++pt) {
            const int col = h * SP + 16 * pt + 4 * fq;
            const f32x4 xv = *(const f32x4*)(ACT + (size_t)(tok0 + irow) * 4096 + col);
            const u32x2 zz = *(const u32x2*)(PROJ + (size_t)(tok0 + irow) * HYB_MAIN + 1536 + col);
            const float z0 = bf2f((bf16_t)(zz.x & 0xffff)), z1 = bf2f((bf16_t)(zz.x >> 16)), z2 = bf2f((bf16_t)(zz.y & 0xffff)), z3 = bf2f((bf16_t)(zz.y >> 16));
            const float y0 = (ay[pt][0] + ei * ah[pt][0] + Dh * xv.x) * siluf(z0), y1 = (ay[pt][1] + ei * ah[pt][1] + Dh * xv.y) * siluf(z1);
            const float y2 = (ay[pt][2] + ei * ah[pt][2] + Dh * xv.z) * siluf(z2), y3 = (ay[pt][3] + ei * ah[pt][3] + Dh * xv.w) * siluf(z3);
            rowsq += y0 * y0 + y1 * y1 + y2 * y2 + y3 * y3;
            u32x2 o; o.x = pk2(y0, y1); o.y = pk2(y2, y3); *(u32x2*)(MIX + (size_t)(tok0 + irow) * HYB_MIX + AW + col) = o;
        }
        __syncthreads();
    }
    rowsq += __shfl_xor(rowsq, 16); rowsq += __shfl_xor(rowsq, 32);
    const float rn = rsqrtf(rowsq * (1.f / 512.f) + EPS);
    const float* nw = c.in(I_SNW) + (size_t)li * SDI + g * 512;
    asm volatile("s_waitcnt vmcnt(0)" ::: "memory");
    bf16_t* mrow = MIX + (size_t)(tok0 + irow) * HYB_MIX + AW + g * 512 + fq * 128;
#pragma unroll 4
    for (int cc = 0; cc < 16; ++cc) {
        const u32x4 v = *(const u32x4*)(mrow + 8 * cc); const float* wv = nw + fq * 128 + 8 * cc; u32x4 o;
        o.x = pk2(bf2f((bf16_t)(v.x & 0xffff)) * rn * wv[0], bf2f((bf16_t)(v.x >> 16)) * rn * wv[1]); o.y = pk2(bf2f((bf16_t)(v.y & 0xffff)) * rn * wv[2], bf2f((bf16_t)(v.y >> 16)) * rn * wv[3]);
        o.z = pk2(bf2f((bf16_t)(v.z & 0xffff)) * rn * wv[4], bf2f((bf16_t)(v.z >> 16)) * rn * wv[5]); o.w = pk2(bf2f((bf16_t)(v.w & 0xffff)) * rn * wv[6], bf2f((bf16_t)(v.w >> 16)) * rn * wv[7]);
        *(u32x4*)(mrow + 8 * cc) = o;
    }
}

DI void gdn_pre_token(const Ctx& c, int li, int tok) {
    const bf16_t* PROJ = c.ws<bf16_t>(W_PROJ); float* ACT = c.ws<float>(W_ACT); float* AUX = c.ws<float>(W_AUX); const float* EX = c.ws<float>(W_EXTRA);
    const int lane = c.lane; const bool smp = tok >= T; const int b = smp ? tok - T : tok / SEQ, s = smp ? 0 : tok % SEQ;
    const float* cw = c.in(I_GCW) + (size_t)li * 4 * GQKV;
    const float* st = c.in(I_GCONV) + (size_t)(li * NS + b) * 3 * GQKV;
    const bf16_t* prow = PROJ + (size_t)tok * GDN_MAIN;
    float* osc = c.p.out + O_SGC + (size_t)(li * NS + b) * 3 * GQKV;
#pragma unroll 1
    for (int hc = 0; hc < 32; ++hc) {
        float v[2];
#pragma unroll
        for (int e = 0; e < 2; ++e) {
            const int ch = hc * 128 + e * 64 + lane;
            const float x3 = bf2f(prow[ch]); float x0, x1, x2;
            if (smp) { x0 = st[ch]; x1 = st[GQKV + ch]; x2 = st[2 * GQKV + ch]; }
            else { x2 = s >= 1 ? bf2f(prow[ch - GDN_MAIN]) : 0.f; x1 = s >= 2 ? bf2f(prow[ch - 2 * GDN_MAIN]) : 0.f; x0 = s >= 3 ? bf2f(prow[ch - 3 * GDN_MAIN]) : 0.f; }
            v[e] = siluf(x0 * cw[ch] + x1 * cw[GQKV + ch] + x2 * cw[2 * GQKV + ch] + x3 * cw[3 * GQKV + ch]);
            if (smp) { osc[ch] = x1; osc[GQKV + ch] = x2; osc[2 * GQKV + ch] = x3; }
            else if (s >= SEQ - 3) c.p.out[O_PGC + ((size_t)(li * NB + b) * 3 + (s - (SEQ - 3))) * GQKV + ch] = x3;
        }
        if (hc < 16) {
            const float ss = wave_sum(v[0] * v[0] + v[1] * v[1]);
            const float r = rsqrtf(ss + EPS) * (hc < 8 ? 0.08838834764831845f : 1.f);
            v[0] *= r; v[1] *= r;
        }
        ACT[(size_t)tok * 4096 + hc * 128 + lane] = v[0]; ACT[(size_t)tok * 4096 + hc * 128 + 64 + lane] = v[1];
    }
    if (lane < GH) {
        AUX[(size_t)tok * 32 + lane] = sigmoidf_(EX[(size_t)tok * 32 + lane]);
        AUX[(size_t)tok * 32 + 16 + lane] = -__expf(c.in(I_GALOG)[li * GH + lane]) * softplusf_(EX[(size_t)tok * 32 + 16 + lane] + c.in(I_GDTB)[li * GH + lane]);
    }
}
DI void gdn_seq_phase(const Ctx& c, int li, int first_item) {
    const float* ACT = c.ws<float>(W_ACT); const float* AUX = c.ws<float>(W_AUX); float* Y = c.ws<float>(W_Y);
    const int slot = c.tid >> 8, t8 = c.tid & 255, col = t8 >> 1, half = t8 & 1;
    LAS float* kq = (LAS float*)c.lds + slot * 512;
    const int nslot = gridDim.x * 2;
    for (int base = first_item; base < NB * GH + NS * GH; base += nslot) {
        const int item = base + blockIdx.x * 2 + slot;
        const bool wg_prompt = (base + blockIdx.x * 2) < NB * GH;
        const int L = wg_prompt ? SEQ : 1;
        const bool valid = item < NB * GH + NS * GH;
        const bool smp = item >= NB * GH; const int it = smp ? item - NB * GH : item;
        const int seq = valid ? it / GH : 0, vh = valid ? it % GH : 0, hq = vh >> 1;
        const int tok0 = smp ? T + seq : seq * SEQ;
        float S[64];
        if (valid && smp) { const float* s0 = c.in(I_GST) + ((size_t)(li * NS + seq) * GH + vh) * GDK * GDV + (size_t)(64 * half) * GDV + col;
#pragma unroll
            for (int k = 0; k < 64; ++k) S[k] = s0[(size_t)k * GDV]; }
        else {
#pragma unroll
            for (int k = 0; k < 64; ++k) S[k] = 0.f; }
        __syncthreads();
        for (int t = 0; t < L; ++t) {
            LAS float* cur = kq + (t & 1) * 256;
            const float* a = ACT + (size_t)(tok0 + t) * 4096;
            cur[t8] = a[(t8 < 128 ? 1024 : -128) + hq * 128 + t8];
            const float vv = a[2048 + vh * 128 + col], beta = AUX[(size_t)(tok0 + t) * 32 + vh], eg = __expf(AUX[(size_t)(tok0 + t) * 32 + 16 + vh]);
            __syncthreads();
            const LAS float* kk = cur + 64 * half; const LAS float* qq = cur + 128 + 64 * half;
            float ks = 0.f;
#pragma unroll
            for (int k = 0; k < 64; k += 4) { const f32x4 kv = *(const LAS f32x4*)(kk + k); ks += kv.x * S[k] + kv.y * S[k + 1] + kv.z * S[k + 2] + kv.w * S[k + 3]; }
            ks += __shfl_xor(ks, 1);
            const float u = beta * (vv - eg * ks);
            asm volatile("" ::: "memory");
            float o = 0.f;
#pragma unroll
            for (int k = 0; k < 64; k += 4) { const f32x4 kv = *(const LAS f32x4*)(kk + k); const f32x4 qv = *(const LAS f32x4*)(qq + k);
                S[k] = eg * S[k] + kv.x * u; S[k + 1] = eg * S[k + 1] + kv.y * u; S[k + 2] = eg * S[k + 2] + kv.z * u; S[k + 3] = eg * S[k + 3] + kv.w * u;
                o += qv.x * S[k] + qv.y * S[k + 1] + qv.z * S[k + 2] + qv.w * S[k + 3]; }
            o += __shfl_xor(o, 1);
            if (valid && half == 0) Y[(size_t)(tok0 + t) * 2048 + vh * 128 + col] = o;
        }
        if (valid) { float* so = (smp ? c.p.out + O_SGS + ((size_t)(li * NS + seq) * GH + vh) * GDK * GDV : c.p.out + O_PGS + ((size_t)(li * NB + seq) * GH + vh) * GDK * GDV) + (size_t)(64 * half) * GDV + col;
#pragma unroll
            for (int k = 0; k < 64; ++k) so[(size_t)k * GDV] = S[k]; }
        __syncthreads();
    }
}

constexpr size_t W_KCD = W_GO;
constexpr size_t W_U0 = W_HID;
constexpr size_t W_GC = W_HID + (size_t)67108864;
constexpr size_t W_QB = W_H;
constexpr size_t W_ATTG = W_MIXED;
constexpr size_t W_KT = W_MIXED + (size_t)33554432;
constexpr int GA_LDS = 20000;
constexpr int GCH = SEQ / 64;

DI bf16x8 pack8(const f32x4 a, const f32x4 b) { u32x4 r; r.x = pk2(a.x, a.y); r.y = pk2(a.z, a.w); r.z = pk2(b.x, b.y); r.w = pk2(b.z, b.w); return __builtin_bit_cast(bf16x8, r); }
DI bf16x8 gfrag_f32(const float* p) { return pack8(*(const f32x4*)p, *(const f32x4*)(p + 4)); }

DI void gdn_a_item(const Ctx& c, int li, int item) {
    const float* ACT = c.ws<float>(W_ACT); const float* AUX = c.ws<float>(W_AUX);
    const int ch = item & (GCH - 1), vh = (item >> 6) & 15, b = item >> 10, hq = vh >> 1, tok0 = b * SEQ + ch * 64;
    int lane_ = c.lane; asm volatile("" : "+v"(lane_));
    const int lane = lane_, fr = lane & 15, fq = lane >> 4;
    LAS unsigned char* wl = c.lds + c.wave * GA_LDS;
    LAS float* As = (LAS float*)wl; LAS bf16_t* Ts = (LAS bf16_t*)wl; LAS bf16_t* KsT = (LAS bf16_t*)wl;
    LAS float* gcS = (LAS float*)(wl + 17408); LAS float* btS = gcS + 64; LAS float* beS = gcS + 128;
    bf16_t* KCDg = c.ws<bf16_t>(W_KCD) + (size_t)item * 8192; bf16_t* ATTg = c.ws<bf16_t>(W_ATTG) + (size_t)item * 4096; bf16_t* U0g = c.ws<bf16_t>(W_U0) + (size_t)item * 8192;
    const int qitem = (b * GQH + hq) * GCH + ch;
    { const float gi = AUX[(size_t)(tok0 + lane) * 32 + 16 + vh], bi = AUX[(size_t)(tok0 + lane) * 32 + vh];
      float gc = gi;
#pragma unroll
      for (int o = 1; o < 64; o <<= 1) { const float t = __shfl_up(gc, o); if (lane >= o) gc += t; }
      gcS[lane] = gc; btS[lane] = bi; beS[lane] = bi * __expf(gc); c.ws<float>(W_GC)[(size_t)(tok0 + lane) * 16 + vh] = gc; }
    LDS_WAIT();
    {
        bf16x8 kf[4][4];
#pragma unroll
        for (int t = 0; t < 4; ++t) {
#pragma unroll
            for (int ks = 0; ks < 4; ++ks) kf[t][ks] = gfrag_f32(ACT + (size_t)(tok0 + 16 * t + fr) * 4096 + 1024 + hq * 128 + 32 * ks + 8 * fq);
            asm volatile("" ::: "memory");
        }
#pragma unroll
        for (int it = 0; it < 4; ++it) {
            bf16x8 qf[4];
#pragma unroll
            for (int ks = 0; ks < 4; ++ks) qf[ks] = gfrag_f32(ACT + (size_t)(tok0 + 16 * it + fr) * 4096 + hq * 128 + 32 * ks + 8 * fq);
            const int i = 16 * it + fr; const float gci = gcS[i], bti = btS[i];
#pragma unroll
            for (int jt = 0; jt < 4; ++jt) {
                bf16_t* ap = ATTg + (unsigned)(i * 64 + 16 * jt + 4 * fq);
                if (jt > it) { *(unsigned long long*)ap = 0ull; continue; }
                f32x4 kk = (f32x4){0.f, 0.f, 0.f, 0.f}, qk = (f32x4){0.f, 0.f, 0.f, 0.f};
#pragma unroll
                for (int ks = 0; ks < 4; ++ks) { kk = __builtin_amdgcn_mfma_f32_16x16x32_bf16(kf[jt][ks], kf[it][ks], kk, 0, 0, 0); qk = __builtin_amdgcn_mfma_f32_16x16x32_bf16(kf[jt][ks], qf[ks], qk, 0, 0, 0); }
                f32x4 av, tv;
#pragma unroll
                for (int r = 0; r < 4; ++r) { const int j = 16 * jt + 4 * fq + r; const float dec = __expf(gci - gcS[j]); av[r] = j < i ? bti * kk[r] * dec : 0.f; tv[r] = j <= i ? qk[r] * dec : 0.f; }
                *(LAS f32x4*)(As + i * 64 + 16 * jt + 4 * fq) = av;
                *(unsigned long long*)ap = (unsigned long long)pk2(tv[0], tv[1]) | ((unsigned long long)pk2(tv[2], tv[3]) << 32);
            }
        }
    }
    LDS_WAIT();
    float Tr[64];
#pragma unroll
    for (int i = 0; i < 64; ++i) {
        float acc = lane == i ? 1.f : 0.f;
#pragma unroll
        for (int j = 0; j < i; ++j) acc -= As[i * 64 + j] * Tr[j];
        Tr[i] = acc;
    }
    LDS_WAIT();
#pragma unroll
    for (int i = 0; i < 64; ++i) Ts[i * 72 + lane] = f2bf(Tr[i]);
    LDS_WAIT();
    {
        bf16x8 tf[4][2];
#pragma unroll
        for (int it = 0; it < 4; ++it)
#pragma unroll
            for (int ks = 0; ks < 2; ++ks) tf[it][ks] = lds_frag(Ts + (16 * it + fr) * 72 + 32 * ks + 8 * fq);
#pragma unroll 1
        for (int nt = 0; nt < 8; ++nt) {
            f32x4 au[4], ak[4];
#pragma unroll
            for (int it = 0; it < 4; ++it) { au[it] = (f32x4){0.f, 0.f, 0.f, 0.f}; ak[it] = (f32x4){0.f, 0.f, 0.f, 0.f}; }
#pragma unroll
            for (int ks = 0; ks < 2; ++ks) {
                float vv[8], kv[8];
#pragma unroll
                for (int e = 0; e < 8; ++e) { const float* rp = ACT + (size_t)(tok0 + 32 * ks + 8 * fq + e) * 4096 + 16 * nt + fr; vv[e] = rp[2048 + vh * 128] * btS[32 * ks + 8 * fq + e]; kv[e] = rp[1024 + hq * 128] * beS[32 * ks + 8 * fq + e]; }
                u32x4 pv, pk; pv.x = pk2(vv[0], vv[1]); pv.y = pk2(vv[2], vv[3]); pv.z = pk2(vv[4], vv[5]); pv.w = pk2(vv[6], vv[7]);
                pk.x = pk2(kv[0], kv[1]); pk.y = pk2(kv[2], kv[3]); pk.z = pk2(kv[4], kv[5]); pk.w = pk2(kv[6], kv[7]);
                const bf16x8 vfrag = __builtin_bit_cast(bf16x8, pv), kfrag = __builtin_bit_cast(bf16x8, pk);
#pragma unroll
                for (int it = 0; it < 4; ++it) { au[it] = __builtin_amdgcn_mfma_f32_16x16x32_bf16(tf[it][ks], vfrag, au[it], 0, 0, 0);
                                                 ak[it] = __builtin_amdgcn_mfma_f32_16x16x32_bf16(kfrag, tf[it][ks], ak[it], 0, 0, 0); }
            }
#pragma unroll
            for (int it = 0; it < 4; ++it) {
                *(unsigned long long*)(U0g + (unsigned)(((nt * 4 + it) * 64 + lane) * 4)) = (unsigned long long)pk2(au[it][0], au[it][1]) | ((unsigned long long)pk2(au[it][2], au[it][3]) << 32);
                *(unsigned long long*)(KCDg + (unsigned)((16 * it + fr) * 128 + 16 * nt + 4 * fq)) = (unsigned long long)pk2(ak[it][0], ak[it][1]) | ((unsigned long long)pk2(ak[it][2], ak[it][3]) << 32);
            }
        }
    }
    if ((vh & 1) == 0) {
        bf16_t* QBg = c.ws<bf16_t>(W_QB) + (size_t)qitem * 8192; bf16_t* KTg = c.ws<bf16_t>(W_KT) + (size_t)qitem * 8192;
#pragma unroll 4
        for (int it = 0; it < 16; ++it) { const int q = it * 64 + lane, row = q >> 4, c16 = q & 15;
            *(bf16x8*)(QBg + row * 128 + 8 * c16) = gfrag_f32(ACT + (size_t)(tok0 + row) * 4096 + hq * 128 + 8 * c16); }
        LDS_WAIT();
#pragma unroll 4
        for (int j = 0; j < 64; ++j) { const float2 kv = *(const float2*)(ACT + (size_t)(tok0 + j) * 4096 + 1024 + hq * 128 + 2 * lane);
            KsT[(2 * lane) * 68 + j] = f2bf(kv.x); KsT[(2 * lane + 1) * 68 + j] = f2bf(kv.y); }
        LDS_WAIT();
#pragma unroll 4
        for (int ii = 0; ii < 32; ++ii) { const int row = 4 * ii + fq, c8 = fr; *(u32x2*)(KTg + row * 64 + 4 * c8) = *(const LAS u32x2*)(KsT + row * 68 + 4 * c8); }
    }
    LDS_WAIT();
}

constexpr int GS_KCD = 0, GS_QB = 17408, GS_ATT = 34816, GS_KT = 44032, GS_GC = 62464, GS_BUF = 62720;
DI void gdn_scan_wg(const Ctx& c, int li, int bvh) {
    const int vh = bvh & 15, b = bvh >> 4, hq = vh >> 1, lane = c.lane, fr = lane & 15, fq = lane >> 4, w = c.wave, tid = c.tid;
    const bf16_t* KCDg = c.ws<bf16_t>(W_KCD) + (size_t)(bvh * GCH) * 8192; const bf16_t* ATTg = c.ws<bf16_t>(W_ATTG) + (size_t)(bvh * GCH) * 4096;
    const bf16_t* U0g = c.ws<bf16_t>(W_U0) + (size_t)(bvh * GCH) * 8192;
    const bf16_t* QBg = c.ws<bf16_t>(W_QB) + (size_t)((b * GQH + hq) * GCH) * 8192; const bf16_t* KTg = c.ws<bf16_t>(W_KT) + (size_t)((b * GQH + hq) * GCH) * 8192;
    const float* GCg = c.ws<float>(W_GC); float* Y = c.ws<float>(W_Y);
    const bf16_t* src[7]; int dst[7]; int stp[7];
#pragma unroll
    for (int k = 0; k < 7; ++k) {
        const int q = tid + 512 * k;
        if (k < 2) { const int row = q >> 4, cc = q & 15; src[k] = KCDg + row * 128 + 8 * cc; dst[k] = GS_KCD + row * 272 + 16 * cc; stp[k] = 8192; }
        else if (k < 4) { const int qq = q - 1024, row = qq >> 4, cc = qq & 15; src[k] = QBg + row * 128 + 8 * cc; dst[k] = GS_QB + row * 272 + 16 * cc; stp[k] = 8192; }
        else if (k < 5) { const int qq = q - 2048, row = qq >> 3, cc = qq & 7; src[k] = ATTg + row * 64 + 8 * cc; dst[k] = GS_ATT + row * 144 + 16 * cc; stp[k] = 4096; }
        else { const int qq = q - 2560, row = qq >> 3, cc = qq & 7; src[k] = KTg + row * 64 + 8 * cc; dst[k] = GS_KT + row * 144 + 16 * cc; stp[k] = 8192; }
    }
    f32x4 sacc[8];
#pragma unroll
    for (int t = 0; t < 8; ++t) sacc[t] = (f32x4){0.f, 0.f, 0.f, 0.f};
    __syncthreads();
    u32x4 stg[7]; float gstg = 0.f;
#pragma unroll
    for (int k = 0; k < 7; ++k) stg[k] = *(const u32x4*)(src[k]);
    if (tid < 64) gstg = GCg[(size_t)(b * SEQ + tid) * 16 + vh];
#pragma unroll
    for (int k = 0; k < 7; ++k) *(LAS u32x4*)(c.lds + dst[k]) = stg[k];
    if (tid < 64) *(LAS float*)(c.lds + GS_GC + 4 * tid) = gstg;
    __syncthreads();
#pragma unroll 1
    for (int t = 0; t < GCH; ++t) {
        LAS unsigned char* buf = c.lds + (t & 1) * GS_BUF; LAS unsigned char* nbuf = c.lds + ((t + 1) & 1) * GS_BUF;
        const int tok0 = b * SEQ + t * 64;
        const bool more = t + 1 < GCH;
        if (more) {
#pragma unroll
            for (int k = 0; k < 7; ++k) stg[k] = *(const u32x4*)(src[k] + (size_t)(t + 1) * stp[k]);
            if (tid < 64) gstg = GCg[(size_t)(tok0 + 64 + tid) * 16 + vh];
        }
        u32x2 u0r[4];
#pragma unroll
        for (int it = 0; it < 4; ++it) u0r[it] = *(const u32x2*)(U0g + (size_t)t * 8192 + ((size_t)(w * 4 + it) * 64 + lane) * 4);
        const LAS bf16_t* KCD = (const LAS bf16_t*)(buf + GS_KCD); const LAS bf16_t* QB = (const LAS bf16_t*)(buf + GS_QB);
        const LAS bf16_t* ATT = (const LAS bf16_t*)(buf + GS_ATT); const LAS bf16_t* KT = (const LAS bf16_t*)(buf + GS_KT); const LAS float* gcS = (const LAS float*)(buf + GS_GC);
        bf16x8 sfrag[4];
#pragma unroll
        for (int ks = 0; ks < 4; ++ks) sfrag[ks] = pack8(sacc[2 * ks], sacc[2 * ks + 1]);
        const float gl = gcS[63], egl = __expf(gl);
        bf16x8 ufrag[2], udfrag[2]; f32x4 ov[4];
#pragma unroll
        for (int hp = 0; hp < 2; ++hp) {
            f32x4 uu[2];
#pragma unroll
            for (int h2 = 0; h2 < 2; ++h2) {
                const int it = 2 * hp + h2;
                f32x4 ks_ = (f32x4){0.f, 0.f, 0.f, 0.f}, qs_ = (f32x4){0.f, 0.f, 0.f, 0.f};
#pragma unroll
                for (int ks = 0; ks < 4; ++ks) {
                    ks_ = __builtin_amdgcn_mfma_f32_16x16x32_bf16(lds_frag2(KCD + (16 * it + fr) * 136 + 32 * ks + 4 * fq, KCD + (16 * it + fr) * 136 + 32 * ks + 16 + 4 * fq), sfrag[ks], ks_, 0, 0, 0);
                    qs_ = __builtin_amdgcn_mfma_f32_16x16x32_bf16(lds_frag2(QB + (16 * it + fr) * 136 + 32 * ks + 4 * fq, QB + (16 * it + fr) * 136 + 32 * ks + 16 + 4 * fq), sfrag[ks], qs_, 0, 0, 0);
                }
                const f32x4 gci = *(const LAS f32x4*)(gcS + 16 * it + 4 * fq);
                f32x4 u;
                u[0] = bf2f((bf16_t)(u0r[it].x & 0xffff)) - ks_[0]; u[1] = bf2f((bf16_t)(u0r[it].x >> 16)) - ks_[1]; u[2] = bf2f((bf16_t)(u0r[it].y & 0xffff)) - ks_[2]; u[3] = bf2f((bf16_t)(u0r[it].y >> 16)) - ks_[3];
                uu[h2] = u;
#pragma unroll
                for (int r = 0; r < 4; ++r) ov[it][r] = qs_[r] * __expf(gci[r]);
            }
            ufrag[hp] = pack8(uu[0], uu[1]);
            const f32x4 g0 = *(const LAS f32x4*)(gcS + 32 * hp + 4 * fq), g1 = *(const LAS f32x4*)(gcS + 32 * hp + 16 + 4 * fq);
            f32x4 d0, d1;
#pragma unroll
            for (int r = 0; r < 4; ++r) { d0[r] = uu[0][r] * __expf(gl - g0[r]); d1[r] = uu[1][r] * __expf(gl - g1[r]); }
            udfrag[hp] = pack8(d0, d1);
        }
#pragma unroll
        for (int it = 0; it < 4; ++it) {
            f32x4 au = ov[it];
#pragma unroll
            for (int ks = 0; ks < 2; ++ks) au = __builtin_amdgcn_mfma_f32_16x16x32_bf16(lds_frag2(ATT + (16 * it + fr) * 72 + 32 * ks + 4 * fq, ATT + (16 * it + fr) * 72 + 32 * ks + 16 + 4 * fq), ufrag[ks], au, 0, 0, 0);
#pragma unroll
            for (int r = 0; r < 4; ++r) Y[(size_t)(tok0 + 16 * it + 4 * fq + r) * 2048 + vh * 128 + 16 * w + fr] = au[r];
        }
#pragma unroll
        for (int tt = 0; tt < 8; ++tt) {
            f32x4 a = sacc[tt] * egl;
#pragma unroll
            for (int ks = 0; ks < 2; ++ks) a = __builtin_amdgcn_mfma_f32_16x16x32_bf16(lds_frag2(KT + (16 * tt + fr) * 72 + 32 * ks + 4 * fq, KT + (16 * tt + fr) * 72 + 32 * ks + 16 + 4 * fq), udfrag[ks], a, 0, 0, 0);
            sacc[tt] = a;
        }
        if (more) {
#pragma unroll
            for (int k = 0; k < 7; ++k) *(LAS u32x4*)(nbuf + dst[k]) = stg[k];
            if (tid < 64) *(LAS float*)(nbuf + GS_GC + 4 * tid) = gstg;
        }
        __syncthreads();
    }
    float* so = c.p.out + O_PGS + ((size_t)(li * NB + b) * GH + vh) * GDK * GDV;
#pragma unroll
    for (int tt = 0; tt < 8; ++tt)
#pragma unroll
        for (int r = 0; r < 4; ++r) so[(size_t)(16 * tt + 4 * fq + r) * GDV + 16 * w + fr] = sacc[tt][r];
}

DI void gdn_post_token(const Ctx& c, int li, int tok) {
    const bf16_t* PROJ = c.ws<bf16_t>(W_PROJ); const float* Y = c.ws<float>(W_Y); bf16_t* MIX = c.ws<bf16_t>(W_MIXED);
    const float* nw = c.in(I_GNW) + (size_t)li * GDV; const int lane = c.lane;
#pragma unroll 4
    for (int vh = 0; vh < GH; ++vh) {
        const float o0 = Y[(size_t)tok * 2048 + vh * 128 + lane], o1 = Y[(size_t)tok * 2048 + vh * 128 + 64 + lane];
        const float r = rsqrtf(wave_sum(o0 * o0 + o1 * o1) * (1.f / 128.f) + EPS);
        const float z0 = bf2f(PROJ[(size_t)tok * GDN_MAIN + 4096 + vh * 128 + lane]), z1 = bf2f(PROJ[(size_t)tok * GDN_MAIN + 4096 + vh * 128 + 64 + lane]);
        MIX[(size_t)tok * GVW + vh * 128 + lane] = f2bf(o0 * r * nw[lane] * siluf(z0));
        MIX[(size_t)tok * GVW + vh * 128 + 64 + lane] = f2bf(o1 * r * nw[64 + lane] * siluf(z1));
    }
}

constexpr int PH_PER_LAYER = 10, N_PHASES = 1 + DEPTH * PH_PER_LAYER;
#ifndef ONLY
#define ONLY -1
#endif
#define EN(x) (ONLY < 0 || ONLY == (x))
DI void run_phase(const Ctx& c, int ph) {
    if (ph == 0) { if (!EN(0)) return;
        for (int i = 0; i < 2; ++i) {
            transpose_mat(c, c.in(I_WHIN) + (size_t)i * D * HYB_IN, D, HYB_IN, c.ws<bf16_t>(W_HIN) + (size_t)i * HYB_IN * D, 0);
            transpose_mat(c, c.in(I_WHOUT) + (size_t)i * HYB_MIX * D, HYB_MIX, D, c.ws<bf16_t>(W_HOUT) + (size_t)i * D * HYB_MIX, 0);
            transpose_mat(c, c.in(I_WGIN) + (size_t)i * D * GDN_IN, D, GDN_IN, c.ws<bf16_t>(W_GIN) + (size_t)i * GDN_IN * D, 0);
            transpose_mat(c, c.in(I_WGOUT) + (size_t)i * GVW * D, GVW, D, c.ws<bf16_t>(W_GOUT) + (size_t)i * D * GVW, 0);
        }
        for (int l = 0; l < 4; ++l) {
            transpose_mat(c, c.in(I_WFG) + (size_t)l * D * FF, D, FF, c.ws<bf16_t>(W_GU) + (size_t)l * 2 * FF * D, 1);
            transpose_mat(c, c.in(I_WFU) + (size_t)l * D * FF, D, FF, c.ws<bf16_t>(W_GU) + (size_t)l * 2 * FF * D, 2);
            transpose_mat(c, c.in(I_WFD) + (size_t)l * FF * D, FF, D, c.ws<bf16_t>(W_DN) + (size_t)l * D * FF, 0);
        }
        rowpass_phase(c, 0, nullptr, c.in(I_NMPRE), true);
        const size_t gt = (size_t)blockIdx.x * NTHR + c.tid, gn = (size_t)gridDim.x * NTHR;
        const size_t per = (size_t)(WIN - 1) * AW / 4, tot = (size_t)2 * NS * per;
        for (size_t i = gt; i < tot; i += gn) { const size_t sq = i / per, r = i % per;
            ((f32x4*)(c.p.out + O_SK + sq * WIN * AW))[r] = ((const f32x4*)(c.in(I_CK) + sq * WIN * AW + AW))[r];
            ((f32x4*)(c.p.out + O_SV + sq * WIN * AW))[r] = ((const f32x4*)(c.in(I_CV) + sq * WIN * AW + AW))[r]; }
        return;
    }
    const int l = (ph - 1) / PH_PER_LAYER, sp = (ph - 1) % PH_PER_LAYER, li = l >> 1; const bool hyb = (l & 1) == 0;
    bf16_t* H = c.ws<bf16_t>(W_H); bf16_t* PROJ = c.ws<bf16_t>(W_PROJ); bf16_t* MIX = c.ws<bf16_t>(W_MIXED); float* GO = c.ws<float>(W_GO); bf16_t* HID = c.ws<bf16_t>(W_HID);
    switch (sp) {
    case 0: {
        if (!EN(1)) break;
        const bf16_t* Wt = hyb ? c.ws<bf16_t>(W_HIN) + (size_t)li * HYB_IN * D : c.ws<bf16_t>(W_GIN) + (size_t)li * GDN_IN * D;
        const int nmain = hyb ? HYB_MAIN : GDN_MAIN, nall = hyb ? HYB_IN : GDN_IN;
        { pg8::Gemm g{H, Wt, T, nmain, D}; pg8::StaticOrder S; S.init(T, nmain, gridDim.x, blockIdx.x); pg8::EpiBf16Plain E{PROJ, nmain};
          pg8::gemm_phase<pg8::EpiBf16Plain, pg8::StaticOrder>(c.lds, g, S, E, nullptr); }
        { Epi e{0, PROJ, c.ws<float>(W_EXTRA), nmain, 0}; gemm_simple(c, H, D, T, Wt + (size_t)nmain * D, D, nall - nmain, D, e); }
        { Epi e{0, PROJ + (size_t)T * nmain, c.ws<float>(W_EXTRA) + (size_t)T * 32, nmain, nmain}; gemm_simple(c, H + (size_t)T * D, D, NS, Wt, D, nall, D, e); }
    } break;
    case 1: {
        if (hyb) {
            if (EN(2)) for (int tok = c.gw; tok < TT; tok += c.ngw) hyb_pre_token(c, li, tok);
            LAS float* pl = (LAS float*)(c.lds + c.wave * 2048);
            if (EN(3)) for (int it = c.gw; it < TT * AH; it += c.ngw) attn_wave(c, li, it / AH, it % AH, pl);
        } else { if (EN(4)) for (int tok = c.gw; tok < TT; tok += c.ngw) gdn_pre_token(c, li, tok); }
    } break;
    case 2: {
        if (hyb) { if (EN(5)) { for (int it = blockIdx.x; it < NB * NCH * 2; it += gridDim.x) ssd_a_item(c, li, it);
                                for (int it = NB * SH * SP + c.gw; it < (NB + NS) * SH * SP; it += c.ngw) ssd_wave(c, li, it); } }
        else if (EN(6)) { gdn_seq_phase(c, li, NB * GH); for (int it = c.gw; it < NB * GH * GCH; it += c.ngw) gdn_a_item(c, li, it); }
    } break;
    case 3: {
        if (hyb) { if (EN(7)) { ssd_scan_phase(c, li); for (int tok = T + c.gw; tok < TT; tok += c.ngw) hyb_post_token(c, li, tok); } }
        else { if (EN(8)) for (int it = blockIdx.x; it < NB * GH; it += gridDim.x) gdn_scan_wg(c, li, it); }
    } break;
    case 4: {
        if (hyb) { if (EN(14)) for (int it = blockIdx.x; it < NB * NCH * 2; it += gridDim.x) ssd_b_item(c, li, it); }
        else if (EN(15)) for (int tok = c.gw; tok < TT; tok += c.ngw) gdn_post_token(c, li, tok);
    } break;
    case 5: {
        if (!EN(9)) break;
        const bf16_t* Wt = hyb ? c.ws<bf16_t>(W_HOUT) + (size_t)li * D * HYB_MIX : c.ws<bf16_t>(W_GOUT) + (size_t)li * D * GVW; const int kk = hyb ? HYB_MIX : GVW;
        { pg8::Gemm g{MIX, Wt, T, D, kk}; pg8::StaticOrder S; S.init(T, D, gridDim.x, blockIdx.x); pg8::EpiF32 E{GO, D, nullptr};
          pg8::gemm_phase<pg8::EpiF32, pg8::StaticOrder>(c.lds, g, S, E, nullptr); }
        { Epi e{1, nullptr, GO + (size_t)T * D, D, 0}; gemm_simple(c, MIX + (size_t)T * kk, kk, NS, Wt, kk, D, kk, e); }
    } break;
    case 6: if (EN(10)) rowpass_phase(c, 1, c.in(I_NMPOST) + (size_t)l * D, c.in(I_NFPRE) + (size_t)l * D, l == 0); break;
    case 7: if (EN(11)) { const bf16_t* Wt = c.ws<bf16_t>(W_GU) + (size_t)l * 2 * FF * D;
        { pg8::Gemm g{H, Wt, T, 2 * FF, D}; pg8::StaticOrder S; S.init(T, 2 * FF, gridDim.x, blockIdx.x); pg8::EpiSwiglu E{HID, FF};
          pg8::gemm_phase<pg8::EpiSwiglu, pg8::StaticOrder>(c.lds, g, S, E, nullptr); }
        { Epi e{2, HID + (size_t)T * FF, nullptr, FF, 0}; gemm_simple(c, H + (size_t)T * D, D, NS, Wt, D, 2 * FF, D, e); } } break;
    case 8: if (EN(12)) { const bf16_t* Wt = c.ws<bf16_t>(W_DN) + (size_t)l * D * FF;
        { pg8::Gemm g{HID, Wt, T, D, FF}; pg8::StaticOrder S; S.init(T, D, gridDim.x, blockIdx.x); pg8::EpiF32 E{GO, D, nullptr};
          pg8::gemm_phase<pg8::EpiF32, pg8::StaticOrder>(c.lds, g, S, E, nullptr); }
        { Epi e{1, nullptr, GO + (size_t)T * D, D, 0}; gemm_simple(c, HID + (size_t)T * FF, FF, NS, Wt, FF, D, FF, e); } } break;
    case 9: if (EN(13)) rowpass_phase(c, l == DEPTH - 1 ? 2 : 1, c.in(I_NFPOST) + (size_t)l * D, l == DEPTH - 1 ? nullptr : c.in(I_NMPRE) + (size_t)(l + 1) * D, false); break;
    default: break;
    }
}

extern __shared__ __attribute__((aligned(16))) unsigned char g_shm[];
__global__ void __launch_bounds__(NTHR, 2) mega(Params p) {
    cg::grid_group grid = cg::this_grid();
    for (int ph = p.ph_lo; ph < p.ph_hi; ++ph) {
        int tid_ = threadIdx.x; asm volatile("" : "+v"(tid_));
        Ctx c; c.p.kp = (KParams)__builtin_amdgcn_kernarg_segment_ptr(); c.p.out = c.p.kp->out; c.tid = tid_; c.lane = tid_ & 63; c.wave = __builtin_amdgcn_readfirstlane(tid_ >> 6);
        c.gw = blockIdx.x * NWAVE + c.wave; c.ngw = gridDim.x * NWAVE; c.lds = (LAS unsigned char*)g_shm;
        run_phase(c, ph);
        if (ph + 1 < p.ph_hi) grid.sync();
    }
}

extern "C" void kernel_launch(void* const* d_in, const int* in_sizes, int n_in, void* d_out, int out_size, void* d_ws, size_t ws_size, hipStream_t stream) {
    static int grid = 0;
    if (!grid) {
        int dev = 0, cus = 0, per = 0; hipGetDevice(&dev); hipDeviceGetAttribute(&cus, hipDeviceAttributeMultiprocessorCount, dev);
        hipFuncSetAttribute((const void*)mega, hipFuncAttributeMaxDynamicSharedMemorySize, LDS_BYTES);
        hipOccupancyMaxActiveBlocksPerMultiprocessor(&per, (const void*)mega, NTHR, LDS_BYTES);
        if (n_in != 30 || (size_t)out_size != O_END || ws_size < W_END) fprintf(stderr, "kernel_launch: unexpected shapes n_in %d out %d (want %zu) ws %zu (want %zu)\n", n_in, out_size, (size_t)O_END, ws_size, (size_t)W_END);
        if (per < 1) fprintf(stderr, "kernel_launch: occupancy query says %d blocks per CU\n", per);
        grid = cus;
    }
    Params p{}; for (int i = 0; i < 30; ++i) p.in[i] = (const float*)d_in[i];
    p.out = (float*)d_out; p.ws = (unsigned char*)d_ws; p.ph_lo = 0; p.ph_hi = N_PHASES;
    void* args[] = {&p};
    hipError_t e = hipLaunchCooperativeKernel((const void*)mega, dim3(grid), dim3(NTHR), args, LDS_BYTES, stream);
    if (e != hipSuccess) fprintf(stderr, "kernel_launch: cooperative launch failed: %s\n", hipGetErrorString(e));
}
```

```cpp
#include <hip/hip_runtime.h>
#include <hip/hip_cooperative_groups.h>
#include <cstdio>
#include <cstdint>
namespace cg = cooperative_groups;

#define DI __device__ __forceinline__
#define LAS __attribute__((address_space(3)))
typedef unsigned short bf16_t;
typedef short bf16x8 __attribute__((ext_vector_type(8)));
typedef float f32x4 __attribute__((ext_vector_type(4)));
typedef unsigned u32x2 __attribute__((ext_vector_type(2)));
typedef unsigned u32x4 __attribute__((ext_vector_type(4)));

constexpr int D = 1024, NB = 4, SEQ = 4096, T = NB * SEQ, NS = 32, TT = T + NS, DEPTH = 4;
constexpr int AH = 8, AHD = 64, AW = 512, WIN = 2048;
constexpr int SH = 16, SP = 64, SN = 128, SG = 2, SDI = 1024, SXBC = 1536;
constexpr int HYB_IN = 4112, HYB_MAIN = 4096, HYB_MIX = 1536;
constexpr int GH = 16, GQH = 8, GDK = 128, GDV = 128, GQKV = 4096, GVW = 2048, GDN_IN = 6176, GDN_MAIN = 6144;
constexpr int FF = 2816;
constexpr float EPS = 1e-6f;
constexpr int NTHR = 512, NWAVE = 8, LDS_BYTES = 163840;

enum { I_XP = 0, I_XS, I_CK, I_CV, I_SCONV, I_SSM, I_GCONV, I_GST, I_RELB, I_NMPRE, I_NMPOST, I_NFPRE, I_NFPOST, I_WHIN, I_SCW, I_SCB, I_SDTB, I_SALOG, I_SD, I_SNW,
       I_WHOUT, I_WGIN, I_GCW, I_GDTB, I_GALOG, I_GNW, I_WGOUT, I_WFG, I_WFU, I_WFD };

constexpr size_t O_YP = 0;
constexpr size_t O_YS = O_YP + (size_t)T * D;
constexpr size_t O_PK = O_YS + (size_t)NS * D;
constexpr size_t O_PV = O_PK + (size_t)2 * NB * WIN * AW;
constexpr size_t O_PSC = O_PV + (size_t)2 * NB * WIN * AW;
constexpr size_t O_PSS = O_PSC + (size_t)2 * NB * 3 * SXBC;
constexpr size_t O_PGC = O_PSS + (size_t)2 * NB * SH * SP * SN;
constexpr size_t O_PGS = O_PGC + (size_t)2 * NB * 3 * GQKV;
constexpr size_t O_SK = O_PGS + (size_t)2 * NB * GH * GDK * GDV;
constexpr size_t O_SV = O_SK + (size_t)2 * NS * WIN * AW;
constexpr size_t O_SSC = O_SV + (size_t)2 * NS * WIN * AW;
constexpr size_t O_SSS = O_SSC + (size_t)2 * NS * 3 * SXBC;
constexpr size_t O_SGC = O_SSS + (size_t)2 * NS * SH * SP * SN;
constexpr size_t O_SGS = O_SGC + (size_t)2 * NS * 3 * GQKV;
constexpr size_t O_END = O_SGS + (size_t)2 * NS * GH * GDK * GDV;

constexpr size_t al256(size_t x) { return (x + 255) & ~(size_t)255; }
constexpr size_t W_CTL = 0;
constexpr size_t W_HIN = 65536;
constexpr size_t W_HOUT = al256(W_HIN + (size_t)2 * HYB_IN * D * 2);
constexpr size_t W_GIN = al256(W_HOUT + (size_t)2 * D * HYB_MIX * 2);
constexpr size_t W_GOUT = al256(W_GIN + (size_t)2 * GDN_IN * D * 2);
constexpr size_t W_GU = al256(W_GOUT + (size_t)2 * D * GVW * 2);
constexpr size_t W_DN = al256(W_GU + (size_t)4 * 2 * FF * D * 2);
constexpr size_t W_X = al256(W_DN + (size_t)4 * D * FF * 2);
constexpr size_t W_H = al256(W_X + (size_t)TT * D * 4);
constexpr size_t W_PROJ = al256(W_H + (size_t)TT * D * 2);
constexpr size_t W_EXTRA = al256(W_PROJ + (size_t)TT * GDN_MAIN * 2);
constexpr size_t W_MIXED = al256(W_EXTRA + (size_t)TT * 32 * 4);
constexpr size_t W_GO = al256(W_MIXED + (size_t)TT * GVW * 2);
constexpr size_t W_HID = al256(W_GO + (size_t)TT * D * 4);
constexpr size_t W_ACT = al256(W_HID + (size_t)TT * FF * 2);
constexpr size_t W_AUX = al256(W_ACT + (size_t)TT * 4096 * 4);
constexpr size_t W_Y = al256(W_AUX + (size_t)TT * 32 * 4);
constexpr size_t W_END = al256(W_Y + (size_t)TT * 2048 * 4);

struct Params { const float* in[30]; float* out; unsigned char* ws; int ph_lo, ph_hi; };

DI float bf2f(bf16_t b) { return __uint_as_float(((unsigned)b) << 16); }
DI bf16_t f2bf(float x) { unsigned u = __float_as_uint(x); u += 0x7fffu + ((u >> 16) & 1u); return (bf16_t)(u >> 16); }
DI unsigned pk2(float lo, float hi) { return (unsigned)f2bf(lo) | ((unsigned)f2bf(hi) << 16); }
DI float wave_sum(float v) {
#pragma unroll
    for (int o = 32; o >= 1; o >>= 1) v += __shfl_xor(v, o);
    return v;
}
DI float wave_max(float v) {
#pragma unroll
    for (int o = 32; o >= 1; o >>= 1) v = fmaxf(v, __shfl_xor(v, o));
    return v;
}
DI float siluf(float x) { return x / (1.f + __expf(-x)); }
DI float sigmoidf_(float x) { return 1.f / (1.f + __expf(-x)); }
DI float softplusf_(float x) { return fmaxf(x, 0.f) + log1pf(__expf(-fabsf(x))); }
#define LDS_WAIT() asm volatile("s_waitcnt lgkmcnt(0)" ::: "memory")
DI bf16x8 lds_frag(const LAS bf16_t* p) { return *(const LAS bf16x8*)p; }
DI bf16x8 lds_frag2(const LAS bf16_t* p0, const LAS bf16_t* p1) {
    const u32x2 a = *(const LAS u32x2*)p0, b = *(const LAS u32x2*)p1; u32x4 r; r.x = a.x; r.y = a.y; r.z = b.x; r.w = b.y; return __builtin_bit_cast(bf16x8, r);
}
DI bf16x8 pack8(const f32x4 a, const f32x4 b) { u32x4 r; r.x = pk2(a.x, a.y); r.y = pk2(a.z, a.w); r.z = pk2(b.x, b.y); r.w = pk2(b.z, b.w); return __builtin_bit_cast(bf16x8, r); }

__device__ const unsigned char c_bucket[3][129] = {
 {0,1,2,3,4,5,6,7,8,9,10,11,12,13,14,15,16,16,16,16,16,16,17,17,17,17,17,17,17,17,18,18,18,18,18,18,18,18,18,18,19,19,19,19,19,19,19,19,19,19,19,19,19,19,20,20,20,20,20,20,20,20,20,20,20,20,20,20,20,20,20,20,20,21,21,21,21,21,21,21,21,21,21,21,21,21,21,21,21,21,21,21,21,21,21,21,21,21,21,22,22,22,22,22,22,22,22,22,22,22,22,22,22,22,22,22,22,22,22,22,22,22,22,22,22,22,22,22,22},
 {0,4,8,12,16,16,17,17,18,18,19,19,19,19,20,20,20,20,20,21,21,21,21,21,21,22,22,22,22,22,22,22,22,22,23,23,23,23,23,23,23,23,23,23,23,23,24,24,24,24,24,24,24,24,24,24,24,24,24,24,24,24,25,25,25,25,25,25,25,25,25,25,25,25,25,25,25,25,25,25,25,25,25,26,26,26,26,26,26,26,26,26,26,26,26,26,26,26,26,26,26,26,26,26,26,26,26,26,26,26,26,26,26,27,27,27,27,27,27,27,27,27,27,27,27,27,27,27,27},
 {0,16,18,19,20,21,21,22,22,23,23,23,24,24,24,24,25,25,25,25,25,26,26,26,26,26,26,26,26,27,27,27,27,27,27,27,27,27,27,28,28,28,28,28,28,28,28,28,28,28,28,28,29,29,29,29,29,29,29,29,29,29,29,29,29,29,29,29,29,29,30,30,30,30,30,30,30,30,30,30,30,30,30,30,30,30,30,30,30,30,30,30,30,30,30,31,31,31,31,31,31,31,31,31,31,31,31,31,31,31,31,31,31,31,31,31,31,31,31,31,31,31,31,31,31,31,31,31,31}};

typedef const Params __attribute__((address_space(4)))* KParams;
struct OutRef { float* out; DI float* operator+(size_t o) const { return out + o; } };
struct PRef { KParams kp; float* out; };
#define XB_TMO      128
#define XB_XCNT(j)  (256  + 64 * (j))
#define XB_XSUB(j)  (1280 + 64 * (j))
#define XB_XGEN(j)  (2304 + 64 * (j))
#define XB_TOP      3328
#define XB_TOPGEN   3392
#define XCD_BAR_WORDS 3456
#define XB_SPIN_CAP (1u << 22)

__device__ __forceinline__ unsigned xb_ld(unsigned* p)              { return __hip_atomic_load(p, __ATOMIC_RELAXED, __HIP_MEMORY_SCOPE_AGENT); }
__device__ __forceinline__ unsigned xb_add(unsigned* p, unsigned v) { return __hip_atomic_fetch_add(p, v, __ATOMIC_RELAXED, __HIP_MEMORY_SCOPE_AGENT); }
__device__ __forceinline__ unsigned xb_xcc_id() { return (unsigned)__builtin_amdgcn_s_getreg((3 << 11) | 20) & 0xFu; }
#define XB_SPIN(cond, bar) do { unsigned _sp = 0; while (cond) { __builtin_amdgcn_s_sleep(1); \
    if ((++_sp & 255u) == 0u) { if (xb_ld(&(bar)[XB_TMO])) break; if (_sp > XB_SPIN_CAP) { atomicAdd(&(bar)[XB_TMO], 1u); break; } } } } while (0)

struct XcdBarrier {
    unsigned* bar; unsigned x;
    volatile LAS unsigned* st;
};

__device__ __forceinline__ XcdBarrier xcd_barrier_post(unsigned* bar, volatile LAS unsigned* st) {
    XcdBarrier b; b.bar = bar; b.x = xb_xcc_id(); b.st = st;
    if (threadIdx.x == 0) (void)xb_add(&bar[XB_XCNT(b.x)], 1u);
    return b;
}
__device__ __forceinline__ void xcd_barrier_complete(unsigned* bar, unsigned x, unsigned& nloc, unsigned& nx) {
    const unsigned G = gridDim.x * gridDim.y * gridDim.z;
    unsigned sum, cnt, mine, sp = 0u;
    for (;;) {
        sum = 0u; cnt = 0u; mine = 0u;
#pragma unroll
        for (unsigned j = 0; j < 16; ++j) { const unsigned c = xb_ld(&bar[XB_XCNT(j)]); sum += c; cnt += (c > 0u) ? 1u : 0u; mine = (j == x) ? c : mine; }
        if (sum == G) break;
        __builtin_amdgcn_s_sleep(1);
        if ((++sp & 255u) == 0u) { if (xb_ld(&bar[XB_TMO])) break; if (sp > XB_SPIN_CAP) { atomicAdd(&bar[XB_TMO], 1u); break; } }
    }
    nloc = mine > 0u ? mine : 1u; nx = cnt > 0u ? cnt : 1u;
}

__device__ __forceinline__ void xcd_barrier(const XcdBarrier& b) {
    asm volatile("s_waitcnt vmcnt(0)" ::: "memory");
    __syncthreads();
    if (threadIdx.x == 0) {
        unsigned* bar = b.bar;
        __builtin_amdgcn_s_waitcnt(0);
        unsigned nloc = b.st[0], nx = b.st[1];
        if (nloc == 0u) { xcd_barrier_complete(bar, b.x, nloc, nx); b.st[0] = nloc; b.st[1] = nx; }
        const unsigned old = xb_add(&bar[XB_XSUB(b.x)], 1u);
        const unsigned gen = old / nloc;
        if (old + 1u == (gen + 1u) * nloc) {
            __builtin_amdgcn_fence(__ATOMIC_RELEASE, "agent");
            asm volatile("s_waitcnt vmcnt(0)" ::: "memory");
            const unsigned og = xb_add(&bar[XB_TOP], 1u);
            const unsigned tg = og / nx;
            if (og + 1u == (tg + 1u) * nx) xb_add(&bar[XB_TOPGEN], 1u);
            else XB_SPIN(xb_ld(&bar[XB_TOPGEN]) == tg, bar);
            __builtin_amdgcn_fence(__ATOMIC_ACQUIRE, "agent");
            xb_add(&bar[XB_XGEN(b.x)], 1u);
            asm volatile("s_waitcnt vmcnt(0)" ::: "memory");
        } else {
            XB_SPIN(xb_ld(&bar[XB_XGEN(b.x)]) == gen, bar);
            __builtin_amdgcn_fence(__ATOMIC_ACQUIRE, "agent");
            asm volatile("s_waitcnt vmcnt(0)" ::: "memory");
        }
    }
    __syncthreads();
}

struct Ctx {
    PRef p; int tid, lane, wave, gw, ngw; LAS unsigned char* lds;
    DI const float* in(int i) const { return p.kp->in[i]; }
    template <class Tp> DI Tp* ws(size_t off) const { return (Tp*)(p.kp->ws + off); }
};

DI int rowmap(int n, int map) { return map == 0 ? n : (32 * (n >> 4) + (n & 15) + (map == 2 ? 16 : 0)); }
DI void transpose_item(const float* W, int K, int N, bf16_t* WT, int map, LAS float* scr, int item, int lane) {
    const int nblk = (N + 31) / 32, kb = item / nblk, nb = item % nblk, k0 = 64 * kb, n0 = 32 * nb;
#pragma unroll 8
    for (int i = 0; i < 32; ++i) { const int kk = 2 * i + (lane >> 5), n = n0 + (lane & 31); scr[kk * 33 + (lane & 31)] = n < N ? W[(size_t)(k0 + kk) * N + n] : 0.f; }
    LDS_WAIT();
    const int c = lane & 7;
#pragma unroll
    for (int j = 0; j < 4; ++j) {
        const int nn = (lane >> 3) + 8 * j, n = n0 + nn; const LAS float* s = scr + (8 * c) * 33 + nn;
        u32x4 o; o.x = pk2(s[0], s[33]); o.y = pk2(s[66], s[99]); o.z = pk2(s[132], s[165]); o.w = pk2(s[198], s[231]);
        if (n < N) *(u32x4*)(WT + (size_t)rowmap(n, map) * K + k0 + 8 * c) = o;
    }
    LDS_WAIT();
}
DI void transpose_mat(const Ctx& c, const float* W, int K, int N, bf16_t* WT, int map) {
    LAS float* scr = (LAS float*)(c.lds + c.wave * 8704);
    const int nit = (K / 64) * ((N + 31) / 32);
    for (int it = c.gw; it < nit; it += c.ngw) transpose_item(W, K, N, WT, map, scr, it, c.lane);
}

DI void rowpass_row(const float* xrow, const float* gorow, const float* gpost, const float* gnext, float* xdst, bf16_t* hrow, float* yout, int lane) {
    f32x4 x[4]; float ss = 0.f;
    if (gorow) {
        f32x4 g[4];
#pragma unroll
        for (int j = 0; j < 4; ++j) { g[j] = *(const f32x4*)(gorow + 4 * lane + 256 * j); ss += g[j].x * g[j].x + g[j].y * g[j].y + g[j].z * g[j].z + g[j].w * g[j].w; }
        const float r = rsqrtf(wave_sum(ss) * (1.f / D) + EPS);
#pragma unroll
        for (int j = 0; j < 4; ++j) { const f32x4 w = *(const f32x4*)(gpost + 4 * lane + 256 * j); x[j] = *(const f32x4*)(xrow + 4 * lane + 256 * j) + g[j] * r * w; }
    } else {
#pragma unroll
        for (int j = 0; j < 4; ++j) x[j] = *(const f32x4*)(xrow + 4 * lane + 256 * j);
    }
    if (xdst) {
#pragma unroll
        for (int j = 0; j < 4; ++j) *(f32x4*)(xdst + 4 * lane + 256 * j) = x[j];
    }
    if (yout) {
#pragma unroll
        for (int j = 0; j < 4; ++j) *(f32x4*)(yout + 4 * lane + 256 * j) = x[j];
    }
    if (hrow) {
        float s2 = 0.f;
#pragma unroll
        for (int j = 0; j < 4; ++j) s2 += x[j].x * x[j].x + x[j].y * x[j].y + x[j].z * x[j].z + x[j].w * x[j].w;
        const float r2 = rsqrtf(wave_sum(s2) * (1.f / D) + EPS);
#pragma unroll
        for (int j = 0; j < 4; ++j) { const f32x4 w = *(const f32x4*)(gnext + 4 * lane + 256 * j); const f32x4 h = x[j] * r2 * w;
            u32x2 o; o.x = pk2(h.x, h.y); o.y = pk2(h.z, h.w); *(u32x2*)(hrow + 4 * lane + 256 * j) = o; }
    }
}
DI void rowpass_phase(const Ctx& c, int mode, const float* gpost, const float* gnext, bool x_from_input) {
    float* X = c.ws<float>(W_X); const float* GO = c.ws<float>(W_GO); bf16_t* H = c.ws<bf16_t>(W_H);
    for (int row = c.gw; row < TT; row += c.ngw) {
        const float* xrow = x_from_input ? (row < T ? c.in(I_XP) + (size_t)row * D : c.in(I_XS) + (size_t)(row - T) * D) : X + (size_t)row * D;
        if (mode == 0) rowpass_row(xrow, nullptr, nullptr, gnext, nullptr, H + (size_t)row * D, nullptr, c.lane);
        else if (mode == 1) rowpass_row(xrow, GO + (size_t)row * D, gpost, gnext, X + (size_t)row * D, H + (size_t)row * D, nullptr, c.lane);
        else rowpass_row(xrow, GO + (size_t)row * D, gpost, nullptr, nullptr, nullptr, c.p.out + (row < T ? O_YP + (size_t)row * D : O_YS + (size_t)(row - T) * D), c.lane);
    }
}

namespace pg8 {
#define PG8_LAS __attribute__((address_space(3)))
typedef unsigned short bf16_t;
typedef short bf16x8 __attribute__((ext_vector_type(8)));
typedef float f32x4 __attribute__((ext_vector_type(4)));
typedef unsigned u32x4 __attribute__((ext_vector_type(4)));
constexpr int BM = 256, BK = 64, HALF = 128, HTB = HALF * BK * 2  , STAGE_BYTES = 8 * HTB, NXCD = 8, WGM = 8;

__host__ __device__ __forceinline__ int lds_byte(int r, int c) { const int st = (r >> 4) * 2 + (c >> 5), rr = r & 15, cc = c & 31, ob = rr * 64 + cc * 2; return st * 1024 + (ob ^ (((ob >> 9) & 1) << 5)); }
__host__ __device__ __forceinline__ void stage_rc(int b, int& R, int& C) { const int st = b / 1024, sb = b % 1024, swz = sb ^ (((sb >> 9) & 1) << 5); R = (st >> 1) * 16 + swz / 64; C = (st & 1) * 32 + (swz % 64) / 2; }
__host__ __device__ __forceinline__ int perm32(int rho) { const int n = rho >> 4, i = rho & 15; return 8 * (i >> 2) + 4 * n + (i & 3); }

struct Unit { int pm, pn; };
struct Gemm { const bf16_t* A; const bf16_t* Bt; int M, N, K; };

struct StaticOrder {
    int nM, nN, nwg, G, c;
    __host__ __device__ void init(int M, int N, int G_, int c_) { nM = M / BM; nN = N / BM; nwg = nM * nN; G = G_; c = c_; }
    __host__ __device__ bool next(int i, Unit& u) const {
        const long L = (long)i * G + c; if (L >= nwg) return false;
        int wgid = (int)L; { const int q = nwg / NXCD, r = nwg % NXCD, xcd = wgid % NXCD, off = wgid / NXCD; wgid = (xcd < r ? xcd * (q + 1) : r * (q + 1) + (xcd - r) * q) + off; }
        const int nig = WGM * nN, gid = wgid / nig, fm = gid * WGM, gsz = (nM - fm) < WGM ? (nM - fm) : WGM;
        u.pm = fm + ((wgid % nig) % gsz); u.pn = (wgid % nig) / gsz; return true;
    }
    __device__ __forceinline__ void a_ready(const Unit&) const {}
    __device__ __forceinline__ void done(const Unit&) const {}
};
__device__ __forceinline__ unsigned cvt_pk_bf16(float lo, float hi) { unsigned r; asm volatile("v_cvt_pk_bf16_f32 %0, %1, %2" : "=v"(r) : "v"(lo), "v"(hi)); return r; }
typedef float f32x2 __attribute__((ext_vector_type(2)));
struct EpiF32 {
    static constexpr bool PERM = false, AFTER_DRAIN = false;
    float* C; int ldc; const float* bias;
    __device__ __forceinline__ void operator()(const f32x4 (&acc)[2][2][4][2], const Unit& u, int wr, int wc, int fr, int fq) const {
        const int row0 = u.pm * BM + wr * 64 + fr, col0 = u.pn * BM + wc * 32 + 4 * fq;
        f32x4 bv[2][2];
#pragma unroll
        for (int bj = 0; bj < 2; ++bj)
#pragma unroll
            for (int n = 0; n < 2; ++n) bv[bj][n] = bias ? *(const f32x4*)(bias + col0 + bj * HALF + n * 16) : (f32x4){0.f, 0.f, 0.f, 0.f};
#pragma unroll
        for (int ai = 0; ai < 2; ++ai)
#pragma unroll
            for (int m = 0; m < 4; ++m) { float* rowp = C + (size_t)(row0 + ai * HALF + m * 16) * ldc + col0;
#pragma unroll
                for (int bj = 0; bj < 2; ++bj)
#pragma unroll
                    for (int n = 0; n < 2; ++n) *(f32x4*)(rowp + bj * HALF + n * 16) = acc[ai][bj][m][n] + bv[bj][n]; }
    }
};
template <class Epi, class Sched, bool STAMP = false>
__device__ __forceinline__ void gemm_phase(PG8_LAS unsigned char* lds, const Gemm g, const Sched& S, const Epi& E, unsigned long long* stamps) {
    int tid_ = threadIdx.x; asm volatile("" : "+v"(tid_));
    const int tid = tid_, wid = __builtin_amdgcn_readfirstlane(tid >> 6), lane = tid & 63, wr = wid >> 2, wc = wid & 3, fr = lane & 15, fq = lane >> 4;
    const int K = g.K, nt = K / BK;
    int ts_lo = 0, ts_hi = 0, nts = 0; const unsigned long long rt_entry = STAMP ? (unsigned long long)wall_clock64() : 0ull;
#define PG8_STAMP() do { if (STAMP && wid == 0 && nts < 64) { const unsigned long long _c = (unsigned long long)clock64(); \
        ts_lo = (lane == nts) ? (int)(unsigned)_c : ts_lo; ts_hi = (lane == nts) ? (int)(unsigned)(_c >> 32) : ts_hi; ++nts; } } while (0)
    PG8_STAMP();
    unsigned voffA[2], voffB[2];
#pragma unroll
    for (int i = 0; i < 2; ++i) { int R, C; stage_rc(tid * 16 + i * 8192, R, C); const int Rb = Epi::PERM ? ((R & ~31) + perm32(R & 31)) : R;
        voffA[i] = (unsigned)(R * K + C) * 2u; voffB[i] = (unsigned)(Rb * K + C) * 2u; }
    const size_t kstep = (size_t)(BK * 2);
    const size_t hstep = (size_t)HALF * K * 2;
    const size_t tstep = 2 * hstep;
    const unsigned ldsw = (unsigned)wid * 1024u;
    const int aoff = lds_byte(wr * 64 + fr, fq * 8), boff = lds_byte(wc * 32 + fr, fq * 8);
#define PG8_SA(b, h) (((b) * 2 + (h)) * HTB)
#define PG8_SB(b, h) ((4 + (b) * 2 + (h)) * HTB)
#define PG8_STAGE(bufoff, gbase, voff) do { _Pragma("unroll") for (int _i = 0; _i < 2; ++_i) \
        __builtin_amdgcn_global_load_lds((const unsigned*)((const char*)(gbase) + (voff)[_i]), (PG8_LAS unsigned*)(lds + (bufoff) + ldsw + _i * 8192), 16, 0, 0); } while (0)
#define PG8_LDA(dst, b, h) do { _Pragma("unroll") for (int m = 0; m < 4; ++m) _Pragma("unroll") for (int k = 0; k < 2; ++k) dst[m][k] = *(const PG8_LAS bf16x8*)(lds + PG8_SA(b, h) + aoff + m * 2048 + k * 1024); } while (0)
#define PG8_LDB(dst, b, h) do { _Pragma("unroll") for (int n = 0; n < 2; ++n) _Pragma("unroll") for (int k = 0; k < 2; ++k) dst[n][k] = *(const PG8_LAS bf16x8*)(lds + PG8_SB(b, h) + boff + n * 2048 + k * 1024); } while (0)
#define PG8_MMA(ai, bj, At, Bt) do { __builtin_amdgcn_s_setprio(1); _Pragma("unroll") for (int m = 0; m < 4; ++m) _Pragma("unroll") for (int n = 0; n < 2; ++n) _Pragma("unroll") for (int k = 0; k < 2; ++k) \
        acc[ai][bj][m][n] = __builtin_amdgcn_mfma_f32_16x16x32_bf16(Bt[n][k], At[m][k], acc[ai][bj][m][n], 0, 0, 0); __builtin_amdgcn_s_setprio(0); } while (0)
#define PG8_WAIT_V(n) asm volatile("s_waitcnt vmcnt(" #n ")" ::: "memory")
#define PG8_WAIT_L(n) asm volatile("s_waitcnt lgkmcnt(" #n ")" ::: "memory")
#define PG8_BAR __builtin_amdgcn_s_barrier()
#define PG8_SCHED __builtin_amdgcn_sched_barrier(0)
    Unit cur, nxt; int ui = 0;
    if (!S.next(0, cur)) return;
    f32x4 acc[2][2][4][2];
#pragma unroll
    for (int a = 0; a < 2; ++a)
#pragma unroll
        for (int b = 0; b < 2; ++b)
#pragma unroll
            for (int m = 0; m < 4; ++m)
#pragma unroll
                for (int n = 0; n < 2; ++n) acc[a][b][m][n] = (f32x4){0.f, 0.f, 0.f, 0.f};
    bf16x8 At[4][2], B0[2][2], B1[2][2];
    const char* cA = (const char*)g.A + (size_t)cur.pm * tstep; const char* cB = (const char*)g.Bt + (size_t)cur.pn * tstep;
    S.a_ready(cur);
    PG8_STAGE(PG8_SB(0, 0), cB, voffB); PG8_STAGE(PG8_SA(0, 0), cA, voffA); PG8_STAGE(PG8_SB(0, 1), cB + hstep, voffB); PG8_STAGE(PG8_SA(0, 1), cA + hstep, voffA);
    if (wr == 1) PG8_BAR;
    PG8_WAIT_V(4); PG8_BAR;
    PG8_STAGE(PG8_SB(1, 0), cB + kstep, voffB); PG8_STAGE(PG8_SA(1, 0), cA + kstep, voffA); PG8_STAGE(PG8_SB(1, 1), cB + hstep + kstep, voffB);
    PG8_WAIT_V(6); PG8_BAR;
    PG8_STAMP();
    for (;;) {
        const bool has_next = S.next(ui + 1, nxt);
        const char* nA = has_next ? (const char*)g.A + (size_t)nxt.pm * tstep : cA; const char* nB = has_next ? (const char*)g.Bt + (size_t)nxt.pn * tstep : cB;
        for (int t = 0; t < nt; t += 2) {
            const bool last = (t == nt - 2);
            const char* a1 = cA + (size_t)(t + 1) * kstep;
            const char* a2 = last ? nA : cA + (size_t)(t + 2) * kstep; const char* b2 = last ? nB : cB + (size_t)(t + 2) * kstep;
            const char* a3 = a2 + kstep; const char* b3 = b2 + kstep;
            if (last && has_next) S.a_ready(nxt);
            PG8_LDB(B0, 0, 0); PG8_SCHED; PG8_LDA(At, 0, 0); PG8_STAGE(PG8_SA(1, 1), a1 + hstep, voffA);
            PG8_WAIT_L(8); PG8_BAR; PG8_WAIT_L(0); PG8_MMA(0, 0, At, B0); PG8_BAR; PG8_SCHED;
            PG8_LDB(B1, 0, 1); PG8_STAGE(PG8_SB(0, 0), b2, voffB);
            PG8_BAR; PG8_WAIT_L(0); PG8_MMA(0, 1, At, B1); PG8_BAR;
            PG8_LDA(At, 0, 1); PG8_STAGE(PG8_SA(0, 0), a2, voffA);
            PG8_BAR; PG8_WAIT_L(0); PG8_MMA(1, 0, At, B0); PG8_BAR; PG8_SCHED;
            PG8_STAGE(PG8_SB(0, 1), b2 + hstep, voffB);
            PG8_WAIT_V(6); PG8_BAR; PG8_MMA(1, 1, At, B1); PG8_BAR;
            PG8_LDB(B0, 1, 0); PG8_SCHED; PG8_LDA(At, 1, 0); PG8_STAGE(PG8_SA(0, 1), a2 + hstep, voffA);
            PG8_WAIT_L(8); PG8_BAR; PG8_WAIT_L(0); PG8_MMA(0, 0, At, B0); PG8_BAR; PG8_SCHED;
            PG8_LDB(B1, 1, 1); PG8_STAGE(PG8_SB(1, 0), b3, voffB);
            PG8_BAR; PG8_WAIT_L(0); PG8_MMA(0, 1, At, B1); PG8_BAR;
            PG8_LDA(At, 1, 1); PG8_STAGE(PG8_SA(1, 0), a3, voffA);
            PG8_BAR; PG8_WAIT_L(0); PG8_MMA(1, 0, At, B0); PG8_BAR; PG8_SCHED;
            PG8_STAGE(PG8_SB(1, 1), b3 + hstep, voffB);
            PG8_WAIT_V(6); PG8_BAR; PG8_MMA(1, 1, At, B1); PG8_BAR;
        }
        PG8_STAMP();
        if constexpr (!Epi::AFTER_DRAIN) { E(acc, cur, wr, wc, fr, fq); S.done(cur); }
        PG8_STAMP();
        if (!has_next) break;
#pragma unroll
        for (int a = 0; a < 2; ++a)
#pragma unroll
            for (int b = 0; b < 2; ++b)
#pragma unroll
                for (int m = 0; m < 4; ++m)
#pragma unroll
                    for (int n = 0; n < 2; ++n) acc[a][b][m][n] = (f32x4){0.f, 0.f, 0.f, 0.f};
        cur = nxt; cA = nA; cB = nB; ++ui;
    }
    PG8_WAIT_V(0);
    if (wr == 0) PG8_BAR;
    PG8_BAR;
    if constexpr (Epi::AFTER_DRAIN) { E.fused(acc, cur, wr, wc, fr, fq, lds, wid, lane); S.done(cur); }
    PG8_STAMP();
    if (STAMP && wid == 0) { stamps[lane] = lane < nts ? (((unsigned long long)(unsigned)ts_hi << 32) | (unsigned)ts_lo) : 0ull;
        if (lane == 62) stamps[62] = rt_entry; if (lane == 63) stamps[63] = (unsigned long long)wall_clock64(); }
#undef PG8_STAMP
#undef PG8_SA
#undef PG8_SB
#undef PG8_STAGE
#undef PG8_LDA
#undef PG8_LDB
#undef PG8_MMA
#undef PG8_WAIT_V
#undef PG8_WAIT_L
#undef PG8_BAR
#undef PG8_SCHED
}
}

namespace pg8 {
struct EpiBf16Plain {
    static constexpr bool PERM = false, AFTER_DRAIN = false;
    bf16_t* O; int ldc;
    __device__ __forceinline__ void operator()(const f32x4 (&acc)[2][2][4][2], const Unit& u, int wr, int wc, int fr, int fq) const {
        const int row0 = u.pm * BM + wr * 64 + fr, col0 = u.pn * BM + wc * 32 + 4 * fq;
#pragma unroll
        for (int ai = 0; ai < 2; ++ai)
#pragma unroll
            for (int m = 0; m < 4; ++m) { bf16_t* rowp = O + (size_t)(row0 + ai * HALF + m * 16) * ldc + col0;
#pragma unroll
                for (int bj = 0; bj < 2; ++bj)
#pragma unroll
                    for (int n = 0; n < 2; ++n) { const f32x4 v = acc[ai][bj][m][n]; unsigned long long w = (unsigned long long)cvt_pk_bf16(v[0], v[1]) | ((unsigned long long)cvt_pk_bf16(v[2], v[3]) << 32);
                        *(unsigned long long*)(rowp + bj * HALF + n * 16) = w; } }
    }
};
struct EpiSwiglu {
    static constexpr bool PERM = false, AFTER_DRAIN = false;
    bf16_t* O; int ldc;
    __device__ __forceinline__ void operator()(const f32x4 (&acc)[2][2][4][2], const Unit& u, int wr, int wc, int fr, int fq) const {
        const int row0 = u.pm * BM + wr * 64 + fr, col0 = u.pn * (BM / 2) + wc * 16 + 4 * fq;
#pragma unroll
        for (int ai = 0; ai < 2; ++ai)
#pragma unroll
            for (int m = 0; m < 4; ++m) { bf16_t* rowp = O + (size_t)(row0 + ai * HALF + m * 16) * ldc + col0;
#pragma unroll
                for (int bj = 0; bj < 2; ++bj) { const f32x4 g = acc[ai][bj][m][0], up = acc[ai][bj][m][1]; float h[4];
#pragma unroll
                    for (int e = 0; e < 4; ++e) h[e] = g[e] / (1.f + __expf(-g[e])) * up[e];
                    unsigned long long w = (unsigned long long)cvt_pk_bf16(h[0], h[1]) | ((unsigned long long)cvt_pk_bf16(h[2], h[3]) << 32);
                    *(unsigned long long*)(rowp + bj * (HALF / 2)) = w; } }
    }
};
}

struct Epi { int mode; bf16_t* ob; float* of; int ldo; int main_cols; };
DI void gemm_simple(const Ctx& c, const bf16_t* A, int lda, int M, const bf16_t* Bt, int ldb, int N, int K, const Epi e) {
    const int mblk = (M + 63) / 64, nblk = (N + 31) / 32, nit = mblk * nblk;
    const int fr = c.lane & 15, fq = c.lane >> 4;
    for (int it = c.gw; it < nit; it += c.ngw) {
        const int mb = it / nblk, nb = it % nblk, m0 = mb * 64, n0 = nb * 32;
        const bf16_t* ap[4]; const bf16_t* bp[2];
#pragma unroll
        for (int m = 0; m < 4; ++m) { int r = m0 + 16 * m + fr; r = r < M ? r : M - 1; ap[m] = A + (size_t)r * lda + 8 * fq; }
#pragma unroll
        for (int n = 0; n < 2; ++n) { int r = n0 + 16 * n + fr; r = r < N ? r : N - 1; bp[n] = Bt + (size_t)r * ldb + 8 * fq; }
        f32x4 acc[4][2];
#pragma unroll
        for (int m = 0; m < 4; ++m)
#pragma unroll
            for (int n = 0; n < 2; ++n) acc[m][n] = (f32x4){0.f, 0.f, 0.f, 0.f};
#pragma unroll 2
        for (int k0 = 0; k0 < K; k0 += 32) {
            bf16x8 a[4], b[2];
#pragma unroll
            for (int m = 0; m < 4; ++m) a[m] = *(const bf16x8*)(ap[m] + k0);
#pragma unroll
            for (int n = 0; n < 2; ++n) b[n] = *(const bf16x8*)(bp[n] + k0);
#pragma unroll
            for (int m = 0; m < 4; ++m)
#pragma unroll
                for (int n = 0; n < 2; ++n) acc[m][n] = __builtin_amdgcn_mfma_f32_16x16x32_bf16(b[n], a[m], acc[m][n], 0, 0, 0);
        }
#pragma unroll
        for (int m = 0; m < 4; ++m) {
            const int row = m0 + 16 * m + fr; if (row >= M) continue;
            if (e.mode == 2) {
                const f32x4 g = acc[m][0], u = acc[m][1]; u32x2 o;
                o.x = pk2(siluf(g.x) * u.x, siluf(g.y) * u.y); o.y = pk2(siluf(g.z) * u.z, siluf(g.w) * u.w);
                *(u32x2*)(e.ob + (size_t)row * e.ldo + 16 * nb + 4 * fq) = o;
            } else {
#pragma unroll
                for (int n = 0; n < 2; ++n) {
                    const int col = n0 + 16 * n + 4 * fq; if (col >= N) continue;
                    const f32x4 v = acc[m][n];
                    if (e.mode == 1) *(f32x4*)(e.of + (size_t)row * e.ldo + col) = v;
                    else if (col < e.main_cols) { u32x2 o; o.x = pk2(v.x, v.y); o.y = pk2(v.z, v.w); *(u32x2*)(e.ob + (size_t)row * e.ldo + col) = o; }
                    else *(f32x4*)(e.of + (size_t)row * 32 + (col - e.main_cols)) = v;
                }
            }
        }
    }
}

DI void attn_wave(const Ctx& c, int li, int tok, int h, LAS float* pl  ) {
    const bf16_t* PROJ = c.ws<bf16_t>(W_PROJ); bf16_t* MIX = c.ws<bf16_t>(W_MIXED);
    const int lane = c.lane; const bool smp = tok >= T;
    const int b = smp ? tok - T : tok / SEQ, s = smp ? WIN : tok % SEQ;
    const float* ck = c.in(I_CK) + ((size_t)(li * NS + b) * WIN) * AW + h * AHD;
    const float* cv = c.in(I_CV) + ((size_t)(li * NS + b) * WIN) * AW + h * AHD;
    const bf16_t* prow0 = smp ? PROJ + (size_t)tok * HYB_MAIN : PROJ + (size_t)(b * SEQ) * HYB_MAIN;
    float q[64];
    { const bf16_t* qp = PROJ + (size_t)tok * HYB_MAIN + h * AHD;
#pragma unroll
      for (int j = 0; j < 8; ++j) { const u32x4 v = *(const u32x4*)(qp + 8 * j);
          q[8*j+0] = bf2f((bf16_t)(v.x & 0xffff)) * 0.125f; q[8*j+1] = bf2f((bf16_t)(v.x >> 16)) * 0.125f; q[8*j+2] = bf2f((bf16_t)(v.y & 0xffff)) * 0.125f; q[8*j+3] = bf2f((bf16_t)(v.y >> 16)) * 0.125f;
          q[8*j+4] = bf2f((bf16_t)(v.z & 0xffff)) * 0.125f; q[8*j+5] = bf2f((bf16_t)(v.z >> 16)) * 0.125f; q[8*j+6] = bf2f((bf16_t)(v.w & 0xffff)) * 0.125f; q[8*j+7] = bf2f((bf16_t)(v.w >> 16)) * 0.125f; } }
    const float* relb = c.in(I_RELB);
    float mx = -1e30f;
#pragma unroll 1
    for (int pat = 0; pat < 3; ++pat) {
        const int d = pat == 0 ? 1 : (pat == 1 ? 4 : 16);
#pragma unroll 1
        for (int rnd = 0; rnd < 3; ++rnd) {
            const int j = rnd * 64 + lane; float lg = -1e30f;
            if (j <= 128) {
                const int R = s - j * d;
                if (R >= 0) {
                    float acc = 0.f;
                    if (smp && R < WIN) { const float* kp = ck + (size_t)R * AW;
#pragma unroll
                        for (int e = 0; e < 16; ++e) { const f32x4 v = *(const f32x4*)(kp + 4 * e); acc += q[4*e] * v.x + q[4*e+1] * v.y + q[4*e+2] * v.z + q[4*e+3] * v.w; }
                    } else { const bf16_t* kp = (smp ? prow0 : prow0 + (size_t)R * HYB_MAIN) + AW + h * AHD;
#pragma unroll
                        for (int e = 0; e < 8; ++e) { const u32x4 v = *(const u32x4*)(kp + 8 * e);
                            acc += q[8*e] * bf2f((bf16_t)(v.x & 0xffff)) + q[8*e+1] * bf2f((bf16_t)(v.x >> 16)) + q[8*e+2] * bf2f((bf16_t)(v.y & 0xffff)) + q[8*e+3] * bf2f((bf16_t)(v.y >> 16))
                                 + q[8*e+4] * bf2f((bf16_t)(v.z & 0xffff)) + q[8*e+5] * bf2f((bf16_t)(v.z >> 16)) + q[8*e+6] * bf2f((bf16_t)(v.w & 0xffff)) + q[8*e+7] * bf2f((bf16_t)(v.w >> 16)); }
                    }
                    lg = acc + relb[c_bucket[pat][j] * AH + h];
                }
                pl[pat * 132 + j] = lg;
            }
            mx = fmaxf(mx, lg);
        }
    }
    mx = wave_max(mx);
    LDS_WAIT();
    float ssum = 0.f;
#pragma unroll 1
    for (int i = lane; i < 396; i += 64) { const int pat = i / 132, j = i % 132; if (j <= 128) { const float lg = pl[i]; const float pv = lg > -1e29f ? __expf(lg - mx) : 0.f; pl[i] = pv; ssum += pv; } }
    ssum = wave_sum(ssum);
    LDS_WAIT();
    float o = 0.f;
#pragma unroll 1
    for (int pat = 0; pat < 3; ++pat) {
        const int d = pat == 0 ? 1 : (pat == 1 ? 4 : 16);
        int jmax = s / d; jmax = jmax > 128 ? 128 : jmax;
#pragma unroll 4
        for (int j = 0; j <= jmax; ++j) {
            const int R = s - j * d; const float pv = pl[pat * 132 + j];
            float vv;
            if (smp && R < WIN) vv = cv[(size_t)R * AW + lane];
            else vv = bf2f((smp ? prow0 : prow0 + (size_t)R * HYB_MAIN)[2 * AW + h * AHD + lane]);
            o += pv * vv;
        }
    }
    MIX[(size_t)tok * HYB_MIX + h * AHD + lane] = f2bf(o / ssum);
    LDS_WAIT();
}


template <int MT>
DI void gemm_ksplit(const Ctx& c, const bf16_t* A, int lda, int M, const bf16_t* Bt, int ldb, int N, int K, const Epi e) {
    const int mblk = (M + 16 * MT - 1) / (16 * MT), nblk = (N + 31) / 32, nit = mblk * nblk;
    const int fr = c.lane & 15, fq = c.lane >> 4, kslice = K / 8, klo = c.wave * kslice;
    LAS float* part = (LAS float*)c.lds;
    for (int it = blockIdx.x; it < nit; it += gridDim.x) {
        const int mb = it / nblk, nb = it % nblk, m0 = mb * 16 * MT, n0 = nb * 32;
        const bf16_t* ap[MT]; const bf16_t* bp[2];
#pragma unroll
        for (int m = 0; m < MT; ++m) { int r = m0 + 16 * m + fr; r = r < M ? r : M - 1; ap[m] = A + (size_t)r * lda + klo + 8 * fq; }
#pragma unroll
        for (int n = 0; n < 2; ++n) { int r = n0 + 16 * n + fr; r = r < N ? r : N - 1; bp[n] = Bt + (size_t)r * ldb + klo + 8 * fq; }
        f32x4 acc[MT][2];
#pragma unroll
        for (int m = 0; m < MT; ++m)
#pragma unroll
            for (int n = 0; n < 2; ++n) acc[m][n] = (f32x4){0.f, 0.f, 0.f, 0.f};
#pragma unroll 2
        for (int k0 = 0; k0 < kslice; k0 += 32) {
            bf16x8 a[MT], b[2];
#pragma unroll
            for (int m = 0; m < MT; ++m) a[m] = *(const bf16x8*)(ap[m] + k0);
#pragma unroll
            for (int n = 0; n < 2; ++n) b[n] = *(const bf16x8*)(bp[n] + k0);
#pragma unroll
            for (int m = 0; m < MT; ++m)
#pragma unroll
                for (int n = 0; n < 2; ++n) acc[m][n] = __builtin_amdgcn_mfma_f32_16x16x32_bf16(b[n], a[m], acc[m][n], 0, 0, 0);
        }
        __syncthreads();
#pragma unroll
        for (int m = 0; m < MT; ++m)
#pragma unroll
            for (int n = 0; n < 2; ++n) *(LAS f32x4*)(part + ((c.wave * (MT * 2) + m * 2 + n) * 64 + c.lane) * 4) = acc[m][n];
        __syncthreads();
        if (c.wave < MT) {
            const int m = c.wave; f32x4 v[2];
#pragma unroll
            for (int n = 0; n < 2; ++n) { v[n] = (f32x4){0.f, 0.f, 0.f, 0.f};
#pragma unroll
                for (int w = 0; w < 8; ++w) v[n] += *(const LAS f32x4*)(part + ((w * (MT * 2) + m * 2 + n) * 64 + c.lane) * 4); }
            const int row = m0 + 16 * m + fr;
            if (row < M) {
                if (e.mode == 2) {
                    const f32x4 g = v[0], u = v[1]; u32x2 o;
                    o.x = pk2(siluf(g.x) * u.x, siluf(g.y) * u.y); o.y = pk2(siluf(g.z) * u.z, siluf(g.w) * u.w);
                    *(u32x2*)(e.ob + (size_t)row * e.ldo + 16 * nb + 4 * fq) = o;
                } else {
#pragma unroll
                    for (int n = 0; n < 2; ++n) {
                        const int col = n0 + 16 * n + 4 * fq; if (col >= N) continue;
                        if (e.mode == 1) *(f32x4*)(e.of + (size_t)row * e.ldo + col) = v[n];
                        else if (col < e.main_cols) { u32x2 o; o.x = pk2(v[n].x, v[n].y); o.y = pk2(v[n].z, v[n].w); *(u32x2*)(e.ob + (size_t)row * e.ldo + col) = o; }
                        else *(f32x4*)(e.of + (size_t)row * 32 + (col - e.main_cols)) = v[n];
                    }
                }
            }
        }
    }
    __syncthreads();
}

constexpr int AT_LDS = 6400;
DI void attn_mfma_item(const Ctx& c, int li, int item) {
    const bf16_t* PROJ = c.ws<bf16_t>(W_PROJ); bf16_t* MIX = c.ws<bf16_t>(W_MIXED);
    int lane_ = c.lane; asm volatile("" : "+v"(lane_));
    const int lane = lane_, fr = lane & 15, fq = lane >> 4;
    const int qb = item & 255, h = (item >> 8) & 7, b = item >> 11, P0 = (qb >> 4) * 256 + (qb & 15);
    LAS unsigned char* wl = c.lds + c.wave * AT_LDS;
    LAS bf16_t* Vt = (LAS bf16_t*)wl; LAS float* tb = (LAS float*)(wl + 4608);
    { const float* relb = c.in(I_RELB);
#pragma unroll 1
      for (int i = lane; i < 396; i += 64) { const int pat = i / 132, j = i % 132; tb[i] = j <= 128 ? relb[c_bucket[pat][j] * AH + h] : 0.f; } }
    const bf16_t* qrow0 = PROJ + (size_t)(b * SEQ) * HYB_MAIN + h * AHD;
    bf16x8 qf[2];
#pragma unroll
    for (int kd = 0; kd < 2; ++kd) qf[kd] = *(const bf16x8*)(qrow0 + (size_t)(P0 + 16 * fr) * HYB_MAIN + 32 * kd + 8 * fq);
    float m = -1e30f, lsum = 0.f;
    f32x4 O[4];
#pragma unroll
    for (int dt = 0; dt < 4; ++dt) O[dt] = (f32x4){0.f, 0.f, 0.f, 0.f};
    LDS_WAIT();
#pragma unroll 1
    for (int pat = 2; pat >= 0; --pat) {
        const int d = pat == 0 ? 1 : (pat == 1 ? 4 : 16), u = 16 / d, nst = pat == 0 ? 12 : (pat == 1 ? 6 : 5), lo = pat == 0 ? -143 : (pat == 1 ? -131 : -144);
        const int qi = u * fr;
        const LAS float* tbp = tb + pat * 132;
        bf16x8 kn[2][2]; u32x4 vn[4];
#pragma unroll
        for (int kt = 0; kt < 2; ++kt) { int pos = P0 + d * (lo + 16 * kt + fr); pos = pos < 0 ? 0 : pos;
#pragma unroll
            for (int kd = 0; kd < 2; ++kd) kn[kt][kd] = *(const bf16x8*)(qrow0 + (size_t)pos * HYB_MAIN + AW + 32 * kd + 8 * fq); }
#pragma unroll
        for (int k4 = 0; k4 < 4; ++k4) { const int q = lane + 64 * k4, row = q >> 3, c8 = q & 7; int pos = P0 + d * (lo + row); pos = pos < 0 ? 0 : pos;
            vn[k4] = *(const u32x4*)(qrow0 + (size_t)pos * HYB_MAIN + 2 * AW + 8 * c8); }
#pragma unroll 1
        for (int st = 0; st < nst; ++st) {
            const int kb = lo + 32 * st;
            bf16x8 kc[2][2]; u32x4 vc[4];
#pragma unroll
            for (int kt = 0; kt < 2; ++kt)
#pragma unroll
                for (int kd = 0; kd < 2; ++kd) kc[kt][kd] = kn[kt][kd];
#pragma unroll
            for (int k4 = 0; k4 < 4; ++k4) vc[k4] = vn[k4];
            if (st + 1 < nst) {
#pragma unroll
                for (int kt = 0; kt < 2; ++kt) { int pos = P0 + d * (kb + 32 + 16 * kt + fr); pos = pos < 0 ? 0 : pos;
#pragma unroll
                    for (int kd = 0; kd < 2; ++kd) kn[kt][kd] = *(const bf16x8*)(qrow0 + (size_t)pos * HYB_MAIN + AW + 32 * kd + 8 * fq); }
#pragma unroll
                for (int k4 = 0; k4 < 4; ++k4) { const int q = lane + 64 * k4, row = q >> 3, c8 = q & 7; int pos = P0 + d * (kb + 32 + row); pos = pos < 0 ? 0 : pos;
                    vn[k4] = *(const u32x4*)(qrow0 + (size_t)pos * HYB_MAIN + 2 * AW + 8 * c8); }
            }
            f32x4 sc[2];
#pragma unroll
            for (int kt = 0; kt < 2; ++kt) { sc[kt] = (f32x4){0.f, 0.f, 0.f, 0.f};
#pragma unroll
                for (int kd = 0; kd < 2; ++kd) sc[kt] = __builtin_amdgcn_mfma_f32_16x16x32_bf16(kc[kt][kd], qf[kd], sc[kt], 0, 0, 0); }
            float tmax = -1e30f; bool ok[2][4];
#pragma unroll
            for (int kt = 0; kt < 2; ++kt)
#pragma unroll
                for (int r = 0; r < 4; ++r) { const int kk = kb + 16 * kt + 4 * fq + r, dist = qi - kk; const bool v = dist >= 0 && dist <= 128 && (P0 + d * kk) >= 0; ok[kt][r] = v;
                    const float lg = v ? sc[kt][r] * 0.125f + tbp[v ? dist : 0] : -1e30f; sc[kt][r] = lg; tmax = fmaxf(tmax, lg); }
            tmax = fmaxf(tmax, __shfl_xor(tmax, 16)); tmax = fmaxf(tmax, __shfl_xor(tmax, 32));
            const float mn = fmaxf(m, tmax), alpha = __expf(m - mn); m = mn;
            float ps = 0.f;
#pragma unroll
            for (int kt = 0; kt < 2; ++kt)
#pragma unroll
                for (int r = 0; r < 4; ++r) { const float pv = ok[kt][r] ? __expf(sc[kt][r] - mn) : 0.f; sc[kt][r] = pv; ps += pv; }
            lsum = lsum * alpha + ps;
            const bf16x8 pfrag = pack8(sc[0], sc[1]);
#pragma unroll
            for (int dt = 0; dt < 4; ++dt) O[dt] *= alpha;
            LDS_WAIT();
#pragma unroll
            for (int k4 = 0; k4 < 4; ++k4) { const int q = lane + 64 * k4, row = q >> 3, c8 = q & 7; const u32x4 v = vc[k4]; LAS bf16_t* vp = Vt + (8 * c8) * 36 + row;
                vp[0] = (bf16_t)(v.x & 0xffff); vp[36] = (bf16_t)(v.x >> 16); vp[72] = (bf16_t)(v.y & 0xffff); vp[108] = (bf16_t)(v.y >> 16);
                vp[144] = (bf16_t)(v.z & 0xffff); vp[180] = (bf16_t)(v.z >> 16); vp[216] = (bf16_t)(v.w & 0xffff); vp[252] = (bf16_t)(v.w >> 16); }
            LDS_WAIT();
#pragma unroll
            for (int dt = 0; dt < 4; ++dt) O[dt] = __builtin_amdgcn_mfma_f32_16x16x32_bf16(lds_frag2(Vt + (16 * dt + fr) * 36 + 4 * fq, Vt + (16 * dt + fr) * 36 + 16 + 4 * fq), pfrag, O[dt], 0, 0, 0);
        }
    }
    lsum += __shfl_xor(lsum, 16); lsum += __shfl_xor(lsum, 32);
    const float inv = 1.f / lsum;
    bf16_t* orow = MIX + (size_t)(b * SEQ + P0 + 16 * fr) * HYB_MIX + h * AHD;
#pragma unroll
    for (int dt = 0; dt < 4; ++dt) { u32x2 o; o.x = pk2(O[dt][0] * inv, O[dt][1] * inv); o.y = pk2(O[dt][2] * inv, O[dt][3] * inv); *(u32x2*)(orow + 16 * dt + 4 * fq) = o; }
    LDS_WAIT();
}

DI void unpack8(const u32x4 v, float* f) {
    f[0] = bf2f((bf16_t)(v.x & 0xffff)); f[1] = bf2f((bf16_t)(v.x >> 16)); f[2] = bf2f((bf16_t)(v.y & 0xffff)); f[3] = bf2f((bf16_t)(v.y >> 16));
    f[4] = bf2f((bf16_t)(v.z & 0xffff)); f[5] = bf2f((bf16_t)(v.z >> 16)); f[6] = bf2f((bf16_t)(v.w & 0xffff)); f[7] = bf2f((bf16_t)(v.w >> 16));
}
DI void load8f(const float* p, float* f) { const f32x4 a = *(const f32x4*)p, b = *(const f32x4*)(p + 4); f[0] = a.x; f[1] = a.y; f[2] = a.z; f[3] = a.w; f[4] = b.x; f[5] = b.y; f[6] = b.z; f[7] = b.w; }
DI void store8f(float* p, const float* f) { *(f32x4*)p = (f32x4){f[0], f[1], f[2], f[3]}; *(f32x4*)(p + 4) = (f32x4){f[4], f[5], f[6], f[7]}; }
DI void conv8(const bf16_t* prow, int ld, const float* st, int nch, const float* cw, int ch0, bool smp, int s, float* x1, float* x2, float* x3, float* y) {
    float x0[8], w[8];
    unpack8(*(const u32x4*)(prow + ch0), x3);
    if (smp) { load8f(st + ch0, x0); load8f(st + nch + ch0, x1); load8f(st + 2 * nch + ch0, x2); }
    else {
        const u32x4 z = (u32x4){0u, 0u, 0u, 0u};
        unpack8(s >= 1 ? *(const u32x4*)(prow + ch0 - ld) : z, x2); unpack8(s >= 2 ? *(const u32x4*)(prow + ch0 - 2 * ld) : z, x1); unpack8(s >= 3 ? *(const u32x4*)(prow + ch0 - 3 * ld) : z, x0);
    }
    load8f(cw + ch0, w);
#pragma unroll
    for (int e = 0; e < 8; ++e) y[e] = x0[e] * w[e];
    load8f(cw + nch + ch0, w);
#pragma unroll
    for (int e = 0; e < 8; ++e) y[e] += x1[e] * w[e];
    load8f(cw + 2 * nch + ch0, w);
#pragma unroll
    for (int e = 0; e < 8; ++e) y[e] += x2[e] * w[e];
    load8f(cw + 3 * nch + ch0, w);
#pragma unroll
    for (int e = 0; e < 8; ++e) y[e] += x3[e] * w[e];
}
DI void hyb_pre_token(const Ctx& c, int li, int tok) {
    const bf16_t* PROJ = c.ws<bf16_t>(W_PROJ); float* ACT = c.ws<float>(W_ACT); float* AUX = c.ws<float>(W_AUX); const float* EX = c.ws<float>(W_EXTRA);
    const int lane = c.lane; const bool smp = tok >= T; const int b = smp ? tok - T : tok / SEQ, s = smp ? 0 : tok % SEQ;
    const float* cw = c.in(I_SCW) + (size_t)li * 4 * SXBC; const float* cb = c.in(I_SCB) + (size_t)li * SXBC;
    const float* st = c.in(I_SCONV) + (size_t)(li * NS + b) * 3 * SXBC;
    const bf16_t* prow = PROJ + (size_t)tok * HYB_MAIN + 2560;
#pragma unroll 1
    for (int it = 0; it < 3; ++it) {
        const int ch0 = 512 * it + 8 * lane; float x1[8], x2[8], x3[8], y[8], bb[8];
        conv8(prow, HYB_MAIN, st, SXBC, cw, ch0, smp, s, x1, x2, x3, y);
        load8f(cb + ch0, bb);
#pragma unroll
        for (int e = 0; e < 8; ++e) y[e] = siluf(y[e] + bb[e]);
        store8f(ACT + (size_t)tok * 4096 + ch0, y);
        if (smp) { float* o = c.p.out + O_SSC + (size_t)(li * NS + b) * 3 * SXBC + ch0; store8f(o, x1); store8f(o + SXBC, x2); store8f(o + 2 * SXBC, x3); }
        else if (s >= SEQ - 3) store8f(c.p.out + O_PSC + ((size_t)(li * NB + b) * 3 + (s - (SEQ - 3))) * SXBC + ch0, x3);
    }
    if (lane < SH) AUX[(size_t)tok * 32 + lane] = softplusf_(EX[(size_t)tok * 32 + lane] + c.in(I_SDTB)[li * SH + lane]);
    if (smp || s >= SEQ - WIN) {
        float* ok = smp ? c.p.out + O_SK + ((size_t)(li * NS + b) * WIN + (WIN - 1)) * AW : c.p.out + O_PK + ((size_t)(li * NB + b) * WIN + (s - (SEQ - WIN))) * AW;
        float* ov = smp ? c.p.out + O_SV + ((size_t)(li * NS + b) * WIN + (WIN - 1)) * AW : c.p.out + O_PV + ((size_t)(li * NB + b) * WIN + (s - (SEQ - WIN))) * AW;
        const bf16_t* kr = PROJ + (size_t)tok * HYB_MAIN + AW;
        float f[8];
        unpack8(*(const u32x4*)(kr + 8 * lane), f); store8f(ok + 8 * lane, f);
        unpack8(*(const u32x4*)(kr + AW + 8 * lane), f); store8f(ov + 8 * lane, f);
    }
}

DI void ssd_wave(const Ctx& c, int li, int item) {
    const float* ACT = c.ws<float>(W_ACT); const float* AUX = c.ws<float>(W_AUX); float* Y = c.ws<float>(W_Y);
    const int lane = c.lane;
    const bool smp = item >= NB * SH * SP; const int it = smp ? item - NB * SH * SP : item;
    const int seq = it / (SH * SP), h = (it / SP) % SH, p = it % SP, g = h / (SH / SG);
    const int L = smp ? 1 : SEQ; const int tok0 = smp ? T + seq : seq * SEQ;
    const float Ah = -__expf(c.in(I_SALOG)[li * SH + h]), Dh = c.in(I_SD)[li * SH + h];
    float h0 = 0.f, h1 = 0.f;
    if (smp) { const float* s0 = c.in(I_SSM) + (((size_t)(li * NS + seq) * SH + h) * SP + p) * SN; h0 = s0[2 * lane]; h1 = s0[2 * lane + 1]; }
#pragma unroll 2
    for (int t = 0; t < L; ++t) {
        const float* a = ACT + (size_t)(tok0 + t) * 4096;
        const float dt = AUX[(size_t)(tok0 + t) * 32 + h], xv = a[h * SP + p];
        const float2 Bv = *(const float2*)(a + SDI + g * SN + 2 * lane), Cv = *(const float2*)(a + SDI + SG * SN + g * SN + 2 * lane);
        const float dec = __expf(dt * Ah), dx = dt * xv;
        h0 = h0 * dec + dx * Bv.x; h1 = h1 * dec + dx * Bv.y;
        const float y = wave_sum(h0 * Cv.x + h1 * Cv.y);
        if (lane == 0) Y[(size_t)(tok0 + t) * 2048 + h * SP + p] = y + Dh * xv;
    }
    float* so = smp ? c.p.out + O_SSS + (((size_t)(li * NS + seq) * SH + h) * SP + p) * SN : c.p.out + O_PSS + (((size_t)(li * NB + seq) * SH + h) * SP + p) * SN;
    *(float2*)(so + 2 * lane) = make_float2(h0, h1);
}
DI void hyb_post_token(const Ctx& c, int li, int tok) {
    const bf16_t* PROJ = c.ws<bf16_t>(W_PROJ); const float* Y = c.ws<float>(W_Y); bf16_t* MIX = c.ws<bf16_t>(W_MIXED);
    const float* nw = c.in(I_SNW) + (size_t)li * SDI; const int lane = c.lane;
    float v[16]; float ss0 = 0.f, ss1 = 0.f;
#pragma unroll
    for (int j = 0; j < 16; ++j) { const int ch = lane + 64 * j; const float z = bf2f(PROJ[(size_t)tok * HYB_MAIN + 1536 + ch]); v[j] = Y[(size_t)tok * 2048 + ch] * siluf(z); if (j < 8) ss0 += v[j] * v[j]; else ss1 += v[j] * v[j]; }
    const float r0 = rsqrtf(wave_sum(ss0) * (1.f / 512.f) + EPS), r1 = rsqrtf(wave_sum(ss1) * (1.f / 512.f) + EPS);
#pragma unroll
    for (int j = 0; j < 16; ++j) { const int ch = lane + 64 * j; MIX[(size_t)tok * HYB_MIX + AW + ch] = f2bf(v[j] * (j < 8 ? r0 : r1) * nw[ch]); }
}


constexpr int SLD = 136;
constexpr int L_C = 0, L_B = 34816, L_XT = 69632, L_HS = 87040, L_CS = 104448, L_DT = 108544;
constexpr size_t W_ST = W_HID;
constexpr size_t W_DEC = W_HID + (size_t)NB * 32 * SH * SP * SN * 4;
constexpr int NCH = SEQ / 128;

DI void ssd_chunk_scalars(const Ctx& c, int li, int tok0, int g) {
    const float* AUX = c.ws<float>(W_AUX); LAS float* csS = (LAS float*)(c.lds + L_CS); LAS float* dtS = (LAS float*)(c.lds + L_DT);
    const int hh = c.wave, lane = c.lane, h = 8 * g + hh;
    const float Ah = -__expf(c.in(I_SALOG)[li * SH + h]);
    const float d0 = AUX[(size_t)(tok0 + lane) * 32 + h], d1 = AUX[(size_t)(tok0 + 64 + lane) * 32 + h];
    float s0 = d0 * Ah, s1 = d1 * Ah;
#pragma unroll
    for (int o = 1; o < 64; o <<= 1) { const float t0 = __shfl_up(s0, o), t1 = __shfl_up(s1, o); if (lane >= o) { s0 += t0; s1 += t1; } }
    s1 += __shfl(s0, 63);
    csS[lane * 8 + hh] = s0; csS[(64 + lane) * 8 + hh] = s1; dtS[lane * 8 + hh] = d0; dtS[(64 + lane) * 8 + hh] = d1;
}
DI void ssd_a_item(const Ctx& c, int li, int item) {
    const float* ACT = c.ws<float>(W_ACT); float* ST = c.ws<float>(W_ST); float* DEC = c.ws<float>(W_DEC);
    const int g = item & 1, ch = (item >> 1) % NCH, b = item / (2 * NCH), tok0 = b * SEQ + ch * 128;
    LAS bf16_t* BT = (LAS bf16_t*)(c.lds + L_B); LAS bf16_t* XT = (LAS bf16_t*)(c.lds + L_XT);
    const LAS float* csS = (const LAS float*)(c.lds + L_CS); const LAS float* dtS = (const LAS float*)(c.lds + L_DT);
    const int fr = c.lane & 15, fq = c.lane >> 4, w = c.wave;
    __syncthreads();
    ssd_chunk_scalars(c, li, tok0, g);
#pragma unroll 4
    for (int it = 0; it < 32; ++it) { const int idx = it * NTHR + c.tid, j = idx >> 7, n = idx & 127; BT[n * SLD + j] = f2bf(ACT[(size_t)(tok0 + j) * 4096 + SDI + g * SN + n]); }
    __syncthreads();
    if (c.tid < 8) DEC[(size_t)(b * NCH + ch) * SH + 8 * g + c.tid] = __expf(csS[127 * 8 + c.tid]);
    const int pt = w & 3, nt0 = (w >> 2) * 4;
#pragma unroll 1
    for (int hh = 0; hh < 8; ++hh) {
        const int h = 8 * g + hh; const float csl = csS[127 * 8 + hh];
#pragma unroll 4
        for (int it = 0; it < 16; ++it) { const int idx = it * NTHR + c.tid, j = idx >> 6, p = idx & 63;
            XT[p * SLD + j] = f2bf(ACT[(size_t)(tok0 + j) * 4096 + h * SP + p] * __expf(csl - csS[j * 8 + hh]) * dtS[j * 8 + hh]); }
        __syncthreads();
        f32x4 acc[4];
#pragma unroll
        for (int n = 0; n < 4; ++n) acc[n] = (f32x4){0.f, 0.f, 0.f, 0.f};
#pragma unroll
        for (int ks = 0; ks < 4; ++ks) {
            const bf16x8 a = lds_frag(XT + (16 * pt + fr) * SLD + 32 * ks + 8 * fq);
#pragma unroll
            for (int n = 0; n < 4; ++n) { const bf16x8 bb = lds_frag(BT + (16 * (nt0 + n) + fr) * SLD + 32 * ks + 8 * fq); acc[n] = __builtin_amdgcn_mfma_f32_16x16x32_bf16(bb, a, acc[n], 0, 0, 0); }
        }
        float* so = ST + ((((size_t)(b * NCH + ch) * SH + h) * SP + 16 * pt + fr) * SN);
#pragma unroll
        for (int n = 0; n < 4; ++n) *(f32x4*)(so + 16 * (nt0 + n) + 4 * fq) = acc[n];
        __syncthreads();
    }
}
DI void ssd_scan_phase(const Ctx& c, int li) {
    float* ST = c.ws<float>(W_ST); const float* DEC = c.ws<float>(W_DEC);
    for (int idx = blockIdx.x * NTHR + c.tid; idx < NB * SH * SP * SN / 4; idx += gridDim.x * NTHR) {
        const int n4 = idx & 31, p = (idx >> 5) & 63, h = (idx >> 11) & 15, b = idx >> 15;
        f32x4 hcur = (f32x4){0.f, 0.f, 0.f, 0.f};
#pragma unroll 8
        for (int ch = 0; ch < NCH; ++ch) {
            f32x4* a = (f32x4*)(ST + ((((size_t)(b * NCH + ch) * SH + h) * SP + p) * SN)) + n4;
            const f32x4 s = *a; const float d = DEC[(size_t)(b * NCH + ch) * SH + h];
            *a = hcur; hcur = hcur * d + s;
        }
        *((f32x4*)(c.p.out + O_PSS + ((((size_t)(li * NB + b) * SH + h) * SP + p) * SN)) + n4) = hcur;
    }
}
DI void ssd_b_item(const Ctx& c, int li, int item) {
    const float* ACT = c.ws<float>(W_ACT); const float* ST = c.ws<float>(W_ST); const bf16_t* PROJ = c.ws<bf16_t>(W_PROJ); bf16_t* MIX = c.ws<bf16_t>(W_MIXED);
    const int g = item & 1, ch = (item >> 1) % NCH, b = item / (2 * NCH), tok0 = b * SEQ + ch * 128;
    LAS bf16_t* CS_ = (LAS bf16_t*)(c.lds + L_C); LAS bf16_t* BS = (LAS bf16_t*)(c.lds + L_B); LAS bf16_t* XT = (LAS bf16_t*)(c.lds + L_XT); LAS bf16_t* HS = (LAS bf16_t*)(c.lds + L_HS);
    const LAS float* csS = (const LAS float*)(c.lds + L_CS); const LAS float* dtS = (const LAS float*)(c.lds + L_DT);
    const int fr = c.lane & 15, fq = c.lane >> 4, w = c.wave, irow = 16 * w + fr;
    __syncthreads();
    ssd_chunk_scalars(c, li, tok0, g);
#pragma unroll 4
    for (int it = 0; it < 8; ++it) { const int idx = it * NTHR + c.tid, i = idx >> 5, n4 = idx & 31;
        const f32x4 bv = *(const f32x4*)(ACT + (size_t)(tok0 + i) * 4096 + SDI + g * SN + 4 * n4), cv = *(const f32x4*)(ACT + (size_t)(tok0 + i) * 4096 + SDI + SG * SN + g * SN + 4 * n4);
        u32x2 o; o.x = pk2(bv.x, bv.y); o.y = pk2(bv.z, bv.w); *(LAS u32x2*)(BS + i * SLD + 4 * n4) = o;
        o.x = pk2(cv.x, cv.y); o.y = pk2(cv.z, cv.w); *(LAS u32x2*)(CS_ + i * SLD + 4 * n4) = o; }
    __syncthreads();
    f32x4 cb[8];
#pragma unroll
    for (int jt = 0; jt < 8; ++jt) cb[jt] = (f32x4){0.f, 0.f, 0.f, 0.f};
    bf16x8 cfrag[4];
#pragma unroll
    for (int ks = 0; ks < 4; ++ks) cfrag[ks] = lds_frag(CS_ + irow * SLD + 32 * ks + 8 * fq);
#pragma unroll
    for (int jt = 0; jt < 8; ++jt) if (jt <= w) {
#pragma unroll
        for (int ks = 0; ks < 4; ++ks) cb[jt] = __builtin_amdgcn_mfma_f32_16x16x32_bf16(lds_frag(BS + (16 * jt + fr) * SLD + 32 * ks + 8 * fq), cfrag[ks], cb[jt], 0, 0, 0);
    }
    float rowsq = 0.f;
#pragma unroll 1
    for (int hh = 0; hh < 8; ++hh) {
        const int h = 8 * g + hh; const float Dh = c.in(I_SD)[li * SH + h];
#pragma unroll 4
        for (int it = 0; it < 16; ++it) { const int idx = it * NTHR + c.tid, j = idx >> 6, p = idx & 63; XT[p * SLD + j] = f2bf(ACT[(size_t)(tok0 + j) * 4096 + h * SP + p]); }
#pragma unroll
        for (int it = 0; it < 4; ++it) { const int idx = it * NTHR + c.tid, p = idx >> 5, n4 = idx & 31;
            const f32x4 v = *((const f32x4*)(ST + ((((size_t)(b * NCH + ch) * SH + h) * SP + p) * SN)) + n4);
            u32x2 o; o.x = pk2(v.x, v.y); o.y = pk2(v.z, v.w); *(LAS u32x2*)(HS + p * SLD + 4 * n4) = o; }
        __syncthreads();
        const float csi = csS[irow * 8 + hh];
        f32x4 ay[4], ah[4];
#pragma unroll
        for (int pt = 0; pt < 4; ++pt) { ay[pt] = (f32x4){0.f, 0.f, 0.f, 0.f}; ah[pt] = (f32x4){0.f, 0.f, 0.f, 0.f}; }
#pragma unroll
        for (int ks = 0; ks < 4; ++ks) {
#pragma unroll
            for (int pt = 0; pt < 4; ++pt) ah[pt] = __builtin_amdgcn_mfma_f32_16x16x32_bf16(lds_frag(HS + (16 * pt + fr) * SLD + 32 * ks + 8 * fq), cfrag[ks], ah[pt], 0, 0, 0);
            if (2 * ks <= w) {
                float mv[8];
#pragma unroll
                for (int e = 0; e < 8; ++e) {
                    const int j = 32 * ks + (e < 4 ? 4 * fq + e : 16 + 4 * fq + (e - 4));
                    const float cbv = e < 4 ? cb[2 * ks][e] : cb[2 * ks + 1][e - 4];
                    mv[e] = j <= irow ? cbv * __expf(csi - csS[j * 8 + hh]) * dtS[j * 8 + hh] : 0.f;
                }
                u32x4 mp; mp.x = pk2(mv[0], mv[1]); mp.y = pk2(mv[2], mv[3]); mp.z = pk2(mv[4], mv[5]); mp.w = pk2(mv[6], mv[7]);
                const bf16x8 mfrag = __builtin_bit_cast(bf16x8, mp);
#pragma unroll
                for (int pt = 0; pt < 4; ++pt) ay[pt] = __builtin_amdgcn_mfma_f32_16x16x32_bf16(lds_frag2(XT + (16 * pt + fr) * SLD + 32 * ks + 4 * fq, XT + (16 * pt + fr) * SLD + 32 * ks + 16 + 4 * fq), mfrag, ay[pt], 0, 0, 0);
            }
        }
        const float ei = __expf(csi);
#pragma unroll
        for (int pt = 0; pt < 4; ++pt) {
            const int col = h * SP + 16 * pt + 4 * fq;
            const f32x4 xv = *(const f32x4*)(ACT + (size_t)(tok0 + irow) * 4096 + col);
            const u32x2 zz = *(const u32x2*)(PROJ + (size_t)(tok0 + irow) * HYB_MAIN + 1536 + col);
            const float z0 = bf2f((bf16_t)(zz.x & 0xffff)), z1 = bf2f((bf16_t)(zz.x >> 16)), z2 = bf2f((bf16_t)(zz.y & 0xffff)), z3 = bf2f((bf16_t)(zz.y >> 16));
            const float y0 = (ay[pt][0] + ei * ah[pt][0] + Dh * xv.x) * siluf(z0), y1 = (ay[pt][1] + ei * ah[pt][1] + Dh * xv.y) * siluf(z1);
            const float y2 = (ay[pt][2] + ei * ah[pt][2] + Dh * xv.z) * siluf(z2), y3 = (ay[pt][3] + ei * ah[pt][3] + Dh * xv.w) * siluf(z3);
            rowsq += y0 * y0 + y1 * y1 + y2 * y2 + y3 * y3;
            u32x2 o; o.x = pk2(y0, y1); o.y = pk2(y2, y3); *(u32x2*)(MIX + (size_t)(tok0 + irow) * HYB_MIX + AW + col) = o;
        }
        __syncthreads();
    }
    rowsq += __shfl_xor(rowsq, 16); rowsq += __shfl_xor(rowsq, 32);
    const float rn = rsqrtf(rowsq * (1.f / 512.f) + EPS);
    const float* nw = c.in(I_SNW) + (size_t)li * SDI + g * 512;
    asm volatile("s_waitcnt vmcnt(0)" ::: "memory");
    bf16_t* mrow = MIX + (size_t)(tok0 + irow) * HYB_MIX + AW + g * 512 + fq * 128;
#pragma unroll 4
    for (int cc = 0; cc < 16; ++cc) {
        const u32x4 v = *(const u32x4*)(mrow + 8 * cc); const float* wv = nw + fq * 128 + 8 * cc; u32x4 o;
        o.x = pk2(bf2f((bf16_t)(v.x & 0xffff)) * rn * wv[0], bf2f((bf16_t)(v.x >> 16)) * rn * wv[1]); o.y = pk2(bf2f((bf16_t)(v.y & 0xffff)) * rn * wv[2], bf2f((bf16_t)(v.y >> 16)) * rn * wv[3]);
        o.z = pk2(bf2f((bf16_t)(v.z & 0xffff)) * rn * wv[4], bf2f((bf16_t)(v.z >> 16)) * rn * wv[5]); o.w = pk2(bf2f((bf16_t)(v.w & 0xffff)) * rn * wv[6], bf2f((bf16_t)(v.w >> 16)) * rn * wv[7]);
        *(u32x4*)(mrow + 8 * cc) = o;
    }
}

DI void gdn_pre_token(const Ctx& c, int li, int tok) {
    const bf16_t* PROJ = c.ws<bf16_t>(W_PROJ); float* ACT = c.ws<float>(W_ACT); float* AUX = c.ws<float>(W_AUX); const float* EX = c.ws<float>(W_EXTRA);
    const int lane = c.lane; const bool smp = tok >= T; const int b = smp ? tok - T : tok / SEQ, s = smp ? 0 : tok % SEQ;
    const float* cw = c.in(I_GCW) + (size_t)li * 4 * GQKV;
    const float* st = c.in(I_GCONV) + (size_t)(li * NS + b) * 3 * GQKV;
    const bf16_t* prow = PROJ + (size_t)tok * GDN_MAIN;
#pragma unroll 1
    for (int it = 0; it < 8; ++it) {
        const int ch0 = 512 * it + 8 * lane; float x1[8], x2[8], x3[8], y[8];
        conv8(prow, GDN_MAIN, st, GQKV, cw, ch0, smp, s, x1, x2, x3, y);
        float ss = 0.f;
#pragma unroll
        for (int e = 0; e < 8; ++e) { y[e] = siluf(y[e]); ss += y[e] * y[e]; }
        if (it < 4) {
            ss += __shfl_xor(ss, 1); ss += __shfl_xor(ss, 2); ss += __shfl_xor(ss, 4); ss += __shfl_xor(ss, 8);
            const float r = rsqrtf(ss + EPS) * (it < 2 ? 0.08838834764831845f : 1.f);
#pragma unroll
            for (int e = 0; e < 8; ++e) y[e] *= r;
        }
        store8f(ACT + (size_t)tok * 4096 + ch0, y);
        if (smp) { float* o = c.p.out + O_SGC + (size_t)(li * NS + b) * 3 * GQKV + ch0; store8f(o, x1); store8f(o + GQKV, x2); store8f(o + 2 * GQKV, x3); }
        else if (s >= SEQ - 3) store8f(c.p.out + O_PGC + ((size_t)(li * NB + b) * 3 + (s - (SEQ - 3))) * GQKV + ch0, x3);
    }
    if (lane < GH) {
        AUX[(size_t)tok * 32 + lane] = sigmoidf_(EX[(size_t)tok * 32 + lane]);
        AUX[(size_t)tok * 32 + 16 + lane] = -__expf(c.in(I_GALOG)[li * GH + lane]) * softplusf_(EX[(size_t)tok * 32 + 16 + lane] + c.in(I_GDTB)[li * GH + lane]);
    }
}
DI void gdn_seq_phase(const Ctx& c, int li, int first_item) {
    const float* ACT = c.ws<float>(W_ACT); const float* AUX = c.ws<float>(W_AUX); float* Y = c.ws<float>(W_Y);
    const int slot = c.tid >> 8, t8 = c.tid & 255, col = t8 >> 1, half = t8 & 1;
    LAS float* kq = (LAS float*)c.lds + slot * 512;
    const int nslot = gridDim.x * 2;
    for (int base = first_item; base < NB * GH + NS * GH; base += nslot) {
        const int item = base + blockIdx.x * 2 + slot;
        const bool wg_prompt = (base + blockIdx.x * 2) < NB * GH;
        const int L = wg_prompt ? SEQ : 1;
        const bool valid = item < NB * GH + NS * GH;
        const bool smp = item >= NB * GH; const int it = smp ? item - NB * GH : item;
        const int seq = valid ? it / GH : 0, vh = valid ? it % GH : 0, hq = vh >> 1;
        const int tok0 = smp ? T + seq : seq * SEQ;
        float S[64];
        if (valid && smp) { const float* s0 = c.in(I_GST) + ((size_t)(li * NS + seq) * GH + vh) * GDK * GDV + (size_t)(64 * half) * GDV + col;
#pragma unroll
            for (int k = 0; k < 64; ++k) S[k] = s0[(size_t)k * GDV]; }
        else {
#pragma unroll
            for (int k = 0; k < 64; ++k) S[k] = 0.f; }
        __syncthreads();
        for (int t = 0; t < L; ++t) {
            LAS float* cur = kq + (t & 1) * 256;
            const float* a = ACT + (size_t)(tok0 + t) * 4096;
            cur[t8] = a[(t8 < 128 ? 1024 : -128) + hq * 128 + t8];
            const float vv = a[2048 + vh * 128 + col], beta = AUX[(size_t)(tok0 + t) * 32 + vh], eg = __expf(AUX[(size_t)(tok0 + t) * 32 + 16 + vh]);
            __syncthreads();
            const LAS float* kk = cur + 64 * half; const LAS float* qq = cur + 128 + 64 * half;
            float ks = 0.f;
#pragma unroll
            for (int k = 0; k < 64; k += 4) { const f32x4 kv = *(const LAS f32x4*)(kk + k); ks += kv.x * S[k] + kv.y * S[k + 1] + kv.z * S[k + 2] + kv.w * S[k + 3]; }
            ks += __shfl_xor(ks, 1);
            const float u = beta * (vv - eg * ks);
            asm volatile("" ::: "memory");
            float o = 0.f;
#pragma unroll
            for (int k = 0; k < 64; k += 4) { const f32x4 kv = *(const LAS f32x4*)(kk + k); const f32x4 qv = *(const LAS f32x4*)(qq + k);
                S[k] = eg * S[k] + kv.x * u; S[k + 1] = eg * S[k + 1] + kv.y * u; S[k + 2] = eg * S[k + 2] + kv.z * u; S[k + 3] = eg * S[k + 3] + kv.w * u;
                o += qv.x * S[k] + qv.y * S[k + 1] + qv.z * S[k + 2] + qv.w * S[k + 3]; }
            o += __shfl_xor(o, 1);
            if (valid && half == 0) Y[(size_t)(tok0 + t) * 2048 + vh * 128 + col] = o;
        }
        if (valid) { float* so = (smp ? c.p.out + O_SGS + ((size_t)(li * NS + seq) * GH + vh) * GDK * GDV : c.p.out + O_PGS + ((size_t)(li * NB + seq) * GH + vh) * GDK * GDV) + (size_t)(64 * half) * GDV + col;
#pragma unroll
            for (int k = 0; k < 64; ++k) so[(size_t)k * GDV] = S[k]; }
        __syncthreads();
    }
}

constexpr size_t W_KCD = W_GO;
constexpr size_t W_U0 = W_HID;
constexpr size_t W_GC = W_HID + (size_t)67108864;
constexpr size_t W_QB = W_H;
constexpr size_t W_ATTG = W_MIXED;
constexpr size_t W_KT = W_MIXED + (size_t)33554432;
constexpr int GA_LDS = 20000;
constexpr int GCH = SEQ / 64;

DI bf16x8 gfrag_f32(const float* p) { return pack8(*(const f32x4*)p, *(const f32x4*)(p + 4)); }

DI void gdn_a_item(const Ctx& c, int li, int item) {
    const float* ACT = c.ws<float>(W_ACT); const float* AUX = c.ws<float>(W_AUX);
    const int ch = item & (GCH - 1), vh = (item >> 6) & 15, b = item >> 10, hq = vh >> 1, tok0 = b * SEQ + ch * 64;
    int lane_ = c.lane; asm volatile("" : "+v"(lane_));
    const int lane = lane_, fr = lane & 15, fq = lane >> 4;
    LAS unsigned char* wl = c.lds + c.wave * GA_LDS;
    LAS float* As = (LAS float*)wl; LAS bf16_t* Ts = (LAS bf16_t*)wl; LAS bf16_t* KsT = (LAS bf16_t*)wl;
    LAS float* gcS = (LAS float*)(wl + 17408); LAS float* btS = gcS + 64; LAS float* beS = gcS + 128;
    bf16_t* KCDg = c.ws<bf16_t>(W_KCD) + (size_t)item * 8192; bf16_t* ATTg = c.ws<bf16_t>(W_ATTG) + (size_t)item * 4096; bf16_t* U0g = c.ws<bf16_t>(W_U0) + (size_t)item * 8192;
    const int qitem = (b * GQH + hq) * GCH + ch;
    { const float gi = AUX[(size_t)(tok0 + lane) * 32 + 16 + vh], bi = AUX[(size_t)(tok0 + lane) * 32 + vh];
      float gc = gi;
#pragma unroll
      for (int o = 1; o < 64; o <<= 1) { const float t = __shfl_up(gc, o); if (lane >= o) gc += t; }
      gcS[lane] = gc; btS[lane] = bi; beS[lane] = bi * __expf(gc); c.ws<float>(W_GC)[(size_t)(tok0 + lane) * 16 + vh] = gc; }
    LDS_WAIT();
    {
        bf16x8 kf[4][4];
#pragma unroll
        for (int t = 0; t < 4; ++t) {
#pragma unroll
            for (int ks = 0; ks < 4; ++ks) kf[t][ks] = gfrag_f32(ACT + (size_t)(tok0 + 16 * t + fr) * 4096 + 1024 + hq * 128 + 32 * ks + 8 * fq);
            asm volatile("" ::: "memory");
        }
#pragma unroll
        for (int it = 0; it < 4; ++it) {
            bf16x8 qf[4];
#pragma unroll
            for (int ks = 0; ks < 4; ++ks) qf[ks] = gfrag_f32(ACT + (size_t)(tok0 + 16 * it + fr) * 4096 + hq * 128 + 32 * ks + 8 * fq);
            const int i = 16 * it + fr; const float gci = gcS[i], bti = btS[i];
#pragma unroll
            for (int jt = 0; jt < 4; ++jt) {
                bf16_t* ap = ATTg + (unsigned)(i * 64 + 16 * jt + 4 * fq);
                if (jt > it) { *(unsigned long long*)ap = 0ull; continue; }
                f32x4 kk = (f32x4){0.f, 0.f, 0.f, 0.f}, qk = (f32x4){0.f, 0.f, 0.f, 0.f};
#pragma unroll
                for (int ks = 0; ks < 4; ++ks) { kk = __builtin_amdgcn_mfma_f32_16x16x32_bf16(kf[jt][ks], kf[it][ks], kk, 0, 0, 0); qk = __builtin_amdgcn_mfma_f32_16x16x32_bf16(kf[jt][ks], qf[ks], qk, 0, 0, 0); }
                f32x4 av, tv;
#pragma unroll
                for (int r = 0; r < 4; ++r) { const int j = 16 * jt + 4 * fq + r; const float dec = __expf(gci - gcS[j]); av[r] = j < i ? bti * kk[r] * dec : 0.f; tv[r] = j <= i ? qk[r] * dec : 0.f; }
                *(LAS f32x4*)(As + i * 64 + 16 * jt + 4 * fq) = av;
                *(unsigned long long*)ap = (unsigned long long)pk2(tv[0], tv[1]) | ((unsigned long long)pk2(tv[2], tv[3]) << 32);
            }
        }
    }
    LDS_WAIT();
    float Tr[64];
#pragma unroll
    for (int i = 0; i < 64; ++i) {
        float acc = lane == i ? 1.f : 0.f;
#pragma unroll
        for (int j = 0; j < i; ++j) acc -= As[i * 64 + j] * Tr[j];
        Tr[i] = acc;
    }
    LDS_WAIT();
#pragma unroll
    for (int i = 0; i < 64; ++i) Ts[i * 72 + lane] = f2bf(Tr[i]);
    LDS_WAIT();
    {
        bf16x8 tf[4][2];
#pragma unroll
        for (int it = 0; it < 4; ++it)
#pragma unroll
            for (int ks = 0; ks < 2; ++ks) tf[it][ks] = lds_frag(Ts + (16 * it + fr) * 72 + 32 * ks + 8 * fq);
#pragma unroll 1
        for (int nt = 0; nt < 8; ++nt) {
            f32x4 au[4], ak[4];
#pragma unroll
            for (int it = 0; it < 4; ++it) { au[it] = (f32x4){0.f, 0.f, 0.f, 0.f}; ak[it] = (f32x4){0.f, 0.f, 0.f, 0.f}; }
#pragma unroll
            for (int ks = 0; ks < 2; ++ks) {
                float vv[8], kv[8];
#pragma unroll
                for (int e = 0; e < 8; ++e) { const float* rp = ACT + (size_t)(tok0 + 32 * ks + 8 * fq + e) * 4096 + 16 * nt + fr; vv[e] = rp[2048 + vh * 128] * btS[32 * ks + 8 * fq + e]; kv[e] = rp[1024 + hq * 128] * beS[32 * ks + 8 * fq + e]; }
                u32x4 pv, pk; pv.x = pk2(vv[0], vv[1]); pv.y = pk2(vv[2], vv[3]); pv.z = pk2(vv[4], vv[5]); pv.w = pk2(vv[6], vv[7]);
                pk.x = pk2(kv[0], kv[1]); pk.y = pk2(kv[2], kv[3]); pk.z = pk2(kv[4], kv[5]); pk.w = pk2(kv[6], kv[7]);
                const bf16x8 vfrag = __builtin_bit_cast(bf16x8, pv), kfrag = __builtin_bit_cast(bf16x8, pk);
#pragma unroll
                for (int it = 0; it < 4; ++it) { au[it] = __builtin_amdgcn_mfma_f32_16x16x32_bf16(tf[it][ks], vfrag, au[it], 0, 0, 0);
                                                 ak[it] = __builtin_amdgcn_mfma_f32_16x16x32_bf16(kfrag, tf[it][ks], ak[it], 0, 0, 0); }
            }
#pragma unroll
            for (int it = 0; it < 4; ++it) {
                *(unsigned long long*)(U0g + (unsigned)(((nt * 4 + it) * 64 + lane) * 4)) = (unsigned long long)pk2(au[it][0], au[it][1]) | ((unsigned long long)pk2(au[it][2], au[it][3]) << 32);
                *(unsigned long long*)(KCDg + (unsigned)((16 * it + fr) * 128 + 16 * nt + 4 * fq)) = (unsigned long long)pk2(ak[it][0], ak[it][1]) | ((unsigned long long)pk2(ak[it][2], ak[it][3]) << 32);
            }
        }
    }
    if ((vh & 1) == 0) {
        bf16_t* QBg = c.ws<bf16_t>(W_QB) + (size_t)qitem * 8192; bf16_t* KTg = c.ws<bf16_t>(W_KT) + (size_t)qitem * 8192;
#pragma unroll 4
        for (int it = 0; it < 16; ++it) { const int q = it * 64 + lane, row = q >> 4, c16 = q & 15;
            *(bf16x8*)(QBg + row * 128 + 8 * c16) = gfrag_f32(ACT + (size_t)(tok0 + row) * 4096 + hq * 128 + 8 * c16); }
        LDS_WAIT();
#pragma unroll 4
        for (int j = 0; j < 64; ++j) { const float2 kv = *(const float2*)(ACT + (size_t)(tok0 + j) * 4096 + 1024 + hq * 128 + 2 * lane);
            KsT[(2 * lane) * 68 + j] = f2bf(kv.x); KsT[(2 * lane + 1) * 68 + j] = f2bf(kv.y); }
        LDS_WAIT();
#pragma unroll 4
        for (int ii = 0; ii < 32; ++ii) { const int row = 4 * ii + fq, c8 = fr; *(u32x2*)(KTg + row * 64 + 4 * c8) = *(const LAS u32x2*)(KsT + row * 68 + 4 * c8); }
    }
    LDS_WAIT();
}

constexpr int GS_KCD = 0, GS_QB = 17408, GS_ATT = 34816, GS_KT = 44032, GS_GC = 62464, GS_BUF = 62720;
DI void gdn_scan_wg(const Ctx& c, int li, int bvh) {
    const int vh = bvh & 15, b = bvh >> 4, hq = vh >> 1, lane = c.lane, fr = lane & 15, fq = lane >> 4, w = c.wave, tid = c.tid;
    const bf16_t* KCDg = c.ws<bf16_t>(W_KCD) + (size_t)(bvh * GCH) * 8192; const bf16_t* ATTg = c.ws<bf16_t>(W_ATTG) + (size_t)(bvh * GCH) * 4096;
    const bf16_t* U0g = c.ws<bf16_t>(W_U0) + (size_t)(bvh * GCH) * 8192;
    const bf16_t* QBg = c.ws<bf16_t>(W_QB) + (size_t)((b * GQH + hq) * GCH) * 8192; const bf16_t* KTg = c.ws<bf16_t>(W_KT) + (size_t)((b * GQH + hq) * GCH) * 8192;
    const float* GCg = c.ws<float>(W_GC); float* Y = c.ws<float>(W_Y);
    const bf16_t* src[7]; int dst[7]; int stp[7];
#pragma unroll
    for (int k = 0; k < 7; ++k) {
        const int q = tid + 512 * k;
        if (k < 2) { const int row = q >> 4, cc = q & 15; src[k] = KCDg + row * 128 + 8 * cc; dst[k] = GS_KCD + row * 272 + 16 * cc; stp[k] = 8192; }
        else if (k < 4) { const int qq = q - 1024, row = qq >> 4, cc = qq & 15; src[k] = QBg + row * 128 + 8 * cc; dst[k] = GS_QB + row * 272 + 16 * cc; stp[k] = 8192; }
        else if (k < 5) { const int qq = q - 2048, row = qq >> 3, cc = qq & 7; src[k] = ATTg + row * 64 + 8 * cc; dst[k] = GS_ATT + row * 144 + 16 * cc; stp[k] = 4096; }
        else { const int qq = q - 2560, row = qq >> 3, cc = qq & 7; src[k] = KTg + row * 64 + 8 * cc; dst[k] = GS_KT + row * 144 + 16 * cc; stp[k] = 8192; }
    }
    f32x4 sacc[8];
#pragma unroll
    for (int t = 0; t < 8; ++t) sacc[t] = (f32x4){0.f, 0.f, 0.f, 0.f};
    __syncthreads();
    u32x4 stg[7]; float gstg = 0.f;
#pragma unroll
    for (int k = 0; k < 7; ++k) stg[k] = *(const u32x4*)(src[k]);
    if (tid < 64) gstg = GCg[(size_t)(b * SEQ + tid) * 16 + vh];
#pragma unroll
    for (int k = 0; k < 7; ++k) *(LAS u32x4*)(c.lds + dst[k]) = stg[k];
    if (tid < 64) *(LAS float*)(c.lds + GS_GC + 4 * tid) = gstg;
    __syncthreads();
#pragma unroll 1
    for (int t = 0; t < GCH; ++t) {
        LAS unsigned char* buf = c.lds + (t & 1) * GS_BUF; LAS unsigned char* nbuf = c.lds + ((t + 1) & 1) * GS_BUF;
        const int tok0 = b * SEQ + t * 64;
        const bool more = t + 1 < GCH;
        if (more) {
#pragma unroll
            for (int k = 0; k < 7; ++k) stg[k] = *(const u32x4*)(src[k] + (size_t)(t + 1) * stp[k]);
            if (tid < 64) gstg = GCg[(size_t)(tok0 + 64 + tid) * 16 + vh];
        }
        u32x2 u0r[4];
#pragma unroll
        for (int it = 0; it < 4; ++it) u0r[it] = *(const u32x2*)(U0g + (size_t)t * 8192 + ((size_t)(w * 4 + it) * 64 + lane) * 4);
        const LAS bf16_t* KCD = (const LAS bf16_t*)(buf + GS_KCD); const LAS bf16_t* QB = (const LAS bf16_t*)(buf + GS_QB);
        const LAS bf16_t* ATT = (const LAS bf16_t*)(buf + GS_ATT); const LAS bf16_t* KT = (const LAS bf16_t*)(buf + GS_KT); const LAS float* gcS = (const LAS float*)(buf + GS_GC);
        bf16x8 sfrag[4];
#pragma unroll
        for (int ks = 0; ks < 4; ++ks) sfrag[ks] = pack8(sacc[2 * ks], sacc[2 * ks + 1]);
        const float gl = gcS[63], egl = __expf(gl);
        bf16x8 ufrag[2], udfrag[2]; f32x4 ov[4];
#pragma unroll
        for (int hp = 0; hp < 2; ++hp) {
            f32x4 uu[2];
#pragma unroll
            for (int h2 = 0; h2 < 2; ++h2) {
                const int it = 2 * hp + h2;
                f32x4 ks_ = (f32x4){0.f, 0.f, 0.f, 0.f}, qs_ = (f32x4){0.f, 0.f, 0.f, 0.f};
#pragma unroll
                for (int ks = 0; ks < 4; ++ks) {
                    ks_ = __builtin_amdgcn_mfma_f32_16x16x32_bf16(lds_frag2(KCD + (16 * it + fr) * 136 + 32 * ks + 4 * fq, KCD + (16 * it + fr) * 136 + 32 * ks + 16 + 4 * fq), sfrag[ks], ks_, 0, 0, 0);
                    qs_ = __builtin_amdgcn_mfma_f32_16x16x32_bf16(lds_frag2(QB + (16 * it + fr) * 136 + 32 * ks + 4 * fq, QB + (16 * it + fr) * 136 + 32 * ks + 16 + 4 * fq), sfrag[ks], qs_, 0, 0, 0);
                }
                const f32x4 gci = *(const LAS f32x4*)(gcS + 16 * it + 4 * fq);
                f32x4 u;
                u[0] = bf2f((bf16_t)(u0r[it].x & 0xffff)) - ks_[0]; u[1] = bf2f((bf16_t)(u0r[it].x >> 16)) - ks_[1]; u[2] = bf2f((bf16_t)(u0r[it].y & 0xffff)) - ks_[2]; u[3] = bf2f((bf16_t)(u0r[it].y >> 16)) - ks_[3];
                uu[h2] = u;
#pragma unroll
                for (int r = 0; r < 4; ++r) ov[it][r] = qs_[r] * __expf(gci[r]);
            }
            ufrag[hp] = pack8(uu[0], uu[1]);
            const f32x4 g0 = *(const LAS f32x4*)(gcS + 32 * hp + 4 * fq), g1 = *(const LAS f32x4*)(gcS + 32 * hp + 16 + 4 * fq);
            f32x4 d0, d1;
#pragma unroll
            for (int r = 0; r < 4; ++r) { d0[r] = uu[0][r] * __expf(gl - g0[r]); d1[r] = uu[1][r] * __expf(gl - g1[r]); }
            udfrag[hp] = pack8(d0, d1);
        }
#pragma unroll
        for (int it = 0; it < 4; ++it) {
            f32x4 au = ov[it];
#pragma unroll
            for (int ks = 0; ks < 2; ++ks) au = __builtin_amdgcn_mfma_f32_16x16x32_bf16(lds_frag2(ATT + (16 * it + fr) * 72 + 32 * ks + 4 * fq, ATT + (16 * it + fr) * 72 + 32 * ks + 16 + 4 * fq), ufrag[ks], au, 0, 0, 0);
#pragma unroll
            for (int r = 0; r < 4; ++r) Y[(size_t)(tok0 + 16 * it + 4 * fq + r) * 2048 + vh * 128 + 16 * w + fr] = au[r];
        }
#pragma unroll
        for (int tt = 0; tt < 8; ++tt) {
            f32x4 a = sacc[tt] * egl;
#pragma unroll
            for (int ks = 0; ks < 2; ++ks) a = __builtin_amdgcn_mfma_f32_16x16x32_bf16(lds_frag2(KT + (16 * tt + fr) * 72 + 32 * ks + 4 * fq, KT + (16 * tt + fr) * 72 + 32 * ks + 16 + 4 * fq), udfrag[ks], a, 0, 0, 0);
            sacc[tt] = a;
        }
        if (more) {
#pragma unroll
            for (int k = 0; k < 7; ++k) *(LAS u32x4*)(nbuf + dst[k]) = stg[k];
            if (tid < 64) *(LAS float*)(nbuf + GS_GC + 4 * tid) = gstg;
        }
        __syncthreads();
    }
    float* so = c.p.out + O_PGS + ((size_t)(li * NB + b) * GH + vh) * GDK * GDV;
#pragma unroll
    for (int tt = 0; tt < 8; ++tt)
#pragma unroll
        for (int r = 0; r < 4; ++r) so[(size_t)(16 * tt + 4 * fq + r) * GDV + 16 * w + fr] = sacc[tt][r];
}

DI void gdn_post_token(const Ctx& c, int li, int tok) {
    const bf16_t* PROJ = c.ws<bf16_t>(W_PROJ); const float* Y = c.ws<float>(W_Y); bf16_t* MIX = c.ws<bf16_t>(W_MIXED);
    const float* nw = c.in(I_GNW) + (size_t)li * GDV; const int lane = c.lane;
#pragma unroll 1
    for (int it = 0; it < 4; ++it) {
        const int ch0 = 512 * it + 8 * lane; float o[8], z[8], w[8];
        load8f(Y + (size_t)tok * 2048 + ch0, o); unpack8(*(const u32x4*)(PROJ + (size_t)tok * GDN_MAIN + 4096 + ch0), z); load8f(nw + (ch0 & 127), w);
        float ss = 0.f;
#pragma unroll
        for (int e = 0; e < 8; ++e) ss += o[e] * o[e];
        ss += __shfl_xor(ss, 1); ss += __shfl_xor(ss, 2); ss += __shfl_xor(ss, 4); ss += __shfl_xor(ss, 8);
        const float r = rsqrtf(ss * (1.f / 128.f) + EPS);
        u32x4 ov; ov.x = pk2(o[0] * r * w[0] * siluf(z[0]), o[1] * r * w[1] * siluf(z[1])); ov.y = pk2(o[2] * r * w[2] * siluf(z[2]), o[3] * r * w[3] * siluf(z[3]));
        ov.z = pk2(o[4] * r * w[4] * siluf(z[4]), o[5] * r * w[5] * siluf(z[5])); ov.w = pk2(o[6] * r * w[6] * siluf(z[6]), o[7] * r * w[7] * siluf(z[7]));
        *(u32x4*)(MIX + (size_t)tok * GVW + ch0) = ov;
    }
}

constexpr int PH_PER_LAYER = 10, N_PHASES = 1 + DEPTH * PH_PER_LAYER;
#ifndef ONLY
#define ONLY -1
#endif
#define EN(x) (ONLY < 0 || ONLY == (x))
DI void run_phase(const Ctx& c, int ph) {
    if (ph == 0) { if (!EN(0)) return;
        for (int i = 0; i < 2; ++i) {
            transpose_mat(c, c.in(I_WHIN) + (size_t)i * D * HYB_IN, D, HYB_IN, c.ws<bf16_t>(W_HIN) + (size_t)i * HYB_IN * D, 0);
            transpose_mat(c, c.in(I_WHOUT) + (size_t)i * HYB_MIX * D, HYB_MIX, D, c.ws<bf16_t>(W_HOUT) + (size_t)i * D * HYB_MIX, 0);
            transpose_mat(c, c.in(I_WGIN) + (size_t)i * D * GDN_IN, D, GDN_IN, c.ws<bf16_t>(W_GIN) + (size_t)i * GDN_IN * D, 0);
            transpose_mat(c, c.in(I_WGOUT) + (size_t)i * GVW * D, GVW, D, c.ws<bf16_t>(W_GOUT) + (size_t)i * D * GVW, 0);
        }
        for (int l = 0; l < 4; ++l) {
            transpose_mat(c, c.in(I_WFG) + (size_t)l * D * FF, D, FF, c.ws<bf16_t>(W_GU) + (size_t)l * 2 * FF * D, 1);
            transpose_mat(c, c.in(I_WFU) + (size_t)l * D * FF, D, FF, c.ws<bf16_t>(W_GU) + (size_t)l * 2 * FF * D, 2);
            transpose_mat(c, c.in(I_WFD) + (size_t)l * FF * D, FF, D, c.ws<bf16_t>(W_DN) + (size_t)l * D * FF, 0);
        }
        rowpass_phase(c, 0, nullptr, c.in(I_NMPRE), true);
        const size_t gt = (size_t)blockIdx.x * NTHR + c.tid, gn = (size_t)gridDim.x * NTHR;
        const size_t per = (size_t)(WIN - 1) * AW / 4, tot = (size_t)2 * NS * per;
        for (size_t i = gt; i < tot; i += gn) { const size_t sq = i / per, r = i % per;
            ((f32x4*)(c.p.out + O_SK + sq * WIN * AW))[r] = ((const f32x4*)(c.in(I_CK) + sq * WIN * AW + AW))[r];
            ((f32x4*)(c.p.out + O_SV + sq * WIN * AW))[r] = ((const f32x4*)(c.in(I_CV) + sq * WIN * AW + AW))[r]; }
        return;
    }
    const int l = (ph - 1) / PH_PER_LAYER, sp = (ph - 1) % PH_PER_LAYER, li = l >> 1; const bool hyb = (l & 1) == 0;
    bf16_t* H = c.ws<bf16_t>(W_H); bf16_t* PROJ = c.ws<bf16_t>(W_PROJ); bf16_t* MIX = c.ws<bf16_t>(W_MIXED); float* GO = c.ws<float>(W_GO); bf16_t* HID = c.ws<bf16_t>(W_HID);
    switch (sp) {
    case 0: {
        if (!EN(1)) break;
        const bf16_t* Wt = hyb ? c.ws<bf16_t>(W_HIN) + (size_t)li * HYB_IN * D : c.ws<bf16_t>(W_GIN) + (size_t)li * GDN_IN * D;
        const int nmain = hyb ? HYB_MAIN : GDN_MAIN, nall = hyb ? HYB_IN : GDN_IN;
        { pg8::Gemm g{H, Wt, T, nmain, D}; pg8::StaticOrder S; S.init(T, nmain, gridDim.x, blockIdx.x); pg8::EpiBf16Plain E{PROJ, nmain};
          pg8::gemm_phase<pg8::EpiBf16Plain, pg8::StaticOrder>(c.lds, g, S, E, nullptr); }
        { Epi e{0, PROJ, c.ws<float>(W_EXTRA), nmain, 0}; gemm_ksplit<4>(c, H, D, T, Wt + (size_t)nmain * D, D, nall - nmain, D, e); }
        { Epi e{0, PROJ + (size_t)T * nmain, c.ws<float>(W_EXTRA) + (size_t)T * 32, nmain, nmain}; gemm_ksplit<2>(c, H + (size_t)T * D, D, NS, Wt, D, nall, D, e); }
    } break;
    case 1: {
        if (hyb) {
            if (EN(2)) for (int tok = c.gw; tok < TT; tok += c.ngw) hyb_pre_token(c, li, tok);
            LAS float* pl = (LAS float*)(c.lds + NWAVE * AT_LDS + c.wave * 2048);
            if (EN(3)) { for (int it = T * AH + c.gw; it < TT * AH; it += c.ngw) attn_wave(c, li, it / AH, it % AH, pl);
                         for (int it = c.gw; it < NB * AH * 256; it += c.ngw) attn_mfma_item(c, li, it); }
        } else { if (EN(4)) for (int tok = c.gw; tok < TT; tok += c.ngw) gdn_pre_token(c, li, tok); }
    } break;
    case 2: {
        if (hyb) { if (EN(5)) { for (int it = blockIdx.x; it < NB * NCH * 2; it += gridDim.x) ssd_a_item(c, li, it);
                                for (int it = NB * SH * SP + c.gw; it < (NB + NS) * SH * SP; it += c.ngw) ssd_wave(c, li, it); } }
        else if (EN(6)) { gdn_seq_phase(c, li, NB * GH); for (int it = c.gw; it < NB * GH * GCH; it += c.ngw) gdn_a_item(c, li, it); }
    } break;
    case 3: {
        if (hyb) { if (EN(7)) { ssd_scan_phase(c, li); for (int tok = T + c.gw; tok < TT; tok += c.ngw) hyb_post_token(c, li, tok); } }
        else { if (EN(8)) for (int it = blockIdx.x; it < NB * GH; it += gridDim.x) gdn_scan_wg(c, li, it); }
    } break;
    case 4: {
        if (hyb) { if (EN(14)) for (int it = blockIdx.x; it < NB * NCH * 2; it += gridDim.x) ssd_b_item(c, li, it); }
        else if (EN(15)) for (int tok = c.gw; tok < TT; tok += c.ngw) gdn_post_token(c, li, tok);
    } break;
    case 5: {
        if (!EN(9)) break;
        const bf16_t* Wt = hyb ? c.ws<bf16_t>(W_HOUT) + (size_t)li * D * HYB_MIX : c.ws<bf16_t>(W_GOUT) + (size_t)li * D * GVW; const int kk = hyb ? HYB_MIX : GVW;
        { pg8::Gemm g{MIX, Wt, T, D, kk}; pg8::StaticOrder S; S.init(T, D, gridDim.x, blockIdx.x); pg8::EpiF32 E{GO, D, nullptr};
          pg8::gemm_phase<pg8::EpiF32, pg8::StaticOrder>(c.lds, g, S, E, nullptr); }
        { Epi e{1, nullptr, GO + (size_t)T * D, D, 0}; gemm_ksplit<2>(c, MIX + (size_t)T * kk, kk, NS, Wt, kk, D, kk, e); }
    } break;
    case 6: if (EN(10)) rowpass_phase(c, 1, c.in(I_NMPOST) + (size_t)l * D, c.in(I_NFPRE) + (size_t)l * D, l == 0); break;
    case 7: if (EN(11)) { const bf16_t* Wt = c.ws<bf16_t>(W_GU) + (size_t)l * 2 * FF * D;
        { pg8::Gemm g{H, Wt, T, 2 * FF, D}; pg8::StaticOrder S; S.init(T, 2 * FF, gridDim.x, blockIdx.x); pg8::EpiSwiglu E{HID, FF};
          pg8::gemm_phase<pg8::EpiSwiglu, pg8::StaticOrder>(c.lds, g, S, E, nullptr); }
        { Epi e{2, HID + (size_t)T * FF, nullptr, FF, 0}; gemm_ksplit<2>(c, H + (size_t)T * D, D, NS, Wt, D, 2 * FF, D, e); } } break;
    case 8: if (EN(12)) { const bf16_t* Wt = c.ws<bf16_t>(W_DN) + (size_t)l * D * FF;
        { pg8::Gemm g{HID, Wt, T, D, FF}; pg8::StaticOrder S; S.init(T, D, gridDim.x, blockIdx.x); pg8::EpiF32 E{GO, D, nullptr};
          pg8::gemm_phase<pg8::EpiF32, pg8::StaticOrder>(c.lds, g, S, E, nullptr); }
        { Epi e{1, nullptr, GO + (size_t)T * D, D, 0}; gemm_ksplit<2>(c, HID + (size_t)T * FF, FF, NS, Wt, FF, D, FF, e); } } break;
    case 9: if (EN(13)) rowpass_phase(c, l == DEPTH - 1 ? 2 : 1, c.in(I_NFPOST) + (size_t)l * D, l == DEPTH - 1 ? nullptr : c.in(I_NMPRE) + (size_t)(l + 1) * D, false); break;
    default: break;
    }
}

extern __shared__ __attribute__((aligned(16))) unsigned char g_shm[];
__global__ void __launch_bounds__(NTHR, 2) mega(Params p) {
    cg::grid_group grid = cg::this_grid();
    volatile LAS unsigned* bst = (volatile LAS unsigned*)((LAS unsigned char*)g_shm + LDS_BYTES - 16);
    if (threadIdx.x == 0) { bst[0] = 0u; bst[1] = 0u; bst[2] = 0u; bst[3] = 0u; }
    __syncthreads();
    const XcdBarrier xb = xcd_barrier_post((unsigned*)p.ws, bst);
    for (int ph = p.ph_lo; ph < p.ph_hi; ++ph) {
        int tid_ = threadIdx.x; asm volatile("" : "+v"(tid_));
        Ctx c; c.p.kp = (KParams)__builtin_amdgcn_kernarg_segment_ptr(); c.p.out = c.p.kp->out; c.tid = tid_; c.lane = tid_ & 63; c.wave = __builtin_amdgcn_readfirstlane(tid_ >> 6);
        c.gw = blockIdx.x * NWAVE + c.wave; c.ngw = gridDim.x * NWAVE; c.lds = (LAS unsigned char*)g_shm;
        run_phase(c, ph);
#ifdef PROBE_MASK
        { const int l_ = (ph - 1) / PH_PER_LAYER, sp_ = (ph - 1) % PH_PER_LAYER; const int bit = ph == 0 ? 20 : sp_ + 10 * (l_ & 1);
          if ((PROBE_MASK >> bit) & 1) { xcd_barrier(xb); run_phase(c, ph); } }
#endif
        if (ph + 1 < p.ph_hi) { if (ph == p.ph_lo) grid.sync(); else xcd_barrier(xb); }
    }
}

extern "C" void kernel_launch(void* const* d_in, const int* in_sizes, int n_in, void* d_out, int out_size, void* d_ws, size_t ws_size, hipStream_t stream) {
    static int grid = 0;
    if (!grid) {
        int dev = 0, cus = 0, per = 0; hipGetDevice(&dev); hipDeviceGetAttribute(&cus, hipDeviceAttributeMultiprocessorCount, dev);
        hipFuncSetAttribute((const void*)mega, hipFuncAttributeMaxDynamicSharedMemorySize, LDS_BYTES);
        hipOccupancyMaxActiveBlocksPerMultiprocessor(&per, (const void*)mega, NTHR, LDS_BYTES);
        if (n_in != 30 || (size_t)out_size != O_END || ws_size < W_END) fprintf(stderr, "kernel_launch: unexpected shapes n_in %d out %d (want %zu) ws %zu (want %zu)\n", n_in, out_size, (size_t)O_END, ws_size, (size_t)W_END);
        if (per < 1) fprintf(stderr, "kernel_launch: occupancy query says %d blocks per CU\n", per);
        grid = cus;
    }
    hipMemsetAsync(d_ws, 0, 16384, stream);
    Params p{}; for (int i = 0; i < 30; ++i) p.in[i] = (const float*)d_in[i];
    p.out = (float*)d_out; p.ws = (unsigned char*)d_ws; p.ph_lo = 0; p.ph_hi = N_PHASES;
    void* args[] = {&p};
    hipError_t e = hipLaunchCooperativeKernel((const void*)mega, dim3(grid), dim3(NTHR), args, LDS_BYTES, stream);
    if (e != hipSuccess) fprintf(stderr, "kernel_launch: cooperative launch failed: %s\n", hipGetErrorString(e));
}
```

```cpp
#include <hip/hip_runtime.h>
#include <hip/hip_cooperative_groups.h>
#include <cstdio>
#include <cstdint>
namespace cg = cooperative_groups;

#define DI __device__ __forceinline__
#define LAS __attribute__((address_space(3)))
typedef unsigned short bf16_t;
typedef short bf16x8 __attribute__((ext_vector_type(8)));
typedef float f32x4 __attribute__((ext_vector_type(4)));
typedef unsigned u32x2 __attribute__((ext_vector_type(2)));
typedef unsigned u32x4 __attribute__((ext_vector_type(4)));

constexpr int D = 1024, NB = 4, SEQ = 4096, T = NB * SEQ, NS = 32, TT = T + NS, DEPTH = 4;
constexpr int AH = 8, AHD = 64, AW = 512, WIN = 2048;
constexpr int SH = 16, SP = 64, SN = 128, SG = 2, SDI = 1024, SXBC = 1536;
constexpr int HYB_IN = 4112, HYB_MAIN = 4096, HYB_MIX = 1536;
constexpr int GH = 16, GQH = 8, GDK = 128, GDV = 128, GQKV = 4096, GVW = 2048, GDN_IN = 6176, GDN_MAIN = 6144;
constexpr int FF = 2816;
constexpr float EPS = 1e-6f;
constexpr int NTHR = 512, NWAVE = 8, LDS_BYTES = 163840;

enum { I_XP = 0, I_XS, I_CK, I_CV, I_SCONV, I_SSM, I_GCONV, I_GST, I_RELB, I_NMPRE, I_NMPOST, I_NFPRE, I_NFPOST, I_WHIN, I_SCW, I_SCB, I_SDTB, I_SALOG, I_SD, I_SNW,
       I_WHOUT, I_WGIN, I_GCW, I_GDTB, I_GALOG, I_GNW, I_WGOUT, I_WFG, I_WFU, I_WFD };

constexpr size_t O_YP = 0;
constexpr size_t O_YS = O_YP + (size_t)T * D;
constexpr size_t O_PK = O_YS + (size_t)NS * D;
constexpr size_t O_PV = O_PK + (size_t)2 * NB * WIN * AW;
constexpr size_t O_PSC = O_PV + (size_t)2 * NB * WIN * AW;
constexpr size_t O_PSS = O_PSC + (size_t)2 * NB * 3 * SXBC;
constexpr size_t O_PGC = O_PSS + (size_t)2 * NB * SH * SP * SN;
constexpr size_t O_PGS = O_PGC + (size_t)2 * NB * 3 * GQKV;
constexpr size_t O_SK = O_PGS + (size_t)2 * NB * GH * GDK * GDV;
constexpr size_t O_SV = O_SK + (size_t)2 * NS * WIN * AW;
constexpr size_t O_SSC = O_SV + (size_t)2 * NS * WIN * AW;
constexpr size_t O_SSS = O_SSC + (size_t)2 * NS * 3 * SXBC;
constexpr size_t O_SGC = O_SSS + (size_t)2 * NS * SH * SP * SN;
constexpr size_t O_SGS = O_SGC + (size_t)2 * NS * 3 * GQKV;
constexpr size_t O_END = O_SGS + (size_t)2 * NS * GH * GDK * GDV;

constexpr size_t al256(size_t x) { return (x + 255) & ~(size_t)255; }
constexpr size_t W_CTL = 0;
constexpr size_t W_HIN = 65536;
constexpr size_t W_HOUT = al256(W_HIN + (size_t)2 * HYB_IN * D * 2);
constexpr size_t W_GIN = al256(W_HOUT + (size_t)2 * D * HYB_MIX * 2);
constexpr size_t W_GOUT = al256(W_GIN + (size_t)2 * GDN_IN * D * 2);
constexpr size_t W_GU = al256(W_GOUT + (size_t)2 * D * GVW * 2);
constexpr size_t W_DN = al256(W_GU + (size_t)4 * 2 * FF * D * 2);
constexpr size_t W_X = al256(W_DN + (size_t)4 * D * FF * 2);
constexpr size_t W_H = al256(W_X + (size_t)TT * D * 4);
constexpr size_t W_PROJ = al256(W_H + (size_t)TT * D * 2);
constexpr size_t W_EXTRA = al256(W_PROJ + (size_t)TT * GDN_MAIN * 2);
constexpr size_t W_MIXED = al256(W_EXTRA + (size_t)TT * 32 * 4);
constexpr size_t W_GO = al256(W_MIXED + (size_t)TT * GVW * 2);
constexpr size_t W_HID = al256(W_GO + (size_t)TT * D * 4);
constexpr size_t W_ACT = al256(W_HID + (size_t)TT * FF * 2);
constexpr size_t W_AUX = al256(W_ACT + (size_t)TT * 4096 * 4);
constexpr size_t W_Y = al256(W_AUX + (size_t)TT * 32 * 4);
constexpr size_t W_END = al256(W_Y + (size_t)TT * 2048 * 4);

struct Params { const float* in[30]; float* out; unsigned char* ws; int ph_lo, ph_hi; };

DI float bf2f(bf16_t b) { return __uint_as_float(((unsigned)b) << 16); }
DI bf16_t f2bf(float x) { unsigned u = __float_as_uint(x); u += 0x7fffu + ((u >> 16) & 1u); return (bf16_t)(u >> 16); }
typedef float f32x2_ __attribute__((ext_vector_type(2))); typedef __bf16 bf16x2_ __attribute__((ext_vector_type(2)));
DI unsigned pk2(float lo, float hi) { const f32x2_ v = {lo, hi}; return __builtin_bit_cast(unsigned, __builtin_convertvector(v, bf16x2_)); }
DI float wave_sum(float v) {
#pragma unroll
    for (int o = 32; o >= 1; o >>= 1) v += __shfl_xor(v, o);
    return v;
}
DI float wave_max(float v) {
#pragma unroll
    for (int o = 32; o >= 1; o >>= 1) v = fmaxf(v, __shfl_xor(v, o));
    return v;
}
DI float siluf(float x) { return x / (1.f + __expf(-x)); }
DI float sigmoidf_(float x) { return 1.f / (1.f + __expf(-x)); }
DI float softplusf_(float x) { return fmaxf(x, 0.f) + log1pf(__expf(-fabsf(x))); }
#define LDS_WAIT() asm volatile("s_waitcnt lgkmcnt(0)" ::: "memory")
DI bf16x8 lds_frag(const LAS bf16_t* p) { return *(const LAS bf16x8*)p; }
DI bf16x8 lds_frag2(const LAS bf16_t* p0, const LAS bf16_t* p1) {
    const u32x2 a = *(const LAS u32x2*)p0, b = *(const LAS u32x2*)p1; u32x4 r; r.x = a.x; r.y = a.y; r.z = b.x; r.w = b.y; return __builtin_bit_cast(bf16x8, r);
}
DI bf16x8 pack8(const f32x4 a, const f32x4 b) { u32x4 r; r.x = pk2(a.x, a.y); r.y = pk2(a.z, a.w); r.z = pk2(b.x, b.y); r.w = pk2(b.z, b.w); return __builtin_bit_cast(bf16x8, r); }

__device__ const unsigned char c_bucket[3][129] = {
 {0,1,2,3,4,5,6,7,8,9,10,11,12,13,14,15,16,16,16,16,16,16,17,17,17,17,17,17,17,17,18,18,18,18,18,18,18,18,18,18,19,19,19,19,19,19,19,19,19,19,19,19,19,19,20,20,20,20,20,20,20,20,20,20,20,20,20,20,20,20,20,20,20,21,21,21,21,21,21,21,21,21,21,21,21,21,21,21,21,21,21,21,21,21,21,21,21,21,21,22,22,22,22,22,22,22,22,22,22,22,22,22,22,22,22,22,22,22,22,22,22,22,22,22,22,22,22,22,22},
 {0,4,8,12,16,16,17,17,18,18,19,19,19,19,20,20,20,20,20,21,21,21,21,21,21,22,22,22,22,22,22,22,22,22,23,23,23,23,23,23,23,23,23,23,23,23,24,24,24,24,24,24,24,24,24,24,24,24,24,24,24,24,25,25,25,25,25,25,25,25,25,25,25,25,25,25,25,25,25,25,25,25,25,26,26,26,26,26,26,26,26,26,26,26,26,26,26,26,26,26,26,26,26,26,26,26,26,26,26,26,26,26,26,27,27,27,27,27,27,27,27,27,27,27,27,27,27,27,27},
 {0,16,18,19,20,21,21,22,22,23,23,23,24,24,24,24,25,25,25,25,25,26,26,26,26,26,26,26,26,27,27,27,27,27,27,27,27,27,27,28,28,28,28,28,28,28,28,28,28,28,28,28,29,29,29,29,29,29,29,29,29,29,29,29,29,29,29,29,29,29,30,30,30,30,30,30,30,30,30,30,30,30,30,30,30,30,30,30,30,30,30,30,30,30,30,31,31,31,31,31,31,31,31,31,31,31,31,31,31,31,31,31,31,31,31,31,31,31,31,31,31,31,31,31,31,31,31,31,31}};

typedef const Params __attribute__((address_space(4)))* KParams;
struct OutRef { float* out; DI float* operator+(size_t o) const { return out + o; } };
struct PRef { KParams kp; float* out; };
#define XB_TMO      128
#define XB_XCNT(j)  (256  + 64 * (j))
#define XB_XSUB(j)  (1280 + 64 * (j))
#define XB_XGEN(j)  (2304 + 64 * (j))
#define XB_TOP      3328
#define XB_TOPGEN   3392
#define XCD_BAR_WORDS 3456
#define XB_SPIN_CAP (1u << 22)

__device__ __forceinline__ unsigned xb_ld(unsigned* p)              { return __hip_atomic_load(p, __ATOMIC_RELAXED, __HIP_MEMORY_SCOPE_AGENT); }
__device__ __forceinline__ unsigned xb_add(unsigned* p, unsigned v) { return __hip_atomic_fetch_add(p, v, __ATOMIC_RELAXED, __HIP_MEMORY_SCOPE_AGENT); }
__device__ __forceinline__ unsigned xb_xcc_id() { return (unsigned)__builtin_amdgcn_s_getreg((3 << 11) | 20) & 0xFu; }
#define XB_SPIN(cond, bar) do { unsigned _sp = 0; while (cond) { __builtin_amdgcn_s_sleep(1); \
    if ((++_sp & 255u) == 0u) { if (xb_ld(&(bar)[XB_TMO])) break; if (_sp > XB_SPIN_CAP) { atomicAdd(&(bar)[XB_TMO], 1u); break; } } } } while (0)

struct XcdBarrier {
    unsigned* bar; unsigned x;
    volatile LAS unsigned* st;
};

__device__ __forceinline__ XcdBarrier xcd_barrier_post(unsigned* bar, volatile LAS unsigned* st) {
    XcdBarrier b; b.bar = bar; b.x = xb_xcc_id(); b.st = st;
    if (threadIdx.x == 0) (void)xb_add(&bar[XB_XCNT(b.x)], 1u);
    return b;
}
__device__ __forceinline__ void xcd_barrier_complete(unsigned* bar, unsigned x, unsigned& nloc, unsigned& nx) {
    const unsigned G = gridDim.x * gridDim.y * gridDim.z;
    unsigned sum, cnt, mine, sp = 0u;
    for (;;) {
        sum = 0u; cnt = 0u; mine = 0u;
#pragma unroll
        for (unsigned j = 0; j < 16; ++j) { const unsigned c = xb_ld(&bar[XB_XCNT(j)]); sum += c; cnt += (c > 0u) ? 1u : 0u; mine = (j == x) ? c : mine; }
        if (sum == G) break;
        __builtin_amdgcn_s_sleep(1);
        if ((++sp & 255u) == 0u) { if (xb_ld(&bar[XB_TMO])) break; if (sp > XB_SPIN_CAP) { atomicAdd(&bar[XB_TMO], 1u); break; } }
    }
    nloc = mine > 0u ? mine : 1u; nx = cnt > 0u ? cnt : 1u;
}

__device__ __forceinline__ void xcd_barrier(const XcdBarrier& b) {
    asm volatile("s_waitcnt vmcnt(0)" ::: "memory");
    __syncthreads();
    if (threadIdx.x == 0) {
        unsigned* bar = b.bar;
        __builtin_amdgcn_s_waitcnt(0);
        unsigned nloc = b.st[0], nx = b.st[1];
        if (nloc == 0u) { xcd_barrier_complete(bar, b.x, nloc, nx); b.st[0] = nloc; b.st[1] = nx; }
        const unsigned old = xb_add(&bar[XB_XSUB(b.x)], 1u);
        const unsigned gen = old / nloc;
        if (old + 1u == (gen + 1u) * nloc) {
            __builtin_amdgcn_fence(__ATOMIC_RELEASE, "agent");
            asm volatile("s_waitcnt vmcnt(0)" ::: "memory");
            const unsigned og = xb_add(&bar[XB_TOP], 1u);
            const unsigned tg = og / nx;
            if (og + 1u == (tg + 1u) * nx) xb_add(&bar[XB_TOPGEN], 1u);
            else XB_SPIN(xb_ld(&bar[XB_TOPGEN]) == tg, bar);
            __builtin_amdgcn_fence(__ATOMIC_ACQUIRE, "agent");
            xb_add(&bar[XB_XGEN(b.x)], 1u);
            asm volatile("s_waitcnt vmcnt(0)" ::: "memory");
        } else {
            XB_SPIN(xb_ld(&bar[XB_XGEN(b.x)]) == gen, bar);
            __builtin_amdgcn_fence(__ATOMIC_ACQUIRE, "agent");
            asm volatile("s_waitcnt vmcnt(0)" ::: "memory");
        }
    }
    __syncthreads();
}

struct Ctx {
    PRef p; int tid, lane, wave, gw, ngw; LAS unsigned char* lds;
    DI const float* in(int i) const { return p.kp->in[i]; }
    template <class Tp> DI Tp* ws(size_t off) const { return (Tp*)(p.kp->ws + off); }
};

DI int rowmap(int n, int map) { return map == 0 ? n : (32 * (n >> 4) + (n & 15) + (map == 2 ? 16 : 0)); }
DI void transpose_item(const float* W, int K, int N, bf16_t* WT, int map, LAS float* scr, int item, int lane) {
    const int nblk = (N + 31) / 32, kb = item / nblk, nb = item % nblk, k0 = 64 * kb, n0 = 32 * nb;
    float wv[32];
#pragma unroll
    for (int i = 0; i < 32; ++i) { const int kk = 2 * i + (lane >> 5), n = n0 + (lane & 31); wv[i] = n < N ? W[(size_t)(k0 + kk) * N + n] : 0.f; }
#pragma unroll
    for (int i = 0; i < 32; ++i) scr[(2 * i + (lane >> 5)) * 33 + (lane & 31)] = wv[i];
    LDS_WAIT();
    const int c = lane & 7;
#pragma unroll
    for (int j = 0; j < 4; ++j) {
        const int nn = (lane >> 3) + 8 * j, n = n0 + nn; const LAS float* s = scr + (8 * c) * 33 + nn;
        u32x4 o; o.x = pk2(s[0], s[33]); o.y = pk2(s[66], s[99]); o.z = pk2(s[132], s[165]); o.w = pk2(s[198], s[231]);
        if (n < N) *(u32x4*)(WT + (size_t)rowmap(n, map) * K + k0 + 8 * c) = o;
    }
    LDS_WAIT();
}
DI void transpose_mat(const Ctx& c, const float* W, int K, int N, bf16_t* WT, int map) {
    LAS float* scr = (LAS float*)(c.lds + c.wave * 8704);
    const int nit = (K / 64) * ((N + 31) / 32);
    for (int it = c.gw; it < nit; it += c.ngw) transpose_item(W, K, N, WT, map, scr, it, c.lane);
}

DI void rowpass_row(const float* xrow, const float* gorow, const float* gpost, const float* gnext, float* xdst, bf16_t* hrow, float* yout, int lane) {
    f32x4 x[4]; float ss = 0.f;
    if (gorow) {
        f32x4 g[4];
#pragma unroll
        for (int j = 0; j < 4; ++j) { g[j] = *(const f32x4*)(gorow + 4 * lane + 256 * j); ss += g[j].x * g[j].x + g[j].y * g[j].y + g[j].z * g[j].z + g[j].w * g[j].w; }
        const float r = rsqrtf(wave_sum(ss) * (1.f / D) + EPS);
#pragma unroll
        for (int j = 0; j < 4; ++j) { const f32x4 w = *(const f32x4*)(gpost + 4 * lane + 256 * j); x[j] = *(const f32x4*)(xrow + 4 * lane + 256 * j) + g[j] * r * w; }
    } else {
#pragma unroll
        for (int j = 0; j < 4; ++j) x[j] = *(const f32x4*)(xrow + 4 * lane + 256 * j);
    }
    if (xdst) {
#pragma unroll
        for (int j = 0; j < 4; ++j) *(f32x4*)(xdst + 4 * lane + 256 * j) = x[j];
    }
    if (yout) {
#pragma unroll
        for (int j = 0; j < 4; ++j) *(f32x4*)(yout + 4 * lane + 256 * j) = x[j];
    }
    if (hrow) {
        float s2 = 0.f;
#pragma unroll
        for (int j = 0; j < 4; ++j) s2 += x[j].x * x[j].x + x[j].y * x[j].y + x[j].z * x[j].z + x[j].w * x[j].w;
        const float r2 = rsqrtf(wave_sum(s2) * (1.f / D) + EPS);
#pragma unroll
        for (int j = 0; j < 4; ++j) { const f32x4 w = *(const f32x4*)(gnext + 4 * lane + 256 * j); const f32x4 h = x[j] * r2 * w;
            u32x2 o; o.x = pk2(h.x, h.y); o.y = pk2(h.z, h.w); *(u32x2*)(hrow + 4 * lane + 256 * j) = o; }
    }
}
DI void rowpass_phase(const Ctx& c, int mode, const float* gpost, const float* gnext, bool x_from_input) {
    float* X = c.ws<float>(W_X); const float* GO = c.ws<float>(W_GO); bf16_t* H = c.ws<bf16_t>(W_H);
    for (int row = c.gw; row < TT; row += c.ngw) {
        const float* xrow = x_from_input ? (row < T ? c.in(I_XP) + (size_t)row * D : c.in(I_XS) + (size_t)(row - T) * D) : X + (size_t)row * D;
        if (mode == 0) rowpass_row(xrow, nullptr, nullptr, gnext, nullptr, H + (size_t)row * D, nullptr, c.lane);
        else if (mode == 1) rowpass_row(xrow, GO + (size_t)row * D, gpost, gnext, X + (size_t)row * D, H + (size_t)row * D, nullptr, c.lane);
        else rowpass_row(xrow, GO + (size_t)row * D, gpost, nullptr, nullptr, nullptr, c.p.out + (row < T ? O_YP + (size_t)row * D : O_YS + (size_t)(row - T) * D), c.lane);
    }
}

namespace pg8 {
#define PG8_LAS __attribute__((address_space(3)))
typedef unsigned short bf16_t;
typedef short bf16x8 __attribute__((ext_vector_type(8)));
typedef float f32x4 __attribute__((ext_vector_type(4)));
typedef unsigned u32x4 __attribute__((ext_vector_type(4)));
constexpr int BM = 256, BK = 64, HALF = 128, HTB = HALF * BK * 2  , STAGE_BYTES = 8 * HTB, NXCD = 8, WGM = 8;

__host__ __device__ __forceinline__ int lds_byte(int r, int c) { const int st = (r >> 4) * 2 + (c >> 5), rr = r & 15, cc = c & 31, ob = rr * 64 + cc * 2; return st * 1024 + (ob ^ (((ob >> 9) & 1) << 5)); }
__host__ __device__ __forceinline__ void stage_rc(int b, int& R, int& C) { const int st = b / 1024, sb = b % 1024, swz = sb ^ (((sb >> 9) & 1) << 5); R = (st >> 1) * 16 + swz / 64; C = (st & 1) * 32 + (swz % 64) / 2; }
__host__ __device__ __forceinline__ int perm32(int rho) { const int n = rho >> 4, i = rho & 15; return 8 * (i >> 2) + 4 * n + (i & 3); }

struct Unit { int pm, pn; };
struct Gemm { const bf16_t* A; const bf16_t* Bt; int M, N, K; };

struct StaticOrder {
    int nM, nN, nwg, G, c;
    __host__ __device__ void init(int M, int N, int G_, int c_) { nM = M / BM; nN = N / BM; nwg = nM * nN; G = G_; c = c_; }
    __host__ __device__ bool next(int i, Unit& u) const {
        const long L = (long)i * G + c; if (L >= nwg) return false;
        int wgid = (int)L; { const int q = nwg / NXCD, r = nwg % NXCD, xcd = wgid % NXCD, off = wgid / NXCD; wgid = (xcd < r ? xcd * (q + 1) : r * (q + 1) + (xcd - r) * q) + off; }
        const int nig = WGM * nN, gid = wgid / nig, fm = gid * WGM, gsz = (nM - fm) < WGM ? (nM - fm) : WGM;
        u.pm = fm + ((wgid % nig) % gsz); u.pn = (wgid % nig) / gsz; return true;
    }
    __device__ __forceinline__ void a_ready(const Unit&) const {}
    __device__ __forceinline__ void done(const Unit&) const {}
};
__device__ __forceinline__ unsigned cvt_pk_bf16(float lo, float hi) { unsigned r; asm volatile("v_cvt_pk_bf16_f32 %0, %1, %2" : "=v"(r) : "v"(lo), "v"(hi)); return r; }
typedef float f32x2 __attribute__((ext_vector_type(2)));
struct EpiF32 {
    static constexpr bool PERM = false, AFTER_DRAIN = false;
    float* C; int ldc; const float* bias;
    __device__ __forceinline__ void operator()(const f32x4 (&acc)[2][2][4][2], const Unit& u, int wr, int wc, int fr, int fq) const {
        const int row0 = u.pm * BM + wr * 64 + fr, col0 = u.pn * BM + wc * 32 + 4 * fq;
        f32x4 bv[2][2];
#pragma unroll
        for (int bj = 0; bj < 2; ++bj)
#pragma unroll
            for (int n = 0; n < 2; ++n) bv[bj][n] = bias ? *(const f32x4*)(bias + col0 + bj * HALF + n * 16) : (f32x4){0.f, 0.f, 0.f, 0.f};
#pragma unroll
        for (int ai = 0; ai < 2; ++ai)
#pragma unroll
            for (int m = 0; m < 4; ++m) { float* rowp = C + (size_t)(row0 + ai * HALF + m * 16) * ldc + col0;
#pragma unroll
                for (int bj = 0; bj < 2; ++bj)
#pragma unroll
                    for (int n = 0; n < 2; ++n) *(f32x4*)(rowp + bj * HALF + n * 16) = acc[ai][bj][m][n] + bv[bj][n]; }
    }
};
template <class Epi, class Sched, bool STAMP = false>
__device__ __forceinline__ void gemm_phase(PG8_LAS unsigned char* lds, const Gemm g, const Sched& S, const Epi& E, unsigned long long* stamps) {
    int tid_ = threadIdx.x; asm volatile("" : "+v"(tid_));
    const int tid = tid_, wid = __builtin_amdgcn_readfirstlane(tid >> 6), lane = tid & 63, wr = wid >> 2, wc = wid & 3, fr = lane & 15, fq = lane >> 4;
    const int K = g.K, nt = K / BK;
    int ts_lo = 0, ts_hi = 0, nts = 0; const unsigned long long rt_entry = STAMP ? (unsigned long long)wall_clock64() : 0ull;
#define PG8_STAMP() do { if (STAMP && wid == 0 && nts < 64) { const unsigned long long _c = (unsigned long long)clock64(); \
        ts_lo = (lane == nts) ? (int)(unsigned)_c : ts_lo; ts_hi = (lane == nts) ? (int)(unsigned)(_c >> 32) : ts_hi; ++nts; } } while (0)
    PG8_STAMP();
    unsigned voffA[2], voffB[2];
#pragma unroll
    for (int i = 0; i < 2; ++i) { int R, C; stage_rc(tid * 16 + i * 8192, R, C); const int Rb = Epi::PERM ? ((R & ~31) + perm32(R & 31)) : R;
        voffA[i] = (unsigned)(R * K + C) * 2u; voffB[i] = (unsigned)(Rb * K + C) * 2u; }
    const size_t kstep = (size_t)(BK * 2);
    const size_t hstep = (size_t)HALF * K * 2;
    const size_t tstep = 2 * hstep;
    const unsigned ldsw = (unsigned)wid * 1024u;
    const int aoff = lds_byte(wr * 64 + fr, fq * 8), boff = lds_byte(wc * 32 + fr, fq * 8);
#define PG8_SA(b, h) (((b) * 2 + (h)) * HTB)
#define PG8_SB(b, h) ((4 + (b) * 2 + (h)) * HTB)
#define PG8_STAGE(bufoff, gbase, voff) do { _Pragma("unroll") for (int _i = 0; _i < 2; ++_i) \
        __builtin_amdgcn_global_load_lds((const unsigned*)((const char*)(gbase) + (voff)[_i]), (PG8_LAS unsigned*)(lds + (bufoff) + ldsw + _i * 8192), 16, 0, 0); } while (0)
#define PG8_LDA(dst, b, h) do { _Pragma("unroll") for (int m = 0; m < 4; ++m) _Pragma("unroll") for (int k = 0; k < 2; ++k) dst[m][k] = *(const PG8_LAS bf16x8*)(lds + PG8_SA(b, h) + aoff + m * 2048 + k * 1024); } while (0)
#define PG8_LDB(dst, b, h) do { _Pragma("unroll") for (int n = 0; n < 2; ++n) _Pragma("unroll") for (int k = 0; k < 2; ++k) dst[n][k] = *(const PG8_LAS bf16x8*)(lds + PG8_SB(b, h) + boff + n * 2048 + k * 1024); } while (0)
#define PG8_MMA(ai, bj, At, Bt) do { __builtin_amdgcn_s_setprio(1); _Pragma("unroll") for (int m = 0; m < 4; ++m) _Pragma("unroll") for (int n = 0; n < 2; ++n) _Pragma("unroll") for (int k = 0; k < 2; ++k) \
        acc[ai][bj][m][n] = __builtin_amdgcn_mfma_f32_16x16x32_bf16(Bt[n][k], At[m][k], acc[ai][bj][m][n], 0, 0, 0); __builtin_amdgcn_s_setprio(0); } while (0)
#define PG8_WAIT_V(n) asm volatile("s_waitcnt vmcnt(" #n ")" ::: "memory")
#define PG8_WAIT_L(n) asm volatile("s_waitcnt lgkmcnt(" #n ")" ::: "memory")
#define PG8_BAR __builtin_amdgcn_s_barrier()
#define PG8_SCHED __builtin_amdgcn_sched_barrier(0)
    Unit cur, nxt; int ui = 0;
    if (!S.next(0, cur)) return;
    f32x4 acc[2][2][4][2];
#pragma unroll
    for (int a = 0; a < 2; ++a)
#pragma unroll
        for (int b = 0; b < 2; ++b)
#pragma unroll
            for (int m = 0; m < 4; ++m)
#pragma unroll
                for (int n = 0; n < 2; ++n) acc[a][b][m][n] = (f32x4){0.f, 0.f, 0.f, 0.f};
    bf16x8 At[4][2], B0[2][2], B1[2][2];
    const char* cA = (const char*)g.A + (size_t)cur.pm * tstep; const char* cB = (const char*)g.Bt + (size_t)cur.pn * tstep;
    S.a_ready(cur);
    PG8_STAGE(PG8_SB(0, 0), cB, voffB); PG8_STAGE(PG8_SA(0, 0), cA, voffA); PG8_STAGE(PG8_SB(0, 1), cB + hstep, voffB); PG8_STAGE(PG8_SA(0, 1), cA + hstep, voffA);
    if (wr == 1) PG8_BAR;
    PG8_WAIT_V(4); PG8_BAR;
    PG8_STAGE(PG8_SB(1, 0), cB + kstep, voffB); PG8_STAGE(PG8_SA(1, 0), cA + kstep, voffA); PG8_STAGE(PG8_SB(1, 1), cB + hstep + kstep, voffB);
    PG8_WAIT_V(6); PG8_BAR;
    PG8_STAMP();
    for (;;) {
        const bool has_next = S.next(ui + 1, nxt);
        const char* nA = has_next ? (const char*)g.A + (size_t)nxt.pm * tstep : cA; const char* nB = has_next ? (const char*)g.Bt + (size_t)nxt.pn * tstep : cB;
        for (int t = 0; t < nt; t += 2) {
            const bool last = (t == nt - 2);
            const char* a1 = cA + (size_t)(t + 1) * kstep;
            const char* a2 = last ? nA : cA + (size_t)(t + 2) * kstep; const char* b2 = last ? nB : cB + (size_t)(t + 2) * kstep;
            const char* a3 = a2 + kstep; const char* b3 = b2 + kstep;
            if (last && has_next) S.a_ready(nxt);
            PG8_LDB(B0, 0, 0); PG8_SCHED; PG8_LDA(At, 0, 0); PG8_STAGE(PG8_SA(1, 1), a1 + hstep, voffA);
            PG8_WAIT_L(8); PG8_BAR; PG8_WAIT_L(0); PG8_MMA(0, 0, At, B0); PG8_BAR; PG8_SCHED;
            PG8_LDB(B1, 0, 1); PG8_STAGE(PG8_SB(0, 0), b2, voffB);
            PG8_BAR; PG8_WAIT_L(0); PG8_MMA(0, 1, At, B1); PG8_BAR;
            PG8_LDA(At, 0, 1); PG8_STAGE(PG8_SA(0, 0), a2, voffA);
            PG8_BAR; PG8_WAIT_L(0); PG8_MMA(1, 0, At, B0); PG8_BAR; PG8_SCHED;
            PG8_STAGE(PG8_SB(0, 1), b2 + hstep, voffB);
            PG8_WAIT_V(6); PG8_BAR; PG8_MMA(1, 1, At, B1); PG8_BAR;
            PG8_LDB(B0, 1, 0); PG8_SCHED; PG8_LDA(At, 1, 0); PG8_STAGE(PG8_SA(0, 1), a2 + hstep, voffA);
            PG8_WAIT_L(8); PG8_BAR; PG8_WAIT_L(0); PG8_MMA(0, 0, At, B0); PG8_BAR; PG8_SCHED;
            PG8_LDB(B1, 1, 1); PG8_STAGE(PG8_SB(1, 0), b3, voffB);
            PG8_BAR; PG8_WAIT_L(0); PG8_MMA(0, 1, At, B1); PG8_BAR;
            PG8_LDA(At, 1, 1); PG8_STAGE(PG8_SA(1, 0), a3, voffA);
            PG8_BAR; PG8_WAIT_L(0); PG8_MMA(1, 0, At, B0); PG8_BAR; PG8_SCHED;
            PG8_STAGE(PG8_SB(1, 1), b3 + hstep, voffB);
            PG8_WAIT_V(6); PG8_BAR; PG8_MMA(1, 1, At, B1); PG8_BAR;
        }
        PG8_STAMP();
        if constexpr (!Epi::AFTER_DRAIN) { E(acc, cur, wr, wc, fr, fq); S.done(cur); }
        PG8_STAMP();
        if (!has_next) break;
#pragma unroll
        for (int a = 0; a < 2; ++a)
#pragma unroll
            for (int b = 0; b < 2; ++b)
#pragma unroll
                for (int m = 0; m < 4; ++m)
#pragma unroll
                    for (int n = 0; n < 2; ++n) acc[a][b][m][n] = (f32x4){0.f, 0.f, 0.f, 0.f};
        cur = nxt; cA = nA; cB = nB; ++ui;
    }
    PG8_WAIT_V(0);
    if (wr == 0) PG8_BAR;
    PG8_BAR;
    if constexpr (Epi::AFTER_DRAIN) { E.fused(acc, cur, wr, wc, fr, fq, lds, wid, lane); S.done(cur); }
    PG8_STAMP();
    if (STAMP && wid == 0) { stamps[lane] = lane < nts ? (((unsigned long long)(unsigned)ts_hi << 32) | (unsigned)ts_lo) : 0ull;
        if (lane == 62) stamps[62] = rt_entry; if (lane == 63) stamps[63] = (unsigned long long)wall_clock64(); }
#undef PG8_STAMP
#undef PG8_SA
#undef PG8_SB
#undef PG8_STAGE
#undef PG8_LDA
#undef PG8_LDB
#undef PG8_MMA
#undef PG8_WAIT_V
#undef PG8_WAIT_L
#undef PG8_BAR
#undef PG8_SCHED
}
}

namespace pg8 {
struct EpiBf16Plain {
    static constexpr bool PERM = false, AFTER_DRAIN = false;
    bf16_t* O; int ldc;
    __device__ __forceinline__ void operator()(const f32x4 (&acc)[2][2][4][2], const Unit& u, int wr, int wc, int fr, int fq) const {
        const int row0 = u.pm * BM + wr * 64 + fr, col0 = u.pn * BM + wc * 32 + 4 * fq;
#pragma unroll
        for (int ai = 0; ai < 2; ++ai)
#pragma unroll
            for (int m = 0; m < 4; ++m) { bf16_t* rowp = O + (size_t)(row0 + ai * HALF + m * 16) * ldc + col0;
#pragma unroll
                for (int bj = 0; bj < 2; ++bj)
#pragma unroll
                    for (int n = 0; n < 2; ++n) { const f32x4 v = acc[ai][bj][m][n]; unsigned long long w = (unsigned long long)cvt_pk_bf16(v[0], v[1]) | ((unsigned long long)cvt_pk_bf16(v[2], v[3]) << 32);
                        *(unsigned long long*)(rowp + bj * HALF + n * 16) = w; } }
    }
};
struct EpiSwiglu {
    static constexpr bool PERM = false, AFTER_DRAIN = false;
    bf16_t* O; int ldc;
    __device__ __forceinline__ void operator()(const f32x4 (&acc)[2][2][4][2], const Unit& u, int wr, int wc, int fr, int fq) const {
        const int row0 = u.pm * BM + wr * 64 + fr, col0 = u.pn * (BM / 2) + wc * 16 + 4 * fq;
#pragma unroll
        for (int ai = 0; ai < 2; ++ai)
#pragma unroll
            for (int m = 0; m < 4; ++m) { bf16_t* rowp = O + (size_t)(row0 + ai * HALF + m * 16) * ldc + col0;
#pragma unroll
                for (int bj = 0; bj < 2; ++bj) { const f32x4 g = acc[ai][bj][m][0], up = acc[ai][bj][m][1]; float h[4];
#pragma unroll
                    for (int e = 0; e < 4; ++e) h[e] = g[e] / (1.f + __expf(-g[e])) * up[e];
                    unsigned long long w = (unsigned long long)cvt_pk_bf16(h[0], h[1]) | ((unsigned long long)cvt_pk_bf16(h[2], h[3]) << 32);
                    *(unsigned long long*)(rowp + bj * (HALF / 2)) = w; } }
    }
};
}

struct Epi { int mode; bf16_t* ob; float* of; int ldo; int main_cols; };
DI void gemm_simple(const Ctx& c, const bf16_t* A, int lda, int M, const bf16_t* Bt, int ldb, int N, int K, const Epi e) {
    const int mblk = (M + 63) / 64, nblk = (N + 31) / 32, nit = mblk * nblk;
    const int fr = c.lane & 15, fq = c.lane >> 4;
    for (int it = c.gw; it < nit; it += c.ngw) {
        const int mb = it / nblk, nb = it % nblk, m0 = mb * 64, n0 = nb * 32;
        const bf16_t* ap[4]; const bf16_t* bp[2];
#pragma unroll
        for (int m = 0; m < 4; ++m) { int r = m0 + 16 * m + fr; r = r < M ? r : M - 1; ap[m] = A + (size_t)r * lda + 8 * fq; }
#pragma unroll
        for (int n = 0; n < 2; ++n) { int r = n0 + 16 * n + fr; r = r < N ? r : N - 1; bp[n] = Bt + (size_t)r * ldb + 8 * fq; }
        f32x4 acc[4][2];
#pragma unroll
        for (int m = 0; m < 4; ++m)
#pragma unroll
            for (int n = 0; n < 2; ++n) acc[m][n] = (f32x4){0.f, 0.f, 0.f, 0.f};
#pragma unroll 2
        for (int k0 = 0; k0 < K; k0 += 32) {
            bf16x8 a[4], b[2];
#pragma unroll
            for (int m = 0; m < 4; ++m) a[m] = *(const bf16x8*)(ap[m] + k0);
#pragma unroll
            for (int n = 0; n < 2; ++n) b[n] = *(const bf16x8*)(bp[n] + k0);
#pragma unroll
            for (int m = 0; m < 4; ++m)
#pragma unroll
                for (int n = 0; n < 2; ++n) acc[m][n] = __builtin_amdgcn_mfma_f32_16x16x32_bf16(b[n], a[m], acc[m][n], 0, 0, 0);
        }
#pragma unroll
        for (int m = 0; m < 4; ++m) {
            const int row = m0 + 16 * m + fr; if (row >= M) continue;
            if (e.mode == 2) {
                const f32x4 g = acc[m][0], u = acc[m][1]; u32x2 o;
                o.x = pk2(siluf(g.x) * u.x, siluf(g.y) * u.y); o.y = pk2(siluf(g.z) * u.z, siluf(g.w) * u.w);
                *(u32x2*)(e.ob + (size_t)row * e.ldo + 16 * nb + 4 * fq) = o;
            } else {
#pragma unroll
                for (int n = 0; n < 2; ++n) {
                    const int col = n0 + 16 * n + 4 * fq; if (col >= N) continue;
                    const f32x4 v = acc[m][n];
                    if (e.mode == 1) *(f32x4*)(e.of + (size_t)row * e.ldo + col) = v;
                    else if (col < e.main_cols) { u32x2 o; o.x = pk2(v.x, v.y); o.y = pk2(v.z, v.w); *(u32x2*)(e.ob + (size_t)row * e.ldo + col) = o; }
                    else *(f32x4*)(e.of + (size_t)row * 32 + (col - e.main_cols)) = v;
                }
            }
        }
    }
}

DI void attn_wave(const Ctx& c, int li, int tok, int h, LAS float* pl  ) {
    const bf16_t* PROJ = c.ws<bf16_t>(W_PROJ); bf16_t* MIX = c.ws<bf16_t>(W_MIXED);
    const int lane = c.lane; const bool smp = tok >= T;
    const int b = smp ? tok - T : tok / SEQ, s = smp ? WIN : tok % SEQ;
    const float* ck = c.in(I_CK) + ((size_t)(li * NS + b) * WIN) * AW + h * AHD;
    const float* cv = c.in(I_CV) + ((size_t)(li * NS + b) * WIN) * AW + h * AHD;
    const bf16_t* prow0 = smp ? PROJ + (size_t)tok * HYB_MAIN : PROJ + (size_t)(b * SEQ) * HYB_MAIN;
    float q[64];
    { const bf16_t* qp = PROJ + (size_t)tok * HYB_MAIN + h * AHD;
#pragma unroll
      for (int j = 0; j < 8; ++j) { const u32x4 v = *(const u32x4*)(qp + 8 * j);
          q[8*j+0] = bf2f((bf16_t)(v.x & 0xffff)) * 0.125f; q[8*j+1] = bf2f((bf16_t)(v.x >> 16)) * 0.125f; q[8*j+2] = bf2f((bf16_t)(v.y & 0xffff)) * 0.125f; q[8*j+3] = bf2f((bf16_t)(v.y >> 16)) * 0.125f;
          q[8*j+4] = bf2f((bf16_t)(v.z & 0xffff)) * 0.125f; q[8*j+5] = bf2f((bf16_t)(v.z >> 16)) * 0.125f; q[8*j+6] = bf2f((bf16_t)(v.w & 0xffff)) * 0.125f; q[8*j+7] = bf2f((bf16_t)(v.w >> 16)) * 0.125f; } }
    const float* relb = c.in(I_RELB);
    float mx = -1e30f;
#pragma unroll 1
    for (int pat = 0; pat < 3; ++pat) {
        const int d = pat == 0 ? 1 : (pat == 1 ? 4 : 16);
#pragma unroll
        for (int rnd = 0; rnd < 3; ++rnd) {
            const int j = rnd * 64 + lane; float lg = -1e30f;
            if (j <= 128) {
                const int R = s - j * d;
                if (R >= 0) {
                    float acc = 0.f;
                    if (smp && R < WIN) { const float* kp = ck + (size_t)R * AW;
#pragma unroll
                        for (int e = 0; e < 16; ++e) { const f32x4 v = *(const f32x4*)(kp + 4 * e); acc += q[4*e] * v.x + q[4*e+1] * v.y + q[4*e+2] * v.z + q[4*e+3] * v.w; }
                    } else { const bf16_t* kp = (smp ? prow0 : prow0 + (size_t)R * HYB_MAIN) + AW + h * AHD;
#pragma unroll
                        for (int e = 0; e < 8; ++e) { const u32x4 v = *(const u32x4*)(kp + 8 * e);
                            acc += q[8*e] * bf2f((bf16_t)(v.x & 0xffff)) + q[8*e+1] * bf2f((bf16_t)(v.x >> 16)) + q[8*e+2] * bf2f((bf16_t)(v.y & 0xffff)) + q[8*e+3] * bf2f((bf16_t)(v.y >> 16))
                                 + q[8*e+4] * bf2f((bf16_t)(v.z & 0xffff)) + q[8*e+5] * bf2f((bf16_t)(v.z >> 16)) + q[8*e+6] * bf2f((bf16_t)(v.w & 0xffff)) + q[8*e+7] * bf2f((bf16_t)(v.w >> 16)); }
                    }
                    lg = acc + relb[c_bucket[pat][j] * AH + h];
                }
                pl[pat * 132 + j] = lg;
            }
            mx = fmaxf(mx, lg);
        }
    }
    mx = wave_max(mx);
    LDS_WAIT();
    float ssum = 0.f;
#pragma unroll 1
    for (int i = lane; i < 396; i += 64) { const int pat = i / 132, j = i % 132; if (j <= 128) { const float lg = pl[i]; const float pv = lg > -1e29f ? __expf(lg - mx) : 0.f; pl[i] = pv; ssum += pv; } }
    ssum = wave_sum(ssum);
    LDS_WAIT();
    {
        const int kg = lane >> 4, dc = lane & 15;
        f32x4 o4 = (f32x4){0.f, 0.f, 0.f, 0.f};
        if (smp) {
#pragma unroll 1
            for (int pat = 0; pat < 3; ++pat) {
                const int d = pat == 0 ? 1 : (pat == 1 ? 4 : 16);
                if (kg == 0) { const u32x2 vv = *(const u32x2*)(prow0 + 2 * AW + h * AHD + 4 * dc); const float pv = pl[pat * 132];
                    o4.x += pv * bf2f((bf16_t)(vv.x & 0xffff)); o4.y += pv * bf2f((bf16_t)(vv.x >> 16)); o4.z += pv * bf2f((bf16_t)(vv.y & 0xffff)); o4.w += pv * bf2f((bf16_t)(vv.y >> 16)); }
#pragma unroll 16
                for (int i4 = 0; i4 < 32; ++i4) { const int j = 1 + 4 * i4 + kg; const f32x4 vv = *(const f32x4*)(cv + (size_t)(WIN - j * d) * AW + 4 * dc); o4 += vv * pl[pat * 132 + j]; }
            }
        } else {
#pragma unroll 1
            for (int pat = 0; pat < 3; ++pat) {
                const int d = pat == 0 ? 1 : (pat == 1 ? 4 : 16);
                int jmax = s / d; jmax = jmax > 128 ? 128 : jmax;
#pragma unroll 4
                for (int j = kg; j <= jmax; j += 4) { const u32x2 vv = *(const u32x2*)(prow0 + (size_t)(s - j * d) * HYB_MAIN + 2 * AW + h * AHD + 4 * dc); const float pv = pl[pat * 132 + j];
                    o4.x += pv * bf2f((bf16_t)(vv.x & 0xffff)); o4.y += pv * bf2f((bf16_t)(vv.x >> 16)); o4.z += pv * bf2f((bf16_t)(vv.y & 0xffff)); o4.w += pv * bf2f((bf16_t)(vv.y >> 16)); }
            }
        }
#pragma unroll
        for (int e = 0; e < 4; ++e) { o4[e] += __shfl_xor(o4[e], 16); o4[e] += __shfl_xor(o4[e], 32); }
        const float inv = 1.f / ssum;
        if (kg == 0) { u32x2 o; o.x = pk2(o4.x * inv, o4.y * inv); o.y = pk2(o4.z * inv, o4.w * inv); *(u32x2*)(MIX + (size_t)tok * HYB_MIX + h * AHD + 4 * dc) = o; }
    }
    LDS_WAIT();
}

template <int MT>
DI void gemm_ksplit(const Ctx& c, const bf16_t* A, int lda, int M, const bf16_t* Bt, int ldb, int N, int K, const Epi e) {
    const int mblk = (M + 16 * MT - 1) / (16 * MT), nblk = (N + 31) / 32, nit = mblk * nblk;
    const int fr = c.lane & 15, fq = c.lane >> 4, kslice = K / 8, klo = c.wave * kslice;
    LAS float* part = (LAS float*)c.lds;
    for (int it = blockIdx.x; it < nit; it += gridDim.x) {
        const int mb = it / nblk, nb = it % nblk, m0 = mb * 16 * MT, n0 = nb * 32;
        const bf16_t* ap[MT]; const bf16_t* bp[2];
#pragma unroll
        for (int m = 0; m < MT; ++m) { int r = m0 + 16 * m + fr; r = r < M ? r : M - 1; ap[m] = A + (size_t)r * lda + klo + 8 * fq; }
#pragma unroll
        for (int n = 0; n < 2; ++n) { int r = n0 + 16 * n + fr; r = r < N ? r : N - 1; bp[n] = Bt + (size_t)r * ldb + klo + 8 * fq; }
        f32x4 acc[MT][2];
#pragma unroll
        for (int m = 0; m < MT; ++m)
#pragma unroll
            for (int n = 0; n < 2; ++n) acc[m][n] = (f32x4){0.f, 0.f, 0.f, 0.f};
#pragma unroll 2
        for (int k0 = 0; k0 < kslice; k0 += 32) {
            bf16x8 a[MT], b[2];
#pragma unroll
            for (int m = 0; m < MT; ++m) a[m] = *(const bf16x8*)(ap[m] + k0);
#pragma unroll
            for (int n = 0; n < 2; ++n) b[n] = *(const bf16x8*)(bp[n] + k0);
#pragma unroll
            for (int m = 0; m < MT; ++m)
#pragma unroll
                for (int n = 0; n < 2; ++n) acc[m][n] = __builtin_amdgcn_mfma_f32_16x16x32_bf16(b[n], a[m], acc[m][n], 0, 0, 0);
        }
        __syncthreads();
#pragma unroll
        for (int m = 0; m < MT; ++m)
#pragma unroll
            for (int n = 0; n < 2; ++n) *(LAS f32x4*)(part + ((c.wave * (MT * 2) + m * 2 + n) * 64 + c.lane) * 4) = acc[m][n];
        __syncthreads();
        if (c.wave < MT) {
            const int m = c.wave; f32x4 v[2];
#pragma unroll
            for (int n = 0; n < 2; ++n) { v[n] = (f32x4){0.f, 0.f, 0.f, 0.f};
#pragma unroll
                for (int w = 0; w < 8; ++w) v[n] += *(const LAS f32x4*)(part + ((w * (MT * 2) + m * 2 + n) * 64 + c.lane) * 4); }
            const int row = m0 + 16 * m + fr;
            if (row < M) {
                if (e.mode == 2) {
                    const f32x4 g = v[0], u = v[1]; u32x2 o;
                    o.x = pk2(siluf(g.x) * u.x, siluf(g.y) * u.y); o.y = pk2(siluf(g.z) * u.z, siluf(g.w) * u.w);
                    *(u32x2*)(e.ob + (size_t)row * e.ldo + 16 * nb + 4 * fq) = o;
                } else {
#pragma unroll
                    for (int n = 0; n < 2; ++n) {
                        const int col = n0 + 16 * n + 4 * fq; if (col >= N) continue;
                        if (e.mode == 1) *(f32x4*)(e.of + (size_t)row * e.ldo + col) = v[n];
                        else if (col < e.main_cols) { u32x2 o; o.x = pk2(v[n].x, v[n].y); o.y = pk2(v[n].z, v[n].w); *(u32x2*)(e.ob + (size_t)row * e.ldo + col) = o; }
                        else *(f32x4*)(e.of + (size_t)row * 32 + (col - e.main_cols)) = v[n];
                    }
                }
            }
        }
    }
    __syncthreads();
}

constexpr int AT_LDS = 1600;
struct AtStep { int d, u, kb; const LAS float* tbp; };
DI AtStep at_step(int g, const LAS float* tb) {
    AtStep s;
    if (g < 12) { s.d = 1; s.u = 16; s.kb = -143 + 32 * g; s.tbp = tb; }
    else if (g < 18) { s.d = 4; s.u = 4; s.kb = -131 + 32 * (g - 12); s.tbp = tb + 132; }
    else if (g < 23) { s.d = 16; s.u = 1; s.kb = -144 + 32 * (g - 18); s.tbp = tb + 264; }
    else { s.d = 1; s.u = 0; s.kb = 100000; s.tbp = tb; }
    return s;
}
struct AtBuf { bf16x8 k[2][2]; bf16x8 v[2][2]; };
DI void at_load(AtBuf& bf, const bf16_t* qrow0, int P0, const AtStep st, int fr, int fq) {
#pragma unroll
    for (int kt = 0; kt < 2; ++kt) {
        int pos = P0 + st.d * (st.kb + 16 * kt + fr); pos = pos < 0 ? 0 : (pos > SEQ - 1 ? SEQ - 1 : pos);
        const bf16_t* rp = qrow0 + (size_t)pos * HYB_MAIN + 8 * fq;
        bf.k[kt][0] = *(const bf16x8*)(rp + AW); bf.k[kt][1] = *(const bf16x8*)(rp + AW + 32);
        bf.v[kt][0] = *(const bf16x8*)(rp + 2 * AW); bf.v[kt][1] = *(const bf16x8*)(rp + 2 * AW + 32);
    }
}
DI void attn_mfma_item(const Ctx& c, int li, int item) {
    const bf16_t* PROJ = c.ws<bf16_t>(W_PROJ); bf16_t* MIX = c.ws<bf16_t>(W_MIXED);
    int lane_ = c.lane; asm volatile("" : "+v"(lane_));
    const int lane = lane_, fr = lane & 15, fq = lane >> 4;
    const int qb = item & 255, h = (item >> 8) & 7, b = item >> 11, P0 = (qb >> 4) * 256 + (qb & 15);
    LAS float* tb = (LAS float*)(c.lds + c.wave * AT_LDS);
    { const float* relb = c.in(I_RELB);
#pragma unroll 1
      for (int i = lane; i < 396; i += 64) { const int pat = i / 132, j = i % 132; tb[i] = j <= 128 ? relb[c_bucket[pat][j] * AH + h] : 0.f; } }
    const bf16_t* qrow0 = PROJ + (size_t)(b * SEQ) * HYB_MAIN + h * AHD;
    bf16x8 qf[2], idf[2];
#pragma unroll
    for (int kd = 0; kd < 2; ++kd) qf[kd] = *(const bf16x8*)(qrow0 + (size_t)(P0 + 16 * fr) * HYB_MAIN + 32 * kd + 8 * fq);
#pragma unroll
    for (int hs = 0; hs < 2; ++hs)
#pragma unroll
        for (int e = 0; e < 8; ++e) idf[hs][e] = (8 * fq + e) == (16 * hs + fr) ? (short)0x3F80 : (short)0;
    float m = -1e30f, lsum = 0.f;
    f32x4 O[4];
#pragma unroll
    for (int dt = 0; dt < 4; ++dt) O[dt] = (f32x4){0.f, 0.f, 0.f, 0.f};
    AtBuf b0, b1, b2;
    at_load(b0, qrow0, P0, at_step(0, tb), fr, fq); at_load(b1, qrow0, P0, at_step(1, tb), fr, fq); at_load(b2, qrow0, P0, at_step(2, tb), fr, fq);
    LDS_WAIT();
#define AT_STEP(bf, g) do { \
        const AtStep st = at_step((g), tb); const int qi = st.u * fr; \
        f32x4 sc[2]; \
        _Pragma("unroll") for (int kt = 0; kt < 2; ++kt) { sc[kt] = (f32x4){0.f, 0.f, 0.f, 0.f}; \
            _Pragma("unroll") for (int kd = 0; kd < 2; ++kd) sc[kt] = __builtin_amdgcn_mfma_f32_16x16x32_bf16(bf.k[kt][kd], qf[kd], sc[kt], 0, 0, 0); } \
        f32x4 dv[2][4]; \
        _Pragma("unroll") for (int kt = 0; kt < 2; ++kt) _Pragma("unroll") for (int dt = 0; dt < 4; ++dt) \
            dv[kt][dt] = __builtin_amdgcn_mfma_f32_16x16x32_bf16(bf.v[kt][dt >> 1], idf[dt & 1], (f32x4){0.f, 0.f, 0.f, 0.f}, 0, 0, 0);     \
        const AtStep nx = at_step((g) + 3, tb); at_load(bf, qrow0, P0, nx, fr, fq);     \
        float tmax = -1e30f; bool ok[2][4]; \
        _Pragma("unroll") for (int kt = 0; kt < 2; ++kt) _Pragma("unroll") for (int r = 0; r < 4; ++r) { \
            const int kk = st.kb + 16 * kt + 4 * fq + r, dist = qi - kk; const bool v = dist >= 0 && dist <= 128 && (P0 + st.d * kk) >= 0; ok[kt][r] = v; \
            const int di = dist < 0 ? 0 : (dist > 128 ? 128 : dist); const float bias = *(const volatile LAS float*)(st.tbp + di);     \
            const float lg = v ? sc[kt][r] * 0.125f + bias : -1e30f; sc[kt][r] = lg; tmax = fmaxf(tmax, lg); } \
        tmax = fmaxf(tmax, __shfl_xor(tmax, 16)); tmax = fmaxf(tmax, __shfl_xor(tmax, 32)); \
        const float mn = fmaxf(m, tmax), alpha = __expf(m - mn); m = mn; \
        float ps = 0.f; \
        _Pragma("unroll") for (int kt = 0; kt < 2; ++kt) _Pragma("unroll") for (int r = 0; r < 4; ++r) { const float pv = ok[kt][r] ? __expf(sc[kt][r] - mn) : 0.f; sc[kt][r] = pv; ps += pv; } \
        lsum = lsum * alpha + ps; \
        const bf16x8 pfrag = pack8(sc[0], sc[1]); \
        _Pragma("unroll") for (int dt = 0; dt < 4; ++dt) O[dt] = __builtin_amdgcn_mfma_f32_16x16x32_bf16(pack8(dv[0][dt], dv[1][dt]), pfrag, O[dt] * alpha, 0, 0, 0); } while (0)
#pragma unroll 1
    for (int g = 0; g < 24; g += 3) { AT_STEP(b0, g); AT_STEP(b1, g + 1); AT_STEP(b2, g + 2); }
#undef AT_STEP
    lsum += __shfl_xor(lsum, 16); lsum += __shfl_xor(lsum, 32);
    const float inv = 1.f / lsum;
    bf16_t* orow = MIX + (size_t)(b * SEQ + P0 + 16 * fr) * HYB_MIX + h * AHD;
#pragma unroll
    for (int dt = 0; dt < 4; ++dt) { u32x2 o; o.x = pk2(O[dt][0] * inv, O[dt][1] * inv); o.y = pk2(O[dt][2] * inv, O[dt][3] * inv); *(u32x2*)(orow + 16 * dt + 4 * fq) = o; }
    LDS_WAIT();
}

DI void unpack8(const u32x4 v, float* f) {
    f[0] = bf2f((bf16_t)(v.x & 0xffff)); f[1] = bf2f((bf16_t)(v.x >> 16)); f[2] = bf2f((bf16_t)(v.y & 0xffff)); f[3] = bf2f((bf16_t)(v.y >> 16));
    f[4] = bf2f((bf16_t)(v.z & 0xffff)); f[5] = bf2f((bf16_t)(v.z >> 16)); f[6] = bf2f((bf16_t)(v.w & 0xffff)); f[7] = bf2f((bf16_t)(v.w >> 16));
}
DI void load8f(const float* p, float* f) { const f32x4 a = *(const f32x4*)p, b = *(const f32x4*)(p + 4); f[0] = a.x; f[1] = a.y; f[2] = a.z; f[3] = a.w; f[4] = b.x; f[5] = b.y; f[6] = b.z; f[7] = b.w; }
DI void store8f(float* p, const float* f) { *(f32x4*)p = (f32x4){f[0], f[1], f[2], f[3]}; *(f32x4*)(p + 4) = (f32x4){f[4], f[5], f[6], f[7]}; }
DI void conv8(const bf16_t* prow, int ld, const float* st, int nch, const float* cw, int ch0, bool smp, int s, float* x1, float* x2, float* x3, float* y) {
    float x0[8], w[8];
    unpack8(*(const u32x4*)(prow + ch0), x3);
    if (smp) { load8f(st + ch0, x0); load8f(st + nch + ch0, x1); load8f(st + 2 * nch + ch0, x2); }
    else {
        const u32x4 z = (u32x4){0u, 0u, 0u, 0u};
        unpack8(s >= 1 ? *(const u32x4*)(prow + ch0 - ld) : z, x2); unpack8(s >= 2 ? *(const u32x4*)(prow + ch0 - 2 * ld) : z, x1); unpack8(s >= 3 ? *(const u32x4*)(prow + ch0 - 3 * ld) : z, x0);
    }
    load8f(cw + ch0, w);
#pragma unroll
    for (int e = 0; e < 8; ++e) y[e] = x0[e] * w[e];
    load8f(cw + nch + ch0, w);
#pragma unroll
    for (int e = 0; e < 8; ++e) y[e] += x1[e] * w[e];
    load8f(cw + 2 * nch + ch0, w);
#pragma unroll
    for (int e = 0; e < 8; ++e) y[e] += x2[e] * w[e];
    load8f(cw + 3 * nch + ch0, w);
#pragma unroll
    for (int e = 0; e < 8; ++e) y[e] += x3[e] * w[e];
}
DI void hyb_pre_token(const Ctx& c, int li, int tok) {
    const bf16_t* PROJ = c.ws<bf16_t>(W_PROJ); float* ACT = c.ws<float>(W_ACT); float* AUX = c.ws<float>(W_AUX); const float* EX = c.ws<float>(W_EXTRA);
    const int lane = c.lane; const bool smp = tok >= T; const int b = smp ? tok - T : tok / SEQ, s = smp ? 0 : tok % SEQ;
    const float* cw = c.in(I_SCW) + (size_t)li * 4 * SXBC; const float* cb = c.in(I_SCB) + (size_t)li * SXBC;
    const float* st = c.in(I_SCONV) + (size_t)(li * NS + b) * 3 * SXBC;
    const bf16_t* prow = PROJ + (size_t)tok * HYB_MAIN + 2560;
#pragma unroll 1
    for (int it = 0; it < 3; ++it) {
        const int ch0 = 512 * it + 8 * lane; float x1[8], x2[8], x3[8], y[8], bb[8];
        conv8(prow, HYB_MAIN, st, SXBC, cw, ch0, smp, s, x1, x2, x3, y);
        load8f(cb + ch0, bb);
#pragma unroll
        for (int e = 0; e < 8; ++e) y[e] = siluf(y[e] + bb[e]);
        store8f(ACT + (size_t)tok * 4096 + ch0, y);
        if (smp) { float* o = c.p.out + O_SSC + (size_t)(li * NS + b) * 3 * SXBC + ch0; store8f(o, x1); store8f(o + SXBC, x2); store8f(o + 2 * SXBC, x3); }
        else if (s >= SEQ - 3) store8f(c.p.out + O_PSC + ((size_t)(li * NB + b) * 3 + (s - (SEQ - 3))) * SXBC + ch0, x3);
    }
    if (lane < SH) AUX[(size_t)tok * 32 + lane] = softplusf_(EX[(size_t)tok * 32 + lane] + c.in(I_SDTB)[li * SH + lane]);
    if (smp || s >= SEQ - WIN) {
        float* ok = smp ? c.p.out + O_SK + ((size_t)(li * NS + b) * WIN + (WIN - 1)) * AW : c.p.out + O_PK + ((size_t)(li * NB + b) * WIN + (s - (SEQ - WIN))) * AW;
        float* ov = smp ? c.p.out + O_SV + ((size_t)(li * NS + b) * WIN + (WIN - 1)) * AW : c.p.out + O_PV + ((size_t)(li * NB + b) * WIN + (s - (SEQ - WIN))) * AW;
        const bf16_t* kr = PROJ + (size_t)tok * HYB_MAIN + AW;
        float f[8];
        unpack8(*(const u32x4*)(kr + 8 * lane), f); store8f(ok + 8 * lane, f);
        unpack8(*(const u32x4*)(kr + AW + 8 * lane), f); store8f(ov + 8 * lane, f);
    }
}

DI void ssd_wave(const Ctx& c, int li, int item) {
    const float* ACT = c.ws<float>(W_ACT); const float* AUX = c.ws<float>(W_AUX); float* Y = c.ws<float>(W_Y);
    const int lane = c.lane;
    const bool smp = item >= NB * SH * SP; const int it = smp ? item - NB * SH * SP : item;
    const int seq = it / (SH * SP), h = (it / SP) % SH, p = it % SP, g = h / (SH / SG);
    const int L = smp ? 1 : SEQ; const int tok0 = smp ? T + seq : seq * SEQ;
    const float Ah = -__expf(c.in(I_SALOG)[li * SH + h]), Dh = c.in(I_SD)[li * SH + h];
    float h0 = 0.f, h1 = 0.f;
    if (smp) { const float* s0 = c.in(I_SSM) + (((size_t)(li * NS + seq) * SH + h) * SP + p) * SN; h0 = s0[2 * lane]; h1 = s0[2 * lane + 1]; }
#pragma unroll 2
    for (int t = 0; t < L; ++t) {
        const float* a = ACT + (size_t)(tok0 + t) * 4096;
        const float dt = AUX[(size_t)(tok0 + t) * 32 + h], xv = a[h * SP + p];
        const float2 Bv = *(const float2*)(a + SDI + g * SN + 2 * lane), Cv = *(const float2*)(a + SDI + SG * SN + g * SN + 2 * lane);
        const float dec = __expf(dt * Ah), dx = dt * xv;
        h0 = h0 * dec + dx * Bv.x; h1 = h1 * dec + dx * Bv.y;
        const float y = wave_sum(h0 * Cv.x + h1 * Cv.y);
        if (lane == 0) Y[(size_t)(tok0 + t) * 2048 + h * SP + p] = y + Dh * xv;
    }
    float* so = smp ? c.p.out + O_SSS + (((size_t)(li * NS + seq) * SH + h) * SP + p) * SN : c.p.out + O_PSS + (((size_t)(li * NB + seq) * SH + h) * SP + p) * SN;
    *(float2*)(so + 2 * lane) = make_float2(h0, h1);
}
DI void ssd_sample_item(const Ctx& c, int li, int item) {
    const float* ACT = c.ws<float>(W_ACT); const float* AUX = c.ws<float>(W_AUX); float* Y = c.ws<float>(W_Y);
    const int lane = c.lane, seq = item / SH, h = item % SH, g = h / (SH / SG), tok = T + seq;
    const float Ah = -__expf(c.in(I_SALOG)[li * SH + h]), Dh = c.in(I_SD)[li * SH + h];
    const float* a = ACT + (size_t)tok * 4096;
    const float dt = AUX[(size_t)tok * 32 + h], dec = __expf(dt * Ah);
    const float2 Bv = *(const float2*)(a + SDI + g * SN + 2 * lane), Cv = *(const float2*)(a + SDI + SG * SN + g * SN + 2 * lane);
    const float* s0 = c.in(I_SSM) + ((size_t)(li * NS + seq) * SH + h) * SP * SN; float* so = c.p.out + O_SSS + ((size_t)(li * NS + seq) * SH + h) * SP * SN;
    const float xl = a[h * SP + lane];
    float ysum = 0.f;
#pragma unroll 16
    for (int p = 0; p < SP; ++p) {
        const float2 hv = *(const float2*)(s0 + (size_t)p * SN + 2 * lane);
        const float dx = dt * __shfl(xl, p);
        const float h0 = hv.x * dec + dx * Bv.x, h1 = hv.y * dec + dx * Bv.y;
        *(float2*)(so + (size_t)p * SN + 2 * lane) = make_float2(h0, h1);
        const float y = wave_sum(h0 * Cv.x + h1 * Cv.y);
        ysum = lane == p ? y : ysum;
    }
    Y[(size_t)tok * 2048 + h * SP + lane] = ysum + Dh * xl;
}
DI void hyb_post_token(const Ctx& c, int li, int tok) {
    const bf16_t* PROJ = c.ws<bf16_t>(W_PROJ); const float* Y = c.ws<float>(W_Y); bf16_t* MIX = c.ws<bf16_t>(W_MIXED);
    const float* nw = c.in(I_SNW) + (size_t)li * SDI; const int lane = c.lane;
    float v[16]; float ss0 = 0.f, ss1 = 0.f;
#pragma unroll
    for (int j = 0; j < 16; ++j) { const int ch = lane + 64 * j; const float z = bf2f(PROJ[(size_t)tok * HYB_MAIN + 1536 + ch]); v[j] = Y[(size_t)tok * 2048 + ch] * siluf(z); if (j < 8) ss0 += v[j] * v[j]; else ss1 += v[j] * v[j]; }
    const float r0 = rsqrtf(wave_sum(ss0) * (1.f / 512.f) + EPS), r1 = rsqrtf(wave_sum(ss1) * (1.f / 512.f) + EPS);
#pragma unroll
    for (int j = 0; j < 16; ++j) { const int ch = lane + 64 * j; MIX[(size_t)tok * HYB_MIX + AW + ch] = f2bf(v[j] * (j < 8 ? r0 : r1) * nw[ch]); }
}


constexpr int SLD = 136;
constexpr int L_C = 0, L_B = 34816, L_XT = 69632, L_HS = 87040, L_CS = 104448, L_DT = 108544;
constexpr size_t W_ST = W_HID;
constexpr size_t W_DEC = W_HID + (size_t)NB * 32 * SH * SP * SN * 4;
constexpr int NCH = SEQ / 128;

DI void ssd_chunk_scalars(const Ctx& c, int li, int tok0, int g) {
    const float* AUX = c.ws<float>(W_AUX); LAS float* csS = (LAS float*)(c.lds + L_CS); LAS float* dtS = (LAS float*)(c.lds + L_DT);
    const int hh = c.wave, lane = c.lane, h = 8 * g + hh;
    const float Ah = -__expf(c.in(I_SALOG)[li * SH + h]);
    const float d0 = AUX[(size_t)(tok0 + lane) * 32 + h], d1 = AUX[(size_t)(tok0 + 64 + lane) * 32 + h];
    float s0 = d0 * Ah, s1 = d1 * Ah;
#pragma unroll
    for (int o = 1; o < 64; o <<= 1) { const float t0 = __shfl_up(s0, o), t1 = __shfl_up(s1, o); if (lane >= o) { s0 += t0; s1 += t1; } }
    s1 += __shfl(s0, 63);
    csS[lane * 8 + hh] = s0; csS[(64 + lane) * 8 + hh] = s1; dtS[lane * 8 + hh] = d0; dtS[(64 + lane) * 8 + hh] = d1;
}
DI void ssd_a_item(const Ctx& c, int li, int item) {
    const float* ACT = c.ws<float>(W_ACT); float* ST = c.ws<float>(W_ST); float* DEC = c.ws<float>(W_DEC);
    const int g = item & 1, ch = (item >> 1) % NCH, b = item / (2 * NCH), tok0 = b * SEQ + ch * 128;
    LAS bf16_t* BT = (LAS bf16_t*)(c.lds + L_B); LAS bf16_t* XT = (LAS bf16_t*)(c.lds + L_XT);
    const LAS float* csS = (const LAS float*)(c.lds + L_CS); const LAS float* dtS = (const LAS float*)(c.lds + L_DT);
    const int fr = c.lane & 15, fq = c.lane >> 4, w = c.wave;
    __syncthreads();
    ssd_chunk_scalars(c, li, tok0, g);
#pragma unroll 4
    for (int it = 0; it < 32; ++it) { const int idx = it * NTHR + c.tid, j = idx >> 7, n = idx & 127; BT[n * SLD + j] = f2bf(ACT[(size_t)(tok0 + j) * 4096 + SDI + g * SN + n]); }
    __syncthreads();
    if (c.tid < 8) DEC[(size_t)(b * NCH + ch) * SH + 8 * g + c.tid] = __expf(csS[127 * 8 + c.tid]);
    const int pt = w & 3, nt0 = (w >> 2) * 4;
#pragma unroll 1
    for (int hh = 0; hh < 8; ++hh) {
        const int h = 8 * g + hh; const float csl = csS[127 * 8 + hh];
#pragma unroll 4
        for (int it = 0; it < 16; ++it) { const int idx = it * NTHR + c.tid, j = idx >> 6, p = idx & 63;
            XT[p * SLD + j] = f2bf(ACT[(size_t)(tok0 + j) * 4096 + h * SP + p] * __expf(csl - csS[j * 8 + hh]) * dtS[j * 8 + hh]); }
        __syncthreads();
        f32x4 acc[4];
#pragma unroll
        for (int n = 0; n < 4; ++n) acc[n] = (f32x4){0.f, 0.f, 0.f, 0.f};
#pragma unroll
        for (int ks = 0; ks < 4; ++ks) {
            const bf16x8 a = lds_frag(XT + (16 * pt + fr) * SLD + 32 * ks + 8 * fq);
#pragma unroll
            for (int n = 0; n < 4; ++n) { const bf16x8 bb = lds_frag(BT + (16 * (nt0 + n) + fr) * SLD + 32 * ks + 8 * fq); acc[n] = __builtin_amdgcn_mfma_f32_16x16x32_bf16(bb, a, acc[n], 0, 0, 0); }
        }
        float* so = ST + ((((size_t)(b * NCH + ch) * SH + h) * SP + 16 * pt + fr) * SN);
#pragma unroll
        for (int n = 0; n < 4; ++n) *(f32x4*)(so + 16 * (nt0 + n) + 4 * fq) = acc[n];
        __syncthreads();
    }
}
DI void ssd_scan_phase(const Ctx& c, int li) {
    float* ST = c.ws<float>(W_ST); const float* DEC = c.ws<float>(W_DEC);
    for (int idx = blockIdx.x * NTHR + c.tid; idx < NB * SH * SP * SN / 4; idx += gridDim.x * NTHR) {
        const int n4 = idx & 31, p = (idx >> 5) & 63, h = (idx >> 11) & 15, b = idx >> 15;
        f32x4 hcur = (f32x4){0.f, 0.f, 0.f, 0.f};
#pragma unroll 8
        for (int ch = 0; ch < NCH; ++ch) {
            f32x4* a = (f32x4*)(ST + ((((size_t)(b * NCH + ch) * SH + h) * SP + p) * SN)) + n4;
            const f32x4 s = *a; const float d = DEC[(size_t)(b * NCH + ch) * SH + h];
            *a = hcur; hcur = hcur * d + s;
        }
        *((f32x4*)(c.p.out + O_PSS + ((((size_t)(li * NB + b) * SH + h) * SP + p) * SN)) + n4) = hcur;
    }
}
DI void ssd_b_item(const Ctx& c, int li, int item) {
    const float* ACT = c.ws<float>(W_ACT); const float* ST = c.ws<float>(W_ST); const bf16_t* PROJ = c.ws<bf16_t>(W_PROJ); bf16_t* MIX = c.ws<bf16_t>(W_MIXED);
    const int g = item & 1, ch = (item >> 1) % NCH, b = item / (2 * NCH), tok0 = b * SEQ + ch * 128;
    LAS bf16_t* CS_ = (LAS bf16_t*)(c.lds + L_C); LAS bf16_t* BS = (LAS bf16_t*)(c.lds + L_B); LAS bf16_t* XT = (LAS bf16_t*)(c.lds + L_XT); LAS bf16_t* HS = (LAS bf16_t*)(c.lds + L_HS);
    const LAS float* csS = (const LAS float*)(c.lds + L_CS); const LAS float* dtS = (const LAS float*)(c.lds + L_DT);
    const int fr = c.lane & 15, fq = c.lane >> 4, w = c.wave, irow = 16 * w + fr;
    __syncthreads();
    ssd_chunk_scalars(c, li, tok0, g);
#pragma unroll 4
    for (int it = 0; it < 8; ++it) { const int idx = it * NTHR + c.tid, i = idx >> 5, n4 = idx & 31;
        const f32x4 bv = *(const f32x4*)(ACT + (size_t)(tok0 + i) * 4096 + SDI + g * SN + 4 * n4), cv = *(const f32x4*)(ACT + (size_t)(tok0 + i) * 4096 + SDI + SG * SN + g * SN + 4 * n4);
        u32x2 o; o.x = pk2(bv.x, bv.y); o.y = pk2(bv.z, bv.w); *(LAS u32x2*)(BS + i * SLD + 4 * n4) = o;
        o.x = pk2(cv.x, cv.y); o.y = pk2(cv.z, cv.w); *(LAS u32x2*)(CS_ + i * SLD + 4 * n4) = o; }
    __syncthreads();
    f32x4 cb[8];
#pragma unroll
    for (int jt = 0; jt < 8; ++jt) cb[jt] = (f32x4){0.f, 0.f, 0.f, 0.f};
    bf16x8 cfrag[4];
#pragma unroll
    for (int ks = 0; ks < 4; ++ks) cfrag[ks] = lds_frag(CS_ + irow * SLD + 32 * ks + 8 * fq);
#pragma unroll
    for (int jt = 0; jt < 8; ++jt) if (jt <= w) {
#pragma unroll
        for (int ks = 0; ks < 4; ++ks) cb[jt] = __builtin_amdgcn_mfma_f32_16x16x32_bf16(lds_frag(BS + (16 * jt + fr) * SLD + 32 * ks + 8 * fq), cfrag[ks], cb[jt], 0, 0, 0);
    }
    float rowsq = 0.f;
#pragma unroll 1
    for (int hh = 0; hh < 8; ++hh) {
        const int h = 8 * g + hh; const float Dh = c.in(I_SD)[li * SH + h];
#pragma unroll 4
        for (int it = 0; it < 16; ++it) { const int idx = it * NTHR + c.tid, j = idx >> 6, p = idx & 63; XT[p * SLD + j] = f2bf(ACT[(size_t)(tok0 + j) * 4096 + h * SP + p]); }
#pragma unroll
        for (int it = 0; it < 4; ++it) { const int idx = it * NTHR + c.tid, p = idx >> 5, n4 = idx & 31;
            const f32x4 v = *((const f32x4*)(ST + ((((size_t)(b * NCH + ch) * SH + h) * SP + p) * SN)) + n4);
            u32x2 o; o.x = pk2(v.x, v.y); o.y = pk2(v.z, v.w); *(LAS u32x2*)(HS + p * SLD + 4 * n4) = o; }
        __syncthreads();
        const float csi = csS[irow * 8 + hh];
        f32x4 ay[4], ah[4];
#pragma unroll
        for (int pt = 0; pt < 4; ++pt) { ay[pt] = (f32x4){0.f, 0.f, 0.f, 0.f}; ah[pt] = (f32x4){0.f, 0.f, 0.f, 0.f}; }
#pragma unroll
        for (int ks = 0; ks < 4; ++ks) {
#pragma unroll
            for (int pt = 0; pt < 4; ++pt) ah[pt] = __builtin_amdgcn_mfma_f32_16x16x32_bf16(lds_frag(HS + (16 * pt + fr) * SLD + 32 * ks + 8 * fq), cfrag[ks], ah[pt], 0, 0, 0);
            if (2 * ks <= w) {
                float mv[8];
#pragma unroll
                for (int e = 0; e < 8; ++e) {
                    const int j = 32 * ks + (e < 4 ? 4 * fq + e : 16 + 4 * fq + (e - 4));
                    const float cbv = e < 4 ? cb[2 * ks][e] : cb[2 * ks + 1][e - 4];
                    const float csj = *(const volatile LAS float*)(csS + j * 8 + hh), dtj = *(const volatile LAS float*)(dtS + j * 8 + hh);
                    mv[e] = j <= irow ? cbv * __expf(csi - csj) * dtj : 0.f;
                }
                u32x4 mp; mp.x = pk2(mv[0], mv[1]); mp.y = pk2(mv[2], mv[3]); mp.z = pk2(mv[4], mv[5]); mp.w = pk2(mv[6], mv[7]);
                const bf16x8 mfrag = __builtin_bit_cast(bf16x8, mp);
#pragma unroll
                for (int pt = 0; pt < 4; ++pt) ay[pt] = __builtin_amdgcn_mfma_f32_16x16x32_bf16(lds_frag2(XT + (16 * pt + fr) * SLD + 32 * ks + 4 * fq, XT + (16 * pt + fr) * SLD + 32 * ks + 16 + 4 * fq), mfrag, ay[pt], 0, 0, 0);
            }
        }
        const float ei = __expf(csi);
#pragma unroll
        for (int pt = 0; pt < 4; ++pt) {
            const int col = h * SP + 16 * pt + 4 * fq;
            const f32x4 xv = *(const f32x4*)(ACT + (size_t)(tok0 + irow) * 4096 + col);
            const u32x2 zz = *(const u32x2*)(PROJ + (size_t)(tok0 + irow) * HYB_MAIN + 1536 + col);
            const float z0 = bf2f((bf16_t)(zz.x & 0xffff)), z1 = bf2f((bf16_t)(zz.x >> 16)), z2 = bf2f((bf16_t)(zz.y & 0xffff)), z3 = bf2f((bf16_t)(zz.y >> 16));
            const float y0 = (ay[pt][0] + ei * ah[pt][0] + Dh * xv.x) * siluf(z0), y1 = (ay[pt][1] + ei * ah[pt][1] + Dh * xv.y) * siluf(z1);
            const float y2 = (ay[pt][2] + ei * ah[pt][2] + Dh * xv.z) * siluf(z2), y3 = (ay[pt][3] + ei * ah[pt][3] + Dh * xv.w) * siluf(z3);
            rowsq += y0 * y0 + y1 * y1 + y2 * y2 + y3 * y3;
            u32x2 o; o.x = pk2(y0, y1); o.y = pk2(y2, y3); *(u32x2*)(MIX + (size_t)(tok0 + irow) * HYB_MIX + AW + col) = o;
        }
        __syncthreads();
    }
    rowsq += __shfl_xor(rowsq, 16); rowsq += __shfl_xor(rowsq, 32);
    const float rn = rsqrtf(rowsq * (1.f / 512.f) + EPS);
    const float* nw = c.in(I_SNW) + (size_t)li * SDI + g * 512;
    asm volatile("s_waitcnt vmcnt(0)" ::: "memory");
    bf16_t* mrow = MIX + (size_t)(tok0 + irow) * HYB_MIX + AW + g * 512 + fq * 128;
#pragma unroll 4
    for (int cc = 0; cc < 16; ++cc) {
        const u32x4 v = *(const u32x4*)(mrow + 8 * cc); const float* wv = nw + fq * 128 + 8 * cc; u32x4 o;
        o.x = pk2(bf2f((bf16_t)(v.x & 0xffff)) * rn * wv[0], bf2f((bf16_t)(v.x >> 16)) * rn * wv[1]); o.y = pk2(bf2f((bf16_t)(v.y & 0xffff)) * rn * wv[2], bf2f((bf16_t)(v.y >> 16)) * rn * wv[3]);
        o.z = pk2(bf2f((bf16_t)(v.z & 0xffff)) * rn * wv[4], bf2f((bf16_t)(v.z >> 16)) * rn * wv[5]); o.w = pk2(bf2f((bf16_t)(v.w & 0xffff)) * rn * wv[6], bf2f((bf16_t)(v.w >> 16)) * rn * wv[7]);
        *(u32x4*)(mrow + 8 * cc) = o;
    }
}

DI void gdn_pre_token(const Ctx& c, int li, int tok) {
    const bf16_t* PROJ = c.ws<bf16_t>(W_PROJ); bf16_t* ACTB = c.ws<bf16_t>(W_ACT); float* AUX = c.ws<float>(W_AUX); const float* EX = c.ws<float>(W_EXTRA);
    const int lane = c.lane; const bool smp = tok >= T; const int b = smp ? tok - T : tok / SEQ, s = smp ? 0 : tok % SEQ;
    const float* cw = c.in(I_GCW) + (size_t)li * 4 * GQKV;
    const float* st = c.in(I_GCONV) + (size_t)(li * NS + b) * 3 * GQKV;
    const bf16_t* prow = PROJ + (size_t)tok * GDN_MAIN;
#pragma unroll 1
    for (int it = 0; it < 8; ++it) {
        const int ch0 = 512 * it + 8 * lane; float x1[8], x2[8], x3[8], y[8];
        conv8(prow, GDN_MAIN, st, GQKV, cw, ch0, smp, s, x1, x2, x3, y);
        float ss = 0.f;
#pragma unroll
        for (int e = 0; e < 8; ++e) { y[e] = siluf(y[e]); ss += y[e] * y[e]; }
        if (it < 4) {
            ss += __shfl_xor(ss, 1); ss += __shfl_xor(ss, 2); ss += __shfl_xor(ss, 4); ss += __shfl_xor(ss, 8);
            const float r = rsqrtf(ss + EPS) * (it < 2 ? 0.08838834764831845f : 1.f);
#pragma unroll
            for (int e = 0; e < 8; ++e) y[e] *= r;
        }
        { u32x4 o; o.x = pk2(y[0], y[1]); o.y = pk2(y[2], y[3]); o.z = pk2(y[4], y[5]); o.w = pk2(y[6], y[7]); *(u32x4*)(ACTB + (size_t)tok * 4096 + ch0) = o; }
        if (smp) { float* o = c.p.out + O_SGC + (size_t)(li * NS + b) * 3 * GQKV + ch0; store8f(o, x1); store8f(o + GQKV, x2); store8f(o + 2 * GQKV, x3); }
        else if (s >= SEQ - 3) store8f(c.p.out + O_PGC + ((size_t)(li * NB + b) * 3 + (s - (SEQ - 3))) * GQKV + ch0, x3);
    }
    if (lane < GH) {
        AUX[(size_t)tok * 32 + lane] = sigmoidf_(EX[(size_t)tok * 32 + lane]);
        AUX[(size_t)tok * 32 + 16 + lane] = -__expf(c.in(I_GALOG)[li * GH + lane]) * softplusf_(EX[(size_t)tok * 32 + 16 + lane] + c.in(I_GDTB)[li * GH + lane]);
    }
}
DI void gdn_pre_range(const Ctx& c, int li, int item) {
    const bf16_t* PROJ = c.ws<bf16_t>(W_PROJ); bf16_t* ACTB = c.ws<bf16_t>(W_ACT); float* AUX = c.ws<float>(W_AUX); const float* EX = c.ws<float>(W_EXTRA);
    int lane_ = c.lane; asm volatile("" : "+v"(lane_));
    const int lane = lane_, it = item & 7, rg = item >> 3, tok0 = rg * 64, b = tok0 / SEQ, s0 = tok0 % SEQ, ch0 = 512 * it + 8 * lane;
    const float* cw = c.in(I_GCW) + (size_t)li * 4 * GQKV;
    float w0[8], w1[8], w2[8], w3[8], xa[8], xb[8], xc[8];
    load8f(cw + ch0, w0); load8f(cw + GQKV + ch0, w1); load8f(cw + 2 * GQKV + ch0, w2); load8f(cw + 3 * GQKV + ch0, w3);
    const bf16_t* prow = PROJ + (size_t)tok0 * GDN_MAIN + ch0;
    const u32x4 z4 = (u32x4){0u, 0u, 0u, 0u};
    unpack8(s0 >= 3 ? *(const u32x4*)(prow - 3 * GDN_MAIN) : z4, xa); unpack8(s0 >= 2 ? *(const u32x4*)(prow - 2 * GDN_MAIN) : z4, xb); unpack8(s0 >= 1 ? *(const u32x4*)(prow - GDN_MAIN) : z4, xc);
    const float qscale = it < 2 ? 0.08838834764831845f : 1.f;
    const float gal = lane >= 16 && lane < 32 ? -__expf(c.in(I_GALOG)[li * GH + lane - 16]) : 0.f, gdb = lane >= 16 && lane < 32 ? c.in(I_GDTB)[li * GH + lane - 16] : 0.f;
#pragma unroll 1
    for (int tb = 0; tb < 64; tb += 16) {
        u32x4 raw[16];
#pragma unroll
        for (int j = 0; j < 16; ++j) raw[j] = *(const u32x4*)(prow + (size_t)(tb + j) * GDN_MAIN);
#pragma unroll
        for (int j = 0; j < 16; ++j) {
            const int t = tb + j;
            float xd[8], y[8];
            unpack8(raw[j], xd);
            float ss = 0.f;
#pragma unroll
            for (int e = 0; e < 8; ++e) { y[e] = siluf(xa[e] * w0[e] + xb[e] * w1[e] + xc[e] * w2[e] + xd[e] * w3[e]); ss += y[e] * y[e]; }
            if (it < 4) {
                ss += __shfl_xor(ss, 1); ss += __shfl_xor(ss, 2); ss += __shfl_xor(ss, 4); ss += __shfl_xor(ss, 8);
                const float r = rsqrtf(ss + EPS) * qscale;
#pragma unroll
                for (int e = 0; e < 8; ++e) y[e] *= r;
            }
            { u32x4 o; o.x = pk2(y[0], y[1]); o.y = pk2(y[2], y[3]); o.z = pk2(y[4], y[5]); o.w = pk2(y[6], y[7]); *(u32x4*)(ACTB + (size_t)(tok0 + t) * 4096 + ch0) = o; }
            if (s0 + t >= SEQ - 3) store8f(c.p.out + O_PGC + ((size_t)(li * NB + b) * 3 + (s0 + t - (SEQ - 3))) * GQKV + ch0, xd);
            if (it == 0 && lane < 32) {
                const float ev = EX[(size_t)(tok0 + t) * 32 + lane];
                AUX[(size_t)(tok0 + t) * 32 + lane] = lane < 16 ? sigmoidf_(ev) : gal * softplusf_(ev + gdb);
            }
#pragma unroll
            for (int e = 0; e < 8; ++e) { xa[e] = xb[e]; xb[e] = xc[e]; xc[e] = xd[e]; }
        }
    }
}
DI void gdn_seq_phase(const Ctx& c, int li, int first_item) {
    const bf16_t* ACTB = c.ws<bf16_t>(W_ACT); const float* AUX = c.ws<float>(W_AUX); float* Y = c.ws<float>(W_Y);
    const int slot = c.tid >> 8, t8 = c.tid & 255, col = t8 >> 1, half = t8 & 1;
    LAS float* kq = (LAS float*)c.lds + slot * 512;
    const int nslot = gridDim.x * 2;
    for (int base = first_item; base < NB * GH + NS * GH; base += nslot) {
        const int item = base + blockIdx.x * 2 + slot;
        const bool wg_prompt = (base + blockIdx.x * 2) < NB * GH;
        const int L = wg_prompt ? SEQ : 1;
        const bool valid = item < NB * GH + NS * GH;
        const bool smp = item >= NB * GH; const int it = smp ? item - NB * GH : item;
        const int seq = valid ? it / GH : 0, vh = valid ? it % GH : 0, hq = vh >> 1;
        const int tok0 = smp ? T + seq : seq * SEQ;
        float S[64];
        if (valid && smp) { const float* s0 = c.in(I_GST) + ((size_t)(li * NS + seq) * GH + vh) * GDK * GDV + (size_t)(64 * half) * GDV + col;
#pragma unroll
            for (int k = 0; k < 64; ++k) S[k] = s0[(size_t)k * GDV]; }
        else {
#pragma unroll
            for (int k = 0; k < 64; ++k) S[k] = 0.f; }
        __syncthreads();
        for (int t = 0; t < L; ++t) {
            LAS float* cur = kq + (t & 1) * 256;
            const bf16_t* a = ACTB + (size_t)(tok0 + t) * 4096;
            cur[t8] = bf2f(a[(t8 < 128 ? 1024 : -128) + hq * 128 + t8]);
            const float vv = bf2f(a[2048 + vh * 128 + col]), beta = AUX[(size_t)(tok0 + t) * 32 + vh], eg = __expf(AUX[(size_t)(tok0 + t) * 32 + 16 + vh]);
            __syncthreads();
            const LAS float* kk = cur + 64 * half; const LAS float* qq = cur + 128 + 64 * half;
            float ks = 0.f;
#pragma unroll
            for (int k = 0; k < 64; k += 4) { const f32x4 kv = *(const LAS f32x4*)(kk + k); ks += kv.x * S[k] + kv.y * S[k + 1] + kv.z * S[k + 2] + kv.w * S[k + 3]; }
            ks += __shfl_xor(ks, 1);
            const float u = beta * (vv - eg * ks);
            asm volatile("" ::: "memory");
            float o = 0.f;
#pragma unroll
            for (int k = 0; k < 64; k += 4) { const f32x4 kv = *(const LAS f32x4*)(kk + k); const f32x4 qv = *(const LAS f32x4*)(qq + k);
                S[k] = eg * S[k] + kv.x * u; S[k + 1] = eg * S[k + 1] + kv.y * u; S[k + 2] = eg * S[k + 2] + kv.z * u; S[k + 3] = eg * S[k + 3] + kv.w * u;
                o += qv.x * S[k] + qv.y * S[k + 1] + qv.z * S[k + 2] + qv.w * S[k + 3]; }
            o += __shfl_xor(o, 1);
            if (valid && half == 0) Y[(size_t)(tok0 + t) * 2048 + vh * 128 + col] = o;
        }
        if (valid) { float* so = (smp ? c.p.out + O_SGS + ((size_t)(li * NS + seq) * GH + vh) * GDK * GDV : c.p.out + O_PGS + ((size_t)(li * NB + seq) * GH + vh) * GDK * GDV) + (size_t)(64 * half) * GDV + col;
#pragma unroll
            for (int k = 0; k < 64; ++k) so[(size_t)k * GDV] = S[k]; }
        __syncthreads();
    }
}

constexpr size_t W_KCD = W_GO;
constexpr size_t W_U0 = W_HID;
constexpr size_t W_GC = W_HID + (size_t)67108864;
constexpr size_t W_QB = W_H;
constexpr size_t W_ATTG = W_Y;
constexpr size_t W_KT = W_Y + (size_t)33554432;
constexpr int GA_LDS = 20000;
constexpr int GCH = SEQ / 64;

DI bf16x8 gfrag_f32(const float* p) { return pack8(*(const f32x4*)p, *(const f32x4*)(p + 4)); }

DI void gdn_a_item(const Ctx& c, int li, int item) {
    const bf16_t* ACTB = c.ws<bf16_t>(W_ACT); const float* AUX = c.ws<float>(W_AUX);
    const int ch = item & (GCH - 1), vh = (item >> 6) & 15, b = item >> 10, hq = vh >> 1, tok0 = b * SEQ + ch * 64;
    int lane_ = c.lane; asm volatile("" : "+v"(lane_));
    const int lane = lane_, fr = lane & 15, fq = lane >> 4;
    LAS unsigned char* wl = c.lds + c.wave * GA_LDS;
    LAS float* As = (LAS float*)wl; LAS bf16_t* Ts = (LAS bf16_t*)wl; LAS bf16_t* KsT = (LAS bf16_t*)wl;
    LAS float* gcS = (LAS float*)(wl + 17408); LAS float* btS = gcS + 64; LAS float* beS = gcS + 128;
    bf16_t* KCDg = c.ws<bf16_t>(W_KCD) + (size_t)item * 8192; bf16_t* ATTg = c.ws<bf16_t>(W_ATTG) + (size_t)item * 4096; bf16_t* U0g = c.ws<bf16_t>(W_U0) + (size_t)item * 8192;
    const int qitem = (b * GQH + hq) * GCH + ch;
    { const float gi = AUX[(size_t)(tok0 + lane) * 32 + 16 + vh], bi = AUX[(size_t)(tok0 + lane) * 32 + vh];
      float gc = gi;
#pragma unroll
      for (int o = 1; o < 64; o <<= 1) { const float t = __shfl_up(gc, o); if (lane >= o) gc += t; }
      gcS[lane] = gc; btS[lane] = bi; beS[lane] = bi * __expf(gc); c.ws<float>(W_GC)[(size_t)(tok0 + lane) * 16 + vh] = gc; }
    LDS_WAIT();
    {
        bf16x8 kf[4][4];
#pragma unroll
        for (int t = 0; t < 4; ++t) {
#pragma unroll
            for (int ks = 0; ks < 4; ++ks) kf[t][ks] = *(const bf16x8*)(ACTB + (size_t)(tok0 + 16 * t + fr) * 4096 + 1024 + hq * 128 + 32 * ks + 8 * fq);
            asm volatile("" ::: "memory");
        }
#pragma unroll
        for (int it = 0; it < 4; ++it) {
            bf16x8 qf[4];
#pragma unroll
            for (int ks = 0; ks < 4; ++ks) qf[ks] = *(const bf16x8*)(ACTB + (size_t)(tok0 + 16 * it + fr) * 4096 + hq * 128 + 32 * ks + 8 * fq);
            const int i = 16 * it + fr; const float gci = gcS[i], bti = btS[i];
#pragma unroll
            for (int jt = 0; jt < 4; ++jt) {
                bf16_t* ap = ATTg + (unsigned)(i * 64 + 16 * jt + 4 * fq);
                if (jt > it) { *(unsigned long long*)ap = 0ull; continue; }
                f32x4 kk = (f32x4){0.f, 0.f, 0.f, 0.f}, qk = (f32x4){0.f, 0.f, 0.f, 0.f};
#pragma unroll
                for (int ks = 0; ks < 4; ++ks) { kk = __builtin_amdgcn_mfma_f32_16x16x32_bf16(kf[jt][ks], kf[it][ks], kk, 0, 0, 0); qk = __builtin_amdgcn_mfma_f32_16x16x32_bf16(kf[jt][ks], qf[ks], qk, 0, 0, 0); }
                f32x4 av, tv;
#pragma unroll
                for (int r = 0; r < 4; ++r) { const int j = 16 * jt + 4 * fq + r; const float dec = __expf(gci - gcS[j]); av[r] = j < i ? bti * kk[r] * dec : 0.f; tv[r] = j <= i ? qk[r] * dec : 0.f; }
                *(LAS f32x4*)(As + i * 64 + 16 * jt + 4 * fq) = av;
                *(unsigned long long*)ap = (unsigned long long)pk2(tv[0], tv[1]) | ((unsigned long long)pk2(tv[2], tv[3]) << 32);
            }
        }
    }
    LDS_WAIT();
    float Tr[64];
#pragma unroll
    for (int i = 0; i < 64; ++i) {
        float acc = lane == i ? 1.f : 0.f;
#pragma unroll
        for (int j = 0; j < i; ++j) acc -= As[i * 64 + j] * Tr[j];
        Tr[i] = acc;
    }
    LDS_WAIT();
#pragma unroll
    for (int i = 0; i < 64; ++i) Ts[i * 72 + lane] = f2bf(Tr[i]);
    LDS_WAIT();
    {
        bf16x8 tfp[4][2], idf[2];
#pragma unroll
        for (int it = 0; it < 4; ++it)
#pragma unroll
            for (int ks = 0; ks < 2; ++ks) tfp[it][ks] = lds_frag2(Ts + (16 * it + fr) * 72 + 32 * ks + 4 * fq, Ts + (16 * it + fr) * 72 + 32 * ks + 16 + 4 * fq);
#pragma unroll
        for (int hs = 0; hs < 2; ++hs)
#pragma unroll
            for (int e = 0; e < 8; ++e) idf[hs][e] = (8 * fq + e) == (16 * hs + fr) ? (short)0x3F80 : (short)0;
        bf16_t* KTg = c.ws<bf16_t>(W_KT) + (size_t)qitem * 8192;
        const bool wr_k = (vh & 1) == 0;
        const bf16_t* AK = ACTB + (size_t)tok0 * 4096 + 1024 + hq * 128; const bf16_t* AV = ACTB + (size_t)tok0 * 4096 + 2048 + vh * 128;
#pragma unroll 1
        for (int cc = 0; cc < 4; ++cc) {
            bf16x8 vf[4], kf2[4];
#pragma unroll
            for (int t = 0; t < 4; ++t) { vf[t] = *(const bf16x8*)(AV + (size_t)(16 * t + fr) * 4096 + 32 * cc + 8 * fq); kf2[t] = *(const bf16x8*)(AK + (size_t)(16 * t + fr) * 4096 + 32 * cc + 8 * fq); }
#pragma unroll
            for (int hs = 0; hs < 2; ++hs) {
                const int nt = 2 * cc + hs;
                f32x4 dvv[4], dkk[4];
#pragma unroll
                for (int t = 0; t < 4; ++t) {
                    const f32x4 z = (f32x4){0.f, 0.f, 0.f, 0.f};
                    dvv[t] = __builtin_amdgcn_mfma_f32_16x16x32_bf16(vf[t], idf[hs], z, 0, 0, 0);
                    dkk[t] = __builtin_amdgcn_mfma_f32_16x16x32_bf16(kf2[t], idf[hs], z, 0, 0, 0);
                    if (wr_k) *(unsigned long long*)(KTg + (unsigned)((16 * nt + fr) * 64 + 16 * t + 4 * fq)) = (unsigned long long)pk2(dkk[t][0], dkk[t][1]) | ((unsigned long long)pk2(dkk[t][2], dkk[t][3]) << 32);
                    const f32x4 bt = *(const LAS f32x4*)(btS + 16 * t + 4 * fq), be = *(const LAS f32x4*)(beS + 16 * t + 4 * fq);
                    dvv[t] *= bt; dkk[t] *= be;
                }
                f32x4 au[4], ak[4];
#pragma unroll
                for (int it = 0; it < 4; ++it) { au[it] = (f32x4){0.f, 0.f, 0.f, 0.f}; ak[it] = (f32x4){0.f, 0.f, 0.f, 0.f}; }
#pragma unroll
                for (int ks = 0; ks < 2; ++ks) {
                    const bf16x8 vfrag = pack8(dvv[2 * ks], dvv[2 * ks + 1]), kfrag = pack8(dkk[2 * ks], dkk[2 * ks + 1]);
#pragma unroll
                    for (int it = 0; it < 4; ++it) { au[it] = __builtin_amdgcn_mfma_f32_16x16x32_bf16(tfp[it][ks], vfrag, au[it], 0, 0, 0);
                                                     ak[it] = __builtin_amdgcn_mfma_f32_16x16x32_bf16(kfrag, tfp[it][ks], ak[it], 0, 0, 0); }
                }
#pragma unroll
                for (int it = 0; it < 4; ++it) {
                    *(unsigned long long*)(U0g + (unsigned)(((nt * 4 + it) * 64 + lane) * 4)) = (unsigned long long)pk2(au[it][0], au[it][1]) | ((unsigned long long)pk2(au[it][2], au[it][3]) << 32);
                    *(unsigned long long*)(KCDg + (unsigned)((16 * it + fr) * 128 + 16 * nt + 4 * fq)) = (unsigned long long)pk2(ak[it][0], ak[it][1]) | ((unsigned long long)pk2(ak[it][2], ak[it][3]) << 32);
                }
            }
        }
    }
    LDS_WAIT();
}

constexpr int GS_KCD = 0, GS_QB = 17408, GS_ATT = 34816, GS_KT = 44032, GS_GC = 62464, GS_BUF = 62720;
DI bf16x8 fragA(const LAS unsigned char* p) { const u32x2 x = *(const volatile LAS u32x2*)p, y = *(const volatile LAS u32x2*)(p + 128);     u32x4 r; r.x = x.x; r.y = x.y; r.z = y.x; r.w = y.y; return __builtin_bit_cast(bf16x8, r); }
DI bf16x8 fragB(const LAS unsigned char* p) { const u32x2 x = *(const volatile LAS u32x2*)p, y = *(const volatile LAS u32x2*)(p + 256); u32x4 r; r.x = x.x; r.y = x.y; r.z = y.x; r.w = y.y; return __builtin_bit_cast(bf16x8, r); }
DI void gdn_scan_wg(const Ctx& c, int li, int bvh) {
    const int vh = bvh & 15, b = bvh >> 4, hq = vh >> 1, lane = c.lane, fr = lane & 15, fq = lane >> 4, w = c.wave, tid = c.tid;
    const bf16_t* KCDg = c.ws<bf16_t>(W_KCD) + (size_t)(bvh * GCH) * 8192; const bf16_t* ATTg = c.ws<bf16_t>(W_ATTG) + (size_t)(bvh * GCH) * 4096;
    const bf16_t* U0g = c.ws<bf16_t>(W_U0) + (size_t)(bvh * GCH) * 8192;
    const bf16_t* QBg = c.ws<bf16_t>(W_ACT) + (size_t)(b * SEQ) * 4096 + hq * 128; const bf16_t* KTg = c.ws<bf16_t>(W_KT) + (size_t)((b * GQH + hq) * GCH) * 8192;
    const float* GCg = c.ws<float>(W_GC); bf16_t* MIX = c.ws<bf16_t>(W_MIXED); const bf16_t* PROJ = c.ws<bf16_t>(W_PROJ);
    LAS float* OT = (LAS float*)(c.lds + 2 * GS_BUF);
    LAS float* nwS = OT + 64 * 132;
    if (tid < GDV) nwS[tid] = c.in(I_GNW)[li * GDV + tid];
#define GS_DMA(tn, bb) do { \
        LAS unsigned char* lb_ = c.lds + (bb) * GS_BUF; \
        _Pragma("unroll") for (int k = 0; k < 2; ++k) { const int p_ = 8 * k + w; \
            __builtin_amdgcn_global_load_lds((const unsigned*)(KCDg + (size_t)(tn) * 8192 + p_ * 512 + srcA), (LAS unsigned*)(lb_ + GS_KCD + p_ * 1088), 16, 0, 0); \
            __builtin_amdgcn_global_load_lds((const unsigned*)(QBg + (size_t)(tn) * (64 * 4096) + p_ * (4 * 4096) + srcQ), (LAS unsigned*)(lb_ + GS_QB + p_ * 1088), 16, 0, 0); \
            __builtin_amdgcn_global_load_lds((const unsigned*)(KTg + (size_t)(tn) * 8192 + p_ * 512 + srcB), (LAS unsigned*)(lb_ + GS_KT + p_ * 1152), 16, 0, 0); } \
        __builtin_amdgcn_global_load_lds((const unsigned*)(ATTg + (size_t)(tn) * 4096 + w * 512 + srcB), (LAS unsigned*)(lb_ + GS_ATT + w * 1152), 16, 0, 0); } while (0)
    const int srcA = (lane & 3) * 128 + 8 * (lane >> 2), srcQ = (lane & 3) * 4096 + 8 * (lane >> 2), srcB = (lane & 7) * 64 + 8 * (lane >> 3);
    const int offA = (fr >> 2) * 1088 + (fr & 3) * 16 + (fq >> 1) * 64 + 8 * (fq & 1), offB = (fr >> 3) * 1152 + (fr & 7) * 16 + (fq >> 1) * 128 + 8 * (fq & 1);
    f32x4 sacc[8];
#pragma unroll
    for (int t = 0; t < 8; ++t) sacc[t] = (f32x4){0.f, 0.f, 0.f, 0.f};
    __syncthreads();
    u32x2 u0n[4];
#pragma unroll
    for (int it = 0; it < 4; ++it) u0n[it] = *(const u32x2*)(U0g + ((size_t)(w * 4 + it) * 64 + lane) * 4);
    GS_DMA(0, 0);
    if (tid < 64) *(LAS float*)(c.lds + GS_GC + 4 * tid) = GCg[(size_t)(b * SEQ + tid) * 16 + vh];
    asm volatile("s_waitcnt vmcnt(0)" ::: "memory");
    __syncthreads();
#pragma unroll 1
    for (int t = 0; t < GCH; ++t) {
        const LAS unsigned char* buf = c.lds + (t & 1) * GS_BUF; LAS unsigned char* nbuf = c.lds + ((t + 1) & 1) * GS_BUF;
        const int tok0 = b * SEQ + t * 64;
        const bool more = t + 1 < GCH;
        u32x2 u0r[4];
#pragma unroll
        for (int it = 0; it < 4; ++it) u0r[it] = u0n[it];
        float gstg = 0.f;
        if (more) {
#pragma unroll
            for (int it = 0; it < 4; ++it) u0n[it] = *(const u32x2*)(U0g + (size_t)(t + 1) * 8192 + ((size_t)(w * 4 + it) * 64 + lane) * 4);
            if (tid < 64) gstg = GCg[(size_t)(tok0 + 64 + tid) * 16 + vh];
            GS_DMA(t + 1, (t + 1) & 1);
        }
        const LAS unsigned char* KCD = buf + GS_KCD; const LAS unsigned char* QB = buf + GS_QB; const LAS unsigned char* ATT = buf + GS_ATT; const LAS unsigned char* KT = buf + GS_KT;
        const LAS float* gcS = (const LAS float*)(buf + GS_GC);
        bf16x8 sfrag[4];
#pragma unroll
        for (int ks = 0; ks < 4; ++ks) sfrag[ks] = pack8(sacc[2 * ks], sacc[2 * ks + 1]);
        const float gl = gcS[63], egl = __expf(gl);
        bf16x8 ufrag[2], udfrag[2]; f32x4 ov[4];
#pragma unroll
        for (int hp = 0; hp < 2; ++hp) {
            f32x4 uu[2];
#pragma unroll
            for (int h2 = 0; h2 < 2; ++h2) {
                const int it = 2 * hp + h2;
                f32x4 ks_ = (f32x4){0.f, 0.f, 0.f, 0.f}, qs_ = (f32x4){0.f, 0.f, 0.f, 0.f};
#pragma unroll
                for (int ks = 0; ks < 4; ++ks) {
                    ks_ = __builtin_amdgcn_mfma_f32_16x16x32_bf16(fragA(KCD + offA + it * 4352 + ks * 256), sfrag[ks], ks_, 0, 0, 0);
                    qs_ = __builtin_amdgcn_mfma_f32_16x16x32_bf16(fragA(QB + offA + it * 4352 + ks * 256), sfrag[ks], qs_, 0, 0, 0);
                }
                const f32x4 gci = *(const LAS f32x4*)(gcS + 16 * it + 4 * fq);
                f32x4 u;
                u[0] = bf2f((bf16_t)(u0r[it].x & 0xffff)) - ks_[0]; u[1] = bf2f((bf16_t)(u0r[it].x >> 16)) - ks_[1]; u[2] = bf2f((bf16_t)(u0r[it].y & 0xffff)) - ks_[2]; u[3] = bf2f((bf16_t)(u0r[it].y >> 16)) - ks_[3];
                uu[h2] = u;
#pragma unroll
                for (int r = 0; r < 4; ++r) ov[it][r] = qs_[r] * __expf(gci[r]);
            }
            ufrag[hp] = pack8(uu[0], uu[1]);
            const f32x4 g0 = *(const LAS f32x4*)(gcS + 32 * hp + 4 * fq), g1 = *(const LAS f32x4*)(gcS + 32 * hp + 16 + 4 * fq);
            f32x4 d0, d1;
#pragma unroll
            for (int r = 0; r < 4; ++r) { d0[r] = uu[0][r] * __expf(gl - g0[r]); d1[r] = uu[1][r] * __expf(gl - g1[r]); }
            udfrag[hp] = pack8(d0, d1);
        }
#pragma unroll
        for (int it = 0; it < 4; ++it) {
            f32x4 au = ov[it];
#pragma unroll
            for (int ks = 0; ks < 2; ++ks) au = __builtin_amdgcn_mfma_f32_16x16x32_bf16(fragB(ATT + offB + it * 2304 + ks * 512), ufrag[ks], au, 0, 0, 0);
#pragma unroll
            for (int r = 0; r < 4; ++r) OT[(16 * it + 4 * fq + r) * 132 + 16 * w + fr] = au[r];
        }
        LDS_WAIT(); __builtin_amdgcn_s_barrier(); asm volatile("" ::: "memory");
        const int frow = tid >> 3, fc = tid & 7;
        const u32x4 zlo = *(const u32x4*)(PROJ + (size_t)(tok0 + frow) * GDN_MAIN + 4096 + vh * 128 + 16 * fc), zhi = *(const u32x4*)(PROJ + (size_t)(tok0 + frow) * GDN_MAIN + 4096 + vh * 128 + 16 * fc + 8);
#pragma unroll
        for (int tt = 0; tt < 8; ++tt) {
            f32x4 a = sacc[tt] * egl;
#pragma unroll
            for (int ks = 0; ks < 2; ++ks) a = __builtin_amdgcn_mfma_f32_16x16x32_bf16(fragB(KT + offB + tt * 2304 + ks * 512), udfrag[ks], a, 0, 0, 0);
            sacc[tt] = a;
        }
        {
            float ov16[16], zf[16];
#pragma unroll
            for (int q4 = 0; q4 < 4; ++q4) { const f32x4 v = *(const LAS f32x4*)(OT + frow * 132 + 16 * fc + 4 * q4); ov16[4 * q4] = v.x; ov16[4 * q4 + 1] = v.y; ov16[4 * q4 + 2] = v.z; ov16[4 * q4 + 3] = v.w; }
            float ss = 0.f;
#pragma unroll
            for (int e = 0; e < 16; ++e) ss += ov16[e] * ov16[e];
            ss += __shfl_xor(ss, 1); ss += __shfl_xor(ss, 2); ss += __shfl_xor(ss, 4);
            const float rn = rsqrtf(ss * (1.f / 128.f) + EPS);
            unpack8(zlo, zf); unpack8(zhi, zf + 8);
            float res[16];
#pragma unroll
            for (int e = 0; e < 16; ++e) res[e] = ov16[e] * rn * nwS[16 * fc + e] * siluf(zf[e]);
            u32x4 o0, o1; o0.x = pk2(res[0], res[1]); o0.y = pk2(res[2], res[3]); o0.z = pk2(res[4], res[5]); o0.w = pk2(res[6], res[7]);
            o1.x = pk2(res[8], res[9]); o1.y = pk2(res[10], res[11]); o1.z = pk2(res[12], res[13]); o1.w = pk2(res[14], res[15]);
            bf16_t* mp = MIX + (size_t)(tok0 + frow) * GVW + vh * 128 + 16 * fc;
            *(u32x4*)mp = o0; *(u32x4*)(mp + 8) = o1;
        }
        if (more && tid < 64) *(LAS float*)(nbuf + GS_GC + 4 * tid) = gstg;
        asm volatile("s_waitcnt vmcnt(0)" ::: "memory");
        __syncthreads();
    }
#undef GS_DMA
    float* so = c.p.out + O_PGS + ((size_t)(li * NB + b) * GH + vh) * GDK * GDV;
#pragma unroll
    for (int tt = 0; tt < 8; ++tt)
#pragma unroll
        for (int r = 0; r < 4; ++r) so[(size_t)(16 * tt + 4 * fq + r) * GDV + 16 * w + fr] = sacc[tt][r];
}

DI void gdn_post_token(const Ctx& c, int li, int tok) {
    const bf16_t* PROJ = c.ws<bf16_t>(W_PROJ); const float* Y = c.ws<float>(W_Y); bf16_t* MIX = c.ws<bf16_t>(W_MIXED);
    const float* nw = c.in(I_GNW) + (size_t)li * GDV; const int lane = c.lane;
#pragma unroll 1
    for (int it = 0; it < 4; ++it) {
        const int ch0 = 512 * it + 8 * lane; float o[8], z[8], w[8];
        load8f(Y + (size_t)tok * 2048 + ch0, o); unpack8(*(const u32x4*)(PROJ + (size_t)tok * GDN_MAIN + 4096 + ch0), z); load8f(nw + (ch0 & 127), w);
        float ss = 0.f;
#pragma unroll
        for (int e = 0; e < 8; ++e) ss += o[e] * o[e];
        ss += __shfl_xor(ss, 1); ss += __shfl_xor(ss, 2); ss += __shfl_xor(ss, 4); ss += __shfl_xor(ss, 8);
        const float r = rsqrtf(ss * (1.f / 128.f) + EPS);
        u32x4 ov; ov.x = pk2(o[0] * r * w[0] * siluf(z[0]), o[1] * r * w[1] * siluf(z[1])); ov.y = pk2(o[2] * r * w[2] * siluf(z[2]), o[3] * r * w[3] * siluf(z[3]));
        ov.z = pk2(o[4] * r * w[4] * siluf(z[4]), o[5] * r * w[5] * siluf(z[5])); ov.w = pk2(o[6] * r * w[6] * siluf(z[6]), o[7] * r * w[7] * siluf(z[7]));
        *(u32x4*)(MIX + (size_t)tok * GVW + ch0) = ov;
    }
}

DI void cache_copy(const Ctx& c, int wg, int nwg) {
    const size_t gt = (size_t)wg * NTHR + c.tid, gn = (size_t)nwg * NTHR;
    const size_t per = (size_t)(WIN - 1) * AW / 4, tot = (size_t)2 * NS * per;
#pragma unroll 4
    for (size_t i = gt; i < tot; i += gn) { const size_t sq = i / per, r = i % per;
        ((f32x4*)(c.p.out + O_SK + sq * WIN * AW))[r] = ((const f32x4*)(c.in(I_CK) + sq * WIN * AW + AW))[r];
        ((f32x4*)(c.p.out + O_SV + sq * WIN * AW))[r] = ((const f32x4*)(c.in(I_CV) + sq * WIN * AW + AW))[r]; }
}
constexpr int PH_PER_LAYER = 10, N_PHASES = 1 + 2 * 10 + 2 * 9;
DI void phase_decode(int ph, int& l, int& sp) {
    int q = ph - 1; l = 0; if (q >= 10) { q -= 10; l = 1; if (q >= 9) { q -= 9; l = 2; if (q >= 10) { q -= 10; l = 3; } } }
    sp = (l & 1) ? (q >= 4 ? q + 1 : q) : q;
}
#ifndef ONLY
#define ONLY -1
#endif
#define EN(x) (ONLY < 0 || ONLY == (x))
DI void run_phase(const Ctx& c, int ph) {
    if (ph == 0) { if (!EN(0)) return;
        for (int i = 0; i < 2; ++i) {
            transpose_mat(c, c.in(I_WHIN) + (size_t)i * D * HYB_IN, D, HYB_IN, c.ws<bf16_t>(W_HIN) + (size_t)i * HYB_IN * D, 0);
            transpose_mat(c, c.in(I_WHOUT) + (size_t)i * HYB_MIX * D, HYB_MIX, D, c.ws<bf16_t>(W_HOUT) + (size_t)i * D * HYB_MIX, 0);
            transpose_mat(c, c.in(I_WGIN) + (size_t)i * D * GDN_IN, D, GDN_IN, c.ws<bf16_t>(W_GIN) + (size_t)i * GDN_IN * D, 0);
            transpose_mat(c, c.in(I_WGOUT) + (size_t)i * GVW * D, GVW, D, c.ws<bf16_t>(W_GOUT) + (size_t)i * D * GVW, 0);
        }
        for (int l = 0; l < 4; ++l) {
            transpose_mat(c, c.in(I_WFG) + (size_t)l * D * FF, D, FF, c.ws<bf16_t>(W_GU) + (size_t)l * 2 * FF * D, 1);
            transpose_mat(c, c.in(I_WFU) + (size_t)l * D * FF, D, FF, c.ws<bf16_t>(W_GU) + (size_t)l * 2 * FF * D, 2);
            transpose_mat(c, c.in(I_WFD) + (size_t)l * FF * D, FF, D, c.ws<bf16_t>(W_DN) + (size_t)l * D * FF, 0);
        }
        rowpass_phase(c, 0, nullptr, c.in(I_NMPRE), true);
        return;
    }
    int l, sp; phase_decode(ph, l, sp); const int li = l >> 1; const bool hyb = (l & 1) == 0;
    bf16_t* H = c.ws<bf16_t>(W_H); bf16_t* PROJ = c.ws<bf16_t>(W_PROJ); bf16_t* MIX = c.ws<bf16_t>(W_MIXED); float* GO = c.ws<float>(W_GO); bf16_t* HID = c.ws<bf16_t>(W_HID);
    switch (sp) {
    case 0: {
        if (!EN(1)) break;
        const bf16_t* Wt = hyb ? c.ws<bf16_t>(W_HIN) + (size_t)li * HYB_IN * D : c.ws<bf16_t>(W_GIN) + (size_t)li * GDN_IN * D;
        const int nmain = hyb ? HYB_MAIN : GDN_MAIN, nall = hyb ? HYB_IN : GDN_IN;
        { pg8::Gemm g{H, Wt, T, nmain, D}; pg8::StaticOrder S; S.init(T, nmain, gridDim.x, blockIdx.x); pg8::EpiBf16Plain E{PROJ, nmain};
          pg8::gemm_phase<pg8::EpiBf16Plain, pg8::StaticOrder>(c.lds, g, S, E, nullptr); }
        { Epi e{0, PROJ, c.ws<float>(W_EXTRA), nmain, 0}; gemm_ksplit<4>(c, H, D, T, Wt + (size_t)nmain * D, D, nall - nmain, D, e); }
        { Epi e{0, PROJ + (size_t)T * nmain, c.ws<float>(W_EXTRA) + (size_t)T * 32, nmain, nmain}; gemm_ksplit<2>(c, H + (size_t)T * D, D, NS, Wt, D, nall, D, e); }
    } break;
    case 1: {
        if (hyb) {
            if (EN(2)) for (int tok = c.gw; tok < TT; tok += c.ngw) hyb_pre_token(c, li, tok);
            LAS float* pl = (LAS float*)(c.lds + NWAVE * AT_LDS + c.wave * 2048);
            if (EN(3)) { if (c.wave == 0) for (int it = T * AH + blockIdx.x; it < TT * AH; it += gridDim.x) attn_wave(c, li, it / AH, it % AH, pl);
                         for (int it = c.gw; it < NB * AH * 256; it += c.ngw) attn_mfma_item(c, li, it); }
        } else { if (EN(4)) { for (int tok = T + c.gw; tok < TT; tok += c.ngw) gdn_pre_token(c, li, tok);
                               for (int it = c.gw; it < (T / 64) * 8; it += c.ngw) gdn_pre_range(c, li, it); } }
    } break;
    case 2: {
        if (hyb) { if (EN(5)) { for (int it = blockIdx.x; it < NB * NCH * 2; it += gridDim.x) ssd_a_item(c, li, it);
                                for (int it = c.gw; it < NS * SH; it += c.ngw) ssd_sample_item(c, li, it); } }
        else if (EN(6)) { gdn_seq_phase(c, li, NB * GH); for (int it = c.gw; it < NB * GH * GCH; it += c.ngw) gdn_a_item(c, li, it); }
    } break;
    case 3: {
        if (hyb) { if (EN(7)) { ssd_scan_phase(c, li); for (int tok = T + c.gw; tok < TT; tok += c.ngw) hyb_post_token(c, li, tok); } }
        else { if (EN(8)) { for (int it = blockIdx.x; it < NB * GH; it += gridDim.x) gdn_scan_wg(c, li, it);
                            if ((int)blockIdx.x >= NB * GH) { for (int tok = T + (blockIdx.x - NB * GH) * NWAVE + c.wave; tok < TT; tok += (gridDim.x - NB * GH) * NWAVE) gdn_post_token(c, li, tok);
                                                              if (l == 1) cache_copy(c, blockIdx.x - NB * GH, gridDim.x - NB * GH); } } }
    } break;
    case 4: {
        if (hyb) { if (EN(14)) for (int it = blockIdx.x; it < NB * NCH * 2; it += gridDim.x) ssd_b_item(c, li, it); }
    } break;
    case 5: {
        if (!EN(9)) break;
        const bf16_t* Wt = hyb ? c.ws<bf16_t>(W_HOUT) + (size_t)li * D * HYB_MIX : c.ws<bf16_t>(W_GOUT) + (size_t)li * D * GVW; const int kk = hyb ? HYB_MIX : GVW;
        { pg8::Gemm g{MIX, Wt, T, D, kk}; pg8::StaticOrder S; S.init(T, D, gridDim.x, blockIdx.x); pg8::EpiF32 E{GO, D, nullptr};
          pg8::gemm_phase<pg8::EpiF32, pg8::StaticOrder>(c.lds, g, S, E, nullptr); }
        { Epi e{1, nullptr, GO + (size_t)T * D, D, 0}; gemm_ksplit<2>(c, MIX + (size_t)T * kk, kk, NS, Wt, kk, D, kk, e); }
    } break;
    case 6: if (EN(10)) rowpass_phase(c, 1, c.in(I_NMPOST) + (size_t)l * D, c.in(I_NFPRE) + (size_t)l * D, l == 0); break;
    case 7: if (EN(11)) { const bf16_t* Wt = c.ws<bf16_t>(W_GU) + (size_t)l * 2 * FF * D;
        { pg8::Gemm g{H, Wt, T, 2 * FF, D}; pg8::StaticOrder S; S.init(T, 2 * FF, gridDim.x, blockIdx.x); pg8::EpiSwiglu E{HID, FF};
          pg8::gemm_phase<pg8::EpiSwiglu, pg8::StaticOrder>(c.lds, g, S, E, nullptr); }
        { Epi e{2, HID + (size_t)T * FF, nullptr, FF, 0}; gemm_ksplit<2>(c, H + (size_t)T * D, D, NS, Wt, D, 2 * FF, D, e); } } break;
    case 8: if (EN(12)) { const bf16_t* Wt = c.ws<bf16_t>(W_DN) + (size_t)l * D * FF;
        { pg8::Gemm g{HID, Wt, T, D, FF}; pg8::StaticOrder S; S.init(T, D, gridDim.x, blockIdx.x); pg8::EpiF32 E{GO, D, nullptr};
          pg8::gemm_phase<pg8::EpiF32, pg8::StaticOrder>(c.lds, g, S, E, nullptr); }
        { Epi e{1, nullptr, GO + (size_t)T * D, D, 0}; gemm_ksplit<2>(c, HID + (size_t)T * FF, FF, NS, Wt, FF, D, FF, e); } } break;
    case 9: if (EN(13)) rowpass_phase(c, l == DEPTH - 1 ? 2 : 1, c.in(I_NFPOST) + (size_t)l * D, l == DEPTH - 1 ? nullptr : c.in(I_NMPRE) + (size_t)(l + 1) * D, false); break;
    default: break;
    }
}

extern __shared__ __attribute__((aligned(16))) unsigned char g_shm[];
__global__ void __launch_bounds__(NTHR, 2) mega(Params p) {
    cg::grid_group grid = cg::this_grid();
    volatile LAS unsigned* bst = (volatile LAS unsigned*)((LAS unsigned char*)g_shm + LDS_BYTES - 16);
    if (threadIdx.x == 0) { bst[0] = 0u; bst[1] = 0u; bst[2] = 0u; bst[3] = 0u; }
    __syncthreads();
    const XcdBarrier xb = xcd_barrier_post((unsigned*)p.ws, bst);
    for (int ph = p.ph_lo; ph < p.ph_hi; ++ph) {
        int tid_ = threadIdx.x; asm volatile("" : "+v"(tid_));
        Ctx c; c.p.kp = (KParams)__builtin_amdgcn_kernarg_segment_ptr(); c.p.out = c.p.kp->out; c.tid = tid_; c.lane = tid_ & 63; c.wave = __builtin_amdgcn_readfirstlane(tid_ >> 6);
        c.gw = blockIdx.x * NWAVE + c.wave; c.ngw = gridDim.x * NWAVE; c.lds = (LAS unsigned char*)g_shm;
        run_phase(c, ph);
#ifdef PROBE_MASK
        { int l_ = 0, sp_ = 0; if (ph > 0) phase_decode(ph, l_, sp_); const int bit = ph == 0 ? 20 : sp_ + 10 * (l_ & 1);
          if ((PROBE_MASK >> bit) & 1) { xcd_barrier(xb); run_phase(c, ph); } }
#endif
        if (ph + 1 < p.ph_hi) { if (ph == p.ph_lo) grid.sync(); else xcd_barrier(xb); }
    }
}

extern "C" void kernel_launch(void* const* d_in, const int* in_sizes, int n_in, void* d_out, int out_size, void* d_ws, size_t ws_size, hipStream_t stream) {
    static int grid = 0;
    if (!grid) {
        int dev = 0, cus = 0, per = 0; hipGetDevice(&dev); hipDeviceGetAttribute(&cus, hipDeviceAttributeMultiprocessorCount, dev);
        hipFuncSetAttribute((const void*)mega, hipFuncAttributeMaxDynamicSharedMemorySize, LDS_BYTES);
        hipOccupancyMaxActiveBlocksPerMultiprocessor(&per, (const void*)mega, NTHR, LDS_BYTES);
        if (n_in != 30 || (size_t)out_size != O_END || ws_size < W_END) fprintf(stderr, "kernel_launch: unexpected shapes n_in %d out %d (want %zu) ws %zu (want %zu)\n", n_in, out_size, (size_t)O_END, ws_size, (size_t)W_END);
        if (per < 1) fprintf(stderr, "kernel_launch: occupancy query says %d blocks per CU\n", per);
        grid = cus;
    }
    hipMemsetAsync(d_ws, 0, 16384, stream);
    Params p{}; for (int i = 0; i < 30; ++i) p.in[i] = (const float*)d_in[i];
    p.out = (float*)d_out; p.ws = (unsigned char*)d_ws; p.ph_lo = 0; p.ph_hi = N_PHASES;
    void* args[] = {&p};
    hipError_t e = hipLaunchCooperativeKernel((const void*)mega, dim3(grid), dim3(NTHR), args, LDS_BYTES, stream);
    if (e != hipSuccess) fprintf(stderr, "kernel_launch: cooperative launch failed: %s\n", hipGetErrorString(e));
}
```

```cpp
#include <hip/hip_runtime.h>
#include <hip/hip_cooperative_groups.h>
#include <cstdio>
#include <cstdint>
namespace cg = cooperative_groups;

#define DI __device__ __forceinline__
#define LAS __attribute__((address_space(3)))
typedef unsigned short bf16_t;
typedef short bf16x8 __attribute__((ext_vector_type(8)));
typedef float f32x4 __attribute__((ext_vector_type(4)));
typedef unsigned u32x2 __attribute__((ext_vector_type(2)));
typedef unsigned u32x4 __attribute__((ext_vector_type(4)));

constexpr int D = 1024, NB = 4, SEQ = 4096, T = NB * SEQ, NS = 32, TT = T + NS, DEPTH = 4;
constexpr int AH = 8, AHD = 64, AW = 512, WIN = 2048;
constexpr int SH = 16, SP = 64, SN = 128, SG = 2, SDI = 1024, SXBC = 1536;
constexpr int HYB_IN = 4112, HYB_MAIN = 4096, HYB_MIX = 1536;
constexpr int GH = 16, GQH = 8, GDK = 128, GDV = 128, GQKV = 4096, GVW = 2048, GDN_IN = 6176, GDN_MAIN = 6144;
constexpr int FF = 2816;
constexpr float EPS = 1e-6f;
constexpr int NTHR = 512, NWAVE = 8, LDS_BYTES = 163840;

enum { I_XP = 0, I_XS, I_CK, I_CV, I_SCONV, I_SSM, I_GCONV, I_GST, I_RELB, I_NMPRE, I_NMPOST, I_NFPRE, I_NFPOST, I_WHIN, I_SCW, I_SCB, I_SDTB, I_SALOG, I_SD, I_SNW,
       I_WHOUT, I_WGIN, I_GCW, I_GDTB, I_GALOG, I_GNW, I_WGOUT, I_WFG, I_WFU, I_WFD };

constexpr size_t O_YP = 0;
constexpr size_t O_YS = O_YP + (size_t)T * D;
constexpr size_t O_PK = O_YS + (size_t)NS * D;
constexpr size_t O_PV = O_PK + (size_t)2 * NB * WIN * AW;
constexpr size_t O_PSC = O_PV + (size_t)2 * NB * WIN * AW;
constexpr size_t O_PSS = O_PSC + (size_t)2 * NB * 3 * SXBC;
constexpr size_t O_PGC = O_PSS + (size_t)2 * NB * SH * SP * SN;
constexpr size_t O_PGS = O_PGC + (size_t)2 * NB * 3 * GQKV;
constexpr size_t O_SK = O_PGS + (size_t)2 * NB * GH * GDK * GDV;
constexpr size_t O_SV = O_SK + (size_t)2 * NS * WIN * AW;
constexpr size_t O_SSC = O_SV + (size_t)2 * NS * WIN * AW;
constexpr size_t O_SSS = O_SSC + (size_t)2 * NS * 3 * SXBC;
constexpr size_t O_SGC = O_SSS + (size_t)2 * NS * SH * SP * SN;
constexpr size_t O_SGS = O_SGC + (size_t)2 * NS * 3 * GQKV;
constexpr size_t O_END = O_SGS + (size_t)2 * NS * GH * GDK * GDV;

constexpr size_t al256(size_t x) { return (x + 255) & ~(size_t)255; }
constexpr size_t W_CTL = 0;
constexpr size_t W_HIN = 65536;
constexpr size_t W_HOUT = al256(W_HIN + (size_t)2 * HYB_IN * D * 2);
constexpr size_t W_GIN = al256(W_HOUT + (size_t)2 * D * HYB_MIX * 2);
constexpr size_t W_GOUT = al256(W_GIN + (size_t)2 * GDN_IN * D * 2);
constexpr size_t W_GU = al256(W_GOUT + (size_t)2 * D * GVW * 2);
constexpr size_t W_DN = al256(W_GU + (size_t)4 * 2 * FF * D * 2);
constexpr size_t W_X = al256(W_DN + (size_t)4 * D * FF * 2);
constexpr size_t W_H = al256(W_X + (size_t)TT * D * 4);
constexpr size_t W_PROJ = al256(W_H + (size_t)TT * D * 2);
constexpr size_t W_EXTRA = al256(W_PROJ + (size_t)TT * GDN_MAIN * 2);
constexpr size_t W_MIXED = al256(W_EXTRA + (size_t)TT * 32 * 4);
constexpr size_t W_GO = al256(W_MIXED + (size_t)TT * GVW * 2);
constexpr size_t W_HID = al256(W_GO + (size_t)TT * D * 4);
constexpr size_t W_ACT = al256(W_HID + (size_t)TT * FF * 2);
constexpr size_t W_AUX = al256(W_ACT + (size_t)TT * 4096 * 4);
constexpr size_t W_Y = al256(W_AUX + (size_t)TT * 32 * 4);
constexpr size_t W_END = al256(W_Y + (size_t)TT * 2048 * 4);

struct Params { const float* in[30]; float* out; unsigned char* ws; int ph_lo, ph_hi; };

DI float bf2f(bf16_t b) { return __uint_as_float(((unsigned)b) << 16); }
DI bf16_t f2bf(float x) { unsigned u = __float_as_uint(x); u += 0x7fffu + ((u >> 16) & 1u); return (bf16_t)(u >> 16); }
typedef float f32x2_ __attribute__((ext_vector_type(2))); typedef __bf16 bf16x2_ __attribute__((ext_vector_type(2)));
DI unsigned pk2(float lo, float hi) { const f32x2_ v = {lo, hi}; return __builtin_bit_cast(unsigned, __builtin_convertvector(v, bf16x2_)); }
DI float wave_sum(float v) {
#pragma unroll
    for (int o = 32; o >= 1; o >>= 1) v += __shfl_xor(v, o);
    return v;
}
DI float wave_max(float v) {
#pragma unroll
    for (int o = 32; o >= 1; o >>= 1) v = fmaxf(v, __shfl_xor(v, o));
    return v;
}
DI float siluf(float x) { return x / (1.f + __expf(-x)); }
DI float sigmoidf_(float x) { return 1.f / (1.f + __expf(-x)); }
DI float softplusf_(float x) { return fmaxf(x, 0.f) + log1pf(__expf(-fabsf(x))); }
#define LDS_WAIT() asm volatile("s_waitcnt lgkmcnt(0)" ::: "memory")
DI bf16x8 lds_frag(const LAS bf16_t* p) { return *(const LAS bf16x8*)p; }
DI bf16x8 lds_frag2(const LAS bf16_t* p0, const LAS bf16_t* p1) {
    const u32x2 a = *(const LAS u32x2*)p0, b = *(const LAS u32x2*)p1; u32x4 r; r.x = a.x; r.y = a.y; r.z = b.x; r.w = b.y; return __builtin_bit_cast(bf16x8, r);
}
DI bf16x8 pack8(const f32x4 a, const f32x4 b) { u32x4 r; r.x = pk2(a.x, a.y); r.y = pk2(a.z, a.w); r.z = pk2(b.x, b.y); r.w = pk2(b.z, b.w); return __builtin_bit_cast(bf16x8, r); }

__device__ const unsigned char c_bucket[3][129] = {
 {0,1,2,3,4,5,6,7,8,9,10,11,12,13,14,15,16,16,16,16,16,16,17,17,17,17,17,17,17,17,18,18,18,18,18,18,18,18,18,18,19,19,19,19,19,19,19,19,19,19,19,19,19,19,20,20,20,20,20,20,20,20,20,20,20,20,20,20,20,20,20,20,20,21,21,21,21,21,21,21,21,21,21,21,21,21,21,21,21,21,21,21,21,21,21,21,21,21,21,22,22,22,22,22,22,22,22,22,22,22,22,22,22,22,22,22,22,22,22,22,22,22,22,22,22,22,22,22,22},
 {0,4,8,12,16,16,17,17,18,18,19,19,19,19,20,20,20,20,20,21,21,21,21,21,21,22,22,22,22,22,22,22,22,22,23,23,23,23,23,23,23,23,23,23,23,23,24,24,24,24,24,24,24,24,24,24,24,24,24,24,24,24,25,25,25,25,25,25,25,25,25,25,25,25,25,25,25,25,25,25,25,25,25,26,26,26,26,26,26,26,26,26,26,26,26,26,26,26,26,26,26,26,26,26,26,26,26,26,26,26,26,26,26,27,27,27,27,27,27,27,27,27,27,27,27,27,27,27,27},
 {0,16,18,19,20,21,21,22,22,23,23,23,24,24,24,24,25,25,25,25,25,26,26,26,26,26,26,26,26,27,27,27,27,27,27,27,27,27,27,28,28,28,28,28,28,28,28,28,28,28,28,28,29,29,29,29,29,29,29,29,29,29,29,29,29,29,29,29,29,29,30,30,30,30,30,30,30,30,30,30,30,30,30,30,30,30,30,30,30,30,30,30,30,30,30,31,31,31,31,31,31,31,31,31,31,31,31,31,31,31,31,31,31,31,31,31,31,31,31,31,31,31,31,31,31,31,31,31,31}};

typedef const Params __attribute__((address_space(4)))* KParams;
struct OutRef { float* out; DI float* operator+(size_t o) const { return out + o; } };
struct PRef { KParams kp; float* out; };
#define XB_TMO      128
#define XB_XCNT(j)  (256  + 64 * (j))
#define XB_XSUB(j)  (1280 + 64 * (j))
#define XB_XGEN(j)  (2304 + 64 * (j))
#define XB_TOP      3328
#define XB_TOPGEN   3392
#define XCD_BAR_WORDS 3456
#define XB_SPIN_CAP (1u << 22)

__device__ __forceinline__ unsigned xb_ld(unsigned* p)              { return __hip_atomic_load(p, __ATOMIC_RELAXED, __HIP_MEMORY_SCOPE_AGENT); }
__device__ __forceinline__ unsigned xb_add(unsigned* p, unsigned v) { return __hip_atomic_fetch_add(p, v, __ATOMIC_RELAXED, __HIP_MEMORY_SCOPE_AGENT); }
__device__ __forceinline__ unsigned xb_xcc_id() { return (unsigned)__builtin_amdgcn_s_getreg((3 << 11) | 20) & 0xFu; }
#define XB_SPIN(cond, bar) do { unsigned _sp = 0; while (cond) { __builtin_amdgcn_s_sleep(1); \
    if ((++_sp & 255u) == 0u) { if (xb_ld(&(bar)[XB_TMO])) break; if (_sp > XB_SPIN_CAP) { atomicAdd(&(bar)[XB_TMO], 1u); break; } } } } while (0)

struct XcdBarrier {
    unsigned* bar; unsigned x;
    volatile LAS unsigned* st;
};

__device__ __forceinline__ XcdBarrier xcd_barrier_post(unsigned* bar, volatile LAS unsigned* st) {
    XcdBarrier b; b.bar = bar; b.x = xb_xcc_id(); b.st = st;
    if (threadIdx.x == 0) (void)xb_add(&bar[XB_XCNT(b.x)], 1u);
    return b;
}
__device__ __forceinline__ void xcd_barrier_complete(unsigned* bar, unsigned x, unsigned& nloc, unsigned& nx) {
    const unsigned G = gridDim.x * gridDim.y * gridDim.z;
    unsigned sum, cnt, mine, sp = 0u;
    for (;;) {
        sum = 0u; cnt = 0u; mine = 0u;
#pragma unroll
        for (unsigned j = 0; j < 16; ++j) { const unsigned c = xb_ld(&bar[XB_XCNT(j)]); sum += c; cnt += (c > 0u) ? 1u : 0u; mine = (j == x) ? c : mine; }
        if (sum == G) break;
        __builtin_amdgcn_s_sleep(1);
        if ((++sp & 255u) == 0u) { if (xb_ld(&bar[XB_TMO])) break; if (sp > XB_SPIN_CAP) { atomicAdd(&bar[XB_TMO], 1u); break; } }
    }
    nloc = mine > 0u ? mine : 1u; nx = cnt > 0u ? cnt : 1u;
}

__device__ __forceinline__ void xcd_barrier(const XcdBarrier& b) {
    asm volatile("s_waitcnt vmcnt(0)" ::: "memory");
    __syncthreads();
    if (threadIdx.x == 0) {
        unsigned* bar = b.bar;
        __builtin_amdgcn_s_waitcnt(0);
        unsigned nloc = b.st[0], nx = b.st[1];
        if (nloc == 0u) { xcd_barrier_complete(bar, b.x, nloc, nx); b.st[0] = nloc; b.st[1] = nx; }
        const unsigned old = xb_add(&bar[XB_XSUB(b.x)], 1u);
        const unsigned gen = old / nloc;
        if (old + 1u == (gen + 1u) * nloc) {
            __builtin_amdgcn_fence(__ATOMIC_RELEASE, "agent");
            asm volatile("s_waitcnt vmcnt(0)" ::: "memory");
            const unsigned og = xb_add(&bar[XB_TOP], 1u);
            const unsigned tg = og / nx;
            if (og + 1u == (tg + 1u) * nx) xb_add(&bar[XB_TOPGEN], 1u);
            else XB_SPIN(xb_ld(&bar[XB_TOPGEN]) == tg, bar);
            __builtin_amdgcn_fence(__ATOMIC_ACQUIRE, "agent");
            xb_add(&bar[XB_XGEN(b.x)], 1u);
            asm volatile("s_waitcnt vmcnt(0)" ::: "memory");
        } else {
            XB_SPIN(xb_ld(&bar[XB_XGEN(b.x)]) == gen, bar);
            __builtin_amdgcn_fence(__ATOMIC_ACQUIRE, "agent");
            asm volatile("s_waitcnt vmcnt(0)" ::: "memory");
        }
    }
    __syncthreads();
}

struct Ctx {
    PRef p; int tid, lane, wave, gw, ngw; LAS unsigned char* lds;
    DI const float* in(int i) const { return p.kp->in[i]; }
    template <class Tp> DI Tp* ws(size_t off) const { return (Tp*)(p.kp->ws + off); }
};

DI int rowmap(int n, int map) { return map == 0 ? n : (32 * (n >> 4) + (n & 15) + (map == 2 ? 16 : 0)); }
DI void transpose_item(const float* W, int K, int N, bf16_t* WT, int map, LAS float* scr, int item, int lane) {
    const int nblk = (N + 31) / 32, kb = item / nblk, nb = item % nblk, k0 = 64 * kb, n0 = 32 * nb;
    float wv[32];
#pragma unroll
    for (int i = 0; i < 32; ++i) { const int kk = 2 * i + (lane >> 5), n = n0 + (lane & 31); wv[i] = n < N ? W[(size_t)(k0 + kk) * N + n] : 0.f; }
#pragma unroll
    for (int i = 0; i < 32; ++i) scr[(2 * i + (lane >> 5)) * 33 + (lane & 31)] = wv[i];
    LDS_WAIT();
    const int c = lane & 7;
#pragma unroll
    for (int j = 0; j < 4; ++j) {
        const int nn = (lane >> 3) + 8 * j, n = n0 + nn; const LAS float* s = scr + (8 * c) * 33 + nn;
        u32x4 o; o.x = pk2(s[0], s[33]); o.y = pk2(s[66], s[99]); o.z = pk2(s[132], s[165]); o.w = pk2(s[198], s[231]);
        if (n < N) *(u32x4*)(WT + (size_t)rowmap(n, map) * K + k0 + 8 * c) = o;
    }
    LDS_WAIT();
}
DI void transpose_mat(const Ctx& c, const float* W, int K, int N, bf16_t* WT, int map) {
    LAS float* scr = (LAS float*)(c.lds + c.wave * 8704);
    const int nit = (K / 64) * ((N + 31) / 32);
    for (int it = c.gw; it < nit; it += c.ngw) transpose_item(W, K, N, WT, map, scr, it, c.lane);
}

DI void rowpass_row(const float* xrow, const bf16_t* gorow, const float* gpost, const float* gnext, float* xdst, bf16_t* hrow, float* yout, int lane) {
    f32x4 x[4]; float ss = 0.f;
    if (gorow) {
        f32x4 g[4];
#pragma unroll
        for (int j = 0; j < 4; ++j) { const u32x2 gv = *(const u32x2*)(gorow + 4 * lane + 256 * j); g[j] = (f32x4){bf2f((bf16_t)(gv.x & 0xffff)), bf2f((bf16_t)(gv.x >> 16)), bf2f((bf16_t)(gv.y & 0xffff)), bf2f((bf16_t)(gv.y >> 16))}; ss += g[j].x * g[j].x + g[j].y * g[j].y + g[j].z * g[j].z + g[j].w * g[j].w; }
        const float r = rsqrtf(wave_sum(ss) * (1.f / D) + EPS);
#pragma unroll
        for (int j = 0; j < 4; ++j) { const f32x4 w = *(const f32x4*)(gpost + 4 * lane + 256 * j); x[j] = *(const f32x4*)(xrow + 4 * lane + 256 * j) + g[j] * r * w; }
    } else {
#pragma unroll
        for (int j = 0; j < 4; ++j) x[j] = *(const f32x4*)(xrow + 4 * lane + 256 * j);
    }
    if (xdst) {
#pragma unroll
        for (int j = 0; j < 4; ++j) *(f32x4*)(xdst + 4 * lane + 256 * j) = x[j];
    }
    if (yout) {
#pragma unroll
        for (int j = 0; j < 4; ++j) *(f32x4*)(yout + 4 * lane + 256 * j) = x[j];
    }
    if (hrow) {
        float s2 = 0.f;
#pragma unroll
        for (int j = 0; j < 4; ++j) s2 += x[j].x * x[j].x + x[j].y * x[j].y + x[j].z * x[j].z + x[j].w * x[j].w;
        const float r2 = rsqrtf(wave_sum(s2) * (1.f / D) + EPS);
#pragma unroll
        for (int j = 0; j < 4; ++j) { const f32x4 w = *(const f32x4*)(gnext + 4 * lane + 256 * j); const f32x4 h = x[j] * r2 * w;
            u32x2 o; o.x = pk2(h.x, h.y); o.y = pk2(h.z, h.w); *(u32x2*)(hrow + 4 * lane + 256 * j) = o; }
    }
}
DI void rowpass_phase(const Ctx& c, int mode, const float* gpost, const float* gnext, bool x_from_input) {
    float* X = c.ws<float>(W_X); const bf16_t* GO = c.ws<bf16_t>(W_GO); bf16_t* H = c.ws<bf16_t>(W_H);
    for (int row = c.gw; row < TT; row += c.ngw) {
        const float* xrow = x_from_input ? (row < T ? c.in(I_XP) + (size_t)row * D : c.in(I_XS) + (size_t)(row - T) * D) : X + (size_t)row * D;
        if (mode == 0) rowpass_row(xrow, nullptr, nullptr, gnext, nullptr, H + (size_t)row * D, nullptr, c.lane);
        else if (mode == 1) rowpass_row(xrow, GO + (size_t)row * D, gpost, gnext, X + (size_t)row * D, H + (size_t)row * D, nullptr, c.lane);
        else rowpass_row(xrow, GO + (size_t)row * D, gpost, nullptr, nullptr, nullptr, c.p.out + (row < T ? O_YP + (size_t)row * D : O_YS + (size_t)(row - T) * D), c.lane);
    }
}

namespace pg8 {
#define PG8_LAS __attribute__((address_space(3)))
typedef unsigned short bf16_t;
typedef short bf16x8 __attribute__((ext_vector_type(8)));
typedef float f32x4 __attribute__((ext_vector_type(4)));
typedef unsigned u32x4 __attribute__((ext_vector_type(4)));
constexpr int BM = 256, BK = 64, HALF = 128, HTB = HALF * BK * 2  , STAGE_BYTES = 8 * HTB, NXCD = 8, WGM = 8;

__host__ __device__ __forceinline__ int lds_byte(int r, int c) { const int st = (r >> 4) * 2 + (c >> 5), rr = r & 15, cc = c & 31, ob = rr * 64 + cc * 2; return st * 1024 + (ob ^ (((ob >> 9) & 1) << 5)); }
__host__ __device__ __forceinline__ void stage_rc(int b, int& R, int& C) { const int st = b / 1024, sb = b % 1024, swz = sb ^ (((sb >> 9) & 1) << 5); R = (st >> 1) * 16 + swz / 64; C = (st & 1) * 32 + (swz % 64) / 2; }
__host__ __device__ __forceinline__ int perm32(int rho) { const int n = rho >> 4, i = rho & 15; return 8 * (i >> 2) + 4 * n + (i & 3); }

struct Unit { int pm, pn; };
struct Gemm { const bf16_t* A; const bf16_t* Bt; int M, N, K; };

struct StaticOrder {
    int nM, nN, nwg, G, c;
    __host__ __device__ void init(int M, int N, int G_, int c_) { nM = M / BM; nN = N / BM; nwg = nM * nN; G = G_; c = c_; }
    __host__ __device__ bool next(int i, Unit& u) const {
        const long L = (long)i * G + c; if (L >= nwg) return false;
        int wgid = (int)L; { const int q = nwg / NXCD, r = nwg % NXCD, xcd = wgid % NXCD, off = wgid / NXCD; wgid = (xcd < r ? xcd * (q + 1) : r * (q + 1) + (xcd - r) * q) + off; }
        const int nig = WGM * nN, gid = wgid / nig, fm = gid * WGM, gsz = (nM - fm) < WGM ? (nM - fm) : WGM;
        u.pm = fm + ((wgid % nig) % gsz); u.pn = (wgid % nig) / gsz; return true;
    }
    __device__ __forceinline__ void a_ready(const Unit&) const {}
    __device__ __forceinline__ void done(const Unit&) const {}
};
__device__ __forceinline__ unsigned cvt_pk_bf16(float lo, float hi) { unsigned r; asm volatile("v_cvt_pk_bf16_f32 %0, %1, %2" : "=v"(r) : "v"(lo), "v"(hi)); return r; }
typedef float f32x2 __attribute__((ext_vector_type(2)));
struct EpiF32 {
    static constexpr bool PERM = false, AFTER_DRAIN = false;
    float* C; int ldc; const float* bias;
    __device__ __forceinline__ void operator()(const f32x4 (&acc)[2][2][4][2], const Unit& u, int wr, int wc, int fr, int fq) const {
        const int row0 = u.pm * BM + wr * 64 + fr, col0 = u.pn * BM + wc * 32 + 4 * fq;
        f32x4 bv[2][2];
#pragma unroll
        for (int bj = 0; bj < 2; ++bj)
#pragma unroll
            for (int n = 0; n < 2; ++n) bv[bj][n] = bias ? *(const f32x4*)(bias + col0 + bj * HALF + n * 16) : (f32x4){0.f, 0.f, 0.f, 0.f};
#pragma unroll
        for (int ai = 0; ai < 2; ++ai)
#pragma unroll
            for (int m = 0; m < 4; ++m) { float* rowp = C + (size_t)(row0 + ai * HALF + m * 16) * ldc + col0;
#pragma unroll
                for (int bj = 0; bj < 2; ++bj)
#pragma unroll
                    for (int n = 0; n < 2; ++n) *(f32x4*)(rowp + bj * HALF + n * 16) = acc[ai][bj][m][n] + bv[bj][n]; }
    }
};
template <class Epi, class Sched, bool STAMP = false>
__device__ __forceinline__ void gemm_phase(PG8_LAS unsigned char* lds, const Gemm g, const Sched& S, const Epi& E, unsigned long long* stamps) {
    int tid_ = threadIdx.x; asm volatile("" : "+v"(tid_));
    const int tid = tid_, wid = __builtin_amdgcn_readfirstlane(tid >> 6), lane = tid & 63, wr = wid >> 2, wc = wid & 3, fr = lane & 15, fq = lane >> 4;
    const int K = g.K, nt = K / BK;
    int ts_lo = 0, ts_hi = 0, nts = 0; const unsigned long long rt_entry = STAMP ? (unsigned long long)wall_clock64() : 0ull;
#define PG8_STAMP() do { if (STAMP && wid == 0 && nts < 64) { const unsigned long long _c = (unsigned long long)clock64(); \
        ts_lo = (lane == nts) ? (int)(unsigned)_c : ts_lo; ts_hi = (lane == nts) ? (int)(unsigned)(_c >> 32) : ts_hi; ++nts; } } while (0)
    PG8_STAMP();
    unsigned voffA[2], voffB[2];
#pragma unroll
    for (int i = 0; i < 2; ++i) { int R, C; stage_rc(tid * 16 + i * 8192, R, C); const int Rb = Epi::PERM ? ((R & ~31) + perm32(R & 31)) : R;
        voffA[i] = (unsigned)(R * K + C) * 2u; voffB[i] = (unsigned)(Rb * K + C) * 2u; }
    const size_t kstep = (size_t)(BK * 2);
    const size_t hstep = (size_t)HALF * K * 2;
    const size_t tstep = 2 * hstep;
    const unsigned ldsw = (unsigned)wid * 1024u;
    const int aoff = lds_byte(wr * 64 + fr, fq * 8), boff = lds_byte(wc * 32 + fr, fq * 8);
#define PG8_SA(b, h) (((b) * 2 + (h)) * HTB)
#define PG8_SB(b, h) ((4 + (b) * 2 + (h)) * HTB)
#define PG8_STAGE(bufoff, gbase, voff) do { _Pragma("unroll") for (int _i = 0; _i < 2; ++_i) \
        __builtin_amdgcn_global_load_lds((const unsigned*)((const char*)(gbase) + (voff)[_i]), (PG8_LAS unsigned*)(lds + (bufoff) + ldsw + _i * 8192), 16, 0, 0); } while (0)
#define PG8_LDA(dst, b, h) do { _Pragma("unroll") for (int m = 0; m < 4; ++m) _Pragma("unroll") for (int k = 0; k < 2; ++k) dst[m][k] = *(const PG8_LAS bf16x8*)(lds + PG8_SA(b, h) + aoff + m * 2048 + k * 1024); } while (0)
#define PG8_LDB(dst, b, h) do { _Pragma("unroll") for (int n = 0; n < 2; ++n) _Pragma("unroll") for (int k = 0; k < 2; ++k) dst[n][k] = *(const PG8_LAS bf16x8*)(lds + PG8_SB(b, h) + boff + n * 2048 + k * 1024); } while (0)
#define PG8_MMA(ai, bj, At, Bt) do { __builtin_amdgcn_s_setprio(1); _Pragma("unroll") for (int m = 0; m < 4; ++m) _Pragma("unroll") for (int n = 0; n < 2; ++n) _Pragma("unroll") for (int k = 0; k < 2; ++k) \
        acc[ai][bj][m][n] = __builtin_amdgcn_mfma_f32_16x16x32_bf16(Bt[n][k], At[m][k], acc[ai][bj][m][n], 0, 0, 0); __builtin_amdgcn_s_setprio(0); } while (0)
#define PG8_WAIT_V(n) asm volatile("s_waitcnt vmcnt(" #n ")" ::: "memory")
#define PG8_WAIT_L(n) asm volatile("s_waitcnt lgkmcnt(" #n ")" ::: "memory")
#define PG8_BAR __builtin_amdgcn_s_barrier()
#define PG8_SCHED __builtin_amdgcn_sched_barrier(0)
    Unit cur, nxt; int ui = 0;
    if (!S.next(0, cur)) return;
    f32x4 acc[2][2][4][2];
#pragma unroll
    for (int a = 0; a < 2; ++a)
#pragma unroll
        for (int b = 0; b < 2; ++b)
#pragma unroll
            for (int m = 0; m < 4; ++m)
#pragma unroll
                for (int n = 0; n < 2; ++n) acc[a][b][m][n] = (f32x4){0.f, 0.f, 0.f, 0.f};
    bf16x8 At[4][2], B0[2][2], B1[2][2];
    const char* cA = (const char*)g.A + (size_t)cur.pm * tstep; const char* cB = (const char*)g.Bt + (size_t)cur.pn * tstep;
    S.a_ready(cur);
    PG8_STAGE(PG8_SB(0, 0), cB, voffB); PG8_STAGE(PG8_SA(0, 0), cA, voffA); PG8_STAGE(PG8_SB(0, 1), cB + hstep, voffB); PG8_STAGE(PG8_SA(0, 1), cA + hstep, voffA);
    if (wr == 1) PG8_BAR;
    PG8_WAIT_V(4); PG8_BAR;
    PG8_STAGE(PG8_SB(1, 0), cB + kstep, voffB); PG8_STAGE(PG8_SA(1, 0), cA + kstep, voffA); PG8_STAGE(PG8_SB(1, 1), cB + hstep + kstep, voffB);
    PG8_WAIT_V(6); PG8_BAR;
    PG8_STAMP();
    for (;;) {
        const bool has_next = S.next(ui + 1, nxt);
        const char* nA = has_next ? (const char*)g.A + (size_t)nxt.pm * tstep : cA; const char* nB = has_next ? (const char*)g.Bt + (size_t)nxt.pn * tstep : cB;
        for (int t = 0; t < nt; t += 2) {
            const bool last = (t == nt - 2);
            const char* a1 = cA + (size_t)(t + 1) * kstep;
            const char* a2 = last ? nA : cA + (size_t)(t + 2) * kstep; const char* b2 = last ? nB : cB + (size_t)(t + 2) * kstep;
            const char* a3 = a2 + kstep; const char* b3 = b2 + kstep;
            if (last && has_next) S.a_ready(nxt);
            PG8_LDB(B0, 0, 0); PG8_SCHED; PG8_LDA(At, 0, 0); PG8_STAGE(PG8_SA(1, 1), a1 + hstep, voffA);
            PG8_WAIT_L(8); PG8_BAR; PG8_WAIT_L(0); PG8_MMA(0, 0, At, B0); PG8_BAR; PG8_SCHED;
            PG8_LDB(B1, 0, 1); PG8_STAGE(PG8_SB(0, 0), b2, voffB);
            PG8_BAR; PG8_WAIT_L(0); PG8_MMA(0, 1, At, B1); PG8_BAR;
            PG8_LDA(At, 0, 1); PG8_STAGE(PG8_SA(0, 0), a2, voffA);
            PG8_BAR; PG8_WAIT_L(0); PG8_MMA(1, 0, At, B0); PG8_BAR; PG8_SCHED;
            PG8_STAGE(PG8_SB(0, 1), b2 + hstep, voffB);
            PG8_WAIT_V(6); PG8_BAR; PG8_MMA(1, 1, At, B1); PG8_BAR;
            PG8_LDB(B0, 1, 0); PG8_SCHED; PG8_LDA(At, 1, 0); PG8_STAGE(PG8_SA(0, 1), a2 + hstep, voffA);
            PG8_WAIT_L(8); PG8_BAR; PG8_WAIT_L(0); PG8_MMA(0, 0, At, B0); PG8_BAR; PG8_SCHED;
            PG8_LDB(B1, 1, 1); PG8_STAGE(PG8_SB(1, 0), b3, voffB);
            PG8_BAR; PG8_WAIT_L(0); PG8_MMA(0, 1, At, B1); PG8_BAR;
            PG8_LDA(At, 1, 1); PG8_STAGE(PG8_SA(1, 0), a3, voffA);
            PG8_BAR; PG8_WAIT_L(0); PG8_MMA(1, 0, At, B0); PG8_BAR; PG8_SCHED;
            PG8_STAGE(PG8_SB(1, 1), b3 + hstep, voffB);
            PG8_WAIT_V(6); PG8_BAR; PG8_MMA(1, 1, At, B1); PG8_BAR;
        }
        PG8_STAMP();
        if constexpr (!Epi::AFTER_DRAIN) { E(acc, cur, wr, wc, fr, fq); S.done(cur); }
        PG8_STAMP();
        if (!has_next) break;
#pragma unroll
        for (int a = 0; a < 2; ++a)
#pragma unroll
            for (int b = 0; b < 2; ++b)
#pragma unroll
                for (int m = 0; m < 4; ++m)
#pragma unroll
                    for (int n = 0; n < 2; ++n) acc[a][b][m][n] = (f32x4){0.f, 0.f, 0.f, 0.f};
        cur = nxt; cA = nA; cB = nB; ++ui;
    }
    PG8_WAIT_V(0);
    if (wr == 0) PG8_BAR;
    PG8_BAR;
    if constexpr (Epi::AFTER_DRAIN) { E.fused(acc, cur, wr, wc, fr, fq, lds, wid, lane); S.done(cur); }
    PG8_STAMP();
    if (STAMP && wid == 0) { stamps[lane] = lane < nts ? (((unsigned long long)(unsigned)ts_hi << 32) | (unsigned)ts_lo) : 0ull;
        if (lane == 62) stamps[62] = rt_entry; if (lane == 63) stamps[63] = (unsigned long long)wall_clock64(); }
#undef PG8_STAMP
#undef PG8_SA
#undef PG8_SB
#undef PG8_STAGE
#undef PG8_LDA
#undef PG8_LDB
#undef PG8_MMA
#undef PG8_WAIT_V
#undef PG8_WAIT_L
#undef PG8_BAR
#undef PG8_SCHED
}
}

namespace pg8 {
struct EpiBf16Plain {
    static constexpr bool PERM = false, AFTER_DRAIN = false;
    bf16_t* O; int ldc;
    __device__ __forceinline__ void operator()(const f32x4 (&acc)[2][2][4][2], const Unit& u, int wr, int wc, int fr, int fq) const {
        const int row0 = u.pm * BM + wr * 64 + fr, col0 = u.pn * BM + wc * 32 + 4 * fq;
#pragma unroll
        for (int ai = 0; ai < 2; ++ai)
#pragma unroll
            for (int m = 0; m < 4; ++m) { bf16_t* rowp = O + (size_t)(row0 + ai * HALF + m * 16) * ldc + col0;
#pragma unroll
                for (int bj = 0; bj < 2; ++bj)
#pragma unroll
                    for (int n = 0; n < 2; ++n) { const f32x4 v = acc[ai][bj][m][n]; unsigned long long w = (unsigned long long)cvt_pk_bf16(v[0], v[1]) | ((unsigned long long)cvt_pk_bf16(v[2], v[3]) << 32);
                        *(unsigned long long*)(rowp + bj * HALF + n * 16) = w; } }
    }
};
struct EpiBf16Perm {
    static constexpr bool PERM = true, AFTER_DRAIN = false;
    bf16_t* O; int ldc;
    __device__ __forceinline__ void operator()(const f32x4 (&acc)[2][2][4][2], const Unit& u, int wr, int wc, int fr, int fq) const {
        const int row0 = u.pm * BM + wr * 64 + fr, col0 = u.pn * BM + wc * 32 + 8 * fq;
#pragma unroll
        for (int ai = 0; ai < 2; ++ai)
#pragma unroll
            for (int m = 0; m < 4; ++m) { bf16_t* rowp = O + (size_t)(row0 + ai * HALF + m * 16) * ldc + col0;
#pragma unroll
                for (int bj = 0; bj < 2; ++bj) { const f32x4 v0 = acc[ai][bj][m][0], v1 = acc[ai][bj][m][1]; u32x4 w;
                    w.x = cvt_pk_bf16(v0[0], v0[1]); w.y = cvt_pk_bf16(v0[2], v0[3]); w.z = cvt_pk_bf16(v1[0], v1[1]); w.w = cvt_pk_bf16(v1[2], v1[3]);
                    *(u32x4*)(rowp + bj * HALF) = w; } }
    }
};
struct EpiSwiglu {
    static constexpr bool PERM = false, AFTER_DRAIN = false;
    bf16_t* O; int ldc;
    __device__ __forceinline__ void operator()(const f32x4 (&acc)[2][2][4][2], const Unit& u, int wr, int wc, int fr, int fq) const {
        const int row0 = u.pm * BM + wr * 64 + fr, col0 = u.pn * (BM / 2) + wc * 16 + 4 * fq;
#pragma unroll
        for (int ai = 0; ai < 2; ++ai)
#pragma unroll
            for (int m = 0; m < 4; ++m) { bf16_t* rowp = O + (size_t)(row0 + ai * HALF + m * 16) * ldc + col0;
#pragma unroll
                for (int bj = 0; bj < 2; ++bj) { const f32x4 g = acc[ai][bj][m][0], up = acc[ai][bj][m][1]; float h[4];
#pragma unroll
                    for (int e = 0; e < 4; ++e) h[e] = g[e] / (1.f + __expf(-g[e])) * up[e];
                    unsigned long long w = (unsigned long long)cvt_pk_bf16(h[0], h[1]) | ((unsigned long long)cvt_pk_bf16(h[2], h[3]) << 32);
                    *(unsigned long long*)(rowp + bj * (HALF / 2)) = w; } }
    }
};
}

struct Epi { int mode; bf16_t* ob; float* of; int ldo; int main_cols; };
DI void gemm_simple(const Ctx& c, const bf16_t* A, int lda, int M, const bf16_t* Bt, int ldb, int N, int K, const Epi e) {
    const int mblk = (M + 63) / 64, nblk = (N + 31) / 32, nit = mblk * nblk;
    const int fr = c.lane & 15, fq = c.lane >> 4;
    for (int it = c.gw; it < nit; it += c.ngw) {
        const int mb = it / nblk, nb = it % nblk, m0 = mb * 64, n0 = nb * 32;
        const bf16_t* ap[4]; const bf16_t* bp[2];
#pragma unroll
        for (int m = 0; m < 4; ++m) { int r = m0 + 16 * m + fr; r = r < M ? r : M - 1; ap[m] = A + (size_t)r * lda + 8 * fq; }
#pragma unroll
        for (int n = 0; n < 2; ++n) { int r = n0 + 16 * n + fr; r = r < N ? r : N - 1; bp[n] = Bt + (size_t)r * ldb + 8 * fq; }
        f32x4 acc[4][2];
#pragma unroll
        for (int m = 0; m < 4; ++m)
#pragma unroll
            for (int n = 0; n < 2; ++n) acc[m][n] = (f32x4){0.f, 0.f, 0.f, 0.f};
#pragma unroll 2
        for (int k0 = 0; k0 < K; k0 += 32) {
            bf16x8 a[4], b[2];
#pragma unroll
            for (int m = 0; m < 4; ++m) a[m] = *(const bf16x8*)(ap[m] + k0);
#pragma unroll
            for (int n = 0; n < 2; ++n) b[n] = *(const bf16x8*)(bp[n] + k0);
#pragma unroll
            for (int m = 0; m < 4; ++m)
#pragma unroll
                for (int n = 0; n < 2; ++n) acc[m][n] = __builtin_amdgcn_mfma_f32_16x16x32_bf16(b[n], a[m], acc[m][n], 0, 0, 0);
        }
#pragma unroll
        for (int m = 0; m < 4; ++m) {
            const int row = m0 + 16 * m + fr; if (row >= M) continue;
            if (e.mode == 2) {
                const f32x4 g = acc[m][0], u = acc[m][1]; u32x2 o;
                o.x = pk2(siluf(g.x) * u.x, siluf(g.y) * u.y); o.y = pk2(siluf(g.z) * u.z, siluf(g.w) * u.w);
                *(u32x2*)(e.ob + (size_t)row * e.ldo + 16 * nb + 4 * fq) = o;
            } else {
#pragma unroll
                for (int n = 0; n < 2; ++n) {
                    const int col = n0 + 16 * n + 4 * fq; if (col >= N) continue;
                    const f32x4 v = acc[m][n];
                    if (e.mode == 1) *(f32x4*)(e.of + (size_t)row * e.ldo + col) = v;
                    else if (col < e.main_cols) { u32x2 o; o.x = pk2(v.x, v.y); o.y = pk2(v.z, v.w); *(u32x2*)(e.ob + (size_t)row * e.ldo + col) = o; }
                    else *(f32x4*)(e.of + (size_t)row * 32 + (col - e.main_cols)) = v;
                }
            }
        }
    }
}

DI void attn_wave(const Ctx& c, int li, int tok, int h, LAS float* pl  ) {
    const bf16_t* PROJ = c.ws<bf16_t>(W_PROJ); bf16_t* MIX = c.ws<bf16_t>(W_MIXED);
    const int lane = c.lane; const bool smp = tok >= T;
    const int b = smp ? tok - T : tok / SEQ, s = smp ? WIN : tok % SEQ;
    const float* ck = c.in(I_CK) + ((size_t)(li * NS + b) * WIN) * AW + h * AHD;
    const float* cv = c.in(I_CV) + ((size_t)(li * NS + b) * WIN) * AW + h * AHD;
    const bf16_t* prow0 = smp ? PROJ + (size_t)tok * HYB_MAIN : PROJ + (size_t)(b * SEQ) * HYB_MAIN;
    float q[64];
    { const bf16_t* qp = PROJ + (size_t)tok * HYB_MAIN + h * AHD;
#pragma unroll
      for (int j = 0; j < 8; ++j) { const u32x4 v = *(const u32x4*)(qp + 8 * j);
          q[8*j+0] = bf2f((bf16_t)(v.x & 0xffff)) * 0.125f; q[8*j+1] = bf2f((bf16_t)(v.x >> 16)) * 0.125f; q[8*j+2] = bf2f((bf16_t)(v.y & 0xffff)) * 0.125f; q[8*j+3] = bf2f((bf16_t)(v.y >> 16)) * 0.125f;
          q[8*j+4] = bf2f((bf16_t)(v.z & 0xffff)) * 0.125f; q[8*j+5] = bf2f((bf16_t)(v.z >> 16)) * 0.125f; q[8*j+6] = bf2f((bf16_t)(v.w & 0xffff)) * 0.125f; q[8*j+7] = bf2f((bf16_t)(v.w >> 16)) * 0.125f; } }
    const float* relb = c.in(I_RELB);
    float mx = -1e30f;
#pragma unroll 1
    for (int pat = 0; pat < 3; ++pat) {
        const int d = pat == 0 ? 1 : (pat == 1 ? 4 : 16);
#pragma unroll
        for (int rnd = 0; rnd < 3; ++rnd) {
            const int j = rnd * 64 + lane; float lg = -1e30f;
            if (j <= 128) {
                const int R = s - j * d;
                if (R >= 0) {
                    float acc = 0.f;
                    if (smp && R < WIN) { const float* kp = ck + (size_t)R * AW;
#pragma unroll
                        for (int e = 0; e < 16; ++e) { const f32x4 v = *(const f32x4*)(kp + 4 * e); acc += q[4*e] * v.x + q[4*e+1] * v.y + q[4*e+2] * v.z + q[4*e+3] * v.w; }
                    } else { const bf16_t* kp = (smp ? prow0 : prow0 + (size_t)R * HYB_MAIN) + AW + h * AHD;
#pragma unroll
                        for (int e = 0; e < 8; ++e) { const u32x4 v = *(const u32x4*)(kp + 8 * e);
                            acc += q[8*e] * bf2f((bf16_t)(v.x & 0xffff)) + q[8*e+1] * bf2f((bf16_t)(v.x >> 16)) + q[8*e+2] * bf2f((bf16_t)(v.y & 0xffff)) + q[8*e+3] * bf2f((bf16_t)(v.y >> 16))
                                 + q[8*e+4] * bf2f((bf16_t)(v.z & 0xffff)) + q[8*e+5] * bf2f((bf16_t)(v.z >> 16)) + q[8*e+6] * bf2f((bf16_t)(v.w & 0xffff)) + q[8*e+7] * bf2f((bf16_t)(v.w >> 16)); }
                    }
                    lg = acc + relb[c_bucket[pat][j] * AH + h];
                }
                pl[pat * 132 + j] = lg;
            }
            mx = fmaxf(mx, lg);
        }
    }
    mx = wave_max(mx);
    LDS_WAIT();
    float ssum = 0.f;
#pragma unroll 1
    for (int i = lane; i < 396; i += 64) { const int pat = i / 132, j = i % 132; if (j <= 128) { const float lg = pl[i]; const float pv = lg > -1e29f ? __expf(lg - mx) : 0.f; pl[i] = pv; ssum += pv; } }
    ssum = wave_sum(ssum);
    LDS_WAIT();
    {
        const int kg = lane >> 4, dc = lane & 15;
        f32x4 o4 = (f32x4){0.f, 0.f, 0.f, 0.f};
        if (smp) {
#pragma unroll 1
            for (int pat = 0; pat < 3; ++pat) {
                const int d = pat == 0 ? 1 : (pat == 1 ? 4 : 16);
                if (kg == 0) { const u32x2 vv = *(const u32x2*)(prow0 + 2 * AW + h * AHD + 4 * dc); const float pv = pl[pat * 132];
                    o4.x += pv * bf2f((bf16_t)(vv.x & 0xffff)); o4.y += pv * bf2f((bf16_t)(vv.x >> 16)); o4.z += pv * bf2f((bf16_t)(vv.y & 0xffff)); o4.w += pv * bf2f((bf16_t)(vv.y >> 16)); }
#pragma unroll 16
                for (int i4 = 0; i4 < 32; ++i4) { const int j = 1 + 4 * i4 + kg; const f32x4 vv = *(const f32x4*)(cv + (size_t)(WIN - j * d) * AW + 4 * dc); o4 += vv * pl[pat * 132 + j]; }
            }
        } else {
#pragma unroll 1
            for (int pat = 0; pat < 3; ++pat) {
                const int d = pat == 0 ? 1 : (pat == 1 ? 4 : 16);
                int jmax = s / d; jmax = jmax > 128 ? 128 : jmax;
#pragma unroll 4
                for (int j = kg; j <= jmax; j += 4) { const u32x2 vv = *(const u32x2*)(prow0 + (size_t)(s - j * d) * HYB_MAIN + 2 * AW + h * AHD + 4 * dc); const float pv = pl[pat * 132 + j];
                    o4.x += pv * bf2f((bf16_t)(vv.x & 0xffff)); o4.y += pv * bf2f((bf16_t)(vv.x >> 16)); o4.z += pv * bf2f((bf16_t)(vv.y & 0xffff)); o4.w += pv * bf2f((bf16_t)(vv.y >> 16)); }
            }
        }
#pragma unroll
        for (int e = 0; e < 4; ++e) { o4[e] += __shfl_xor(o4[e], 16); o4[e] += __shfl_xor(o4[e], 32); }
        const float inv = 1.f / ssum;
        if (kg == 0) { u32x2 o; o.x = pk2(o4.x * inv, o4.y * inv); o.y = pk2(o4.z * inv, o4.w * inv); *(u32x2*)(MIX + (size_t)tok * HYB_MIX + h * AHD + 4 * dc) = o; }
    }
    LDS_WAIT();
}

template <int MT>
DI void gemm_ksplit(const Ctx& c, const bf16_t* A, int lda, int M, const bf16_t* Bt, int ldb, int N, int K, const Epi e) {
    const int mblk = (M + 16 * MT - 1) / (16 * MT), nblk = (N + 31) / 32, nit = mblk * nblk;
    const int fr = c.lane & 15, fq = c.lane >> 4, kslice = K / 8, klo = c.wave * kslice;
    LAS float* part = (LAS float*)c.lds;
    for (int it = blockIdx.x; it < nit; it += gridDim.x) {
        const int mb = it / nblk, nb = it % nblk, m0 = mb * 16 * MT, n0 = nb * 32;
        const bf16_t* ap[MT]; const bf16_t* bp[2];
#pragma unroll
        for (int m = 0; m < MT; ++m) { int r = m0 + 16 * m + fr; r = r < M ? r : M - 1; ap[m] = A + (size_t)r * lda + klo + 8 * fq; }
#pragma unroll
        for (int n = 0; n < 2; ++n) { int r = n0 + 16 * n + fr; r = r < N ? r : N - 1; bp[n] = Bt + (size_t)r * ldb + klo + 8 * fq; }
        f32x4 acc[MT][2];
#pragma unroll
        for (int m = 0; m < MT; ++m)
#pragma unroll
            for (int n = 0; n < 2; ++n) acc[m][n] = (f32x4){0.f, 0.f, 0.f, 0.f};
#pragma unroll 2
        for (int k0 = 0; k0 < kslice; k0 += 32) {
            bf16x8 a[MT], b[2];
#pragma unroll
            for (int m = 0; m < MT; ++m) a[m] = *(const bf16x8*)(ap[m] + k0);
#pragma unroll
            for (int n = 0; n < 2; ++n) b[n] = *(const bf16x8*)(bp[n] + k0);
#pragma unroll
            for (int m = 0; m < MT; ++m)
#pragma unroll
                for (int n = 0; n < 2; ++n) acc[m][n] = __builtin_amdgcn_mfma_f32_16x16x32_bf16(b[n], a[m], acc[m][n], 0, 0, 0);
        }
        __syncthreads();
#pragma unroll
        for (int m = 0; m < MT; ++m)
#pragma unroll
            for (int n = 0; n < 2; ++n) *(LAS f32x4*)(part + ((c.wave * (MT * 2) + m * 2 + n) * 64 + c.lane) * 4) = acc[m][n];
        __syncthreads();
        if (c.wave < MT) {
            const int m = c.wave; f32x4 v[2];
#pragma unroll
            for (int n = 0; n < 2; ++n) { v[n] = (f32x4){0.f, 0.f, 0.f, 0.f};
#pragma unroll
                for (int w = 0; w < 8; ++w) v[n] += *(const LAS f32x4*)(part + ((w * (MT * 2) + m * 2 + n) * 64 + c.lane) * 4); }
            const int row = m0 + 16 * m + fr;
            if (row < M) {
                if (e.mode == 2) {
                    const f32x4 g = v[0], u = v[1]; u32x2 o;
                    o.x = pk2(siluf(g.x) * u.x, siluf(g.y) * u.y); o.y = pk2(siluf(g.z) * u.z, siluf(g.w) * u.w);
                    *(u32x2*)(e.ob + (size_t)row * e.ldo + 16 * nb + 4 * fq) = o;
                } else {
#pragma unroll
                    for (int n = 0; n < 2; ++n) {
                        const int col = n0 + 16 * n + 4 * fq; if (col >= N) continue;
                        if (e.mode == 1) *(f32x4*)(e.of + (size_t)row * e.ldo + col) = v[n];
                        else if (col < e.main_cols) { u32x2 o; o.x = pk2(v[n].x, v[n].y); o.y = pk2(v[n].z, v[n].w); *(u32x2*)(e.ob + (size_t)row * e.ldo + col) = o; }
                        else *(f32x4*)(e.of + (size_t)row * 32 + (col - e.main_cols)) = v[n];
                    }
                }
            }
        }
    }
    __syncthreads();
}

constexpr int AT_LDS = 1600;
struct AtStep { int d, u, kb; const LAS float* tbp; };
DI AtStep at_step(int g, const LAS float* tb) {
    AtStep s;
    if (g < 12) { s.d = 1; s.u = 16; s.kb = -143 + 32 * g; s.tbp = tb; }
    else if (g < 18) { s.d = 4; s.u = 4; s.kb = -131 + 32 * (g - 12); s.tbp = tb + 132; }
    else if (g < 23) { s.d = 16; s.u = 1; s.kb = -144 + 32 * (g - 18); s.tbp = tb + 264; }
    else { s.d = 1; s.u = 0; s.kb = 100000; s.tbp = tb; }
    return s;
}
struct AtBuf { bf16x8 k[2][2]; bf16x8 v[2][2]; };
DI void at_load(AtBuf& bf, const bf16_t* qrow0, int P0, const AtStep st, int fr, int fq) {
#pragma unroll
    for (int kt = 0; kt < 2; ++kt) {
        int pos = P0 + st.d * (st.kb + 16 * kt + fr); pos = pos < 0 ? 0 : (pos > SEQ - 1 ? SEQ - 1 : pos);
        const bf16_t* rp = qrow0 + (size_t)pos * HYB_MAIN + 8 * fq;
        bf.k[kt][0] = *(const bf16x8*)(rp + AW); bf.k[kt][1] = *(const bf16x8*)(rp + AW + 32);
        bf.v[kt][0] = *(const bf16x8*)(rp + 2 * AW); bf.v[kt][1] = *(const bf16x8*)(rp + 2 * AW + 32);
    }
}
DI void attn_mfma_item(const Ctx& c, int li, int item) {
    const bf16_t* PROJ = c.ws<bf16_t>(W_PROJ); bf16_t* MIX = c.ws<bf16_t>(W_MIXED);
    int lane_ = c.lane; asm volatile("" : "+v"(lane_));
    const int lane = lane_, fr = lane & 15, fq = lane >> 4;
    const int qb = item & 255, h = (item >> 8) & 7, b = item >> 11, P0 = (qb >> 4) * 256 + (qb & 15);
    LAS float* tb = (LAS float*)(c.lds + c.wave * AT_LDS);
    { const float* relb = c.in(I_RELB);
#pragma unroll 1
      for (int i = lane; i < 396; i += 64) { const int pat = i / 132, j = i % 132; tb[i] = j <= 128 ? relb[c_bucket[pat][j] * AH + h] : 0.f; } }
    const bf16_t* qrow0 = PROJ + (size_t)(b * SEQ) * HYB_MAIN + h * AHD;
    bf16x8 qf[2], idf[2];
#pragma unroll
    for (int kd = 0; kd < 2; ++kd) qf[kd] = *(const bf16x8*)(qrow0 + (size_t)(P0 + 16 * fr) * HYB_MAIN + 32 * kd + 8 * fq);
#pragma unroll
    for (int hs = 0; hs < 2; ++hs)
#pragma unroll
        for (int e = 0; e < 8; ++e) idf[hs][e] = (8 * fq + e) == (16 * hs + fr) ? (short)0x3F80 : (short)0;
    float m = -1e30f, lsum = 0.f;
    f32x4 O[4];
#pragma unroll
    for (int dt = 0; dt < 4; ++dt) O[dt] = (f32x4){0.f, 0.f, 0.f, 0.f};
    AtBuf b0, b1, b2;
    at_load(b0, qrow0, P0, at_step(0, tb), fr, fq); at_load(b1, qrow0, P0, at_step(1, tb), fr, fq); at_load(b2, qrow0, P0, at_step(2, tb), fr, fq);
    LDS_WAIT();
#define AT_STEP(bf, g) do { \
        const AtStep st = at_step((g), tb); const int qi = st.u * fr; \
        f32x4 sc[2]; \
        _Pragma("unroll") for (int kt = 0; kt < 2; ++kt) { sc[kt] = (f32x4){0.f, 0.f, 0.f, 0.f}; \
            _Pragma("unroll") for (int kd = 0; kd < 2; ++kd) sc[kt] = __builtin_amdgcn_mfma_f32_16x16x32_bf16(bf.k[kt][kd], qf[kd], sc[kt], 0, 0, 0); } \
        f32x4 dv[2][4]; \
        _Pragma("unroll") for (int kt = 0; kt < 2; ++kt) _Pragma("unroll") for (int dt = 0; dt < 4; ++dt) \
            dv[kt][dt] = __builtin_amdgcn_mfma_f32_16x16x32_bf16(bf.v[kt][dt >> 1], idf[dt & 1], (f32x4){0.f, 0.f, 0.f, 0.f}, 0, 0, 0);     \
        const AtStep nx = at_step((g) + 3, tb); at_load(bf, qrow0, P0, nx, fr, fq);     \
        float tmax = -1e30f; bool ok[2][4]; \
        _Pragma("unroll") for (int kt = 0; kt < 2; ++kt) _Pragma("unroll") for (int r = 0; r < 4; ++r) { \
            const int kk = st.kb + 16 * kt + 4 * fq + r, dist = qi - kk; const bool v = dist >= 0 && dist <= 128 && (P0 + st.d * kk) >= 0; ok[kt][r] = v; \
            const int di = dist < 0 ? 0 : (dist > 128 ? 128 : dist); const float bias = *(const volatile LAS float*)(st.tbp + di);     \
            const float lg = v ? sc[kt][r] * 0.125f + bias : -1e30f; sc[kt][r] = lg; tmax = fmaxf(tmax, lg); } \
        tmax = fmaxf(tmax, __shfl_xor(tmax, 16)); tmax = fmaxf(tmax, __shfl_xor(tmax, 32)); \
        const float mn = fmaxf(m, tmax), alpha = __expf(m - mn); m = mn; \
        float ps = 0.f; \
        _Pragma("unroll") for (int kt = 0; kt < 2; ++kt) _Pragma("unroll") for (int r = 0; r < 4; ++r) { const float pv = ok[kt][r] ? __expf(sc[kt][r] - mn) : 0.f; sc[kt][r] = pv; ps += pv; } \
        lsum = lsum * alpha + ps; \
        const bf16x8 pfrag = pack8(sc[0], sc[1]); \
        _Pragma("unroll") for (int dt = 0; dt < 4; ++dt) O[dt] = __builtin_amdgcn_mfma_f32_16x16x32_bf16(pack8(dv[0][dt], dv[1][dt]), pfrag, O[dt] * alpha, 0, 0, 0); } while (0)
#pragma unroll 1
    for (int g = 0; g < 24; g += 3) { AT_STEP(b0, g); AT_STEP(b1, g + 1); AT_STEP(b2, g + 2); }
#undef AT_STEP
    lsum += __shfl_xor(lsum, 16); lsum += __shfl_xor(lsum, 32);
    const float inv = 1.f / lsum;
    bf16_t* orow = MIX + (size_t)(b * SEQ + P0 + 16 * fr) * HYB_MIX + h * AHD;
#pragma unroll
    for (int dt = 0; dt < 4; ++dt) { u32x2 o; o.x = pk2(O[dt][0] * inv, O[dt][1] * inv); o.y = pk2(O[dt][2] * inv, O[dt][3] * inv); *(u32x2*)(orow + 16 * dt + 4 * fq) = o; }
    LDS_WAIT();
}

DI void unpack8(const u32x4 v, float* f) {
    f[0] = bf2f((bf16_t)(v.x & 0xffff)); f[1] = bf2f((bf16_t)(v.x >> 16)); f[2] = bf2f((bf16_t)(v.y & 0xffff)); f[3] = bf2f((bf16_t)(v.y >> 16));
    f[4] = bf2f((bf16_t)(v.z & 0xffff)); f[5] = bf2f((bf16_t)(v.z >> 16)); f[6] = bf2f((bf16_t)(v.w & 0xffff)); f[7] = bf2f((bf16_t)(v.w >> 16));
}
DI void load8f(const float* p, float* f) { const f32x4 a = *(const f32x4*)p, b = *(const f32x4*)(p + 4); f[0] = a.x; f[1] = a.y; f[2] = a.z; f[3] = a.w; f[4] = b.x; f[5] = b.y; f[6] = b.z; f[7] = b.w; }
DI void store8f(float* p, const float* f) { *(f32x4*)p = (f32x4){f[0], f[1], f[2], f[3]}; *(f32x4*)(p + 4) = (f32x4){f[4], f[5], f[6], f[7]}; }
DI void conv8(const bf16_t* prow, int ld, const float* st, int nch, const float* cw, int ch0, bool smp, int s, float* x1, float* x2, float* x3, float* y) {
    float x0[8], w[8];
    unpack8(*(const u32x4*)(prow + ch0), x3);
    if (smp) { load8f(st + ch0, x0); load8f(st + nch + ch0, x1); load8f(st + 2 * nch + ch0, x2); }
    else {
        const u32x4 z = (u32x4){0u, 0u, 0u, 0u};
        unpack8(s >= 1 ? *(const u32x4*)(prow + ch0 - ld) : z, x2); unpack8(s >= 2 ? *(const u32x4*)(prow + ch0 - 2 * ld) : z, x1); unpack8(s >= 3 ? *(const u32x4*)(prow + ch0 - 3 * ld) : z, x0);
    }
    load8f(cw + ch0, w);
#pragma unroll
    for (int e = 0; e < 8; ++e) y[e] = x0[e] * w[e];
    load8f(cw + nch + ch0, w);
#pragma unroll
    for (int e = 0; e < 8; ++e) y[e] += x1[e] * w[e];
    load8f(cw + 2 * nch + ch0, w);
#pragma unroll
    for (int e = 0; e < 8; ++e) y[e] += x2[e] * w[e];
    load8f(cw + 3 * nch + ch0, w);
#pragma unroll
    for (int e = 0; e < 8; ++e) y[e] += x3[e] * w[e];
}
DI void hyb_pre_token(const Ctx& c, int li, int tok) {
    const bf16_t* PROJ = c.ws<bf16_t>(W_PROJ); float* ACT = c.ws<float>(W_ACT); float* AUX = c.ws<float>(W_AUX); const float* EX = c.ws<float>(W_EXTRA);
    const int lane = c.lane; const bool smp = tok >= T; const int b = smp ? tok - T : tok / SEQ, s = smp ? 0 : tok % SEQ;
    const float* cw = c.in(I_SCW) + (size_t)li * 4 * SXBC; const float* cb = c.in(I_SCB) + (size_t)li * SXBC;
    const float* st = c.in(I_SCONV) + (size_t)(li * NS + b) * 3 * SXBC;
    const bf16_t* prow = PROJ + (size_t)tok * HYB_MAIN + 2560;
#pragma unroll 1
    for (int it = 0; it < 3; ++it) {
        const int ch0 = 512 * it + 8 * lane; float x1[8], x2[8], x3[8], y[8], bb[8];
        conv8(prow, HYB_MAIN, st, SXBC, cw, ch0, smp, s, x1, x2, x3, y);
        load8f(cb + ch0, bb);
#pragma unroll
        for (int e = 0; e < 8; ++e) y[e] = siluf(y[e] + bb[e]);
        store8f(ACT + (size_t)tok * 4096 + ch0, y);
        if (smp) { float* o = c.p.out + O_SSC + (size_t)(li * NS + b) * 3 * SXBC + ch0; store8f(o, x1); store8f(o + SXBC, x2); store8f(o + 2 * SXBC, x3); }
        else if (s >= SEQ - 3) store8f(c.p.out + O_PSC + ((size_t)(li * NB + b) * 3 + (s - (SEQ - 3))) * SXBC + ch0, x3);
    }
    if (lane < SH) AUX[(size_t)tok * 32 + lane] = softplusf_(EX[(size_t)tok * 32 + lane] + c.in(I_SDTB)[li * SH + lane]);
    if (smp || s >= SEQ - WIN) {
        float* ok = smp ? c.p.out + O_SK + ((size_t)(li * NS + b) * WIN + (WIN - 1)) * AW : c.p.out + O_PK + ((size_t)(li * NB + b) * WIN + (s - (SEQ - WIN))) * AW;
        float* ov = smp ? c.p.out + O_SV + ((size_t)(li * NS + b) * WIN + (WIN - 1)) * AW : c.p.out + O_PV + ((size_t)(li * NB + b) * WIN + (s - (SEQ - WIN))) * AW;
        const bf16_t* kr = PROJ + (size_t)tok * HYB_MAIN + AW;
        float f[8];
        unpack8(*(const u32x4*)(kr + 8 * lane), f); store8f(ok + 8 * lane, f);
        unpack8(*(const u32x4*)(kr + AW + 8 * lane), f); store8f(ov + 8 * lane, f);
    }
}

DI void ssd_wave(const Ctx& c, int li, int item) {
    const float* ACT = c.ws<float>(W_ACT); const float* AUX = c.ws<float>(W_AUX); float* Y = c.ws<float>(W_Y);
    const int lane = c.lane;
    const bool smp = item >= NB * SH * SP; const int it = smp ? item - NB * SH * SP : item;
    const int seq = it / (SH * SP), h = (it / SP) % SH, p = it % SP, g = h / (SH / SG);
    const int L = smp ? 1 : SEQ; const int tok0 = smp ? T + seq : seq * SEQ;
    const float Ah = -__expf(c.in(I_SALOG)[li * SH + h]), Dh = c.in(I_SD)[li * SH + h];
    float h0 = 0.f, h1 = 0.f;
    if (smp) { const float* s0 = c.in(I_SSM) + (((size_t)(li * NS + seq) * SH + h) * SP + p) * SN; h0 = s0[2 * lane]; h1 = s0[2 * lane + 1]; }
#pragma unroll 2
    for (int t = 0; t < L; ++t) {
        const float* a = ACT + (size_t)(tok0 + t) * 4096;
        const float dt = AUX[(size_t)(tok0 + t) * 32 + h], xv = a[h * SP + p];
        const float2 Bv = *(const float2*)(a + SDI + g * SN + 2 * lane), Cv = *(const float2*)(a + SDI + SG * SN + g * SN + 2 * lane);
        const float dec = __expf(dt * Ah), dx = dt * xv;
        h0 = h0 * dec + dx * Bv.x; h1 = h1 * dec + dx * Bv.y;
        const float y = wave_sum(h0 * Cv.x + h1 * Cv.y);
        if (lane == 0) Y[(size_t)(tok0 + t) * 2048 + h * SP + p] = y + Dh * xv;
    }
    float* so = smp ? c.p.out + O_SSS + (((size_t)(li * NS + seq) * SH + h) * SP + p) * SN : c.p.out + O_PSS + (((size_t)(li * NB + seq) * SH + h) * SP + p) * SN;
    *(float2*)(so + 2 * lane) = make_float2(h0, h1);
}
DI void ssd_sample_item(const Ctx& c, int li, int item) {
    const float* ACT = c.ws<float>(W_ACT); const float* AUX = c.ws<float>(W_AUX); float* Y = c.ws<float>(W_Y);
    const int lane = c.lane, seq = item / SH, h = item % SH, g = h / (SH / SG), tok = T + seq;
    const float Ah = -__expf(c.in(I_SALOG)[li * SH + h]), Dh = c.in(I_SD)[li * SH + h];
    const float* a = ACT + (size_t)tok * 4096;
    const float dt = AUX[(size_t)tok * 32 + h], dec = __expf(dt * Ah);
    const float2 Bv = *(const float2*)(a + SDI + g * SN + 2 * lane), Cv = *(const float2*)(a + SDI + SG * SN + g * SN + 2 * lane);
    const float* s0 = c.in(I_SSM) + ((size_t)(li * NS + seq) * SH + h) * SP * SN; float* so = c.p.out + O_SSS + ((size_t)(li * NS + seq) * SH + h) * SP * SN;
    const float xl = a[h * SP + lane];
    float ysum = 0.f;
#pragma unroll 16
    for (int p = 0; p < SP; ++p) {
        const float2 hv = *(const float2*)(s0 + (size_t)p * SN + 2 * lane);
        const float dx = dt * __shfl(xl, p);
        const float h0 = hv.x * dec + dx * Bv.x, h1 = hv.y * dec + dx * Bv.y;
        *(float2*)(so + (size_t)p * SN + 2 * lane) = make_float2(h0, h1);
        const float y = wave_sum(h0 * Cv.x + h1 * Cv.y);
        ysum = lane == p ? y : ysum;
    }
    Y[(size_t)tok * 2048 + h * SP + lane] = ysum + Dh * xl;
}
DI void hyb_post_token(const Ctx& c, int li, int tok) {
    const bf16_t* PROJ = c.ws<bf16_t>(W_PROJ); const float* Y = c.ws<float>(W_Y); bf16_t* MIX = c.ws<bf16_t>(W_MIXED);
    const float* nw = c.in(I_SNW) + (size_t)li * SDI; const int lane = c.lane;
    float v[16]; float ss0 = 0.f, ss1 = 0.f;
#pragma unroll
    for (int j = 0; j < 16; ++j) { const int ch = lane + 64 * j; const float z = bf2f(PROJ[(size_t)tok * HYB_MAIN + 1536 + ch]); v[j] = Y[(size_t)tok * 2048 + ch] * siluf(z); if (j < 8) ss0 += v[j] * v[j]; else ss1 += v[j] * v[j]; }
    const float r0 = rsqrtf(wave_sum(ss0) * (1.f / 512.f) + EPS), r1 = rsqrtf(wave_sum(ss1) * (1.f / 512.f) + EPS);
#pragma unroll
    for (int j = 0; j < 16; ++j) { const int ch = lane + 64 * j; MIX[(size_t)tok * HYB_MIX + AW + ch] = f2bf(v[j] * (j < 8 ? r0 : r1) * nw[ch]); }
}


constexpr int SLD = 136;
constexpr int L_C = 0, L_B = 34816, L_XT = 69632, L_HS = 87040, L_CS = 104448, L_DT = 108544;
constexpr size_t W_ST = W_HID;
constexpr size_t W_DEC = W_HID + (size_t)NB * 32 * SH * SP * SN * 4;
constexpr int NCH = SEQ / 128;

DI void ssd_chunk_scalars(const Ctx& c, int li, int tok0, int g) {
    const float* AUX = c.ws<float>(W_AUX); LAS float* csS = (LAS float*)(c.lds + L_CS); LAS float* dtS = (LAS float*)(c.lds + L_DT);
    const int hh = c.wave, lane = c.lane, h = 8 * g + hh;
    const float Ah = -__expf(c.in(I_SALOG)[li * SH + h]);
    const float d0 = AUX[(size_t)(tok0 + lane) * 32 + h], d1 = AUX[(size_t)(tok0 + 64 + lane) * 32 + h];
    float s0 = d0 * Ah, s1 = d1 * Ah;
#pragma unroll
    for (int o = 1; o < 64; o <<= 1) { const float t0 = __shfl_up(s0, o), t1 = __shfl_up(s1, o); if (lane >= o) { s0 += t0; s1 += t1; } }
    s1 += __shfl(s0, 63);
    csS[lane * 8 + hh] = s0; csS[(64 + lane) * 8 + hh] = s1; dtS[lane * 8 + hh] = d0; dtS[(64 + lane) * 8 + hh] = d1;
}
DI void ssd_a_item(const Ctx& c, int li, int item) {
    int tid_o = c.tid; asm volatile("" : "+v"(tid_o));
    const int lane_o = tid_o & 63;
    const float* ACT = c.ws<float>(W_ACT); float* ST = c.ws<float>(W_ST); float* DEC = c.ws<float>(W_DEC);
    const int g = item & 1, ch = (item >> 1) % NCH, b = item / (2 * NCH), tok0 = b * SEQ + ch * 128;
    LAS bf16_t* BT = (LAS bf16_t*)(c.lds + L_B); LAS bf16_t* XT = (LAS bf16_t*)(c.lds + L_XT);
    const LAS float* csS = (const LAS float*)(c.lds + L_CS); const LAS float* dtS = (const LAS float*)(c.lds + L_DT);
    const int fr = lane_o & 15, fq = lane_o >> 4, w = c.wave;
    __syncthreads();
    ssd_chunk_scalars(c, li, tok0, g);
#pragma unroll 4
    for (int it = 0; it < 32; ++it) { const int idx = it * NTHR + tid_o, j = idx >> 7, n = idx & 127; BT[n * SLD + j] = f2bf(ACT[(size_t)(tok0 + j) * 4096 + SDI + g * SN + n]); }
    __syncthreads();
    if (tid_o < 8) DEC[(size_t)(b * NCH + ch) * SH + 8 * g + tid_o] = __expf(csS[127 * 8 + tid_o]);
    const int pt = w & 3, nt0 = (w >> 2) * 4;
    float xr[16];
#pragma unroll
    for (int it = 0; it < 16; ++it) { const int idx = it * NTHR + tid_o, j = idx >> 6, p = idx & 63; xr[it] = ACT[(size_t)(tok0 + j) * 4096 + (8 * g) * SP + p]; }
#pragma unroll 1
    for (int hh = 0; hh < 8; ++hh) {
        const int h = 8 * g + hh; const float csl = csS[127 * 8 + hh];
#pragma unroll
        for (int it = 0; it < 16; ++it) { const int idx = it * NTHR + tid_o, j = idx >> 6, p = idx & 63;
            XT[p * SLD + j] = f2bf(xr[it] * __expf(csl - csS[j * 8 + hh]) * dtS[j * 8 + hh]); }
        __syncthreads();
        if (hh + 1 < 8) {
#pragma unroll
            for (int it = 0; it < 16; ++it) { const int idx = it * NTHR + tid_o, j = idx >> 6, p = idx & 63; xr[it] = ACT[(size_t)(tok0 + j) * 4096 + (h + 1) * SP + p]; }
        }
        f32x4 acc[4];
#pragma unroll
        for (int n = 0; n < 4; ++n) acc[n] = (f32x4){0.f, 0.f, 0.f, 0.f};
#pragma unroll
        for (int ks = 0; ks < 4; ++ks) {
            const bf16x8 a = lds_frag(XT + (16 * pt + fr) * SLD + 32 * ks + 8 * fq);
#pragma unroll
            for (int n = 0; n < 4; ++n) { const bf16x8 bb = lds_frag(BT + (16 * (nt0 + n) + fr) * SLD + 32 * ks + 8 * fq); acc[n] = __builtin_amdgcn_mfma_f32_16x16x32_bf16(bb, a, acc[n], 0, 0, 0); }
        }
        float* so = ST + ((((size_t)(b * NCH + ch) * SH + h) * SP + 16 * pt + fr) * SN);
#pragma unroll
        for (int n = 0; n < 4; ++n) *(f32x4*)(so + 16 * (nt0 + n) + 4 * fq) = acc[n];
        __syncthreads();
    }
}
DI void ssd_scan_phase(const Ctx& c, int li) {
    float* ST = c.ws<float>(W_ST); const float* DEC = c.ws<float>(W_DEC);
    for (int idx = blockIdx.x * NTHR + c.tid; idx < NB * SH * SP * SN / 4; idx += gridDim.x * NTHR) {
        const int n4 = idx & 31, p = (idx >> 5) & 63, h = (idx >> 11) & 15, b = idx >> 15;
        f32x4 hcur = (f32x4){0.f, 0.f, 0.f, 0.f};
#pragma unroll 8
        for (int ch = 0; ch < NCH; ++ch) {
            f32x4* a = (f32x4*)(ST + ((((size_t)(b * NCH + ch) * SH + h) * SP + p) * SN)) + n4;
            const f32x4 s = *a; const float d = DEC[(size_t)(b * NCH + ch) * SH + h];
            *a = hcur; hcur = hcur * d + s;
        }
        *((f32x4*)(c.p.out + O_PSS + ((((size_t)(li * NB + b) * SH + h) * SP + p) * SN)) + n4) = hcur;
    }
}
DI void ssd_b_item(const Ctx& c, int li, int item) {
    int tid_o = c.tid; asm volatile("" : "+v"(tid_o));
    const int lane_o = tid_o & 63;
    const float* ACT = c.ws<float>(W_ACT); const float* ST = c.ws<float>(W_ST); const bf16_t* PROJ = c.ws<bf16_t>(W_PROJ); bf16_t* MIX = c.ws<bf16_t>(W_MIXED);
    const int g = item & 1, ch = (item >> 1) % NCH, b = item / (2 * NCH), tok0 = b * SEQ + ch * 128;
    LAS bf16_t* CS_ = (LAS bf16_t*)(c.lds + L_C); LAS bf16_t* BS = (LAS bf16_t*)(c.lds + L_B); LAS bf16_t* XT = (LAS bf16_t*)(c.lds + L_XT); LAS bf16_t* HS = (LAS bf16_t*)(c.lds + L_HS);
    const LAS float* csS = (const LAS float*)(c.lds + L_CS); const LAS float* dtS = (const LAS float*)(c.lds + L_DT);
    const int fr = lane_o & 15, fq = lane_o >> 4, w = c.wave, irow = 16 * w + fr;
    __syncthreads();
    ssd_chunk_scalars(c, li, tok0, g);
#pragma unroll 4
    for (int it = 0; it < 8; ++it) { const int idx = it * NTHR + tid_o, i = idx >> 5, n4 = idx & 31;
        const f32x4 bv = *(const f32x4*)(ACT + (size_t)(tok0 + i) * 4096 + SDI + g * SN + 4 * n4), cv = *(const f32x4*)(ACT + (size_t)(tok0 + i) * 4096 + SDI + SG * SN + g * SN + 4 * n4);
        u32x2 o; o.x = pk2(bv.x, bv.y); o.y = pk2(bv.z, bv.w); *(LAS u32x2*)(BS + i * SLD + 4 * n4) = o;
        o.x = pk2(cv.x, cv.y); o.y = pk2(cv.z, cv.w); *(LAS u32x2*)(CS_ + i * SLD + 4 * n4) = o; }
    __syncthreads();
    f32x4 cb[8];
#pragma unroll
    for (int jt = 0; jt < 8; ++jt) cb[jt] = (f32x4){0.f, 0.f, 0.f, 0.f};
    bf16x8 cfrag[4];
#pragma unroll
    for (int ks = 0; ks < 4; ++ks) cfrag[ks] = lds_frag(CS_ + irow * SLD + 32 * ks + 8 * fq);
#pragma unroll
    for (int jt = 0; jt < 8; ++jt) if (jt <= w) {
#pragma unroll
        for (int ks = 0; ks < 4; ++ks) cb[jt] = __builtin_amdgcn_mfma_f32_16x16x32_bf16(lds_frag(BS + (16 * jt + fr) * SLD + 32 * ks + 8 * fq), cfrag[ks], cb[jt], 0, 0, 0);
    }
    float rowsq = 0.f;
    float xr[16]; f32x4 hr[4];
#pragma unroll
    for (int it = 0; it < 16; ++it) { const int idx = it * NTHR + tid_o, j = idx >> 6, p = idx & 63; xr[it] = ACT[(size_t)(tok0 + j) * 4096 + (8 * g) * SP + p]; }
#pragma unroll
    for (int it = 0; it < 4; ++it) { const int idx = it * NTHR + tid_o, p = idx >> 5, n4 = idx & 31; hr[it] = *((const f32x4*)(ST + ((((size_t)(b * NCH + ch) * SH + 8 * g) * SP + p) * SN)) + n4); }
#pragma unroll 1
    for (int hh = 0; hh < 8; ++hh) {
        const int h = 8 * g + hh; const float Dh = c.in(I_SD)[li * SH + h];
        int tw = tid_o; asm volatile("" : "+v"(tw));
#pragma unroll
        for (int it = 0; it < 16; ++it) { const int idx = it * NTHR + tw, j = idx >> 6, p = idx & 63; XT[p * SLD + j] = f2bf(xr[it]); }
#pragma unroll
        for (int it = 0; it < 4; ++it) { const int idx = it * NTHR + tw, p = idx >> 5, n4 = idx & 31; const f32x4 v = hr[it];
            u32x2 o; o.x = pk2(v.x, v.y); o.y = pk2(v.z, v.w); *(LAS u32x2*)(HS + p * SLD + 4 * n4) = o; }
        __syncthreads();
        if (hh + 1 < 8) {
            int tq = tid_o; asm volatile("" : "+v"(tq));
#pragma unroll
            for (int it = 0; it < 16; ++it) { const int idx = it * NTHR + tq, j = idx >> 6, p = idx & 63; xr[it] = ACT[(size_t)(tok0 + j) * 4096 + (h + 1) * SP + p]; }
#pragma unroll
            for (int it = 0; it < 4; ++it) { const int idx = it * NTHR + tq, p = idx >> 5, n4 = idx & 31; hr[it] = *((const f32x4*)(ST + ((((size_t)(b * NCH + ch) * SH + h + 1) * SP + p) * SN)) + n4); }
        }
        const float csi = csS[irow * 8 + hh];
        f32x4 ay[4], ah[4];
#pragma unroll
        for (int pt = 0; pt < 4; ++pt) { ay[pt] = (f32x4){0.f, 0.f, 0.f, 0.f}; ah[pt] = (f32x4){0.f, 0.f, 0.f, 0.f}; }
#pragma unroll
        for (int ks = 0; ks < 4; ++ks) {
#pragma unroll
            for (int pt = 0; pt < 4; ++pt) ah[pt] = __builtin_amdgcn_mfma_f32_16x16x32_bf16(lds_frag(HS + (16 * pt + fr) * SLD + 32 * ks + 8 * fq), cfrag[ks], ah[pt], 0, 0, 0);
            if (2 * ks <= w) {
                float mv[8];
#pragma unroll
                for (int e = 0; e < 8; ++e) {
                    const int j = 32 * ks + (e < 4 ? 4 * fq + e : 16 + 4 * fq + (e - 4));
                    const float cbv = e < 4 ? cb[2 * ks][e] : cb[2 * ks + 1][e - 4];
                    const float csj = *(const volatile LAS float*)(csS + j * 8 + hh), dtj = *(const volatile LAS float*)(dtS + j * 8 + hh);
                    mv[e] = j <= irow ? cbv * __expf(csi - csj) * dtj : 0.f;
                }
                u32x4 mp; mp.x = pk2(mv[0], mv[1]); mp.y = pk2(mv[2], mv[3]); mp.z = pk2(mv[4], mv[5]); mp.w = pk2(mv[6], mv[7]);
                const bf16x8 mfrag = __builtin_bit_cast(bf16x8, mp);
#pragma unroll
                for (int pt = 0; pt < 4; ++pt) ay[pt] = __builtin_amdgcn_mfma_f32_16x16x32_bf16(lds_frag2(XT + (16 * pt + fr) * SLD + 32 * ks + 4 * fq, XT + (16 * pt + fr) * SLD + 32 * ks + 16 + 4 * fq), mfrag, ay[pt], 0, 0, 0);
            }
        }
        const float ei = __expf(csi);
#pragma unroll
        for (int pt = 0; pt < 4; ++pt) {
            const int col = h * SP + 16 * pt + 4 * fq;
            const f32x4 xv = *(const f32x4*)(ACT + (size_t)(tok0 + irow) * 4096 + col);
            const u32x2 zz = *(const u32x2*)(PROJ + (size_t)(tok0 + irow) * HYB_MAIN + 1536 + col);
            const float z0 = bf2f((bf16_t)(zz.x & 0xffff)), z1 = bf2f((bf16_t)(zz.x >> 16)), z2 = bf2f((bf16_t)(zz.y & 0xffff)), z3 = bf2f((bf16_t)(zz.y >> 16));
            const float y0 = (ay[pt][0] + ei * ah[pt][0] + Dh * xv.x) * siluf(z0), y1 = (ay[pt][1] + ei * ah[pt][1] + Dh * xv.y) * siluf(z1);
            const float y2 = (ay[pt][2] + ei * ah[pt][2] + Dh * xv.z) * siluf(z2), y3 = (ay[pt][3] + ei * ah[pt][3] + Dh * xv.w) * siluf(z3);
            rowsq += y0 * y0 + y1 * y1 + y2 * y2 + y3 * y3;
            u32x2 o; o.x = pk2(y0, y1); o.y = pk2(y2, y3); *(u32x2*)(MIX + (size_t)(tok0 + irow) * HYB_MIX + AW + col) = o;
        }
        __syncthreads();
    }
    rowsq += __shfl_xor(rowsq, 16); rowsq += __shfl_xor(rowsq, 32);
    const float rn = rsqrtf(rowsq * (1.f / 512.f) + EPS);
    const float* nw = c.in(I_SNW) + (size_t)li * SDI + g * 512;
    asm volatile("s_waitcnt vmcnt(0)" ::: "memory");
    bf16_t* mrow = MIX + (size_t)(tok0 + irow) * HYB_MIX + AW + g * 512 + fq * 128;
#pragma unroll 4
    for (int cc = 0; cc < 16; ++cc) {
        const u32x4 v = *(const u32x4*)(mrow + 8 * cc); const float* wv = nw + fq * 128 + 8 * cc; u32x4 o;
        o.x = pk2(bf2f((bf16_t)(v.x & 0xffff)) * rn * wv[0], bf2f((bf16_t)(v.x >> 16)) * rn * wv[1]); o.y = pk2(bf2f((bf16_t)(v.y & 0xffff)) * rn * wv[2], bf2f((bf16_t)(v.y >> 16)) * rn * wv[3]);
        o.z = pk2(bf2f((bf16_t)(v.z & 0xffff)) * rn * wv[4], bf2f((bf16_t)(v.z >> 16)) * rn * wv[5]); o.w = pk2(bf2f((bf16_t)(v.w & 0xffff)) * rn * wv[6], bf2f((bf16_t)(v.w >> 16)) * rn * wv[7]);
        *(u32x4*)(mrow + 8 * cc) = o;
    }
}

DI void gdn_pre_token(const Ctx& c, int li, int tok) {
    const bf16_t* PROJ = c.ws<bf16_t>(W_PROJ); bf16_t* ACTB = c.ws<bf16_t>(W_ACT); float* AUX = c.ws<float>(W_AUX); const float* EX = c.ws<float>(W_EXTRA);
    const int lane = c.lane; const bool smp = tok >= T; const int b = smp ? tok - T : tok / SEQ, s = smp ? 0 : tok % SEQ;
    const float* cw = c.in(I_GCW) + (size_t)li * 4 * GQKV;
    const float* st = c.in(I_GCONV) + (size_t)(li * NS + b) * 3 * GQKV;
    const bf16_t* prow = PROJ + (size_t)tok * GDN_MAIN;
#pragma unroll 1
    for (int it = 0; it < 8; ++it) {
        const int ch0 = 512 * it + 8 * lane; float x1[8], x2[8], x3[8], y[8];
        conv8(prow, GDN_MAIN, st, GQKV, cw, ch0, smp, s, x1, x2, x3, y);
        float ss = 0.f;
#pragma unroll
        for (int e = 0; e < 8; ++e) { y[e] = siluf(y[e]); ss += y[e] * y[e]; }
        if (it < 4) {
            ss += __shfl_xor(ss, 1); ss += __shfl_xor(ss, 2); ss += __shfl_xor(ss, 4); ss += __shfl_xor(ss, 8);
            const float r = rsqrtf(ss + EPS) * (it < 2 ? 0.08838834764831845f : 1.f);
#pragma unroll
            for (int e = 0; e < 8; ++e) y[e] *= r;
        }
        { u32x4 o; o.x = pk2(y[0], y[1]); o.y = pk2(y[2], y[3]); o.z = pk2(y[4], y[5]); o.w = pk2(y[6], y[7]); *(u32x4*)(ACTB + (size_t)tok * 4096 + ch0) = o; }
        if (smp) { float* o = c.p.out + O_SGC + (size_t)(li * NS + b) * 3 * GQKV + ch0; store8f(o, x1); store8f(o + GQKV, x2); store8f(o + 2 * GQKV, x3); }
        else if (s >= SEQ - 3) store8f(c.p.out + O_PGC + ((size_t)(li * NB + b) * 3 + (s - (SEQ - 3))) * GQKV + ch0, x3);
    }
    if (lane < GH) {
        AUX[(size_t)tok * 32 + lane] = sigmoidf_(EX[(size_t)tok * 32 + lane]);
        AUX[(size_t)tok * 32 + 16 + lane] = -__expf(c.in(I_GALOG)[li * GH + lane]) * softplusf_(EX[(size_t)tok * 32 + 16 + lane] + c.in(I_GDTB)[li * GH + lane]);
    }
}
DI void gdn_pre_range(const Ctx& c, int li, int item) {
    const bf16_t* PROJ = c.ws<bf16_t>(W_PROJ); bf16_t* ACTB = c.ws<bf16_t>(W_ACT); float* AUX = c.ws<float>(W_AUX); const float* EX = c.ws<float>(W_EXTRA);
    int lane_ = c.lane; asm volatile("" : "+v"(lane_));
    const int lane = lane_, it = item & 7, rg = item >> 3, tok0 = rg * 64, b = tok0 / SEQ, s0 = tok0 % SEQ, ch0 = 512 * it + 8 * lane;
    const float* cw = c.in(I_GCW) + (size_t)li * 4 * GQKV;
    float w0[8], w1[8], w2[8], w3[8], xa[8], xb[8], xc[8];
    load8f(cw + ch0, w0); load8f(cw + GQKV + ch0, w1); load8f(cw + 2 * GQKV + ch0, w2); load8f(cw + 3 * GQKV + ch0, w3);
    const bf16_t* prow = PROJ + (size_t)tok0 * GDN_MAIN + ch0;
    const u32x4 z4 = (u32x4){0u, 0u, 0u, 0u};
    unpack8(s0 >= 3 ? *(const u32x4*)(prow - 3 * GDN_MAIN) : z4, xa); unpack8(s0 >= 2 ? *(const u32x4*)(prow - 2 * GDN_MAIN) : z4, xb); unpack8(s0 >= 1 ? *(const u32x4*)(prow - GDN_MAIN) : z4, xc);
    const float qscale = it < 2 ? 0.08838834764831845f : 1.f;
    const float gal = lane >= 16 && lane < 32 ? -__expf(c.in(I_GALOG)[li * GH + lane - 16]) : 0.f, gdb = lane >= 16 && lane < 32 ? c.in(I_GDTB)[li * GH + lane - 16] : 0.f;
    u32x4 rawn[16];
#pragma unroll
    for (int j = 0; j < 16; ++j) rawn[j] = *(const u32x4*)(prow + (size_t)j * GDN_MAIN);
#pragma unroll 1
    for (int tb = 0; tb < 64; tb += 16) {
        u32x4 raw[16];
#pragma unroll
        for (int j = 0; j < 16; ++j) raw[j] = rawn[j];
        if (tb + 16 < 64) {
#pragma unroll
            for (int j = 0; j < 16; ++j) rawn[j] = *(const u32x4*)(prow + (size_t)(tb + 16 + j) * GDN_MAIN);
        }
#pragma unroll
        for (int j = 0; j < 16; ++j) {
            const int t = tb + j;
            float xd[8], y[8];
            unpack8(raw[j], xd);
            float ss = 0.f;
#pragma unroll
            for (int e = 0; e < 8; ++e) { y[e] = siluf(xa[e] * w0[e] + xb[e] * w1[e] + xc[e] * w2[e] + xd[e] * w3[e]); ss += y[e] * y[e]; }
            if (it < 4) {
                ss += __shfl_xor(ss, 1); ss += __shfl_xor(ss, 2); ss += __shfl_xor(ss, 4); ss += __shfl_xor(ss, 8);
                const float r = rsqrtf(ss + EPS) * qscale;
#pragma unroll
                for (int e = 0; e < 8; ++e) y[e] *= r;
            }
            { u32x4 o; o.x = pk2(y[0], y[1]); o.y = pk2(y[2], y[3]); o.z = pk2(y[4], y[5]); o.w = pk2(y[6], y[7]); *(u32x4*)(ACTB + (size_t)(tok0 + t) * 4096 + ch0) = o; }
            if (s0 + t >= SEQ - 3) store8f(c.p.out + O_PGC + ((size_t)(li * NB + b) * 3 + (s0 + t - (SEQ - 3))) * GQKV + ch0, xd);
            if (it == 0 && lane < 32) {
                const float ev = EX[(size_t)(tok0 + t) * 32 + lane];
                AUX[(size_t)(tok0 + t) * 32 + lane] = lane < 16 ? sigmoidf_(ev) : gal * softplusf_(ev + gdb);
            }
#pragma unroll
            for (int e = 0; e < 8; ++e) { xa[e] = xb[e]; xb[e] = xc[e]; xc[e] = xd[e]; }
        }
    }
}
DI void gdn_seq_phase(const Ctx& c, int li, int first_item, int wg, int nwg) {
    const bf16_t* ACTB = c.ws<bf16_t>(W_ACT); const float* AUX = c.ws<float>(W_AUX); bf16_t* MIX = c.ws<bf16_t>(W_MIXED); const bf16_t* PROJ = c.ws<bf16_t>(W_PROJ);
    LAS float* red = (LAS float*)c.lds + 1024;
    const int slot = c.tid >> 8, t8 = c.tid & 255, col = t8 >> 1, half = t8 & 1;
    LAS float* kq = (LAS float*)c.lds + slot * 512;
    const int nslot = nwg * 2;
    for (int base = first_item; base < NB * GH + NS * GH; base += nslot) {
        const int item = base + wg * 2 + slot;
        const bool wg_prompt = (base + wg * 2) < NB * GH;
        const int L = wg_prompt ? SEQ : 1;
        const bool valid = item < NB * GH + NS * GH;
        const bool smp = item >= NB * GH; const int it = smp ? item - NB * GH : item;
        const int seq = valid ? it / GH : 0, vh = valid ? it % GH : 0, hq = vh >> 1;
        const int tok0 = smp ? T + seq : seq * SEQ;
        float S[64];
        if (valid && smp) { const float* s0 = c.in(I_GST) + ((size_t)(li * NS + seq) * GH + vh) * GDK * GDV + (size_t)(64 * half) * GDV + col;
#pragma unroll
            for (int k = 0; k < 64; ++k) S[k] = s0[(size_t)k * GDV]; }
        else {
#pragma unroll
            for (int k = 0; k < 64; ++k) S[k] = 0.f; }
        __syncthreads();
        for (int t = 0; t < L; ++t) {
            LAS float* cur = kq + (t & 1) * 256;
            const bf16_t* a = ACTB + (size_t)(tok0 + t) * 4096;
            cur[t8] = bf2f(a[(t8 < 128 ? 1024 : -128) + hq * 128 + t8]);
            const float vv = bf2f(a[2048 + vh * 128 + col]), beta = AUX[(size_t)(tok0 + t) * 32 + vh], eg = __expf(AUX[(size_t)(tok0 + t) * 32 + 16 + vh]);
            __syncthreads();
            const LAS float* kk = cur + 64 * half; const LAS float* qq = cur + 128 + 64 * half;
            float ks = 0.f;
#pragma unroll
            for (int k = 0; k < 64; k += 4) { const f32x4 kv = *(const LAS f32x4*)(kk + k); ks += kv.x * S[k] + kv.y * S[k + 1] + kv.z * S[k + 2] + kv.w * S[k + 3]; }
            ks += __shfl_xor(ks, 1);
            const float u = beta * (vv - eg * ks);
            asm volatile("" ::: "memory");
            float o = 0.f;
#pragma unroll
            for (int k = 0; k < 64; k += 4) { const f32x4 kv = *(const LAS f32x4*)(kk + k); const f32x4 qv = *(const LAS f32x4*)(qq + k);
                S[k] = eg * S[k] + kv.x * u; S[k + 1] = eg * S[k + 1] + kv.y * u; S[k + 2] = eg * S[k + 2] + kv.z * u; S[k + 3] = eg * S[k + 3] + kv.w * u;
                o += qv.x * S[k] + qv.y * S[k + 1] + qv.z * S[k + 2] + qv.w * S[k + 3]; }
            o += __shfl_xor(o, 1);
            { const float sq = wave_sum(half == 0 ? o * o : 0.f); if (c.lane == 0) red[slot * 4 + ((c.tid >> 6) & 3)] = sq; }
            __syncthreads();
            if (valid && half == 0) { const float tot = red[slot * 4] + red[slot * 4 + 1] + red[slot * 4 + 2] + red[slot * 4 + 3];
                const float z = bf2f(PROJ[(size_t)(tok0 + t) * GDN_MAIN + 4096 + vh * 128 + col]);
                MIX[(size_t)(tok0 + t) * GVW + vh * 128 + col] = f2bf(o * rsqrtf(tot * (1.f / 128.f) + EPS) * c.in(I_GNW)[li * GDV + col] * siluf(z)); }
        }
        if (valid) { float* so = (smp ? c.p.out + O_SGS + ((size_t)(li * NS + seq) * GH + vh) * GDK * GDV : c.p.out + O_PGS + ((size_t)(li * NB + seq) * GH + vh) * GDK * GDV) + (size_t)(64 * half) * GDV + col;
#pragma unroll
            for (int k = 0; k < 64; ++k) so[(size_t)k * GDV] = S[k]; }
        __syncthreads();
    }
}

constexpr size_t W_KCD = W_GO;
constexpr size_t W_U0 = W_HID;
constexpr size_t W_GC = W_HID + (size_t)67108864;
constexpr size_t W_QB = W_H;
constexpr size_t W_ATTG = W_Y;
constexpr size_t W_KT = W_Y + (size_t)33554432;
constexpr int GA_LDS = 20000;
constexpr int GCH = SEQ / 64;

DI bf16x8 gfrag_f32(const float* p) { return pack8(*(const f32x4*)p, *(const f32x4*)(p + 4)); }

DI void gdn_a_item(const Ctx& c, int li, int item) {
    const bf16_t* ACTB = c.ws<bf16_t>(W_ACT); const float* AUX = c.ws<float>(W_AUX);
    const int ch = item & (GCH - 1), vh = (item >> 6) & 15, b = item >> 10, hq = vh >> 1, tok0 = b * SEQ + ch * 64;
    int lane_ = c.lane; asm volatile("" : "+v"(lane_));
    const int lane = lane_, fr = lane & 15, fq = lane >> 4;
    LAS unsigned char* wl = c.lds + c.wave * GA_LDS;
    LAS float* As = (LAS float*)wl; LAS bf16_t* Ts = (LAS bf16_t*)wl; LAS bf16_t* KsT = (LAS bf16_t*)wl;
    LAS float* gcS = (LAS float*)(wl + 17408); LAS float* btS = gcS + 64; LAS float* beS = gcS + 128;
    bf16_t* KCDg = c.ws<bf16_t>(W_KCD) + (size_t)item * 8192; bf16_t* ATTg = c.ws<bf16_t>(W_ATTG) + (size_t)item * 4096; bf16_t* U0g = c.ws<bf16_t>(W_U0) + (size_t)item * 8192;
    const int qitem = (b * GQH + hq) * GCH + ch;
    { const float gi = AUX[(size_t)(tok0 + lane) * 32 + 16 + vh], bi = AUX[(size_t)(tok0 + lane) * 32 + vh];
      float gc = gi;
#pragma unroll
      for (int o = 1; o < 64; o <<= 1) { const float t = __shfl_up(gc, o); if (lane >= o) gc += t; }
      gcS[lane] = gc; btS[lane] = bi; beS[lane] = bi * __expf(gc); c.ws<float>(W_GC)[(size_t)(tok0 + lane) * 16 + vh] = gc; }
    LDS_WAIT();
    {
        bf16x8 kf[4][4], qfa[4][4];
#pragma unroll
        for (int t = 0; t < 4; ++t)
#pragma unroll
            for (int ks = 0; ks < 4; ++ks) { const bf16_t* rp = ACTB + (size_t)(tok0 + 16 * t + fr) * 4096 + hq * 128 + 32 * ks + 8 * fq; kf[t][ks] = *(const bf16x8*)(rp + 1024); qfa[t][ks] = *(const bf16x8*)rp; }
#pragma unroll
        for (int it = 0; it < 4; ++it) {
            const int i = 16 * it + fr; const float gci = gcS[i], bti = btS[i];
#pragma unroll
            for (int jt = 0; jt < 4; ++jt) {
                bf16_t* ap = ATTg + (unsigned)(i * 64 + 16 * jt + 4 * fq);
                if (jt > it) { *(unsigned long long*)ap = 0ull; continue; }
                f32x4 kk = (f32x4){0.f, 0.f, 0.f, 0.f}, qk = (f32x4){0.f, 0.f, 0.f, 0.f};
#pragma unroll
                for (int ks = 0; ks < 4; ++ks) { kk = __builtin_amdgcn_mfma_f32_16x16x32_bf16(kf[jt][ks], kf[it][ks], kk, 0, 0, 0); qk = __builtin_amdgcn_mfma_f32_16x16x32_bf16(kf[jt][ks], qfa[it][ks], qk, 0, 0, 0); }
                f32x4 av, tv;
#pragma unroll
                for (int r = 0; r < 4; ++r) { const int j = 16 * jt + 4 * fq + r; const float dec = __expf(gci - gcS[j]); av[r] = j < i ? bti * kk[r] * dec : 0.f; tv[r] = j <= i ? qk[r] * dec : 0.f; }
                *(LAS f32x4*)(As + i * 64 + 16 * jt + 4 * fq) = av;
                *(unsigned long long*)ap = (unsigned long long)pk2(tv[0], tv[1]) | ((unsigned long long)pk2(tv[2], tv[3]) << 32);
            }
        }
    }
    LDS_WAIT();
    float Tr[64];
#pragma unroll
    for (int i = 0; i < 64; ++i) {
        float acc = lane == i ? 1.f : 0.f;
#pragma unroll
        for (int j = 0; j < i; ++j) acc -= As[i * 64 + j] * Tr[j];
        Tr[i] = acc;
    }
    LDS_WAIT();
#pragma unroll
    for (int i = 0; i < 64; ++i) Ts[i * 72 + lane] = f2bf(Tr[i]);
    LDS_WAIT();
    {
        bf16x8 tfp[4][2], idf[2];
#pragma unroll
        for (int it = 0; it < 4; ++it)
#pragma unroll
            for (int ks = 0; ks < 2; ++ks) tfp[it][ks] = lds_frag2(Ts + (16 * it + fr) * 72 + 32 * ks + 4 * fq, Ts + (16 * it + fr) * 72 + 32 * ks + 16 + 4 * fq);
#pragma unroll
        for (int hs = 0; hs < 2; ++hs)
#pragma unroll
            for (int e = 0; e < 8; ++e) idf[hs][e] = (8 * fq + e) == (16 * hs + fr) ? (short)0x3F80 : (short)0;
        bf16_t* KTg = c.ws<bf16_t>(W_KT) + (size_t)qitem * 8192;
        const bool wr_k = (vh & 1) == 0;
        const bf16_t* AK = ACTB + (size_t)tok0 * 4096 + 1024 + hq * 128; const bf16_t* AV = ACTB + (size_t)tok0 * 4096 + 2048 + vh * 128;
        bf16x8 vfn[4], kfn[4];
#pragma unroll
        for (int t = 0; t < 4; ++t) { vfn[t] = *(const bf16x8*)(AV + (size_t)(16 * t + fr) * 4096 + 8 * fq); kfn[t] = *(const bf16x8*)(AK + (size_t)(16 * t + fr) * 4096 + 8 * fq); }
#pragma unroll 1
        for (int cc = 0; cc < 4; ++cc) {
            bf16x8 vf[4], kf2[4];
#pragma unroll
            for (int t = 0; t < 4; ++t) { vf[t] = vfn[t]; kf2[t] = kfn[t]; }
            if (cc + 1 < 4) {
#pragma unroll
                for (int t = 0; t < 4; ++t) { vfn[t] = *(const bf16x8*)(AV + (size_t)(16 * t + fr) * 4096 + 32 * (cc + 1) + 8 * fq); kfn[t] = *(const bf16x8*)(AK + (size_t)(16 * t + fr) * 4096 + 32 * (cc + 1) + 8 * fq); }
            }
#pragma unroll
            for (int hs = 0; hs < 2; ++hs) {
                const int nt = 2 * cc + hs;
                f32x4 dvv[4], dkk[4];
#pragma unroll
                for (int t = 0; t < 4; ++t) {
                    const f32x4 z = (f32x4){0.f, 0.f, 0.f, 0.f};
                    dvv[t] = __builtin_amdgcn_mfma_f32_16x16x32_bf16(vf[t], idf[hs], z, 0, 0, 0);
                    dkk[t] = __builtin_amdgcn_mfma_f32_16x16x32_bf16(kf2[t], idf[hs], z, 0, 0, 0);
                    if (wr_k) *(unsigned long long*)(KTg + (unsigned)((16 * nt + fr) * 64 + 16 * t + 4 * fq)) = (unsigned long long)pk2(dkk[t][0], dkk[t][1]) | ((unsigned long long)pk2(dkk[t][2], dkk[t][3]) << 32);
                    const f32x4 bt = *(const LAS f32x4*)(btS + 16 * t + 4 * fq), be = *(const LAS f32x4*)(beS + 16 * t + 4 * fq);
                    dvv[t] *= bt; dkk[t] *= be;
                }
                f32x4 au[4], ak[4];
#pragma unroll
                for (int it = 0; it < 4; ++it) { au[it] = (f32x4){0.f, 0.f, 0.f, 0.f}; ak[it] = (f32x4){0.f, 0.f, 0.f, 0.f}; }
#pragma unroll
                for (int ks = 0; ks < 2; ++ks) {
                    const bf16x8 vfrag = pack8(dvv[2 * ks], dvv[2 * ks + 1]), kfrag = pack8(dkk[2 * ks], dkk[2 * ks + 1]);
#pragma unroll
                    for (int it = 0; it < 4; ++it) { au[it] = __builtin_amdgcn_mfma_f32_16x16x32_bf16(tfp[it][ks], vfrag, au[it], 0, 0, 0);
                                                     ak[it] = __builtin_amdgcn_mfma_f32_16x16x32_bf16(kfrag, tfp[it][ks], ak[it], 0, 0, 0); }
                }
#pragma unroll
                for (int it = 0; it < 4; ++it) {
                    *(unsigned long long*)(U0g + (unsigned)(((nt * 4 + it) * 64 + lane) * 4)) = (unsigned long long)pk2(au[it][0], au[it][1]) | ((unsigned long long)pk2(au[it][2], au[it][3]) << 32);
                    *(unsigned long long*)(KCDg + (unsigned)((16 * it + fr) * 128 + 16 * nt + 4 * fq)) = (unsigned long long)pk2(ak[it][0], ak[it][1]) | ((unsigned long long)pk2(ak[it][2], ak[it][3]) << 32);
                }
            }
        }
    }
    LDS_WAIT();
}

constexpr int GS_KCD = 0, GS_QB = 17408, GS_ATT = 34816, GS_KT = 44032, GS_GC = 62464, GS_BUF = 62720;
DI bf16x8 fragA(const LAS unsigned char* p) { const u32x2 x = *(const volatile LAS u32x2*)p, y = *(const volatile LAS u32x2*)(p + 128);     u32x4 r; r.x = x.x; r.y = x.y; r.z = y.x; r.w = y.y; return __builtin_bit_cast(bf16x8, r); }
DI bf16x8 fragB(const LAS unsigned char* p) { const u32x2 x = *(const volatile LAS u32x2*)p, y = *(const volatile LAS u32x2*)(p + 256); u32x4 r; r.x = x.x; r.y = x.y; r.z = y.x; r.w = y.y; return __builtin_bit_cast(bf16x8, r); }
DI void gdn_scan_wg(const Ctx& c, int li, int bvh) {
    const int vh = bvh & 15, b = bvh >> 4, hq = vh >> 1, lane = c.lane, fr = lane & 15, fq = lane >> 4, w = c.wave, tid = c.tid;
    const bf16_t* KCDg = c.ws<bf16_t>(W_KCD) + (size_t)(bvh * GCH) * 8192; const bf16_t* ATTg = c.ws<bf16_t>(W_ATTG) + (size_t)(bvh * GCH) * 4096;
    const bf16_t* U0g = c.ws<bf16_t>(W_U0) + (size_t)(bvh * GCH) * 8192;
    const bf16_t* QBg = c.ws<bf16_t>(W_ACT) + (size_t)(b * SEQ) * 4096 + hq * 128; const bf16_t* KTg = c.ws<bf16_t>(W_KT) + (size_t)((b * GQH + hq) * GCH) * 8192;
    const float* GCg = c.ws<float>(W_GC); bf16_t* MIX = c.ws<bf16_t>(W_MIXED); const bf16_t* PROJ = c.ws<bf16_t>(W_PROJ);
    LAS float* OT = (LAS float*)(c.lds + 2 * GS_BUF);
    LAS float* nwS = OT + 64 * 132;
    if (tid < GDV) nwS[tid] = c.in(I_GNW)[li * GDV + tid];
#define GS_DMA(tn, bb) do { \
        LAS unsigned char* lb_ = c.lds + (bb) * GS_BUF; \
        _Pragma("unroll") for (int k = 0; k < 2; ++k) { const int p_ = 8 * k + w; \
            __builtin_amdgcn_global_load_lds((const unsigned*)(KCDg + (size_t)(tn) * 8192 + p_ * 512 + srcA), (LAS unsigned*)(lb_ + GS_KCD + p_ * 1088), 16, 0, 0); \
            __builtin_amdgcn_global_load_lds((const unsigned*)(QBg + (size_t)(tn) * (64 * 4096) + p_ * (4 * 4096) + srcQ), (LAS unsigned*)(lb_ + GS_QB + p_ * 1088), 16, 0, 0); \
            __builtin_amdgcn_global_load_lds((const unsigned*)(KTg + (size_t)(tn) * 8192 + p_ * 512 + srcB), (LAS unsigned*)(lb_ + GS_KT + p_ * 1152), 16, 0, 0); } \
        __builtin_amdgcn_global_load_lds((const unsigned*)(ATTg + (size_t)(tn) * 4096 + w * 512 + srcB), (LAS unsigned*)(lb_ + GS_ATT + w * 1152), 16, 0, 0); } while (0)
    const int srcA = (lane & 3) * 128 + 8 * (lane >> 2), srcQ = (lane & 3) * 4096 + 8 * (lane >> 2), srcB = (lane & 7) * 64 + 8 * (lane >> 3);
    const int offA = (fr >> 2) * 1088 + (fr & 3) * 16 + (fq >> 1) * 64 + 8 * (fq & 1), offB = (fr >> 3) * 1152 + (fr & 7) * 16 + (fq >> 1) * 128 + 8 * (fq & 1);
    f32x4 sacc[8];
#pragma unroll
    for (int t = 0; t < 8; ++t) sacc[t] = (f32x4){0.f, 0.f, 0.f, 0.f};
    __syncthreads();
    u32x2 u0n[4];
#pragma unroll
    for (int it = 0; it < 4; ++it) u0n[it] = *(const u32x2*)(U0g + ((size_t)(w * 4 + it) * 64 + lane) * 4);
    GS_DMA(0, 0);
    if (tid < 64) *(LAS float*)(c.lds + GS_GC + 4 * tid) = GCg[(size_t)(b * SEQ + tid) * 16 + vh];
    asm volatile("s_waitcnt vmcnt(0)" ::: "memory");
    __syncthreads();
#pragma unroll 1
    for (int t = 0; t < GCH; ++t) {
        const LAS unsigned char* buf = c.lds + (t & 1) * GS_BUF; LAS unsigned char* nbuf = c.lds + ((t + 1) & 1) * GS_BUF;
        const int tok0 = b * SEQ + t * 64;
        const bool more = t + 1 < GCH;
        u32x2 u0r[4];
#pragma unroll
        for (int it = 0; it < 4; ++it) u0r[it] = u0n[it];
        float gstg = 0.f;
        if (more) {
#pragma unroll
            for (int it = 0; it < 4; ++it) u0n[it] = *(const u32x2*)(U0g + (size_t)(t + 1) * 8192 + ((size_t)(w * 4 + it) * 64 + lane) * 4);
            if (tid < 64) gstg = GCg[(size_t)(tok0 + 64 + tid) * 16 + vh];
            GS_DMA(t + 1, (t + 1) & 1);
        }
        const LAS unsigned char* KCD = buf + GS_KCD; const LAS unsigned char* QB = buf + GS_QB; const LAS unsigned char* ATT = buf + GS_ATT; const LAS unsigned char* KT = buf + GS_KT;
        const LAS float* gcS = (const LAS float*)(buf + GS_GC);
        bf16x8 sfrag[4];
#pragma unroll
        for (int ks = 0; ks < 4; ++ks) sfrag[ks] = pack8(sacc[2 * ks], sacc[2 * ks + 1]);
        const float gl = gcS[63], egl = __expf(gl);
        bf16x8 ufrag[2], udfrag[2]; f32x4 ov[4];
#pragma unroll
        for (int hp = 0; hp < 2; ++hp) {
            f32x4 uu[2];
#pragma unroll
            for (int h2 = 0; h2 < 2; ++h2) {
                const int it = 2 * hp + h2;
                f32x4 ks_ = (f32x4){0.f, 0.f, 0.f, 0.f}, qs_ = (f32x4){0.f, 0.f, 0.f, 0.f};
#pragma unroll
                for (int ks = 0; ks < 4; ++ks) {
                    ks_ = __builtin_amdgcn_mfma_f32_16x16x32_bf16(fragA(KCD + offA + it * 4352 + ks * 256), sfrag[ks], ks_, 0, 0, 0);
                    qs_ = __builtin_amdgcn_mfma_f32_16x16x32_bf16(fragA(QB + offA + it * 4352 + ks * 256), sfrag[ks], qs_, 0, 0, 0);
                }
                const f32x4 gci = *(const LAS f32x4*)(gcS + 16 * it + 4 * fq);
                f32x4 u;
                u[0] = bf2f((bf16_t)(u0r[it].x & 0xffff)) - ks_[0]; u[1] = bf2f((bf16_t)(u0r[it].x >> 16)) - ks_[1]; u[2] = bf2f((bf16_t)(u0r[it].y & 0xffff)) - ks_[2]; u[3] = bf2f((bf16_t)(u0r[it].y >> 16)) - ks_[3];
                uu[h2] = u;
#pragma unroll
                for (int r = 0; r < 4; ++r) ov[it][r] = qs_[r] * __expf(gci[r]);
            }
            ufrag[hp] = pack8(uu[0], uu[1]);
            const f32x4 g0 = *(const LAS f32x4*)(gcS + 32 * hp + 4 * fq), g1 = *(const LAS f32x4*)(gcS + 32 * hp + 16 + 4 * fq);
            f32x4 d0, d1;
#pragma unroll
            for (int r = 0; r < 4; ++r) { d0[r] = uu[0][r] * __expf(gl - g0[r]); d1[r] = uu[1][r] * __expf(gl - g1[r]); }
            udfrag[hp] = pack8(d0, d1);
        }
#pragma unroll
        for (int it = 0; it < 4; ++it) {
            f32x4 au = ov[it];
#pragma unroll
            for (int ks = 0; ks < 2; ++ks) au = __builtin_amdgcn_mfma_f32_16x16x32_bf16(fragB(ATT + offB + it * 2304 + ks * 512), ufrag[ks], au, 0, 0, 0);
#pragma unroll
            for (int r = 0; r < 4; ++r) OT[(16 * it + 4 * fq + r) * 132 + 16 * w + fr] = au[r];
        }
        LDS_WAIT(); __builtin_amdgcn_s_barrier(); asm volatile("" ::: "memory");
        const int frow = tid >> 3, fc = tid & 7;
        const u32x4 zlo = *(const u32x4*)(PROJ + (size_t)(tok0 + frow) * GDN_MAIN + 4096 + vh * 128 + 16 * fc), zhi = *(const u32x4*)(PROJ + (size_t)(tok0 + frow) * GDN_MAIN + 4096 + vh * 128 + 16 * fc + 8);
#pragma unroll
        for (int tt = 0; tt < 8; ++tt) {
            f32x4 a = sacc[tt] * egl;
#pragma unroll
            for (int ks = 0; ks < 2; ++ks) a = __builtin_amdgcn_mfma_f32_16x16x32_bf16(fragB(KT + offB + tt * 2304 + ks * 512), udfrag[ks], a, 0, 0, 0);
            sacc[tt] = a;
        }
        {
            float ov16[16], zf[16];
#pragma unroll
            for (int q4 = 0; q4 < 4; ++q4) { const f32x4 v = *(const LAS f32x4*)(OT + frow * 132 + 16 * fc + 4 * q4); ov16[4 * q4] = v.x; ov16[4 * q4 + 1] = v.y; ov16[4 * q4 + 2] = v.z; ov16[4 * q4 + 3] = v.w; }
            float ss = 0.f;
#pragma unroll
            for (int e = 0; e < 16; ++e) ss += ov16[e] * ov16[e];
            ss += __shfl_xor(ss, 1); ss += __shfl_xor(ss, 2); ss += __shfl_xor(ss, 4);
            const float rn = rsqrtf(ss * (1.f / 128.f) + EPS);
            unpack8(zlo, zf); unpack8(zhi, zf + 8);
            float res[16];
#pragma unroll
            for (int e = 0; e < 16; ++e) res[e] = ov16[e] * rn * nwS[16 * fc + e] * siluf(zf[e]);
            u32x4 o0, o1; o0.x = pk2(res[0], res[1]); o0.y = pk2(res[2], res[3]); o0.z = pk2(res[4], res[5]); o0.w = pk2(res[6], res[7]);
            o1.x = pk2(res[8], res[9]); o1.y = pk2(res[10], res[11]); o1.z = pk2(res[12], res[13]); o1.w = pk2(res[14], res[15]);
            bf16_t* mp = MIX + (size_t)(tok0 + frow) * GVW + vh * 128 + 16 * fc;
            *(u32x4*)mp = o0; *(u32x4*)(mp + 8) = o1;
        }
        if (more && tid < 64) *(LAS float*)(nbuf + GS_GC + 4 * tid) = gstg;
        asm volatile("s_waitcnt vmcnt(0)" ::: "memory");
        __syncthreads();
    }
#undef GS_DMA
    float* so = c.p.out + O_PGS + ((size_t)(li * NB + b) * GH + vh) * GDK * GDV;
#pragma unroll
    for (int tt = 0; tt < 8; ++tt)
#pragma unroll
        for (int r = 0; r < 4; ++r) so[(size_t)(16 * tt + 4 * fq + r) * GDV + 16 * w + fr] = sacc[tt][r];
}

DI void gdn_post_token(const Ctx& c, int li, int tok) {
    const bf16_t* PROJ = c.ws<bf16_t>(W_PROJ); const float* Y = c.ws<float>(W_Y); bf16_t* MIX = c.ws<bf16_t>(W_MIXED);
    const float* nw = c.in(I_GNW) + (size_t)li * GDV; const int lane = c.lane;
#pragma unroll 1
    for (int it = 0; it < 4; ++it) {
        const int ch0 = 512 * it + 8 * lane; float o[8], z[8], w[8];
        load8f(Y + (size_t)tok * 2048 + ch0, o); unpack8(*(const u32x4*)(PROJ + (size_t)tok * GDN_MAIN + 4096 + ch0), z); load8f(nw + (ch0 & 127), w);
        float ss = 0.f;
#pragma unroll
        for (int e = 0; e < 8; ++e) ss += o[e] * o[e];
        ss += __shfl_xor(ss, 1); ss += __shfl_xor(ss, 2); ss += __shfl_xor(ss, 4); ss += __shfl_xor(ss, 8);
        const float r = rsqrtf(ss * (1.f / 128.f) + EPS);
        u32x4 ov; ov.x = pk2(o[0] * r * w[0] * siluf(z[0]), o[1] * r * w[1] * siluf(z[1])); ov.y = pk2(o[2] * r * w[2] * siluf(z[2]), o[3] * r * w[3] * siluf(z[3]));
        ov.z = pk2(o[4] * r * w[4] * siluf(z[4]), o[5] * r * w[5] * siluf(z[5])); ov.w = pk2(o[6] * r * w[6] * siluf(z[6]), o[7] * r * w[7] * siluf(z[7]));
        *(u32x4*)(MIX + (size_t)tok * GVW + ch0) = ov;
    }
}

DI void cache_copy(const Ctx& c, int wg, int nwg) {
    const size_t gt = (size_t)wg * NTHR + c.tid, gn = (size_t)nwg * NTHR;
    const size_t per = (size_t)(WIN - 1) * AW / 4, tot = (size_t)2 * NS * per;
#pragma unroll 4
    for (size_t i = gt; i < tot; i += gn) { const size_t sq = i / per, r = i % per;
        ((f32x4*)(c.p.out + O_SK + sq * WIN * AW))[r] = ((const f32x4*)(c.in(I_CK) + sq * WIN * AW + AW))[r];
        ((f32x4*)(c.p.out + O_SV + sq * WIN * AW))[r] = ((const f32x4*)(c.in(I_CV) + sq * WIN * AW + AW))[r]; }
}
constexpr int PH_PER_LAYER = 10, N_PHASES = 1 + 2 * 10 + 2 * 8;
DI void phase_decode(int ph, int& l, int& sp) {
    int q = ph - 1; l = 0; if (q >= 10) { q -= 10; l = 1; if (q >= 8) { q -= 8; l = 2; if (q >= 10) { q -= 10; l = 3; } } }
    sp = (l & 1) ? (q >= 3 ? q + 2 : (q == 2 ? 3 : q)) : q;
}
#ifndef ONLY
#define ONLY -1
#endif
#define EN(x) (ONLY < 0 || ONLY == (x))
DI void run_phase(const Ctx& c, int ph) {
    if (ph == 0) { if (!EN(0)) return;
        for (int i = 0; i < 2; ++i) {
            transpose_mat(c, c.in(I_WHIN) + (size_t)i * D * HYB_IN, D, HYB_IN, c.ws<bf16_t>(W_HIN) + (size_t)i * HYB_IN * D, 0);
            transpose_mat(c, c.in(I_WHOUT) + (size_t)i * HYB_MIX * D, HYB_MIX, D, c.ws<bf16_t>(W_HOUT) + (size_t)i * D * HYB_MIX, 0);
            transpose_mat(c, c.in(I_WGIN) + (size_t)i * D * GDN_IN, D, GDN_IN, c.ws<bf16_t>(W_GIN) + (size_t)i * GDN_IN * D, 0);
            transpose_mat(c, c.in(I_WGOUT) + (size_t)i * GVW * D, GVW, D, c.ws<bf16_t>(W_GOUT) + (size_t)i * D * GVW, 0);
        }
        for (int l = 0; l < 4; ++l) {
            transpose_mat(c, c.in(I_WFG) + (size_t)l * D * FF, D, FF, c.ws<bf16_t>(W_GU) + (size_t)l * 2 * FF * D, 1);
            transpose_mat(c, c.in(I_WFU) + (size_t)l * D * FF, D, FF, c.ws<bf16_t>(W_GU) + (size_t)l * 2 * FF * D, 2);
            transpose_mat(c, c.in(I_WFD) + (size_t)l * FF * D, FF, D, c.ws<bf16_t>(W_DN) + (size_t)l * D * FF, 0);
        }
        rowpass_phase(c, 0, nullptr, c.in(I_NMPRE), true);
        return;
    }
    int l, sp; phase_decode(ph, l, sp); const int li = l >> 1; const bool hyb = (l & 1) == 0;
    bf16_t* H = c.ws<bf16_t>(W_H); bf16_t* PROJ = c.ws<bf16_t>(W_PROJ); bf16_t* MIX = c.ws<bf16_t>(W_MIXED); bf16_t* GO = c.ws<bf16_t>(W_GO); bf16_t* HID = c.ws<bf16_t>(W_HID);
    switch (sp) {
    case 0: {
        if (!EN(1)) break;
        const bf16_t* Wt = hyb ? c.ws<bf16_t>(W_HIN) + (size_t)li * HYB_IN * D : c.ws<bf16_t>(W_GIN) + (size_t)li * GDN_IN * D;
        const int nmain = hyb ? HYB_MAIN : GDN_MAIN, nall = hyb ? HYB_IN : GDN_IN;
        { pg8::Gemm g{H, Wt, T, nmain, D}; pg8::StaticOrder S; S.init(T, nmain, gridDim.x, blockIdx.x); pg8::EpiBf16Perm E{PROJ, nmain};
          pg8::gemm_phase<pg8::EpiBf16Perm, pg8::StaticOrder>(c.lds, g, S, E, nullptr); }
        { Epi e{0, PROJ, c.ws<float>(W_EXTRA), nmain, 0}; gemm_ksplit<4>(c, H, D, T, Wt + (size_t)nmain * D, D, nall - nmain, D, e); }
        { Epi e{0, PROJ + (size_t)T * nmain, c.ws<float>(W_EXTRA) + (size_t)T * 32, nmain, nmain}; gemm_ksplit<2>(c, H + (size_t)T * D, D, NS, Wt, D, nall, D, e); }
    } break;
    case 1: {
        if (hyb) {
            if (EN(2)) for (int tok = c.gw; tok < TT; tok += c.ngw) hyb_pre_token(c, li, tok);
            LAS float* pl = (LAS float*)(c.lds + NWAVE * AT_LDS + c.wave * 2048);
            if (EN(3)) { if (c.wave == 0) for (int it = T * AH + blockIdx.x; it < TT * AH; it += gridDim.x) attn_wave(c, li, it / AH, it % AH, pl);
                         for (int it = c.gw; it < NB * AH * 256; it += c.ngw) attn_mfma_item(c, li, it); }
        } else { if (EN(4)) {
            for (int tok = T + c.gw; tok < TT; tok += c.ngw) gdn_pre_token(c, li, tok);
            for (int rg = blockIdx.x; rg < T / 64; rg += gridDim.x) {
                gdn_pre_range(c, li, rg * 8 + c.wave);
                asm volatile("s_waitcnt vmcnt(0)" ::: "memory"); __syncthreads();
                const int bb = rg >> 6, ch = rg & 63;
#pragma unroll 1
                for (int k2 = 0; k2 < 2; ++k2) gdn_a_item(c, li, ((bb * GH + 2 * c.wave + k2) << 6) + ch);
                __syncthreads();
            } } }
    } break;
    case 2: {
        if (hyb) { if (EN(5)) { for (int it = blockIdx.x; it < NB * NCH * 2; it += gridDim.x) ssd_a_item(c, li, it);
                                for (int it = c.gw; it < NS * SH; it += c.ngw) ssd_sample_item(c, li, it); } }
        else { }
    } break;
    case 3: {
        if (hyb) { if (EN(7)) { ssd_scan_phase(c, li); for (int tok = T + c.gw; tok < TT; tok += c.ngw) hyb_post_token(c, li, tok); } }
        else { if (EN(8)) { for (int it = blockIdx.x; it < NB * GH; it += gridDim.x) gdn_scan_wg(c, li, it);
                            if ((int)blockIdx.x >= NB * GH) { gdn_seq_phase(c, li, NB * GH, blockIdx.x - NB * GH, gridDim.x - NB * GH);
                                                              if (l == 1) cache_copy(c, blockIdx.x - NB * GH, gridDim.x - NB * GH); } } }
    } break;
    case 4: {
        if (hyb) { if (EN(14)) for (int it = blockIdx.x; it < NB * NCH * 2; it += gridDim.x) ssd_b_item(c, li, it); }
    } break;
    case 5: {
        if (!EN(9)) break;
        const bf16_t* Wt = hyb ? c.ws<bf16_t>(W_HOUT) + (size_t)li * D * HYB_MIX : c.ws<bf16_t>(W_GOUT) + (size_t)li * D * GVW; const int kk = hyb ? HYB_MIX : GVW;
        { pg8::Gemm g{MIX, Wt, T, D, kk}; pg8::StaticOrder S; S.init(T, D, gridDim.x, blockIdx.x); pg8::EpiBf16Perm E{GO, D};
          pg8::gemm_phase<pg8::EpiBf16Perm, pg8::StaticOrder>(c.lds, g, S, E, nullptr); }
        { Epi e{0, GO + (size_t)T * D, nullptr, D, D}; gemm_ksplit<2>(c, MIX + (size_t)T * kk, kk, NS, Wt, kk, D, kk, e); }
    } break;
    case 6: if (EN(10)) rowpass_phase(c, 1, c.in(I_NMPOST) + (size_t)l * D, c.in(I_NFPRE) + (size_t)l * D, l == 0); break;
    case 7: if (EN(11)) { const bf16_t* Wt = c.ws<bf16_t>(W_GU) + (size_t)l * 2 * FF * D;
        { pg8::Gemm g{H, Wt, T, 2 * FF, D}; pg8::StaticOrder S; S.init(T, 2 * FF, gridDim.x, blockIdx.x); pg8::EpiSwiglu E{HID, FF};
          pg8::gemm_phase<pg8::EpiSwiglu, pg8::StaticOrder>(c.lds, g, S, E, nullptr); }
        { Epi e{2, HID + (size_t)T * FF, nullptr, FF, 0}; gemm_ksplit<2>(c, H + (size_t)T * D, D, NS, Wt, D, 2 * FF, D, e); } } break;
    case 8: if (EN(12)) { const bf16_t* Wt = c.ws<bf16_t>(W_DN) + (size_t)l * D * FF;
        { pg8::Gemm g{HID, Wt, T, D, FF}; pg8::StaticOrder S; S.init(T, D, gridDim.x, blockIdx.x); pg8::EpiBf16Perm E{GO, D};
          pg8::gemm_phase<pg8::EpiBf16Perm, pg8::StaticOrder>(c.lds, g, S, E, nullptr); }
        { Epi e{0, GO + (size_t)T * D, nullptr, D, D}; gemm_ksplit<2>(c, HID + (size_t)T * FF, FF, NS, Wt, FF, D, FF, e); } } break;
    case 9: if (EN(13)) rowpass_phase(c, l == DEPTH - 1 ? 2 : 1, c.in(I_NFPOST) + (size_t)l * D, l == DEPTH - 1 ? nullptr : c.in(I_NMPRE) + (size_t)(l + 1) * D, false); break;
    default: break;
    }
}

extern __shared__ __attribute__((aligned(16))) unsigned char g_shm[];
__global__ void __launch_bounds__(NTHR, 2) mega(Params p) {
    cg::grid_group grid = cg::this_grid();
    volatile LAS unsigned* bst = (volatile LAS unsigned*)((LAS unsigned char*)g_shm + LDS_BYTES - 16);
    if (threadIdx.x == 0) { bst[0] = 0u; bst[1] = 0u; bst[2] = 0u; bst[3] = 0u; }
    __syncthreads();
    const XcdBarrier xb = xcd_barrier_post((unsigned*)p.ws, bst);
    for (int ph = p.ph_lo; ph < p.ph_hi; ++ph) {
        int tid_ = threadIdx.x; asm volatile("" : "+v"(tid_));
        Ctx c; c.p.kp = (KParams)__builtin_amdgcn_kernarg_segment_ptr(); c.p.out = c.p.kp->out; c.tid = tid_; c.lane = tid_ & 63; c.wave = __builtin_amdgcn_readfirstlane(tid_ >> 6);
        c.gw = blockIdx.x * NWAVE + c.wave; c.ngw = gridDim.x * NWAVE; c.lds = (LAS unsigned char*)g_shm;
        run_phase(c, ph);
#ifdef PROBE_MASK
        { int l_ = 0, sp_ = 0; if (ph > 0) phase_decode(ph, l_, sp_); const int bit = ph == 0 ? 20 : sp_ + 10 * (l_ & 1);
          if ((PROBE_MASK >> bit) & 1) { xcd_barrier(xb); run_phase(c, ph); } }
#endif
        if (ph + 1 < p.ph_hi) { if (ph == p.ph_lo) grid.sync(); else xcd_barrier(xb); }
    }
}

extern "C" void kernel_launch(void* const* d_in, const int* in_sizes, int n_in, void* d_out, int out_size, void* d_ws, size_t ws_size, hipStream_t stream) {
    static int grid = 0;
    if (!grid) {
        int dev = 0, cus = 0, per = 0; hipGetDevice(&dev); hipDeviceGetAttribute(&cus, hipDeviceAttributeMultiprocessorCount, dev);
        hipFuncSetAttribute((const void*)mega, hipFuncAttributeMaxDynamicSharedMemorySize, LDS_BYTES);
        hipOccupancyMaxActiveBlocksPerMultiprocessor(&per, (const void*)mega, NTHR, LDS_BYTES);
        if (n_in != 30 || (size_t)out_size != O_END || ws_size < W_END) fprintf(stderr, "kernel_launch: unexpected shapes n_in %d out %d (want %zu) ws %zu (want %zu)\n", n_in, out_size, (size_t)O_END, ws_size, (size_t)W_END);
        if (per < 1) fprintf(stderr, "kernel_launch: occupancy query says %d blocks per CU\n", per);
        grid = cus;
    }
    hipMemsetAsync(d_ws, 0, 16384, stream);
    Params p{}; for (int i = 0; i < 30; ++i) p.in[i] = (const float*)d_in[i];
    p.out = (float*)d_out; p.ws = (unsigned char*)d_ws; p.ph_lo = 0; p.ph_hi = N_PHASES;
    void* args[] = {&p};
    hipError_t e = hipLaunchCooperativeKernel((const void*)mega, dim3(grid), dim3(NTHR), args, LDS_BYTES, stream);
    if (e != hipSuccess) fprintf(stderr, "kernel_launch: cooperative launch failed: %s\n", hipGetErrorString(e));
}
```

```cpp
#include <hip/hip_runtime.h>
#include <hip/hip_cooperative_groups.h>
#include <cstdio>
#include <cstdint>
namespace cg = cooperative_groups;

#define DI __device__ __forceinline__
#define LAS __attribute__((address_space(3)))
typedef unsigned short bf16_t;
typedef short bf16x8 __attribute__((ext_vector_type(8)));
typedef float f32x4 __attribute__((ext_vector_type(4)));
typedef unsigned u32x2 __attribute__((ext_vector_type(2)));
typedef unsigned u32x4 __attribute__((ext_vector_type(4)));

constexpr int D = 1024, NB = 4, SEQ = 4096, T = NB * SEQ, NS = 32, TT = T + NS, DEPTH = 4;
constexpr int AH = 8, AHD = 64, AW = 512, WIN = 2048;
constexpr int SH = 16, SP = 64, SN = 128, SG = 2, SDI = 1024, SXBC = 1536;
constexpr int HYB_IN = 4112, HYB_MAIN = 4096, HYB_MIX = 1536;
constexpr int GH = 16, GQH = 8, GDK = 128, GDV = 128, GQKV = 4096, GVW = 2048, GDN_IN = 6176, GDN_MAIN = 6144;
constexpr int FF = 2816;
constexpr float EPS = 1e-6f;
constexpr int NTHR = 512, NWAVE = 8, LDS_BYTES = 163840;

enum { I_XP = 0, I_XS, I_CK, I_CV, I_SCONV, I_SSM, I_GCONV, I_GST, I_RELB, I_NMPRE, I_NMPOST, I_NFPRE, I_NFPOST, I_WHIN, I_SCW, I_SCB, I_SDTB, I_SALOG, I_SD, I_SNW,
       I_WHOUT, I_WGIN, I_GCW, I_GDTB, I_GALOG, I_GNW, I_WGOUT, I_WFG, I_WFU, I_WFD };

constexpr size_t O_YP = 0;
constexpr size_t O_YS = O_YP + (size_t)T * D;
constexpr size_t O_PK = O_YS + (size_t)NS * D;
constexpr size_t O_PV = O_PK + (size_t)2 * NB * WIN * AW;
constexpr size_t O_PSC = O_PV + (size_t)2 * NB * WIN * AW;
constexpr size_t O_PSS = O_PSC + (size_t)2 * NB * 3 * SXBC;
constexpr size_t O_PGC = O_PSS + (size_t)2 * NB * SH * SP * SN;
constexpr size_t O_PGS = O_PGC + (size_t)2 * NB * 3 * GQKV;
constexpr size_t O_SK = O_PGS + (size_t)2 * NB * GH * GDK * GDV;
constexpr size_t O_SV = O_SK + (size_t)2 * NS * WIN * AW;
constexpr size_t O_SSC = O_SV + (size_t)2 * NS * WIN * AW;
constexpr size_t O_SSS = O_SSC + (size_t)2 * NS * 3 * SXBC;
constexpr size_t O_SGC = O_SSS + (size_t)2 * NS * SH * SP * SN;
constexpr size_t O_SGS = O_SGC + (size_t)2 * NS * 3 * GQKV;
constexpr size_t O_END = O_SGS + (size_t)2 * NS * GH * GDK * GDV;

constexpr size_t al256(size_t x) { return (x + 255) & ~(size_t)255; }
constexpr size_t W_CTL = 0;
constexpr size_t W_HIN = 65536;
constexpr size_t W_HOUT = al256(W_HIN + (size_t)2 * HYB_IN * D * 2);
constexpr size_t W_GIN = al256(W_HOUT + (size_t)2 * D * HYB_MIX * 2);
constexpr size_t W_GOUT = al256(W_GIN + (size_t)2 * GDN_IN * D * 2);
constexpr size_t W_GU = al256(W_GOUT + (size_t)2 * D * GVW * 2);
constexpr size_t W_DN = al256(W_GU + (size_t)4 * 2 * FF * D * 2);
constexpr size_t W_X = al256(W_DN + (size_t)4 * D * FF * 2);
constexpr size_t W_H = al256(W_X + (size_t)TT * D * 4);
constexpr size_t W_PROJ = al256(W_H + (size_t)TT * D * 2);
constexpr size_t W_EXTRA = al256(W_PROJ + (size_t)TT * GDN_MAIN * 2);
constexpr size_t W_MIXED = al256(W_EXTRA + (size_t)TT * 32 * 4);
constexpr size_t W_GO = al256(W_MIXED + (size_t)TT * GVW * 2);
constexpr size_t W_HID = al256(W_GO + (size_t)TT * D * 4);
constexpr size_t W_ACT = al256(W_HID + (size_t)TT * FF * 2);
constexpr size_t W_AUX = al256(W_ACT + (size_t)TT * 4096 * 4);
constexpr size_t W_Y = al256(W_AUX + (size_t)TT * 32 * 4);
constexpr size_t W_END = al256(W_Y + (size_t)TT * 2048 * 4);

struct Params { const float* in[30]; float* out; unsigned char* ws; int ph_lo, ph_hi; };

DI float bf2f(bf16_t b) { return __uint_as_float(((unsigned)b) << 16); }
DI bf16_t f2bf(float x) { unsigned u = __float_as_uint(x); u += 0x7fffu + ((u >> 16) & 1u); return (bf16_t)(u >> 16); }
typedef float f32x2_ __attribute__((ext_vector_type(2))); typedef __bf16 bf16x2_ __attribute__((ext_vector_type(2)));
DI unsigned pk2(float lo, float hi) { const f32x2_ v = {lo, hi}; return __builtin_bit_cast(unsigned, __builtin_convertvector(v, bf16x2_)); }
DI float wave_sum(float v) {
#pragma unroll
    for (int o = 32; o >= 1; o >>= 1) v += __shfl_xor(v, o);
    return v;
}
DI float wave_max(float v) {
#pragma unroll
    for (int o = 32; o >= 1; o >>= 1) v = fmaxf(v, __shfl_xor(v, o));
    return v;
}
DI float siluf(float x) { return x / (1.f + __expf(-x)); }
DI float sigmoidf_(float x) { return 1.f / (1.f + __expf(-x)); }
DI float softplusf_(float x) { return fmaxf(x, 0.f) + log1pf(__expf(-fabsf(x))); }
#define LDS_WAIT() asm volatile("s_waitcnt lgkmcnt(0)" ::: "memory")
DI bf16x8 lds_frag(const LAS bf16_t* p) { return *(const LAS bf16x8*)p; }
DI bf16x8 lds_frag2(const LAS bf16_t* p0, const LAS bf16_t* p1) {
    const u32x2 a = *(const LAS u32x2*)p0, b = *(const LAS u32x2*)p1; u32x4 r; r.x = a.x; r.y = a.y; r.z = b.x; r.w = b.y; return __builtin_bit_cast(bf16x8, r);
}
DI bf16x8 pack8(const f32x4 a, const f32x4 b) { u32x4 r; r.x = pk2(a.x, a.y); r.y = pk2(a.z, a.w); r.z = pk2(b.x, b.y); r.w = pk2(b.z, b.w); return __builtin_bit_cast(bf16x8, r); }

__device__ const unsigned char c_bucket[3][129] = {
 {0,1,2,3,4,5,6,7,8,9,10,11,12,13,14,15,16,16,16,16,16,16,17,17,17,17,17,17,17,17,18,18,18,18,18,18,18,18,18,18,19,19,19,19,19,19,19,19,19,19,19,19,19,19,20,20,20,20,20,20,20,20,20,20,20,20,20,20,20,20,20,20,20,21,21,21,21,21,21,21,21,21,21,21,21,21,21,21,21,21,21,21,21,21,21,21,21,21,21,22,22,22,22,22,22,22,22,22,22,22,22,22,22,22,22,22,22,22,22,22,22,22,22,22,22,22,22,22,22},
 {0,4,8,12,16,16,17,17,18,18,19,19,19,19,20,20,20,20,20,21,21,21,21,21,21,22,22,22,22,22,22,22,22,22,23,23,23,23,23,23,23,23,23,23,23,23,24,24,24,24,24,24,24,24,24,24,24,24,24,24,24,24,25,25,25,25,25,25,25,25,25,25,25,25,25,25,25,25,25,25,25,25,25,26,26,26,26,26,26,26,26,26,26,26,26,26,26,26,26,26,26,26,26,26,26,26,26,26,26,26,26,26,26,27,27,27,27,27,27,27,27,27,27,27,27,27,27,27,27},
 {0,16,18,19,20,21,21,22,22,23,23,23,24,24,24,24,25,25,25,25,25,26,26,26,26,26,26,26,26,27,27,27,27,27,27,27,27,27,27,28,28,28,28,28,28,28,28,28,28,28,28,28,29,29,29,29,29,29,29,29,29,29,29,29,29,29,29,29,29,29,30,30,30,30,30,30,30,30,30,30,30,30,30,30,30,30,30,30,30,30,30,30,30,30,30,31,31,31,31,31,31,31,31,31,31,31,31,31,31,31,31,31,31,31,31,31,31,31,31,31,31,31,31,31,31,31,31,31,31}};

typedef const Params __attribute__((address_space(4)))* KParams;
struct OutRef { float* out; DI float* operator+(size_t o) const { return out + o; } };
struct PRef { KParams kp; float* out; };
#define XB_TMO      128
#define XB_XCNT(j)  (256  + 64 * (j))
#define XB_XSUB(j)  (1280 + 64 * (j))
#define XB_XGEN(j)  (2304 + 64 * (j))
#define XB_TOP      3328
#define XB_TOPGEN   3392
#define XCD_BAR_WORDS 3456
#define XB_SPIN_CAP (1u << 22)

__device__ __forceinline__ unsigned xb_ld(unsigned* p)              { return __hip_atomic_load(p, __ATOMIC_RELAXED, __HIP_MEMORY_SCOPE_AGENT); }
__device__ __forceinline__ unsigned xb_add(unsigned* p, unsigned v) { return __hip_atomic_fetch_add(p, v, __ATOMIC_RELAXED, __HIP_MEMORY_SCOPE_AGENT); }
__device__ __forceinline__ unsigned xb_xcc_id() { return (unsigned)__builtin_amdgcn_s_getreg((3 << 11) | 20) & 0xFu; }
#define XB_SPIN(cond, bar) do { unsigned _sp = 0; while (cond) { __builtin_amdgcn_s_sleep(1); \
    if ((++_sp & 255u) == 0u) { if (xb_ld(&(bar)[XB_TMO])) break; if (_sp > XB_SPIN_CAP) { atomicAdd(&(bar)[XB_TMO], 1u); break; } } } } while (0)

struct XcdBarrier {
    unsigned* bar; unsigned x;
    volatile LAS unsigned* st;
};

__device__ __forceinline__ XcdBarrier xcd_barrier_post(unsigned* bar, volatile LAS unsigned* st) {
    XcdBarrier b; b.bar = bar; b.x = xb_xcc_id(); b.st = st;
    if (threadIdx.x == 0) (void)xb_add(&bar[XB_XCNT(b.x)], 1u);
    return b;
}
__device__ __forceinline__ void xcd_barrier_complete(unsigned* bar, unsigned x, unsigned& nloc, unsigned& nx) {
    const unsigned G = gridDim.x * gridDim.y * gridDim.z;
    unsigned sum, cnt, mine, sp = 0u;
    for (;;) {
        sum = 0u; cnt = 0u; mine = 0u;
#pragma unroll
        for (unsigned j = 0; j < 16; ++j) { const unsigned c = xb_ld(&bar[XB_XCNT(j)]); sum += c; cnt += (c > 0u) ? 1u : 0u; mine = (j == x) ? c : mine; }
        if (sum == G) break;
        __builtin_amdgcn_s_sleep(1);
        if ((++sp & 255u) == 0u) { if (xb_ld(&bar[XB_TMO])) break; if (sp > XB_SPIN_CAP) { atomicAdd(&bar[XB_TMO], 1u); break; } }
    }
    nloc = mine > 0u ? mine : 1u; nx = cnt > 0u ? cnt : 1u;
}

__device__ __forceinline__ void xcd_barrier(const XcdBarrier& b) {
    asm volatile("s_waitcnt vmcnt(0)" ::: "memory");
    __syncthreads();
    if (threadIdx.x == 0) {
        unsigned* bar = b.bar;
        __builtin_amdgcn_s_waitcnt(0);
        unsigned nloc = b.st[0], nx = b.st[1];
        if (nloc == 0u) { xcd_barrier_complete(bar, b.x, nloc, nx); b.st[0] = nloc; b.st[1] = nx; }
        const unsigned old = xb_add(&bar[XB_XSUB(b.x)], 1u);
        const unsigned gen = old / nloc;
        if (old + 1u == (gen + 1u) * nloc) {
            __builtin_amdgcn_fence(__ATOMIC_RELEASE, "agent");
            asm volatile("s_waitcnt vmcnt(0)" ::: "memory");
            const unsigned og = xb_add(&bar[XB_TOP], 1u);
            const unsigned tg = og / nx;
            if (og + 1u == (tg + 1u) * nx) xb_add(&bar[XB_TOPGEN], 1u);
            else XB_SPIN(xb_ld(&bar[XB_TOPGEN]) == tg, bar);
            __builtin_amdgcn_fence(__ATOMIC_ACQUIRE, "agent");
            xb_add(&bar[XB_XGEN(b.x)], 1u);
            asm volatile("s_waitcnt vmcnt(0)" ::: "memory");
        } else {
            XB_SPIN(xb_ld(&bar[XB_XGEN(b.x)]) == gen, bar);
            __builtin_amdgcn_fence(__ATOMIC_ACQUIRE, "agent");
            asm volatile("s_waitcnt vmcnt(0)" ::: "memory");
        }
    }
    __syncthreads();
}

struct Ctx {
    PRef p; int tid, lane, wave, gw, ngw; LAS unsigned char* lds;
    DI const float* in(int i) const { return p.kp->in[i]; }
    template <class Tp> DI Tp* ws(size_t off) const { return (Tp*)(p.kp->ws + off); }
};

DI int rowmap(int n, int map) { return map == 0 ? n : (32 * (n >> 4) + (n & 15) + (map == 2 ? 16 : 0)); }
DI void transpose_item(const float* W, int K, int N, bf16_t* WT, int map, LAS float* scr, int item, int lane) {
    const int nblk = (N + 31) / 32, kb = item / nblk, nb = item % nblk, k0 = 64 * kb, n0 = 32 * nb;
    float wv[32];
#pragma unroll
    for (int i = 0; i < 32; ++i) { const int kk = 2 * i + (lane >> 5), n = n0 + (lane & 31); wv[i] = n < N ? W[(size_t)(k0 + kk) * N + n] : 0.f; }
#pragma unroll
    for (int i = 0; i < 32; ++i) scr[(2 * i + (lane >> 5)) * 33 + (lane & 31)] = wv[i];
    LDS_WAIT();
    const int c = lane & 7;
#pragma unroll
    for (int j = 0; j < 4; ++j) {
        const int nn = (lane >> 3) + 8 * j, n = n0 + nn; const LAS float* s = scr + (8 * c) * 33 + nn;
        u32x4 o; o.x = pk2(s[0], s[33]); o.y = pk2(s[66], s[99]); o.z = pk2(s[132], s[165]); o.w = pk2(s[198], s[231]);
        if (n < N) *(u32x4*)(WT + (size_t)rowmap(n, map) * K + k0 + 8 * c) = o;
    }
    LDS_WAIT();
}
DI void transpose_mat(const Ctx& c, const float* W, int K, int N, bf16_t* WT, int map, int gw0 = -1, int ngw0 = 0) {
    LAS float* scr = (LAS float*)(c.lds + c.wave * 8704);
    const int nit = (K / 64) * ((N + 31) / 32);
    const int g0 = gw0 < 0 ? c.gw : gw0, n0 = gw0 < 0 ? c.ngw : ngw0;
    for (int it = g0; it < nit; it += n0) transpose_item(W, K, N, WT, map, scr, it, c.lane);
}

DI void rowpass_row(const float* xrow, const bf16_t* gorow, const float* gpost, const float* gnext, float* xdst, bf16_t* hrow, float* yout, int lane) {
    f32x4 x[4]; float ss = 0.f;
    if (gorow) {
        f32x4 g[4];
#pragma unroll
        for (int j = 0; j < 4; ++j) { const u32x2 gv = *(const u32x2*)(gorow + 4 * lane + 256 * j); g[j] = (f32x4){bf2f((bf16_t)(gv.x & 0xffff)), bf2f((bf16_t)(gv.x >> 16)), bf2f((bf16_t)(gv.y & 0xffff)), bf2f((bf16_t)(gv.y >> 16))}; ss += g[j].x * g[j].x + g[j].y * g[j].y + g[j].z * g[j].z + g[j].w * g[j].w; }
        const float r = rsqrtf(wave_sum(ss) * (1.f / D) + EPS);
#pragma unroll
        for (int j = 0; j < 4; ++j) { const f32x4 w = *(const f32x4*)(gpost + 4 * lane + 256 * j); x[j] = *(const f32x4*)(xrow + 4 * lane + 256 * j) + g[j] * r * w; }
    } else {
#pragma unroll
        for (int j = 0; j < 4; ++j) x[j] = *(const f32x4*)(xrow + 4 * lane + 256 * j);
    }
    if (xdst) {
#pragma unroll
        for (int j = 0; j < 4; ++j) *(f32x4*)(xdst + 4 * lane + 256 * j) = x[j];
    }
    if (yout) {
#pragma unroll
        for (int j = 0; j < 4; ++j) *(f32x4*)(yout + 4 * lane + 256 * j) = x[j];
    }
    if (hrow) {
        float s2 = 0.f;
#pragma unroll
        for (int j = 0; j < 4; ++j) s2 += x[j].x * x[j].x + x[j].y * x[j].y + x[j].z * x[j].z + x[j].w * x[j].w;
        const float r2 = rsqrtf(wave_sum(s2) * (1.f / D) + EPS);
#pragma unroll
        for (int j = 0; j < 4; ++j) { const f32x4 w = *(const f32x4*)(gnext + 4 * lane + 256 * j); const f32x4 h = x[j] * r2 * w;
            u32x2 o; o.x = pk2(h.x, h.y); o.y = pk2(h.z, h.w); *(u32x2*)(hrow + 4 * lane + 256 * j) = o; }
    }
}
DI void rowpass_rows4(const float* xrow, const bf16_t* gorow, const float* gpost, const float* gnext, float* xdst, bf16_t* hrow, float* yout, int lane) {
    f32x4 x[4][4]; float ss[4] = {0.f, 0.f, 0.f, 0.f};
#pragma unroll
    for (int r = 0; r < 4; ++r)
#pragma unroll
        for (int j = 0; j < 4; ++j) x[r][j] = *(const f32x4*)(xrow + (size_t)r * D + 4 * lane + 256 * j);
    if (gorow) {
        u32x2 gv[4][4];
#pragma unroll
        for (int r = 0; r < 4; ++r)
#pragma unroll
            for (int j = 0; j < 4; ++j) gv[r][j] = *(const u32x2*)(gorow + (size_t)r * D + 4 * lane + 256 * j);
        f32x4 wp[4];
#pragma unroll
        for (int j = 0; j < 4; ++j) wp[j] = *(const f32x4*)(gpost + 4 * lane + 256 * j);
#pragma unroll
        for (int r = 0; r < 4; ++r)
#pragma unroll
            for (int j = 0; j < 4; ++j) { const float a = bf2f((bf16_t)(gv[r][j].x & 0xffff)), b2 = bf2f((bf16_t)(gv[r][j].x >> 16)), c2 = bf2f((bf16_t)(gv[r][j].y & 0xffff)), d2 = bf2f((bf16_t)(gv[r][j].y >> 16)); ss[r] += a * a + b2 * b2 + c2 * c2 + d2 * d2; }
#pragma unroll
        for (int o = 32; o >= 1; o >>= 1) { ss[0] += __shfl_xor(ss[0], o); ss[1] += __shfl_xor(ss[1], o); ss[2] += __shfl_xor(ss[2], o); ss[3] += __shfl_xor(ss[3], o); }
#pragma unroll
        for (int r = 0; r < 4; ++r) { const float rn = rsqrtf(ss[r] * (1.f / D) + EPS);
#pragma unroll
            for (int j = 0; j < 4; ++j) { const f32x4 g = (f32x4){bf2f((bf16_t)(gv[r][j].x & 0xffff)), bf2f((bf16_t)(gv[r][j].x >> 16)), bf2f((bf16_t)(gv[r][j].y & 0xffff)), bf2f((bf16_t)(gv[r][j].y >> 16))}; x[r][j] += g * rn * wp[j]; } }
    }
    if (xdst) {
#pragma unroll
        for (int r = 0; r < 4; ++r)
#pragma unroll
            for (int j = 0; j < 4; ++j) *(f32x4*)(xdst + (size_t)r * D + 4 * lane + 256 * j) = x[r][j];
    }
    if (yout) {
#pragma unroll
        for (int r = 0; r < 4; ++r)
#pragma unroll
            for (int j = 0; j < 4; ++j) *(f32x4*)(yout + (size_t)r * D + 4 * lane + 256 * j) = x[r][j];
    }
    if (hrow) {
        float s2[4];
#pragma unroll
        for (int r = 0; r < 4; ++r) { s2[r] = 0.f;
#pragma unroll
            for (int j = 0; j < 4; ++j) s2[r] += x[r][j].x * x[r][j].x + x[r][j].y * x[r][j].y + x[r][j].z * x[r][j].z + x[r][j].w * x[r][j].w; }
#pragma unroll
        for (int o = 32; o >= 1; o >>= 1) { s2[0] += __shfl_xor(s2[0], o); s2[1] += __shfl_xor(s2[1], o); s2[2] += __shfl_xor(s2[2], o); s2[3] += __shfl_xor(s2[3], o); }
        f32x4 wn[4];
#pragma unroll
        for (int j = 0; j < 4; ++j) wn[j] = *(const f32x4*)(gnext + 4 * lane + 256 * j);
#pragma unroll
        for (int r = 0; r < 4; ++r) { const float r2 = rsqrtf(s2[r] * (1.f / D) + EPS);
#pragma unroll
            for (int j = 0; j < 4; ++j) { const f32x4 h = x[r][j] * r2 * wn[j]; u32x2 o; o.x = pk2(h.x, h.y); o.y = pk2(h.z, h.w); *(u32x2*)(hrow + (size_t)r * D + 4 * lane + 256 * j) = o; } }
    }
}
DI void rowpass_phase(const Ctx& c, int mode, const float* gpost, const float* gnext, bool x_from_input) {
    float* X = c.ws<float>(W_X); const bf16_t* GO = c.ws<bf16_t>(W_GO); bf16_t* H = c.ws<bf16_t>(W_H);
    int lane_ = c.lane; asm volatile("" : "+v"(lane_));
    for (int row = T + c.gw; row < TT; row += c.ngw) {
        const float* xrow = x_from_input ? c.in(I_XS) + (size_t)(row - T) * D : X + (size_t)row * D;
        if (mode == 0) rowpass_row(xrow, nullptr, nullptr, gnext, nullptr, H + (size_t)row * D, nullptr, lane_);
        else if (mode == 1) rowpass_row(xrow, GO + (size_t)row * D, gpost, gnext, X + (size_t)row * D, H + (size_t)row * D, nullptr, lane_);
        else rowpass_row(xrow, GO + (size_t)row * D, gpost, nullptr, nullptr, nullptr, c.p.out + O_YS + (size_t)(row - T) * D, lane_);
    }
    for (int g4 = c.gw; g4 < T / 4; g4 += c.ngw) {
        const int row = 4 * g4;
        const float* xrow = x_from_input ? c.in(I_XP) + (size_t)row * D : X + (size_t)row * D;
        if (mode == 0) rowpass_rows4(xrow, nullptr, nullptr, gnext, nullptr, H + (size_t)row * D, nullptr, lane_);
        else if (mode == 1) rowpass_rows4(xrow, GO + (size_t)row * D, gpost, gnext, X + (size_t)row * D, H + (size_t)row * D, nullptr, lane_);
        else rowpass_rows4(xrow, GO + (size_t)row * D, gpost, nullptr, nullptr, nullptr, c.p.out + O_YP + (size_t)row * D, lane_);
    }
}

namespace pg8 {
#define PG8_LAS __attribute__((address_space(3)))
typedef unsigned short bf16_t;
typedef short bf16x8 __attribute__((ext_vector_type(8)));
typedef float f32x4 __attribute__((ext_vector_type(4)));
typedef unsigned u32x4 __attribute__((ext_vector_type(4)));
constexpr int BM = 256, BK = 64, HALF = 128, HTB = HALF * BK * 2  , STAGE_BYTES = 8 * HTB, NXCD = 8, WGM = 8;

__host__ __device__ __forceinline__ int lds_byte(int r, int c) { const int st = (r >> 4) * 2 + (c >> 5), rr = r & 15, cc = c & 31, ob = rr * 64 + cc * 2; return st * 1024 + (ob ^ (((ob >> 9) & 1) << 5)); }
__host__ __device__ __forceinline__ void stage_rc(int b, int& R, int& C) { const int st = b / 1024, sb = b % 1024, swz = sb ^ (((sb >> 9) & 1) << 5); R = (st >> 1) * 16 + swz / 64; C = (st & 1) * 32 + (swz % 64) / 2; }
__host__ __device__ __forceinline__ int perm32(int rho) { const int n = rho >> 4, i = rho & 15; return 8 * (i >> 2) + 4 * n + (i & 3); }

struct Unit { int pm, pn; };
struct Gemm { const bf16_t* A; const bf16_t* Bt; int M, N, K; };

struct StaticOrder {
    int nM, nN, nwg, G, c;
    __host__ __device__ void init(int M, int N, int G_, int c_) { nM = M / BM; nN = N / BM; nwg = nM * nN; G = G_; c = c_; }
    __host__ __device__ bool next(int i, Unit& u) const {
        const long L = (long)i * G + c; if (L >= nwg) return false;
        int wgid = (int)L; { const int q = nwg / NXCD, r = nwg % NXCD, xcd = wgid % NXCD, off = wgid / NXCD; wgid = (xcd < r ? xcd * (q + 1) : r * (q + 1) + (xcd - r) * q) + off; }
        const int nig = WGM * nN, gid = wgid / nig, fm = gid * WGM, gsz = (nM - fm) < WGM ? (nM - fm) : WGM;
        u.pm = fm + ((wgid % nig) % gsz); u.pn = (wgid % nig) / gsz; return true;
    }
    __device__ __forceinline__ void a_ready(const Unit&) const {}
    __device__ __forceinline__ void done(const Unit&) const {}
};
__device__ __forceinline__ unsigned cvt_pk_bf16(float lo, float hi) { unsigned r; asm volatile("v_cvt_pk_bf16_f32 %0, %1, %2" : "=v"(r) : "v"(lo), "v"(hi)); return r; }
typedef float f32x2 __attribute__((ext_vector_type(2)));
struct EpiF32 {
    static constexpr bool PERM = false, AFTER_DRAIN = false;
    float* C; int ldc; const float* bias;
    __device__ __forceinline__ void operator()(const f32x4 (&acc)[2][2][4][2], const Unit& u, int wr, int wc, int fr, int fq) const {
        const int row0 = u.pm * BM + wr * 64 + fr, col0 = u.pn * BM + wc * 32 + 4 * fq;
        f32x4 bv[2][2];
#pragma unroll
        for (int bj = 0; bj < 2; ++bj)
#pragma unroll
            for (int n = 0; n < 2; ++n) bv[bj][n] = bias ? *(const f32x4*)(bias + col0 + bj * HALF + n * 16) : (f32x4){0.f, 0.f, 0.f, 0.f};
#pragma unroll
        for (int ai = 0; ai < 2; ++ai)
#pragma unroll
            for (int m = 0; m < 4; ++m) { float* rowp = C + (size_t)(row0 + ai * HALF + m * 16) * ldc + col0;
#pragma unroll
                for (int bj = 0; bj < 2; ++bj)
#pragma unroll
                    for (int n = 0; n < 2; ++n) *(f32x4*)(rowp + bj * HALF + n * 16) = acc[ai][bj][m][n] + bv[bj][n]; }
    }
};
template <class Epi, class Sched, bool STAMP = false>
__device__ __forceinline__ void gemm_phase(PG8_LAS unsigned char* lds, const Gemm g, const Sched& S, const Epi& E, unsigned long long* stamps) {
    int tid_ = threadIdx.x; asm volatile("" : "+v"(tid_));
    const int tid = tid_, wid = __builtin_amdgcn_readfirstlane(tid >> 6), lane = tid & 63, wr = wid >> 2, wc = wid & 3, fr = lane & 15, fq = lane >> 4;
    const int K = g.K, nt = K / BK;
    int ts_lo = 0, ts_hi = 0, nts = 0; const unsigned long long rt_entry = STAMP ? (unsigned long long)wall_clock64() : 0ull;
#define PG8_STAMP() do { if (STAMP && wid == 0 && nts < 64) { const unsigned long long _c = (unsigned long long)clock64(); \
        ts_lo = (lane == nts) ? (int)(unsigned)_c : ts_lo; ts_hi = (lane == nts) ? (int)(unsigned)(_c >> 32) : ts_hi; ++nts; } } while (0)
    PG8_STAMP();
    unsigned voffA[2], voffB[2];
#pragma unroll
    for (int i = 0; i < 2; ++i) { int R, C; stage_rc(tid * 16 + i * 8192, R, C); const int Rb = Epi::PERM ? ((R & ~31) + perm32(R & 31)) : R;
        voffA[i] = (unsigned)(R * K + C) * 2u; voffB[i] = (unsigned)(Rb * K + C) * 2u; }
    const size_t kstep = (size_t)(BK * 2);
    const size_t hstep = (size_t)HALF * K * 2;
    const size_t tstep = 2 * hstep;
    const unsigned ldsw = (unsigned)wid * 1024u;
    const int aoff = lds_byte(wr * 64 + fr, fq * 8), boff = lds_byte(wc * 32 + fr, fq * 8);
#define PG8_SA(b, h) (((b) * 2 + (h)) * HTB)
#define PG8_SB(b, h) ((4 + (b) * 2 + (h)) * HTB)
#define PG8_STAGE(bufoff, gbase, voff) do { _Pragma("unroll") for (int _i = 0; _i < 2; ++_i) \
        __builtin_amdgcn_global_load_lds((const unsigned*)((const char*)(gbase) + (voff)[_i]), (PG8_LAS unsigned*)(lds + (bufoff) + ldsw + _i * 8192), 16, 0, 0); } while (0)
#define PG8_LDA(dst, b, h) do { _Pragma("unroll") for (int m = 0; m < 4; ++m) _Pragma("unroll") for (int k = 0; k < 2; ++k) dst[m][k] = *(const PG8_LAS bf16x8*)(lds + PG8_SA(b, h) + aoff + m * 2048 + k * 1024); } while (0)
#define PG8_LDB(dst, b, h) do { _Pragma("unroll") for (int n = 0; n < 2; ++n) _Pragma("unroll") for (int k = 0; k < 2; ++k) dst[n][k] = *(const PG8_LAS bf16x8*)(lds + PG8_SB(b, h) + boff + n * 2048 + k * 1024); } while (0)
#define PG8_MMA(ai, bj, At, Bt) do { __builtin_amdgcn_s_setprio(1); _Pragma("unroll") for (int m = 0; m < 4; ++m) _Pragma("unroll") for (int n = 0; n < 2; ++n) _Pragma("unroll") for (int k = 0; k < 2; ++k) \
        acc[ai][bj][m][n] = __builtin_amdgcn_mfma_f32_16x16x32_bf16(Bt[n][k], At[m][k], acc[ai][bj][m][n], 0, 0, 0); __builtin_amdgcn_s_setprio(0); } while (0)
#define PG8_WAIT_V(n) asm volatile("s_waitcnt vmcnt(" #n ")" ::: "memory")
#define PG8_WAIT_L(n) asm volatile("s_waitcnt lgkmcnt(" #n ")" ::: "memory")
#define PG8_BAR __builtin_amdgcn_s_barrier()
#define PG8_SCHED __builtin_amdgcn_sched_barrier(0)
    Unit cur, nxt; int ui = 0;
    if (!S.next(0, cur)) return;
    f32x4 acc[2][2][4][2];
#pragma unroll
    for (int a = 0; a < 2; ++a)
#pragma unroll
        for (int b = 0; b < 2; ++b)
#pragma unroll
            for (int m = 0; m < 4; ++m)
#pragma unroll
                for (int n = 0; n < 2; ++n) acc[a][b][m][n] = (f32x4){0.f, 0.f, 0.f, 0.f};
    bf16x8 At[4][2], B0[2][2], B1[2][2];
    const char* cA = (const char*)g.A + (size_t)cur.pm * tstep; const char* cB = (const char*)g.Bt + (size_t)cur.pn * tstep;
    S.a_ready(cur);
    PG8_STAGE(PG8_SB(0, 0), cB, voffB); PG8_STAGE(PG8_SA(0, 0), cA, voffA); PG8_STAGE(PG8_SB(0, 1), cB + hstep, voffB); PG8_STAGE(PG8_SA(0, 1), cA + hstep, voffA);
    if (wr == 1) PG8_BAR;
    PG8_WAIT_V(4); PG8_BAR;
    PG8_STAGE(PG8_SB(1, 0), cB + kstep, voffB); PG8_STAGE(PG8_SA(1, 0), cA + kstep, voffA); PG8_STAGE(PG8_SB(1, 1), cB + hstep + kstep, voffB);
    PG8_WAIT_V(6); PG8_BAR;
    PG8_STAMP();
    for (;;) {
        const bool has_next = S.next(ui + 1, nxt);
        const char* nA = has_next ? (const char*)g.A + (size_t)nxt.pm * tstep : cA; const char* nB = has_next ? (const char*)g.Bt + (size_t)nxt.pn * tstep : cB;
        for (int t = 0; t < nt; t += 2) {
            const bool last = (t == nt - 2);
            const char* a1 = cA + (size_t)(t + 1) * kstep;
            const char* a2 = last ? nA : cA + (size_t)(t + 2) * kstep; const char* b2 = last ? nB : cB + (size_t)(t + 2) * kstep;
            const char* a3 = a2 + kstep; const char* b3 = b2 + kstep;
            if (last && has_next) S.a_ready(nxt);
            PG8_LDB(B0, 0, 0); PG8_SCHED; PG8_LDA(At, 0, 0); PG8_STAGE(PG8_SA(1, 1), a1 + hstep, voffA);
            PG8_WAIT_L(8); PG8_BAR; PG8_WAIT_L(0); PG8_MMA(0, 0, At, B0); PG8_BAR; PG8_SCHED;
            PG8_LDB(B1, 0, 1); PG8_STAGE(PG8_SB(0, 0), b2, voffB);
            PG8_BAR; PG8_WAIT_L(0); PG8_MMA(0, 1, At, B1); PG8_BAR;
            PG8_LDA(At, 0, 1); PG8_STAGE(PG8_SA(0, 0), a2, voffA);
            PG8_BAR; PG8_WAIT_L(0); PG8_MMA(1, 0, At, B0); PG8_BAR; PG8_SCHED;
            PG8_STAGE(PG8_SB(0, 1), b2 + hstep, voffB);
            PG8_WAIT_V(6); PG8_BAR; PG8_MMA(1, 1, At, B1); PG8_BAR;
            PG8_LDB(B0, 1, 0); PG8_SCHED; PG8_LDA(At, 1, 0); PG8_STAGE(PG8_SA(0, 1), a2 + hstep, voffA);
            PG8_WAIT_L(8); PG8_BAR; PG8_WAIT_L(0); PG8_MMA(0, 0, At, B0); PG8_BAR; PG8_SCHED;
            PG8_LDB(B1, 1, 1); PG8_STAGE(PG8_SB(1, 0), b3, voffB);
            PG8_BAR; PG8_WAIT_L(0); PG8_MMA(0, 1, At, B1); PG8_BAR;
            PG8_LDA(At, 1, 1); PG8_STAGE(PG8_SA(1, 0), a3, voffA);
            PG8_BAR; PG8_WAIT_L(0); PG8_MMA(1, 0, At, B0); PG8_BAR; PG8_SCHED;
            PG8_STAGE(PG8_SB(1, 1), b3 + hstep, voffB);
            PG8_WAIT_V(6); PG8_BAR; PG8_MMA(1, 1, At, B1); PG8_BAR;
        }
        PG8_STAMP();
        if constexpr (!Epi::AFTER_DRAIN) { E(acc, cur, wr, wc, fr, fq); S.done(cur); }
        PG8_STAMP();
        if (!has_next) break;
#pragma unroll
        for (int a = 0; a < 2; ++a)
#pragma unroll
            for (int b = 0; b < 2; ++b)
#pragma unroll
                for (int m = 0; m < 4; ++m)
#pragma unroll
                    for (int n = 0; n < 2; ++n) acc[a][b][m][n] = (f32x4){0.f, 0.f, 0.f, 0.f};
        cur = nxt; cA = nA; cB = nB; ++ui;
    }
    PG8_WAIT_V(0);
    if (wr == 0) PG8_BAR;
    PG8_BAR;
    if constexpr (Epi::AFTER_DRAIN) { E.fused(acc, cur, wr, wc, fr, fq, lds, wid, lane); S.done(cur); }
    PG8_STAMP();
    if (STAMP && wid == 0) { stamps[lane] = lane < nts ? (((unsigned long long)(unsigned)ts_hi << 32) | (unsigned)ts_lo) : 0ull;
        if (lane == 62) stamps[62] = rt_entry; if (lane == 63) stamps[63] = (unsigned long long)wall_clock64(); }
#undef PG8_STAMP
#undef PG8_SA
#undef PG8_SB
#undef PG8_STAGE
#undef PG8_LDA
#undef PG8_LDB
#undef PG8_MMA
#undef PG8_WAIT_V
#undef PG8_WAIT_L
#undef PG8_BAR
#undef PG8_SCHED
}
}

namespace pg8 {
struct EpiBf16Plain {
    static constexpr bool PERM = false, AFTER_DRAIN = false;
    bf16_t* O; int ldc;
    __device__ __forceinline__ void operator()(const f32x4 (&acc)[2][2][4][2], const Unit& u, int wr, int wc, int fr, int fq) const {
        const int row0 = u.pm * BM + wr * 64 + fr, col0 = u.pn * BM + wc * 32 + 4 * fq;
#pragma unroll
        for (int ai = 0; ai < 2; ++ai)
#pragma unroll
            for (int m = 0; m < 4; ++m) { bf16_t* rowp = O + (size_t)(row0 + ai * HALF + m * 16) * ldc + col0;
#pragma unroll
                for (int bj = 0; bj < 2; ++bj)
#pragma unroll
                    for (int n = 0; n < 2; ++n) { const f32x4 v = acc[ai][bj][m][n]; unsigned long long w = (unsigned long long)cvt_pk_bf16(v[0], v[1]) | ((unsigned long long)cvt_pk_bf16(v[2], v[3]) << 32);
                        *(unsigned long long*)(rowp + bj * HALF + n * 16) = w; } }
    }
};
struct EpiBf16Perm {
    static constexpr bool PERM = true, AFTER_DRAIN = false;
    bf16_t* O; int ldc;
    __device__ __forceinline__ void operator()(const f32x4 (&acc)[2][2][4][2], const Unit& u, int wr, int wc, int fr, int fq) const {
        const int row0 = u.pm * BM + wr * 64 + fr, col0 = u.pn * BM + wc * 32 + 8 * fq;
#pragma unroll
        for (int ai = 0; ai < 2; ++ai)
#pragma unroll
            for (int m = 0; m < 4; ++m) { bf16_t* rowp = O + (size_t)(row0 + ai * HALF + m * 16) * ldc + col0;
#pragma unroll
                for (int bj = 0; bj < 2; ++bj) { const f32x4 v0 = acc[ai][bj][m][0], v1 = acc[ai][bj][m][1]; u32x4 w;
                    w.x = cvt_pk_bf16(v0[0], v0[1]); w.y = cvt_pk_bf16(v0[2], v0[3]); w.z = cvt_pk_bf16(v1[0], v1[1]); w.w = cvt_pk_bf16(v1[2], v1[3]);
                    *(u32x4*)(rowp + bj * HALF) = w; } }
    }
};
struct EpiSwiglu {
    static constexpr bool PERM = false, AFTER_DRAIN = false;
    bf16_t* O; int ldc;
    __device__ __forceinline__ void operator()(const f32x4 (&acc)[2][2][4][2], const Unit& u, int wr, int wc, int fr, int fq) const {
        const int row0 = u.pm * BM + wr * 64 + fr, col0 = u.pn * (BM / 2) + wc * 16 + 4 * fq;
#pragma unroll
        for (int ai = 0; ai < 2; ++ai)
#pragma unroll
            for (int m = 0; m < 4; ++m) { bf16_t* rowp = O + (size_t)(row0 + ai * HALF + m * 16) * ldc + col0;
#pragma unroll
                for (int bj = 0; bj < 2; ++bj) { const f32x4 g = acc[ai][bj][m][0], up = acc[ai][bj][m][1]; float h[4];
#pragma unroll
                    for (int e = 0; e < 4; ++e) h[e] = g[e] / (1.f + __expf(-g[e])) * up[e];
                    unsigned long long w = (unsigned long long)cvt_pk_bf16(h[0], h[1]) | ((unsigned long long)cvt_pk_bf16(h[2], h[3]) << 32);
                    *(unsigned long long*)(rowp + bj * (HALF / 2)) = w; } }
    }
};
}

struct Epi { int mode; bf16_t* ob; float* of; int ldo; int main_cols; };
DI void gemm_simple(const Ctx& c, const bf16_t* A, int lda, int M, const bf16_t* Bt, int ldb, int N, int K, const Epi e) {
    const int mblk = (M + 63) / 64, nblk = (N + 31) / 32, nit = mblk * nblk;
    const int fr = c.lane & 15, fq = c.lane >> 4;
    for (int it = c.gw; it < nit; it += c.ngw) {
        const int mb = it / nblk, nb = it % nblk, m0 = mb * 64, n0 = nb * 32;
        const bf16_t* ap[4]; const bf16_t* bp[2];
#pragma unroll
        for (int m = 0; m < 4; ++m) { int r = m0 + 16 * m + fr; r = r < M ? r : M - 1; ap[m] = A + (size_t)r * lda + 8 * fq; }
#pragma unroll
        for (int n = 0; n < 2; ++n) { int r = n0 + 16 * n + fr; r = r < N ? r : N - 1; bp[n] = Bt + (size_t)r * ldb + 8 * fq; }
        f32x4 acc[4][2];
#pragma unroll
        for (int m = 0; m < 4; ++m)
#pragma unroll
            for (int n = 0; n < 2; ++n) acc[m][n] = (f32x4){0.f, 0.f, 0.f, 0.f};
#pragma unroll 2
        for (int k0 = 0; k0 < K; k0 += 32) {
            bf16x8 a[4], b[2];
#pragma unroll
            for (int m = 0; m < 4; ++m) a[m] = *(const bf16x8*)(ap[m] + k0);
#pragma unroll
            for (int n = 0; n < 2; ++n) b[n] = *(const bf16x8*)(bp[n] + k0);
#pragma unroll
            for (int m = 0; m < 4; ++m)
#pragma unroll
                for (int n = 0; n < 2; ++n) acc[m][n] = __builtin_amdgcn_mfma_f32_16x16x32_bf16(b[n], a[m], acc[m][n], 0, 0, 0);
        }
#pragma unroll
        for (int m = 0; m < 4; ++m) {
            const int row = m0 + 16 * m + fr; if (row >= M) continue;
            if (e.mode == 2) {
                const f32x4 g = acc[m][0], u = acc[m][1]; u32x2 o;
                o.x = pk2(siluf(g.x) * u.x, siluf(g.y) * u.y); o.y = pk2(siluf(g.z) * u.z, siluf(g.w) * u.w);
                *(u32x2*)(e.ob + (size_t)row * e.ldo + 16 * nb + 4 * fq) = o;
            } else {
#pragma unroll
                for (int n = 0; n < 2; ++n) {
                    const int col = n0 + 16 * n + 4 * fq; if (col >= N) continue;
                    const f32x4 v = acc[m][n];
                    if (e.mode == 1) *(f32x4*)(e.of + (size_t)row * e.ldo + col) = v;
                    else if (col < e.main_cols) { u32x2 o; o.x = pk2(v.x, v.y); o.y = pk2(v.z, v.w); *(u32x2*)(e.ob + (size_t)row * e.ldo + col) = o; }
                    else *(f32x4*)(e.of + (size_t)row * 32 + (col - e.main_cols)) = v;
                }
            }
        }
    }
}

DI void attn_wave(const Ctx& c, int li, int tok, int h, LAS float* pl  ) {
    const bf16_t* PROJ = c.ws<bf16_t>(W_PROJ); bf16_t* MIX = c.ws<bf16_t>(W_MIXED);
    const int lane = c.lane; const bool smp = tok >= T;
    const int b = smp ? tok - T : tok / SEQ, s = smp ? WIN : tok % SEQ;
    const float* ck = c.in(I_CK) + ((size_t)(li * NS + b) * WIN) * AW + h * AHD;
    const float* cv = c.in(I_CV) + ((size_t)(li * NS + b) * WIN) * AW + h * AHD;
    const bf16_t* prow0 = smp ? PROJ + (size_t)tok * HYB_MAIN : PROJ + (size_t)(b * SEQ) * HYB_MAIN;
    float q[64];
    { const bf16_t* qp = PROJ + (size_t)tok * HYB_MAIN + h * AHD;
#pragma unroll
      for (int j = 0; j < 8; ++j) { const u32x4 v = *(const u32x4*)(qp + 8 * j);
          q[8*j+0] = bf2f((bf16_t)(v.x & 0xffff)) * 0.125f; q[8*j+1] = bf2f((bf16_t)(v.x >> 16)) * 0.125f; q[8*j+2] = bf2f((bf16_t)(v.y & 0xffff)) * 0.125f; q[8*j+3] = bf2f((bf16_t)(v.y >> 16)) * 0.125f;
          q[8*j+4] = bf2f((bf16_t)(v.z & 0xffff)) * 0.125f; q[8*j+5] = bf2f((bf16_t)(v.z >> 16)) * 0.125f; q[8*j+6] = bf2f((bf16_t)(v.w & 0xffff)) * 0.125f; q[8*j+7] = bf2f((bf16_t)(v.w >> 16)) * 0.125f; } }
    const float* relb = c.in(I_RELB);
    float mx = -1e30f;
#pragma unroll 1
    for (int pat = 0; pat < 3; ++pat) {
        const int d = pat == 0 ? 1 : (pat == 1 ? 4 : 16);
#pragma unroll
        for (int rnd = 0; rnd < 3; ++rnd) {
            const int j = rnd * 64 + lane; float lg = -1e30f;
            if (j <= 128) {
                const int R = s - j * d;
                if (R >= 0) {
                    float acc = 0.f;
                    if (smp && R < WIN) { const float* kp = ck + (size_t)R * AW;
#pragma unroll
                        for (int e = 0; e < 16; ++e) { const f32x4 v = *(const f32x4*)(kp + 4 * e); acc += q[4*e] * v.x + q[4*e+1] * v.y + q[4*e+2] * v.z + q[4*e+3] * v.w; }
                    } else { const bf16_t* kp = (smp ? prow0 : prow0 + (size_t)R * HYB_MAIN) + AW + h * AHD;
#pragma unroll
                        for (int e = 0; e < 8; ++e) { const u32x4 v = *(const u32x4*)(kp + 8 * e);
                            acc += q[8*e] * bf2f((bf16_t)(v.x & 0xffff)) + q[8*e+1] * bf2f((bf16_t)(v.x >> 16)) + q[8*e+2] * bf2f((bf16_t)(v.y & 0xffff)) + q[8*e+3] * bf2f((bf16_t)(v.y >> 16))
                                 + q[8*e+4] * bf2f((bf16_t)(v.z & 0xffff)) + q[8*e+5] * bf2f((bf16_t)(v.z >> 16)) + q[8*e+6] * bf2f((bf16_t)(v.w & 0xffff)) + q[8*e+7] * bf2f((bf16_t)(v.w >> 16)); }
                    }
                    lg = acc + relb[c_bucket[pat][j] * AH + h];
                }
                pl[pat * 132 + j] = lg;
            }
            mx = fmaxf(mx, lg);
        }
    }
    mx = wave_max(mx);
    LDS_WAIT();
    float ssum = 0.f;
#pragma unroll 1
    for (int i = lane; i < 396; i += 64) { const int pat = i / 132, j = i % 132; if (j <= 128) { const float lg = pl[i]; const float pv = lg > -1e29f ? __expf(lg - mx) : 0.f; pl[i] = pv; ssum += pv; } }
    ssum = wave_sum(ssum);
    LDS_WAIT();
    {
        const int kg = lane >> 4, dc = lane & 15;
        f32x4 o4 = (f32x4){0.f, 0.f, 0.f, 0.f};
        if (smp) {
#pragma unroll 1
            for (int pat = 0; pat < 3; ++pat) {
                const int d = pat == 0 ? 1 : (pat == 1 ? 4 : 16);
                if (kg == 0) { const u32x2 vv = *(const u32x2*)(prow0 + 2 * AW + h * AHD + 4 * dc); const float pv = pl[pat * 132];
                    o4.x += pv * bf2f((bf16_t)(vv.x & 0xffff)); o4.y += pv * bf2f((bf16_t)(vv.x >> 16)); o4.z += pv * bf2f((bf16_t)(vv.y & 0xffff)); o4.w += pv * bf2f((bf16_t)(vv.y >> 16)); }
#pragma unroll 16
                for (int i4 = 0; i4 < 32; ++i4) { const int j = 1 + 4 * i4 + kg; const f32x4 vv = *(const f32x4*)(cv + (size_t)(WIN - j * d) * AW + 4 * dc); o4 += vv * pl[pat * 132 + j]; }
            }
        } else {
#pragma unroll 1
            for (int pat = 0; pat < 3; ++pat) {
                const int d = pat == 0 ? 1 : (pat == 1 ? 4 : 16);
                int jmax = s / d; jmax = jmax > 128 ? 128 : jmax;
#pragma unroll 4
                for (int j = kg; j <= jmax; j += 4) { const u32x2 vv = *(const u32x2*)(prow0 + (size_t)(s - j * d) * HYB_MAIN + 2 * AW + h * AHD + 4 * dc); const float pv = pl[pat * 132 + j];
                    o4.x += pv * bf2f((bf16_t)(vv.x & 0xffff)); o4.y += pv * bf2f((bf16_t)(vv.x >> 16)); o4.z += pv * bf2f((bf16_t)(vv.y & 0xffff)); o4.w += pv * bf2f((bf16_t)(vv.y >> 16)); }
            }
        }
#pragma unroll
        for (int e = 0; e < 4; ++e) { o4[e] += __shfl_xor(o4[e], 16); o4[e] += __shfl_xor(o4[e], 32); }
        const float inv = 1.f / ssum;
        if (kg == 0) { u32x2 o; o.x = pk2(o4.x * inv, o4.y * inv); o.y = pk2(o4.z * inv, o4.w * inv); *(u32x2*)(MIX + (size_t)tok * HYB_MIX + h * AHD + 4 * dc) = o; }
    }
    LDS_WAIT();
}

template <int MT>
DI void gemm_ksplit(const Ctx& c, const bf16_t* A, int lda, int M, const bf16_t* Bt, int ldb, int N, int K, const Epi e) {
    const int mblk = (M + 16 * MT - 1) / (16 * MT), nblk = (N + 31) / 32, nit = mblk * nblk;
    const int fr = c.lane & 15, fq = c.lane >> 4, kslice = K / 8, klo = c.wave * kslice;
    LAS float* part = (LAS float*)c.lds;
    for (int it = blockIdx.x; it < nit; it += gridDim.x) {
        const int mb = it / nblk, nb = it % nblk, m0 = mb * 16 * MT, n0 = nb * 32;
        const bf16_t* ap[MT]; const bf16_t* bp[2];
#pragma unroll
        for (int m = 0; m < MT; ++m) { int r = m0 + 16 * m + fr; r = r < M ? r : M - 1; ap[m] = A + (size_t)r * lda + klo + 8 * fq; }
#pragma unroll
        for (int n = 0; n < 2; ++n) { int r = n0 + 16 * n + fr; r = r < N ? r : N - 1; bp[n] = Bt + (size_t)r * ldb + klo + 8 * fq; }
        f32x4 acc[MT][2];
#pragma unroll
        for (int m = 0; m < MT; ++m)
#pragma unroll
            for (int n = 0; n < 2; ++n) acc[m][n] = (f32x4){0.f, 0.f, 0.f, 0.f};
#pragma unroll 2
        for (int k0 = 0; k0 < kslice; k0 += 32) {
            bf16x8 a[MT], b[2];
#pragma unroll
            for (int m = 0; m < MT; ++m) a[m] = *(const bf16x8*)(ap[m] + k0);
#pragma unroll
            for (int n = 0; n < 2; ++n) b[n] = *(const bf16x8*)(bp[n] + k0);
#pragma unroll
            for (int m = 0; m < MT; ++m)
#pragma unroll
                for (int n = 0; n < 2; ++n) acc[m][n] = __builtin_amdgcn_mfma_f32_16x16x32_bf16(b[n], a[m], acc[m][n], 0, 0, 0);
        }
        __syncthreads();
#pragma unroll
        for (int m = 0; m < MT; ++m)
#pragma unroll
            for (int n = 0; n < 2; ++n) *(LAS f32x4*)(part + ((c.wave * (MT * 2) + m * 2 + n) * 64 + c.lane) * 4) = acc[m][n];
        __syncthreads();
        if (c.wave < MT) {
            const int m = c.wave; f32x4 v[2];
#pragma unroll
            for (int n = 0; n < 2; ++n) { v[n] = (f32x4){0.f, 0.f, 0.f, 0.f};
#pragma unroll
                for (int w = 0; w < 8; ++w) v[n] += *(const LAS f32x4*)(part + ((w * (MT * 2) + m * 2 + n) * 64 + c.lane) * 4); }
            const int row = m0 + 16 * m + fr;
            if (row < M) {
                if (e.mode == 2) {
                    const f32x4 g = v[0], u = v[1]; u32x2 o;
                    o.x = pk2(siluf(g.x) * u.x, siluf(g.y) * u.y); o.y = pk2(siluf(g.z) * u.z, siluf(g.w) * u.w);
                    *(u32x2*)(e.ob + (size_t)row * e.ldo + 16 * nb + 4 * fq) = o;
                } else {
#pragma unroll
                    for (int n = 0; n < 2; ++n) {
                        const int col = n0 + 16 * n + 4 * fq; if (col >= N) continue;
                        if (e.mode == 1) *(f32x4*)(e.of + (size_t)row * e.ldo + col) = v[n];
                        else if (col < e.main_cols) { u32x2 o; o.x = pk2(v[n].x, v[n].y); o.y = pk2(v[n].z, v[n].w); *(u32x2*)(e.ob + (size_t)row * e.ldo + col) = o; }
                        else *(f32x4*)(e.of + (size_t)row * 32 + (col - e.main_cols)) = v[n];
                    }
                }
            }
        }
    }
    __syncthreads();
}

constexpr int AT_LDS = 1600;
struct AtStep { int d, u, kb; const LAS float* tbp; };
DI AtStep at_step(int g, const LAS float* tb) {
    AtStep s;
    if (g < 12) { s.d = 1; s.u = 16; s.kb = -143 + 32 * g; s.tbp = tb; }
    else if (g < 18) { s.d = 4; s.u = 4; s.kb = -131 + 32 * (g - 12); s.tbp = tb + 132; }
    else if (g < 23) { s.d = 16; s.u = 1; s.kb = -144 + 32 * (g - 18); s.tbp = tb + 264; }
    else { s.d = 1; s.u = 0; s.kb = 100000; s.tbp = tb; }
    return s;
}
struct AtBuf { bf16x8 k[2][2]; bf16x8 v[2][2]; };
DI void at_load(AtBuf& bf, const bf16_t* qrow0, int P0, const AtStep st, int fr, int fq) {
#pragma unroll
    for (int kt = 0; kt < 2; ++kt) {
        int pos = P0 + st.d * (st.kb + 16 * kt + fr); pos = pos < 0 ? 0 : (pos > SEQ - 1 ? SEQ - 1 : pos);
        const bf16_t* rp = qrow0 + (size_t)pos * HYB_MAIN + 8 * fq;
        bf.k[kt][0] = *(const bf16x8*)(rp + AW); bf.k[kt][1] = *(const bf16x8*)(rp + AW + 32);
        bf.v[kt][0] = *(const bf16x8*)(rp + 2 * AW); bf.v[kt][1] = *(const bf16x8*)(rp + 2 * AW + 32);
    }
}
DI void attn_mfma_item(const Ctx& c, int li, int item) {
    const bf16_t* PROJ = c.ws<bf16_t>(W_PROJ); bf16_t* MIX = c.ws<bf16_t>(W_MIXED);
    int lane_ = c.lane; asm volatile("" : "+v"(lane_));
    const int lane = lane_, fr = lane & 15, fq = lane >> 4;
    const int qb = item & 255, h = (item >> 8) & 7, b = item >> 11, P0 = (qb >> 4) * 256 + (qb & 15);
    LAS float* tb = (LAS float*)(c.lds + c.wave * AT_LDS);
    { const float* relb = c.in(I_RELB);
#pragma unroll 1
      for (int i = lane; i < 396; i += 64) { const int pat = i / 132, j = i % 132; tb[i] = j <= 128 ? relb[c_bucket[pat][j] * AH + h] : 0.f; } }
    const bf16_t* qrow0 = PROJ + (size_t)(b * SEQ) * HYB_MAIN + h * AHD;
    bf16x8 qf[2], idf[2];
#pragma unroll
    for (int kd = 0; kd < 2; ++kd) qf[kd] = *(const bf16x8*)(qrow0 + (size_t)(P0 + 16 * fr) * HYB_MAIN + 32 * kd + 8 * fq);
#pragma unroll
    for (int hs = 0; hs < 2; ++hs)
#pragma unroll
        for (int e = 0; e < 8; ++e) idf[hs][e] = (8 * fq + e) == (16 * hs + fr) ? (short)0x3F80 : (short)0;
    float m = -1e30f, lsum = 0.f;
    f32x4 O[4];
#pragma unroll
    for (int dt = 0; dt < 4; ++dt) O[dt] = (f32x4){0.f, 0.f, 0.f, 0.f};
    AtBuf b0, b1, b2;
    at_load(b0, qrow0, P0, at_step(0, tb), fr, fq); at_load(b1, qrow0, P0, at_step(1, tb), fr, fq); at_load(b2, qrow0, P0, at_step(2, tb), fr, fq);
    LDS_WAIT();
#define AT_STEP(bf, g) do { \
        const AtStep st = at_step((g), tb); const int qi = st.u * fr; \
        f32x4 sc[2]; \
        _Pragma("unroll") for (int kt = 0; kt < 2; ++kt) { sc[kt] = (f32x4){0.f, 0.f, 0.f, 0.f}; \
            _Pragma("unroll") for (int kd = 0; kd < 2; ++kd) sc[kt] = __builtin_amdgcn_mfma_f32_16x16x32_bf16(bf.k[kt][kd], qf[kd], sc[kt], 0, 0, 0); } \
        f32x4 dv[2][4]; \
        _Pragma("unroll") for (int kt = 0; kt < 2; ++kt) _Pragma("unroll") for (int dt = 0; dt < 4; ++dt) \
            dv[kt][dt] = __builtin_amdgcn_mfma_f32_16x16x32_bf16(bf.v[kt][dt >> 1], idf[dt & 1], (f32x4){0.f, 0.f, 0.f, 0.f}, 0, 0, 0);     \
        const AtStep nx = at_step((g) + 3, tb); at_load(bf, qrow0, P0, nx, fr, fq);     \
        float tmax = -1e30f; bool ok[2][4]; \
        _Pragma("unroll") for (int kt = 0; kt < 2; ++kt) _Pragma("unroll") for (int r = 0; r < 4; ++r) { \
            const int kk = st.kb + 16 * kt + 4 * fq + r, dist = qi - kk; const bool v = dist >= 0 && dist <= 128 && (P0 + st.d * kk) >= 0; ok[kt][r] = v; \
            const int di = dist < 0 ? 0 : (dist > 128 ? 128 : dist); const float bias = *(const volatile LAS float*)(st.tbp + di);     \
            const float lg = v ? sc[kt][r] * 0.125f + bias : -1e30f; sc[kt][r] = lg; tmax = fmaxf(tmax, lg); } \
        tmax = fmaxf(tmax, __shfl_xor(tmax, 16)); tmax = fmaxf(tmax, __shfl_xor(tmax, 32)); \
        const float mn = fmaxf(m, tmax), alpha = __expf(m - mn); m = mn; \
        float ps = 0.f; \
        _Pragma("unroll") for (int kt = 0; kt < 2; ++kt) _Pragma("unroll") for (int r = 0; r < 4; ++r) { const float pv = ok[kt][r] ? __expf(sc[kt][r] - mn) : 0.f; sc[kt][r] = pv; ps += pv; } \
        lsum = lsum * alpha + ps; \
        const bf16x8 pfrag = pack8(sc[0], sc[1]); \
        _Pragma("unroll") for (int dt = 0; dt < 4; ++dt) O[dt] = __builtin_amdgcn_mfma_f32_16x16x32_bf16(pack8(dv[0][dt], dv[1][dt]), pfrag, O[dt] * alpha, 0, 0, 0); } while (0)
#pragma unroll 1
    for (int g = 0; g < 24; g += 3) { AT_STEP(b0, g); AT_STEP(b1, g + 1); AT_STEP(b2, g + 2); }
#undef AT_STEP
    lsum += __shfl_xor(lsum, 16); lsum += __shfl_xor(lsum, 32);
    const float inv = 1.f / lsum;
    bf16_t* orow = MIX + (size_t)(b * SEQ + P0 + 16 * fr) * HYB_MIX + h * AHD;
#pragma unroll
    for (int dt = 0; dt < 4; ++dt) { u32x2 o; o.x = pk2(O[dt][0] * inv, O[dt][1] * inv); o.y = pk2(O[dt][2] * inv, O[dt][3] * inv); *(u32x2*)(orow + 16 * dt + 4 * fq) = o; }
    LDS_WAIT();
}

DI void unpack8(const u32x4 v, float* f) {
    f[0] = bf2f((bf16_t)(v.x & 0xffff)); f[1] = bf2f((bf16_t)(v.x >> 16)); f[2] = bf2f((bf16_t)(v.y & 0xffff)); f[3] = bf2f((bf16_t)(v.y >> 16));
    f[4] = bf2f((bf16_t)(v.z & 0xffff)); f[5] = bf2f((bf16_t)(v.z >> 16)); f[6] = bf2f((bf16_t)(v.w & 0xffff)); f[7] = bf2f((bf16_t)(v.w >> 16));
}
DI void load8f(const float* p, float* f) { const f32x4 a = *(const f32x4*)p, b = *(const f32x4*)(p + 4); f[0] = a.x; f[1] = a.y; f[2] = a.z; f[3] = a.w; f[4] = b.x; f[5] = b.y; f[6] = b.z; f[7] = b.w; }
DI void store8f(float* p, const float* f) { *(f32x4*)p = (f32x4){f[0], f[1], f[2], f[3]}; *(f32x4*)(p + 4) = (f32x4){f[4], f[5], f[6], f[7]}; }
DI void conv8(const bf16_t* prow, int ld, const float* st, int nch, const float* cw, int ch0, bool smp, int s, float* x1, float* x2, float* x3, float* y) {
    float x0[8], w[8];
    unpack8(*(const u32x4*)(prow + ch0), x3);
    if (smp) { load8f(st + ch0, x0); load8f(st + nch + ch0, x1); load8f(st + 2 * nch + ch0, x2); }
    else {
        const u32x4 z = (u32x4){0u, 0u, 0u, 0u};
        unpack8(s >= 1 ? *(const u32x4*)(prow + ch0 - ld) : z, x2); unpack8(s >= 2 ? *(const u32x4*)(prow + ch0 - 2 * ld) : z, x1); unpack8(s >= 3 ? *(const u32x4*)(prow + ch0 - 3 * ld) : z, x0);
    }
    load8f(cw + ch0, w);
#pragma unroll
    for (int e = 0; e < 8; ++e) y[e] = x0[e] * w[e];
    load8f(cw + nch + ch0, w);
#pragma unroll
    for (int e = 0; e < 8; ++e) y[e] += x1[e] * w[e];
    load8f(cw + 2 * nch + ch0, w);
#pragma unroll
    for (int e = 0; e < 8; ++e) y[e] += x2[e] * w[e];
    load8f(cw + 3 * nch + ch0, w);
#pragma unroll
    for (int e = 0; e < 8; ++e) y[e] += x3[e] * w[e];
}
DI void hyb_pre_token(const Ctx& c, int li, int tok) {
    const bf16_t* PROJ = c.ws<bf16_t>(W_PROJ); float* ACT = c.ws<float>(W_ACT); float* AUX = c.ws<float>(W_AUX); const float* EX = c.ws<float>(W_EXTRA);
    const int lane = c.lane; const bool smp = tok >= T; const int b = smp ? tok - T : tok / SEQ, s = smp ? 0 : tok % SEQ;
    const float* cw = c.in(I_SCW) + (size_t)li * 4 * SXBC; const float* cb = c.in(I_SCB) + (size_t)li * SXBC;
    const float* st = c.in(I_SCONV) + (size_t)(li * NS + b) * 3 * SXBC;
    const bf16_t* prow = PROJ + (size_t)tok * HYB_MAIN + 2560;
#pragma unroll 1
    for (int it = 0; it < 3; ++it) {
        const int ch0 = 512 * it + 8 * lane; float x1[8], x2[8], x3[8], y[8], bb[8];
        conv8(prow, HYB_MAIN, st, SXBC, cw, ch0, smp, s, x1, x2, x3, y);
        load8f(cb + ch0, bb);
#pragma unroll
        for (int e = 0; e < 8; ++e) y[e] = siluf(y[e] + bb[e]);
        store8f(ACT + (size_t)tok * 4096 + ch0, y);
        if (smp) { float* o = c.p.out + O_SSC + (size_t)(li * NS + b) * 3 * SXBC + ch0; store8f(o, x1); store8f(o + SXBC, x2); store8f(o + 2 * SXBC, x3); }
        else if (s >= SEQ - 3) store8f(c.p.out + O_PSC + ((size_t)(li * NB + b) * 3 + (s - (SEQ - 3))) * SXBC + ch0, x3);
    }
    if (lane < SH) AUX[(size_t)tok * 32 + lane] = softplusf_(EX[(size_t)tok * 32 + lane] + c.in(I_SDTB)[li * SH + lane]);
    if (smp || s >= SEQ - WIN) {
        float* ok = smp ? c.p.out + O_SK + ((size_t)(li * NS + b) * WIN + (WIN - 1)) * AW : c.p.out + O_PK + ((size_t)(li * NB + b) * WIN + (s - (SEQ - WIN))) * AW;
        float* ov = smp ? c.p.out + O_SV + ((size_t)(li * NS + b) * WIN + (WIN - 1)) * AW : c.p.out + O_PV + ((size_t)(li * NB + b) * WIN + (s - (SEQ - WIN))) * AW;
        const bf16_t* kr = PROJ + (size_t)tok * HYB_MAIN + AW;
        float f[8];
        unpack8(*(const u32x4*)(kr + 8 * lane), f); store8f(ok + 8 * lane, f);
        unpack8(*(const u32x4*)(kr + AW + 8 * lane), f); store8f(ov + 8 * lane, f);
    }
}

DI void ssd_wave(const Ctx& c, int li, int item) {
    const float* ACT = c.ws<float>(W_ACT); const float* AUX = c.ws<float>(W_AUX); float* Y = c.ws<float>(W_Y);
    const int lane = c.lane;
    const bool smp = item >= NB * SH * SP; const int it = smp ? item - NB * SH * SP : item;
    const int seq = it / (SH * SP), h = (it / SP) % SH, p = it % SP, g = h / (SH / SG);
    const int L = smp ? 1 : SEQ; const int tok0 = smp ? T + seq : seq * SEQ;
    const float Ah = -__expf(c.in(I_SALOG)[li * SH + h]), Dh = c.in(I_SD)[li * SH + h];
    float h0 = 0.f, h1 = 0.f;
    if (smp) { const float* s0 = c.in(I_SSM) + (((size_t)(li * NS + seq) * SH + h) * SP + p) * SN; h0 = s0[2 * lane]; h1 = s0[2 * lane + 1]; }
#pragma unroll 2
    for (int t = 0; t < L; ++t) {
        const float* a = ACT + (size_t)(tok0 + t) * 4096;
        const float dt = AUX[(size_t)(tok0 + t) * 32 + h], xv = a[h * SP + p];
        const float2 Bv = *(const float2*)(a + SDI + g * SN + 2 * lane), Cv = *(const float2*)(a + SDI + SG * SN + g * SN + 2 * lane);
        const float dec = __expf(dt * Ah), dx = dt * xv;
        h0 = h0 * dec + dx * Bv.x; h1 = h1 * dec + dx * Bv.y;
        const float y = wave_sum(h0 * Cv.x + h1 * Cv.y);
        if (lane == 0) Y[(size_t)(tok0 + t) * 2048 + h * SP + p] = y + Dh * xv;
    }
    float* so = smp ? c.p.out + O_SSS + (((size_t)(li * NS + seq) * SH + h) * SP + p) * SN : c.p.out + O_PSS + (((size_t)(li * NB + seq) * SH + h) * SP + p) * SN;
    *(float2*)(so + 2 * lane) = make_float2(h0, h1);
}
DI void ssd_sample_item(const Ctx& c, int li, int item) {
    const float* ACT = c.ws<float>(W_ACT); const float* AUX = c.ws<float>(W_AUX); float* Y = c.ws<float>(W_Y);
    const int lane = c.lane, seq = item / SH, h = item % SH, g = h / (SH / SG), tok = T + seq;
    const float Ah = -__expf(c.in(I_SALOG)[li * SH + h]), Dh = c.in(I_SD)[li * SH + h];
    const float* a = ACT + (size_t)tok * 4096;
    const float dt = AUX[(size_t)tok * 32 + h], dec = __expf(dt * Ah);
    const float2 Bv = *(const float2*)(a + SDI + g * SN + 2 * lane), Cv = *(const float2*)(a + SDI + SG * SN + g * SN + 2 * lane);
    const float* s0 = c.in(I_SSM) + ((size_t)(li * NS + seq) * SH + h) * SP * SN; float* so = c.p.out + O_SSS + ((size_t)(li * NS + seq) * SH + h) * SP * SN;
    const float xl = a[h * SP + lane];
    float ysum = 0.f;
#pragma unroll 16
    for (int p = 0; p < SP; ++p) {
        const float2 hv = *(const float2*)(s0 + (size_t)p * SN + 2 * lane);
        const float dx = dt * __shfl(xl, p);
        const float h0 = hv.x * dec + dx * Bv.x, h1 = hv.y * dec + dx * Bv.y;
        *(float2*)(so + (size_t)p * SN + 2 * lane) = make_float2(h0, h1);
        const float y = wave_sum(h0 * Cv.x + h1 * Cv.y);
        ysum = lane == p ? y : ysum;
    }
    Y[(size_t)tok * 2048 + h * SP + lane] = ysum + Dh * xl;
}
DI void hyb_post_token(const Ctx& c, int li, int tok) {
    const bf16_t* PROJ = c.ws<bf16_t>(W_PROJ); const float* Y = c.ws<float>(W_Y); bf16_t* MIX = c.ws<bf16_t>(W_MIXED);
    const float* nw = c.in(I_SNW) + (size_t)li * SDI; const int lane = c.lane;
    float v[16]; float ss0 = 0.f, ss1 = 0.f;
#pragma unroll
    for (int j = 0; j < 16; ++j) { const int ch = lane + 64 * j; const float z = bf2f(PROJ[(size_t)tok * HYB_MAIN + 1536 + ch]); v[j] = Y[(size_t)tok * 2048 + ch] * siluf(z); if (j < 8) ss0 += v[j] * v[j]; else ss1 += v[j] * v[j]; }
    const float r0 = rsqrtf(wave_sum(ss0) * (1.f / 512.f) + EPS), r1 = rsqrtf(wave_sum(ss1) * (1.f / 512.f) + EPS);
#pragma unroll
    for (int j = 0; j < 16; ++j) { const int ch = lane + 64 * j; MIX[(size_t)tok * HYB_MIX + AW + ch] = f2bf(v[j] * (j < 8 ? r0 : r1) * nw[ch]); }
}


constexpr int SLD = 136;
constexpr int L_C = 0, L_B = 34816, L_XT = 69632, L_HS = 87040, L_CS = 104448, L_DT = 108544;
constexpr size_t W_ST = W_HID;
constexpr size_t W_DEC = W_HID + (size_t)NB * 32 * SH * SP * SN * 4;
constexpr int NCH = SEQ / 128;

DI void ssd_chunk_scalars(const Ctx& c, int li, int tok0, int g) {
    const float* AUX = c.ws<float>(W_AUX); LAS float* csS = (LAS float*)(c.lds + L_CS); LAS float* dtS = (LAS float*)(c.lds + L_DT);
    const int hh = c.wave, lane = c.lane, h = 8 * g + hh;
    const float Ah = -__expf(c.in(I_SALOG)[li * SH + h]);
    const float d0 = AUX[(size_t)(tok0 + lane) * 32 + h], d1 = AUX[(size_t)(tok0 + 64 + lane) * 32 + h];
    float s0 = d0 * Ah, s1 = d1 * Ah;
#pragma unroll
    for (int o = 1; o < 64; o <<= 1) { const float t0 = __shfl_up(s0, o), t1 = __shfl_up(s1, o); if (lane >= o) { s0 += t0; s1 += t1; } }
    s1 += __shfl(s0, 63);
    csS[lane * 8 + hh] = s0; csS[(64 + lane) * 8 + hh] = s1; dtS[lane * 8 + hh] = d0; dtS[(64 + lane) * 8 + hh] = d1;
}
DI void ssd_a_item(const Ctx& c, int li, int item) {
    int tid_o = c.tid; asm volatile("" : "+v"(tid_o));
    const int lane_o = tid_o & 63;
    const float* ACT = c.ws<float>(W_ACT); float* ST = c.ws<float>(W_ST); float* DEC = c.ws<float>(W_DEC);
    const int g = item & 1, ch = (item >> 1) % NCH, b = item / (2 * NCH), tok0 = b * SEQ + ch * 128;
    LAS bf16_t* BT = (LAS bf16_t*)(c.lds + L_B); LAS bf16_t* XT = (LAS bf16_t*)(c.lds + L_XT);
    const LAS float* csS = (const LAS float*)(c.lds + L_CS); const LAS float* dtS = (const LAS float*)(c.lds + L_DT);
    const int fr = lane_o & 15, fq = lane_o >> 4, w = c.wave;
    __syncthreads();
    ssd_chunk_scalars(c, li, tok0, g);
#pragma unroll 4
    for (int it = 0; it < 32; ++it) { const int idx = it * NTHR + tid_o, j = idx >> 7, n = idx & 127; BT[n * SLD + j] = f2bf(ACT[(size_t)(tok0 + j) * 4096 + SDI + g * SN + n]); }
    __syncthreads();
    if (tid_o < 8) DEC[(size_t)(b * NCH + ch) * SH + 8 * g + tid_o] = __expf(csS[127 * 8 + tid_o]);
    const int pt = w & 3, nt0 = (w >> 2) * 4;
    float xr[16];
#pragma unroll
    for (int it = 0; it < 16; ++it) { const int idx = it * NTHR + tid_o, j = idx >> 6, p = idx & 63; xr[it] = ACT[(size_t)(tok0 + j) * 4096 + (8 * g) * SP + p]; }
#pragma unroll 1
    for (int hh = 0; hh < 8; ++hh) {
        const int h = 8 * g + hh; const float csl = csS[127 * 8 + hh];
#pragma unroll
        for (int it = 0; it < 16; ++it) { const int idx = it * NTHR + tid_o, j = idx >> 6, p = idx & 63;
            XT[p * SLD + j] = f2bf(xr[it] * __expf(csl - csS[j * 8 + hh]) * dtS[j * 8 + hh]); }
        __syncthreads();
        if (hh + 1 < 8) {
#pragma unroll
            for (int it = 0; it < 16; ++it) { const int idx = it * NTHR + tid_o, j = idx >> 6, p = idx & 63; xr[it] = ACT[(size_t)(tok0 + j) * 4096 + (h + 1) * SP + p]; }
        }
        f32x4 acc[4];
#pragma unroll
        for (int n = 0; n < 4; ++n) acc[n] = (f32x4){0.f, 0.f, 0.f, 0.f};
#pragma unroll
        for (int ks = 0; ks < 4; ++ks) {
            const bf16x8 a = lds_frag(XT + (16 * pt + fr) * SLD + 32 * ks + 8 * fq);
#pragma unroll
            for (int n = 0; n < 4; ++n) { const bf16x8 bb = lds_frag(BT + (16 * (nt0 + n) + fr) * SLD + 32 * ks + 8 * fq); acc[n] = __builtin_amdgcn_mfma_f32_16x16x32_bf16(bb, a, acc[n], 0, 0, 0); }
        }
        float* so = ST + ((((size_t)(b * NCH + ch) * SH + h) * SP + 16 * pt + fr) * SN);
#pragma unroll
        for (int n = 0; n < 4; ++n) *(f32x4*)(so + 16 * (nt0 + n) + 4 * fq) = acc[n];
        __syncthreads();
    }
}
DI void ssd_scan_phase(const Ctx& c, int li) {
    float* ST = c.ws<float>(W_ST); const float* DEC = c.ws<float>(W_DEC);
    for (int idx = blockIdx.x * NTHR + c.tid; idx < NB * SH * SP * SN / 4; idx += gridDim.x * NTHR) {
        const int n4 = idx & 31, p = (idx >> 5) & 63, h = (idx >> 11) & 15, b = idx >> 15;
        f32x4 hcur = (f32x4){0.f, 0.f, 0.f, 0.f};
#pragma unroll 8
        for (int ch = 0; ch < NCH; ++ch) {
            f32x4* a = (f32x4*)(ST + ((((size_t)(b * NCH + ch) * SH + h) * SP + p) * SN)) + n4;
            const f32x4 s = *a; const float d = DEC[(size_t)(b * NCH + ch) * SH + h];
            *a = hcur; hcur = hcur * d + s;
        }
        *((f32x4*)(c.p.out + O_PSS + ((((size_t)(li * NB + b) * SH + h) * SP + p) * SN)) + n4) = hcur;
    }
}
DI void ssd_b_item(const Ctx& c, int li, int item) {
    int tid_o = c.tid; asm volatile("" : "+v"(tid_o));
    const int lane_o = tid_o & 63;
    const float* ACT = c.ws<float>(W_ACT); const float* ST = c.ws<float>(W_ST); const bf16_t* PROJ = c.ws<bf16_t>(W_PROJ); bf16_t* MIX = c.ws<bf16_t>(W_MIXED);
    const int g = item & 1, ch = (item >> 1) % NCH, b = item / (2 * NCH), tok0 = b * SEQ + ch * 128;
    LAS bf16_t* CS_ = (LAS bf16_t*)(c.lds + L_C); LAS bf16_t* BS = (LAS bf16_t*)(c.lds + L_B); LAS bf16_t* XT = (LAS bf16_t*)(c.lds + L_XT); LAS bf16_t* HS = (LAS bf16_t*)(c.lds + L_HS);
    const LAS float* csS = (const LAS float*)(c.lds + L_CS); const LAS float* dtS = (const LAS float*)(c.lds + L_DT);
    const int fr = lane_o & 15, fq = lane_o >> 4, w = c.wave, irow = 16 * w + fr;
    __syncthreads();
    ssd_chunk_scalars(c, li, tok0, g);
#pragma unroll 4
    for (int it = 0; it < 8; ++it) { const int idx = it * NTHR + tid_o, i = idx >> 5, n4 = idx & 31;
        const f32x4 bv = *(const f32x4*)(ACT + (size_t)(tok0 + i) * 4096 + SDI + g * SN + 4 * n4), cv = *(const f32x4*)(ACT + (size_t)(tok0 + i) * 4096 + SDI + SG * SN + g * SN + 4 * n4);
        u32x2 o; o.x = pk2(bv.x, bv.y); o.y = pk2(bv.z, bv.w); *(LAS u32x2*)(BS + i * SLD + 4 * n4) = o;
        o.x = pk2(cv.x, cv.y); o.y = pk2(cv.z, cv.w); *(LAS u32x2*)(CS_ + i * SLD + 4 * n4) = o; }
    __syncthreads();
    f32x4 cb[8];
#pragma unroll
    for (int jt = 0; jt < 8; ++jt) cb[jt] = (f32x4){0.f, 0.f, 0.f, 0.f};
    bf16x8 cfrag[4];
#pragma unroll
    for (int ks = 0; ks < 4; ++ks) cfrag[ks] = lds_frag(CS_ + irow * SLD + 32 * ks + 8 * fq);
#pragma unroll
    for (int jt = 0; jt < 8; ++jt) if (jt <= w) {
#pragma unroll
        for (int ks = 0; ks < 4; ++ks) cb[jt] = __builtin_amdgcn_mfma_f32_16x16x32_bf16(lds_frag(BS + (16 * jt + fr) * SLD + 32 * ks + 8 * fq), cfrag[ks], cb[jt], 0, 0, 0);
    }
    float rowsq = 0.f;
    float xr[16]; f32x4 hr[4];
#pragma unroll
    for (int it = 0; it < 16; ++it) { const int idx = it * NTHR + tid_o, j = idx >> 6, p = idx & 63; xr[it] = ACT[(size_t)(tok0 + j) * 4096 + (8 * g) * SP + p]; }
#pragma unroll
    for (int it = 0; it < 4; ++it) { const int idx = it * NTHR + tid_o, p = idx >> 5, n4 = idx & 31; hr[it] = *((const f32x4*)(ST + ((((size_t)(b * NCH + ch) * SH + 8 * g) * SP + p) * SN)) + n4); }
#pragma unroll 1
    for (int hh = 0; hh < 8; ++hh) {
        const int h = 8 * g + hh; const float Dh = c.in(I_SD)[li * SH + h];
        int tw = tid_o; asm volatile("" : "+v"(tw));
#pragma unroll
        for (int it = 0; it < 16; ++it) { const int idx = it * NTHR + tw, j = idx >> 6, p = idx & 63; XT[p * SLD + j] = f2bf(xr[it]); }
#pragma unroll
        for (int it = 0; it < 4; ++it) { const int idx = it * NTHR + tw, p = idx >> 5, n4 = idx & 31; const f32x4 v = hr[it];
            u32x2 o; o.x = pk2(v.x, v.y); o.y = pk2(v.z, v.w); *(LAS u32x2*)(HS + p * SLD + 4 * n4) = o; }
        __syncthreads();
        if (hh + 1 < 8) {
            int tq = tid_o; asm volatile("" : "+v"(tq));
#pragma unroll
            for (int it = 0; it < 16; ++it) { const int idx = it * NTHR + tq, j = idx >> 6, p = idx & 63; xr[it] = ACT[(size_t)(tok0 + j) * 4096 + (h + 1) * SP + p]; }
#pragma unroll
            for (int it = 0; it < 4; ++it) { const int idx = it * NTHR + tq, p = idx >> 5, n4 = idx & 31; hr[it] = *((const f32x4*)(ST + ((((size_t)(b * NCH + ch) * SH + h + 1) * SP + p) * SN)) + n4); }
        }
        const float csi = csS[irow * 8 + hh];
        f32x4 ay[4], ah[4];
#pragma unroll
        for (int pt = 0; pt < 4; ++pt) { ay[pt] = (f32x4){0.f, 0.f, 0.f, 0.f}; ah[pt] = (f32x4){0.f, 0.f, 0.f, 0.f}; }
#pragma unroll
        for (int ks = 0; ks < 4; ++ks) {
#pragma unroll
            for (int pt = 0; pt < 4; ++pt) ah[pt] = __builtin_amdgcn_mfma_f32_16x16x32_bf16(lds_frag(HS + (16 * pt + fr) * SLD + 32 * ks + 8 * fq), cfrag[ks], ah[pt], 0, 0, 0);
            if (2 * ks <= w) {
                float mv[8];
#pragma unroll
                for (int e = 0; e < 8; ++e) {
                    const int j = 32 * ks + (e < 4 ? 4 * fq + e : 16 + 4 * fq + (e - 4));
                    const float cbv = e < 4 ? cb[2 * ks][e] : cb[2 * ks + 1][e - 4];
                    const float csj = *(const volatile LAS float*)(csS + j * 8 + hh), dtj = *(const volatile LAS float*)(dtS + j * 8 + hh);
                    mv[e] = j <= irow ? cbv * __expf(csi - csj) * dtj : 0.f;
                }
                u32x4 mp; mp.x = pk2(mv[0], mv[1]); mp.y = pk2(mv[2], mv[3]); mp.z = pk2(mv[4], mv[5]); mp.w = pk2(mv[6], mv[7]);
                const bf16x8 mfrag = __builtin_bit_cast(bf16x8, mp);
#pragma unroll
                for (int pt = 0; pt < 4; ++pt) ay[pt] = __builtin_amdgcn_mfma_f32_16x16x32_bf16(lds_frag2(XT + (16 * pt + fr) * SLD + 32 * ks + 4 * fq, XT + (16 * pt + fr) * SLD + 32 * ks + 16 + 4 * fq), mfrag, ay[pt], 0, 0, 0);
            }
        }
        const float ei = __expf(csi);
#pragma unroll
        for (int pt = 0; pt < 4; ++pt) {
            const int col = h * SP + 16 * pt + 4 * fq;
            const f32x4 xv = *(const f32x4*)(ACT + (size_t)(tok0 + irow) * 4096 + col);
            const u32x2 zz = *(const u32x2*)(PROJ + (size_t)(tok0 + irow) * HYB_MAIN + 1536 + col);
            const float z0 = bf2f((bf16_t)(zz.x & 0xffff)), z1 = bf2f((bf16_t)(zz.x >> 16)), z2 = bf2f((bf16_t)(zz.y & 0xffff)), z3 = bf2f((bf16_t)(zz.y >> 16));
            const float y0 = (ay[pt][0] + ei * ah[pt][0] + Dh * xv.x) * siluf(z0), y1 = (ay[pt][1] + ei * ah[pt][1] + Dh * xv.y) * siluf(z1);
            const float y2 = (ay[pt][2] + ei * ah[pt][2] + Dh * xv.z) * siluf(z2), y3 = (ay[pt][3] + ei * ah[pt][3] + Dh * xv.w) * siluf(z3);
            rowsq += y0 * y0 + y1 * y1 + y2 * y2 + y3 * y3;
            u32x2 o; o.x = pk2(y0, y1); o.y = pk2(y2, y3); *(u32x2*)(MIX + (size_t)(tok0 + irow) * HYB_MIX + AW + col) = o;
        }
        __syncthreads();
    }
    rowsq += __shfl_xor(rowsq, 16); rowsq += __shfl_xor(rowsq, 32);
    const float rn = rsqrtf(rowsq * (1.f / 512.f) + EPS);
    const float* nw = c.in(I_SNW) + (size_t)li * SDI + g * 512;
    asm volatile("s_waitcnt vmcnt(0)" ::: "memory");
    bf16_t* mrow = MIX + (size_t)(tok0 + irow) * HYB_MIX + AW + g * 512 + fq * 128;
#pragma unroll 4
    for (int cc = 0; cc < 16; ++cc) {
        const u32x4 v = *(const u32x4*)(mrow + 8 * cc); const float* wv = nw + fq * 128 + 8 * cc; u32x4 o;
        o.x = pk2(bf2f((bf16_t)(v.x & 0xffff)) * rn * wv[0], bf2f((bf16_t)(v.x >> 16)) * rn * wv[1]); o.y = pk2(bf2f((bf16_t)(v.y & 0xffff)) * rn * wv[2], bf2f((bf16_t)(v.y >> 16)) * rn * wv[3]);
        o.z = pk2(bf2f((bf16_t)(v.z & 0xffff)) * rn * wv[4], bf2f((bf16_t)(v.z >> 16)) * rn * wv[5]); o.w = pk2(bf2f((bf16_t)(v.w & 0xffff)) * rn * wv[6], bf2f((bf16_t)(v.w >> 16)) * rn * wv[7]);
        *(u32x4*)(mrow + 8 * cc) = o;
    }
}

DI void gdn_pre_token(const Ctx& c, int li, int tok) {
    const bf16_t* PROJ = c.ws<bf16_t>(W_PROJ); bf16_t* ACTB = c.ws<bf16_t>(W_ACT); float* AUX = c.ws<float>(W_AUX); const float* EX = c.ws<float>(W_EXTRA);
    const int lane = c.lane; const bool smp = tok >= T; const int b = smp ? tok - T : tok / SEQ, s = smp ? 0 : tok % SEQ;
    const float* cw = c.in(I_GCW) + (size_t)li * 4 * GQKV;
    const float* st = c.in(I_GCONV) + (size_t)(li * NS + b) * 3 * GQKV;
    const bf16_t* prow = PROJ + (size_t)tok * GDN_MAIN;
#pragma unroll 1
    for (int it = 0; it < 8; ++it) {
        const int ch0 = 512 * it + 8 * lane; float x1[8], x2[8], x3[8], y[8];
        conv8(prow, GDN_MAIN, st, GQKV, cw, ch0, smp, s, x1, x2, x3, y);
        float ss = 0.f;
#pragma unroll
        for (int e = 0; e < 8; ++e) { y[e] = siluf(y[e]); ss += y[e] * y[e]; }
        if (it < 4) {
            ss += __shfl_xor(ss, 1); ss += __shfl_xor(ss, 2); ss += __shfl_xor(ss, 4); ss += __shfl_xor(ss, 8);
            const float r = rsqrtf(ss + EPS) * (it < 2 ? 0.08838834764831845f : 1.f);
#pragma unroll
            for (int e = 0; e < 8; ++e) y[e] *= r;
        }
        { u32x4 o; o.x = pk2(y[0], y[1]); o.y = pk2(y[2], y[3]); o.z = pk2(y[4], y[5]); o.w = pk2(y[6], y[7]); *(u32x4*)(ACTB + (size_t)tok * 4096 + ch0) = o; }
        if (smp) { float* o = c.p.out + O_SGC + (size_t)(li * NS + b) * 3 * GQKV + ch0; store8f(o, x1); store8f(o + GQKV, x2); store8f(o + 2 * GQKV, x3); }
        else if (s >= SEQ - 3) store8f(c.p.out + O_PGC + ((size_t)(li * NB + b) * 3 + (s - (SEQ - 3))) * GQKV + ch0, x3);
    }
    if (lane < GH) {
        AUX[(size_t)tok * 32 + lane] = sigmoidf_(EX[(size_t)tok * 32 + lane]);
        AUX[(size_t)tok * 32 + 16 + lane] = -__expf(c.in(I_GALOG)[li * GH + lane]) * softplusf_(EX[(size_t)tok * 32 + 16 + lane] + c.in(I_GDTB)[li * GH + lane]);
    }
}
DI void gdn_pre_range(const Ctx& c, int li, int item) {
    const bf16_t* PROJ = c.ws<bf16_t>(W_PROJ); bf16_t* ACTB = c.ws<bf16_t>(W_ACT); float* AUX = c.ws<float>(W_AUX); const float* EX = c.ws<float>(W_EXTRA);
    int lane_ = c.lane; asm volatile("" : "+v"(lane_));
    const int lane = lane_, it = item & 7, rg = item >> 3, tok0 = rg * 64, b = tok0 / SEQ, s0 = tok0 % SEQ, ch0 = 512 * it + 8 * lane;
    const float* cw = c.in(I_GCW) + (size_t)li * 4 * GQKV;
    float w0[8], w1[8], w2[8], w3[8], xa[8], xb[8], xc[8];
    load8f(cw + ch0, w0); load8f(cw + GQKV + ch0, w1); load8f(cw + 2 * GQKV + ch0, w2); load8f(cw + 3 * GQKV + ch0, w3);
    const bf16_t* prow = PROJ + (size_t)tok0 * GDN_MAIN + ch0;
    const u32x4 z4 = (u32x4){0u, 0u, 0u, 0u};
    unpack8(s0 >= 3 ? *(const u32x4*)(prow - 3 * GDN_MAIN) : z4, xa); unpack8(s0 >= 2 ? *(const u32x4*)(prow - 2 * GDN_MAIN) : z4, xb); unpack8(s0 >= 1 ? *(const u32x4*)(prow - GDN_MAIN) : z4, xc);
    const float qscale = it < 2 ? 0.08838834764831845f : 1.f;
    const float gal = lane >= 16 && lane < 32 ? -__expf(c.in(I_GALOG)[li * GH + lane - 16]) : 0.f, gdb = lane >= 16 && lane < 32 ? c.in(I_GDTB)[li * GH + lane - 16] : 0.f;
    u32x4 rawn[16];
#pragma unroll
    for (int j = 0; j < 16; ++j) rawn[j] = *(const u32x4*)(prow + (size_t)j * GDN_MAIN);
#pragma unroll 1
    for (int tb = 0; tb < 64; tb += 16) {
        u32x4 raw[16];
#pragma unroll
        for (int j = 0; j < 16; ++j) raw[j] = rawn[j];
        if (tb + 16 < 64) {
#pragma unroll
            for (int j = 0; j < 16; ++j) rawn[j] = *(const u32x4*)(prow + (size_t)(tb + 16 + j) * GDN_MAIN);
        }
#pragma unroll
        for (int j = 0; j < 16; ++j) {
            const int t = tb + j;
            float xd[8], y[8];
            unpack8(raw[j], xd);
            float ss = 0.f;
#pragma unroll
            for (int e = 0; e < 8; ++e) { y[e] = siluf(xa[e] * w0[e] + xb[e] * w1[e] + xc[e] * w2[e] + xd[e] * w3[e]); ss += y[e] * y[e]; }
            if (it < 4) {
                ss += __shfl_xor(ss, 1); ss += __shfl_xor(ss, 2); ss += __shfl_xor(ss, 4); ss += __shfl_xor(ss, 8);
                const float r = rsqrtf(ss + EPS) * qscale;
#pragma unroll
                for (int e = 0; e < 8; ++e) y[e] *= r;
            }
            { u32x4 o; o.x = pk2(y[0], y[1]); o.y = pk2(y[2], y[3]); o.z = pk2(y[4], y[5]); o.w = pk2(y[6], y[7]); *(u32x4*)(ACTB + (size_t)(tok0 + t) * 4096 + ch0) = o; }
            if (s0 + t >= SEQ - 3) store8f(c.p.out + O_PGC + ((size_t)(li * NB + b) * 3 + (s0 + t - (SEQ - 3))) * GQKV + ch0, xd);
            if (it == 0 && lane < 32) {
                const float ev = EX[(size_t)(tok0 + t) * 32 + lane];
                AUX[(size_t)(tok0 + t) * 32 + lane] = lane < 16 ? sigmoidf_(ev) : gal * softplusf_(ev + gdb);
            }
#pragma unroll
            for (int e = 0; e < 8; ++e) { xa[e] = xb[e]; xb[e] = xc[e]; xc[e] = xd[e]; }
        }
    }
}
DI void gdn_seq_phase(const Ctx& c, int li, int first_item, int wg, int nwg) {
    const bf16_t* ACTB = c.ws<bf16_t>(W_ACT); const float* AUX = c.ws<float>(W_AUX); bf16_t* MIX = c.ws<bf16_t>(W_MIXED); const bf16_t* PROJ = c.ws<bf16_t>(W_PROJ);
    LAS float* red = (LAS float*)c.lds + 1024;
    const int slot = c.tid >> 8, t8 = c.tid & 255, col = t8 >> 1, half = t8 & 1;
    LAS float* kq = (LAS float*)c.lds + slot * 512;
    const int nslot = nwg * 2;
    for (int base = first_item; base < NB * GH + NS * GH; base += nslot) {
        const int item = base + wg * 2 + slot;
        const bool wg_prompt = (base + wg * 2) < NB * GH;
        const int L = wg_prompt ? SEQ : 1;
        const bool valid = item < NB * GH + NS * GH;
        const bool smp = item >= NB * GH; const int it = smp ? item - NB * GH : item;
        const int seq = valid ? it / GH : 0, vh = valid ? it % GH : 0, hq = vh >> 1;
        const int tok0 = smp ? T + seq : seq * SEQ;
        float S[64];
        if (valid && smp) { const float* s0 = c.in(I_GST) + ((size_t)(li * NS + seq) * GH + vh) * GDK * GDV + (size_t)(64 * half) * GDV + col;
#pragma unroll
            for (int k = 0; k < 64; ++k) S[k] = s0[(size_t)k * GDV]; }
        else {
#pragma unroll
            for (int k = 0; k < 64; ++k) S[k] = 0.f; }
        __syncthreads();
        for (int t = 0; t < L; ++t) {
            LAS float* cur = kq + (t & 1) * 256;
            const bf16_t* a = ACTB + (size_t)(tok0 + t) * 4096;
            cur[t8] = bf2f(a[(t8 < 128 ? 1024 : -128) + hq * 128 + t8]);
            const float vv = bf2f(a[2048 + vh * 128 + col]), beta = AUX[(size_t)(tok0 + t) * 32 + vh], eg = __expf(AUX[(size_t)(tok0 + t) * 32 + 16 + vh]);
            __syncthreads();
            const LAS float* kk = cur + 64 * half; const LAS float* qq = cur + 128 + 64 * half;
            float ks = 0.f;
#pragma unroll
            for (int k = 0; k < 64; k += 4) { const f32x4 kv = *(const LAS f32x4*)(kk + k); ks += kv.x * S[k] + kv.y * S[k + 1] + kv.z * S[k + 2] + kv.w * S[k + 3]; }
            ks += __shfl_xor(ks, 1);
            const float u = beta * (vv - eg * ks);
            asm volatile("" ::: "memory");
            float o = 0.f;
#pragma unroll
            for (int k = 0; k < 64; k += 4) { const f32x4 kv = *(const LAS f32x4*)(kk + k); const f32x4 qv = *(const LAS f32x4*)(qq + k);
                S[k] = eg * S[k] + kv.x * u; S[k + 1] = eg * S[k + 1] + kv.y * u; S[k + 2] = eg * S[k + 2] + kv.z * u; S[k + 3] = eg * S[k + 3] + kv.w * u;
                o += qv.x * S[k] + qv.y * S[k + 1] + qv.z * S[k + 2] + qv.w * S[k + 3]; }
            o += __shfl_xor(o, 1);
            { const float sq = wave_sum(half == 0 ? o * o : 0.f); if (c.lane == 0) red[slot * 4 + ((c.tid >> 6) & 3)] = sq; }
            __syncthreads();
            if (valid && half == 0) { const float tot = red[slot * 4] + red[slot * 4 + 1] + red[slot * 4 + 2] + red[slot * 4 + 3];
                const float z = bf2f(PROJ[(size_t)(tok0 + t) * GDN_MAIN + 4096 + vh * 128 + col]);
                MIX[(size_t)(tok0 + t) * GVW + vh * 128 + col] = f2bf(o * rsqrtf(tot * (1.f / 128.f) + EPS) * c.in(I_GNW)[li * GDV + col] * siluf(z)); }
        }
        if (valid) { float* so = (smp ? c.p.out + O_SGS + ((size_t)(li * NS + seq) * GH + vh) * GDK * GDV : c.p.out + O_PGS + ((size_t)(li * NB + seq) * GH + vh) * GDK * GDV) + (size_t)(64 * half) * GDV + col;
#pragma unroll
            for (int k = 0; k < 64; ++k) so[(size_t)k * GDV] = S[k]; }
        __syncthreads();
    }
}

constexpr size_t W_KCD = W_GO;
constexpr size_t W_U0 = W_HID;
constexpr size_t W_GC = W_HID + (size_t)67108864;
constexpr size_t W_QB = W_H;
constexpr size_t W_ATTG = W_Y;
constexpr size_t W_KT = W_Y + (size_t)33554432;
constexpr int GA_LDS = 20000;
constexpr int GCH = SEQ / 64;

DI bf16x8 gfrag_f32(const float* p) { return pack8(*(const f32x4*)p, *(const f32x4*)(p + 4)); }

DI void gdn_a_item(const Ctx& c, int li, int item) {
    const bf16_t* ACTB = c.ws<bf16_t>(W_ACT); const float* AUX = c.ws<float>(W_AUX);
    const int ch = item & (GCH - 1), vh = (item >> 6) & 15, b = item >> 10, hq = vh >> 1, tok0 = b * SEQ + ch * 64;
    int lane_ = c.lane; asm volatile("" : "+v"(lane_));
    const int lane = lane_, fr = lane & 15, fq = lane >> 4;
    LAS unsigned char* wl = c.lds + c.wave * GA_LDS;
    LAS float* As = (LAS float*)wl; LAS bf16_t* Ts = (LAS bf16_t*)wl; LAS bf16_t* KsT = (LAS bf16_t*)wl;
    LAS float* gcS = (LAS float*)(wl + 17408); LAS float* btS = gcS + 64; LAS float* beS = gcS + 128;
    bf16_t* KCDg = c.ws<bf16_t>(W_KCD) + (size_t)item * 8192; bf16_t* ATTg = c.ws<bf16_t>(W_ATTG) + (size_t)item * 4096; bf16_t* U0g = c.ws<bf16_t>(W_U0) + (size_t)item * 8192;
    const int qitem = (b * GQH + hq) * GCH + ch;
    { const float gi = AUX[(size_t)(tok0 + lane) * 32 + 16 + vh], bi = AUX[(size_t)(tok0 + lane) * 32 + vh];
      float gc = gi;
#pragma unroll
      for (int o = 1; o < 64; o <<= 1) { const float t = __shfl_up(gc, o); if (lane >= o) gc += t; }
      gcS[lane] = gc; btS[lane] = bi; beS[lane] = bi * __expf(gc); c.ws<float>(W_GC)[(size_t)(tok0 + lane) * 16 + vh] = gc; }
    LDS_WAIT();
    {
        bf16x8 kf[4][4], qfa[4][4];
#pragma unroll
        for (int t = 0; t < 4; ++t)
#pragma unroll
            for (int ks = 0; ks < 4; ++ks) { const bf16_t* rp = ACTB + (size_t)(tok0 + 16 * t + fr) * 4096 + hq * 128 + 32 * ks + 8 * fq; kf[t][ks] = *(const bf16x8*)(rp + 1024); qfa[t][ks] = *(const bf16x8*)rp; }
#pragma unroll
        for (int it = 0; it < 4; ++it) {
            const int i = 16 * it + fr; const float gci = gcS[i], bti = btS[i];
#pragma unroll
            for (int jt = 0; jt < 4; ++jt) {
                bf16_t* ap = ATTg + (unsigned)(i * 64 + 16 * jt + 4 * fq);
                if (jt > it) { *(unsigned long long*)ap = 0ull; continue; }
                f32x4 kk = (f32x4){0.f, 0.f, 0.f, 0.f}, qk = (f32x4){0.f, 0.f, 0.f, 0.f};
#pragma unroll
                for (int ks = 0; ks < 4; ++ks) { kk = __builtin_amdgcn_mfma_f32_16x16x32_bf16(kf[jt][ks], kf[it][ks], kk, 0, 0, 0); qk = __builtin_amdgcn_mfma_f32_16x16x32_bf16(kf[jt][ks], qfa[it][ks], qk, 0, 0, 0); }
                f32x4 av, tv;
#pragma unroll
                for (int r = 0; r < 4; ++r) { const int j = 16 * jt + 4 * fq + r; const float dec = __expf(gci - gcS[j]); av[r] = j < i ? bti * kk[r] * dec : 0.f; tv[r] = j <= i ? qk[r] * dec : 0.f; }
                *(LAS f32x4*)(As + i * 64 + 16 * jt + 4 * fq) = av;
                *(unsigned long long*)ap = (unsigned long long)pk2(tv[0], tv[1]) | ((unsigned long long)pk2(tv[2], tv[3]) << 32);
            }
        }
    }
    LDS_WAIT();
    float Tr[64];
#pragma unroll
    for (int i = 0; i < 64; ++i) {
        float acc = lane == i ? 1.f : 0.f;
#pragma unroll
        for (int j = 0; j < i; ++j) acc -= As[i * 64 + j] * Tr[j];
        Tr[i] = acc;
    }
    LDS_WAIT();
#pragma unroll
    for (int i = 0; i < 64; ++i) Ts[i * 72 + lane] = f2bf(Tr[i]);
    LDS_WAIT();
    {
        bf16x8 tfp[4][2], idf[2];
#pragma unroll
        for (int it = 0; it < 4; ++it)
#pragma unroll
            for (int ks = 0; ks < 2; ++ks) tfp[it][ks] = lds_frag2(Ts + (16 * it + fr) * 72 + 32 * ks + 4 * fq, Ts + (16 * it + fr) * 72 + 32 * ks + 16 + 4 * fq);
#pragma unroll
        for (int hs = 0; hs < 2; ++hs)
#pragma unroll
            for (int e = 0; e < 8; ++e) idf[hs][e] = (8 * fq + e) == (16 * hs + fr) ? (short)0x3F80 : (short)0;
        bf16_t* KTg = c.ws<bf16_t>(W_KT) + (size_t)qitem * 8192;
        const bool wr_k = (vh & 1) == 0;
        const bf16_t* AK = ACTB + (size_t)tok0 * 4096 + 1024 + hq * 128; const bf16_t* AV = ACTB + (size_t)tok0 * 4096 + 2048 + vh * 128;
        bf16x8 vfn[4], kfn[4];
#pragma unroll
        for (int t = 0; t < 4; ++t) { vfn[t] = *(const bf16x8*)(AV + (size_t)(16 * t + fr) * 4096 + 8 * fq); kfn[t] = *(const bf16x8*)(AK + (size_t)(16 * t + fr) * 4096 + 8 * fq); }
#pragma unroll 1
        for (int cc = 0; cc < 4; ++cc) {
            bf16x8 vf[4], kf2[4];
#pragma unroll
            for (int t = 0; t < 4; ++t) { vf[t] = vfn[t]; kf2[t] = kfn[t]; }
            if (cc + 1 < 4) {
#pragma unroll
                for (int t = 0; t < 4; ++t) { vfn[t] = *(const bf16x8*)(AV + (size_t)(16 * t + fr) * 4096 + 32 * (cc + 1) + 8 * fq); kfn[t] = *(const bf16x8*)(AK + (size_t)(16 * t + fr) * 4096 + 32 * (cc + 1) + 8 * fq); }
            }
#pragma unroll
            for (int hs = 0; hs < 2; ++hs) {
                const int nt = 2 * cc + hs;
                f32x4 dvv[4], dkk[4];
#pragma unroll
                for (int t = 0; t < 4; ++t) {
                    const f32x4 z = (f32x4){0.f, 0.f, 0.f, 0.f};
                    dvv[t] = __builtin_amdgcn_mfma_f32_16x16x32_bf16(vf[t], idf[hs], z, 0, 0, 0);
                    dkk[t] = __builtin_amdgcn_mfma_f32_16x16x32_bf16(kf2[t], idf[hs], z, 0, 0, 0);
                    if (wr_k) *(unsigned long long*)(KTg + (unsigned)((16 * nt + fr) * 64 + 16 * t + 4 * fq)) = (unsigned long long)pk2(dkk[t][0], dkk[t][1]) | ((unsigned long long)pk2(dkk[t][2], dkk[t][3]) << 32);
                    const f32x4 bt = *(const LAS f32x4*)(btS + 16 * t + 4 * fq), be = *(const LAS f32x4*)(beS + 16 * t + 4 * fq);
                    dvv[t] *= bt; dkk[t] *= be;
                }
                f32x4 au[4], ak[4];
#pragma unroll
                for (int it = 0; it < 4; ++it) { au[it] = (f32x4){0.f, 0.f, 0.f, 0.f}; ak[it] = (f32x4){0.f, 0.f, 0.f, 0.f}; }
#pragma unroll
                for (int ks = 0; ks < 2; ++ks) {
                    const bf16x8 vfrag = pack8(dvv[2 * ks], dvv[2 * ks + 1]), kfrag = pack8(dkk[2 * ks], dkk[2 * ks + 1]);
#pragma unroll
                    for (int it = 0; it < 4; ++it) { au[it] = __builtin_amdgcn_mfma_f32_16x16x32_bf16(tfp[it][ks], vfrag, au[it], 0, 0, 0);
                                                     ak[it] = __builtin_amdgcn_mfma_f32_16x16x32_bf16(kfrag, tfp[it][ks], ak[it], 0, 0, 0); }
                }
#pragma unroll
                for (int it = 0; it < 4; ++it) {
                    *(unsigned long long*)(U0g + (unsigned)(((nt * 4 + it) * 64 + lane) * 4)) = (unsigned long long)pk2(au[it][0], au[it][1]) | ((unsigned long long)pk2(au[it][2], au[it][3]) << 32);
                    *(unsigned long long*)(KCDg + (unsigned)((16 * it + fr) * 128 + 16 * nt + 4 * fq)) = (unsigned long long)pk2(ak[it][0], ak[it][1]) | ((unsigned long long)pk2(ak[it][2], ak[it][3]) << 32);
                }
            }
        }
    }
    LDS_WAIT();
}

constexpr int GS_KCD = 0, GS_QB = 17408, GS_ATT = 34816, GS_KT = 44032, GS_GC = 62464, GS_BUF = 62720;
DI bf16x8 fragA(const LAS unsigned char* p) { const u32x2 x = *(const volatile LAS u32x2*)p, y = *(const volatile LAS u32x2*)(p + 128);     u32x4 r; r.x = x.x; r.y = x.y; r.z = y.x; r.w = y.y; return __builtin_bit_cast(bf16x8, r); }
DI bf16x8 fragB(const LAS unsigned char* p) { const u32x2 x = *(const volatile LAS u32x2*)p, y = *(const volatile LAS u32x2*)(p + 256); u32x4 r; r.x = x.x; r.y = x.y; r.z = y.x; r.w = y.y; return __builtin_bit_cast(bf16x8, r); }
DI void gdn_scan_wg(const Ctx& c, int li, int bvh) {
    const int vh = bvh & 15, b = bvh >> 4, hq = vh >> 1, lane = c.lane, fr = lane & 15, fq = lane >> 4, w = c.wave, tid = c.tid;
    const bf16_t* KCDg = c.ws<bf16_t>(W_KCD) + (size_t)(bvh * GCH) * 8192; const bf16_t* ATTg = c.ws<bf16_t>(W_ATTG) + (size_t)(bvh * GCH) * 4096;
    const bf16_t* U0g = c.ws<bf16_t>(W_U0) + (size_t)(bvh * GCH) * 8192;
    const bf16_t* QBg = c.ws<bf16_t>(W_ACT) + (size_t)(b * SEQ) * 4096 + hq * 128; const bf16_t* KTg = c.ws<bf16_t>(W_KT) + (size_t)((b * GQH + hq) * GCH) * 8192;
    const float* GCg = c.ws<float>(W_GC); bf16_t* MIX = c.ws<bf16_t>(W_MIXED); const bf16_t* PROJ = c.ws<bf16_t>(W_PROJ);
    LAS float* OT = (LAS float*)(c.lds + 2 * GS_BUF);
    LAS float* nwS = OT + 64 * 132;
    if (tid < GDV) nwS[tid] = c.in(I_GNW)[li * GDV + tid];
#define GS_DMA(tn, bb) do { \
        LAS unsigned char* lb_ = c.lds + (bb) * GS_BUF; \
        _Pragma("unroll") for (int k = 0; k < 2; ++k) { const int p_ = 8 * k + w; \
            __builtin_amdgcn_global_load_lds((const unsigned*)(KCDg + (size_t)(tn) * 8192 + p_ * 512 + srcA), (LAS unsigned*)(lb_ + GS_KCD + p_ * 1088), 16, 0, 0); \
            __builtin_amdgcn_global_load_lds((const unsigned*)(QBg + (size_t)(tn) * (64 * 4096) + p_ * (4 * 4096) + srcQ), (LAS unsigned*)(lb_ + GS_QB + p_ * 1088), 16, 0, 0); \
            __builtin_amdgcn_global_load_lds((const unsigned*)(KTg + (size_t)(tn) * 8192 + p_ * 512 + srcB), (LAS unsigned*)(lb_ + GS_KT + p_ * 1152), 16, 0, 0); } \
        __builtin_amdgcn_global_load_lds((const unsigned*)(ATTg + (size_t)(tn) * 4096 + w * 512 + srcB), (LAS unsigned*)(lb_ + GS_ATT + w * 1152), 16, 0, 0); } while (0)
    const int srcA = (lane & 3) * 128 + 8 * (lane >> 2), srcQ = (lane & 3) * 4096 + 8 * (lane >> 2), srcB = (lane & 7) * 64 + 8 * (lane >> 3);
    const int offA = (fr >> 2) * 1088 + (fr & 3) * 16 + (fq >> 1) * 64 + 8 * (fq & 1), offB = (fr >> 3) * 1152 + (fr & 7) * 16 + (fq >> 1) * 128 + 8 * (fq & 1);
    f32x4 sacc[8];
#pragma unroll
    for (int t = 0; t < 8; ++t) sacc[t] = (f32x4){0.f, 0.f, 0.f, 0.f};
    __syncthreads();
    u32x2 u0n[4];
#pragma unroll
    for (int it = 0; it < 4; ++it) u0n[it] = *(const u32x2*)(U0g + ((size_t)(w * 4 + it) * 64 + lane) * 4);
    GS_DMA(0, 0);
    if (tid < 64) *(LAS float*)(c.lds + GS_GC + 4 * tid) = GCg[(size_t)(b * SEQ + tid) * 16 + vh];
    asm volatile("s_waitcnt vmcnt(0)" ::: "memory");
    __syncthreads();
#pragma unroll 1
    for (int t = 0; t < GCH; ++t) {
        const LAS unsigned char* buf = c.lds + (t & 1) * GS_BUF; LAS unsigned char* nbuf = c.lds + ((t + 1) & 1) * GS_BUF;
        const int tok0 = b * SEQ + t * 64;
        const bool more = t + 1 < GCH;
        u32x2 u0r[4];
#pragma unroll
        for (int it = 0; it < 4; ++it) u0r[it] = u0n[it];
        float gstg = 0.f;
        if (more) {
#pragma unroll
            for (int it = 0; it < 4; ++it) u0n[it] = *(const u32x2*)(U0g + (size_t)(t + 1) * 8192 + ((size_t)(w * 4 + it) * 64 + lane) * 4);
            if (tid < 64) gstg = GCg[(size_t)(tok0 + 64 + tid) * 16 + vh];
            GS_DMA(t + 1, (t + 1) & 1);
        }
        const LAS unsigned char* KCD = buf + GS_KCD; const LAS unsigned char* QB = buf + GS_QB; const LAS unsigned char* ATT = buf + GS_ATT; const LAS unsigned char* KT = buf + GS_KT;
        const LAS float* gcS = (const LAS float*)(buf + GS_GC);
        bf16x8 sfrag[4];
#pragma unroll
        for (int ks = 0; ks < 4; ++ks) sfrag[ks] = pack8(sacc[2 * ks], sacc[2 * ks + 1]);
        const float gl = gcS[63], egl = __expf(gl);
        bf16x8 ufrag[2], udfrag[2]; f32x4 ov[4];
#pragma unroll
        for (int hp = 0; hp < 2; ++hp) {
            f32x4 uu[2];
#pragma unroll
            for (int h2 = 0; h2 < 2; ++h2) {
                const int it = 2 * hp + h2;
                f32x4 ks_ = (f32x4){0.f, 0.f, 0.f, 0.f}, qs_ = (f32x4){0.f, 0.f, 0.f, 0.f};
#pragma unroll
                for (int ks = 0; ks < 4; ++ks) {
                    ks_ = __builtin_amdgcn_mfma_f32_16x16x32_bf16(fragA(KCD + offA + it * 4352 + ks * 256), sfrag[ks], ks_, 0, 0, 0);
                    qs_ = __builtin_amdgcn_mfma_f32_16x16x32_bf16(fragA(QB + offA + it * 4352 + ks * 256), sfrag[ks], qs_, 0, 0, 0);
                }
                const f32x4 gci = *(const LAS f32x4*)(gcS + 16 * it + 4 * fq);
                f32x4 u;
                u[0] = bf2f((bf16_t)(u0r[it].x & 0xffff)) - ks_[0]; u[1] = bf2f((bf16_t)(u0r[it].x >> 16)) - ks_[1]; u[2] = bf2f((bf16_t)(u0r[it].y & 0xffff)) - ks_[2]; u[3] = bf2f((bf16_t)(u0r[it].y >> 16)) - ks_[3];
                uu[h2] = u;
#pragma unroll
                for (int r = 0; r < 4; ++r) ov[it][r] = qs_[r] * __expf(gci[r]);
            }
            ufrag[hp] = pack8(uu[0], uu[1]);
            const f32x4 g0 = *(const LAS f32x4*)(gcS + 32 * hp + 4 * fq), g1 = *(const LAS f32x4*)(gcS + 32 * hp + 16 + 4 * fq);
            f32x4 d0, d1;
#pragma unroll
            for (int r = 0; r < 4; ++r) { d0[r] = uu[0][r] * __expf(gl - g0[r]); d1[r] = uu[1][r] * __expf(gl - g1[r]); }
            udfrag[hp] = pack8(d0, d1);
        }
#pragma unroll
        for (int it = 0; it < 4; ++it) {
            f32x4 au = ov[it];
#pragma unroll
            for (int ks = 0; ks < 2; ++ks) au = __builtin_amdgcn_mfma_f32_16x16x32_bf16(fragB(ATT + offB + it * 2304 + ks * 512), ufrag[ks], au, 0, 0, 0);
#pragma unroll
            for (int r = 0; r < 4; ++r) OT[(16 * it + 4 * fq + r) * 132 + 16 * w + fr] = au[r];
        }
        LDS_WAIT(); __builtin_amdgcn_s_barrier(); asm volatile("" ::: "memory");
        const int frow = tid >> 3, fc = tid & 7;
        const u32x4 zlo = *(const u32x4*)(PROJ + (size_t)(tok0 + frow) * GDN_MAIN + 4096 + vh * 128 + 16 * fc), zhi = *(const u32x4*)(PROJ + (size_t)(tok0 + frow) * GDN_MAIN + 4096 + vh * 128 + 16 * fc + 8);
#pragma unroll
        for (int tt = 0; tt < 8; ++tt) {
            f32x4 a = sacc[tt] * egl;
#pragma unroll
            for (int ks = 0; ks < 2; ++ks) a = __builtin_amdgcn_mfma_f32_16x16x32_bf16(fragB(KT + offB + tt * 2304 + ks * 512), udfrag[ks], a, 0, 0, 0);
            sacc[tt] = a;
        }
        {
            float ov16[16], zf[16];
#pragma unroll
            for (int q4 = 0; q4 < 4; ++q4) { const f32x4 v = *(const LAS f32x4*)(OT + frow * 132 + 16 * fc + 4 * q4); ov16[4 * q4] = v.x; ov16[4 * q4 + 1] = v.y; ov16[4 * q4 + 2] = v.z; ov16[4 * q4 + 3] = v.w; }
            float ss = 0.f;
#pragma unroll
            for (int e = 0; e < 16; ++e) ss += ov16[e] * ov16[e];
            ss += __shfl_xor(ss, 1); ss += __shfl_xor(ss, 2); ss += __shfl_xor(ss, 4);
            const float rn = rsqrtf(ss * (1.f / 128.f) + EPS);
            unpack8(zlo, zf); unpack8(zhi, zf + 8);
            float res[16];
#pragma unroll
            for (int e = 0; e < 16; ++e) res[e] = ov16[e] * rn * nwS[16 * fc + e] * siluf(zf[e]);
            u32x4 o0, o1; o0.x = pk2(res[0], res[1]); o0.y = pk2(res[2], res[3]); o0.z = pk2(res[4], res[5]); o0.w = pk2(res[6], res[7]);
            o1.x = pk2(res[8], res[9]); o1.y = pk2(res[10], res[11]); o1.z = pk2(res[12], res[13]); o1.w = pk2(res[14], res[15]);
            bf16_t* mp = MIX + (size_t)(tok0 + frow) * GVW + vh * 128 + 16 * fc;
            *(u32x4*)mp = o0; *(u32x4*)(mp + 8) = o1;
        }
        if (more && tid < 64) *(LAS float*)(nbuf + GS_GC + 4 * tid) = gstg;
        asm volatile("s_waitcnt vmcnt(0)" ::: "memory");
        __syncthreads();
    }
#undef GS_DMA
    float* so = c.p.out + O_PGS + ((size_t)(li * NB + b) * GH + vh) * GDK * GDV;
#pragma unroll
    for (int tt = 0; tt < 8; ++tt)
#pragma unroll
        for (int r = 0; r < 4; ++r) so[(size_t)(16 * tt + 4 * fq + r) * GDV + 16 * w + fr] = sacc[tt][r];
}

DI void gdn_post_token(const Ctx& c, int li, int tok) {
    const bf16_t* PROJ = c.ws<bf16_t>(W_PROJ); const float* Y = c.ws<float>(W_Y); bf16_t* MIX = c.ws<bf16_t>(W_MIXED);
    const float* nw = c.in(I_GNW) + (size_t)li * GDV; const int lane = c.lane;
#pragma unroll 1
    for (int it = 0; it < 4; ++it) {
        const int ch0 = 512 * it + 8 * lane; float o[8], z[8], w[8];
        load8f(Y + (size_t)tok * 2048 + ch0, o); unpack8(*(const u32x4*)(PROJ + (size_t)tok * GDN_MAIN + 4096 + ch0), z); load8f(nw + (ch0 & 127), w);
        float ss = 0.f;
#pragma unroll
        for (int e = 0; e < 8; ++e) ss += o[e] * o[e];
        ss += __shfl_xor(ss, 1); ss += __shfl_xor(ss, 2); ss += __shfl_xor(ss, 4); ss += __shfl_xor(ss, 8);
        const float r = rsqrtf(ss * (1.f / 128.f) + EPS);
        u32x4 ov; ov.x = pk2(o[0] * r * w[0] * siluf(z[0]), o[1] * r * w[1] * siluf(z[1])); ov.y = pk2(o[2] * r * w[2] * siluf(z[2]), o[3] * r * w[3] * siluf(z[3]));
        ov.z = pk2(o[4] * r * w[4] * siluf(z[4]), o[5] * r * w[5] * siluf(z[5])); ov.w = pk2(o[6] * r * w[6] * siluf(z[6]), o[7] * r * w[7] * siluf(z[7]));
        *(u32x4*)(MIX + (size_t)tok * GVW + ch0) = ov;
    }
}

DI void cache_copy(const Ctx& c, int wg, int nwg) {
    const size_t gt = (size_t)wg * NTHR + c.tid, gn = (size_t)nwg * NTHR;
    const size_t per = (size_t)(WIN - 1) * AW / 4, tot = (size_t)2 * NS * per;
#pragma unroll 4
    for (size_t i = gt; i < tot; i += gn) { const size_t sq = i / per, r = i % per;
        ((f32x4*)(c.p.out + O_SK + sq * WIN * AW))[r] = ((const f32x4*)(c.in(I_CK) + sq * WIN * AW + AW))[r];
        ((f32x4*)(c.p.out + O_SV + sq * WIN * AW))[r] = ((const f32x4*)(c.in(I_CV) + sq * WIN * AW + AW))[r]; }
}
DI void weights_half(const Ctx& c, int half, int gw0, int ngw0) {
    const int i = half;
    transpose_mat(c, c.in(I_WHIN) + (size_t)i * D * HYB_IN, D, HYB_IN, c.ws<bf16_t>(W_HIN) + (size_t)i * HYB_IN * D, 0, gw0, ngw0);
    transpose_mat(c, c.in(I_WHOUT) + (size_t)i * HYB_MIX * D, HYB_MIX, D, c.ws<bf16_t>(W_HOUT) + (size_t)i * D * HYB_MIX, 0, gw0, ngw0);
    transpose_mat(c, c.in(I_WGIN) + (size_t)i * D * GDN_IN, D, GDN_IN, c.ws<bf16_t>(W_GIN) + (size_t)i * GDN_IN * D, 0, gw0, ngw0);
    transpose_mat(c, c.in(I_WGOUT) + (size_t)i * GVW * D, GVW, D, c.ws<bf16_t>(W_GOUT) + (size_t)i * D * GVW, 0, gw0, ngw0);
    for (int l = 2 * half; l < 2 * half + 2; ++l) {
        transpose_mat(c, c.in(I_WFG) + (size_t)l * D * FF, D, FF, c.ws<bf16_t>(W_GU) + (size_t)l * 2 * FF * D, 1, gw0, ngw0);
        transpose_mat(c, c.in(I_WFU) + (size_t)l * D * FF, D, FF, c.ws<bf16_t>(W_GU) + (size_t)l * 2 * FF * D, 2, gw0, ngw0);
        transpose_mat(c, c.in(I_WFD) + (size_t)l * FF * D, FF, D, c.ws<bf16_t>(W_DN) + (size_t)l * D * FF, 0, gw0, ngw0);
    }
}
constexpr int PH_PER_LAYER = 10, N_PHASES = 1 + 2 * 10 + 2 * 8;
DI void phase_decode(int ph, int& l, int& sp) {
    int q = ph - 1; l = 0; if (q >= 10) { q -= 10; l = 1; if (q >= 8) { q -= 8; l = 2; if (q >= 10) { q -= 10; l = 3; } } }
    sp = (l & 1) ? (q >= 3 ? q + 2 : (q == 2 ? 3 : q)) : q;
}
#ifndef ONLY
#define ONLY -1
#endif
#define EN(x) (ONLY < 0 || ONLY == (x))
DI void run_phase(const Ctx& c, int ph) {
    if (ph == 0) { if (!EN(0)) return;
        weights_half(c, 0, -1, 0);
        rowpass_phase(c, 0, nullptr, c.in(I_NMPRE), true);
        return;
    }
    int l, sp; phase_decode(ph, l, sp); const int li = l >> 1; const bool hyb = (l & 1) == 0;
    bf16_t* H = c.ws<bf16_t>(W_H); bf16_t* PROJ = c.ws<bf16_t>(W_PROJ); bf16_t* MIX = c.ws<bf16_t>(W_MIXED); bf16_t* GO = c.ws<bf16_t>(W_GO); bf16_t* HID = c.ws<bf16_t>(W_HID);
    switch (sp) {
    case 0: {
        if (!EN(1)) break;
        const bf16_t* Wt = hyb ? c.ws<bf16_t>(W_HIN) + (size_t)li * HYB_IN * D : c.ws<bf16_t>(W_GIN) + (size_t)li * GDN_IN * D;
        const int nmain = hyb ? HYB_MAIN : GDN_MAIN, nall = hyb ? HYB_IN : GDN_IN;
        { pg8::Gemm g{H, Wt, T, nmain, D}; pg8::StaticOrder S; S.init(T, nmain, gridDim.x, blockIdx.x); pg8::EpiBf16Perm E{PROJ, nmain};
          pg8::gemm_phase<pg8::EpiBf16Perm, pg8::StaticOrder>(c.lds, g, S, E, nullptr); }
        { Epi e{0, PROJ, c.ws<float>(W_EXTRA), nmain, 0}; gemm_ksplit<4>(c, H, D, T, Wt + (size_t)nmain * D, D, nall - nmain, D, e); }
        { Epi e{0, PROJ + (size_t)T * nmain, c.ws<float>(W_EXTRA) + (size_t)T * 32, nmain, nmain}; gemm_ksplit<2>(c, H + (size_t)T * D, D, NS, Wt, D, nall, D, e); }
    } break;
    case 1: {
        if (hyb) {
            if (EN(2)) for (int tok = c.gw; tok < TT; tok += c.ngw) hyb_pre_token(c, li, tok);
            LAS float* pl = (LAS float*)(c.lds + NWAVE * AT_LDS + c.wave * 2048);
            if (EN(3)) { if (c.wave == 0) for (int it = T * AH + blockIdx.x; it < TT * AH; it += gridDim.x) attn_wave(c, li, it / AH, it % AH, pl);
                         for (int it = c.gw; it < NB * AH * 256; it += c.ngw) attn_mfma_item(c, li, it); }
        } else { if (EN(4)) {
            for (int tok = T + c.gw; tok < TT; tok += c.ngw) gdn_pre_token(c, li, tok);
            for (int rg = blockIdx.x; rg < T / 64; rg += gridDim.x) {
                gdn_pre_range(c, li, rg * 8 + c.wave);
                asm volatile("s_waitcnt vmcnt(0)" ::: "memory"); __syncthreads();
                const int bb = rg >> 6, ch = rg & 63;
#pragma unroll 1
                for (int k2 = 0; k2 < 2; ++k2) gdn_a_item(c, li, ((bb * GH + 2 * c.wave + k2) << 6) + ch);
                __syncthreads();
            } } }
    } break;
    case 2: {
        if (hyb) { if (EN(5)) { for (int it = blockIdx.x; it < NB * NCH * 2; it += gridDim.x) ssd_a_item(c, li, it);
                                for (int it = c.gw; it < NS * SH; it += c.ngw) ssd_sample_item(c, li, it); } }
        else { }
    } break;
    case 3: {
        if (hyb) { if (EN(7)) { ssd_scan_phase(c, li); for (int tok = T + c.gw; tok < TT; tok += c.ngw) hyb_post_token(c, li, tok); } }
        else { if (EN(8)) { for (int it = blockIdx.x; it < NB * GH; it += gridDim.x) gdn_scan_wg(c, li, it);
                            if ((int)blockIdx.x >= NB * GH) { gdn_seq_phase(c, li, NB * GH, blockIdx.x - NB * GH, gridDim.x - NB * GH);
                                                              if (l == 1) { cache_copy(c, blockIdx.x - NB * GH, gridDim.x - NB * GH);
                                                                            weights_half(c, 1, (blockIdx.x - NB * GH) * NWAVE + c.wave, (gridDim.x - NB * GH) * NWAVE); } } } }
    } break;
    case 4: {
        if (hyb) { if (EN(14)) for (int it = blockIdx.x; it < NB * NCH * 2; it += gridDim.x) ssd_b_item(c, li, it); }
    } break;
    case 5: {
        if (!EN(9)) break;
        const bf16_t* Wt = hyb ? c.ws<bf16_t>(W_HOUT) + (size_t)li * D * HYB_MIX : c.ws<bf16_t>(W_GOUT) + (size_t)li * D * GVW; const int kk = hyb ? HYB_MIX : GVW;
        { pg8::Gemm g{MIX, Wt, T, D, kk}; pg8::StaticOrder S; S.init(T, D, gridDim.x, blockIdx.x); pg8::EpiBf16Perm E{GO, D};
          pg8::gemm_phase<pg8::EpiBf16Perm, pg8::StaticOrder>(c.lds, g, S, E, nullptr); }
        { Epi e{0, GO + (size_t)T * D, nullptr, D, D}; gemm_ksplit<2>(c, MIX + (size_t)T * kk, kk, NS, Wt, kk, D, kk, e); }
    } break;
    case 6: if (EN(10)) rowpass_phase(c, 1, c.in(I_NMPOST) + (size_t)l * D, c.in(I_NFPRE) + (size_t)l * D, l == 0); break;
    case 7: if (EN(11)) { const bf16_t* Wt = c.ws<bf16_t>(W_GU) + (size_t)l * 2 * FF * D;
        { pg8::Gemm g{H, Wt, T, 2 * FF, D}; pg8::StaticOrder S; S.init(T, 2 * FF, gridDim.x, blockIdx.x); pg8::EpiSwiglu E{HID, FF};
          pg8::gemm_phase<pg8::EpiSwiglu, pg8::StaticOrder>(c.lds, g, S, E, nullptr); }
        { Epi e{2, HID + (size_t)T * FF, nullptr, FF, 0}; gemm_ksplit<2>(c, H + (size_t)T * D, D, NS, Wt, D, 2 * FF, D, e); } } break;
    case 8: if (EN(12)) { const bf16_t* Wt = c.ws<bf16_t>(W_DN) + (size_t)l * D * FF;
        { pg8::Gemm g{HID, Wt, T, D, FF}; pg8::StaticOrder S; S.init(T, D, gridDim.x, blockIdx.x); pg8::EpiBf16Perm E{GO, D};
          pg8::gemm_phase<pg8::EpiBf16Perm, pg8::StaticOrder>(c.lds, g, S, E, nullptr); }
        { Epi e{0, GO + (size_t)T * D, nullptr, D, D}; gemm_ksplit<2>(c, HID + (size_t)T * FF, FF, NS, Wt, FF, D, FF, e); } } break;
    case 9: if (EN(13)) rowpass_phase(c, l == DEPTH - 1 ? 2 : 1, c.in(I_NFPOST) + (size_t)l * D, l == DEPTH - 1 ? nullptr : c.in(I_NMPRE) + (size_t)(l + 1) * D, false); break;
    default: break;
    }
}

extern __shared__ __attribute__((aligned(16))) unsigned char g_shm[];
__global__ void __launch_bounds__(NTHR, 2) mega(Params p) {
    cg::grid_group grid = cg::this_grid();
    volatile LAS unsigned* bst = (volatile LAS unsigned*)((LAS unsigned char*)g_shm + LDS_BYTES - 16);
    if (threadIdx.x == 0) { bst[0] = 0u; bst[1] = 0u; bst[2] = 0u; bst[3] = 0u; }
    __syncthreads();
    const XcdBarrier xb = xcd_barrier_post((unsigned*)p.ws, bst);
    for (int ph = p.ph_lo; ph < p.ph_hi; ++ph) {
        int tid_ = threadIdx.x; asm volatile("" : "+v"(tid_));
        Ctx c; c.p.kp = (KParams)__builtin_amdgcn_kernarg_segment_ptr(); c.p.out = c.p.kp->out; c.tid = tid_; c.lane = tid_ & 63; c.wave = __builtin_amdgcn_readfirstlane(tid_ >> 6);
        c.gw = blockIdx.x * NWAVE + c.wave; c.ngw = gridDim.x * NWAVE; c.lds = (LAS unsigned char*)g_shm;
        run_phase(c, ph);
#ifdef PROBE_MASK
        { int l_ = 0, sp_ = 0; if (ph > 0) phase_decode(ph, l_, sp_); const int bit = ph == 0 ? 20 : sp_ + 10 * (l_ & 1);
          if ((PROBE_MASK >> bit) & 1) { xcd_barrier(xb); run_phase(c, ph); } }
#endif
        if (ph + 1 < p.ph_hi) { if (ph == p.ph_lo) grid.sync(); else xcd_barrier(xb); }
    }
}

extern "C" void kernel_launch(void* const* d_in, const int* in_sizes, int n_in, void* d_out, int out_size, void* d_ws, size_t ws_size, hipStream_t stream) {
    static int grid = 0;
    if (!grid) {
        int dev = 0, cus = 0, per = 0; hipGetDevice(&dev); hipDeviceGetAttribute(&cus, hipDeviceAttributeMultiprocessorCount, dev);
        hipFuncSetAttribute((const void*)mega, hipFuncAttributeMaxDynamicSharedMemorySize, LDS_BYTES);
        hipOccupancyMaxActiveBlocksPerMultiprocessor(&per, (const void*)mega, NTHR, LDS_BYTES);
        if (n_in != 30 || (size_t)out_size != O_END || ws_size < W_END) fprintf(stderr, "kernel_launch: unexpected shapes n_in %d out %d (want %zu) ws %zu (want %zu)\n", n_in, out_size, (size_t)O_END, ws_size, (size_t)W_END);
        if (per < 1) fprintf(stderr, "kernel_launch: occupancy query says %d blocks per CU\n", per);
        grid = cus;
    }
    hipMemsetAsync(d_ws, 0, 16384, stream);
    Params p{}; for (int i = 0; i < 30; ++i) p.in[i] = (const float*)d_in[i];
    p.out = (float*)d_out; p.ws = (unsigned char*)d_ws; p.ph_lo = 0; p.ph_hi = N_PHASES;
    void* args[] = {&p};
    hipError_t e = hipLaunchCooperativeKernel((const void*)mega, dim3(grid), dim3(NTHR), args, LDS_BYTES, stream);
    if (e != hipSuccess) fprintf(stderr, "kernel_launch: cooperative launch failed: %s\n", hipGetErrorString(e));
}
```

```cpp
#include <hip/hip_runtime.h>
#include <hip/hip_cooperative_groups.h>
#include <cstdio>
#include <cstdint>
namespace cg = cooperative_groups;

#define DI __device__ __forceinline__
#define LAS __attribute__((address_space(3)))
typedef unsigned short bf16_t;
typedef short bf16x8 __attribute__((ext_vector_type(8)));
typedef float f32x4 __attribute__((ext_vector_type(4)));
typedef unsigned u32x2 __attribute__((ext_vector_type(2)));
typedef unsigned u32x4 __attribute__((ext_vector_type(4)));

constexpr int D = 1024, NB = 4, SEQ = 4096, T = NB * SEQ, NS = 32, TT = T + NS, DEPTH = 4;
constexpr int AH = 8, AHD = 64, AW = 512, WIN = 2048;
constexpr int SH = 16, SP = 64, SN = 128, SG = 2, SDI = 1024, SXBC = 1536;
constexpr int HYB_IN = 4112, HYB_MAIN = 4096, HYB_MIX = 1536;
constexpr int GH = 16, GQH = 8, GDK = 128, GDV = 128, GQKV = 4096, GVW = 2048, GDN_IN = 6176, GDN_MAIN = 6144;
constexpr int FF = 2816;
constexpr float EPS = 1e-6f;
constexpr int NTHR = 512, NWAVE = 8, LDS_BYTES = 163840;

enum { I_XP = 0, I_XS, I_CK, I_CV, I_SCONV, I_SSM, I_GCONV, I_GST, I_RELB, I_NMPRE, I_NMPOST, I_NFPRE, I_NFPOST, I_WHIN, I_SCW, I_SCB, I_SDTB, I_SALOG, I_SD, I_SNW,
       I_WHOUT, I_WGIN, I_GCW, I_GDTB, I_GALOG, I_GNW, I_WGOUT, I_WFG, I_WFU, I_WFD };

constexpr size_t O_YP = 0;
constexpr size_t O_YS = O_YP + (size_t)T * D;
constexpr size_t O_PK = O_YS + (size_t)NS * D;
constexpr size_t O_PV = O_PK + (size_t)2 * NB * WIN * AW;
constexpr size_t O_PSC = O_PV + (size_t)2 * NB * WIN * AW;
constexpr size_t O_PSS = O_PSC + (size_t)2 * NB * 3 * SXBC;
constexpr size_t O_PGC = O_PSS + (size_t)2 * NB * SH * SP * SN;
constexpr size_t O_PGS = O_PGC + (size_t)2 * NB * 3 * GQKV;
constexpr size_t O_SK = O_PGS + (size_t)2 * NB * GH * GDK * GDV;
constexpr size_t O_SV = O_SK + (size_t)2 * NS * WIN * AW;
constexpr size_t O_SSC = O_SV + (size_t)2 * NS * WIN * AW;
constexpr size_t O_SSS = O_SSC + (size_t)2 * NS * 3 * SXBC;
constexpr size_t O_SGC = O_SSS + (size_t)2 * NS * SH * SP * SN;
constexpr size_t O_SGS = O_SGC + (size_t)2 * NS * 3 * GQKV;
constexpr size_t O_END = O_SGS + (size_t)2 * NS * GH * GDK * GDV;

constexpr size_t al256(size_t x) { return (x + 255) & ~(size_t)255; }
constexpr size_t W_CTL = 0;
constexpr size_t W_HIN = 65536;
constexpr size_t W_HOUT = al256(W_HIN + (size_t)2 * HYB_IN * D * 2);
constexpr size_t W_GIN = al256(W_HOUT + (size_t)2 * D * HYB_MIX * 2);
constexpr size_t W_GOUT = al256(W_GIN + (size_t)2 * GDN_IN * D * 2);
constexpr size_t W_GU = al256(W_GOUT + (size_t)2 * D * GVW * 2);
constexpr size_t W_DN = al256(W_GU + (size_t)4 * 2 * FF * D * 2);
constexpr size_t W_X = al256(W_DN + (size_t)4 * D * FF * 2);
constexpr size_t W_H = al256(W_X + (size_t)TT * D * 4);
constexpr size_t W_PROJ = al256(W_H + (size_t)TT * D * 2);
constexpr size_t W_EXTRA = al256(W_PROJ + (size_t)TT * GDN_MAIN * 2);
constexpr size_t W_MIXED = al256(W_EXTRA + (size_t)TT * 32 * 4);
constexpr size_t W_GO = al256(W_MIXED + (size_t)TT * GVW * 2);
constexpr size_t W_HID = al256(W_GO + (size_t)TT * D * 4);
constexpr size_t W_ACT = al256(W_HID + (size_t)TT * FF * 2);
constexpr size_t W_AUX = al256(W_ACT + (size_t)TT * 4096 * 4);
constexpr size_t W_Y = al256(W_AUX + (size_t)TT * 32 * 4);
constexpr size_t W_END = al256(W_Y + (size_t)TT * 2048 * 4);

struct Params { const float* in[30]; float* out; unsigned char* ws; int ph_lo, ph_hi; };

DI float bf2f(bf16_t b) { return __uint_as_float(((unsigned)b) << 16); }
DI bf16_t f2bf(float x) { unsigned u = __float_as_uint(x); u += 0x7fffu + ((u >> 16) & 1u); return (bf16_t)(u >> 16); }
typedef float f32x2_ __attribute__((ext_vector_type(2))); typedef __bf16 bf16x2_ __attribute__((ext_vector_type(2)));
DI unsigned pk2(float lo, float hi) { const f32x2_ v = {lo, hi}; return __builtin_bit_cast(unsigned, __builtin_convertvector(v, bf16x2_)); }
DI float wave_sum(float v) {
#pragma unroll
    for (int o = 32; o >= 1; o >>= 1) v += __shfl_xor(v, o);
    return v;
}
DI float wave_max(float v) {
#pragma unroll
    for (int o = 32; o >= 1; o >>= 1) v = fmaxf(v, __shfl_xor(v, o));
    return v;
}
DI float siluf(float x) { return x / (1.f + __expf(-x)); }
DI float sigmoidf_(float x) { return 1.f / (1.f + __expf(-x)); }
DI float softplusf_(float x) { return fmaxf(x, 0.f) + log1pf(__expf(-fabsf(x))); }
#define LDS_WAIT() asm volatile("s_waitcnt lgkmcnt(0)" ::: "memory")
DI bf16x8 lds_frag(const LAS bf16_t* p) { return *(const LAS bf16x8*)p; }
DI bf16x8 lds_frag2(const LAS bf16_t* p0, const LAS bf16_t* p1) {
    const u32x2 a = *(const LAS u32x2*)p0, b = *(const LAS u32x2*)p1; u32x4 r; r.x = a.x; r.y = a.y; r.z = b.x; r.w = b.y; return __builtin_bit_cast(bf16x8, r);
}
DI bf16x8 pack8(const f32x4 a, const f32x4 b) { u32x4 r; r.x = pk2(a.x, a.y); r.y = pk2(a.z, a.w); r.z = pk2(b.x, b.y); r.w = pk2(b.z, b.w); return __builtin_bit_cast(bf16x8, r); }

__device__ const unsigned char c_bucket[3][129] = {
 {0,1,2,3,4,5,6,7,8,9,10,11,12,13,14,15,16,16,16,16,16,16,17,17,17,17,17,17,17,17,18,18,18,18,18,18,18,18,18,18,19,19,19,19,19,19,19,19,19,19,19,19,19,19,20,20,20,20,20,20,20,20,20,20,20,20,20,20,20,20,20,20,20,21,21,21,21,21,21,21,21,21,21,21,21,21,21,21,21,21,21,21,21,21,21,21,21,21,21,22,22,22,22,22,22,22,22,22,22,22,22,22,22,22,22,22,22,22,22,22,22,22,22,22,22,22,22,22,22},
 {0,4,8,12,16,16,17,17,18,18,19,19,19,19,20,20,20,20,20,21,21,21,21,21,21,22,22,22,22,22,22,22,22,22,23,23,23,23,23,23,23,23,23,23,23,23,24,24,24,24,24,24,24,24,24,24,24,24,24,24,24,24,25,25,25,25,25,25,25,25,25,25,25,25,25,25,25,25,25,25,25,25,25,26,26,26,26,26,26,26,26,26,26,26,26,26,26,26,26,26,26,26,26,26,26,26,26,26,26,26,26,26,26,27,27,27,27,27,27,27,27,27,27,27,27,27,27,27,27},
 {0,16,18,19,20,21,21,22,22,23,23,23,24,24,24,24,25,25,25,25,25,26,26,26,26,26,26,26,26,27,27,27,27,27,27,27,27,27,27,28,28,28,28,28,28,28,28,28,28,28,28,28,29,29,29,29,29,29,29,29,29,29,29,29,29,29,29,29,29,29,30,30,30,30,30,30,30,30,30,30,30,30,30,30,30,30,30,30,30,30,30,30,30,30,30,31,31,31,31,31,31,31,31,31,31,31,31,31,31,31,31,31,31,31,31,31,31,31,31,31,31,31,31,31,31,31,31,31,31}};

typedef const Params __attribute__((address_space(4)))* KParams;
struct OutRef { float* out; DI float* operator+(size_t o) const { return out + o; } };
struct PRef { KParams kp; float* out; };
#define XB_TMO      128
#define XB_XCNT(j)  (256  + 64 * (j))
#define XB_XSUB(j)  (1280 + 64 * (j))
#define XB_XGEN(j)  (2304 + 64 * (j))
#define XB_TOP      3328
#define XB_TOPGEN   3392
#define XCD_BAR_WORDS 3456
#define XB_SPIN_CAP (1u << 22)

__device__ __forceinline__ unsigned xb_ld(unsigned* p)              { return __hip_atomic_load(p, __ATOMIC_RELAXED, __HIP_MEMORY_SCOPE_AGENT); }
__device__ __forceinline__ unsigned xb_add(unsigned* p, unsigned v) { return __hip_atomic_fetch_add(p, v, __ATOMIC_RELAXED, __HIP_MEMORY_SCOPE_AGENT); }
__device__ __forceinline__ unsigned xb_xcc_id() { return (unsigned)__builtin_amdgcn_s_getreg((3 << 11) | 20) & 0xFu; }
#define XB_SPIN(cond, bar) do { unsigned _sp = 0; while (cond) { __builtin_amdgcn_s_sleep(1); \
    if ((++_sp & 255u) == 0u) { if (xb_ld(&(bar)[XB_TMO])) break; if (_sp > XB_SPIN_CAP) { atomicAdd(&(bar)[XB_TMO], 1u); break; } } } } while (0)

struct XcdBarrier {
    unsigned* bar; unsigned x;
    volatile LAS unsigned* st;
};

__device__ __forceinline__ XcdBarrier xcd_barrier_post(unsigned* bar, volatile LAS unsigned* st) {
    XcdBarrier b; b.bar = bar; b.x = xb_xcc_id(); b.st = st;
    if (threadIdx.x == 0) (void)xb_add(&bar[XB_XCNT(b.x)], 1u);
    return b;
}
__device__ __forceinline__ void xcd_barrier_complete(unsigned* bar, unsigned x, unsigned& nloc, unsigned& nx) {
    const unsigned G = gridDim.x * gridDim.y * gridDim.z;
    unsigned sum, cnt, mine, sp = 0u;
    for (;;) {
        sum = 0u; cnt = 0u; mine = 0u;
#pragma unroll
        for (unsigned j = 0; j < 16; ++j) { const unsigned c = xb_ld(&bar[XB_XCNT(j)]); sum += c; cnt += (c > 0u) ? 1u : 0u; mine = (j == x) ? c : mine; }
        if (sum == G) break;
        __builtin_amdgcn_s_sleep(1);
        if ((++sp & 255u) == 0u) { if (xb_ld(&bar[XB_TMO])) break; if (sp > XB_SPIN_CAP) { atomicAdd(&bar[XB_TMO], 1u); break; } }
    }
    nloc = mine > 0u ? mine : 1u; nx = cnt > 0u ? cnt : 1u;
}

__device__ __forceinline__ void xcd_barrier(const XcdBarrier& b) {
    asm volatile("s_waitcnt vmcnt(0)" ::: "memory");
    __syncthreads();
    if (threadIdx.x == 0) {
        unsigned* bar = b.bar;
        __builtin_amdgcn_s_waitcnt(0);
        unsigned nloc = b.st[0], nx = b.st[1];
        if (nloc == 0u) { xcd_barrier_complete(bar, b.x, nloc, nx); b.st[0] = nloc; b.st[1] = nx; }
        const unsigned old = xb_add(&bar[XB_XSUB(b.x)], 1u);
        const unsigned gen = old / nloc;
        if (old + 1u == (gen + 1u) * nloc) {
            __builtin_amdgcn_fence(__ATOMIC_RELEASE, "agent");
            asm volatile("s_waitcnt vmcnt(0)" ::: "memory");
            const unsigned og = xb_add(&bar[XB_TOP], 1u);
            const unsigned tg = og / nx;
            if (og + 1u == (tg + 1u) * nx) xb_add(&bar[XB_TOPGEN], 1u);
            else XB_SPIN(xb_ld(&bar[XB_TOPGEN]) == tg, bar);
            __builtin_amdgcn_fence(__ATOMIC_ACQUIRE, "agent");
            xb_add(&bar[XB_XGEN(b.x)], 1u);
            asm volatile("s_waitcnt vmcnt(0)" ::: "memory");
        } else {
            XB_SPIN(xb_ld(&bar[XB_XGEN(b.x)]) == gen, bar);
            __builtin_amdgcn_fence(__ATOMIC_ACQUIRE, "agent");
            asm volatile("s_waitcnt vmcnt(0)" ::: "memory");
        }
    }
    __syncthreads();
}

struct Ctx {
    PRef p; int tid, lane, wave, gw, ngw; LAS unsigned char* lds;
    DI const float* in(int i) const { return p.kp->in[i]; }
    template <class Tp> DI Tp* ws(size_t off) const { return (Tp*)(p.kp->ws + off); }
};

DI int rowmap(int n, int map) { return map == 0 ? n : (32 * (n >> 4) + (n & 15) + (map == 2 ? 16 : 0)); }
DI void transpose_item(const float* W, int K, int N, bf16_t* WT, int map, LAS float* scr, int item, int lane) {
    const int nblk = (N + 31) / 32, kb = item / nblk, nb = item % nblk, k0 = 64 * kb, n0 = 32 * nb;
    float wv[32];
#pragma unroll
    for (int i = 0; i < 32; ++i) { const int kk = 2 * i + (lane >> 5), n = n0 + (lane & 31); wv[i] = n < N ? W[(size_t)(k0 + kk) * N + n] : 0.f; }
#pragma unroll
    for (int i = 0; i < 32; ++i) scr[(2 * i + (lane >> 5)) * 33 + (lane & 31)] = wv[i];
    LDS_WAIT();
    const int c = lane & 7;
#pragma unroll
    for (int j = 0; j < 4; ++j) {
        const int nn = (lane >> 3) + 8 * j, n = n0 + nn; const LAS float* s = scr + (8 * c) * 33 + nn;
        u32x4 o; o.x = pk2(s[0], s[33]); o.y = pk2(s[66], s[99]); o.z = pk2(s[132], s[165]); o.w = pk2(s[198], s[231]);
        if (n < N) *(u32x4*)(WT + (size_t)rowmap(n, map) * K + k0 + 8 * c) = o;
    }
    LDS_WAIT();
}
DI void transpose_mat(const Ctx& c, const float* W, int K, int N, bf16_t* WT, int map, int gw0 = -1, int ngw0 = 0) {
    LAS float* scr = (LAS float*)(c.lds + c.wave * 8704);
    const int nit = (K / 64) * ((N + 31) / 32);
    const int g0 = gw0 < 0 ? c.gw : gw0, n0 = gw0 < 0 ? c.ngw : ngw0;
    for (int it = g0; it < nit; it += n0) transpose_item(W, K, N, WT, map, scr, it, c.lane);
}

DI void rowpass_row(const float* xrow, const bf16_t* gorow, const float* gpost, const float* gnext, float* xdst, bf16_t* hrow, float* yout, int lane) {
    f32x4 x[4]; float ss = 0.f;
    if (gorow) {
        f32x4 g[4];
#pragma unroll
        for (int j = 0; j < 4; ++j) { const u32x2 gv = *(const u32x2*)(gorow + 4 * lane + 256 * j); g[j] = (f32x4){bf2f((bf16_t)(gv.x & 0xffff)), bf2f((bf16_t)(gv.x >> 16)), bf2f((bf16_t)(gv.y & 0xffff)), bf2f((bf16_t)(gv.y >> 16))}; ss += g[j].x * g[j].x + g[j].y * g[j].y + g[j].z * g[j].z + g[j].w * g[j].w; }
        const float r = rsqrtf(wave_sum(ss) * (1.f / D) + EPS);
#pragma unroll
        for (int j = 0; j < 4; ++j) { const f32x4 w = *(const f32x4*)(gpost + 4 * lane + 256 * j); x[j] = *(const f32x4*)(xrow + 4 * lane + 256 * j) + g[j] * r * w; }
    } else {
#pragma unroll
        for (int j = 0; j < 4; ++j) x[j] = *(const f32x4*)(xrow + 4 * lane + 256 * j);
    }
    if (xdst) {
#pragma unroll
        for (int j = 0; j < 4; ++j) *(f32x4*)(xdst + 4 * lane + 256 * j) = x[j];
    }
    if (yout) {
#pragma unroll
        for (int j = 0; j < 4; ++j) *(f32x4*)(yout + 4 * lane + 256 * j) = x[j];
    }
    if (hrow) {
        float s2 = 0.f;
#pragma unroll
        for (int j = 0; j < 4; ++j) s2 += x[j].x * x[j].x + x[j].y * x[j].y + x[j].z * x[j].z + x[j].w * x[j].w;
        const float r2 = rsqrtf(wave_sum(s2) * (1.f / D) + EPS);
#pragma unroll
        for (int j = 0; j < 4; ++j) { const f32x4 w = *(const f32x4*)(gnext + 4 * lane + 256 * j); const f32x4 h = x[j] * r2 * w;
            u32x2 o; o.x = pk2(h.x, h.y); o.y = pk2(h.z, h.w); *(u32x2*)(hrow + 4 * lane + 256 * j) = o; }
    }
}
DI void rowpass_rows4(const float* xrow, const bf16_t* gorow, const float* gpost, const float* gnext, float* xdst, bf16_t* hrow, float* yout, int lane) {
    f32x4 x[4][4]; float ss[4] = {0.f, 0.f, 0.f, 0.f};
#pragma unroll
    for (int r = 0; r < 4; ++r)
#pragma unroll
        for (int j = 0; j < 4; ++j) x[r][j] = *(const f32x4*)(xrow + (size_t)r * D + 4 * lane + 256 * j);
    if (gorow) {
        u32x2 gv[4][4];
#pragma unroll
        for (int r = 0; r < 4; ++r)
#pragma unroll
            for (int j = 0; j < 4; ++j) gv[r][j] = *(const u32x2*)(gorow + (size_t)r * D + 4 * lane + 256 * j);
        f32x4 wp[4];
#pragma unroll
        for (int j = 0; j < 4; ++j) wp[j] = *(const f32x4*)(gpost + 4 * lane + 256 * j);
#pragma unroll
        for (int r = 0; r < 4; ++r)
#pragma unroll
            for (int j = 0; j < 4; ++j) { const float a = bf2f((bf16_t)(gv[r][j].x & 0xffff)), b2 = bf2f((bf16_t)(gv[r][j].x >> 16)), c2 = bf2f((bf16_t)(gv[r][j].y & 0xffff)), d2 = bf2f((bf16_t)(gv[r][j].y >> 16)); ss[r] += a * a + b2 * b2 + c2 * c2 + d2 * d2; }
#pragma unroll
        for (int o = 32; o >= 1; o >>= 1) { ss[0] += __shfl_xor(ss[0], o); ss[1] += __shfl_xor(ss[1], o); ss[2] += __shfl_xor(ss[2], o); ss[3] += __shfl_xor(ss[3], o); }
#pragma unroll
        for (int r = 0; r < 4; ++r) { const float rn = rsqrtf(ss[r] * (1.f / D) + EPS);
#pragma unroll
            for (int j = 0; j < 4; ++j) { const f32x4 g = (f32x4){bf2f((bf16_t)(gv[r][j].x & 0xffff)), bf2f((bf16_t)(gv[r][j].x >> 16)), bf2f((bf16_t)(gv[r][j].y & 0xffff)), bf2f((bf16_t)(gv[r][j].y >> 16))}; x[r][j] += g * rn * wp[j]; } }
    }
    if (xdst) {
#pragma unroll
        for (int r = 0; r < 4; ++r)
#pragma unroll
            for (int j = 0; j < 4; ++j) *(f32x4*)(xdst + (size_t)r * D + 4 * lane + 256 * j) = x[r][j];
    }
    if (yout) {
#pragma unroll
        for (int r = 0; r < 4; ++r)
#pragma unroll
            for (int j = 0; j < 4; ++j) *(f32x4*)(yout + (size_t)r * D + 4 * lane + 256 * j) = x[r][j];
    }
    if (hrow) {
        float s2[4];
#pragma unroll
        for (int r = 0; r < 4; ++r) { s2[r] = 0.f;
#pragma unroll
            for (int j = 0; j < 4; ++j) s2[r] += x[r][j].x * x[r][j].x + x[r][j].y * x[r][j].y + x[r][j].z * x[r][j].z + x[r][j].w * x[r][j].w; }
#pragma unroll
        for (int o = 32; o >= 1; o >>= 1) { s2[0] += __shfl_xor(s2[0], o); s2[1] += __shfl_xor(s2[1], o); s2[2] += __shfl_xor(s2[2], o); s2[3] += __shfl_xor(s2[3], o); }
        f32x4 wn[4];
#pragma unroll
        for (int j = 0; j < 4; ++j) wn[j] = *(const f32x4*)(gnext + 4 * lane + 256 * j);
#pragma unroll
        for (int r = 0; r < 4; ++r) { const float r2 = rsqrtf(s2[r] * (1.f / D) + EPS);
#pragma unroll
            for (int j = 0; j < 4; ++j) { const f32x4 h = x[r][j] * r2 * wn[j]; u32x2 o; o.x = pk2(h.x, h.y); o.y = pk2(h.z, h.w); *(u32x2*)(hrow + (size_t)r * D + 4 * lane + 256 * j) = o; } }
    }
}
DI void rowpass_phase(const Ctx& c, int mode, const float* gpost, const float* gnext, bool x_from_input) {
    float* X = c.ws<float>(W_X); const bf16_t* GO = c.ws<bf16_t>(W_GO); bf16_t* H = c.ws<bf16_t>(W_H);
    int lane_ = c.lane; asm volatile("" : "+v"(lane_));
    for (int row = T + c.gw; row < TT; row += c.ngw) {
        const float* xrow = x_from_input ? c.in(I_XS) + (size_t)(row - T) * D : X + (size_t)row * D;
        if (mode == 0) rowpass_row(xrow, nullptr, nullptr, gnext, nullptr, H + (size_t)row * D, nullptr, lane_);
        else if (mode == 1) rowpass_row(xrow, GO + (size_t)row * D, gpost, gnext, X + (size_t)row * D, H + (size_t)row * D, nullptr, lane_);
        else rowpass_row(xrow, GO + (size_t)row * D, gpost, nullptr, nullptr, nullptr, c.p.out + O_YS + (size_t)(row - T) * D, lane_);
    }
    for (int g4 = c.gw; g4 < T / 4; g4 += c.ngw) {
        const int row = 4 * g4;
        const float* xrow = x_from_input ? c.in(I_XP) + (size_t)row * D : X + (size_t)row * D;
        if (mode == 0) rowpass_rows4(xrow, nullptr, nullptr, gnext, nullptr, H + (size_t)row * D, nullptr, lane_);
        else if (mode == 1) rowpass_rows4(xrow, GO + (size_t)row * D, gpost, gnext, X + (size_t)row * D, H + (size_t)row * D, nullptr, lane_);
        else rowpass_rows4(xrow, GO + (size_t)row * D, gpost, nullptr, nullptr, nullptr, c.p.out + O_YP + (size_t)row * D, lane_);
    }
}

namespace pg8 {
#define PG8_LAS __attribute__((address_space(3)))
typedef unsigned short bf16_t;
typedef short bf16x8 __attribute__((ext_vector_type(8)));
typedef float f32x4 __attribute__((ext_vector_type(4)));
typedef unsigned u32x4 __attribute__((ext_vector_type(4)));
constexpr int BM = 256, BK = 64, HALF = 128, HTB = HALF * BK * 2  , STAGE_BYTES = 8 * HTB, NXCD = 8, WGM = 8;

__host__ __device__ __forceinline__ int lds_byte(int r, int c) { const int st = (r >> 4) * 2 + (c >> 5), rr = r & 15, cc = c & 31, ob = rr * 64 + cc * 2; return st * 1024 + (ob ^ (((ob >> 9) & 1) << 5)); }
__host__ __device__ __forceinline__ void stage_rc(int b, int& R, int& C) { const int st = b / 1024, sb = b % 1024, swz = sb ^ (((sb >> 9) & 1) << 5); R = (st >> 1) * 16 + swz / 64; C = (st & 1) * 32 + (swz % 64) / 2; }
__host__ __device__ __forceinline__ int perm32(int rho) { const int n = rho >> 4, i = rho & 15; return 8 * (i >> 2) + 4 * n + (i & 3); }

struct Unit { int pm, pn; };
struct Gemm { const bf16_t* A; const bf16_t* Bt; int M, N, K; };

struct StaticOrder {
    int nM, nN, nwg, G, c;
    __host__ __device__ void init(int M, int N, int G_, int c_) { nM = M / BM; nN = N / BM; nwg = nM * nN; G = G_; c = c_; }
    __host__ __device__ bool next(int i, Unit& u) const {
        const long L = (long)i * G + c; if (L >= nwg) return false;
        int wgid = (int)L; { const int q = nwg / NXCD, r = nwg % NXCD, xcd = wgid % NXCD, off = wgid / NXCD; wgid = (xcd < r ? xcd * (q + 1) : r * (q + 1) + (xcd - r) * q) + off; }
        const int nig = WGM * nN, gid = wgid / nig, fm = gid * WGM, gsz = (nM - fm) < WGM ? (nM - fm) : WGM;
        u.pm = fm + ((wgid % nig) % gsz); u.pn = (wgid % nig) / gsz; return true;
    }
    __device__ __forceinline__ void a_ready(const Unit&) const {}
    __device__ __forceinline__ void done(const Unit&) const {}
};
__device__ __forceinline__ unsigned cvt_pk_bf16(float lo, float hi) { unsigned r; asm volatile("v_cvt_pk_bf16_f32 %0, %1, %2" : "=v"(r) : "v"(lo), "v"(hi)); return r; }
typedef float f32x2 __attribute__((ext_vector_type(2)));
struct EpiF32 {
    static constexpr bool PERM = false, AFTER_DRAIN = false;
    float* C; int ldc; const float* bias;
    __device__ __forceinline__ void operator()(const f32x4 (&acc)[2][2][4][2], const Unit& u, int wr, int wc, int fr, int fq) const {
        const int row0 = u.pm * BM + wr * 64 + fr, col0 = u.pn * BM + wc * 32 + 4 * fq;
        f32x4 bv[2][2];
#pragma unroll
        for (int bj = 0; bj < 2; ++bj)
#pragma unroll
            for (int n = 0; n < 2; ++n) bv[bj][n] = bias ? *(const f32x4*)(bias + col0 + bj * HALF + n * 16) : (f32x4){0.f, 0.f, 0.f, 0.f};
#pragma unroll
        for (int ai = 0; ai < 2; ++ai)
#pragma unroll
            for (int m = 0; m < 4; ++m) { float* rowp = C + (size_t)(row0 + ai * HALF + m * 16) * ldc + col0;
#pragma unroll
                for (int bj = 0; bj < 2; ++bj)
#pragma unroll
                    for (int n = 0; n < 2; ++n) *(f32x4*)(rowp + bj * HALF + n * 16) = acc[ai][bj][m][n] + bv[bj][n]; }
    }
};
template <class Epi, class Sched, bool STAMP = false>
__device__ __forceinline__ void gemm_phase(PG8_LAS unsigned char* lds, const Gemm g, const Sched& S, const Epi& E, unsigned long long* stamps) {
    int tid_ = threadIdx.x; asm volatile("" : "+v"(tid_));
    const int tid = tid_, wid = __builtin_amdgcn_readfirstlane(tid >> 6), lane = tid & 63, wr = wid >> 2, wc = wid & 3, fr = lane & 15, fq = lane >> 4;
    const int K = g.K, nt = K / BK;
    int ts_lo = 0, ts_hi = 0, nts = 0; const unsigned long long rt_entry = STAMP ? (unsigned long long)wall_clock64() : 0ull;
#define PG8_STAMP() do { if (STAMP && wid == 0 && nts < 64) { const unsigned long long _c = (unsigned long long)clock64(); \
        ts_lo = (lane == nts) ? (int)(unsigned)_c : ts_lo; ts_hi = (lane == nts) ? (int)(unsigned)(_c >> 32) : ts_hi; ++nts; } } while (0)
    PG8_STAMP();
    unsigned voffA[2], voffB[2];
#pragma unroll
    for (int i = 0; i < 2; ++i) { int R, C; stage_rc(tid * 16 + i * 8192, R, C); const int Rb = Epi::PERM ? ((R & ~31) + perm32(R & 31)) : R;
        voffA[i] = (unsigned)(R * K + C) * 2u; voffB[i] = (unsigned)(Rb * K + C) * 2u; }
    const size_t kstep = (size_t)(BK * 2);
    const size_t hstep = (size_t)HALF * K * 2;
    const size_t tstep = 2 * hstep;
    const unsigned ldsw = (unsigned)wid * 1024u;
    const int aoff = lds_byte(wr * 64 + fr, fq * 8), boff = lds_byte(wc * 32 + fr, fq * 8);
#define PG8_SA(b, h) (((b) * 2 + (h)) * HTB)
#define PG8_SB(b, h) ((4 + (b) * 2 + (h)) * HTB)
#define PG8_STAGE(bufoff, gbase, voff) do { _Pragma("unroll") for (int _i = 0; _i < 2; ++_i) \
        __builtin_amdgcn_global_load_lds((const unsigned*)((const char*)(gbase) + (voff)[_i]), (PG8_LAS unsigned*)(lds + (bufoff) + ldsw + _i * 8192), 16, 0, 0); } while (0)
#define PG8_LDA(dst, b, h) do { _Pragma("unroll") for (int m = 0; m < 4; ++m) _Pragma("unroll") for (int k = 0; k < 2; ++k) dst[m][k] = *(const PG8_LAS bf16x8*)(lds + PG8_SA(b, h) + aoff + m * 2048 + k * 1024); } while (0)
#define PG8_LDB(dst, b, h) do { _Pragma("unroll") for (int n = 0; n < 2; ++n) _Pragma("unroll") for (int k = 0; k < 2; ++k) dst[n][k] = *(const PG8_LAS bf16x8*)(lds + PG8_SB(b, h) + boff + n * 2048 + k * 1024); } while (0)
#define PG8_MMA(ai, bj, At, Bt) do { __builtin_amdgcn_s_setprio(1); _Pragma("unroll") for (int m = 0; m < 4; ++m) _Pragma("unroll") for (int n = 0; n < 2; ++n) _Pragma("unroll") for (int k = 0; k < 2; ++k) \
        acc[ai][bj][m][n] = __builtin_amdgcn_mfma_f32_16x16x32_bf16(Bt[n][k], At[m][k], acc[ai][bj][m][n], 0, 0, 0); __builtin_amdgcn_s_setprio(0); } while (0)
#define PG8_WAIT_V(n) asm volatile("s_waitcnt vmcnt(" #n ")" ::: "memory")
#define PG8_WAIT_L(n) asm volatile("s_waitcnt lgkmcnt(" #n ")" ::: "memory")
#define PG8_BAR __builtin_amdgcn_s_barrier()
#define PG8_SCHED __builtin_amdgcn_sched_barrier(0)
    Unit cur, nxt; int ui = 0;
    if (!S.next(0, cur)) return;
    f32x4 acc[2][2][4][2];
#pragma unroll
    for (int a = 0; a < 2; ++a)
#pragma unroll
        for (int b = 0; b < 2; ++b)
#pragma unroll
            for (int m = 0; m < 4; ++m)
#pragma unroll
                for (int n = 0; n < 2; ++n) acc[a][b][m][n] = (f32x4){0.f, 0.f, 0.f, 0.f};
    bf16x8 At[4][2], B0[2][2], B1[2][2];
    const char* cA = (const char*)g.A + (size_t)cur.pm * tstep; const char* cB = (const char*)g.Bt + (size_t)cur.pn * tstep;
    S.a_ready(cur);
    PG8_STAGE(PG8_SB(0, 0), cB, voffB); PG8_STAGE(PG8_SA(0, 0), cA, voffA); PG8_STAGE(PG8_SB(0, 1), cB + hstep, voffB); PG8_STAGE(PG8_SA(0, 1), cA + hstep, voffA);
    if (wr == 1) PG8_BAR;
    PG8_WAIT_V(4); PG8_BAR;
    PG8_STAGE(PG8_SB(1, 0), cB + kstep, voffB); PG8_STAGE(PG8_SA(1, 0), cA + kstep, voffA); PG8_STAGE(PG8_SB(1, 1), cB + hstep + kstep, voffB);
    PG8_WAIT_V(6); PG8_BAR;
    PG8_STAMP();
    for (;;) {
        const bool has_next = S.next(ui + 1, nxt);
        const char* nA = has_next ? (const char*)g.A + (size_t)nxt.pm * tstep : cA; const char* nB = has_next ? (const char*)g.Bt + (size_t)nxt.pn * tstep : cB;
        for (int t = 0; t < nt; t += 2) {
            const bool last = (t == nt - 2);
            const char* a1 = cA + (size_t)(t + 1) * kstep;
            const char* a2 = last ? nA : cA + (size_t)(t + 2) * kstep; const char* b2 = last ? nB : cB + (size_t)(t + 2) * kstep;
            const char* a3 = a2 + kstep; const char* b3 = b2 + kstep;
            if (last && has_next) S.a_ready(nxt);
            PG8_LDB(B0, 0, 0); PG8_SCHED; PG8_LDA(At, 0, 0); PG8_STAGE(PG8_SA(1, 1), a1 + hstep, voffA);
            PG8_WAIT_L(8); PG8_BAR; PG8_WAIT_L(0); PG8_MMA(0, 0, At, B0); PG8_BAR; PG8_SCHED;
            PG8_LDB(B1, 0, 1); PG8_STAGE(PG8_SB(0, 0), b2, voffB);
            PG8_BAR; PG8_WAIT_L(0); PG8_MMA(0, 1, At, B1); PG8_BAR;
            PG8_LDA(At, 0, 1); PG8_STAGE(PG8_SA(0, 0), a2, voffA);
            PG8_BAR; PG8_WAIT_L(0); PG8_MMA(1, 0, At, B0); PG8_BAR; PG8_SCHED;
            PG8_STAGE(PG8_SB(0, 1), b2 + hstep, voffB);
            PG8_WAIT_V(6); PG8_BAR; PG8_MMA(1, 1, At, B1); PG8_BAR;
            PG8_LDB(B0, 1, 0); PG8_SCHED; PG8_LDA(At, 1, 0); PG8_STAGE(PG8_SA(0, 1), a2 + hstep, voffA);
            PG8_WAIT_L(8); PG8_BAR; PG8_WAIT_L(0); PG8_MMA(0, 0, At, B0); PG8_BAR; PG8_SCHED;
            PG8_LDB(B1, 1, 1); PG8_STAGE(PG8_SB(1, 0), b3, voffB);
            PG8_BAR; PG8_WAIT_L(0); PG8_MMA(0, 1, At, B1); PG8_BAR;
            PG8_LDA(At, 1, 1); PG8_STAGE(PG8_SA(1, 0), a3, voffA);
            PG8_BAR; PG8_WAIT_L(0); PG8_MMA(1, 0, At, B0); PG8_BAR; PG8_SCHED;
            PG8_STAGE(PG8_SB(1, 1), b3 + hstep, voffB);
            PG8_WAIT_V(6); PG8_BAR; PG8_MMA(1, 1, At, B1); PG8_BAR;
        }
        PG8_STAMP();
        if constexpr (!Epi::AFTER_DRAIN) { E(acc, cur, wr, wc, fr, fq); S.done(cur); }
        PG8_STAMP();
        if (!has_next) break;
#pragma unroll
        for (int a = 0; a < 2; ++a)
#pragma unroll
            for (int b = 0; b < 2; ++b)
#pragma unroll
                for (int m = 0; m < 4; ++m)
#pragma unroll
                    for (int n = 0; n < 2; ++n) acc[a][b][m][n] = (f32x4){0.f, 0.f, 0.f, 0.f};
        cur = nxt; cA = nA; cB = nB; ++ui;
    }
    PG8_WAIT_V(0);
    if (wr == 0) PG8_BAR;
    PG8_BAR;
    if constexpr (Epi::AFTER_DRAIN) { E.fused(acc, cur, wr, wc, fr, fq, lds, wid, lane); S.done(cur); }
    PG8_STAMP();
    if (STAMP && wid == 0) { stamps[lane] = lane < nts ? (((unsigned long long)(unsigned)ts_hi << 32) | (unsigned)ts_lo) : 0ull;
        if (lane == 62) stamps[62] = rt_entry; if (lane == 63) stamps[63] = (unsigned long long)wall_clock64(); }
#undef PG8_STAMP
#undef PG8_SA
#undef PG8_SB
#undef PG8_STAGE
#undef PG8_LDA
#undef PG8_LDB
#undef PG8_MMA
#undef PG8_WAIT_V
#undef PG8_WAIT_L
#undef PG8_BAR
#undef PG8_SCHED
}
}

namespace pg8 {
struct EpiBf16Plain {
    static constexpr bool PERM = false, AFTER_DRAIN = false;
    bf16_t* O; int ldc;
    __device__ __forceinline__ void operator()(const f32x4 (&acc)[2][2][4][2], const Unit& u, int wr, int wc, int fr, int fq) const {
        const int row0 = u.pm * BM + wr * 64 + fr, col0 = u.pn * BM + wc * 32 + 4 * fq;
#pragma unroll
        for (int ai = 0; ai < 2; ++ai)
#pragma unroll
            for (int m = 0; m < 4; ++m) { bf16_t* rowp = O + (size_t)(row0 + ai * HALF + m * 16) * ldc + col0;
#pragma unroll
                for (int bj = 0; bj < 2; ++bj)
#pragma unroll
                    for (int n = 0; n < 2; ++n) { const f32x4 v = acc[ai][bj][m][n]; unsigned long long w = (unsigned long long)cvt_pk_bf16(v[0], v[1]) | ((unsigned long long)cvt_pk_bf16(v[2], v[3]) << 32);
                        *(unsigned long long*)(rowp + bj * HALF + n * 16) = w; } }
    }
};
struct EpiBf16Perm {
    static constexpr bool PERM = true, AFTER_DRAIN = false;
    bf16_t* O; int ldc;
    __device__ __forceinline__ void operator()(const f32x4 (&acc)[2][2][4][2], const Unit& u, int wr, int wc, int fr, int fq) const {
        const int row0 = u.pm * BM + wr * 64 + fr, col0 = u.pn * BM + wc * 32 + 8 * fq;
#pragma unroll
        for (int ai = 0; ai < 2; ++ai)
#pragma unroll
            for (int m = 0; m < 4; ++m) { bf16_t* rowp = O + (size_t)(row0 + ai * HALF + m * 16) * ldc + col0;
#pragma unroll
                for (int bj = 0; bj < 2; ++bj) { const f32x4 v0 = acc[ai][bj][m][0], v1 = acc[ai][bj][m][1]; u32x4 w;
                    w.x = cvt_pk_bf16(v0[0], v0[1]); w.y = cvt_pk_bf16(v0[2], v0[3]); w.z = cvt_pk_bf16(v1[0], v1[1]); w.w = cvt_pk_bf16(v1[2], v1[3]);
                    *(u32x4*)(rowp + bj * HALF) = w; } }
    }
};
struct EpiSwiglu {
    static constexpr bool PERM = false, AFTER_DRAIN = false;
    bf16_t* O; int ldc;
    __device__ __forceinline__ void operator()(const f32x4 (&acc)[2][2][4][2], const Unit& u, int wr, int wc, int fr, int fq) const {
        const int row0 = u.pm * BM + wr * 64 + fr, col0 = u.pn * (BM / 2) + wc * 16 + 4 * fq;
#pragma unroll
        for (int ai = 0; ai < 2; ++ai)
#pragma unroll
            for (int m = 0; m < 4; ++m) { bf16_t* rowp = O + (size_t)(row0 + ai * HALF + m * 16) * ldc + col0;
#pragma unroll
                for (int bj = 0; bj < 2; ++bj) { const f32x4 g = acc[ai][bj][m][0], up = acc[ai][bj][m][1]; float h[4];
#pragma unroll
                    for (int e = 0; e < 4; ++e) h[e] = g[e] / (1.f + __expf(-g[e])) * up[e];
                    unsigned long long w = (unsigned long long)cvt_pk_bf16(h[0], h[1]) | ((unsigned long long)cvt_pk_bf16(h[2], h[3]) << 32);
                    *(unsigned long long*)(rowp + bj * (HALF / 2)) = w; } }
    }
};
}

struct Epi { int mode; bf16_t* ob; float* of; int ldo; int main_cols; };
DI void gemm_simple(const Ctx& c, const bf16_t* A, int lda, int M, const bf16_t* Bt, int ldb, int N, int K, const Epi e) {
    const int mblk = (M + 63) / 64, nblk = (N + 31) / 32, nit = mblk * nblk;
    const int fr = c.lane & 15, fq = c.lane >> 4;
    for (int it = c.gw; it < nit; it += c.ngw) {
        const int mb = it / nblk, nb = it % nblk, m0 = mb * 64, n0 = nb * 32;
        const bf16_t* ap[4]; const bf16_t* bp[2];
#pragma unroll
        for (int m = 0; m < 4; ++m) { int r = m0 + 16 * m + fr; r = r < M ? r : M - 1; ap[m] = A + (size_t)r * lda + 8 * fq; }
#pragma unroll
        for (int n = 0; n < 2; ++n) { int r = n0 + 16 * n + fr; r = r < N ? r : N - 1; bp[n] = Bt + (size_t)r * ldb + 8 * fq; }
        f32x4 acc[4][2];
#pragma unroll
        for (int m = 0; m < 4; ++m)
#pragma unroll
            for (int n = 0; n < 2; ++n) acc[m][n] = (f32x4){0.f, 0.f, 0.f, 0.f};
#pragma unroll 2
        for (int k0 = 0; k0 < K; k0 += 32) {
            bf16x8 a[4], b[2];
#pragma unroll
            for (int m = 0; m < 4; ++m) a[m] = *(const bf16x8*)(ap[m] + k0);
#pragma unroll
            for (int n = 0; n < 2; ++n) b[n] = *(const bf16x8*)(bp[n] + k0);
#pragma unroll
            for (int m = 0; m < 4; ++m)
#pragma unroll
                for (int n = 0; n < 2; ++n) acc[m][n] = __builtin_amdgcn_mfma_f32_16x16x32_bf16(b[n], a[m], acc[m][n], 0, 0, 0);
        }
#pragma unroll
        for (int m = 0; m < 4; ++m) {
            const int row = m0 + 16 * m + fr; if (row >= M) continue;
            if (e.mode == 2) {
                const f32x4 g = acc[m][0], u = acc[m][1]; u32x2 o;
                o.x = pk2(siluf(g.x) * u.x, siluf(g.y) * u.y); o.y = pk2(siluf(g.z) * u.z, siluf(g.w) * u.w);
                *(u32x2*)(e.ob + (size_t)row * e.ldo + 16 * nb + 4 * fq) = o;
            } else {
#pragma unroll
                for (int n = 0; n < 2; ++n) {
                    const int col = n0 + 16 * n + 4 * fq; if (col >= N) continue;
                    const f32x4 v = acc[m][n];
                    if (e.mode == 1) *(f32x4*)(e.of + (size_t)row * e.ldo + col) = v;
                    else if (col < e.main_cols) { u32x2 o; o.x = pk2(v.x, v.y); o.y = pk2(v.z, v.w); *(u32x2*)(e.ob + (size_t)row * e.ldo + col) = o; }
                    else *(f32x4*)(e.of + (size_t)row * 32 + (col - e.main_cols)) = v;
                }
            }
        }
    }
}

DI void attn_wave(const Ctx& c, int li, int tok, int h, LAS float* pl  ) {
    const bf16_t* PROJ = c.ws<bf16_t>(W_PROJ); bf16_t* MIX = c.ws<bf16_t>(W_MIXED);
    const int lane = c.lane; const bool smp = tok >= T;
    const int b = smp ? tok - T : tok / SEQ, s = smp ? WIN : tok % SEQ;
    const float* ck = c.in(I_CK) + ((size_t)(li * NS + b) * WIN) * AW + h * AHD;
    const float* cv = c.in(I_CV) + ((size_t)(li * NS + b) * WIN) * AW + h * AHD;
    const bf16_t* prow0 = smp ? PROJ + (size_t)tok * HYB_MAIN : PROJ + (size_t)(b * SEQ) * HYB_MAIN;
    float q[64];
    { const bf16_t* qp = PROJ + (size_t)tok * HYB_MAIN + h * AHD;
#pragma unroll
      for (int j = 0; j < 8; ++j) { const u32x4 v = *(const u32x4*)(qp + 8 * j);
          q[8*j+0] = bf2f((bf16_t)(v.x & 0xffff)) * 0.125f; q[8*j+1] = bf2f((bf16_t)(v.x >> 16)) * 0.125f; q[8*j+2] = bf2f((bf16_t)(v.y & 0xffff)) * 0.125f; q[8*j+3] = bf2f((bf16_t)(v.y >> 16)) * 0.125f;
          q[8*j+4] = bf2f((bf16_t)(v.z & 0xffff)) * 0.125f; q[8*j+5] = bf2f((bf16_t)(v.z >> 16)) * 0.125f; q[8*j+6] = bf2f((bf16_t)(v.w & 0xffff)) * 0.125f; q[8*j+7] = bf2f((bf16_t)(v.w >> 16)) * 0.125f; } }
    const float* relb = c.in(I_RELB);
    float mx = -1e30f;
#pragma unroll 1
    for (int pat = 0; pat < 3; ++pat) {
        const int d = pat == 0 ? 1 : (pat == 1 ? 4 : 16);
#pragma unroll
        for (int rnd = 0; rnd < 3; ++rnd) {
            const int j = rnd * 64 + lane; float lg = -1e30f;
            if (j <= 128) {
                const int R = s - j * d;
                if (R >= 0) {
                    float acc = 0.f;
                    if (smp && R < WIN) { const float* kp = ck + (size_t)R * AW;
#pragma unroll
                        for (int e = 0; e < 16; ++e) { const f32x4 v = *(const f32x4*)(kp + 4 * e); acc += q[4*e] * v.x + q[4*e+1] * v.y + q[4*e+2] * v.z + q[4*e+3] * v.w; }
                    } else { const bf16_t* kp = (smp ? prow0 : prow0 + (size_t)R * HYB_MAIN) + AW + h * AHD;
#pragma unroll
                        for (int e = 0; e < 8; ++e) { const u32x4 v = *(const u32x4*)(kp + 8 * e);
                            acc += q[8*e] * bf2f((bf16_t)(v.x & 0xffff)) + q[8*e+1] * bf2f((bf16_t)(v.x >> 16)) + q[8*e+2] * bf2f((bf16_t)(v.y & 0xffff)) + q[8*e+3] * bf2f((bf16_t)(v.y >> 16))
                                 + q[8*e+4] * bf2f((bf16_t)(v.z & 0xffff)) + q[8*e+5] * bf2f((bf16_t)(v.z >> 16)) + q[8*e+6] * bf2f((bf16_t)(v.w & 0xffff)) + q[8*e+7] * bf2f((bf16_t)(v.w >> 16)); }
                    }
                    lg = acc + relb[c_bucket[pat][j] * AH + h];
                }
                pl[pat * 132 + j] = lg;
            }
            mx = fmaxf(mx, lg);
        }
    }
    mx = wave_max(mx);
    LDS_WAIT();
    float ssum = 0.f;
#pragma unroll 1
    for (int i = lane; i < 396; i += 64) { const int pat = i / 132, j = i % 132; if (j <= 128) { const float lg = pl[i]; const float pv = lg > -1e29f ? __expf(lg - mx) : 0.f; pl[i] = pv; ssum += pv; } }
    ssum = wave_sum(ssum);
    LDS_WAIT();
    {
        const int kg = lane >> 4, dc = lane & 15;
        f32x4 o4 = (f32x4){0.f, 0.f, 0.f, 0.f};
        if (smp) {
#pragma unroll 1
            for (int pat = 0; pat < 3; ++pat) {
                const int d = pat == 0 ? 1 : (pat == 1 ? 4 : 16);
                if (kg == 0) { const u32x2 vv = *(const u32x2*)(prow0 + 2 * AW + h * AHD + 4 * dc); const float pv = pl[pat * 132];
                    o4.x += pv * bf2f((bf16_t)(vv.x & 0xffff)); o4.y += pv * bf2f((bf16_t)(vv.x >> 16)); o4.z += pv * bf2f((bf16_t)(vv.y & 0xffff)); o4.w += pv * bf2f((bf16_t)(vv.y >> 16)); }
#pragma unroll 16
                for (int i4 = 0; i4 < 32; ++i4) { const int j = 1 + 4 * i4 + kg; const f32x4 vv = *(const f32x4*)(cv + (size_t)(WIN - j * d) * AW + 4 * dc); o4 += vv * pl[pat * 132 + j]; }
            }
        } else {
#pragma unroll 1
            for (int pat = 0; pat < 3; ++pat) {
                const int d = pat == 0 ? 1 : (pat == 1 ? 4 : 16);
                int jmax = s / d; jmax = jmax > 128 ? 128 : jmax;
#pragma unroll 4
                for (int j = kg; j <= jmax; j += 4) { const u32x2 vv = *(const u32x2*)(prow0 + (size_t)(s - j * d) * HYB_MAIN + 2 * AW + h * AHD + 4 * dc); const float pv = pl[pat * 132 + j];
                    o4.x += pv * bf2f((bf16_t)(vv.x & 0xffff)); o4.y += pv * bf2f((bf16_t)(vv.x >> 16)); o4.z += pv * bf2f((bf16_t)(vv.y & 0xffff)); o4.w += pv * bf2f((bf16_t)(vv.y >> 16)); }
            }
        }
#pragma unroll
        for (int e = 0; e < 4; ++e) { o4[e] += __shfl_xor(o4[e], 16); o4[e] += __shfl_xor(o4[e], 32); }
        const float inv = 1.f / ssum;
        if (kg == 0) { u32x2 o; o.x = pk2(o4.x * inv, o4.y * inv); o.y = pk2(o4.z * inv, o4.w * inv); *(u32x2*)(MIX + (size_t)tok * HYB_MIX + h * AHD + 4 * dc) = o; }
    }
    LDS_WAIT();
}

template <int MT>
DI void gemm_ksplit(const Ctx& c, const bf16_t* A, int lda, int M, const bf16_t* Bt, int ldb, int N, int K, const Epi e) {
    const int mblk = (M + 16 * MT - 1) / (16 * MT), nblk = (N + 31) / 32, nit = mblk * nblk;
    const int fr = c.lane & 15, fq = c.lane >> 4, kslice = K / 8, klo = c.wave * kslice;
    LAS float* part = (LAS float*)c.lds;
    for (int it = blockIdx.x; it < nit; it += gridDim.x) {
        const int mb = it / nblk, nb = it % nblk, m0 = mb * 16 * MT, n0 = nb * 32;
        const bf16_t* ap[MT]; const bf16_t* bp[2];
#pragma unroll
        for (int m = 0; m < MT; ++m) { int r = m0 + 16 * m + fr; r = r < M ? r : M - 1; ap[m] = A + (size_t)r * lda + klo + 8 * fq; }
#pragma unroll
        for (int n = 0; n < 2; ++n) { int r = n0 + 16 * n + fr; r = r < N ? r : N - 1; bp[n] = Bt + (size_t)r * ldb + klo + 8 * fq; }
        f32x4 acc[MT][2];
#pragma unroll
        for (int m = 0; m < MT; ++m)
#pragma unroll
            for (int n = 0; n < 2; ++n) acc[m][n] = (f32x4){0.f, 0.f, 0.f, 0.f};
#pragma unroll 4
        for (int k0 = 0; k0 < kslice; k0 += 32) {
            bf16x8 a[MT], b[2];
#pragma unroll
            for (int m = 0; m < MT; ++m) a[m] = *(const bf16x8*)(ap[m] + k0);
#pragma unroll
            for (int n = 0; n < 2; ++n) b[n] = *(const bf16x8*)(bp[n] + k0);
#pragma unroll
            for (int m = 0; m < MT; ++m)
#pragma unroll
                for (int n = 0; n < 2; ++n) acc[m][n] = __builtin_amdgcn_mfma_f32_16x16x32_bf16(b[n], a[m], acc[m][n], 0, 0, 0);
        }
        __syncthreads();
#pragma unroll
        for (int m = 0; m < MT; ++m)
#pragma unroll
            for (int n = 0; n < 2; ++n) *(LAS f32x4*)(part + ((c.wave * (MT * 2) + m * 2 + n) * 64 + c.lane) * 4) = acc[m][n];
        __syncthreads();
        if (c.wave < MT) {
            const int m = c.wave; f32x4 v[2];
#pragma unroll
            for (int n = 0; n < 2; ++n) { v[n] = (f32x4){0.f, 0.f, 0.f, 0.f};
#pragma unroll
                for (int w = 0; w < 8; ++w) v[n] += *(const LAS f32x4*)(part + ((w * (MT * 2) + m * 2 + n) * 64 + c.lane) * 4); }
            const int row = m0 + 16 * m + fr;
            if (row < M) {
                if (e.mode == 2) {
                    const f32x4 g = v[0], u = v[1]; u32x2 o;
                    o.x = pk2(siluf(g.x) * u.x, siluf(g.y) * u.y); o.y = pk2(siluf(g.z) * u.z, siluf(g.w) * u.w);
                    *(u32x2*)(e.ob + (size_t)row * e.ldo + 16 * nb + 4 * fq) = o;
                } else {
#pragma unroll
                    for (int n = 0; n < 2; ++n) {
                        const int col = n0 + 16 * n + 4 * fq; if (col >= N) continue;
                        if (e.mode == 1) *(f32x4*)(e.of + (size_t)row * e.ldo + col) = v[n];
                        else if (col < e.main_cols) { u32x2 o; o.x = pk2(v[n].x, v[n].y); o.y = pk2(v[n].z, v[n].w); *(u32x2*)(e.ob + (size_t)row * e.ldo + col) = o; }
                        else *(f32x4*)(e.of + (size_t)row * 32 + (col - e.main_cols)) = v[n];
                    }
                }
            }
        }
    }
    __syncthreads();
}

constexpr int AT_LDS = 1600;
struct AtStep { int d, u, kb, sh; const LAS float* tbp; };
DI AtStep at_step(int g, const LAS float* tb) {
    AtStep s;
    if (g < 12) { s.d = 1; s.u = 16; s.sh = 0; s.kb = -143 + 32 * g; s.tbp = tb; }
    else if (g < 18) { s.d = 4; s.u = 4; s.sh = 2; s.kb = -131 + 32 * (g - 12); s.tbp = tb + 132; }
    else if (g < 23) { s.d = 16; s.u = 1; s.sh = 4; s.kb = -144 + 32 * (g - 18); s.tbp = tb + 264; }
    else { s.d = 1; s.u = 0; s.sh = 0; s.kb = 100000; s.tbp = tb; }
    return s;
}
struct AtBuf { bf16x8 k[2][2]; bf16x8 v[2][2]; };
DI void at_load(AtBuf& bf, const bf16_t* qrow0, int P0, const AtStep st, int fr, int fq) {
#pragma unroll
    for (int kt = 0; kt < 2; ++kt) {
        int pos = P0 + st.d * (st.kb + 16 * kt + fr); pos = pos < 0 ? 0 : (pos > SEQ - 1 ? SEQ - 1 : pos);
        const bf16_t* rp = qrow0 + (size_t)pos * HYB_MAIN + 8 * fq;
        bf.k[kt][0] = *(const bf16x8*)(rp + AW); bf.k[kt][1] = *(const bf16x8*)(rp + AW + 32);
        bf.v[kt][0] = *(const bf16x8*)(rp + 2 * AW); bf.v[kt][1] = *(const bf16x8*)(rp + 2 * AW + 32);
    }
}
DI void attn_mfma_item(const Ctx& c, int li, int item) {
    const bf16_t* PROJ = c.ws<bf16_t>(W_PROJ); bf16_t* MIX = c.ws<bf16_t>(W_MIXED);
    int lane_ = c.lane; asm volatile("" : "+v"(lane_));
    const int lane = lane_, fr = lane & 15, fq = lane >> 4;
    const int qb = item & 255, h = (item >> 8) & 7, b = item >> 11, P0 = (qb >> 4) * 256 + (qb & 15);
    LAS float* tb = (LAS float*)(c.lds + c.wave * AT_LDS);
    { const float* relb = c.in(I_RELB);
#pragma unroll 1
      for (int i = lane; i < 396; i += 64) { const int pat = i / 132, j = i % 132; tb[i] = j <= 128 ? relb[c_bucket[pat][j] * AH + h] : 0.f; } }
    const bf16_t* qrow0 = PROJ + (size_t)(b * SEQ) * HYB_MAIN + h * AHD;
    bf16x8 qf[2], idf[2];
#pragma unroll
    for (int kd = 0; kd < 2; ++kd) qf[kd] = *(const bf16x8*)(qrow0 + (size_t)(P0 + 16 * fr) * HYB_MAIN + 32 * kd + 8 * fq);
#pragma unroll
    for (int hs = 0; hs < 2; ++hs)
#pragma unroll
        for (int e = 0; e < 8; ++e) idf[hs][e] = (8 * fq + e) == (16 * hs + fr) ? (short)0x3F80 : (short)0;
    float m = -1e30f, lsum = 0.f;
    f32x4 O[4];
#pragma unroll
    for (int dt = 0; dt < 4; ++dt) O[dt] = (f32x4){0.f, 0.f, 0.f, 0.f};
    AtBuf b0, b1, b2;
    at_load(b0, qrow0, P0, at_step(0, tb), fr, fq); at_load(b1, qrow0, P0, at_step(1, tb), fr, fq); at_load(b2, qrow0, P0, at_step(2, tb), fr, fq);
    LDS_WAIT();
#define AT_STEP(bf, g) do { \
        const AtStep st = at_step((g), tb); const int qi = st.u * fr; \
        f32x4 sc[2]; \
        _Pragma("unroll") for (int kt = 0; kt < 2; ++kt) { sc[kt] = (f32x4){0.f, 0.f, 0.f, 0.f}; \
            _Pragma("unroll") for (int kd = 0; kd < 2; ++kd) sc[kt] = __builtin_amdgcn_mfma_f32_16x16x32_bf16(bf.k[kt][kd], qf[kd], sc[kt], 0, 0, 0); } \
        f32x4 dv[2][4]; \
        _Pragma("unroll") for (int kt = 0; kt < 2; ++kt) _Pragma("unroll") for (int dt = 0; dt < 4; ++dt) \
            dv[kt][dt] = __builtin_amdgcn_mfma_f32_16x16x32_bf16(bf.v[kt][dt >> 1], idf[dt & 1], (f32x4){0.f, 0.f, 0.f, 0.f}, 0, 0, 0);     \
        const AtStep nx = at_step((g) + 3, tb); at_load(bf, qrow0, P0, nx, fr, fq);     \
        float tmax = -1e30f; bool ok[2][4]; \
        const int dbase = qi - st.kb - 4 * fq;                                 \
        int dmx = qi + (P0 >> st.sh); dmx = dmx > 128 ? 128 : dmx;                  \
        _Pragma("unroll") for (int kt = 0; kt < 2; ++kt) _Pragma("unroll") for (int r = 0; r < 4; ++r) { \
            const unsigned dist = (unsigned)(dbase - 16 * kt - r); const bool v = dist <= (unsigned)dmx; ok[kt][r] = v; \
            const unsigned di = dist > 128u ? 128u : dist; const float bias = *(const volatile LAS float*)(st.tbp + di); \
            const float lg = v ? sc[kt][r] * 0.125f + bias : -1e30f; sc[kt][r] = lg; tmax = fmaxf(tmax, lg); } \
        tmax = fmaxf(tmax, __shfl_xor(tmax, 16)); tmax = fmaxf(tmax, __shfl_xor(tmax, 32)); \
        const float mn = fmaxf(m, tmax), alpha = __expf(m - mn); m = mn; \
        float ps = 0.f; \
        _Pragma("unroll") for (int kt = 0; kt < 2; ++kt) _Pragma("unroll") for (int r = 0; r < 4; ++r) { const float pv = ok[kt][r] ? __expf(sc[kt][r] - mn) : 0.f; sc[kt][r] = pv; ps += pv; } \
        lsum = lsum * alpha + ps; \
        const bf16x8 pfrag = pack8(sc[0], sc[1]); \
        _Pragma("unroll") for (int dt = 0; dt < 4; ++dt) O[dt] = __builtin_amdgcn_mfma_f32_16x16x32_bf16(pack8(dv[0][dt], dv[1][dt]), pfrag, O[dt] * alpha, 0, 0, 0); } while (0)
#pragma unroll 1
    for (int g = 0; g < 24; g += 3) { AT_STEP(b0, g); AT_STEP(b1, g + 1); AT_STEP(b2, g + 2); }
#undef AT_STEP
    lsum += __shfl_xor(lsum, 16); lsum += __shfl_xor(lsum, 32);
    const float inv = 1.f / lsum;
    bf16_t* orow = MIX + (size_t)(b * SEQ + P0 + 16 * fr) * HYB_MIX + h * AHD;
#pragma unroll
    for (int dt = 0; dt < 4; ++dt) { u32x2 o; o.x = pk2(O[dt][0] * inv, O[dt][1] * inv); o.y = pk2(O[dt][2] * inv, O[dt][3] * inv); *(u32x2*)(orow + 16 * dt + 4 * fq) = o; }
    LDS_WAIT();
}

DI void unpack8(const u32x4 v, float* f) {
    f[0] = bf2f((bf16_t)(v.x & 0xffff)); f[1] = bf2f((bf16_t)(v.x >> 16)); f[2] = bf2f((bf16_t)(v.y & 0xffff)); f[3] = bf2f((bf16_t)(v.y >> 16));
    f[4] = bf2f((bf16_t)(v.z & 0xffff)); f[5] = bf2f((bf16_t)(v.z >> 16)); f[6] = bf2f((bf16_t)(v.w & 0xffff)); f[7] = bf2f((bf16_t)(v.w >> 16));
}
DI void load8f(const float* p, float* f) { const f32x4 a = *(const f32x4*)p, b = *(const f32x4*)(p + 4); f[0] = a.x; f[1] = a.y; f[2] = a.z; f[3] = a.w; f[4] = b.x; f[5] = b.y; f[6] = b.z; f[7] = b.w; }
DI void store8f(float* p, const float* f) { *(f32x4*)p = (f32x4){f[0], f[1], f[2], f[3]}; *(f32x4*)(p + 4) = (f32x4){f[4], f[5], f[6], f[7]}; }
DI void conv8(const bf16_t* prow, int ld, const float* st, int nch, const float* cw, int ch0, bool smp, int s, float* x1, float* x2, float* x3, float* y) {
    float x0[8], w[8];
    unpack8(*(const u32x4*)(prow + ch0), x3);
    if (smp) { load8f(st + ch0, x0); load8f(st + nch + ch0, x1); load8f(st + 2 * nch + ch0, x2); }
    else {
        const u32x4 z = (u32x4){0u, 0u, 0u, 0u};
        unpack8(s >= 1 ? *(const u32x4*)(prow + ch0 - ld) : z, x2); unpack8(s >= 2 ? *(const u32x4*)(prow + ch0 - 2 * ld) : z, x1); unpack8(s >= 3 ? *(const u32x4*)(prow + ch0 - 3 * ld) : z, x0);
    }
    load8f(cw + ch0, w);
#pragma unroll
    for (int e = 0; e < 8; ++e) y[e] = x0[e] * w[e];
    load8f(cw + nch + ch0, w);
#pragma unroll
    for (int e = 0; e < 8; ++e) y[e] += x1[e] * w[e];
    load8f(cw + 2 * nch + ch0, w);
#pragma unroll
    for (int e = 0; e < 8; ++e) y[e] += x2[e] * w[e];
    load8f(cw + 3 * nch + ch0, w);
#pragma unroll
    for (int e = 0; e < 8; ++e) y[e] += x3[e] * w[e];
}
DI void hyb_pre_token(const Ctx& c, int li, int tok) {
    const bf16_t* PROJ = c.ws<bf16_t>(W_PROJ); float* ACT = c.ws<float>(W_ACT); float* AUX = c.ws<float>(W_AUX); const float* EX = c.ws<float>(W_EXTRA);
    const int lane = c.lane; const bool smp = tok >= T; const int b = smp ? tok - T : tok / SEQ, s = smp ? 0 : tok % SEQ;
    const float* cw = c.in(I_SCW) + (size_t)li * 4 * SXBC; const float* cb = c.in(I_SCB) + (size_t)li * SXBC;
    const float* st = c.in(I_SCONV) + (size_t)(li * NS + b) * 3 * SXBC;
    const bf16_t* prow = PROJ + (size_t)tok * HYB_MAIN + 2560;
#pragma unroll 1
    for (int it = 0; it < 3; ++it) {
        const int ch0 = 512 * it + 8 * lane; float x1[8], x2[8], x3[8], y[8], bb[8];
        conv8(prow, HYB_MAIN, st, SXBC, cw, ch0, smp, s, x1, x2, x3, y);
        load8f(cb + ch0, bb);
#pragma unroll
        for (int e = 0; e < 8; ++e) y[e] = siluf(y[e] + bb[e]);
        store8f(ACT + (size_t)tok * 4096 + ch0, y);
        if (smp) { float* o = c.p.out + O_SSC + (size_t)(li * NS + b) * 3 * SXBC + ch0; store8f(o, x1); store8f(o + SXBC, x2); store8f(o + 2 * SXBC, x3); }
        else if (s >= SEQ - 3) store8f(c.p.out + O_PSC + ((size_t)(li * NB + b) * 3 + (s - (SEQ - 3))) * SXBC + ch0, x3);
    }
    if (lane < SH) AUX[(size_t)tok * 32 + lane] = softplusf_(EX[(size_t)tok * 32 + lane] + c.in(I_SDTB)[li * SH + lane]);
    if (smp || s >= SEQ - WIN) {
        float* ok = smp ? c.p.out + O_SK + ((size_t)(li * NS + b) * WIN + (WIN - 1)) * AW : c.p.out + O_PK + ((size_t)(li * NB + b) * WIN + (s - (SEQ - WIN))) * AW;
        float* ov = smp ? c.p.out + O_SV + ((size_t)(li * NS + b) * WIN + (WIN - 1)) * AW : c.p.out + O_PV + ((size_t)(li * NB + b) * WIN + (s - (SEQ - WIN))) * AW;
        const bf16_t* kr = PROJ + (size_t)tok * HYB_MAIN + AW;
        float f[8];
        unpack8(*(const u32x4*)(kr + 8 * lane), f); store8f(ok + 8 * lane, f);
        unpack8(*(const u32x4*)(kr + AW + 8 * lane), f); store8f(ov + 8 * lane, f);
    }
}

DI void ssd_wave(const Ctx& c, int li, int item) {
    const float* ACT = c.ws<float>(W_ACT); const float* AUX = c.ws<float>(W_AUX); float* Y = c.ws<float>(W_Y);
    const int lane = c.lane;
    const bool smp = item >= NB * SH * SP; const int it = smp ? item - NB * SH * SP : item;
    const int seq = it / (SH * SP), h = (it / SP) % SH, p = it % SP, g = h / (SH / SG);
    const int L = smp ? 1 : SEQ; const int tok0 = smp ? T + seq : seq * SEQ;
    const float Ah = -__expf(c.in(I_SALOG)[li * SH + h]), Dh = c.in(I_SD)[li * SH + h];
    float h0 = 0.f, h1 = 0.f;
    if (smp) { const float* s0 = c.in(I_SSM) + (((size_t)(li * NS + seq) * SH + h) * SP + p) * SN; h0 = s0[2 * lane]; h1 = s0[2 * lane + 1]; }
#pragma unroll 2
    for (int t = 0; t < L; ++t) {
        const float* a = ACT + (size_t)(tok0 + t) * 4096;
        const float dt = AUX[(size_t)(tok0 + t) * 32 + h], xv = a[h * SP + p];
        const float2 Bv = *(const float2*)(a + SDI + g * SN + 2 * lane), Cv = *(const float2*)(a + SDI + SG * SN + g * SN + 2 * lane);
        const float dec = __expf(dt * Ah), dx = dt * xv;
        h0 = h0 * dec + dx * Bv.x; h1 = h1 * dec + dx * Bv.y;
        const float y = wave_sum(h0 * Cv.x + h1 * Cv.y);
        if (lane == 0) Y[(size_t)(tok0 + t) * 2048 + h * SP + p] = y + Dh * xv;
    }
    float* so = smp ? c.p.out + O_SSS + (((size_t)(li * NS + seq) * SH + h) * SP + p) * SN : c.p.out + O_PSS + (((size_t)(li * NB + seq) * SH + h) * SP + p) * SN;
    *(float2*)(so + 2 * lane) = make_float2(h0, h1);
}
DI void ssd_sample_item(const Ctx& c, int li, int item) {
    const float* ACT = c.ws<float>(W_ACT); const float* AUX = c.ws<float>(W_AUX); float* Y = c.ws<float>(W_Y);
    const int lane = c.lane, seq = item / SH, h = item % SH, g = h / (SH / SG), tok = T + seq;
    const float Ah = -__expf(c.in(I_SALOG)[li * SH + h]), Dh = c.in(I_SD)[li * SH + h];
    const float* a = ACT + (size_t)tok * 4096;
    const float dt = AUX[(size_t)tok * 32 + h], dec = __expf(dt * Ah);
    const float2 Bv = *(const float2*)(a + SDI + g * SN + 2 * lane), Cv = *(const float2*)(a + SDI + SG * SN + g * SN + 2 * lane);
    const float* s0 = c.in(I_SSM) + ((size_t)(li * NS + seq) * SH + h) * SP * SN; float* so = c.p.out + O_SSS + ((size_t)(li * NS + seq) * SH + h) * SP * SN;
    const float xl = a[h * SP + lane];
    float ysum = 0.f;
#pragma unroll 16
    for (int p = 0; p < SP; ++p) {
        const float2 hv = *(const float2*)(s0 + (size_t)p * SN + 2 * lane);
        const float dx = dt * __shfl(xl, p);
        const float h0 = hv.x * dec + dx * Bv.x, h1 = hv.y * dec + dx * Bv.y;
        *(float2*)(so + (size_t)p * SN + 2 * lane) = make_float2(h0, h1);
        const float y = wave_sum(h0 * Cv.x + h1 * Cv.y);
        ysum = lane == p ? y : ysum;
    }
    Y[(size_t)tok * 2048 + h * SP + lane] = ysum + Dh * xl;
}
DI void hyb_post_token(const Ctx& c, int li, int tok) {
    const bf16_t* PROJ = c.ws<bf16_t>(W_PROJ); const float* Y = c.ws<float>(W_Y); bf16_t* MIX = c.ws<bf16_t>(W_MIXED);
    const float* nw = c.in(I_SNW) + (size_t)li * SDI; const int lane = c.lane;
    float v[16]; float ss0 = 0.f, ss1 = 0.f;
#pragma unroll
    for (int j = 0; j < 16; ++j) { const int ch = lane + 64 * j; const float z = bf2f(PROJ[(size_t)tok * HYB_MAIN + 1536 + ch]); v[j] = Y[(size_t)tok * 2048 + ch] * siluf(z); if (j < 8) ss0 += v[j] * v[j]; else ss1 += v[j] * v[j]; }
    const float r0 = rsqrtf(wave_sum(ss0) * (1.f / 512.f) + EPS), r1 = rsqrtf(wave_sum(ss1) * (1.f / 512.f) + EPS);
#pragma unroll
    for (int j = 0; j < 16; ++j) { const int ch = lane + 64 * j; MIX[(size_t)tok * HYB_MIX + AW + ch] = f2bf(v[j] * (j < 8 ? r0 : r1) * nw[ch]); }
}


constexpr int SLD = 136;
constexpr int L_C = 0, L_B = 34816, L_XT = 69632, L_HS = 87040, L_CS = 104448, L_DT = 108544;
constexpr size_t W_ST = W_HID;
constexpr size_t W_DEC = W_HID + (size_t)NB * 32 * SH * SP * SN * 4;
constexpr int NCH = SEQ / 128;

DI void ssd_chunk_scalars(const Ctx& c, int li, int tok0, int g) {
    const float* AUX = c.ws<float>(W_AUX); LAS float* csS = (LAS float*)(c.lds + L_CS); LAS float* dtS = (LAS float*)(c.lds + L_DT);
    const int hh = c.wave, lane = c.lane, h = 8 * g + hh;
    const float Ah = -__expf(c.in(I_SALOG)[li * SH + h]);
    const float d0 = AUX[(size_t)(tok0 + lane) * 32 + h], d1 = AUX[(size_t)(tok0 + 64 + lane) * 32 + h];
    float s0 = d0 * Ah, s1 = d1 * Ah;
#pragma unroll
    for (int o = 1; o < 64; o <<= 1) { const float t0 = __shfl_up(s0, o), t1 = __shfl_up(s1, o); if (lane >= o) { s0 += t0; s1 += t1; } }
    s1 += __shfl(s0, 63);
    csS[lane * 8 + hh] = s0; csS[(64 + lane) * 8 + hh] = s1; dtS[lane * 8 + hh] = d0; dtS[(64 + lane) * 8 + hh] = d1;
}
DI void ssd_a_item(const Ctx& c, int li, int item) {
    int tid_o = c.tid; asm volatile("" : "+v"(tid_o));
    const int lane_o = tid_o & 63;
    const float* ACT = c.ws<float>(W_ACT); float* ST = c.ws<float>(W_ST); float* DEC = c.ws<float>(W_DEC);
    const int g = item & 1, ch = (item >> 1) % NCH, b = item / (2 * NCH), tok0 = b * SEQ + ch * 128;
    LAS bf16_t* BT = (LAS bf16_t*)(c.lds + L_B); LAS bf16_t* XT = (LAS bf16_t*)(c.lds + L_XT);
    const LAS float* csS = (const LAS float*)(c.lds + L_CS); const LAS float* dtS = (const LAS float*)(c.lds + L_DT);
    const int fr = lane_o & 15, fq = lane_o >> 4, w = c.wave;
    __syncthreads();
    ssd_chunk_scalars(c, li, tok0, g);
#pragma unroll 16
    for (int it = 0; it < 32; ++it) { const int idx = it * NTHR + tid_o, j = idx >> 7, n = idx & 127; BT[n * SLD + j] = f2bf(ACT[(size_t)(tok0 + j) * 4096 + SDI + g * SN + n]); }
    __syncthreads();
    if (tid_o < 8) DEC[(size_t)(b * NCH + ch) * SH + 8 * g + tid_o] = __expf(csS[127 * 8 + tid_o]);
    const int pt = w & 3, nt0 = (w >> 2) * 4;
    float xr[16];
#pragma unroll
    for (int it = 0; it < 16; ++it) { const int idx = it * NTHR + tid_o, j = idx >> 6, p = idx & 63; xr[it] = ACT[(size_t)(tok0 + j) * 4096 + (8 * g) * SP + p]; }
#pragma unroll 1
    for (int hh = 0; hh < 8; ++hh) {
        const int h = 8 * g + hh; const float csl = csS[127 * 8 + hh];
#pragma unroll
        for (int it = 0; it < 16; ++it) { const int idx = it * NTHR + tid_o, j = idx >> 6, p = idx & 63;
            XT[p * SLD + j] = f2bf(xr[it] * __expf(csl - csS[j * 8 + hh]) * dtS[j * 8 + hh]); }
        __syncthreads();
        if (hh + 1 < 8) {
#pragma unroll
            for (int it = 0; it < 16; ++it) { const int idx = it * NTHR + tid_o, j = idx >> 6, p = idx & 63; xr[it] = ACT[(size_t)(tok0 + j) * 4096 + (h + 1) * SP + p]; }
        }
        f32x4 acc[4];
#pragma unroll
        for (int n = 0; n < 4; ++n) acc[n] = (f32x4){0.f, 0.f, 0.f, 0.f};
#pragma unroll
        for (int ks = 0; ks < 4; ++ks) {
            const bf16x8 a = lds_frag(XT + (16 * pt + fr) * SLD + 32 * ks + 8 * fq);
#pragma unroll
            for (int n = 0; n < 4; ++n) { const bf16x8 bb = lds_frag(BT + (16 * (nt0 + n) + fr) * SLD + 32 * ks + 8 * fq); acc[n] = __builtin_amdgcn_mfma_f32_16x16x32_bf16(bb, a, acc[n], 0, 0, 0); }
        }
        float* so = ST + ((((size_t)(b * NCH + ch) * SH + h) * SP + 16 * pt + fr) * SN);
#pragma unroll
        for (int n = 0; n < 4; ++n) *(f32x4*)(so + 16 * (nt0 + n) + 4 * fq) = acc[n];
        __syncthreads();
    }
}
DI void ssd_scan_phase(const Ctx& c, int li) {
    float* ST = c.ws<float>(W_ST); const float* DEC = c.ws<float>(W_DEC);
    for (int idx = blockIdx.x * NTHR + c.tid; idx < NB * SH * SP * SN / 4; idx += gridDim.x * NTHR) {
        const int n4 = idx & 31, p = (idx >> 5) & 63, h = (idx >> 11) & 15, b = idx >> 15;
        f32x4 hcur = (f32x4){0.f, 0.f, 0.f, 0.f};
#pragma unroll 8
        for (int ch = 0; ch < NCH; ++ch) {
            f32x4* a = (f32x4*)(ST + ((((size_t)(b * NCH + ch) * SH + h) * SP + p) * SN)) + n4;
            const f32x4 s = *a; const float d = DEC[(size_t)(b * NCH + ch) * SH + h];
            *a = hcur; hcur = hcur * d + s;
        }
        *((f32x4*)(c.p.out + O_PSS + ((((size_t)(li * NB + b) * SH + h) * SP + p) * SN)) + n4) = hcur;
    }
}
DI void ssd_b_item(const Ctx& c, int li, int item) {
    int tid_o = c.tid; asm volatile("" : "+v"(tid_o));
    const int lane_o = tid_o & 63;
    const float* ACT = c.ws<float>(W_ACT); const float* ST = c.ws<float>(W_ST); const bf16_t* PROJ = c.ws<bf16_t>(W_PROJ); bf16_t* MIX = c.ws<bf16_t>(W_MIXED);
    const int g = item & 1, ch = (item >> 1) % NCH, b = item / (2 * NCH), tok0 = b * SEQ + ch * 128;
    LAS bf16_t* CS_ = (LAS bf16_t*)(c.lds + L_C); LAS bf16_t* BS = (LAS bf16_t*)(c.lds + L_B); LAS bf16_t* XT = (LAS bf16_t*)(c.lds + L_XT); LAS bf16_t* HS = (LAS bf16_t*)(c.lds + L_HS);
    const LAS float* csS = (const LAS float*)(c.lds + L_CS); const LAS float* dtS = (const LAS float*)(c.lds + L_DT);
    const int fr = lane_o & 15, fq = lane_o >> 4, w = c.wave, irow = 16 * w + fr;
    __syncthreads();
    ssd_chunk_scalars(c, li, tok0, g);
#pragma unroll
    for (int it = 0; it < 8; ++it) { const int idx = it * NTHR + tid_o, i = idx >> 5, n4 = idx & 31;
        const f32x4 bv = *(const f32x4*)(ACT + (size_t)(tok0 + i) * 4096 + SDI + g * SN + 4 * n4), cv = *(const f32x4*)(ACT + (size_t)(tok0 + i) * 4096 + SDI + SG * SN + g * SN + 4 * n4);
        u32x2 o; o.x = pk2(bv.x, bv.y); o.y = pk2(bv.z, bv.w); *(LAS u32x2*)(BS + i * SLD + 4 * n4) = o;
        o.x = pk2(cv.x, cv.y); o.y = pk2(cv.z, cv.w); *(LAS u32x2*)(CS_ + i * SLD + 4 * n4) = o; }
    __syncthreads();
    f32x4 cb[8];
#pragma unroll
    for (int jt = 0; jt < 8; ++jt) cb[jt] = (f32x4){0.f, 0.f, 0.f, 0.f};
    bf16x8 cfrag[4];
#pragma unroll
    for (int ks = 0; ks < 4; ++ks) cfrag[ks] = lds_frag(CS_ + irow * SLD + 32 * ks + 8 * fq);
#pragma unroll
    for (int jt = 0; jt < 8; ++jt) if (jt <= w) {
#pragma unroll
        for (int ks = 0; ks < 4; ++ks) cb[jt] = __builtin_amdgcn_mfma_f32_16x16x32_bf16(lds_frag(BS + (16 * jt + fr) * SLD + 32 * ks + 8 * fq), cfrag[ks], cb[jt], 0, 0, 0);
    }
    float rowsq = 0.f;
    float xr[16]; f32x4 hr[4];
#pragma unroll
    for (int it = 0; it < 16; ++it) { const int idx = it * NTHR + tid_o, j = idx >> 6, p = idx & 63; xr[it] = ACT[(size_t)(tok0 + j) * 4096 + (8 * g) * SP + p]; }
#pragma unroll
    for (int it = 0; it < 4; ++it) { const int idx = it * NTHR + tid_o, p = idx >> 5, n4 = idx & 31; hr[it] = *((const f32x4*)(ST + ((((size_t)(b * NCH + ch) * SH + 8 * g) * SP + p) * SN)) + n4); }
#pragma unroll 1
    for (int hh = 0; hh < 8; ++hh) {
        const int h = 8 * g + hh; const float Dh = c.in(I_SD)[li * SH + h];
        int tw = tid_o; asm volatile("" : "+v"(tw));
#pragma unroll
        for (int it = 0; it < 16; ++it) { const int idx = it * NTHR + tw, j = idx >> 6, p = idx & 63; XT[p * SLD + j] = f2bf(xr[it]); }
#pragma unroll
        for (int it = 0; it < 4; ++it) { const int idx = it * NTHR + tw, p = idx >> 5, n4 = idx & 31; const f32x4 v = hr[it];
            u32x2 o; o.x = pk2(v.x, v.y); o.y = pk2(v.z, v.w); *(LAS u32x2*)(HS + p * SLD + 4 * n4) = o; }
        __syncthreads();
        if (hh + 1 < 8) {
            int tq = tid_o; asm volatile("" : "+v"(tq));
#pragma unroll
            for (int it = 0; it < 16; ++it) { const int idx = it * NTHR + tq, j = idx >> 6, p = idx & 63; xr[it] = ACT[(size_t)(tok0 + j) * 4096 + (h + 1) * SP + p]; }
#pragma unroll
            for (int it = 0; it < 4; ++it) { const int idx = it * NTHR + tq, p = idx >> 5, n4 = idx & 31; hr[it] = *((const f32x4*)(ST + ((((size_t)(b * NCH + ch) * SH + h + 1) * SP + p) * SN)) + n4); }
        }
        const float csi = csS[irow * 8 + hh];
        f32x4 xv4[4]; u32x2 zz4[4];
#pragma unroll
        for (int pt = 0; pt < 4; ++pt) { const int col = h * SP + 16 * pt + 4 * fq; xv4[pt] = *(const f32x4*)(ACT + (size_t)(tok0 + irow) * 4096 + col); zz4[pt] = *(const u32x2*)(PROJ + (size_t)(tok0 + irow) * HYB_MAIN + 1536 + col); }
        f32x4 ay[4], ah[4];
#pragma unroll
        for (int pt = 0; pt < 4; ++pt) { ay[pt] = (f32x4){0.f, 0.f, 0.f, 0.f}; ah[pt] = (f32x4){0.f, 0.f, 0.f, 0.f}; }
#pragma unroll
        for (int ks = 0; ks < 4; ++ks) {
#pragma unroll
            for (int pt = 0; pt < 4; ++pt) ah[pt] = __builtin_amdgcn_mfma_f32_16x16x32_bf16(lds_frag(HS + (16 * pt + fr) * SLD + 32 * ks + 8 * fq), cfrag[ks], ah[pt], 0, 0, 0);
            if (2 * ks <= w) {
                float mv[8];
#pragma unroll
                for (int e = 0; e < 8; ++e) {
                    const int j = 32 * ks + (e < 4 ? 4 * fq + e : 16 + 4 * fq + (e - 4));
                    const float cbv = e < 4 ? cb[2 * ks][e] : cb[2 * ks + 1][e - 4];
                    const float csj = *(const volatile LAS float*)(csS + j * 8 + hh), dtj = *(const volatile LAS float*)(dtS + j * 8 + hh);
                    mv[e] = j <= irow ? cbv * __expf(csi - csj) * dtj : 0.f;
                }
                u32x4 mp; mp.x = pk2(mv[0], mv[1]); mp.y = pk2(mv[2], mv[3]); mp.z = pk2(mv[4], mv[5]); mp.w = pk2(mv[6], mv[7]);
                const bf16x8 mfrag = __builtin_bit_cast(bf16x8, mp);
#pragma unroll
                for (int pt = 0; pt < 4; ++pt) ay[pt] = __builtin_amdgcn_mfma_f32_16x16x32_bf16(lds_frag2(XT + (16 * pt + fr) * SLD + 32 * ks + 4 * fq, XT + (16 * pt + fr) * SLD + 32 * ks + 16 + 4 * fq), mfrag, ay[pt], 0, 0, 0);
            }
        }
        const float ei = __expf(csi);
#pragma unroll
        for (int pt = 0; pt < 4; ++pt) {
            const int col = h * SP + 16 * pt + 4 * fq;
            const f32x4 xv = xv4[pt]; const u32x2 zz = zz4[pt];
            const float z0 = bf2f((bf16_t)(zz.x & 0xffff)), z1 = bf2f((bf16_t)(zz.x >> 16)), z2 = bf2f((bf16_t)(zz.y & 0xffff)), z3 = bf2f((bf16_t)(zz.y >> 16));
            const float y0 = (ay[pt][0] + ei * ah[pt][0] + Dh * xv.x) * siluf(z0), y1 = (ay[pt][1] + ei * ah[pt][1] + Dh * xv.y) * siluf(z1);
            const float y2 = (ay[pt][2] + ei * ah[pt][2] + Dh * xv.z) * siluf(z2), y3 = (ay[pt][3] + ei * ah[pt][3] + Dh * xv.w) * siluf(z3);
            rowsq += y0 * y0 + y1 * y1 + y2 * y2 + y3 * y3;
            u32x2 o; o.x = pk2(y0, y1); o.y = pk2(y2, y3); *(u32x2*)(MIX + (size_t)(tok0 + irow) * HYB_MIX + AW + col) = o;
        }
        __syncthreads();
    }
    rowsq += __shfl_xor(rowsq, 16); rowsq += __shfl_xor(rowsq, 32);
    const float rn = rsqrtf(rowsq * (1.f / 512.f) + EPS);
    const float* nw = c.in(I_SNW) + (size_t)li * SDI + g * 512;
    asm volatile("s_waitcnt vmcnt(0)" ::: "memory");
    bf16_t* mrow = MIX + (size_t)(tok0 + irow) * HYB_MIX + AW + g * 512 + fq * 128;
#pragma unroll 4
    for (int cc = 0; cc < 16; ++cc) {
        const u32x4 v = *(const u32x4*)(mrow + 8 * cc); const float* wv = nw + fq * 128 + 8 * cc; u32x4 o;
        o.x = pk2(bf2f((bf16_t)(v.x & 0xffff)) * rn * wv[0], bf2f((bf16_t)(v.x >> 16)) * rn * wv[1]); o.y = pk2(bf2f((bf16_t)(v.y & 0xffff)) * rn * wv[2], bf2f((bf16_t)(v.y >> 16)) * rn * wv[3]);
        o.z = pk2(bf2f((bf16_t)(v.z & 0xffff)) * rn * wv[4], bf2f((bf16_t)(v.z >> 16)) * rn * wv[5]); o.w = pk2(bf2f((bf16_t)(v.w & 0xffff)) * rn * wv[6], bf2f((bf16_t)(v.w >> 16)) * rn * wv[7]);
        *(u32x4*)(mrow + 8 * cc) = o;
    }
}

DI void gdn_pre_token(const Ctx& c, int li, int tok) {
    const bf16_t* PROJ = c.ws<bf16_t>(W_PROJ); bf16_t* ACTB = c.ws<bf16_t>(W_ACT); float* AUX = c.ws<float>(W_AUX); const float* EX = c.ws<float>(W_EXTRA);
    const int lane = c.lane; const bool smp = tok >= T; const int b = smp ? tok - T : tok / SEQ, s = smp ? 0 : tok % SEQ;
    const float* cw = c.in(I_GCW) + (size_t)li * 4 * GQKV;
    const float* st = c.in(I_GCONV) + (size_t)(li * NS + b) * 3 * GQKV;
    const bf16_t* prow = PROJ + (size_t)tok * GDN_MAIN;
#pragma unroll 1
    for (int it = 0; it < 8; ++it) {
        const int ch0 = 512 * it + 8 * lane; float x1[8], x2[8], x3[8], y[8];
        conv8(prow, GDN_MAIN, st, GQKV, cw, ch0, smp, s, x1, x2, x3, y);
        float ss = 0.f;
#pragma unroll
        for (int e = 0; e < 8; ++e) { y[e] = siluf(y[e]); ss += y[e] * y[e]; }
        if (it < 4) {
            ss += __shfl_xor(ss, 1); ss += __shfl_xor(ss, 2); ss += __shfl_xor(ss, 4); ss += __shfl_xor(ss, 8);
            const float r = rsqrtf(ss + EPS) * (it < 2 ? 0.08838834764831845f : 1.f);
#pragma unroll
            for (int e = 0; e < 8; ++e) y[e] *= r;
        }
        { u32x4 o; o.x = pk2(y[0], y[1]); o.y = pk2(y[2], y[3]); o.z = pk2(y[4], y[5]); o.w = pk2(y[6], y[7]); *(u32x4*)(ACTB + (size_t)tok * 4096 + ch0) = o; }
        if (smp) { float* o = c.p.out + O_SGC + (size_t)(li * NS + b) * 3 * GQKV + ch0; store8f(o, x1); store8f(o + GQKV, x2); store8f(o + 2 * GQKV, x3); }
        else if (s >= SEQ - 3) store8f(c.p.out + O_PGC + ((size_t)(li * NB + b) * 3 + (s - (SEQ - 3))) * GQKV + ch0, x3);
    }
    if (lane < GH) {
        AUX[(size_t)tok * 32 + lane] = sigmoidf_(EX[(size_t)tok * 32 + lane]);
        AUX[(size_t)tok * 32 + 16 + lane] = -__expf(c.in(I_GALOG)[li * GH + lane]) * softplusf_(EX[(size_t)tok * 32 + 16 + lane] + c.in(I_GDTB)[li * GH + lane]);
    }
}
DI void gdn_pre_range(const Ctx& c, int li, int item) {
    const bf16_t* PROJ = c.ws<bf16_t>(W_PROJ); bf16_t* ACTB = c.ws<bf16_t>(W_ACT); float* AUX = c.ws<float>(W_AUX); const float* EX = c.ws<float>(W_EXTRA);
    int lane_ = c.lane; asm volatile("" : "+v"(lane_));
    const int lane = lane_, it = item & 7, rg = item >> 3, tok0 = rg * 64, b = tok0 / SEQ, s0 = tok0 % SEQ, ch0 = 512 * it + 8 * lane;
    const float* cw = c.in(I_GCW) + (size_t)li * 4 * GQKV;
    float w0[8], w1[8], w2[8], w3[8], xa[8], xb[8], xc[8];
    load8f(cw + ch0, w0); load8f(cw + GQKV + ch0, w1); load8f(cw + 2 * GQKV + ch0, w2); load8f(cw + 3 * GQKV + ch0, w3);
    const bf16_t* prow = PROJ + (size_t)tok0 * GDN_MAIN + ch0;
    const u32x4 z4 = (u32x4){0u, 0u, 0u, 0u};
    unpack8(s0 >= 3 ? *(const u32x4*)(prow - 3 * GDN_MAIN) : z4, xa); unpack8(s0 >= 2 ? *(const u32x4*)(prow - 2 * GDN_MAIN) : z4, xb); unpack8(s0 >= 1 ? *(const u32x4*)(prow - GDN_MAIN) : z4, xc);
    const float qscale = it < 2 ? 0.08838834764831845f : 1.f;
    const float gal = lane >= 16 && lane < 32 ? -__expf(c.in(I_GALOG)[li * GH + lane - 16]) : 0.f, gdb = lane >= 16 && lane < 32 ? c.in(I_GDTB)[li * GH + lane - 16] : 0.f;
    u32x4 rawn[16];
#pragma unroll
    for (int j = 0; j < 16; ++j) rawn[j] = *(const u32x4*)(prow + (size_t)j * GDN_MAIN);
#pragma unroll 1
    for (int tb = 0; tb < 64; tb += 16) {
        u32x4 raw[16];
#pragma unroll
        for (int j = 0; j < 16; ++j) raw[j] = rawn[j];
        if (tb + 16 < 64) {
#pragma unroll
            for (int j = 0; j < 16; ++j) rawn[j] = *(const u32x4*)(prow + (size_t)(tb + 16 + j) * GDN_MAIN);
        }
#pragma unroll
        for (int j = 0; j < 16; ++j) {
            const int t = tb + j;
            float xd[8], y[8];
            unpack8(raw[j], xd);
            float ss = 0.f;
#pragma unroll
            for (int e = 0; e < 8; ++e) { y[e] = siluf(xa[e] * w0[e] + xb[e] * w1[e] + xc[e] * w2[e] + xd[e] * w3[e]); ss += y[e] * y[e]; }
            if (it < 4) {
                ss += __shfl_xor(ss, 1); ss += __shfl_xor(ss, 2); ss += __shfl_xor(ss, 4); ss += __shfl_xor(ss, 8);
                const float r = rsqrtf(ss + EPS) * qscale;
#pragma unroll
                for (int e = 0; e < 8; ++e) y[e] *= r;
            }
            { u32x4 o; o.x = pk2(y[0], y[1]); o.y = pk2(y[2], y[3]); o.z = pk2(y[4], y[5]); o.w = pk2(y[6], y[7]); *(u32x4*)(ACTB + (size_t)(tok0 + t) * 4096 + ch0) = o; }
            if (s0 + t >= SEQ - 3) store8f(c.p.out + O_PGC + ((size_t)(li * NB + b) * 3 + (s0 + t - (SEQ - 3))) * GQKV + ch0, xd);
            if (it == 0 && lane < 32) {
                const float ev = EX[(size_t)(tok0 + t) * 32 + lane];
                AUX[(size_t)(tok0 + t) * 32 + lane] = lane < 16 ? sigmoidf_(ev) : gal * softplusf_(ev + gdb);
            }
#pragma unroll
            for (int e = 0; e < 8; ++e) { xa[e] = xb[e]; xb[e] = xc[e]; xc[e] = xd[e]; }
        }
    }
}
DI void gdn_seq_phase(const Ctx& c, int li, int first_item, int wg, int nwg) {
    const bf16_t* ACTB = c.ws<bf16_t>(W_ACT); const float* AUX = c.ws<float>(W_AUX); bf16_t* MIX = c.ws<bf16_t>(W_MIXED); const bf16_t* PROJ = c.ws<bf16_t>(W_PROJ);
    LAS float* red = (LAS float*)c.lds + 1024;
    const int slot = c.tid >> 8, t8 = c.tid & 255, col = t8 >> 1, half = t8 & 1;
    LAS float* kq = (LAS float*)c.lds + slot * 512;
    const int nslot = nwg * 2;
    for (int base = first_item; base < NB * GH + NS * GH; base += nslot) {
        const int item = base + wg * 2 + slot;
        const bool wg_prompt = (base + wg * 2) < NB * GH;
        const int L = wg_prompt ? SEQ : 1;
        const bool valid = item < NB * GH + NS * GH;
        const bool smp = item >= NB * GH; const int it = smp ? item - NB * GH : item;
        const int seq = valid ? it / GH : 0, vh = valid ? it % GH : 0, hq = vh >> 1;
        const int tok0 = smp ? T + seq : seq * SEQ;
        float S[64];
        if (valid && smp) { const float* s0 = c.in(I_GST) + ((size_t)(li * NS + seq) * GH + vh) * GDK * GDV + (size_t)(64 * half) * GDV + col;
#pragma unroll
            for (int k = 0; k < 64; ++k) S[k] = s0[(size_t)k * GDV]; }
        else {
#pragma unroll
            for (int k = 0; k < 64; ++k) S[k] = 0.f; }
        __syncthreads();
        for (int t = 0; t < L; ++t) {
            LAS float* cur = kq + (t & 1) * 256;
            const bf16_t* a = ACTB + (size_t)(tok0 + t) * 4096;
            cur[t8] = bf2f(a[(t8 < 128 ? 1024 : -128) + hq * 128 + t8]);
            const float vv = bf2f(a[2048 + vh * 128 + col]), beta = AUX[(size_t)(tok0 + t) * 32 + vh], eg = __expf(AUX[(size_t)(tok0 + t) * 32 + 16 + vh]);
            __syncthreads();
            const LAS float* kk = cur + 64 * half; const LAS float* qq = cur + 128 + 64 * half;
            float ks = 0.f;
#pragma unroll
            for (int k = 0; k < 64; k += 4) { const f32x4 kv = *(const LAS f32x4*)(kk + k); ks += kv.x * S[k] + kv.y * S[k + 1] + kv.z * S[k + 2] + kv.w * S[k + 3]; }
            ks += __shfl_xor(ks, 1);
            const float u = beta * (vv - eg * ks);
            asm volatile("" ::: "memory");
            float o = 0.f;
#pragma unroll
            for (int k = 0; k < 64; k += 4) { const f32x4 kv = *(const LAS f32x4*)(kk + k); const f32x4 qv = *(const LAS f32x4*)(qq + k);
                S[k] = eg * S[k] + kv.x * u; S[k + 1] = eg * S[k + 1] + kv.y * u; S[k + 2] = eg * S[k + 2] + kv.z * u; S[k + 3] = eg * S[k + 3] + kv.w * u;
                o += qv.x * S[k] + qv.y * S[k + 1] + qv.z * S[k + 2] + qv.w * S[k + 3]; }
            o += __shfl_xor(o, 1);
            { const float sq = wave_sum(half == 0 ? o * o : 0.f); if (c.lane == 0) red[slot * 4 + ((c.tid >> 6) & 3)] = sq; }
            __syncthreads();
            if (valid && half == 0) { const float tot = red[slot * 4] + red[slot * 4 + 1] + red[slot * 4 + 2] + red[slot * 4 + 3];
                const float z = bf2f(PROJ[(size_t)(tok0 + t) * GDN_MAIN + 4096 + vh * 128 + col]);
                MIX[(size_t)(tok0 + t) * GVW + vh * 128 + col] = f2bf(o * rsqrtf(tot * (1.f / 128.f) + EPS) * c.in(I_GNW)[li * GDV + col] * siluf(z)); }
        }
        if (valid) { float* so = (smp ? c.p.out + O_SGS + ((size_t)(li * NS + seq) * GH + vh) * GDK * GDV : c.p.out + O_PGS + ((size_t)(li * NB + seq) * GH + vh) * GDK * GDV) + (size_t)(64 * half) * GDV + col;
#pragma unroll
            for (int k = 0; k < 64; ++k) so[(size_t)k * GDV] = S[k]; }
        __syncthreads();
    }
}

constexpr size_t W_KCD = W_GO;
constexpr size_t W_U0 = W_HID;
constexpr size_t W_GC = W_HID + (size_t)67108864;
constexpr size_t W_QB = W_H;
constexpr size_t W_ATTG = W_Y;
constexpr size_t W_KT = W_Y + (size_t)33554432;
constexpr int GA_LDS = 20000;
constexpr int GCH = SEQ / 64;

DI bf16x8 gfrag_f32(const float* p) { return pack8(*(const f32x4*)p, *(const f32x4*)(p + 4)); }

DI void gdn_a_item(const Ctx& c, int li, int item) {
    const bf16_t* ACTB = c.ws<bf16_t>(W_ACT); const float* AUX = c.ws<float>(W_AUX);
    const int ch = item & (GCH - 1), vh = (item >> 6) & 15, b = item >> 10, hq = vh >> 1, tok0 = b * SEQ + ch * 64;
    int lane_ = c.lane; asm volatile("" : "+v"(lane_));
    const int lane = lane_, fr = lane & 15, fq = lane >> 4;
    LAS unsigned char* wl = c.lds + c.wave * GA_LDS;
    LAS float* As = (LAS float*)wl; LAS bf16_t* Ts = (LAS bf16_t*)wl; LAS bf16_t* KsT = (LAS bf16_t*)wl;
    LAS float* gcS = (LAS float*)(wl + 17408); LAS float* btS = gcS + 64; LAS float* beS = gcS + 128;
    bf16_t* KCDg = c.ws<bf16_t>(W_KCD) + (size_t)item * 8192; bf16_t* ATTg = c.ws<bf16_t>(W_ATTG) + (size_t)item * 4096; bf16_t* U0g = c.ws<bf16_t>(W_U0) + (size_t)item * 8192;
    const int qitem = (b * GQH + hq) * GCH + ch;
    { const float gi = AUX[(size_t)(tok0 + lane) * 32 + 16 + vh], bi = AUX[(size_t)(tok0 + lane) * 32 + vh];
      float gc = gi;
#pragma unroll
      for (int o = 1; o < 64; o <<= 1) { const float t = __shfl_up(gc, o); if (lane >= o) gc += t; }
      gcS[lane] = gc; btS[lane] = bi; beS[lane] = bi * __expf(gc); c.ws<float>(W_GC)[(size_t)(tok0 + lane) * 16 + vh] = gc; }
    LDS_WAIT();
    {
        bf16x8 kf[4][4], qfa[4][4];
#pragma unroll
        for (int t = 0; t < 4; ++t)
#pragma unroll
            for (int ks = 0; ks < 4; ++ks) { const bf16_t* rp = ACTB + (size_t)(tok0 + 16 * t + fr) * 4096 + hq * 128 + 32 * ks + 8 * fq; kf[t][ks] = *(const bf16x8*)(rp + 1024); qfa[t][ks] = *(const bf16x8*)rp; }
#pragma unroll
        for (int it = 0; it < 4; ++it) {
            const int i = 16 * it + fr; const float gci = gcS[i], bti = btS[i];
#pragma unroll
            for (int jt = 0; jt < 4; ++jt) {
                bf16_t* ap = ATTg + (unsigned)(i * 64 + 16 * jt + 4 * fq);
                if (jt > it) { *(unsigned long long*)ap = 0ull; continue; }
                f32x4 kk = (f32x4){0.f, 0.f, 0.f, 0.f}, qk = (f32x4){0.f, 0.f, 0.f, 0.f};
#pragma unroll
                for (int ks = 0; ks < 4; ++ks) { kk = __builtin_amdgcn_mfma_f32_16x16x32_bf16(kf[jt][ks], kf[it][ks], kk, 0, 0, 0); qk = __builtin_amdgcn_mfma_f32_16x16x32_bf16(kf[jt][ks], qfa[it][ks], qk, 0, 0, 0); }
                f32x4 av, tv;
#pragma unroll
                for (int r = 0; r < 4; ++r) { const int j = 16 * jt + 4 * fq + r; const float dec = __expf(gci - gcS[j]); av[r] = j < i ? bti * kk[r] * dec : 0.f; tv[r] = j <= i ? qk[r] * dec : 0.f; }
                *(LAS f32x4*)(As + i * 64 + 16 * jt + 4 * fq) = av;
                *(unsigned long long*)ap = (unsigned long long)pk2(tv[0], tv[1]) | ((unsigned long long)pk2(tv[2], tv[3]) << 32);
            }
        }
    }
    LDS_WAIT();
    float Tr[64];
#pragma unroll
    for (int i = 0; i < 64; ++i) {
        float acc = lane == i ? 1.f : 0.f;
#pragma unroll
        for (int j = 0; j < i; ++j) acc -= As[i * 64 + j] * Tr[j];
        Tr[i] = acc;
    }
    LDS_WAIT();
#pragma unroll
    for (int i = 0; i < 64; ++i) Ts[i * 72 + lane] = f2bf(Tr[i]);
    LDS_WAIT();
    {
        bf16x8 tfp[4][2], idf[2];
#pragma unroll
        for (int it = 0; it < 4; ++it)
#pragma unroll
            for (int ks = 0; ks < 2; ++ks) tfp[it][ks] = lds_frag2(Ts + (16 * it + fr) * 72 + 32 * ks + 4 * fq, Ts + (16 * it + fr) * 72 + 32 * ks + 16 + 4 * fq);
#pragma unroll
        for (int hs = 0; hs < 2; ++hs)
#pragma unroll
            for (int e = 0; e < 8; ++e) idf[hs][e] = (8 * fq + e) == (16 * hs + fr) ? (short)0x3F80 : (short)0;
        bf16_t* KTg = c.ws<bf16_t>(W_KT) + (size_t)qitem * 8192;
        const bool wr_k = (vh & 1) == 0;
        const bf16_t* AK = ACTB + (size_t)tok0 * 4096 + 1024 + hq * 128; const bf16_t* AV = ACTB + (size_t)tok0 * 4096 + 2048 + vh * 128;
        bf16x8 vfn[4], kfn[4];
#pragma unroll
        for (int t = 0; t < 4; ++t) { vfn[t] = *(const bf16x8*)(AV + (size_t)(16 * t + fr) * 4096 + 8 * fq); kfn[t] = *(const bf16x8*)(AK + (size_t)(16 * t + fr) * 4096 + 8 * fq); }
#pragma unroll 1
        for (int cc = 0; cc < 4; ++cc) {
            bf16x8 vf[4], kf2[4];
#pragma unroll
            for (int t = 0; t < 4; ++t) { vf[t] = vfn[t]; kf2[t] = kfn[t]; }
            if (cc + 1 < 4) {
#pragma unroll
                for (int t = 0; t < 4; ++t) { vfn[t] = *(const bf16x8*)(AV + (size_t)(16 * t + fr) * 4096 + 32 * (cc + 1) + 8 * fq); kfn[t] = *(const bf16x8*)(AK + (size_t)(16 * t + fr) * 4096 + 32 * (cc + 1) + 8 * fq); }
            }
#pragma unroll
            for (int hs = 0; hs < 2; ++hs) {
                const int nt = 2 * cc + hs;
                f32x4 dvv[4], dkk[4];
#pragma unroll
                for (int t = 0; t < 4; ++t) {
                    const f32x4 z = (f32x4){0.f, 0.f, 0.f, 0.f};
                    dvv[t] = __builtin_amdgcn_mfma_f32_16x16x32_bf16(vf[t], idf[hs], z, 0, 0, 0);
                    dkk[t] = __builtin_amdgcn_mfma_f32_16x16x32_bf16(kf2[t], idf[hs], z, 0, 0, 0);
                    if (wr_k) *(unsigned long long*)(KTg + (unsigned)((16 * nt + fr) * 64 + 16 * t + 4 * fq)) = (unsigned long long)pk2(dkk[t][0], dkk[t][1]) | ((unsigned long long)pk2(dkk[t][2], dkk[t][3]) << 32);
                    const f32x4 bt = *(const LAS f32x4*)(btS + 16 * t + 4 * fq), be = *(const LAS f32x4*)(beS + 16 * t + 4 * fq);
                    dvv[t] *= bt; dkk[t] *= be;
                }
                f32x4 au[4], ak[4];
#pragma unroll
                for (int it = 0; it < 4; ++it) { au[it] = (f32x4){0.f, 0.f, 0.f, 0.f}; ak[it] = (f32x4){0.f, 0.f, 0.f, 0.f}; }
#pragma unroll
                for (int ks = 0; ks < 2; ++ks) {
                    const bf16x8 vfrag = pack8(dvv[2 * ks], dvv[2 * ks + 1]), kfrag = pack8(dkk[2 * ks], dkk[2 * ks + 1]);
#pragma unroll
                    for (int it = 0; it < 4; ++it) { au[it] = __builtin_amdgcn_mfma_f32_16x16x32_bf16(tfp[it][ks], vfrag, au[it], 0, 0, 0);
                                                     ak[it] = __builtin_amdgcn_mfma_f32_16x16x32_bf16(kfrag, tfp[it][ks], ak[it], 0, 0, 0); }
                }
#pragma unroll
                for (int it = 0; it < 4; ++it) {
                    *(unsigned long long*)(U0g + (unsigned)(((nt * 4 + it) * 64 + lane) * 4)) = (unsigned long long)pk2(au[it][0], au[it][1]) | ((unsigned long long)pk2(au[it][2], au[it][3]) << 32);
                    *(unsigned long long*)(KCDg + (unsigned)((16 * it + fr) * 128 + 16 * nt + 4 * fq)) = (unsigned long long)pk2(ak[it][0], ak[it][1]) | ((unsigned long long)pk2(ak[it][2], ak[it][3]) << 32);
                }
            }
        }
    }
    LDS_WAIT();
}

constexpr int GS_KCD = 0, GS_QB = 17408, GS_ATT = 34816, GS_KT = 44032, GS_GC = 62464, GS_BUF = 62720;
DI bf16x8 fragA(const LAS unsigned char* p) { const u32x2 x = *(const volatile LAS u32x2*)p, y = *(const volatile LAS u32x2*)(p + 128);     u32x4 r; r.x = x.x; r.y = x.y; r.z = y.x; r.w = y.y; return __builtin_bit_cast(bf16x8, r); }
DI bf16x8 fragB(const LAS unsigned char* p) { const u32x2 x = *(const volatile LAS u32x2*)p, y = *(const volatile LAS u32x2*)(p + 256); u32x4 r; r.x = x.x; r.y = x.y; r.z = y.x; r.w = y.y; return __builtin_bit_cast(bf16x8, r); }
DI void gdn_scan_wg(const Ctx& c, int li, int bvh) {
    const int vh = bvh & 15, b = bvh >> 4, hq = vh >> 1, lane = c.lane, fr = lane & 15, fq = lane >> 4, w = c.wave, tid = c.tid;
    const bf16_t* KCDg = c.ws<bf16_t>(W_KCD) + (size_t)(bvh * GCH) * 8192; const bf16_t* ATTg = c.ws<bf16_t>(W_ATTG) + (size_t)(bvh * GCH) * 4096;
    const bf16_t* U0g = c.ws<bf16_t>(W_U0) + (size_t)(bvh * GCH) * 8192;
    const bf16_t* QBg = c.ws<bf16_t>(W_ACT) + (size_t)(b * SEQ) * 4096 + hq * 128; const bf16_t* KTg = c.ws<bf16_t>(W_KT) + (size_t)((b * GQH + hq) * GCH) * 8192;
    const float* GCg = c.ws<float>(W_GC); bf16_t* MIX = c.ws<bf16_t>(W_MIXED); const bf16_t* PROJ = c.ws<bf16_t>(W_PROJ);
    LAS float* OT = (LAS float*)(c.lds + 2 * GS_BUF);
    LAS float* nwS = OT + 64 * 132;
    if (tid < GDV) nwS[tid] = c.in(I_GNW)[li * GDV + tid];
#define GS_DMA(tn, bb) do { \
        LAS unsigned char* lb_ = c.lds + (bb) * GS_BUF; \
        _Pragma("unroll") for (int k = 0; k < 2; ++k) { const int p_ = 8 * k + w; \
            __builtin_amdgcn_global_load_lds((const unsigned*)(KCDg + (size_t)(tn) * 8192 + p_ * 512 + srcA), (LAS unsigned*)(lb_ + GS_KCD + p_ * 1088), 16, 0, 0); \
            __builtin_amdgcn_global_load_lds((const unsigned*)(QBg + (size_t)(tn) * (64 * 4096) + p_ * (4 * 4096) + srcQ), (LAS unsigned*)(lb_ + GS_QB + p_ * 1088), 16, 0, 0); \
            __builtin_amdgcn_global_load_lds((const unsigned*)(KTg + (size_t)(tn) * 8192 + p_ * 512 + srcB), (LAS unsigned*)(lb_ + GS_KT + p_ * 1152), 16, 0, 0); } \
        __builtin_amdgcn_global_load_lds((const unsigned*)(ATTg + (size_t)(tn) * 4096 + w * 512 + srcB), (LAS unsigned*)(lb_ + GS_ATT + w * 1152), 16, 0, 0); } while (0)
    const int srcA = (lane & 3) * 128 + 8 * (lane >> 2), srcQ = (lane & 3) * 4096 + 8 * (lane >> 2), srcB = (lane & 7) * 64 + 8 * (lane >> 3);
    const int offA = (fr >> 2) * 1088 + (fr & 3) * 16 + (fq >> 1) * 64 + 8 * (fq & 1), offB = (fr >> 3) * 1152 + (fr & 7) * 16 + (fq >> 1) * 128 + 8 * (fq & 1);
    f32x4 sacc[8];
#pragma unroll
    for (int t = 0; t < 8; ++t) sacc[t] = (f32x4){0.f, 0.f, 0.f, 0.f};
    __syncthreads();
    u32x2 u0n[4];
#pragma unroll
    for (int it = 0; it < 4; ++it) u0n[it] = *(const u32x2*)(U0g + ((size_t)(w * 4 + it) * 64 + lane) * 4);
    GS_DMA(0, 0);
    if (tid < 64) *(LAS float*)(c.lds + GS_GC + 4 * tid) = GCg[(size_t)(b * SEQ + tid) * 16 + vh];
    asm volatile("s_waitcnt vmcnt(0)" ::: "memory");
    __syncthreads();
#pragma unroll 1
    for (int t = 0; t < GCH; ++t) {
        const LAS unsigned char* buf = c.lds + (t & 1) * GS_BUF; LAS unsigned char* nbuf = c.lds + ((t + 1) & 1) * GS_BUF;
        const int tok0 = b * SEQ + t * 64;
        const bool more = t + 1 < GCH;
        u32x2 u0r[4];
#pragma unroll
        for (int it = 0; it < 4; ++it) u0r[it] = u0n[it];
        float gstg = 0.f;
        if (more) {
#pragma unroll
            for (int it = 0; it < 4; ++it) u0n[it] = *(const u32x2*)(U0g + (size_t)(t + 1) * 8192 + ((size_t)(w * 4 + it) * 64 + lane) * 4);
            if (tid < 64) gstg = GCg[(size_t)(tok0 + 64 + tid) * 16 + vh];
            GS_DMA(t + 1, (t + 1) & 1);
        }
        const LAS unsigned char* KCD = buf + GS_KCD; const LAS unsigned char* QB = buf + GS_QB; const LAS unsigned char* ATT = buf + GS_ATT; const LAS unsigned char* KT = buf + GS_KT;
        const LAS float* gcS = (const LAS float*)(buf + GS_GC);
        bf16x8 sfrag[4];
#pragma unroll
        for (int ks = 0; ks < 4; ++ks) sfrag[ks] = pack8(sacc[2 * ks], sacc[2 * ks + 1]);
        const float gl = gcS[63], egl = __expf(gl);
        bf16x8 ufrag[2], udfrag[2]; f32x4 ov[4];
#pragma unroll
        for (int hp = 0; hp < 2; ++hp) {
            f32x4 uu[2];
#pragma unroll
            for (int h2 = 0; h2 < 2; ++h2) {
                const int it = 2 * hp + h2;
                f32x4 ks_ = (f32x4){0.f, 0.f, 0.f, 0.f}, qs_ = (f32x4){0.f, 0.f, 0.f, 0.f};
#pragma unroll
                for (int ks = 0; ks < 4; ++ks) {
                    ks_ = __builtin_amdgcn_mfma_f32_16x16x32_bf16(fragA(KCD + offA + it * 4352 + ks * 256), sfrag[ks], ks_, 0, 0, 0);
                    qs_ = __builtin_amdgcn_mfma_f32_16x16x32_bf16(fragA(QB + offA + it * 4352 + ks * 256), sfrag[ks], qs_, 0, 0, 0);
                }
                const f32x4 gci = *(const LAS f32x4*)(gcS + 16 * it + 4 * fq);
                f32x4 u;
                u[0] = bf2f((bf16_t)(u0r[it].x & 0xffff)) - ks_[0]; u[1] = bf2f((bf16_t)(u0r[it].x >> 16)) - ks_[1]; u[2] = bf2f((bf16_t)(u0r[it].y & 0xffff)) - ks_[2]; u[3] = bf2f((bf16_t)(u0r[it].y >> 16)) - ks_[3];
                uu[h2] = u;
#pragma unroll
                for (int r = 0; r < 4; ++r) ov[it][r] = qs_[r] * __expf(gci[r]);
            }
            ufrag[hp] = pack8(uu[0], uu[1]);
            const f32x4 g0 = *(const LAS f32x4*)(gcS + 32 * hp + 4 * fq), g1 = *(const LAS f32x4*)(gcS + 32 * hp + 16 + 4 * fq);
            f32x4 d0, d1;
#pragma unroll
            for (int r = 0; r < 4; ++r) { d0[r] = uu[0][r] * __expf(gl - g0[r]); d1[r] = uu[1][r] * __expf(gl - g1[r]); }
            udfrag[hp] = pack8(d0, d1);
        }
#pragma unroll
        for (int it = 0; it < 4; ++it) {
            f32x4 au = ov[it];
#pragma unroll
            for (int ks = 0; ks < 2; ++ks) au = __builtin_amdgcn_mfma_f32_16x16x32_bf16(fragB(ATT + offB + it * 2304 + ks * 512), ufrag[ks], au, 0, 0, 0);
#pragma unroll
            for (int r = 0; r < 4; ++r) OT[(16 * it + 4 * fq + r) * 132 + 16 * w + fr] = au[r];
        }
        LDS_WAIT(); __builtin_amdgcn_s_barrier(); asm volatile("" ::: "memory");
        const int frow = tid >> 3, fc = tid & 7;
        const u32x4 zlo = *(const u32x4*)(PROJ + (size_t)(tok0 + frow) * GDN_MAIN + 4096 + vh * 128 + 16 * fc), zhi = *(const u32x4*)(PROJ + (size_t)(tok0 + frow) * GDN_MAIN + 4096 + vh * 128 + 16 * fc + 8);
#pragma unroll
        for (int tt = 0; tt < 8; ++tt) {
            f32x4 a = sacc[tt] * egl;
#pragma unroll
            for (int ks = 0; ks < 2; ++ks) a = __builtin_amdgcn_mfma_f32_16x16x32_bf16(fragB(KT + offB + tt * 2304 + ks * 512), udfrag[ks], a, 0, 0, 0);
            sacc[tt] = a;
        }
        {
            float ov16[16], zf[16];
#pragma unroll
            for (int q4 = 0; q4 < 4; ++q4) { const f32x4 v = *(const LAS f32x4*)(OT + frow * 132 + 16 * fc + 4 * q4); ov16[4 * q4] = v.x; ov16[4 * q4 + 1] = v.y; ov16[4 * q4 + 2] = v.z; ov16[4 * q4 + 3] = v.w; }
            float ss = 0.f;
#pragma unroll
            for (int e = 0; e < 16; ++e) ss += ov16[e] * ov16[e];
            ss += __shfl_xor(ss, 1); ss += __shfl_xor(ss, 2); ss += __shfl_xor(ss, 4);
            const float rn = rsqrtf(ss * (1.f / 128.f) + EPS);
            unpack8(zlo, zf); unpack8(zhi, zf + 8);
            float res[16];
#pragma unroll
            for (int e = 0; e < 16; ++e) res[e] = ov16[e] * rn * nwS[16 * fc + e] * siluf(zf[e]);
            u32x4 o0, o1; o0.x = pk2(res[0], res[1]); o0.y = pk2(res[2], res[3]); o0.z = pk2(res[4], res[5]); o0.w = pk2(res[6], res[7]);
            o1.x = pk2(res[8], res[9]); o1.y = pk2(res[10], res[11]); o1.z = pk2(res[12], res[13]); o1.w = pk2(res[14], res[15]);
            bf16_t* mp = MIX + (size_t)(tok0 + frow) * GVW + vh * 128 + 16 * fc;
            *(u32x4*)mp = o0; *(u32x4*)(mp + 8) = o1;
        }
        if (more && tid < 64) *(LAS float*)(nbuf + GS_GC + 4 * tid) = gstg;
        asm volatile("s_waitcnt vmcnt(0)" ::: "memory");
        __syncthreads();
    }
#undef GS_DMA
    float* so = c.p.out + O_PGS + ((size_t)(li * NB + b) * GH + vh) * GDK * GDV;
#pragma unroll
    for (int tt = 0; tt < 8; ++tt)
#pragma unroll
        for (int r = 0; r < 4; ++r) so[(size_t)(16 * tt + 4 * fq + r) * GDV + 16 * w + fr] = sacc[tt][r];
}

DI void gdn_post_token(const Ctx& c, int li, int tok) {
    const bf16_t* PROJ = c.ws<bf16_t>(W_PROJ); const float* Y = c.ws<float>(W_Y); bf16_t* MIX = c.ws<bf16_t>(W_MIXED);
    const float* nw = c.in(I_GNW) + (size_t)li * GDV; const int lane = c.lane;
#pragma unroll 1
    for (int it = 0; it < 4; ++it) {
        const int ch0 = 512 * it + 8 * lane; float o[8], z[8], w[8];
        load8f(Y + (size_t)tok * 2048 + ch0, o); unpack8(*(const u32x4*)(PROJ + (size_t)tok * GDN_MAIN + 4096 + ch0), z); load8f(nw + (ch0 & 127), w);
        float ss = 0.f;
#pragma unroll
        for (int e = 0; e < 8; ++e) ss += o[e] * o[e];
        ss += __shfl_xor(ss, 1); ss += __shfl_xor(ss, 2); ss += __shfl_xor(ss, 4); ss += __shfl_xor(ss, 8);
        const float r = rsqrtf(ss * (1.f / 128.f) + EPS);
        u32x4 ov; ov.x = pk2(o[0] * r * w[0] * siluf(z[0]), o[1] * r * w[1] * siluf(z[1])); ov.y = pk2(o[2] * r * w[2] * siluf(z[2]), o[3] * r * w[3] * siluf(z[3]));
        ov.z = pk2(o[4] * r * w[4] * siluf(z[4]), o[5] * r * w[5] * siluf(z[5])); ov.w = pk2(o[6] * r * w[6] * siluf(z[6]), o[7] * r * w[7] * siluf(z[7]));
        *(u32x4*)(MIX + (size_t)tok * GVW + ch0) = ov;
    }
}

DI void cache_copy(const Ctx& c, int wg, int nwg) {
    const size_t gt = (size_t)wg * NTHR + c.tid, gn = (size_t)nwg * NTHR;
    const size_t per = (size_t)(WIN - 1) * AW / 4, tot = (size_t)2 * NS * per;
#pragma unroll 4
    for (size_t i = gt; i < tot; i += gn) { const size_t sq = i / per, r = i % per;
        ((f32x4*)(c.p.out + O_SK + sq * WIN * AW))[r] = ((const f32x4*)(c.in(I_CK) + sq * WIN * AW + AW))[r];
        ((f32x4*)(c.p.out + O_SV + sq * WIN * AW))[r] = ((const f32x4*)(c.in(I_CV) + sq * WIN * AW + AW))[r]; }
}
DI void weights_half(const Ctx& c, int half, int gw0, int ngw0) {
    const int i = half;
    transpose_mat(c, c.in(I_WHIN) + (size_t)i * D * HYB_IN, D, HYB_IN, c.ws<bf16_t>(W_HIN) + (size_t)i * HYB_IN * D, 0, gw0, ngw0);
    transpose_mat(c, c.in(I_WHOUT) + (size_t)i * HYB_MIX * D, HYB_MIX, D, c.ws<bf16_t>(W_HOUT) + (size_t)i * D * HYB_MIX, 0, gw0, ngw0);
    transpose_mat(c, c.in(I_WGIN) + (size_t)i * D * GDN_IN, D, GDN_IN, c.ws<bf16_t>(W_GIN) + (size_t)i * GDN_IN * D, 0, gw0, ngw0);
    transpose_mat(c, c.in(I_WGOUT) + (size_t)i * GVW * D, GVW, D, c.ws<bf16_t>(W_GOUT) + (size_t)i * D * GVW, 0, gw0, ngw0);
    for (int l = 2 * half; l < 2 * half + 2; ++l) {
        transpose_mat(c, c.in(I_WFG) + (size_t)l * D * FF, D, FF, c.ws<bf16_t>(W_GU) + (size_t)l * 2 * FF * D, 1, gw0, ngw0);
        transpose_mat(c, c.in(I_WFU) + (size_t)l * D * FF, D, FF, c.ws<bf16_t>(W_GU) + (size_t)l * 2 * FF * D, 2, gw0, ngw0);
        transpose_mat(c, c.in(I_WFD) + (size_t)l * FF * D, FF, D, c.ws<bf16_t>(W_DN) + (size_t)l * D * FF, 0, gw0, ngw0);
    }
}
constexpr int PH_PER_LAYER = 10, N_PHASES = 1 + 2 * 10 + 2 * 8;
DI void phase_decode(int ph, int& l, int& sp) {
    int q = ph - 1; l = 0; if (q >= 10) { q -= 10; l = 1; if (q >= 8) { q -= 8; l = 2; if (q >= 10) { q -= 10; l = 3; } } }
    sp = (l & 1) ? (q >= 3 ? q + 2 : (q == 2 ? 3 : q)) : q;
}
#ifndef ONLY
#define ONLY -1
#endif
#define EN(x) (ONLY < 0 || ONLY == (x))
DI void run_phase(const Ctx& c, int ph) {
    if (ph == 0) { if (!EN(0)) return;
        weights_half(c, 0, -1, 0);
        rowpass_phase(c, 0, nullptr, c.in(I_NMPRE), true);
        return;
    }
    int l, sp; phase_decode(ph, l, sp); const int li = l >> 1; const bool hyb = (l & 1) == 0;
    bf16_t* H = c.ws<bf16_t>(W_H); bf16_t* PROJ = c.ws<bf16_t>(W_PROJ); bf16_t* MIX = c.ws<bf16_t>(W_MIXED); bf16_t* GO = c.ws<bf16_t>(W_GO); bf16_t* HID = c.ws<bf16_t>(W_HID);
    switch (sp) {
    case 0: {
        if (!EN(1)) break;
        const bf16_t* Wt = hyb ? c.ws<bf16_t>(W_HIN) + (size_t)li * HYB_IN * D : c.ws<bf16_t>(W_GIN) + (size_t)li * GDN_IN * D;
        const int nmain = hyb ? HYB_MAIN : GDN_MAIN, nall = hyb ? HYB_IN : GDN_IN;
        { pg8::Gemm g{H, Wt, T, nmain, D}; pg8::StaticOrder S; S.init(T, nmain, gridDim.x, blockIdx.x); pg8::EpiBf16Perm E{PROJ, nmain};
          pg8::gemm_phase<pg8::EpiBf16Perm, pg8::StaticOrder>(c.lds, g, S, E, nullptr); }
        { Epi e{0, PROJ, c.ws<float>(W_EXTRA), nmain, 0}; gemm_ksplit<4>(c, H, D, T, Wt + (size_t)nmain * D, D, nall - nmain, D, e); }
        { Epi e{0, PROJ + (size_t)T * nmain, c.ws<float>(W_EXTRA) + (size_t)T * 32, nmain, nmain}; gemm_ksplit<2>(c, H + (size_t)T * D, D, NS, Wt, D, nall, D, e); }
    } break;
    case 1: {
        if (hyb) {
            if (EN(2)) for (int tok = c.gw; tok < TT; tok += c.ngw) hyb_pre_token(c, li, tok);
            LAS float* pl = (LAS float*)(c.lds + NWAVE * AT_LDS + c.wave * 2048);
            if (EN(3)) { if (c.wave == 0) for (int it = T * AH + blockIdx.x; it < TT * AH; it += gridDim.x) attn_wave(c, li, it / AH, it % AH, pl);
                         for (int it = c.gw; it < NB * AH * 256; it += c.ngw) attn_mfma_item(c, li, it); }
        } else { if (EN(4)) {
            for (int tok = T + c.gw; tok < TT; tok += c.ngw) gdn_pre_token(c, li, tok);
            for (int rg = blockIdx.x; rg < T / 64; rg += gridDim.x) {
                gdn_pre_range(c, li, rg * 8 + c.wave);
                asm volatile("s_waitcnt vmcnt(0)" ::: "memory"); __syncthreads();
                const int bb = rg >> 6, ch = rg & 63;
#pragma unroll 1
                for (int k2 = 0; k2 < 2; ++k2) gdn_a_item(c, li, ((bb * GH + 2 * c.wave + k2) << 6) + ch);
                __syncthreads();
            } } }
    } break;
    case 2: {
        if (hyb) { if (EN(5)) { for (int it = blockIdx.x; it < NB * NCH * 2; it += gridDim.x) ssd_a_item(c, li, it);
                                for (int it = c.gw; it < NS * SH; it += c.ngw) ssd_sample_item(c, li, it); } }
        else { }
    } break;
    case 3: {
        if (hyb) { if (EN(7)) { ssd_scan_phase(c, li); for (int tok = T + c.gw; tok < TT; tok += c.ngw) hyb_post_token(c, li, tok); } }
        else { if (EN(8)) { for (int it = blockIdx.x; it < NB * GH; it += gridDim.x) gdn_scan_wg(c, li, it);
                            if ((int)blockIdx.x >= NB * GH) { gdn_seq_phase(c, li, NB * GH, blockIdx.x - NB * GH, gridDim.x - NB * GH);
                                                              if (l == 1) { cache_copy(c, blockIdx.x - NB * GH, gridDim.x - NB * GH);
                                                                            weights_half(c, 1, (blockIdx.x - NB * GH) * NWAVE + c.wave, (gridDim.x - NB * GH) * NWAVE); } } } }
    } break;
    case 4: {
        if (hyb) { if (EN(14)) for (int it = blockIdx.x; it < NB * NCH * 2; it += gridDim.x) ssd_b_item(c, li, it); }
    } break;
    case 5: {
        if (!EN(9)) break;
        const bf16_t* Wt = hyb ? c.ws<bf16_t>(W_HOUT) + (size_t)li * D * HYB_MIX : c.ws<bf16_t>(W_GOUT) + (size_t)li * D * GVW; const int kk = hyb ? HYB_MIX : GVW;
        { pg8::Gemm g{MIX, Wt, T, D, kk}; pg8::StaticOrder S; S.init(T, D, gridDim.x, blockIdx.x); pg8::EpiBf16Perm E{GO, D};
          pg8::gemm_phase<pg8::EpiBf16Perm, pg8::StaticOrder>(c.lds, g, S, E, nullptr); }
        { Epi e{0, GO + (size_t)T * D, nullptr, D, D}; gemm_ksplit<2>(c, MIX + (size_t)T * kk, kk, NS, Wt, kk, D, kk, e); }
    } break;
    case 6: if (EN(10)) rowpass_phase(c, 1, c.in(I_NMPOST) + (size_t)l * D, c.in(I_NFPRE) + (size_t)l * D, l == 0); break;
    case 7: if (EN(11)) { const bf16_t* Wt = c.ws<bf16_t>(W_GU) + (size_t)l * 2 * FF * D;
        { pg8::Gemm g{H, Wt, T, 2 * FF, D}; pg8::StaticOrder S; S.init(T, 2 * FF, gridDim.x, blockIdx.x); pg8::EpiSwiglu E{HID, FF};
          pg8::gemm_phase<pg8::EpiSwiglu, pg8::StaticOrder>(c.lds, g, S, E, nullptr); }
        { Epi e{2, HID + (size_t)T * FF, nullptr, FF, 0}; gemm_ksplit<2>(c, H + (size_t)T * D, D, NS, Wt, D, 2 * FF, D, e); } } break;
    case 8: if (EN(12)) { const bf16_t* Wt = c.ws<bf16_t>(W_DN) + (size_t)l * D * FF;
        { pg8::Gemm g{HID, Wt, T, D, FF}; pg8::StaticOrder S; S.init(T, D, gridDim.x, blockIdx.x); pg8::EpiBf16Perm E{GO, D};
          pg8::gemm_phase<pg8::EpiBf16Perm, pg8::StaticOrder>(c.lds, g, S, E, nullptr); }
        { Epi e{0, GO + (size_t)T * D, nullptr, D, D}; gemm_ksplit<2>(c, HID + (size_t)T * FF, FF, NS, Wt, FF, D, FF, e); } } break;
    case 9: if (EN(13)) rowpass_phase(c, l == DEPTH - 1 ? 2 : 1, c.in(I_NFPOST) + (size_t)l * D, l == DEPTH - 1 ? nullptr : c.in(I_NMPRE) + (size_t)(l + 1) * D, false); break;
    default: break;
    }
}

extern __shared__ __attribute__((aligned(16))) unsigned char g_shm[];
__global__ void __launch_bounds__(NTHR, 2) mega(Params p) {
    cg::grid_group grid = cg::this_grid();
    volatile LAS unsigned* bst = (volatile LAS unsigned*)((LAS unsigned char*)g_shm + LDS_BYTES - 16);
    if (threadIdx.x == 0) { bst[0] = 0u; bst[1] = 0u; bst[2] = 0u; bst[3] = 0u; }
    __syncthreads();
    const XcdBarrier xb = xcd_barrier_post((unsigned*)p.ws, bst);
    for (int ph = p.ph_lo; ph < p.ph_hi; ++ph) {
        int tid_ = threadIdx.x; asm volatile("" : "+v"(tid_));
        Ctx c; c.p.kp = (KParams)__builtin_amdgcn_kernarg_segment_ptr(); c.p.out = c.p.kp->out; c.tid = tid_; c.lane = tid_ & 63; c.wave = __builtin_amdgcn_readfirstlane(tid_ >> 6);
        c.gw = blockIdx.x * NWAVE + c.wave; c.ngw = gridDim.x * NWAVE; c.lds = (LAS unsigned char*)g_shm;
        run_phase(c, ph);
#ifdef PROBE_MASK
        { int l_ = 0, sp_ = 0; if (ph > 0) phase_decode(ph, l_, sp_); const int bit = ph == 0 ? 20 : sp_ + 10 * (l_ & 1);
          if ((PROBE_MASK >> bit) & 1) { xcd_barrier(xb); run_phase(c, ph); } }
#endif
        if (ph + 1 < p.ph_hi) { if (ph == p.ph_lo) grid.sync(); else xcd_barrier(xb); }
    }
}

extern "C" void kernel_launch(void* const* d_in, const int* in_sizes, int n_in, void* d_out, int out_size, void* d_ws, size_t ws_size, hipStream_t stream) {
    static int grid = 0;
    if (!grid) {
        int dev = 0, cus = 0, per = 0; hipGetDevice(&dev); hipDeviceGetAttribute(&cus, hipDeviceAttributeMultiprocessorCount, dev);
        hipFuncSetAttribute((const void*)mega, hipFuncAttributeMaxDynamicSharedMemorySize, LDS_BYTES);
        hipOccupancyMaxActiveBlocksPerMultiprocessor(&per, (const void*)mega, NTHR, LDS_BYTES);
        if (n_in != 30 || (size_t)out_size != O_END || ws_size < W_END) fprintf(stderr, "kernel_launch: unexpected shapes n_in %d out %d (want %zu) ws %zu (want %zu)\n", n_in, out_size, (size_t)O_END, ws_size, (size_t)W_END);
        if (per < 1) fprintf(stderr, "kernel_launch: occupancy query says %d blocks per CU\n", per);
        grid = cus;
    }
    hipMemsetAsync(d_ws, 0, 16384, stream);
    Params p{}; for (int i = 0; i < 30; ++i) p.in[i] = (const float*)d_in[i];
    p.out = (float*)d_out; p.ws = (unsigned char*)d_ws; p.ph_lo = 0; p.ph_hi = N_PHASES;
    void* args[] = {&p};
    hipError_t e = hipLaunchCooperativeKernel((const void*)mega, dim3(grid), dim3(NTHR), args, LDS_BYTES, stream);
    if (e != hipSuccess) fprintf(stderr, "kernel_launch: cooperative launch failed: %s\n", hipGetErrorString(e));
}
```

```cpp
#include <hip/hip_runtime.h>
#include <hip/hip_cooperative_groups.h>
#include <cstdio>
#include <cstdint>
namespace cg = cooperative_groups;

#define DI __device__ __forceinline__
#define LAS __attribute__((address_space(3)))
typedef unsigned short bf16_t;
typedef short bf16x8 __attribute__((ext_vector_type(8)));
typedef float f32x4 __attribute__((ext_vector_type(4)));
typedef unsigned u32x2 __attribute__((ext_vector_type(2)));
typedef unsigned u32x4 __attribute__((ext_vector_type(4)));

constexpr int D = 1024, NB = 4, SEQ = 4096, T = NB * SEQ, NS = 32, TT = T + NS, DEPTH = 4;
constexpr int AH = 8, AHD = 64, AW = 512, WIN = 2048;
constexpr int SH = 16, SP = 64, SN = 128, SG = 2, SDI = 1024, SXBC = 1536;
constexpr int HYB_IN = 4112, HYB_MAIN = 4096, HYB_MIX = 1536;
constexpr int GH = 16, GQH = 8, GDK = 128, GDV = 128, GQKV = 4096, GVW = 2048, GDN_IN = 6176, GDN_MAIN = 6144;
constexpr int FF = 2816;
constexpr float EPS = 1e-6f;
constexpr int NTHR = 512, NWAVE = 8, LDS_BYTES = 163840;

enum { I_XP = 0, I_XS, I_CK, I_CV, I_SCONV, I_SSM, I_GCONV, I_GST, I_RELB, I_NMPRE, I_NMPOST, I_NFPRE, I_NFPOST, I_WHIN, I_SCW, I_SCB, I_SDTB, I_SALOG, I_SD, I_SNW,
       I_WHOUT, I_WGIN, I_GCW, I_GDTB, I_GALOG, I_GNW, I_WGOUT, I_WFG, I_WFU, I_WFD };

constexpr size_t O_YP = 0;
constexpr size_t O_YS = O_YP + (size_t)T * D;
constexpr size_t O_PK = O_YS + (size_t)NS * D;
constexpr size_t O_PV = O_PK + (size_t)2 * NB * WIN * AW;
constexpr size_t O_PSC = O_PV + (size_t)2 * NB * WIN * AW;
constexpr size_t O_PSS = O_PSC + (size_t)2 * NB * 3 * SXBC;
constexpr size_t O_PGC = O_PSS + (size_t)2 * NB * SH * SP * SN;
constexpr size_t O_PGS = O_PGC + (size_t)2 * NB * 3 * GQKV;
constexpr size_t O_SK = O_PGS + (size_t)2 * NB * GH * GDK * GDV;
constexpr size_t O_SV = O_SK + (size_t)2 * NS * WIN * AW;
constexpr size_t O_SSC = O_SV + (size_t)2 * NS * WIN * AW;
constexpr size_t O_SSS = O_SSC + (size_t)2 * NS * 3 * SXBC;
constexpr size_t O_SGC = O_SSS + (size_t)2 * NS * SH * SP * SN;
constexpr size_t O_SGS = O_SGC + (size_t)2 * NS * 3 * GQKV;
constexpr size_t O_END = O_SGS + (size_t)2 * NS * GH * GDK * GDV;

constexpr size_t al256(size_t x) { return (x + 255) & ~(size_t)255; }
constexpr size_t W_CTL = 0;
constexpr size_t W_HIN = 65536;
constexpr size_t W_HOUT = al256(W_HIN + (size_t)2 * HYB_IN * D * 2);
constexpr size_t W_GIN = al256(W_HOUT + (size_t)2 * D * HYB_MIX * 2);
constexpr size_t W_GOUT = al256(W_GIN + (size_t)2 * GDN_IN * D * 2);
constexpr size_t W_GU = al256(W_GOUT + (size_t)2 * D * GVW * 2);
constexpr size_t W_DN = al256(W_GU + (size_t)4 * 2 * FF * D * 2);
constexpr size_t W_X = al256(W_DN + (size_t)4 * D * FF * 2);
constexpr size_t W_H = al256(W_X + (size_t)TT * D * 4);
constexpr size_t W_PROJ = al256(W_H + (size_t)TT * D * 2);
constexpr size_t W_EXTRA = al256(W_PROJ + (size_t)TT * GDN_MAIN * 2);
constexpr size_t W_MIXED = al256(W_EXTRA + (size_t)TT * 32 * 4);
constexpr size_t W_GO = al256(W_MIXED + (size_t)TT * GVW * 2);
constexpr size_t W_HID = al256(W_GO + (size_t)TT * D * 4);
constexpr size_t W_ACT = al256(W_HID + (size_t)TT * FF * 2);
constexpr size_t W_AUX = al256(W_ACT + (size_t)TT * 4096 * 4);
constexpr size_t W_Y = al256(W_AUX + (size_t)TT * 32 * 4);
constexpr size_t W_END = al256(W_Y + (size_t)TT * 2048 * 4);

struct Params { const float* in[30]; float* out; unsigned char* ws; int ph_lo, ph_hi; };

DI float bf2f(bf16_t b) { return __uint_as_float(((unsigned)b) << 16); }
DI bf16_t f2bf(float x) { const __bf16 b = (__bf16)x; return __builtin_bit_cast(bf16_t, b); }
typedef float f32x2_ __attribute__((ext_vector_type(2))); typedef __bf16 bf16x2_ __attribute__((ext_vector_type(2)));
DI unsigned pk2(float lo, float hi) { const f32x2_ v = {lo, hi}; return __builtin_bit_cast(unsigned, __builtin_convertvector(v, bf16x2_)); }
DI float wave_sum(float v) {
#pragma unroll
    for (int o = 32; o >= 1; o >>= 1) v += __shfl_xor(v, o);
    return v;
}
DI float wave_max(float v) {
#pragma unroll
    for (int o = 32; o >= 1; o >>= 1) v = fmaxf(v, __shfl_xor(v, o));
    return v;
}
DI float siluf(float x) { return x * __builtin_amdgcn_rcpf(1.f + __expf(-x)); }
DI float sigmoidf_(float x) { return __builtin_amdgcn_rcpf(1.f + __expf(-x)); }
DI float softplusf_(float x) { return fmaxf(x, 0.f) + __logf(1.f + __expf(-fabsf(x))); }
#define LDS_WAIT() asm volatile("s_waitcnt lgkmcnt(0)" ::: "memory")
DI bf16x8 lds_frag(const LAS bf16_t* p) { return *(const LAS bf16x8*)p; }
DI bf16x8 lds_frag2(const LAS bf16_t* p0, const LAS bf16_t* p1) {
    const u32x2 a = *(const LAS u32x2*)p0, b = *(const LAS u32x2*)p1; u32x4 r; r.x = a.x; r.y = a.y; r.z = b.x; r.w = b.y; return __builtin_bit_cast(bf16x8, r);
}
DI bf16x8 pack8(const f32x4 a, const f32x4 b) { u32x4 r; r.x = pk2(a.x, a.y); r.y = pk2(a.z, a.w); r.z = pk2(b.x, b.y); r.w = pk2(b.z, b.w); return __builtin_bit_cast(bf16x8, r); }
DI bf16x8 gfrag_f32(const float* p) { return pack8(*(const f32x4*)p, *(const f32x4*)(p + 4)); }

__device__ const unsigned char c_bucket[3][129] = {
 {0,1,2,3,4,5,6,7,8,9,10,11,12,13,14,15,16,16,16,16,16,16,17,17,17,17,17,17,17,17,18,18,18,18,18,18,18,18,18,18,19,19,19,19,19,19,19,19,19,19,19,19,19,19,20,20,20,20,20,20,20,20,20,20,20,20,20,20,20,20,20,20,20,21,21,21,21,21,21,21,21,21,21,21,21,21,21,21,21,21,21,21,21,21,21,21,21,21,21,22,22,22,22,22,22,22,22,22,22,22,22,22,22,22,22,22,22,22,22,22,22,22,22,22,22,22,22,22,22},
 {0,4,8,12,16,16,17,17,18,18,19,19,19,19,20,20,20,20,20,21,21,21,21,21,21,22,22,22,22,22,22,22,22,22,23,23,23,23,23,23,23,23,23,23,23,23,24,24,24,24,24,24,24,24,24,24,24,24,24,24,24,24,25,25,25,25,25,25,25,25,25,25,25,25,25,25,25,25,25,25,25,25,25,26,26,26,26,26,26,26,26,26,26,26,26,26,26,26,26,26,26,26,26,26,26,26,26,26,26,26,26,26,26,27,27,27,27,27,27,27,27,27,27,27,27,27,27,27,27},
 {0,16,18,19,20,21,21,22,22,23,23,23,24,24,24,24,25,25,25,25,25,26,26,26,26,26,26,26,26,27,27,27,27,27,27,27,27,27,27,28,28,28,28,28,28,28,28,28,28,28,28,28,29,29,29,29,29,29,29,29,29,29,29,29,29,29,29,29,29,29,30,30,30,30,30,30,30,30,30,30,30,30,30,30,30,30,30,30,30,30,30,30,30,30,30,31,31,31,31,31,31,31,31,31,31,31,31,31,31,31,31,31,31,31,31,31,31,31,31,31,31,31,31,31,31,31,31,31,31}};

typedef const Params __attribute__((address_space(4)))* KParams;
struct OutRef { float* out; DI float* operator+(size_t o) const { return out + o; } };
struct PRef { KParams kp; float* out; };
#define XB_TMO      128
#define XB_XCNT(j)  (256  + 64 * (j))
#define XB_XSUB(j)  (1280 + 64 * (j))
#define XB_XGEN(j)  (2304 + 64 * (j))
#define XB_TOP      3328
#define XB_TOPGEN   3392
#define XCD_BAR_WORDS 3456
#define XB_SPIN_CAP (1u << 22)

__device__ __forceinline__ unsigned xb_ld(unsigned* p)              { return __hip_atomic_load(p, __ATOMIC_RELAXED, __HIP_MEMORY_SCOPE_AGENT); }
__device__ __forceinline__ unsigned xb_add(unsigned* p, unsigned v) { return __hip_atomic_fetch_add(p, v, __ATOMIC_RELAXED, __HIP_MEMORY_SCOPE_AGENT); }
__device__ __forceinline__ unsigned xb_xcc_id() { return (unsigned)__builtin_amdgcn_s_getreg((3 << 11) | 20) & 0xFu; }
#define XB_SPIN(cond, bar) do { unsigned _sp = 0; while (cond) { __builtin_amdgcn_s_sleep(1); \
    if ((++_sp & 255u) == 0u) { if (xb_ld(&(bar)[XB_TMO])) break; if (_sp > XB_SPIN_CAP) { atomicAdd(&(bar)[XB_TMO], 1u); break; } } } } while (0)

struct XcdBarrier {
    unsigned* bar; unsigned x;
    volatile LAS unsigned* st;
};

__device__ __forceinline__ XcdBarrier xcd_barrier_post(unsigned* bar, volatile LAS unsigned* st) {
    XcdBarrier b; b.bar = bar; b.x = xb_xcc_id(); b.st = st;
    if (threadIdx.x == 0) (void)xb_add(&bar[XB_XCNT(b.x)], 1u);
    return b;
}
__device__ __forceinline__ void xcd_barrier_complete(unsigned* bar, unsigned x, unsigned& nloc, unsigned& nx) {
    const unsigned G = gridDim.x * gridDim.y * gridDim.z;
    unsigned sum, cnt, mine, sp = 0u;
    for (;;) {
        sum = 0u; cnt = 0u; mine = 0u;
#pragma unroll
        for (unsigned j = 0; j < 16; ++j) { const unsigned c = xb_ld(&bar[XB_XCNT(j)]); sum += c; cnt += (c > 0u) ? 1u : 0u; mine = (j == x) ? c : mine; }
        if (sum == G) break;
        __builtin_amdgcn_s_sleep(1);
        if ((++sp & 255u) == 0u) { if (xb_ld(&bar[XB_TMO])) break; if (sp > XB_SPIN_CAP) { atomicAdd(&bar[XB_TMO], 1u); break; } }
    }
    nloc = mine > 0u ? mine : 1u; nx = cnt > 0u ? cnt : 1u;
}

__device__ __forceinline__ void xcd_barrier(const XcdBarrier& b) {
    asm volatile("s_waitcnt vmcnt(0)" ::: "memory");
    __syncthreads();
    if (threadIdx.x == 0) {
        unsigned* bar = b.bar;
        __builtin_amdgcn_s_waitcnt(0);
        unsigned nloc = b.st[0], nx = b.st[1];
        if (nloc == 0u) { xcd_barrier_complete(bar, b.x, nloc, nx); b.st[0] = nloc; b.st[1] = nx; }
        const unsigned old = xb_add(&bar[XB_XSUB(b.x)], 1u);
        const unsigned gen = old / nloc;
        if (old + 1u == (gen + 1u) * nloc) {
            __builtin_amdgcn_fence(__ATOMIC_RELEASE, "agent");
            asm volatile("s_waitcnt vmcnt(0)" ::: "memory");
            const unsigned og = xb_add(&bar[XB_TOP], 1u);
            const unsigned tg = og / nx;
            if (og + 1u == (tg + 1u) * nx) xb_add(&bar[XB_TOPGEN], 1u);
            else XB_SPIN(xb_ld(&bar[XB_TOPGEN]) == tg, bar);
            __builtin_amdgcn_fence(__ATOMIC_ACQUIRE, "agent");
            xb_add(&bar[XB_XGEN(b.x)], 1u);
            asm volatile("s_waitcnt vmcnt(0)" ::: "memory");
        } else {
            XB_SPIN(xb_ld(&bar[XB_XGEN(b.x)]) == gen, bar);
            __builtin_amdgcn_fence(__ATOMIC_ACQUIRE, "agent");
            asm volatile("s_waitcnt vmcnt(0)" ::: "memory");
        }
    }
    __syncthreads();
}

struct Ctx {
    PRef p; int tid, lane, wave, gw, ngw; LAS unsigned char* lds;
    DI const float* in(int i) const { return p.kp->in[i]; }
    template <class Tp> DI Tp* ws(size_t off) const { return (Tp*)(p.kp->ws + off); }
};

DI int rowmap(int n, int map) { return map == 0 ? n : (32 * (n >> 4) + (n & 15) + (map == 2 ? 16 : 0)); }
DI void transpose_item(const float* W, int K, int N, bf16_t* WT, int map, LAS float* scr, int item, int lane) {
    const int nblk = (N + 31) / 32, kb = item / nblk, nb = item % nblk, k0 = 64 * kb, n0 = 32 * nb;
    float wv[32];
#pragma unroll
    for (int i = 0; i < 32; ++i) { const int kk = 2 * i + (lane >> 5), n = n0 + (lane & 31); wv[i] = n < N ? W[(size_t)(k0 + kk) * N + n] : 0.f; }
#pragma unroll
    for (int i = 0; i < 32; ++i) scr[(2 * i + (lane >> 5)) * 33 + (lane & 31)] = wv[i];
    LDS_WAIT();
    const int c = lane & 7;
#pragma unroll
    for (int j = 0; j < 4; ++j) {
        const int nn = (lane >> 3) + 8 * j, n = n0 + nn; const LAS float* s = scr + (8 * c) * 33 + nn;
        u32x4 o; o.x = pk2(s[0], s[33]); o.y = pk2(s[66], s[99]); o.z = pk2(s[132], s[165]); o.w = pk2(s[198], s[231]);
        if (n < N) *(u32x4*)(WT + (size_t)rowmap(n, map) * K + k0 + 8 * c) = o;
    }
    LDS_WAIT();
}
DI void transpose_mat(const Ctx& c, const float* W, int K, int N, bf16_t* WT, int map, int gw0 = -1, int ngw0 = 0) {
    LAS float* scr = (LAS float*)(c.lds + c.wave * 8704);
    const int nit = (K / 64) * ((N + 31) / 32);
    const int g0 = gw0 < 0 ? c.gw : gw0, n0 = gw0 < 0 ? c.ngw : ngw0;
    for (int it = g0; it < nit; it += n0) transpose_item(W, K, N, WT, map, scr, it, c.lane);
}

DI void rowpass_row(const float* xrow, const bf16_t* gorow, const float* gpost, const float* gnext, float* xdst, bf16_t* hrow, float* yout, int lane) {
    f32x4 x[4]; float ss = 0.f;
    if (gorow) {
        f32x4 g[4];
#pragma unroll
        for (int j = 0; j < 4; ++j) { const u32x2 gv = *(const u32x2*)(gorow + 4 * lane + 256 * j); g[j] = (f32x4){bf2f((bf16_t)(gv.x & 0xffff)), bf2f((bf16_t)(gv.x >> 16)), bf2f((bf16_t)(gv.y & 0xffff)), bf2f((bf16_t)(gv.y >> 16))}; ss += g[j].x * g[j].x + g[j].y * g[j].y + g[j].z * g[j].z + g[j].w * g[j].w; }
        const float r = rsqrtf(wave_sum(ss) * (1.f / D) + EPS);
#pragma unroll
        for (int j = 0; j < 4; ++j) { const f32x4 w = *(const f32x4*)(gpost + 4 * lane + 256 * j); x[j] = *(const f32x4*)(xrow + 4 * lane + 256 * j) + g[j] * r * w; }
    } else {
#pragma unroll
        for (int j = 0; j < 4; ++j) x[j] = *(const f32x4*)(xrow + 4 * lane + 256 * j);
    }
    if (xdst) {
#pragma unroll
        for (int j = 0; j < 4; ++j) *(f32x4*)(xdst + 4 * lane + 256 * j) = x[j];
    }
    if (yout) {
#pragma unroll
        for (int j = 0; j < 4; ++j) *(f32x4*)(yout + 4 * lane + 256 * j) = x[j];
    }
    if (hrow) {
        float s2 = 0.f;
#pragma unroll
        for (int j = 0; j < 4; ++j) s2 += x[j].x * x[j].x + x[j].y * x[j].y + x[j].z * x[j].z + x[j].w * x[j].w;
        const float r2 = rsqrtf(wave_sum(s2) * (1.f / D) + EPS);
#pragma unroll
        for (int j = 0; j < 4; ++j) { const f32x4 w = *(const f32x4*)(gnext + 4 * lane + 256 * j); const f32x4 h = x[j] * r2 * w;
            u32x2 o; o.x = pk2(h.x, h.y); o.y = pk2(h.z, h.w); *(u32x2*)(hrow + 4 * lane + 256 * j) = o; }
    }
}
DI void rowpass_rows4(const float* xrow, const bf16_t* gorow, const float* gpost, const float* gnext, float* xdst, bf16_t* hrow, float* yout, int lane) {
    f32x4 x[4][4]; float ss[4] = {0.f, 0.f, 0.f, 0.f};
#pragma unroll
    for (int r = 0; r < 4; ++r)
#pragma unroll
        for (int j = 0; j < 4; ++j) x[r][j] = *(const f32x4*)(xrow + (size_t)r * D + 4 * lane + 256 * j);
    if (gorow) {
        u32x2 gv[4][4];
#pragma unroll
        for (int r = 0; r < 4; ++r)
#pragma unroll
            for (int j = 0; j < 4; ++j) gv[r][j] = *(const u32x2*)(gorow + (size_t)r * D + 4 * lane + 256 * j);
        f32x4 wp[4];
#pragma unroll
        for (int j = 0; j < 4; ++j) wp[j] = *(const f32x4*)(gpost + 4 * lane + 256 * j);
#pragma unroll
        for (int r = 0; r < 4; ++r)
#pragma unroll
            for (int j = 0; j < 4; ++j) { const float a = bf2f((bf16_t)(gv[r][j].x & 0xffff)), b2 = bf2f((bf16_t)(gv[r][j].x >> 16)), c2 = bf2f((bf16_t)(gv[r][j].y & 0xffff)), d2 = bf2f((bf16_t)(gv[r][j].y >> 16)); ss[r] += a * a + b2 * b2 + c2 * c2 + d2 * d2; }
#pragma unroll
        for (int o = 32; o >= 1; o >>= 1) { ss[0] += __shfl_xor(ss[0], o); ss[1] += __shfl_xor(ss[1], o); ss[2] += __shfl_xor(ss[2], o); ss[3] += __shfl_xor(ss[3], o); }
#pragma unroll
        for (int r = 0; r < 4; ++r) { const float rn = rsqrtf(ss[r] * (1.f / D) + EPS);
#pragma unroll
            for (int j = 0; j < 4; ++j) { const f32x4 g = (f32x4){bf2f((bf16_t)(gv[r][j].x & 0xffff)), bf2f((bf16_t)(gv[r][j].x >> 16)), bf2f((bf16_t)(gv[r][j].y & 0xffff)), bf2f((bf16_t)(gv[r][j].y >> 16))}; x[r][j] += g * rn * wp[j]; } }
    }
    if (xdst) {
#pragma unroll
        for (int r = 0; r < 4; ++r)
#pragma unroll
            for (int j = 0; j < 4; ++j) *(f32x4*)(xdst + (size_t)r * D + 4 * lane + 256 * j) = x[r][j];
    }
    if (yout) {
#pragma unroll
        for (int r = 0; r < 4; ++r)
#pragma unroll
            for (int j = 0; j < 4; ++j) *(f32x4*)(yout + (size_t)r * D + 4 * lane + 256 * j) = x[r][j];
    }
    if (hrow) {
        float s2[4];
#pragma unroll
        for (int r = 0; r < 4; ++r) { s2[r] = 0.f;
#pragma unroll
            for (int j = 0; j < 4; ++j) s2[r] += x[r][j].x * x[r][j].x + x[r][j].y * x[r][j].y + x[r][j].z * x[r][j].z + x[r][j].w * x[r][j].w; }
#pragma unroll
        for (int o = 32; o >= 1; o >>= 1) { s2[0] += __shfl_xor(s2[0], o); s2[1] += __shfl_xor(s2[1], o); s2[2] += __shfl_xor(s2[2], o); s2[3] += __shfl_xor(s2[3], o); }
        f32x4 wn[4];
#pragma unroll
        for (int j = 0; j < 4; ++j) wn[j] = *(const f32x4*)(gnext + 4 * lane + 256 * j);
#pragma unroll
        for (int r = 0; r < 4; ++r) { const float r2 = rsqrtf(s2[r] * (1.f / D) + EPS);
#pragma unroll
            for (int j = 0; j < 4; ++j) { const f32x4 h = x[r][j] * r2 * wn[j]; u32x2 o; o.x = pk2(h.x, h.y); o.y = pk2(h.z, h.w); *(u32x2*)(hrow + (size_t)r * D + 4 * lane + 256 * j) = o; } }
    }
}
DI void rowpass_phase(const Ctx& c, int mode, const float* gpost, const float* gnext, bool x_from_input) {
    float* X = c.ws<float>(W_X); const bf16_t* GO = c.ws<bf16_t>(W_GO); bf16_t* H = c.ws<bf16_t>(W_H);
    int lane_ = c.lane; asm volatile("" : "+v"(lane_));
    for (int row = T + c.gw; row < TT; row += c.ngw) {
        const float* xrow = x_from_input ? c.in(I_XS) + (size_t)(row - T) * D : X + (size_t)row * D;
        if (mode == 0) rowpass_row(xrow, nullptr, nullptr, gnext, nullptr, H + (size_t)row * D, nullptr, lane_);
        else if (mode == 1) rowpass_row(xrow, GO + (size_t)row * D, gpost, gnext, X + (size_t)row * D, H + (size_t)row * D, nullptr, lane_);
        else rowpass_row(xrow, GO + (size_t)row * D, gpost, nullptr, nullptr, nullptr, c.p.out + O_YS + (size_t)(row - T) * D, lane_);
    }
    for (int g4 = c.gw; g4 < T / 4; g4 += c.ngw) {
        const int row = 4 * g4;
        const float* xrow = x_from_input ? c.in(I_XP) + (size_t)row * D : X + (size_t)row * D;
        if (mode == 0) rowpass_rows4(xrow, nullptr, nullptr, gnext, nullptr, H + (size_t)row * D, nullptr, lane_);
        else if (mode == 1) rowpass_rows4(xrow, GO + (size_t)row * D, gpost, gnext, X + (size_t)row * D, H + (size_t)row * D, nullptr, lane_);
        else rowpass_rows4(xrow, GO + (size_t)row * D, gpost, nullptr, nullptr, nullptr, c.p.out + O_YP + (size_t)row * D, lane_);
    }
}

namespace pg8 {
#define PG8_LAS __attribute__((address_space(3)))
typedef unsigned short bf16_t;
typedef short bf16x8 __attribute__((ext_vector_type(8)));
typedef float f32x4 __attribute__((ext_vector_type(4)));
typedef unsigned u32x4 __attribute__((ext_vector_type(4)));
constexpr int BM = 256, BK = 64, HALF = 128, HTB = HALF * BK * 2  , STAGE_BYTES = 8 * HTB, NXCD = 8, WGM = 8;

__host__ __device__ __forceinline__ int lds_byte(int r, int c) { const int st = (r >> 4) * 2 + (c >> 5), rr = r & 15, cc = c & 31, ob = rr * 64 + cc * 2; return st * 1024 + (ob ^ (((ob >> 9) & 1) << 5)); }
__host__ __device__ __forceinline__ void stage_rc(int b, int& R, int& C) { const int st = b / 1024, sb = b % 1024, swz = sb ^ (((sb >> 9) & 1) << 5); R = (st >> 1) * 16 + swz / 64; C = (st & 1) * 32 + (swz % 64) / 2; }
__host__ __device__ __forceinline__ int perm32(int rho) { const int n = rho >> 4, i = rho & 15; return 8 * (i >> 2) + 4 * n + (i & 3); }

struct Unit { int pm, pn; };
struct Gemm { const bf16_t* A; const bf16_t* Bt; int M, N, K; };

struct StaticOrder {
    int nM, nN, nwg, G, c;
    __host__ __device__ void init(int M, int N, int G_, int c_) { nM = M / BM; nN = N / BM; nwg = nM * nN; G = G_; c = c_; }
    __host__ __device__ bool next(int i, Unit& u) const {
        const long L = (long)i * G + c; if (L >= nwg) return false;
        int wgid = (int)L; { const int q = nwg / NXCD, r = nwg % NXCD, xcd = wgid % NXCD, off = wgid / NXCD; wgid = (xcd < r ? xcd * (q + 1) : r * (q + 1) + (xcd - r) * q) + off; }
        const int nig = WGM * nN, gid = wgid / nig, fm = gid * WGM, gsz = (nM - fm) < WGM ? (nM - fm) : WGM;
        u.pm = fm + ((wgid % nig) % gsz); u.pn = (wgid % nig) / gsz; return true;
    }
    __device__ __forceinline__ void a_ready(const Unit&) const {}
    __device__ __forceinline__ void done(const Unit&) const {}
};
__device__ __forceinline__ unsigned cvt_pk_bf16(float lo, float hi) { unsigned r; asm volatile("v_cvt_pk_bf16_f32 %0, %1, %2" : "=v"(r) : "v"(lo), "v"(hi)); return r; }
typedef float f32x2 __attribute__((ext_vector_type(2)));
struct EpiF32 {
    static constexpr bool PERM = false, AFTER_DRAIN = false;
    float* C; int ldc; const float* bias;
    __device__ __forceinline__ void operator()(const f32x4 (&acc)[2][2][4][2], const Unit& u, int wr, int wc, int fr, int fq) const {
        const int row0 = u.pm * BM + wr * 64 + fr, col0 = u.pn * BM + wc * 32 + 4 * fq;
        f32x4 bv[2][2];
#pragma unroll
        for (int bj = 0; bj < 2; ++bj)
#pragma unroll
            for (int n = 0; n < 2; ++n) bv[bj][n] = bias ? *(const f32x4*)(bias + col0 + bj * HALF + n * 16) : (f32x4){0.f, 0.f, 0.f, 0.f};
#pragma unroll
        for (int ai = 0; ai < 2; ++ai)
#pragma unroll
            for (int m = 0; m < 4; ++m) { float* rowp = C + (size_t)(row0 + ai * HALF + m * 16) * ldc + col0;
#pragma unroll
                for (int bj = 0; bj < 2; ++bj)
#pragma unroll
                    for (int n = 0; n < 2; ++n) *(f32x4*)(rowp + bj * HALF + n * 16) = acc[ai][bj][m][n] + bv[bj][n]; }
    }
};
template <class Epi, class Sched, bool STAMP = false>
__device__ __forceinline__ void gemm_phase(PG8_LAS unsigned char* lds, const Gemm g, const Sched& S, const Epi& E, unsigned long long* stamps) {
    int tid_ = threadIdx.x; asm volatile("" : "+v"(tid_));
    const int tid = tid_, wid = __builtin_amdgcn_readfirstlane(tid >> 6), lane = tid & 63, wr = wid >> 2, wc = wid & 3, fr = lane & 15, fq = lane >> 4;
    const int K = g.K, nt = K / BK;
    int ts_lo = 0, ts_hi = 0, nts = 0; const unsigned long long rt_entry = STAMP ? (unsigned long long)wall_clock64() : 0ull;
#define PG8_STAMP() do { if (STAMP && wid == 0 && nts < 64) { const unsigned long long _c = (unsigned long long)clock64(); \
        ts_lo = (lane == nts) ? (int)(unsigned)_c : ts_lo; ts_hi = (lane == nts) ? (int)(unsigned)(_c >> 32) : ts_hi; ++nts; } } while (0)
    PG8_STAMP();
    unsigned voffA[2], voffB[2];
#pragma unroll
    for (int i = 0; i < 2; ++i) { int R, C; stage_rc(tid * 16 + i * 8192, R, C); const int Rb = Epi::PERM ? ((R & ~31) + perm32(R & 31)) : R;
        voffA[i] = (unsigned)(R * K + C) * 2u; voffB[i] = (unsigned)(Rb * K + C) * 2u; }
    const size_t kstep = (size_t)(BK * 2);
    const size_t hstep = (size_t)HALF * K * 2;
    const size_t tstep = 2 * hstep;
    const unsigned ldsw = (unsigned)wid * 1024u;
    const int aoff = lds_byte(wr * 64 + fr, fq * 8), boff = lds_byte(wc * 32 + fr, fq * 8);
#define PG8_SA(b, h) (((b) * 2 + (h)) * HTB)
#define PG8_SB(b, h) ((4 + (b) * 2 + (h)) * HTB)
#define PG8_STAGE(bufoff, gbase, voff) do { _Pragma("unroll") for (int _i = 0; _i < 2; ++_i) \
        __builtin_amdgcn_global_load_lds((const unsigned*)((const char*)(gbase) + (voff)[_i]), (PG8_LAS unsigned*)(lds + (bufoff) + ldsw + _i * 8192), 16, 0, 0); } while (0)
#define PG8_LDA(dst, b, h) do { _Pragma("unroll") for (int m = 0; m < 4; ++m) _Pragma("unroll") for (int k = 0; k < 2; ++k) dst[m][k] = *(const PG8_LAS bf16x8*)(lds + PG8_SA(b, h) + aoff + m * 2048 + k * 1024); } while (0)
#define PG8_LDB(dst, b, h) do { _Pragma("unroll") for (int n = 0; n < 2; ++n) _Pragma("unroll") for (int k = 0; k < 2; ++k) dst[n][k] = *(const PG8_LAS bf16x8*)(lds + PG8_SB(b, h) + boff + n * 2048 + k * 1024); } while (0)
#define PG8_MMA(ai, bj, At, Bt) do { __builtin_amdgcn_s_setprio(1); _Pragma("unroll") for (int m = 0; m < 4; ++m) _Pragma("unroll") for (int n = 0; n < 2; ++n) _Pragma("unroll") for (int k = 0; k < 2; ++k) \
        acc[ai][bj][m][n] = __builtin_amdgcn_mfma_f32_16x16x32_bf16(Bt[n][k], At[m][k], acc[ai][bj][m][n], 0, 0, 0); __builtin_amdgcn_s_setprio(0); } while (0)
#define PG8_WAIT_V(n) asm volatile("s_waitcnt vmcnt(" #n ")" ::: "memory")
#define PG8_WAIT_L(n) asm volatile("s_waitcnt lgkmcnt(" #n ")" ::: "memory")
#define PG8_BAR __builtin_amdgcn_s_barrier()
#define PG8_SCHED __builtin_amdgcn_sched_barrier(0)
    Unit cur, nxt; int ui = 0;
    if (!S.next(0, cur)) return;
    f32x4 acc[2][2][4][2];
#pragma unroll
    for (int a = 0; a < 2; ++a)
#pragma unroll
        for (int b = 0; b < 2; ++b)
#pragma unroll
            for (int m = 0; m < 4; ++m)
#pragma unroll
                for (int n = 0; n < 2; ++n) acc[a][b][m][n] = (f32x4){0.f, 0.f, 0.f, 0.f};
    bf16x8 At[4][2], B0[2][2], B1[2][2];
    const char* cA = (const char*)g.A + (size_t)cur.pm * tstep; const char* cB = (const char*)g.Bt + (size_t)cur.pn * tstep;
    S.a_ready(cur);
    PG8_STAGE(PG8_SB(0, 0), cB, voffB); PG8_STAGE(PG8_SA(0, 0), cA, voffA); PG8_STAGE(PG8_SB(0, 1), cB + hstep, voffB); PG8_STAGE(PG8_SA(0, 1), cA + hstep, voffA);
    if (wr == 1) PG8_BAR;
    PG8_WAIT_V(4); PG8_BAR;
    PG8_STAGE(PG8_SB(1, 0), cB + kstep, voffB); PG8_STAGE(PG8_SA(1, 0), cA + kstep, voffA); PG8_STAGE(PG8_SB(1, 1), cB + hstep + kstep, voffB);
    PG8_WAIT_V(6); PG8_BAR;
    PG8_STAMP();
    for (;;) {
        const bool has_next = S.next(ui + 1, nxt);
        const char* nA = has_next ? (const char*)g.A + (size_t)nxt.pm * tstep : cA; const char* nB = has_next ? (const char*)g.Bt + (size_t)nxt.pn * tstep : cB;
        for (int t = 0; t < nt; t += 2) {
            const bool last = (t == nt - 2);
            const char* a1 = cA + (size_t)(t + 1) * kstep;
            const char* a2 = last ? nA : cA + (size_t)(t + 2) * kstep; const char* b2 = last ? nB : cB + (size_t)(t + 2) * kstep;
            const char* a3 = a2 + kstep; const char* b3 = b2 + kstep;
            if (last && has_next) S.a_ready(nxt);
            PG8_LDB(B0, 0, 0); PG8_SCHED; PG8_LDA(At, 0, 0); PG8_STAGE(PG8_SA(1, 1), a1 + hstep, voffA);
            PG8_WAIT_L(8); PG8_BAR; PG8_WAIT_L(0); PG8_MMA(0, 0, At, B0); PG8_BAR; PG8_SCHED;
            PG8_LDB(B1, 0, 1); PG8_STAGE(PG8_SB(0, 0), b2, voffB);
            PG8_BAR; PG8_WAIT_L(0); PG8_MMA(0, 1, At, B1); PG8_BAR;
            PG8_LDA(At, 0, 1); PG8_STAGE(PG8_SA(0, 0), a2, voffA);
            PG8_BAR; PG8_WAIT_L(0); PG8_MMA(1, 0, At, B0); PG8_BAR; PG8_SCHED;
            PG8_STAGE(PG8_SB(0, 1), b2 + hstep, voffB);
            PG8_WAIT_V(6); PG8_BAR; PG8_MMA(1, 1, At, B1); PG8_BAR;
            PG8_LDB(B0, 1, 0); PG8_SCHED; PG8_LDA(At, 1, 0); PG8_STAGE(PG8_SA(0, 1), a2 + hstep, voffA);
            PG8_WAIT_L(8); PG8_BAR; PG8_WAIT_L(0); PG8_MMA(0, 0, At, B0); PG8_BAR; PG8_SCHED;
            PG8_LDB(B1, 1, 1); PG8_STAGE(PG8_SB(1, 0), b3, voffB);
            PG8_BAR; PG8_WAIT_L(0); PG8_MMA(0, 1, At, B1); PG8_BAR;
            PG8_LDA(At, 1, 1); PG8_STAGE(PG8_SA(1, 0), a3, voffA);
            PG8_BAR; PG8_WAIT_L(0); PG8_MMA(1, 0, At, B0); PG8_BAR; PG8_SCHED;
            PG8_STAGE(PG8_SB(1, 1), b3 + hstep, voffB);
            PG8_WAIT_V(6); PG8_BAR; PG8_MMA(1, 1, At, B1); PG8_BAR;
        }
        PG8_STAMP();
        if constexpr (!Epi::AFTER_DRAIN) { E(acc, cur, wr, wc, fr, fq); S.done(cur); }
        PG8_STAMP();
        if (!has_next) break;
#pragma unroll
        for (int a = 0; a < 2; ++a)
#pragma unroll
            for (int b = 0; b < 2; ++b)
#pragma unroll
                for (int m = 0; m < 4; ++m)
#pragma unroll
                    for (int n = 0; n < 2; ++n) acc[a][b][m][n] = (f32x4){0.f, 0.f, 0.f, 0.f};
        cur = nxt; cA = nA; cB = nB; ++ui;
    }
    PG8_WAIT_V(0);
    if (wr == 0) PG8_BAR;
    PG8_BAR;
    if constexpr (Epi::AFTER_DRAIN) { E.fused(acc, cur, wr, wc, fr, fq, lds, wid, lane); S.done(cur); }
    PG8_STAMP();
    if (STAMP && wid == 0) { stamps[lane] = lane < nts ? (((unsigned long long)(unsigned)ts_hi << 32) | (unsigned)ts_lo) : 0ull;
        if (lane == 62) stamps[62] = rt_entry; if (lane == 63) stamps[63] = (unsigned long long)wall_clock64(); }
#undef PG8_STAMP
#undef PG8_SA
#undef PG8_SB
#undef PG8_STAGE
#undef PG8_LDA
#undef PG8_LDB
#undef PG8_MMA
#undef PG8_WAIT_V
#undef PG8_WAIT_L
#undef PG8_BAR
#undef PG8_SCHED
}
}

namespace pg8 {
struct EpiBf16Plain {
    static constexpr bool PERM = false, AFTER_DRAIN = false;
    bf16_t* O; int ldc;
    __device__ __forceinline__ void operator()(const f32x4 (&acc)[2][2][4][2], const Unit& u, int wr, int wc, int fr, int fq) const {
        const int row0 = u.pm * BM + wr * 64 + fr, col0 = u.pn * BM + wc * 32 + 4 * fq;
#pragma unroll
        for (int ai = 0; ai < 2; ++ai)
#pragma unroll
            for (int m = 0; m < 4; ++m) { bf16_t* rowp = O + (size_t)(row0 + ai * HALF + m * 16) * ldc + col0;
#pragma unroll
                for (int bj = 0; bj < 2; ++bj)
#pragma unroll
                    for (int n = 0; n < 2; ++n) { const f32x4 v = acc[ai][bj][m][n]; unsigned long long w = (unsigned long long)cvt_pk_bf16(v[0], v[1]) | ((unsigned long long)cvt_pk_bf16(v[2], v[3]) << 32);
                        *(unsigned long long*)(rowp + bj * HALF + n * 16) = w; } }
    }
};
struct EpiBf16Perm {
    static constexpr bool PERM = true, AFTER_DRAIN = false;
    bf16_t* O; int ldc;
    __device__ __forceinline__ void operator()(const f32x4 (&acc)[2][2][4][2], const Unit& u, int wr, int wc, int fr, int fq) const {
        const int row0 = u.pm * BM + wr * 64 + fr, col0 = u.pn * BM + wc * 32 + 8 * fq;
#pragma unroll
        for (int ai = 0; ai < 2; ++ai)
#pragma unroll
            for (int m = 0; m < 4; ++m) { bf16_t* rowp = O + (size_t)(row0 + ai * HALF + m * 16) * ldc + col0;
#pragma unroll
                for (int bj = 0; bj < 2; ++bj) { const f32x4 v0 = acc[ai][bj][m][0], v1 = acc[ai][bj][m][1]; u32x4 w;
                    w.x = cvt_pk_bf16(v0[0], v0[1]); w.y = cvt_pk_bf16(v0[2], v0[3]); w.z = cvt_pk_bf16(v1[0], v1[1]); w.w = cvt_pk_bf16(v1[2], v1[3]);
                    *(u32x4*)(rowp + bj * HALF) = w; } }
    }
};
struct EpiSwiglu {
    static constexpr bool PERM = false, AFTER_DRAIN = false;
    bf16_t* O; int ldc;
    __device__ __forceinline__ void operator()(const f32x4 (&acc)[2][2][4][2], const Unit& u, int wr, int wc, int fr, int fq) const {
        const int row0 = u.pm * BM + wr * 64 + fr, col0 = u.pn * (BM / 2) + wc * 16 + 4 * fq;
#pragma unroll
        for (int ai = 0; ai < 2; ++ai)
#pragma unroll
            for (int m = 0; m < 4; ++m) { bf16_t* rowp = O + (size_t)(row0 + ai * HALF + m * 16) * ldc + col0;
#pragma unroll
                for (int bj = 0; bj < 2; ++bj) { const f32x4 g = acc[ai][bj][m][0], up = acc[ai][bj][m][1]; float h[4];
#pragma unroll
                    for (int e = 0; e < 4; ++e) h[e] = g[e] * __builtin_amdgcn_rcpf(1.f + __expf(-g[e])) * up[e];
                    unsigned long long w = (unsigned long long)cvt_pk_bf16(h[0], h[1]) | ((unsigned long long)cvt_pk_bf16(h[2], h[3]) << 32);
                    *(unsigned long long*)(rowp + bj * (HALF / 2)) = w; } }
    }
};
}

struct Epi { int mode; bf16_t* ob; float* of; int ldo; int main_cols; };
DI void gemm_simple(const Ctx& c, const bf16_t* A, int lda, int M, const bf16_t* Bt, int ldb, int N, int K, const Epi e) {
    const int mblk = (M + 63) / 64, nblk = (N + 31) / 32, nit = mblk * nblk;
    const int fr = c.lane & 15, fq = c.lane >> 4;
    for (int it = c.gw; it < nit; it += c.ngw) {
        const int mb = it / nblk, nb = it % nblk, m0 = mb * 64, n0 = nb * 32;
        const bf16_t* ap[4]; const bf16_t* bp[2];
#pragma unroll
        for (int m = 0; m < 4; ++m) { int r = m0 + 16 * m + fr; r = r < M ? r : M - 1; ap[m] = A + (size_t)r * lda + 8 * fq; }
#pragma unroll
        for (int n = 0; n < 2; ++n) { int r = n0 + 16 * n + fr; r = r < N ? r : N - 1; bp[n] = Bt + (size_t)r * ldb + 8 * fq; }
        f32x4 acc[4][2];
#pragma unroll
        for (int m = 0; m < 4; ++m)
#pragma unroll
            for (int n = 0; n < 2; ++n) acc[m][n] = (f32x4){0.f, 0.f, 0.f, 0.f};
#pragma unroll 2
        for (int k0 = 0; k0 < K; k0 += 32) {
            bf16x8 a[4], b[2];
#pragma unroll
            for (int m = 0; m < 4; ++m) a[m] = *(const bf16x8*)(ap[m] + k0);
#pragma unroll
            for (int n = 0; n < 2; ++n) b[n] = *(const bf16x8*)(bp[n] + k0);
#pragma unroll
            for (int m = 0; m < 4; ++m)
#pragma unroll
                for (int n = 0; n < 2; ++n) acc[m][n] = __builtin_amdgcn_mfma_f32_16x16x32_bf16(b[n], a[m], acc[m][n], 0, 0, 0);
        }
#pragma unroll
        for (int m = 0; m < 4; ++m) {
            const int row = m0 + 16 * m + fr; if (row >= M) continue;
            if (e.mode == 2) {
                const f32x4 g = acc[m][0], u = acc[m][1]; u32x2 o;
                o.x = pk2(siluf(g.x) * u.x, siluf(g.y) * u.y); o.y = pk2(siluf(g.z) * u.z, siluf(g.w) * u.w);
                *(u32x2*)(e.ob + (size_t)row * e.ldo + 16 * nb + 4 * fq) = o;
            } else {
#pragma unroll
                for (int n = 0; n < 2; ++n) {
                    const int col = n0 + 16 * n + 4 * fq; if (col >= N) continue;
                    const f32x4 v = acc[m][n];
                    if (e.mode == 1) *(f32x4*)(e.of + (size_t)row * e.ldo + col) = v;
                    else if (col < e.main_cols) { u32x2 o; o.x = pk2(v.x, v.y); o.y = pk2(v.z, v.w); *(u32x2*)(e.ob + (size_t)row * e.ldo + col) = o; }
                    else *(f32x4*)(e.of + (size_t)row * 32 + (col - e.main_cols)) = v;
                }
            }
        }
    }
}

DI void attn_wave(const Ctx& c, int li, int tok, int h, LAS float* pl  ) {
    const bf16_t* PROJ = c.ws<bf16_t>(W_PROJ); bf16_t* MIX = c.ws<bf16_t>(W_MIXED);
    const int lane = c.lane; const bool smp = tok >= T;
    const int b = smp ? tok - T : tok / SEQ, s = smp ? WIN : tok % SEQ;
    const float* ck = c.in(I_CK) + ((size_t)(li * NS + b) * WIN) * AW + h * AHD;
    const float* cv = c.in(I_CV) + ((size_t)(li * NS + b) * WIN) * AW + h * AHD;
    const bf16_t* prow0 = smp ? PROJ + (size_t)tok * HYB_MAIN : PROJ + (size_t)(b * SEQ) * HYB_MAIN;
    float q[64];
    { const bf16_t* qp = PROJ + (size_t)tok * HYB_MAIN + h * AHD;
#pragma unroll
      for (int j = 0; j < 8; ++j) { const u32x4 v = *(const u32x4*)(qp + 8 * j);
          q[8*j+0] = bf2f((bf16_t)(v.x & 0xffff)) * 0.125f; q[8*j+1] = bf2f((bf16_t)(v.x >> 16)) * 0.125f; q[8*j+2] = bf2f((bf16_t)(v.y & 0xffff)) * 0.125f; q[8*j+3] = bf2f((bf16_t)(v.y >> 16)) * 0.125f;
          q[8*j+4] = bf2f((bf16_t)(v.z & 0xffff)) * 0.125f; q[8*j+5] = bf2f((bf16_t)(v.z >> 16)) * 0.125f; q[8*j+6] = bf2f((bf16_t)(v.w & 0xffff)) * 0.125f; q[8*j+7] = bf2f((bf16_t)(v.w >> 16)) * 0.125f; } }
    const float* relb = c.in(I_RELB);
    float mx = -1e30f;
#pragma unroll 1
    for (int pat = 0; pat < 3; ++pat) {
        const int d = pat == 0 ? 1 : (pat == 1 ? 4 : 16);
#pragma unroll
        for (int rnd = 0; rnd < 3; ++rnd) {
            const int j = rnd * 64 + lane; float lg = -1e30f;
            if (j <= 128) {
                const int R = s - j * d;
                if (R >= 0) {
                    float acc = 0.f;
                    if (smp && R < WIN) { const float* kp = ck + (size_t)R * AW;
#pragma unroll
                        for (int e = 0; e < 16; ++e) { const f32x4 v = *(const f32x4*)(kp + 4 * e); acc += q[4*e] * v.x + q[4*e+1] * v.y + q[4*e+2] * v.z + q[4*e+3] * v.w; }
                    } else { const bf16_t* kp = (smp ? prow0 : prow0 + (size_t)R * HYB_MAIN) + AW + h * AHD;
#pragma unroll
                        for (int e = 0; e < 8; ++e) { const u32x4 v = *(const u32x4*)(kp + 8 * e);
                            acc += q[8*e] * bf2f((bf16_t)(v.x & 0xffff)) + q[8*e+1] * bf2f((bf16_t)(v.x >> 16)) + q[8*e+2] * bf2f((bf16_t)(v.y & 0xffff)) + q[8*e+3] * bf2f((bf16_t)(v.y >> 16))
                                 + q[8*e+4] * bf2f((bf16_t)(v.z & 0xffff)) + q[8*e+5] * bf2f((bf16_t)(v.z >> 16)) + q[8*e+6] * bf2f((bf16_t)(v.w & 0xffff)) + q[8*e+7] * bf2f((bf16_t)(v.w >> 16)); }
                    }
                    lg = acc + relb[c_bucket[pat][j] * AH + h];
                }
                pl[pat * 132 + j] = lg;
            }
            mx = fmaxf(mx, lg);
        }
    }
    mx = wave_max(mx);
    LDS_WAIT();
    float ssum = 0.f;
#pragma unroll 1
    for (int i = lane; i < 396; i += 64) { const int pat = i / 132, j = i % 132; if (j <= 128) { const float lg = pl[i]; const float pv = lg > -1e29f ? __expf(lg - mx) : 0.f; pl[i] = pv; ssum += pv; } }
    ssum = wave_sum(ssum);
    LDS_WAIT();
    {
        const int kg = lane >> 4, dc = lane & 15;
        f32x4 o4 = (f32x4){0.f, 0.f, 0.f, 0.f};
        if (smp) {
#pragma unroll 1
            for (int pat = 0; pat < 3; ++pat) {
                const int d = pat == 0 ? 1 : (pat == 1 ? 4 : 16);
                if (kg == 0) { const u32x2 vv = *(const u32x2*)(prow0 + 2 * AW + h * AHD + 4 * dc); const float pv = pl[pat * 132];
                    o4.x += pv * bf2f((bf16_t)(vv.x & 0xffff)); o4.y += pv * bf2f((bf16_t)(vv.x >> 16)); o4.z += pv * bf2f((bf16_t)(vv.y & 0xffff)); o4.w += pv * bf2f((bf16_t)(vv.y >> 16)); }
#pragma unroll 16
                for (int i4 = 0; i4 < 32; ++i4) { const int j = 1 + 4 * i4 + kg; const f32x4 vv = *(const f32x4*)(cv + (size_t)(WIN - j * d) * AW + 4 * dc); o4 += vv * pl[pat * 132 + j]; }
            }
        } else {
#pragma unroll 1
            for (int pat = 0; pat < 3; ++pat) {
                const int d = pat == 0 ? 1 : (pat == 1 ? 4 : 16);
                int jmax = s / d; jmax = jmax > 128 ? 128 : jmax;
#pragma unroll 4
                for (int j = kg; j <= jmax; j += 4) { const u32x2 vv = *(const u32x2*)(prow0 + (size_t)(s - j * d) * HYB_MAIN + 2 * AW + h * AHD + 4 * dc); const float pv = pl[pat * 132 + j];
                    o4.x += pv * bf2f((bf16_t)(vv.x & 0xffff)); o4.y += pv * bf2f((bf16_t)(vv.x >> 16)); o4.z += pv * bf2f((bf16_t)(vv.y & 0xffff)); o4.w += pv * bf2f((bf16_t)(vv.y >> 16)); }
            }
        }
#pragma unroll
        for (int e = 0; e < 4; ++e) { o4[e] += __shfl_xor(o4[e], 16); o4[e] += __shfl_xor(o4[e], 32); }
        const float inv = 1.f / ssum;
        if (kg == 0) { u32x2 o; o.x = pk2(o4.x * inv, o4.y * inv); o.y = pk2(o4.z * inv, o4.w * inv); *(u32x2*)(MIX + (size_t)tok * HYB_MIX + h * AHD + 4 * dc) = o; }
    }
    LDS_WAIT();
}

template <int MT>
DI void gemm_ksplit(const Ctx& c, const bf16_t* A, int lda, int M, const bf16_t* Bt, int ldb, int N, int K, const Epi e) {
    const int mblk = (M + 16 * MT - 1) / (16 * MT), nblk = (N + 31) / 32, nit = mblk * nblk;
    const int fr = c.lane & 15, fq = c.lane >> 4, kslice = K / 8, klo = c.wave * kslice;
    LAS float* part = (LAS float*)c.lds;
    for (int it = blockIdx.x; it < nit; it += gridDim.x) {
        const int mb = it / nblk, nb = it % nblk, m0 = mb * 16 * MT, n0 = nb * 32;
        const bf16_t* ap[MT]; const bf16_t* bp[2];
#pragma unroll
        for (int m = 0; m < MT; ++m) { int r = m0 + 16 * m + fr; r = r < M ? r : M - 1; ap[m] = A + (size_t)r * lda + klo + 8 * fq; }
#pragma unroll
        for (int n = 0; n < 2; ++n) { int r = n0 + 16 * n + fr; r = r < N ? r : N - 1; bp[n] = Bt + (size_t)r * ldb + klo + 8 * fq; }
        f32x4 acc[MT][2];
#pragma unroll
        for (int m = 0; m < MT; ++m)
#pragma unroll
            for (int n = 0; n < 2; ++n) acc[m][n] = (f32x4){0.f, 0.f, 0.f, 0.f};
#pragma unroll 4
        for (int k0 = 0; k0 < kslice; k0 += 32) {
            bf16x8 a[MT], b[2];
#pragma unroll
            for (int m = 0; m < MT; ++m) a[m] = *(const bf16x8*)(ap[m] + k0);
#pragma unroll
            for (int n = 0; n < 2; ++n) b[n] = *(const bf16x8*)(bp[n] + k0);
#pragma unroll
            for (int m = 0; m < MT; ++m)
#pragma unroll
                for (int n = 0; n < 2; ++n) acc[m][n] = __builtin_amdgcn_mfma_f32_16x16x32_bf16(b[n], a[m], acc[m][n], 0, 0, 0);
        }
        __syncthreads();
#pragma unroll
        for (int m = 0; m < MT; ++m)
#pragma unroll
            for (int n = 0; n < 2; ++n) *(LAS f32x4*)(part + ((c.wave * (MT * 2) + m * 2 + n) * 64 + c.lane) * 4) = acc[m][n];
        __syncthreads();
        if (c.wave < MT) {
            const int m = c.wave; f32x4 v[2];
#pragma unroll
            for (int n = 0; n < 2; ++n) { v[n] = (f32x4){0.f, 0.f, 0.f, 0.f};
#pragma unroll
                for (int w = 0; w < 8; ++w) v[n] += *(const LAS f32x4*)(part + ((w * (MT * 2) + m * 2 + n) * 64 + c.lane) * 4); }
            const int row = m0 + 16 * m + fr;
            if (row < M) {
                if (e.mode == 2) {
                    const f32x4 g = v[0], u = v[1]; u32x2 o;
                    o.x = pk2(siluf(g.x) * u.x, siluf(g.y) * u.y); o.y = pk2(siluf(g.z) * u.z, siluf(g.w) * u.w);
                    *(u32x2*)(e.ob + (size_t)row * e.ldo + 16 * nb + 4 * fq) = o;
                } else {
#pragma unroll
                    for (int n = 0; n < 2; ++n) {
                        const int col = n0 + 16 * n + 4 * fq; if (col >= N) continue;
                        if (e.mode == 1) *(f32x4*)(e.of + (size_t)row * e.ldo + col) = v[n];
                        else if (col < e.main_cols) { u32x2 o; o.x = pk2(v[n].x, v[n].y); o.y = pk2(v[n].z, v[n].w); *(u32x2*)(e.ob + (size_t)row * e.ldo + col) = o; }
                        else *(f32x4*)(e.of + (size_t)row * 32 + (col - e.main_cols)) = v[n];
                    }
                }
            }
        }
    }
    __syncthreads();
}

constexpr int AT_LDS = 1600;
struct AtStep { int d, u, kb, sh; const LAS float* tbp; };
DI AtStep at_step(int g, const LAS float* tb) {
    AtStep s;
    if (g < 12) { s.d = 1; s.u = 16; s.sh = 0; s.kb = -143 + 32 * g; s.tbp = tb; }
    else if (g < 18) { s.d = 4; s.u = 4; s.sh = 2; s.kb = -131 + 32 * (g - 12); s.tbp = tb + 132; }
    else if (g < 23) { s.d = 16; s.u = 1; s.sh = 4; s.kb = -144 + 32 * (g - 18); s.tbp = tb + 264; }
    else { s.d = 1; s.u = 0; s.sh = 0; s.kb = 100000; s.tbp = tb; }
    return s;
}
struct AtBuf { bf16x8 k[2][2]; bf16x8 v[2][2]; };
DI void at_load(AtBuf& bf, const bf16_t* qrow0, int P0, const AtStep st, int fr, int fq) {
#pragma unroll
    for (int kt = 0; kt < 2; ++kt) {
        int pos = P0 + st.d * (st.kb + 16 * kt + fr); pos = pos < 0 ? 0 : (pos > SEQ - 1 ? SEQ - 1 : pos);
        const bf16_t* rp = qrow0 + (size_t)pos * HYB_MAIN + 8 * fq;
        bf.k[kt][0] = *(const bf16x8*)(rp + AW); bf.k[kt][1] = *(const bf16x8*)(rp + AW + 32);
        bf.v[kt][0] = *(const bf16x8*)(rp + 2 * AW); bf.v[kt][1] = *(const bf16x8*)(rp + 2 * AW + 32);
    }
}
DI void attn_mfma_item(const Ctx& c, int li, int item) {
    const bf16_t* PROJ = c.ws<bf16_t>(W_PROJ); bf16_t* MIX = c.ws<bf16_t>(W_MIXED);
    int lane_ = c.lane; asm volatile("" : "+v"(lane_));
    const int lane = lane_, fr = lane & 15, fq = lane >> 4;
    const int qb = item & 255, h = (item >> 8) & 7, b = item >> 11, P0 = (qb >> 4) * 256 + (qb & 15);
    LAS float* tb = (LAS float*)(c.lds + c.wave * AT_LDS);
    { const float* relb = c.in(I_RELB);
#pragma unroll 1
      for (int i = lane; i < 396; i += 64) { const int pat = i / 132, j = i % 132; tb[i] = j <= 128 ? relb[c_bucket[pat][j] * AH + h] : 0.f; } }
    const bf16_t* qrow0 = PROJ + (size_t)(b * SEQ) * HYB_MAIN + h * AHD;
    bf16x8 qf[2], idf[2];
#pragma unroll
    for (int kd = 0; kd < 2; ++kd) qf[kd] = *(const bf16x8*)(qrow0 + (size_t)(P0 + 16 * fr) * HYB_MAIN + 32 * kd + 8 * fq);
#pragma unroll
    for (int hs = 0; hs < 2; ++hs)
#pragma unroll
        for (int e = 0; e < 8; ++e) idf[hs][e] = (8 * fq + e) == (16 * hs + fr) ? (short)0x3F80 : (short)0;
    float m = -1e30f, lsum = 0.f;
    f32x4 O[4];
#pragma unroll
    for (int dt = 0; dt < 4; ++dt) O[dt] = (f32x4){0.f, 0.f, 0.f, 0.f};
    AtBuf b0, b1, b2;
    at_load(b0, qrow0, P0, at_step(0, tb), fr, fq); at_load(b1, qrow0, P0, at_step(1, tb), fr, fq); at_load(b2, qrow0, P0, at_step(2, tb), fr, fq);
    LDS_WAIT();
#define AT_STEP(bf, g) do { \
        const AtStep st = at_step((g), tb); const int qi = st.u * fr; \
        f32x4 sc[2]; \
        _Pragma("unroll") for (int kt = 0; kt < 2; ++kt) { sc[kt] = (f32x4){0.f, 0.f, 0.f, 0.f}; \
            _Pragma("unroll") for (int kd = 0; kd < 2; ++kd) sc[kt] = __builtin_amdgcn_mfma_f32_16x16x32_bf16(bf.k[kt][kd], qf[kd], sc[kt], 0, 0, 0); } \
        f32x4 dv[2][4]; \
        _Pragma("unroll") for (int kt = 0; kt < 2; ++kt) _Pragma("unroll") for (int dt = 0; dt < 4; ++dt) \
            dv[kt][dt] = __builtin_amdgcn_mfma_f32_16x16x32_bf16(bf.v[kt][dt >> 1], idf[dt & 1], (f32x4){0.f, 0.f, 0.f, 0.f}, 0, 0, 0);     \
        const AtStep nx = at_step((g) + 3, tb); at_load(bf, qrow0, P0, nx, fr, fq);     \
        float tmax = -1e30f; bool ok[2][4]; \
        const int dbase = qi - st.kb - 4 * fq;                                 \
        int dmx = qi + (P0 >> st.sh); dmx = dmx > 128 ? 128 : dmx;                  \
        _Pragma("unroll") for (int kt = 0; kt < 2; ++kt) _Pragma("unroll") for (int r = 0; r < 4; ++r) { \
            const unsigned dist = (unsigned)(dbase - 16 * kt - r); const bool v = dist <= (unsigned)dmx; ok[kt][r] = v; \
            const unsigned di = dist > 128u ? 128u : dist; const float bias = *(const volatile LAS float*)(st.tbp + di); \
            const float lg = v ? sc[kt][r] * 0.125f + bias : -1e30f; sc[kt][r] = lg; tmax = fmaxf(tmax, lg); } \
        tmax = fmaxf(tmax, __shfl_xor(tmax, 16)); tmax = fmaxf(tmax, __shfl_xor(tmax, 32)); \
        const float mn = fmaxf(m, tmax), alpha = __expf(m - mn); m = mn; \
        float ps = 0.f; \
        _Pragma("unroll") for (int kt = 0; kt < 2; ++kt) _Pragma("unroll") for (int r = 0; r < 4; ++r) { const float pv = ok[kt][r] ? __expf(sc[kt][r] - mn) : 0.f; sc[kt][r] = pv; ps += pv; } \
        lsum = lsum * alpha + ps; \
        const bf16x8 pfrag = pack8(sc[0], sc[1]); \
        _Pragma("unroll") for (int dt = 0; dt < 4; ++dt) O[dt] = __builtin_amdgcn_mfma_f32_16x16x32_bf16(pack8(dv[0][dt], dv[1][dt]), pfrag, O[dt] * alpha, 0, 0, 0); } while (0)
#pragma unroll 1
    for (int g = 0; g < 24; g += 3) { AT_STEP(b0, g); AT_STEP(b1, g + 1); AT_STEP(b2, g + 2); }
#undef AT_STEP
    lsum += __shfl_xor(lsum, 16); lsum += __shfl_xor(lsum, 32);
    const float inv = 1.f / lsum;
    bf16_t* orow = MIX + (size_t)(b * SEQ + P0 + 16 * fr) * HYB_MIX + h * AHD;
#pragma unroll
    for (int dt = 0; dt < 4; ++dt) { u32x2 o; o.x = pk2(O[dt][0] * inv, O[dt][1] * inv); o.y = pk2(O[dt][2] * inv, O[dt][3] * inv); *(u32x2*)(orow + 16 * dt + 4 * fq) = o; }
    LDS_WAIT();
}

DI void unpack8(const u32x4 v, float* f) {
    f[0] = bf2f((bf16_t)(v.x & 0xffff)); f[1] = bf2f((bf16_t)(v.x >> 16)); f[2] = bf2f((bf16_t)(v.y & 0xffff)); f[3] = bf2f((bf16_t)(v.y >> 16));
    f[4] = bf2f((bf16_t)(v.z & 0xffff)); f[5] = bf2f((bf16_t)(v.z >> 16)); f[6] = bf2f((bf16_t)(v.w & 0xffff)); f[7] = bf2f((bf16_t)(v.w >> 16));
}
DI void load8f(const float* p, float* f) { const f32x4 a = *(const f32x4*)p, b = *(const f32x4*)(p + 4); f[0] = a.x; f[1] = a.y; f[2] = a.z; f[3] = a.w; f[4] = b.x; f[5] = b.y; f[6] = b.z; f[7] = b.w; }
DI void store8f(float* p, const float* f) { *(f32x4*)p = (f32x4){f[0], f[1], f[2], f[3]}; *(f32x4*)(p + 4) = (f32x4){f[4], f[5], f[6], f[7]}; }
DI void conv8(const bf16_t* prow, int ld, const float* st, int nch, const float* cw, int ch0, bool smp, int s, float* x1, float* x2, float* x3, float* y) {
    float x0[8], w[8];
    unpack8(*(const u32x4*)(prow + ch0), x3);
    if (smp) { load8f(st + ch0, x0); load8f(st + nch + ch0, x1); load8f(st + 2 * nch + ch0, x2); }
    else {
        const u32x4 z = (u32x4){0u, 0u, 0u, 0u};
        unpack8(s >= 1 ? *(const u32x4*)(prow + ch0 - ld) : z, x2); unpack8(s >= 2 ? *(const u32x4*)(prow + ch0 - 2 * ld) : z, x1); unpack8(s >= 3 ? *(const u32x4*)(prow + ch0 - 3 * ld) : z, x0);
    }
    load8f(cw + ch0, w);
#pragma unroll
    for (int e = 0; e < 8; ++e) y[e] = x0[e] * w[e];
    load8f(cw + nch + ch0, w);
#pragma unroll
    for (int e = 0; e < 8; ++e) y[e] += x1[e] * w[e];
    load8f(cw + 2 * nch + ch0, w);
#pragma unroll
    for (int e = 0; e < 8; ++e) y[e] += x2[e] * w[e];
    load8f(cw + 3 * nch + ch0, w);
#pragma unroll
    for (int e = 0; e < 8; ++e) y[e] += x3[e] * w[e];
}
DI void hyb_pre_token(const Ctx& c, int li, int tok) {
    const bf16_t* PROJ = c.ws<bf16_t>(W_PROJ); float* ACT = c.ws<float>(W_ACT); float* AUX = c.ws<float>(W_AUX); const float* EX = c.ws<float>(W_EXTRA);
    const int lane = c.lane; const bool smp = tok >= T; const int b = smp ? tok - T : tok / SEQ, s = smp ? 0 : tok % SEQ;
    const float* cw = c.in(I_SCW) + (size_t)li * 4 * SXBC; const float* cb = c.in(I_SCB) + (size_t)li * SXBC;
    const float* st = c.in(I_SCONV) + (size_t)(li * NS + b) * 3 * SXBC;
    const bf16_t* prow = PROJ + (size_t)tok * HYB_MAIN + 2560;
#pragma unroll 1
    for (int it = 0; it < 3; ++it) {
        const int ch0 = 512 * it + 8 * lane; float x1[8], x2[8], x3[8], y[8], bb[8];
        conv8(prow, HYB_MAIN, st, SXBC, cw, ch0, smp, s, x1, x2, x3, y);
        load8f(cb + ch0, bb);
#pragma unroll
        for (int e = 0; e < 8; ++e) y[e] = siluf(y[e] + bb[e]);
        store8f(ACT + (size_t)tok * 4096 + ch0, y);
        if (smp) { float* o = c.p.out + O_SSC + (size_t)(li * NS + b) * 3 * SXBC + ch0; store8f(o, x1); store8f(o + SXBC, x2); store8f(o + 2 * SXBC, x3); }
        else if (s >= SEQ - 3) store8f(c.p.out + O_PSC + ((size_t)(li * NB + b) * 3 + (s - (SEQ - 3))) * SXBC + ch0, x3);
    }
    if (lane < SH) AUX[(size_t)tok * 32 + lane] = softplusf_(EX[(size_t)tok * 32 + lane] + c.in(I_SDTB)[li * SH + lane]);
    if (smp || s >= SEQ - WIN) {
        float* ok = smp ? c.p.out + O_SK + ((size_t)(li * NS + b) * WIN + (WIN - 1)) * AW : c.p.out + O_PK + ((size_t)(li * NB + b) * WIN + (s - (SEQ - WIN))) * AW;
        float* ov = smp ? c.p.out + O_SV + ((size_t)(li * NS + b) * WIN + (WIN - 1)) * AW : c.p.out + O_PV + ((size_t)(li * NB + b) * WIN + (s - (SEQ - WIN))) * AW;
        const bf16_t* kr = PROJ + (size_t)tok * HYB_MAIN + AW;
        float f[8];
        unpack8(*(const u32x4*)(kr + 8 * lane), f); store8f(ok + 8 * lane, f);
        unpack8(*(const u32x4*)(kr + AW + 8 * lane), f); store8f(ov + 8 * lane, f);
    }
}

DI void attn_sample_wg(const Ctx& c, int li, int item) {
    const bf16_t* PROJ = c.ws<bf16_t>(W_PROJ); bf16_t* MIX = c.ws<bf16_t>(W_MIXED);
    const int lane = c.lane, w = c.wave, sb = item / AH, h = item % AH, tok = T + sb;
    const float* ck = c.in(I_CK) + ((size_t)(li * NS + sb) * WIN) * AW + h * AHD; const float* cv = c.in(I_CV) + ((size_t)(li * NS + sb) * WIN) * AW + h * AHD;
    const bf16_t* prow0 = PROJ + (size_t)tok * HYB_MAIN;
    LAS float* pw = (LAS float*)(c.lds + NWAVE * AT_LDS + w * 2048);
    const int f0 = 49 * w, nk = (387 - f0) < 49 ? (387 - f0) : 49;
    float q[64];
    { const bf16_t* qp = prow0 + h * AHD;
#pragma unroll
      for (int j = 0; j < 8; ++j) { float f[8]; unpack8(*(const u32x4*)(qp + 8 * j), f);
#pragma unroll
          for (int e = 0; e < 8; ++e) q[8 * j + e] = f[e] * 0.125f; } }
    float lg = -1e30f;
    if (lane < nk) {
        const int f = f0 + lane, pat = f / 129, jj = f % 129, d = pat == 0 ? 1 : (pat == 1 ? 4 : 16);
        float acc = 0.f;
        if (jj == 0) { const bf16_t* kp = prow0 + AW + h * AHD;
#pragma unroll
            for (int e = 0; e < 8; ++e) { float kf[8]; unpack8(*(const u32x4*)(kp + 8 * e), kf);
#pragma unroll
                for (int x = 0; x < 8; ++x) acc += q[8 * e + x] * kf[x]; }
        } else { const float* kp = ck + (size_t)(WIN - jj * d) * AW;
#pragma unroll
            for (int e = 0; e < 16; ++e) { const f32x4 v = *(const f32x4*)(kp + 4 * e); acc += q[4 * e] * v.x + q[4 * e + 1] * v.y + q[4 * e + 2] * v.z + q[4 * e + 3] * v.w; } }
        lg = acc + c.in(I_RELB)[c_bucket[pat][jj] * AH + h];
    }
    const float mw = wave_max(lg), pv = lane < nk ? __expf(lg - mw) : 0.f, lw = wave_sum(pv);
    pw[lane] = pv;
    LDS_WAIT();
    const int kg = lane >> 4, dc = lane & 15;
    f32x4 o4 = (f32x4){0.f, 0.f, 0.f, 0.f};
#pragma unroll
    for (int i = 0; i < 13; ++i) {
        const int idx = 4 * i + kg;
        if (idx < nk) {
            const int f = f0 + idx, pat = f / 129, jj = f % 129, d = pat == 0 ? 1 : (pat == 1 ? 4 : 16); const float p = pw[idx];
            if (jj == 0) { const u32x2 vv = *(const u32x2*)(prow0 + 2 * AW + h * AHD + 4 * dc);
                o4.x += p * bf2f((bf16_t)(vv.x & 0xffff)); o4.y += p * bf2f((bf16_t)(vv.x >> 16)); o4.z += p * bf2f((bf16_t)(vv.y & 0xffff)); o4.w += p * bf2f((bf16_t)(vv.y >> 16)); }
            else o4 += *(const f32x4*)(cv + (size_t)(WIN - jj * d) * AW + 4 * dc) * p;
        }
    }
#pragma unroll
    for (int e = 0; e < 4; ++e) { o4[e] += __shfl_xor(o4[e], 16); o4[e] += __shfl_xor(o4[e], 32); }
    if (kg == 0) *(LAS f32x4*)(pw + 64 + 4 * dc) = o4;
    if (lane == 0) { pw[128] = mw; pw[129] = lw; }
    __syncthreads();
    if (w == 0 && lane < 16) {
        const LAS float* base = (const LAS float*)(c.lds + NWAVE * AT_LDS);
        float M = -1e30f;
#pragma unroll
        for (int x = 0; x < 8; ++x) M = fmaxf(M, base[x * 512 + 128]);
        float L = 0.f; f32x4 o = (f32x4){0.f, 0.f, 0.f, 0.f};
#pragma unroll
        for (int x = 0; x < 8; ++x) { const float sc = __expf(base[x * 512 + 128] - M); L += base[x * 512 + 129] * sc; o += *(const LAS f32x4*)(base + x * 512 + 64 + 4 * lane) * sc; }
        const float inv = 1.f / L; u32x2 ov; ov.x = pk2(o.x * inv, o.y * inv); ov.y = pk2(o.z * inv, o.w * inv);
        *(u32x2*)(MIX + (size_t)tok * HYB_MIX + h * AHD + 4 * lane) = ov;
    }
    __syncthreads();
}

DI void ssd_wave(const Ctx& c, int li, int item) {
    const float* ACT = c.ws<float>(W_ACT); const float* AUX = c.ws<float>(W_AUX); float* Y = c.ws<float>(W_Y);
    const int lane = c.lane;
    const bool smp = item >= NB * SH * SP; const int it = smp ? item - NB * SH * SP : item;
    const int seq = it / (SH * SP), h = (it / SP) % SH, p = it % SP, g = h / (SH / SG);
    const int L = smp ? 1 : SEQ; const int tok0 = smp ? T + seq : seq * SEQ;
    const float Ah = -__expf(c.in(I_SALOG)[li * SH + h]), Dh = c.in(I_SD)[li * SH + h];
    float h0 = 0.f, h1 = 0.f;
    if (smp) { const float* s0 = c.in(I_SSM) + (((size_t)(li * NS + seq) * SH + h) * SP + p) * SN; h0 = s0[2 * lane]; h1 = s0[2 * lane + 1]; }
#pragma unroll 2
    for (int t = 0; t < L; ++t) {
        const float* a = ACT + (size_t)(tok0 + t) * 4096;
        const float dt = AUX[(size_t)(tok0 + t) * 32 + h], xv = a[h * SP + p];
        const float2 Bv = *(const float2*)(a + SDI + g * SN + 2 * lane), Cv = *(const float2*)(a + SDI + SG * SN + g * SN + 2 * lane);
        const float dec = __expf(dt * Ah), dx = dt * xv;
        h0 = h0 * dec + dx * Bv.x; h1 = h1 * dec + dx * Bv.y;
        const float y = wave_sum(h0 * Cv.x + h1 * Cv.y);
        if (lane == 0) Y[(size_t)(tok0 + t) * 2048 + h * SP + p] = y + Dh * xv;
    }
    float* so = smp ? c.p.out + O_SSS + (((size_t)(li * NS + seq) * SH + h) * SP + p) * SN : c.p.out + O_PSS + (((size_t)(li * NB + seq) * SH + h) * SP + p) * SN;
    *(float2*)(so + 2 * lane) = make_float2(h0, h1);
}
DI void ssd_sample_item(const Ctx& c, int li, int qitem) {
    const int item = qitem >> 2, pq = qitem & 3;
    const float* ACT = c.ws<float>(W_ACT); const float* AUX = c.ws<float>(W_AUX); float* Y = c.ws<float>(W_Y);
    const int lane = c.lane, seq = item / SH, h = item % SH, g = h / (SH / SG), tok = T + seq;
    const float Ah = -__expf(c.in(I_SALOG)[li * SH + h]), Dh = c.in(I_SD)[li * SH + h];
    const float* a = ACT + (size_t)tok * 4096;
    const float dt = AUX[(size_t)tok * 32 + h], dec = __expf(dt * Ah);
    const float2 Bv = *(const float2*)(a + SDI + g * SN + 2 * lane), Cv = *(const float2*)(a + SDI + SG * SN + g * SN + 2 * lane);
    const float* s0 = c.in(I_SSM) + ((size_t)(li * NS + seq) * SH + h) * SP * SN; float* so = c.p.out + O_SSS + ((size_t)(li * NS + seq) * SH + h) * SP * SN;
    const float xl = a[h * SP + lane];
    float ysum = 0.f;
#pragma unroll
    for (int pp = 0; pp < 16; ++pp) { const int p = 16 * pq + pp;
        const float2 hv = *(const float2*)(s0 + (size_t)p * SN + 2 * lane);
        const float dx = dt * __shfl(xl, p);
        const float h0 = hv.x * dec + dx * Bv.x, h1 = hv.y * dec + dx * Bv.y;
        *(float2*)(so + (size_t)p * SN + 2 * lane) = make_float2(h0, h1);
        const float y = wave_sum(h0 * Cv.x + h1 * Cv.y);
        ysum = lane == p ? y : ysum;
    }
    if ((lane >> 4) == pq) Y[(size_t)tok * 2048 + h * SP + lane] = ysum + Dh * xl;
}
DI void hyb_post_token(const Ctx& c, int li, int tok) {
    const bf16_t* PROJ = c.ws<bf16_t>(W_PROJ); const float* Y = c.ws<float>(W_Y); bf16_t* MIX = c.ws<bf16_t>(W_MIXED);
    const float* nw = c.in(I_SNW) + (size_t)li * SDI; const int lane = c.lane;
    float v[16]; float ss0 = 0.f, ss1 = 0.f;
#pragma unroll
    for (int j = 0; j < 16; ++j) { const int ch = lane + 64 * j; const float z = bf2f(PROJ[(size_t)tok * HYB_MAIN + 1536 + ch]); v[j] = Y[(size_t)tok * 2048 + ch] * siluf(z); if (j < 8) ss0 += v[j] * v[j]; else ss1 += v[j] * v[j]; }
    const float r0 = rsqrtf(wave_sum(ss0) * (1.f / 512.f) + EPS), r1 = rsqrtf(wave_sum(ss1) * (1.f / 512.f) + EPS);
#pragma unroll
    for (int j = 0; j < 16; ++j) { const int ch = lane + 64 * j; MIX[(size_t)tok * HYB_MIX + AW + ch] = f2bf(v[j] * (j < 8 ? r0 : r1) * nw[ch]); }
}


constexpr int SLD = 136;
constexpr int L_C = 0, L_B = 34816, L_XT = 69632, L_HS = 87040, L_CS = 104448, L_DT = 108544;
constexpr size_t W_ST = W_HID;
constexpr size_t W_DEC = W_HID + (size_t)NB * 32 * SH * SP * SN * 4;
constexpr int NCH = SEQ / 128;

DI void ssd_chunk_scalars(const Ctx& c, int li, int tok0, int g) {
    const float* AUX = c.ws<float>(W_AUX); LAS float* csS = (LAS float*)(c.lds + L_CS); LAS float* dtS = (LAS float*)(c.lds + L_DT);
    const int hh = c.wave, lane = c.lane, h = 8 * g + hh;
    const float Ah = -__expf(c.in(I_SALOG)[li * SH + h]);
    const float d0 = AUX[(size_t)(tok0 + lane) * 32 + h], d1 = AUX[(size_t)(tok0 + 64 + lane) * 32 + h];
    float s0 = d0 * Ah, s1 = d1 * Ah;
#pragma unroll
    for (int o = 1; o < 64; o <<= 1) { const float t0 = __shfl_up(s0, o), t1 = __shfl_up(s1, o); if (lane >= o) { s0 += t0; s1 += t1; } }
    s1 += __shfl(s0, 63);
    csS[lane * 8 + hh] = s0; csS[(64 + lane) * 8 + hh] = s1; dtS[lane * 8 + hh] = d0; dtS[(64 + lane) * 8 + hh] = d1;
}
DI void ssd_a_item(const Ctx& c, int li, int item) {
    int tid_o = c.tid; asm volatile("" : "+v"(tid_o));
    const int lane_o = tid_o & 63;
    const float* ACT = c.ws<float>(W_ACT); float* ST = c.ws<float>(W_ST); float* DEC = c.ws<float>(W_DEC);
    const int g = item & 1, ch = (item >> 1) % NCH, b = item / (2 * NCH), tok0 = b * SEQ + ch * 128;
    LAS bf16_t* BT = (LAS bf16_t*)(c.lds + L_B);
    const LAS float* csS = (const LAS float*)(c.lds + L_CS); const LAS float* dtS = (const LAS float*)(c.lds + L_DT);
    const int fr = lane_o & 15, fq = lane_o >> 4, w = c.wave, h = 8 * g + w;
    bf16x8 idf[2];
#pragma unroll
    for (int hs = 0; hs < 2; ++hs)
#pragma unroll
        for (int e = 0; e < 8; ++e) idf[hs][e] = (8 * fq + e) == (16 * hs + fr) ? (short)0x3F80 : (short)0;
    __syncthreads();
    ssd_chunk_scalars(c, li, tok0, g);
    {
        bf16x8 bfr[8];
#pragma unroll
        for (int jt = 0; jt < 8; ++jt) bfr[jt] = gfrag_f32(ACT + (size_t)(tok0 + 16 * jt + fr) * 4096 + SDI + g * SN + 32 * (w >> 1) + 8 * fq);
#pragma unroll
        for (int jt = 0; jt < 8; ++jt) { const f32x4 d = __builtin_amdgcn_mfma_f32_16x16x32_bf16(bfr[jt], idf[w & 1], (f32x4){0.f, 0.f, 0.f, 0.f}, 0, 0, 0);
            u32x2 o; o.x = pk2(d[0], d[1]); o.y = pk2(d[2], d[3]); *(LAS u32x2*)(BT + (16 * w + fr) * SLD + 16 * jt + 4 * fq) = o; }
    }
    bf16x8 xfr[8][2];
#pragma unroll
    for (int jt = 0; jt < 8; ++jt)
#pragma unroll
        for (int c2 = 0; c2 < 2; ++c2) xfr[jt][c2] = gfrag_f32(ACT + (size_t)(tok0 + 16 * jt + fr) * 4096 + h * SP + 32 * c2 + 8 * fq);
    __syncthreads();
    if (tid_o < 8) DEC[(size_t)(b * NCH + ch) * SH + 8 * g + tid_o] = __expf(csS[127 * 8 + tid_o]);
    const float csl = csS[127 * 8 + w];
    bf16x8 xwf[4][4];
#pragma unroll
    for (int ks = 0; ks < 4; ++ks) {
        f32x4 d[2][4];
#pragma unroll
        for (int j2 = 0; j2 < 2; ++j2) {
            const int jt = 2 * ks + j2; f32x4 we;
#pragma unroll
            for (int r = 0; r < 4; ++r) { const int j = 16 * jt + 4 * fq + r; we[r] = __expf(csl - csS[j * 8 + w]) * dtS[j * 8 + w]; }
#pragma unroll
            for (int pt = 0; pt < 4; ++pt) d[j2][pt] = __builtin_amdgcn_mfma_f32_16x16x32_bf16(xfr[jt][pt >> 1], idf[pt & 1], (f32x4){0.f, 0.f, 0.f, 0.f}, 0, 0, 0) * we;
        }
#pragma unroll
        for (int pt = 0; pt < 4; ++pt) xwf[pt][ks] = pack8(d[0][pt], d[1][pt]);
    }
#pragma unroll 1
    for (int nh = 0; nh < 2; ++nh) {
        f32x4 acc[4][4];
#pragma unroll
        for (int pt = 0; pt < 4; ++pt)
#pragma unroll
            for (int n4 = 0; n4 < 4; ++n4) acc[pt][n4] = (f32x4){0.f, 0.f, 0.f, 0.f};
#pragma unroll
        for (int ks = 0; ks < 4; ++ks)
#pragma unroll
            for (int n4 = 0; n4 < 4; ++n4) {
                const LAS bf16_t* bp = BT + (16 * (4 * nh + n4) + fr) * SLD + 32 * ks + 4 * fq;
                const bf16x8 bb = lds_frag2(bp, bp + 16);
#pragma unroll
                for (int pt = 0; pt < 4; ++pt) acc[pt][n4] = __builtin_amdgcn_mfma_f32_16x16x32_bf16(bb, xwf[pt][ks], acc[pt][n4], 0, 0, 0);
            }
#pragma unroll
        for (int pt = 0; pt < 4; ++pt) {
            float* so = ST + ((((size_t)(b * NCH + ch) * SH + h) * SP + 16 * pt + fr) * SN);
#pragma unroll
            for (int n4 = 0; n4 < 4; ++n4) *(f32x4*)(so + 16 * (4 * nh + n4) + 4 * fq) = acc[pt][n4];
        }
    }
}
DI void ssd_scan_phase(const Ctx& c, int li) {
    float* ST = c.ws<float>(W_ST); const float* DEC = c.ws<float>(W_DEC);
    for (int idx = blockIdx.x * NTHR + c.tid; idx < NB * SH * SP * SN / 4; idx += gridDim.x * NTHR) {
        const int n4 = idx & 31, p = (idx >> 5) & 63, h = (idx >> 11) & 15, b = idx >> 15;
        f32x4 hcur = (f32x4){0.f, 0.f, 0.f, 0.f};
#pragma unroll 8
        for (int ch = 0; ch < NCH; ++ch) {
            f32x4* a = (f32x4*)(ST + ((((size_t)(b * NCH + ch) * SH + h) * SP + p) * SN)) + n4;
            const f32x4 s = *a; const float d = DEC[(size_t)(b * NCH + ch) * SH + h];
            *a = hcur; hcur = hcur * d + s;
        }
        *((f32x4*)(c.p.out + O_PSS + ((((size_t)(li * NB + b) * SH + h) * SP + p) * SN)) + n4) = hcur;
    }
}
DI void ssd_b_item(const Ctx& c, int li, int item) {
    int tid_o = c.tid; asm volatile("" : "+v"(tid_o));
    const int lane_o = tid_o & 63;
    const float* ACT = c.ws<float>(W_ACT); const float* ST = c.ws<float>(W_ST); const bf16_t* PROJ = c.ws<bf16_t>(W_PROJ); bf16_t* MIX = c.ws<bf16_t>(W_MIXED);
    const int g = item & 1, ch = (item >> 1) % NCH, b = item / (2 * NCH), tok0 = b * SEQ + ch * 128;
    LAS bf16_t* CS_ = (LAS bf16_t*)(c.lds + L_C); LAS bf16_t* BS = (LAS bf16_t*)(c.lds + L_B); LAS bf16_t* XT = (LAS bf16_t*)(c.lds + L_XT); LAS bf16_t* HS = (LAS bf16_t*)(c.lds + L_HS);
    const LAS float* csS = (const LAS float*)(c.lds + L_CS); const LAS float* dtS = (const LAS float*)(c.lds + L_DT);
    const int fr = lane_o & 15, fq = lane_o >> 4, w = c.wave, irow = 16 * w + fr;
    __syncthreads();
    ssd_chunk_scalars(c, li, tok0, g);
#pragma unroll
    for (int it = 0; it < 8; ++it) { const int idx = it * NTHR + tid_o, i = idx >> 5, n4 = idx & 31;
        const f32x4 bv = *(const f32x4*)(ACT + (size_t)(tok0 + i) * 4096 + SDI + g * SN + 4 * n4), cv = *(const f32x4*)(ACT + (size_t)(tok0 + i) * 4096 + SDI + SG * SN + g * SN + 4 * n4);
        u32x2 o; o.x = pk2(bv.x, bv.y); o.y = pk2(bv.z, bv.w); *(LAS u32x2*)(BS + i * SLD + 4 * n4) = o;
        o.x = pk2(cv.x, cv.y); o.y = pk2(cv.z, cv.w); *(LAS u32x2*)(CS_ + i * SLD + 4 * n4) = o; }
    __syncthreads();
    f32x4 cb[8];
#pragma unroll
    for (int jt = 0; jt < 8; ++jt) cb[jt] = (f32x4){0.f, 0.f, 0.f, 0.f};
    bf16x8 cfrag[4];
#pragma unroll
    for (int ks = 0; ks < 4; ++ks) cfrag[ks] = lds_frag(CS_ + irow * SLD + 32 * ks + 8 * fq);
#pragma unroll
    for (int jt = 0; jt < 8; ++jt) if (jt <= w) {
#pragma unroll
        for (int ks = 0; ks < 4; ++ks) cb[jt] = __builtin_amdgcn_mfma_f32_16x16x32_bf16(lds_frag(BS + (16 * jt + fr) * SLD + 32 * ks + 8 * fq), cfrag[ks], cb[jt], 0, 0, 0);
    }
    float rowsq = 0.f;
    float xr[16]; f32x4 hr[4];
#pragma unroll
    for (int it = 0; it < 16; ++it) { const int idx = it * NTHR + tid_o, j = idx >> 6, p = idx & 63; xr[it] = ACT[(size_t)(tok0 + j) * 4096 + (8 * g) * SP + p]; }
#pragma unroll
    for (int it = 0; it < 4; ++it) { const int idx = it * NTHR + tid_o, p = idx >> 5, n4 = idx & 31; hr[it] = *((const f32x4*)(ST + ((((size_t)(b * NCH + ch) * SH + 8 * g) * SP + p) * SN)) + n4); }
#pragma unroll 1
    for (int hh = 0; hh < 8; ++hh) {
        const int h = 8 * g + hh; const float Dh = c.in(I_SD)[li * SH + h];
        int tw = tid_o; asm volatile("" : "+v"(tw));
#pragma unroll
        for (int it = 0; it < 16; ++it) { const int idx = it * NTHR + tw, j = idx >> 6, p = idx & 63; XT[p * SLD + j] = f2bf(xr[it]); }
#pragma unroll
        for (int it = 0; it < 4; ++it) { const int idx = it * NTHR + tw, p = idx >> 5, n4 = idx & 31; const f32x4 v = hr[it];
            u32x2 o; o.x = pk2(v.x, v.y); o.y = pk2(v.z, v.w); *(LAS u32x2*)(HS + p * SLD + 4 * n4) = o; }
        __syncthreads();
        if (hh + 1 < 8) {
            int tq = tid_o; asm volatile("" : "+v"(tq));
#pragma unroll
            for (int it = 0; it < 16; ++it) { const int idx = it * NTHR + tq, j = idx >> 6, p = idx & 63; xr[it] = ACT[(size_t)(tok0 + j) * 4096 + (h + 1) * SP + p]; }
#pragma unroll
            for (int it = 0; it < 4; ++it) { const int idx = it * NTHR + tq, p = idx >> 5, n4 = idx & 31; hr[it] = *((const f32x4*)(ST + ((((size_t)(b * NCH + ch) * SH + h + 1) * SP + p) * SN)) + n4); }
        }
        const float csi = csS[irow * 8 + hh];
        f32x4 xv4[4]; u32x2 zz4[4];
#pragma unroll
        for (int pt = 0; pt < 4; ++pt) { const int col = h * SP + 16 * pt + 4 * fq; xv4[pt] = *(const f32x4*)(ACT + (size_t)(tok0 + irow) * 4096 + col); zz4[pt] = *(const u32x2*)(PROJ + (size_t)(tok0 + irow) * HYB_MAIN + 1536 + col); }
        f32x4 ay[4], ah[4];
#pragma unroll
        for (int pt = 0; pt < 4; ++pt) { ay[pt] = (f32x4){0.f, 0.f, 0.f, 0.f}; ah[pt] = (f32x4){0.f, 0.f, 0.f, 0.f}; }
#pragma unroll
        for (int ks = 0; ks < 4; ++ks) {
#pragma unroll
            for (int pt = 0; pt < 4; ++pt) ah[pt] = __builtin_amdgcn_mfma_f32_16x16x32_bf16(lds_frag(HS + (16 * pt + fr) * SLD + 32 * ks + 8 * fq), cfrag[ks], ah[pt], 0, 0, 0);
            if (2 * ks <= w) {
                float mv[8];
#pragma unroll
                for (int e = 0; e < 8; ++e) {
                    const int j = 32 * ks + (e < 4 ? 4 * fq + e : 16 + 4 * fq + (e - 4));
                    const float cbv = e < 4 ? cb[2 * ks][e] : cb[2 * ks + 1][e - 4];
                    const float csj = *(const volatile LAS float*)(csS + j * 8 + hh), dtj = *(const volatile LAS float*)(dtS + j * 8 + hh);
                    mv[e] = j <= irow ? cbv * __expf(csi - csj) * dtj : 0.f;
                }
                u32x4 mp; mp.x = pk2(mv[0], mv[1]); mp.y = pk2(mv[2], mv[3]); mp.z = pk2(mv[4], mv[5]); mp.w = pk2(mv[6], mv[7]);
                const bf16x8 mfrag = __builtin_bit_cast(bf16x8, mp);
#pragma unroll
                for (int pt = 0; pt < 4; ++pt) ay[pt] = __builtin_amdgcn_mfma_f32_16x16x32_bf16(lds_frag2(XT + (16 * pt + fr) * SLD + 32 * ks + 4 * fq, XT + (16 * pt + fr) * SLD + 32 * ks + 16 + 4 * fq), mfrag, ay[pt], 0, 0, 0);
            }
        }
        const float ei = __expf(csi);
#pragma unroll
        for (int pt = 0; pt < 4; ++pt) {
            const int col = h * SP + 16 * pt + 4 * fq;
            const f32x4 xv = xv4[pt]; const u32x2 zz = zz4[pt];
            const float z0 = bf2f((bf16_t)(zz.x & 0xffff)), z1 = bf2f((bf16_t)(zz.x >> 16)), z2 = bf2f((bf16_t)(zz.y & 0xffff)), z3 = bf2f((bf16_t)(zz.y >> 16));
            const float y0 = (ay[pt][0] + ei * ah[pt][0] + Dh * xv.x) * siluf(z0), y1 = (ay[pt][1] + ei * ah[pt][1] + Dh * xv.y) * siluf(z1);
            const float y2 = (ay[pt][2] + ei * ah[pt][2] + Dh * xv.z) * siluf(z2), y3 = (ay[pt][3] + ei * ah[pt][3] + Dh * xv.w) * siluf(z3);
            rowsq += y0 * y0 + y1 * y1 + y2 * y2 + y3 * y3;
            u32x2 o; o.x = pk2(y0, y1); o.y = pk2(y2, y3); *(u32x2*)(MIX + (size_t)(tok0 + irow) * HYB_MIX + AW + col) = o;
        }
        __syncthreads();
    }
    rowsq += __shfl_xor(rowsq, 16); rowsq += __shfl_xor(rowsq, 32);
    const float rn = rsqrtf(rowsq * (1.f / 512.f) + EPS);
    const float* nw = c.in(I_SNW) + (size_t)li * SDI + g * 512;
    asm volatile("s_waitcnt vmcnt(0)" ::: "memory");
    bf16_t* mrow = MIX + (size_t)(tok0 + irow) * HYB_MIX + AW + g * 512 + fq * 128;
#pragma unroll 4
    for (int cc = 0; cc < 16; ++cc) {
        const u32x4 v = *(const u32x4*)(mrow + 8 * cc); const float* wv = nw + fq * 128 + 8 * cc; u32x4 o;
        o.x = pk2(bf2f((bf16_t)(v.x & 0xffff)) * rn * wv[0], bf2f((bf16_t)(v.x >> 16)) * rn * wv[1]); o.y = pk2(bf2f((bf16_t)(v.y & 0xffff)) * rn * wv[2], bf2f((bf16_t)(v.y >> 16)) * rn * wv[3]);
        o.z = pk2(bf2f((bf16_t)(v.z & 0xffff)) * rn * wv[4], bf2f((bf16_t)(v.z >> 16)) * rn * wv[5]); o.w = pk2(bf2f((bf16_t)(v.w & 0xffff)) * rn * wv[6], bf2f((bf16_t)(v.w >> 16)) * rn * wv[7]);
        *(u32x4*)(mrow + 8 * cc) = o;
    }
}

DI void gdn_pre_token(const Ctx& c, int li, int tok) {
    const bf16_t* PROJ = c.ws<bf16_t>(W_PROJ); bf16_t* ACTB = c.ws<bf16_t>(W_ACT); float* AUX = c.ws<float>(W_AUX); const float* EX = c.ws<float>(W_EXTRA);
    const int lane = c.lane; const bool smp = tok >= T; const int b = smp ? tok - T : tok / SEQ, s = smp ? 0 : tok % SEQ;
    const float* cw = c.in(I_GCW) + (size_t)li * 4 * GQKV;
    const float* st = c.in(I_GCONV) + (size_t)(li * NS + b) * 3 * GQKV;
    const bf16_t* prow = PROJ + (size_t)tok * GDN_MAIN;
#pragma unroll 1
    for (int it = 0; it < 8; ++it) {
        const int ch0 = 512 * it + 8 * lane; float x1[8], x2[8], x3[8], y[8];
        conv8(prow, GDN_MAIN, st, GQKV, cw, ch0, smp, s, x1, x2, x3, y);
        float ss = 0.f;
#pragma unroll
        for (int e = 0; e < 8; ++e) { y[e] = siluf(y[e]); ss += y[e] * y[e]; }
        if (it < 4) {
            ss += __shfl_xor(ss, 1); ss += __shfl_xor(ss, 2); ss += __shfl_xor(ss, 4); ss += __shfl_xor(ss, 8);
            const float r = rsqrtf(ss + EPS) * (it < 2 ? 0.08838834764831845f : 1.f);
#pragma unroll
            for (int e = 0; e < 8; ++e) y[e] *= r;
        }
        { u32x4 o; o.x = pk2(y[0], y[1]); o.y = pk2(y[2], y[3]); o.z = pk2(y[4], y[5]); o.w = pk2(y[6], y[7]); *(u32x4*)(ACTB + (size_t)tok * 4096 + ch0) = o; }
        if (smp) { float* o = c.p.out + O_SGC + (size_t)(li * NS + b) * 3 * GQKV + ch0; store8f(o, x1); store8f(o + GQKV, x2); store8f(o + 2 * GQKV, x3); }
        else if (s >= SEQ - 3) store8f(c.p.out + O_PGC + ((size_t)(li * NB + b) * 3 + (s - (SEQ - 3))) * GQKV + ch0, x3);
    }
    if (lane < GH) {
        AUX[(size_t)tok * 32 + lane] = sigmoidf_(EX[(size_t)tok * 32 + lane]);
        AUX[(size_t)tok * 32 + 16 + lane] = -__expf(c.in(I_GALOG)[li * GH + lane]) * softplusf_(EX[(size_t)tok * 32 + 16 + lane] + c.in(I_GDTB)[li * GH + lane]);
    }
}
DI void gdn_pre_range(const Ctx& c, int li, int item) {
    const bf16_t* PROJ = c.ws<bf16_t>(W_PROJ); bf16_t* ACTB = c.ws<bf16_t>(W_ACT); float* AUX = c.ws<float>(W_AUX); const float* EX = c.ws<float>(W_EXTRA);
    int lane_ = c.lane; asm volatile("" : "+v"(lane_));
    const int lane = lane_, it = item & 7, rg = item >> 3, tok0 = rg * 64, b = tok0 / SEQ, s0 = tok0 % SEQ, ch0 = 512 * it + 8 * lane;
    const float* cw = c.in(I_GCW) + (size_t)li * 4 * GQKV;
    float w0[8], w1[8], w2[8], w3[8], xa[8], xb[8], xc[8];
    load8f(cw + ch0, w0); load8f(cw + GQKV + ch0, w1); load8f(cw + 2 * GQKV + ch0, w2); load8f(cw + 3 * GQKV + ch0, w3);
    const bf16_t* prow = PROJ + (size_t)tok0 * GDN_MAIN + ch0;
    const u32x4 z4 = (u32x4){0u, 0u, 0u, 0u};
    unpack8(s0 >= 3 ? *(const u32x4*)(prow - 3 * GDN_MAIN) : z4, xa); unpack8(s0 >= 2 ? *(const u32x4*)(prow - 2 * GDN_MAIN) : z4, xb); unpack8(s0 >= 1 ? *(const u32x4*)(prow - GDN_MAIN) : z4, xc);
    const float qscale = it < 2 ? 0.08838834764831845f : 1.f;
    {
        const int col = lane & 31; const bool isg = col >= 16;
        const float gal = isg ? -__expf(c.in(I_GALOG)[li * GH + col - 16]) : 0.f, gdb = isg ? c.in(I_GDTB)[li * GH + col - 16] : 0.f;
#pragma unroll
        for (int k = 0; k < 4; ++k) { const int tok = tok0 + 8 * it + 2 * k + (lane >> 5); const float ev = EX[(size_t)tok * 32 + col];
            AUX[(size_t)tok * 32 + col] = isg ? gal * softplusf_(ev + gdb) : sigmoidf_(ev); }
    }
    u32x4 rawn[16];
#pragma unroll
    for (int j = 0; j < 16; ++j) rawn[j] = *(const u32x4*)(prow + (size_t)j * GDN_MAIN);
#pragma unroll 1
    for (int tb = 0; tb < 64; tb += 16) {
        u32x4 raw[16];
#pragma unroll
        for (int j = 0; j < 16; ++j) raw[j] = rawn[j];
        if (tb + 16 < 64) {
#pragma unroll
            for (int j = 0; j < 16; ++j) rawn[j] = *(const u32x4*)(prow + (size_t)(tb + 16 + j) * GDN_MAIN);
        }
#pragma unroll
        for (int j = 0; j < 16; ++j) {
            const int t = tb + j;
            float xd[8], y[8];
            unpack8(raw[j], xd);
            float ss = 0.f;
#pragma unroll
            for (int e = 0; e < 8; ++e) { y[e] = siluf(xa[e] * w0[e] + xb[e] * w1[e] + xc[e] * w2[e] + xd[e] * w3[e]); ss += y[e] * y[e]; }
            if (it < 4) {
                ss += __shfl_xor(ss, 1); ss += __shfl_xor(ss, 2); ss += __shfl_xor(ss, 4); ss += __shfl_xor(ss, 8);
                const float r = rsqrtf(ss + EPS) * qscale;
#pragma unroll
                for (int e = 0; e < 8; ++e) y[e] *= r;
            }
            { u32x4 o; o.x = pk2(y[0], y[1]); o.y = pk2(y[2], y[3]); o.z = pk2(y[4], y[5]); o.w = pk2(y[6], y[7]); *(u32x4*)(ACTB + (size_t)(tok0 + t) * 4096 + ch0) = o; }
            if (s0 + t >= SEQ - 3) store8f(c.p.out + O_PGC + ((size_t)(li * NB + b) * 3 + (s0 + t - (SEQ - 3))) * GQKV + ch0, xd);
#pragma unroll
            for (int e = 0; e < 8; ++e) { xa[e] = xb[e]; xb[e] = xc[e]; xc[e] = xd[e]; }
        }
    }
}
DI void gdn_seq_phase(const Ctx& c, int li, int first_item, int wg, int nwg) {
    const bf16_t* ACTB = c.ws<bf16_t>(W_ACT); const float* AUX = c.ws<float>(W_AUX); bf16_t* MIX = c.ws<bf16_t>(W_MIXED); const bf16_t* PROJ = c.ws<bf16_t>(W_PROJ);
    LAS float* red = (LAS float*)c.lds + 1024;
    const int slot = c.tid >> 8, t8 = c.tid & 255, col = t8 >> 1, half = t8 & 1;
    LAS float* kq = (LAS float*)c.lds + slot * 512;
    const int nslot = nwg * 2;
    for (int base = first_item; base < NB * GH + NS * GH; base += nslot) {
        const int item = base + wg * 2 + slot;
        const bool wg_prompt = (base + wg * 2) < NB * GH;
        const int L = wg_prompt ? SEQ : 1;
        const bool valid = item < NB * GH + NS * GH;
        const bool smp = item >= NB * GH; const int it = smp ? item - NB * GH : item;
        const int seq = valid ? it / GH : 0, vh = valid ? it % GH : 0, hq = vh >> 1;
        const int tok0 = smp ? T + seq : seq * SEQ;
        float S[64];
        if (valid && smp) { const float* s0 = c.in(I_GST) + ((size_t)(li * NS + seq) * GH + vh) * GDK * GDV + (size_t)(64 * half) * GDV + col;
#pragma unroll
            for (int k = 0; k < 64; ++k) S[k] = s0[(size_t)k * GDV]; }
        else {
#pragma unroll
            for (int k = 0; k < 64; ++k) S[k] = 0.f; }
        __syncthreads();
        for (int t = 0; t < L; ++t) {
            LAS float* cur = kq + (t & 1) * 256;
            const bf16_t* a = ACTB + (size_t)(tok0 + t) * 4096;
            cur[t8] = bf2f(a[(t8 < 128 ? 1024 : -128) + hq * 128 + t8]);
            const float vv = bf2f(a[2048 + vh * 128 + col]), beta = AUX[(size_t)(tok0 + t) * 32 + vh], eg = __expf(AUX[(size_t)(tok0 + t) * 32 + 16 + vh]);
            __syncthreads();
            const LAS float* kk = cur + 64 * half; const LAS float* qq = cur + 128 + 64 * half;
            float ks = 0.f;
#pragma unroll
            for (int k = 0; k < 64; k += 4) { const f32x4 kv = *(const LAS f32x4*)(kk + k); ks += kv.x * S[k] + kv.y * S[k + 1] + kv.z * S[k + 2] + kv.w * S[k + 3]; }
            ks += __shfl_xor(ks, 1);
            const float u = beta * (vv - eg * ks);
            asm volatile("" ::: "memory");
            float o = 0.f;
#pragma unroll
            for (int k = 0; k < 64; k += 4) { const f32x4 kv = *(const LAS f32x4*)(kk + k); const f32x4 qv = *(const LAS f32x4*)(qq + k);
                S[k] = eg * S[k] + kv.x * u; S[k + 1] = eg * S[k + 1] + kv.y * u; S[k + 2] = eg * S[k + 2] + kv.z * u; S[k + 3] = eg * S[k + 3] + kv.w * u;
                o += qv.x * S[k] + qv.y * S[k + 1] + qv.z * S[k + 2] + qv.w * S[k + 3]; }
            o += __shfl_xor(o, 1);
            { const float sq = wave_sum(half == 0 ? o * o : 0.f); if (c.lane == 0) red[slot * 4 + ((c.tid >> 6) & 3)] = sq; }
            __syncthreads();
            if (valid && half == 0) { const float tot = red[slot * 4] + red[slot * 4 + 1] + red[slot * 4 + 2] + red[slot * 4 + 3];
                const float z = bf2f(PROJ[(size_t)(tok0 + t) * GDN_MAIN + 4096 + vh * 128 + col]);
                MIX[(size_t)(tok0 + t) * GVW + vh * 128 + col] = f2bf(o * rsqrtf(tot * (1.f / 128.f) + EPS) * c.in(I_GNW)[li * GDV + col] * siluf(z)); }
        }
        if (valid) { float* so = (smp ? c.p.out + O_SGS + ((size_t)(li * NS + seq) * GH + vh) * GDK * GDV : c.p.out + O_PGS + ((size_t)(li * NB + seq) * GH + vh) * GDK * GDV) + (size_t)(64 * half) * GDV + col;
#pragma unroll
            for (int k = 0; k < 64; ++k) so[(size_t)k * GDV] = S[k]; }
        __syncthreads();
    }
}

constexpr size_t W_KCD = W_GO;
constexpr size_t W_U0 = W_HID;
constexpr size_t W_GC = W_HID + (size_t)67108864;
constexpr size_t W_E1 = W_GC + (size_t)T * 16 * 4;
constexpr size_t W_E2 = W_E1 + (size_t)T * 16 * 4;
constexpr size_t W_SS = W_E2 + (size_t)T * 16 * 4;
constexpr size_t W_QB = W_H;
constexpr size_t W_ATTG = W_Y;
constexpr size_t W_KT = W_Y + (size_t)33554432;
constexpr int GA_LDS = 20000;
constexpr int GCH = SEQ / 64;


DI void gdn_a_item(const Ctx& c, int li, int item) {
    const bf16_t* ACTB = c.ws<bf16_t>(W_ACT); const float* AUX = c.ws<float>(W_AUX);
    const int ch = item & (GCH - 1), vh = (item >> 6) & 15, b = item >> 10, hq = vh >> 1, tok0 = b * SEQ + ch * 64;
    int lane_ = c.lane; asm volatile("" : "+v"(lane_));
    const int lane = lane_, fr = lane & 15, fq = lane >> 4;
    LAS unsigned char* wl = c.lds + c.wave * GA_LDS;
    LAS float* As = (LAS float*)wl; LAS bf16_t* Ts = (LAS bf16_t*)wl; LAS bf16_t* KsT = (LAS bf16_t*)wl;
    LAS float* gcS = (LAS float*)(wl + 17408); LAS float* btS = gcS + 64; LAS float* beS = gcS + 128;
    bf16_t* KCDg = c.ws<bf16_t>(W_KCD) + (size_t)item * 8192; bf16_t* ATTg = c.ws<bf16_t>(W_ATTG) + (size_t)item * 4096; bf16_t* U0g = c.ws<bf16_t>(W_U0) + (size_t)item * 8192;
    const int qitem = (b * GQH + hq) * GCH + ch;
    { const float gi = AUX[(size_t)(tok0 + lane) * 32 + 16 + vh], bi = AUX[(size_t)(tok0 + lane) * 32 + vh];
      float gc = gi;
#pragma unroll
      for (int o = 1; o < 64; o <<= 1) { const float t = __shfl_up(gc, o); if (lane >= o) gc += t; }
      const float e1 = __expf(gc), gl_ = __shfl(gc, 63);
      gcS[lane] = gc; btS[lane] = bi; beS[lane] = bi * e1; c.ws<float>(W_GC)[(size_t)(tok0 + lane) * 16 + vh] = gc;
      c.ws<float>(W_E1)[(size_t)(tok0 + lane) * 16 + vh] = e1; c.ws<float>(W_E2)[(size_t)(tok0 + lane) * 16 + vh] = __expf(gl_ - gc); }
    LDS_WAIT();
    {
        bf16x8 kf[4][4], qfa[4][4];
#pragma unroll
        for (int t = 0; t < 4; ++t)
#pragma unroll
            for (int ks = 0; ks < 4; ++ks) { const bf16_t* rp = ACTB + (size_t)(tok0 + 16 * t + fr) * 4096 + hq * 128 + 32 * ks + 8 * fq; kf[t][ks] = *(const bf16x8*)(rp + 1024); qfa[t][ks] = *(const bf16x8*)rp; }
#pragma unroll
        for (int it = 0; it < 4; ++it) {
            const int i = 16 * it + fr; const float gci = gcS[i], bti = btS[i];
#pragma unroll
            for (int jt = 0; jt < 4; ++jt) {
                bf16_t* ap = ATTg + (unsigned)(i * 64 + 16 * jt + 4 * fq);
                if (jt > it) { *(unsigned long long*)ap = 0ull; continue; }
                f32x4 kk = (f32x4){0.f, 0.f, 0.f, 0.f}, qk = (f32x4){0.f, 0.f, 0.f, 0.f};
#pragma unroll
                for (int ks = 0; ks < 4; ++ks) { kk = __builtin_amdgcn_mfma_f32_16x16x32_bf16(kf[jt][ks], kf[it][ks], kk, 0, 0, 0); qk = __builtin_amdgcn_mfma_f32_16x16x32_bf16(kf[jt][ks], qfa[it][ks], qk, 0, 0, 0); }
                f32x4 av, tv;
#pragma unroll
                for (int r = 0; r < 4; ++r) { const int j = 16 * jt + 4 * fq + r; const float dec = __expf(gci - gcS[j]); av[r] = j < i ? bti * kk[r] * dec : 0.f; tv[r] = j <= i ? qk[r] * dec : 0.f; }
                *(LAS f32x4*)(As + i * 64 + 16 * jt + 4 * fq) = av;
                *(unsigned long long*)ap = (unsigned long long)pk2(tv[0], tv[1]) | ((unsigned long long)pk2(tv[2], tv[3]) << 32);
            }
        }
    }
    LDS_WAIT();
    float Tr[64];
#pragma unroll
    for (int i = 0; i < 64; ++i) {
        float acc = lane == i ? 1.f : 0.f;
#pragma unroll
        for (int j = 0; j < i; ++j) acc -= As[i * 64 + j] * Tr[j];
        Tr[i] = acc;
    }
    LDS_WAIT();
#pragma unroll
    for (int i = 0; i < 64; ++i) Ts[i * 72 + lane] = f2bf(Tr[i]);
    LDS_WAIT();
    {
        bf16x8 tfp[4][2], idf[2];
#pragma unroll
        for (int it = 0; it < 4; ++it)
#pragma unroll
            for (int ks = 0; ks < 2; ++ks) tfp[it][ks] = lds_frag2(Ts + (16 * it + fr) * 72 + 32 * ks + 4 * fq, Ts + (16 * it + fr) * 72 + 32 * ks + 16 + 4 * fq);
#pragma unroll
        for (int hs = 0; hs < 2; ++hs)
#pragma unroll
            for (int e = 0; e < 8; ++e) idf[hs][e] = (8 * fq + e) == (16 * hs + fr) ? (short)0x3F80 : (short)0;
        bf16_t* KTg = c.ws<bf16_t>(W_KT) + (size_t)qitem * 8192;
        const bool wr_k = (vh & 1) == 0;
        const bf16_t* AK = ACTB + (size_t)tok0 * 4096 + 1024 + hq * 128; const bf16_t* AV = ACTB + (size_t)tok0 * 4096 + 2048 + vh * 128;
        bf16x8 vfn[4], kfn[4];
#pragma unroll
        for (int t = 0; t < 4; ++t) { vfn[t] = *(const bf16x8*)(AV + (size_t)(16 * t + fr) * 4096 + 8 * fq); kfn[t] = *(const bf16x8*)(AK + (size_t)(16 * t + fr) * 4096 + 8 * fq); }
#pragma unroll 1
        for (int cc = 0; cc < 4; ++cc) {
            bf16x8 vf[4], kf2[4];
#pragma unroll
            for (int t = 0; t < 4; ++t) { vf[t] = vfn[t]; kf2[t] = kfn[t]; }
            if (cc + 1 < 4) {
#pragma unroll
                for (int t = 0; t < 4; ++t) { vfn[t] = *(const bf16x8*)(AV + (size_t)(16 * t + fr) * 4096 + 32 * (cc + 1) + 8 * fq); kfn[t] = *(const bf16x8*)(AK + (size_t)(16 * t + fr) * 4096 + 32 * (cc + 1) + 8 * fq); }
            }
#pragma unroll
            for (int hs = 0; hs < 2; ++hs) {
                const int nt = 2 * cc + hs;
                f32x4 dvv[4], dkk[4];
#pragma unroll
                for (int t = 0; t < 4; ++t) {
                    const f32x4 z = (f32x4){0.f, 0.f, 0.f, 0.f};
                    dvv[t] = __builtin_amdgcn_mfma_f32_16x16x32_bf16(vf[t], idf[hs], z, 0, 0, 0);
                    dkk[t] = __builtin_amdgcn_mfma_f32_16x16x32_bf16(kf2[t], idf[hs], z, 0, 0, 0);
                    if (wr_k) *(unsigned long long*)(KTg + (unsigned)((16 * nt + fr) * 64 + 16 * t + 4 * fq)) = (unsigned long long)pk2(dkk[t][0], dkk[t][1]) | ((unsigned long long)pk2(dkk[t][2], dkk[t][3]) << 32);
                    const f32x4 bt = *(const LAS f32x4*)(btS + 16 * t + 4 * fq), be = *(const LAS f32x4*)(beS + 16 * t + 4 * fq);
                    dvv[t] *= bt; dkk[t] *= be;
                }
                f32x4 au[4], ak[4];
#pragma unroll
                for (int it = 0; it < 4; ++it) { au[it] = (f32x4){0.f, 0.f, 0.f, 0.f}; ak[it] = (f32x4){0.f, 0.f, 0.f, 0.f}; }
#pragma unroll
                for (int ks = 0; ks < 2; ++ks) {
                    const bf16x8 vfrag = pack8(dvv[2 * ks], dvv[2 * ks + 1]), kfrag = pack8(dkk[2 * ks], dkk[2 * ks + 1]);
#pragma unroll
                    for (int it = 0; it < 4; ++it) { au[it] = __builtin_amdgcn_mfma_f32_16x16x32_bf16(tfp[it][ks], vfrag, au[it], 0, 0, 0);
                                                     ak[it] = __builtin_amdgcn_mfma_f32_16x16x32_bf16(kfrag, tfp[it][ks], ak[it], 0, 0, 0); }
                }
#pragma unroll
                for (int it = 0; it < 4; ++it) {
                    *(unsigned long long*)(U0g + (unsigned)(((nt * 4 + it) * 64 + lane) * 4)) = (unsigned long long)pk2(au[it][0], au[it][1]) | ((unsigned long long)pk2(au[it][2], au[it][3]) << 32);
                    *(unsigned long long*)(KCDg + (unsigned)((16 * it + fr) * 128 + 16 * nt + 4 * fq)) = (unsigned long long)pk2(ak[it][0], ak[it][1]) | ((unsigned long long)pk2(ak[it][2], ak[it][3]) << 32);
                }
            }
        }
    }
    LDS_WAIT();
}

constexpr int GS_KCD = 0, GS_QB = 17408, GS_ATT = 34816, GS_KT = 44032, GS_GC = 62464, GS_BUF = 62720;
DI bf16x8 fragA(const LAS unsigned char* p) { const u32x2 x = *(const volatile LAS u32x2*)p, y = *(const volatile LAS u32x2*)(p + 128);     u32x4 r; r.x = x.x; r.y = x.y; r.z = y.x; r.w = y.y; return __builtin_bit_cast(bf16x8, r); }
DI bf16x8 fragB(const LAS unsigned char* p) { const u32x2 x = *(const volatile LAS u32x2*)p, y = *(const volatile LAS u32x2*)(p + 256); u32x4 r; r.x = x.x; r.y = x.y; r.z = y.x; r.w = y.y; return __builtin_bit_cast(bf16x8, r); }
DI void gdn_scan_wg(const Ctx& c, int li, int bvh) {
    const int vh = bvh & 15, b = bvh >> 4, hq = vh >> 1, lane = c.lane, fr = lane & 15, fq = lane >> 4, w = c.wave, tid = c.tid;
    const bf16_t* KCDg = c.ws<bf16_t>(W_KCD) + (size_t)(bvh * GCH) * 8192; const bf16_t* ATTg = c.ws<bf16_t>(W_ATTG) + (size_t)(bvh * GCH) * 4096;
    const bf16_t* U0g = c.ws<bf16_t>(W_U0) + (size_t)(bvh * GCH) * 8192;
    const bf16_t* QBg = c.ws<bf16_t>(W_ACT) + (size_t)(b * SEQ) * 4096 + hq * 128; const bf16_t* KTg = c.ws<bf16_t>(W_KT) + (size_t)((b * GQH + hq) * GCH) * 8192;
    const float* GCg = c.ws<float>(W_GC); bf16_t* MIX = c.ws<bf16_t>(W_MIXED); const bf16_t* PROJ = c.ws<bf16_t>(W_PROJ);
    LAS float* OT = (LAS float*)(c.lds + 2 * GS_BUF);
    LAS float* nwS = OT + 64 * 132;
    if (tid < GDV) nwS[tid] = c.in(I_GNW)[li * GDV + tid];
#define GS_DMA(tn, bb) do { \
        LAS unsigned char* lb_ = c.lds + (bb) * GS_BUF; \
        _Pragma("unroll") for (int k = 0; k < 2; ++k) { const int p_ = 8 * k + w; \
            __builtin_amdgcn_global_load_lds((const unsigned*)(KCDg + (size_t)(tn) * 8192 + p_ * 512 + srcA), (LAS unsigned*)(lb_ + GS_KCD + p_ * 1088), 16, 0, 0); \
            __builtin_amdgcn_global_load_lds((const unsigned*)(QBg + (size_t)(tn) * (64 * 4096) + p_ * (4 * 4096) + srcQ), (LAS unsigned*)(lb_ + GS_QB + p_ * 1088), 16, 0, 0); \
            __builtin_amdgcn_global_load_lds((const unsigned*)(KTg + (size_t)(tn) * 8192 + p_ * 512 + srcB), (LAS unsigned*)(lb_ + GS_KT + p_ * 1152), 16, 0, 0); } \
        __builtin_amdgcn_global_load_lds((const unsigned*)(ATTg + (size_t)(tn) * 4096 + w * 512 + srcB), (LAS unsigned*)(lb_ + GS_ATT + w * 1152), 16, 0, 0); } while (0)
    const int srcA = (lane & 3) * 128 + 8 * (lane >> 2), srcQ = (lane & 3) * 4096 + 8 * (lane >> 2), srcB = (lane & 7) * 64 + 8 * (lane >> 3);
    const int offA = (fr >> 2) * 1088 + (fr & 3) * 16 + (fq >> 1) * 64 + 8 * (fq & 1), offB = (fr >> 3) * 1152 + (fr & 7) * 16 + (fq >> 1) * 128 + 8 * (fq & 1);
    f32x4 sacc[8];
#pragma unroll
    for (int t = 0; t < 8; ++t) sacc[t] = (f32x4){0.f, 0.f, 0.f, 0.f};
    __syncthreads();
    u32x2 u0n[4];
#pragma unroll
    for (int it = 0; it < 4; ++it) u0n[it] = *(const u32x2*)(U0g + ((size_t)(w * 4 + it) * 64 + lane) * 4);
    GS_DMA(0, 0);
    if (tid < 64) *(LAS float*)(c.lds + GS_GC + 4 * tid) = GCg[(size_t)(b * SEQ + tid) * 16 + vh];
    asm volatile("s_waitcnt vmcnt(0)" ::: "memory");
    __syncthreads();
#pragma unroll 1
    for (int t = 0; t < GCH; ++t) {
        const LAS unsigned char* buf = c.lds + (t & 1) * GS_BUF; LAS unsigned char* nbuf = c.lds + ((t + 1) & 1) * GS_BUF;
        const int tok0 = b * SEQ + t * 64;
        const bool more = t + 1 < GCH;
        u32x2 u0r[4];
#pragma unroll
        for (int it = 0; it < 4; ++it) u0r[it] = u0n[it];
        float gstg = 0.f;
        if (more) {
#pragma unroll
            for (int it = 0; it < 4; ++it) u0n[it] = *(const u32x2*)(U0g + (size_t)(t + 1) * 8192 + ((size_t)(w * 4 + it) * 64 + lane) * 4);
            if (tid < 64) gstg = GCg[(size_t)(tok0 + 64 + tid) * 16 + vh];
            GS_DMA(t + 1, (t + 1) & 1);
        }
        const LAS unsigned char* KCD = buf + GS_KCD; const LAS unsigned char* QB = buf + GS_QB; const LAS unsigned char* ATT = buf + GS_ATT; const LAS unsigned char* KT = buf + GS_KT;
        const LAS float* gcS = (const LAS float*)(buf + GS_GC);
        bf16x8 sfrag[4];
#pragma unroll
        for (int ks = 0; ks < 4; ++ks) sfrag[ks] = pack8(sacc[2 * ks], sacc[2 * ks + 1]);
        const float gl = gcS[63], egl = __expf(gl);
        bf16x8 ufrag[2], udfrag[2]; f32x4 ov[4];
#pragma unroll
        for (int hp = 0; hp < 2; ++hp) {
            f32x4 uu[2];
#pragma unroll
            for (int h2 = 0; h2 < 2; ++h2) {
                const int it = 2 * hp + h2;
                f32x4 ks_ = (f32x4){0.f, 0.f, 0.f, 0.f}, qs_ = (f32x4){0.f, 0.f, 0.f, 0.f};
#pragma unroll
                for (int ks = 0; ks < 4; ++ks) {
                    ks_ = __builtin_amdgcn_mfma_f32_16x16x32_bf16(fragA(KCD + offA + it * 4352 + ks * 256), sfrag[ks], ks_, 0, 0, 0);
                    qs_ = __builtin_amdgcn_mfma_f32_16x16x32_bf16(fragA(QB + offA + it * 4352 + ks * 256), sfrag[ks], qs_, 0, 0, 0);
                }
                const f32x4 gci = *(const LAS f32x4*)(gcS + 16 * it + 4 * fq);
                f32x4 u;
                u[0] = bf2f((bf16_t)(u0r[it].x & 0xffff)) - ks_[0]; u[1] = bf2f((bf16_t)(u0r[it].x >> 16)) - ks_[1]; u[2] = bf2f((bf16_t)(u0r[it].y & 0xffff)) - ks_[2]; u[3] = bf2f((bf16_t)(u0r[it].y >> 16)) - ks_[3];
                uu[h2] = u;
#pragma unroll
                for (int r = 0; r < 4; ++r) ov[it][r] = qs_[r] * __expf(gci[r]);
            }
            ufrag[hp] = pack8(uu[0], uu[1]);
            const f32x4 g0 = *(const LAS f32x4*)(gcS + 32 * hp + 4 * fq), g1 = *(const LAS f32x4*)(gcS + 32 * hp + 16 + 4 * fq);
            f32x4 d0, d1;
#pragma unroll
            for (int r = 0; r < 4; ++r) { d0[r] = uu[0][r] * __expf(gl - g0[r]); d1[r] = uu[1][r] * __expf(gl - g1[r]); }
            udfrag[hp] = pack8(d0, d1);
        }
#pragma unroll
        for (int it = 0; it < 4; ++it) {
            f32x4 au = ov[it];
#pragma unroll
            for (int ks = 0; ks < 2; ++ks) au = __builtin_amdgcn_mfma_f32_16x16x32_bf16(fragB(ATT + offB + it * 2304 + ks * 512), ufrag[ks], au, 0, 0, 0);
#pragma unroll
            for (int r = 0; r < 4; ++r) OT[(16 * it + 4 * fq + r) * 132 + 16 * w + fr] = au[r];
        }
        LDS_WAIT(); __builtin_amdgcn_s_barrier(); asm volatile("" ::: "memory");
        const int frow = tid >> 3, fc = tid & 7;
        const u32x4 zlo = *(const u32x4*)(PROJ + (size_t)(tok0 + frow) * GDN_MAIN + 4096 + vh * 128 + 16 * fc), zhi = *(const u32x4*)(PROJ + (size_t)(tok0 + frow) * GDN_MAIN + 4096 + vh * 128 + 16 * fc + 8);
#pragma unroll
        for (int tt = 0; tt < 8; ++tt) {
            f32x4 a = sacc[tt] * egl;
#pragma unroll
            for (int ks = 0; ks < 2; ++ks) a = __builtin_amdgcn_mfma_f32_16x16x32_bf16(fragB(KT + offB + tt * 2304 + ks * 512), udfrag[ks], a, 0, 0, 0);
            sacc[tt] = a;
        }
        {
            float ov16[16], zf[16];
#pragma unroll
            for (int q4 = 0; q4 < 4; ++q4) { const f32x4 v = *(const LAS f32x4*)(OT + frow * 132 + 16 * fc + 4 * q4); ov16[4 * q4] = v.x; ov16[4 * q4 + 1] = v.y; ov16[4 * q4 + 2] = v.z; ov16[4 * q4 + 3] = v.w; }
            float ss = 0.f;
#pragma unroll
            for (int e = 0; e < 16; ++e) ss += ov16[e] * ov16[e];
            ss += __shfl_xor(ss, 1); ss += __shfl_xor(ss, 2); ss += __shfl_xor(ss, 4);
            const float rn = rsqrtf(ss * (1.f / 128.f) + EPS);
            unpack8(zlo, zf); unpack8(zhi, zf + 8);
            float res[16];
#pragma unroll
            for (int e = 0; e < 16; ++e) res[e] = ov16[e] * rn * nwS[16 * fc + e] * siluf(zf[e]);
            u32x4 o0, o1; o0.x = pk2(res[0], res[1]); o0.y = pk2(res[2], res[3]); o0.z = pk2(res[4], res[5]); o0.w = pk2(res[6], res[7]);
            o1.x = pk2(res[8], res[9]); o1.y = pk2(res[10], res[11]); o1.z = pk2(res[12], res[13]); o1.w = pk2(res[14], res[15]);
            bf16_t* mp = MIX + (size_t)(tok0 + frow) * GVW + vh * 128 + 16 * fc;
            *(u32x4*)mp = o0; *(u32x4*)(mp + 8) = o1;
        }
        if (more && tid < 64) *(LAS float*)(nbuf + GS_GC + 4 * tid) = gstg;
        asm volatile("s_waitcnt vmcnt(0)" ::: "memory");
        __syncthreads();
    }
#undef GS_DMA
    float* so = c.p.out + O_PGS + ((size_t)(li * NB + b) * GH + vh) * GDK * GDV;
#pragma unroll
    for (int tt = 0; tt < 8; ++tt)
#pragma unroll
        for (int r = 0; r < 4; ++r) so[(size_t)(16 * tt + 4 * fq + r) * GDV + 16 * w + fr] = sacc[tt][r];
}


constexpr int G2_E1 = 62464, G2_E2 = 62720, G2_BUF = 62976, G2_OT = 2 * G2_BUF;
DI void gdn_scan2_wg(const Ctx& c, int li, int bvh, int hf) {
    const int vh = bvh & 15, b = bvh >> 4, hq = vh >> 1, lane = c.lane, fr = lane & 15, fq = lane >> 4, w = c.wave, tid = c.tid;
    const bf16_t* KCDg = c.ws<bf16_t>(W_KCD) + (size_t)(bvh * GCH) * 8192; const bf16_t* ATTg = c.ws<bf16_t>(W_ATTG) + (size_t)(bvh * GCH) * 4096;
    const bf16_t* U0g = c.ws<bf16_t>(W_U0) + (size_t)(bvh * GCH) * 8192;
    const bf16_t* QBg = c.ws<bf16_t>(W_ACT) + (size_t)(b * SEQ) * 4096 + hq * 128; const bf16_t* KTg = c.ws<bf16_t>(W_KT) + (size_t)((b * GQH + hq) * GCH) * 8192;
    const float* E1g = c.ws<float>(W_E1); const float* E2g = c.ws<float>(W_E2); float* SSg = c.ws<float>(W_SS); bf16_t* MIX = c.ws<bf16_t>(W_MIXED);
    LAS float* OT = (LAS float*)(c.lds + G2_OT);
    const bool comp = w < 4; const int hw = w - 4;
#define G2_DMA(tn, bb) do { \
        LAS unsigned char* lb_ = c.lds + (bb) * G2_BUF; \
        _Pragma("unroll") for (int k = 0; k < 4; ++k) { const int p_ = 4 * k + hw; \
            __builtin_amdgcn_global_load_lds((const unsigned*)(KCDg + (size_t)(tn) * 8192 + p_ * 512 + srcA), (LAS unsigned*)(lb_ + GS_KCD + p_ * 1088), 16, 0, 0); \
            __builtin_amdgcn_global_load_lds((const unsigned*)(QBg + (size_t)(tn) * (64 * 4096) + p_ * (4 * 4096) + srcQ), (LAS unsigned*)(lb_ + GS_QB + p_ * 1088), 16, 0, 0); \
            __builtin_amdgcn_global_load_lds((const unsigned*)(KTg + (size_t)(tn) * 8192 + p_ * 512 + srcB), (LAS unsigned*)(lb_ + GS_KT + p_ * 1152), 16, 0, 0); } \
        _Pragma("unroll") for (int k = 0; k < 2; ++k) { const int p_ = 4 * k + hw; \
            __builtin_amdgcn_global_load_lds((const unsigned*)(ATTg + (size_t)(tn) * 4096 + p_ * 512 + srcB), (LAS unsigned*)(lb_ + GS_ATT + p_ * 1152), 16, 0, 0); } } while (0)
#define G2_OUT(tp) do { \
        const int ht_ = tid - 256, row_ = ht_ >> 2, cq_ = ht_ & 3; const LAS float* op_ = OT + ((tp) & 1) * (64 * 68) + row_ * 68 + 16 * cq_; \
        const f32x4 a0 = *(const LAS f32x4*)op_, a1 = *(const LAS f32x4*)(op_ + 4), a2 = *(const LAS f32x4*)(op_ + 8), a3 = *(const LAS f32x4*)(op_ + 12); \
        float ss_ = a0.x * a0.x + a0.y * a0.y + a0.z * a0.z + a0.w * a0.w + a1.x * a1.x + a1.y * a1.y + a1.z * a1.z + a1.w * a1.w \
                  + a2.x * a2.x + a2.y * a2.y + a2.z * a2.z + a2.w * a2.w + a3.x * a3.x + a3.y * a3.y + a3.z * a3.z + a3.w * a3.w; \
        ss_ += __shfl_xor(ss_, 1); ss_ += __shfl_xor(ss_, 2); \
        const size_t tk_ = (size_t)(b * SEQ + (tp) * 64 + row_); \
        if (cq_ == 0) SSg[(tk_ * 16 + vh) * 2 + hf] = ss_; \
        u32x4 o0, o1; o0.x = pk2(a0.x, a0.y); o0.y = pk2(a0.z, a0.w); o0.z = pk2(a1.x, a1.y); o0.w = pk2(a1.z, a1.w); \
        o1.x = pk2(a2.x, a2.y); o1.y = pk2(a2.z, a2.w); o1.z = pk2(a3.x, a3.y); o1.w = pk2(a3.z, a3.w); \
        bf16_t* mp_ = MIX + tk_ * GVW + vh * 128 + 64 * hf + 16 * cq_; *(u32x4*)mp_ = o0; *(u32x4*)(mp_ + 8) = o1; } while (0)
    const int srcA = (lane & 3) * 128 + 8 * (lane >> 2), srcQ = (lane & 3) * 4096 + 8 * (lane >> 2), srcB = (lane & 7) * 64 + 8 * (lane >> 3);
    const int offA = (fr >> 2) * 1088 + (fr & 3) * 16 + (fq >> 1) * 64 + 8 * (fq & 1), offB = (fr >> 3) * 1152 + (fr & 7) * 16 + (fq >> 1) * 128 + 8 * (fq & 1);
    const int nt = 4 * hf + (w & 3);
    f32x4 sacc[8];
#pragma unroll
    for (int t = 0; t < 8; ++t) sacc[t] = (f32x4){0.f, 0.f, 0.f, 0.f};
    __syncthreads();
    u32x2 u0n[4];
#pragma unroll
    for (int it = 0; it < 4; ++it) u0n[it] = (u32x2){0u, 0u};
    if (comp) {
#pragma unroll
        for (int it = 0; it < 4; ++it) u0n[it] = *(const u32x2*)(U0g + ((size_t)(nt * 4 + it) * 64 + lane) * 4);
    } else {
        G2_DMA(0, 0);
        if (hw == 0) { *(LAS float*)(c.lds + G2_E1 + 4 * lane) = E1g[(size_t)(b * SEQ + lane) * 16 + vh]; *(LAS float*)(c.lds + G2_E2 + 4 * lane) = E2g[(size_t)(b * SEQ + lane) * 16 + vh]; }
    }
    asm volatile("s_waitcnt vmcnt(0)" ::: "memory");
    __syncthreads();
#pragma unroll 1
    for (int t = 0; t < GCH; ++t) {
        const LAS unsigned char* buf = c.lds + (t & 1) * G2_BUF; LAS unsigned char* nbuf = c.lds + ((t + 1) & 1) * G2_BUF;
        const int tok0 = b * SEQ + t * 64;
        const bool more = t + 1 < GCH;
        if (comp) {
            u32x2 u0r[4];
#pragma unroll
            for (int it = 0; it < 4; ++it) u0r[it] = u0n[it];
            if (more) {
#pragma unroll
                for (int it = 0; it < 4; ++it) u0n[it] = *(const u32x2*)(U0g + (size_t)(t + 1) * 8192 + ((size_t)(nt * 4 + it) * 64 + lane) * 4);
            }
            const LAS unsigned char* KCD = buf + GS_KCD; const LAS unsigned char* QB = buf + GS_QB; const LAS unsigned char* ATT = buf + GS_ATT; const LAS unsigned char* KT = buf + GS_KT;
            const LAS float* e1S = (const LAS float*)(buf + G2_E1); const LAS float* e2S = (const LAS float*)(buf + G2_E2);
            bf16x8 sfrag[4];
#pragma unroll
            for (int ks = 0; ks < 4; ++ks) sfrag[ks] = pack8(sacc[2 * ks], sacc[2 * ks + 1]);
            const float egl = e1S[63];
            bf16x8 ufrag[2], udfrag[2]; f32x4 ov[4];
#pragma unroll
            for (int hp = 0; hp < 2; ++hp) {
                f32x4 uu[2];
#pragma unroll
                for (int h2 = 0; h2 < 2; ++h2) {
                    const int it = 2 * hp + h2;
                    f32x4 ks_ = (f32x4){0.f, 0.f, 0.f, 0.f}, qs_ = (f32x4){0.f, 0.f, 0.f, 0.f};
#pragma unroll
                    for (int ks = 0; ks < 4; ++ks) {
                        ks_ = __builtin_amdgcn_mfma_f32_16x16x32_bf16(fragA(KCD + offA + it * 4352 + ks * 256), sfrag[ks], ks_, 0, 0, 0);
                        qs_ = __builtin_amdgcn_mfma_f32_16x16x32_bf16(fragA(QB + offA + it * 4352 + ks * 256), sfrag[ks], qs_, 0, 0, 0);
                    }
                    const f32x4 e1 = *(const LAS f32x4*)(e1S + 16 * it + 4 * fq);
                    f32x4 u;
                    u[0] = bf2f((bf16_t)(u0r[it].x & 0xffff)) - ks_[0]; u[1] = bf2f((bf16_t)(u0r[it].x >> 16)) - ks_[1]; u[2] = bf2f((bf16_t)(u0r[it].y & 0xffff)) - ks_[2]; u[3] = bf2f((bf16_t)(u0r[it].y >> 16)) - ks_[3];
                    uu[h2] = u; ov[it] = qs_ * e1;
                }
                ufrag[hp] = pack8(uu[0], uu[1]);
                const f32x4 g0 = *(const LAS f32x4*)(e2S + 32 * hp + 4 * fq), g1 = *(const LAS f32x4*)(e2S + 32 * hp + 16 + 4 * fq);
                udfrag[hp] = pack8(uu[0] * g0, uu[1] * g1);
            }
            LAS float* ot = OT + (t & 1) * (64 * 68);
#pragma unroll
            for (int it = 0; it < 4; ++it) {
                f32x4 au = ov[it];
#pragma unroll
                for (int ks = 0; ks < 2; ++ks) au = __builtin_amdgcn_mfma_f32_16x16x32_bf16(fragB(ATT + offB + it * 2304 + ks * 512), ufrag[ks], au, 0, 0, 0);
#pragma unroll
                for (int r = 0; r < 4; ++r) ot[(16 * it + 4 * fq + r) * 68 + 16 * (w & 3) + fr] = au[r];
            }
#pragma unroll
            for (int tt = 0; tt < 8; ++tt) {
                f32x4 a = sacc[tt] * egl;
#pragma unroll
                for (int ks = 0; ks < 2; ++ks) a = __builtin_amdgcn_mfma_f32_16x16x32_bf16(fragB(KT + offB + tt * 2304 + ks * 512), udfrag[ks], a, 0, 0, 0);
                sacc[tt] = a;
            }
        } else {
            float e1n = 0.f, e2n = 0.f;
            if (more) {
                G2_DMA(t + 1, (t + 1) & 1);
                if (hw == 0) { e1n = E1g[(size_t)(tok0 + 64 + lane) * 16 + vh]; e2n = E2g[(size_t)(tok0 + 64 + lane) * 16 + vh]; }
            }
            if (t > 0) G2_OUT(t - 1);
            if (more && hw == 0) { *(LAS float*)(nbuf + G2_E1 + 4 * lane) = e1n; *(LAS float*)(nbuf + G2_E2 + 4 * lane) = e2n; }
            asm volatile("s_waitcnt vmcnt(0)" ::: "memory");
        }
        __syncthreads();
    }
    if (!comp) G2_OUT(GCH - 1);
#undef G2_DMA
#undef G2_OUT
    if (comp) {
        float* so = c.p.out + O_PGS + ((size_t)(li * NB + b) * GH + vh) * GDK * GDV;
#pragma unroll
        for (int tt = 0; tt < 8; ++tt)
#pragma unroll
            for (int r = 0; r < 4; ++r) so[(size_t)(16 * tt + 4 * fq + r) * GDV + 16 * nt + fr] = sacc[tt][r];
    }
}
DI void gdn_norm_gate_token(const Ctx& c, int li, int tok) {
    const bf16_t* PROJ = c.ws<bf16_t>(W_PROJ); bf16_t* MIX = c.ws<bf16_t>(W_MIXED); const float* SSg = c.ws<float>(W_SS);
    const float* nw = c.in(I_GNW) + (size_t)li * GDV; const int lane = c.lane;
    u32x4 ov[4], zv[4]; float2 sv[4];
#pragma unroll
    for (int it = 0; it < 4; ++it) { const int ch0 = 512 * it + 8 * lane; ov[it] = *(const u32x4*)(MIX + (size_t)tok * GVW + ch0); zv[it] = *(const u32x4*)(PROJ + (size_t)tok * GDN_MAIN + 4096 + ch0);
        sv[it] = *(const float2*)(SSg + ((size_t)tok * 16 + (ch0 >> 7)) * 2); }
#pragma unroll
    for (int it = 0; it < 4; ++it) {
        const int ch0 = 512 * it + 8 * lane; float o[8], z[8], w8[8];
        unpack8(ov[it], o); unpack8(zv[it], z); load8f(nw + (ch0 & 127), w8);
        const float r = rsqrtf((sv[it].x + sv[it].y) * (1.f / 128.f) + EPS);
        u32x4 res; res.x = pk2(o[0] * r * w8[0] * siluf(z[0]), o[1] * r * w8[1] * siluf(z[1])); res.y = pk2(o[2] * r * w8[2] * siluf(z[2]), o[3] * r * w8[3] * siluf(z[3]));
        res.z = pk2(o[4] * r * w8[4] * siluf(z[4]), o[5] * r * w8[5] * siluf(z[5])); res.w = pk2(o[6] * r * w8[6] * siluf(z[6]), o[7] * r * w8[7] * siluf(z[7]));
        *(u32x4*)(MIX + (size_t)tok * GVW + ch0) = res;
    }
}

DI void gdn_post_token(const Ctx& c, int li, int tok) {
    const bf16_t* PROJ = c.ws<bf16_t>(W_PROJ); const float* Y = c.ws<float>(W_Y); bf16_t* MIX = c.ws<bf16_t>(W_MIXED);
    const float* nw = c.in(I_GNW) + (size_t)li * GDV; const int lane = c.lane;
#pragma unroll 1
    for (int it = 0; it < 4; ++it) {
        const int ch0 = 512 * it + 8 * lane; float o[8], z[8], w[8];
        load8f(Y + (size_t)tok * 2048 + ch0, o); unpack8(*(const u32x4*)(PROJ + (size_t)tok * GDN_MAIN + 4096 + ch0), z); load8f(nw + (ch0 & 127), w);
        float ss = 0.f;
#pragma unroll
        for (int e = 0; e < 8; ++e) ss += o[e] * o[e];
        ss += __shfl_xor(ss, 1); ss += __shfl_xor(ss, 2); ss += __shfl_xor(ss, 4); ss += __shfl_xor(ss, 8);
        const float r = rsqrtf(ss * (1.f / 128.f) + EPS);
        u32x4 ov; ov.x = pk2(o[0] * r * w[0] * siluf(z[0]), o[1] * r * w[1] * siluf(z[1])); ov.y = pk2(o[2] * r * w[2] * siluf(z[2]), o[3] * r * w[3] * siluf(z[3]));
        ov.z = pk2(o[4] * r * w[4] * siluf(z[4]), o[5] * r * w[5] * siluf(z[5])); ov.w = pk2(o[6] * r * w[6] * siluf(z[6]), o[7] * r * w[7] * siluf(z[7]));
        *(u32x4*)(MIX + (size_t)tok * GVW + ch0) = ov;
    }
}

DI void cache_copy(const Ctx& c, int wg, int nwg, int part) {
    const size_t gt = (size_t)wg * NTHR + c.tid, gn = (size_t)nwg * NTHR;
    const size_t per = (size_t)(WIN - 1) * AW / 4, tot = (size_t)2 * NS * per, cut = tot / 2, lo = part ? cut : 0, hi = part ? tot : cut;
#pragma unroll 8
    for (size_t i = lo + gt; i < hi; i += gn) { const size_t sq = i / per, r = i % per;
        ((f32x4*)(c.p.out + O_SK + sq * WIN * AW))[r] = ((const f32x4*)(c.in(I_CK) + sq * WIN * AW + AW))[r];
        ((f32x4*)(c.p.out + O_SV + sq * WIN * AW))[r] = ((const f32x4*)(c.in(I_CV) + sq * WIN * AW + AW))[r]; }
}
DI void weights_half(const Ctx& c, int half, int gw0, int ngw0) {
    const int i = half;
    transpose_mat(c, c.in(I_WHIN) + (size_t)i * D * HYB_IN, D, HYB_IN, c.ws<bf16_t>(W_HIN) + (size_t)i * HYB_IN * D, 0, gw0, ngw0);
    transpose_mat(c, c.in(I_WHOUT) + (size_t)i * HYB_MIX * D, HYB_MIX, D, c.ws<bf16_t>(W_HOUT) + (size_t)i * D * HYB_MIX, 0, gw0, ngw0);
    transpose_mat(c, c.in(I_WGIN) + (size_t)i * D * GDN_IN, D, GDN_IN, c.ws<bf16_t>(W_GIN) + (size_t)i * GDN_IN * D, 0, gw0, ngw0);
    transpose_mat(c, c.in(I_WGOUT) + (size_t)i * GVW * D, GVW, D, c.ws<bf16_t>(W_GOUT) + (size_t)i * D * GVW, 0, gw0, ngw0);
    for (int l = 2 * half; l < 2 * half + 2; ++l) {
        transpose_mat(c, c.in(I_WFG) + (size_t)l * D * FF, D, FF, c.ws<bf16_t>(W_GU) + (size_t)l * 2 * FF * D, 1, gw0, ngw0);
        transpose_mat(c, c.in(I_WFU) + (size_t)l * D * FF, D, FF, c.ws<bf16_t>(W_GU) + (size_t)l * 2 * FF * D, 2, gw0, ngw0);
        transpose_mat(c, c.in(I_WFD) + (size_t)l * FF * D, FF, D, c.ws<bf16_t>(W_DN) + (size_t)l * D * FF, 0, gw0, ngw0);
    }
}
constexpr int PH_PER_LAYER = 10, N_PHASES = 1 + 2 * 10 + 2 * 9;
DI void phase_decode(int ph, int& l, int& sp) {
    int q = ph - 1; l = 0; if (q >= 10) { q -= 10; l = 1; if (q >= 9) { q -= 9; l = 2; if (q >= 10) { q -= 10; l = 3; } } }
    sp = (l & 1) ? (q >= 2 ? q + 1 : q) : q;
}
#ifndef ONLY
#define ONLY -1
#endif
#define EN(x) (ONLY < 0 || ONLY == (x))
DI void run_phase(const Ctx& c, int ph) {
    if (ph == 0) { if (!EN(0)) return;
        weights_half(c, 0, -1, 0); weights_half(c, 1, -1, 0);
        rowpass_phase(c, 0, nullptr, c.in(I_NMPRE), true);
        return;
    }
    int l, sp; phase_decode(ph, l, sp); const int li = l >> 1; const bool hyb = (l & 1) == 0;
    bf16_t* H = c.ws<bf16_t>(W_H); bf16_t* PROJ = c.ws<bf16_t>(W_PROJ); bf16_t* MIX = c.ws<bf16_t>(W_MIXED); bf16_t* GO = c.ws<bf16_t>(W_GO); bf16_t* HID = c.ws<bf16_t>(W_HID);
    switch (sp) {
    case 0: {
        if (!EN(1)) break;
        const bf16_t* Wt = hyb ? c.ws<bf16_t>(W_HIN) + (size_t)li * HYB_IN * D : c.ws<bf16_t>(W_GIN) + (size_t)li * GDN_IN * D;
        const int nmain = hyb ? HYB_MAIN : GDN_MAIN, nall = hyb ? HYB_IN : GDN_IN;
        { pg8::Gemm g{H, Wt, T, nmain, D}; pg8::StaticOrder S; S.init(T, nmain, gridDim.x, blockIdx.x); pg8::EpiBf16Perm E{PROJ, nmain};
          pg8::gemm_phase<pg8::EpiBf16Perm, pg8::StaticOrder>(c.lds, g, S, E, nullptr); }
        { Epi e{0, PROJ, c.ws<float>(W_EXTRA), nmain, 0}; gemm_ksplit<4>(c, H, D, T, Wt + (size_t)nmain * D, D, nall - nmain, D, e); }
        { Epi e{0, PROJ + (size_t)T * nmain, c.ws<float>(W_EXTRA) + (size_t)T * 32, nmain, nmain}; gemm_ksplit<2>(c, H + (size_t)T * D, D, NS, Wt, D, nall, D, e); }
    } break;
    case 1: {
        if (hyb) {
            if (EN(2)) { if (c.wave == 0) for (int tok = T + blockIdx.x; tok < TT; tok += gridDim.x) hyb_pre_token(c, li, tok);
                         for (int tok = c.gw; tok < T; tok += c.ngw) hyb_pre_token(c, li, tok); }
            LAS float* pl = (LAS float*)(c.lds + NWAVE * AT_LDS + c.wave * 2048);
            if (EN(3)) { for (int it = blockIdx.x; it < NS * AH; it += gridDim.x) attn_sample_wg(c, li, it);
                         for (int it = c.gw; it < NB * AH * 256; it += c.ngw) attn_mfma_item(c, li, it); }
        } else { if (EN(4)) {
            if (c.wave == 0) for (int tok = T + blockIdx.x; tok < TT; tok += gridDim.x) gdn_pre_token(c, li, tok);
            for (int rg = blockIdx.x; rg < T / 64; rg += gridDim.x) {
                gdn_pre_range(c, li, rg * 8 + c.wave);
                asm volatile("s_waitcnt vmcnt(0)" ::: "memory"); __syncthreads();
                const int bb = rg >> 6, ch = rg & 63;
#pragma unroll 1
                for (int k2 = 0; k2 < 2; ++k2) gdn_a_item(c, li, ((bb * GH + 2 * c.wave + k2) << 6) + ch);
                __syncthreads();
            } } }
    } break;
    case 2: {
        if (hyb) { if (EN(5)) { for (int it = blockIdx.x; it < NB * NCH * 2; it += gridDim.x) ssd_a_item(c, li, it);
                                for (int it = c.gw; it < NS * SH * 4; it += c.ngw) ssd_sample_item(c, li, it); } }
        else { }
    } break;
    case 3: {
        if (hyb) { if (EN(7)) { ssd_scan_phase(c, li); if (c.wave == 0) for (int tok = T + blockIdx.x; tok < TT; tok += gridDim.x) hyb_post_token(c, li, tok); } }
        else { if (EN(8)) {
            constexpr int NSW = 2 * NB * GH;
            if ((int)blockIdx.x < NSW) gdn_scan2_wg(c, li, ((blockIdx.x >> 4) << 3) + (blockIdx.x & 7), (blockIdx.x >> 3) & 1);
            else { const int wg = blockIdx.x - NSW, nwg = gridDim.x - NSW;
                gdn_seq_phase(c, li, NB * GH, wg, nwg);
                cache_copy(c, wg, nwg, l == 1 ? 0 : 1);
                } } }
    } break;
    case 4: {
        if (hyb) { if (EN(14)) for (int it = blockIdx.x; it < NB * NCH * 2; it += gridDim.x) ssd_b_item(c, li, it); }
        else { if (EN(15)) for (int tok = c.gw; tok < T; tok += c.ngw) gdn_norm_gate_token(c, li, tok); }
    } break;
    case 5: {
        if (!EN(9)) break;
        const bf16_t* Wt = hyb ? c.ws<bf16_t>(W_HOUT) + (size_t)li * D * HYB_MIX : c.ws<bf16_t>(W_GOUT) + (size_t)li * D * GVW; const int kk = hyb ? HYB_MIX : GVW;
        { pg8::Gemm g{MIX, Wt, T, D, kk}; pg8::StaticOrder S; S.init(T, D, gridDim.x, blockIdx.x); pg8::EpiBf16Perm E{GO, D};
          pg8::gemm_phase<pg8::EpiBf16Perm, pg8::StaticOrder>(c.lds, g, S, E, nullptr); }
        { Epi e{0, GO + (size_t)T * D, nullptr, D, D}; gemm_ksplit<2>(c, MIX + (size_t)T * kk, kk, NS, Wt, kk, D, kk, e); }
    } break;
    case 6: if (EN(10)) rowpass_phase(c, 1, c.in(I_NMPOST) + (size_t)l * D, c.in(I_NFPRE) + (size_t)l * D, l == 0); break;
    case 7: if (EN(11)) { const bf16_t* Wt = c.ws<bf16_t>(W_GU) + (size_t)l * 2 * FF * D;
        { pg8::Gemm g{H, Wt, T, 2 * FF, D}; pg8::StaticOrder S; S.init(T, 2 * FF, gridDim.x, blockIdx.x); pg8::EpiSwiglu E{HID, FF};
          pg8::gemm_phase<pg8::EpiSwiglu, pg8::StaticOrder>(c.lds, g, S, E, nullptr); }
        { Epi e{2, HID + (size_t)T * FF, nullptr, FF, 0}; gemm_ksplit<2>(c, H + (size_t)T * D, D, NS, Wt, D, 2 * FF, D, e); } } break;
    case 8: if (EN(12)) { const bf16_t* Wt = c.ws<bf16_t>(W_DN) + (size_t)l * D * FF;
        { pg8::Gemm g{HID, Wt, T, D, FF}; pg8::StaticOrder S; S.init(T, D, gridDim.x, blockIdx.x); pg8::EpiBf16Perm E{GO, D};
          pg8::gemm_phase<pg8::EpiBf16Perm, pg8::StaticOrder>(c.lds, g, S, E, nullptr); }
        { Epi e{0, GO + (size_t)T * D, nullptr, D, D}; gemm_ksplit<2>(c, HID + (size_t)T * FF, FF, NS, Wt, FF, D, FF, e); } } break;
    case 9: if (EN(13)) rowpass_phase(c, l == DEPTH - 1 ? 2 : 1, c.in(I_NFPOST) + (size_t)l * D, l == DEPTH - 1 ? nullptr : c.in(I_NMPRE) + (size_t)(l + 1) * D, false); break;
    default: break;
    }
}

extern __shared__ __attribute__((aligned(16))) unsigned char g_shm[];
__global__ void __launch_bounds__(NTHR, 2) mega(Params p) {
    cg::grid_group grid = cg::this_grid();
    volatile LAS unsigned* bst = (volatile LAS unsigned*)((LAS unsigned char*)g_shm + LDS_BYTES - 16);
    if (threadIdx.x == 0) { bst[0] = 0u; bst[1] = 0u; bst[2] = 0u; bst[3] = 0u; }
    __syncthreads();
    const XcdBarrier xb = xcd_barrier_post((unsigned*)p.ws, bst);
    for (int ph = p.ph_lo; ph < p.ph_hi; ++ph) {
        int tid_ = threadIdx.x; asm volatile("" : "+v"(tid_));
        Ctx c; c.p.kp = (KParams)__builtin_amdgcn_kernarg_segment_ptr(); c.p.out = c.p.kp->out; c.tid = tid_; c.lane = tid_ & 63; c.wave = __builtin_amdgcn_readfirstlane(tid_ >> 6);
        c.gw = blockIdx.x * NWAVE + c.wave; c.ngw = gridDim.x * NWAVE; c.lds = (LAS unsigned char*)g_shm;
        run_phase(c, ph);
#ifdef PROBE_MASK
        { int l_ = 0, sp_ = 0; if (ph > 0) phase_decode(ph, l_, sp_); const int bit = ph == 0 ? 20 : sp_ + 10 * (l_ & 1);
          if ((PROBE_MASK >> bit) & 1) { xcd_barrier(xb); run_phase(c, ph); } }
#endif
        if (ph + 1 < p.ph_hi) { if (ph == p.ph_lo) grid.sync(); else xcd_barrier(xb); }
    }
}

extern "C" void kernel_launch(void* const* d_in, const int* in_sizes, int n_in, void* d_out, int out_size, void* d_ws, size_t ws_size, hipStream_t stream) {
    static int grid = 0;
    if (!grid) {
        int dev = 0, cus = 0, per = 0; hipGetDevice(&dev); hipDeviceGetAttribute(&cus, hipDeviceAttributeMultiprocessorCount, dev);
        hipFuncSetAttribute((const void*)mega, hipFuncAttributeMaxDynamicSharedMemorySize, LDS_BYTES);
        hipOccupancyMaxActiveBlocksPerMultiprocessor(&per, (const void*)mega, NTHR, LDS_BYTES);
        if (n_in != 30 || (size_t)out_size != O_END || ws_size < W_END) fprintf(stderr, "kernel_launch: unexpected shapes n_in %d out %d (want %zu) ws %zu (want %zu)\n", n_in, out_size, (size_t)O_END, ws_size, (size_t)W_END);
        if (per < 1) fprintf(stderr, "kernel_launch: occupancy query says %d blocks per CU\n", per);
        grid = cus;
    }
    hipMemsetAsync(d_ws, 0, 16384, stream);
    Params p{}; for (int i = 0; i < 30; ++i) p.in[i] = (const float*)d_in[i];
    p.out = (float*)d_out; p.ws = (unsigned char*)d_ws; p.ph_lo = 0; p.ph_hi = N_PHASES;
    void* args[] = {&p};
    hipError_t e = hipLaunchCooperativeKernel((const void*)mega, dim3(grid), dim3(NTHR), args, LDS_BYTES, stream);
    if (e != hipSuccess) fprintf(stderr, "kernel_launch: cooperative launch failed: %s\n", hipGetErrorString(e));
}
```

```cpp
#include <hip/hip_runtime.h>
#include <hip/hip_cooperative_groups.h>
#include <cstdio>
#include <cstdint>
namespace cg = cooperative_groups;

#define DI __device__ __forceinline__
#define LAS __attribute__((address_space(3)))
typedef unsigned short bf16_t;
typedef short bf16x8 __attribute__((ext_vector_type(8)));
typedef float f32x4 __attribute__((ext_vector_type(4)));
typedef unsigned u32x2 __attribute__((ext_vector_type(2)));
typedef unsigned u32x4 __attribute__((ext_vector_type(4)));

constexpr int D = 1024, NB = 4, SEQ = 4096, T = NB * SEQ, NS = 32, TT = T + NS, DEPTH = 4;
constexpr int AH = 8, AHD = 64, AW = 512, WIN = 2048;
constexpr int SH = 16, SP = 64, SN = 128, SG = 2, SDI = 1024, SXBC = 1536;
constexpr int HYB_IN = 4112, HYB_MAIN = 4096, HYB_MIX = 1536;
constexpr int GH = 16, GQH = 8, GDK = 128, GDV = 128, GQKV = 4096, GVW = 2048, GDN_IN = 6176, GDN_MAIN = 6144;
constexpr int FF = 2816;
constexpr float EPS = 1e-6f;
constexpr int NTHR = 512, NWAVE = 8, LDS_BYTES = 163840;

enum { I_XP = 0, I_XS, I_CK, I_CV, I_SCONV, I_SSM, I_GCONV, I_GST, I_RELB, I_NMPRE, I_NMPOST, I_NFPRE, I_NFPOST, I_WHIN, I_SCW, I_SCB, I_SDTB, I_SALOG, I_SD, I_SNW,
       I_WHOUT, I_WGIN, I_GCW, I_GDTB, I_GALOG, I_GNW, I_WGOUT, I_WFG, I_WFU, I_WFD };

constexpr size_t O_YP = 0;
constexpr size_t O_YS = O_YP + (size_t)T * D;
constexpr size_t O_PK = O_YS + (size_t)NS * D;
constexpr size_t O_PV = O_PK + (size_t)2 * NB * WIN * AW;
constexpr size_t O_PSC = O_PV + (size_t)2 * NB * WIN * AW;
constexpr size_t O_PSS = O_PSC + (size_t)2 * NB * 3 * SXBC;
constexpr size_t O_PGC = O_PSS + (size_t)2 * NB * SH * SP * SN;
constexpr size_t O_PGS = O_PGC + (size_t)2 * NB * 3 * GQKV;
constexpr size_t O_SK = O_PGS + (size_t)2 * NB * GH * GDK * GDV;
constexpr size_t O_SV = O_SK + (size_t)2 * NS * WIN * AW;
constexpr size_t O_SSC = O_SV + (size_t)2 * NS * WIN * AW;
constexpr size_t O_SSS = O_SSC + (size_t)2 * NS * 3 * SXBC;
constexpr size_t O_SGC = O_SSS + (size_t)2 * NS * SH * SP * SN;
constexpr size_t O_SGS = O_SGC + (size_t)2 * NS * 3 * GQKV;
constexpr size_t O_END = O_SGS + (size_t)2 * NS * GH * GDK * GDV;

constexpr size_t al256(size_t x) { return (x + 255) & ~(size_t)255; }
constexpr size_t W_CTL = 0;
constexpr size_t W_HIN = 65536;
constexpr size_t W_HOUT = al256(W_HIN + (size_t)2 * HYB_IN * D * 2);
constexpr size_t W_GIN = al256(W_HOUT + (size_t)2 * D * HYB_MIX * 2);
constexpr size_t W_GOUT = al256(W_GIN + (size_t)2 * GDN_IN * D * 2);
constexpr size_t W_GU = al256(W_GOUT + (size_t)2 * D * GVW * 2);
constexpr size_t W_DN = al256(W_GU + (size_t)4 * 2 * FF * D * 2);
constexpr size_t W_X = al256(W_DN + (size_t)4 * D * FF * 2);
constexpr size_t W_H = al256(W_X + (size_t)TT * D * 4);
constexpr size_t W_PROJ = al256(W_H + (size_t)TT * D * 2);
constexpr size_t W_EXTRA = al256(W_PROJ + (size_t)TT * GDN_MAIN * 2);
constexpr size_t W_MIXED = al256(W_EXTRA + (size_t)TT * 32 * 4);
constexpr size_t W_GO = al256(W_MIXED + (size_t)TT * GVW * 2);
constexpr size_t W_HID = al256(W_GO + (size_t)TT * D * 4);
constexpr size_t W_ACT = al256(W_HID + (size_t)TT * FF * 2);
constexpr size_t W_AUX = al256(W_ACT + (size_t)TT * 4096 * 4);
constexpr size_t W_Y = al256(W_AUX + (size_t)TT * 32 * 4);
constexpr size_t W_END = al256(W_Y + (size_t)TT * 2048 * 4);

struct Params { const float* in[30]; float* out; unsigned char* ws; int ph_lo, ph_hi; };

DI float bf2f(bf16_t b) { return __uint_as_float(((unsigned)b) << 16); }
DI bf16_t f2bf(float x) { const __bf16 b = (__bf16)x; return __builtin_bit_cast(bf16_t, b); }
typedef float f32x2_ __attribute__((ext_vector_type(2))); typedef __bf16 bf16x2_ __attribute__((ext_vector_type(2)));
DI unsigned pk2(float lo, float hi) { const f32x2_ v = {lo, hi}; return __builtin_bit_cast(unsigned, __builtin_convertvector(v, bf16x2_)); }
DI float wave_sum(float v) {
#pragma unroll
    for (int o = 32; o >= 1; o >>= 1) v += __shfl_xor(v, o);
    return v;
}
DI float wave_max(float v) {
#pragma unroll
    for (int o = 32; o >= 1; o >>= 1) v = fmaxf(v, __shfl_xor(v, o));
    return v;
}
DI float siluf(float x) { return x * __builtin_amdgcn_rcpf(1.f + __expf(-x)); }
DI float sigmoidf_(float x) { return __builtin_amdgcn_rcpf(1.f + __expf(-x)); }
DI float softplusf_(float x) { return fmaxf(x, 0.f) + __logf(1.f + __expf(-fabsf(x))); }
#define LDS_WAIT() asm volatile("s_waitcnt lgkmcnt(0)" ::: "memory")
DI bf16x8 lds_frag(const LAS bf16_t* p) { return *(const LAS bf16x8*)p; }
DI bf16x8 lds_frag2(const LAS bf16_t* p0, const LAS bf16_t* p1) {
    const u32x2 a = *(const LAS u32x2*)p0, b = *(const LAS u32x2*)p1; u32x4 r; r.x = a.x; r.y = a.y; r.z = b.x; r.w = b.y; return __builtin_bit_cast(bf16x8, r);
}
DI bf16x8 pack8(const f32x4 a, const f32x4 b) { u32x4 r; r.x = pk2(a.x, a.y); r.y = pk2(a.z, a.w); r.z = pk2(b.x, b.y); r.w = pk2(b.z, b.w); return __builtin_bit_cast(bf16x8, r); }
DI bf16x8 gfrag_f32(const float* p) { return pack8(*(const f32x4*)p, *(const f32x4*)(p + 4)); }

__device__ const unsigned char c_bucket[3][129] = {
 {0,1,2,3,4,5,6,7,8,9,10,11,12,13,14,15,16,16,16,16,16,16,17,17,17,17,17,17,17,17,18,18,18,18,18,18,18,18,18,18,19,19,19,19,19,19,19,19,19,19,19,19,19,19,20,20,20,20,20,20,20,20,20,20,20,20,20,20,20,20,20,20,20,21,21,21,21,21,21,21,21,21,21,21,21,21,21,21,21,21,21,21,21,21,21,21,21,21,21,22,22,22,22,22,22,22,22,22,22,22,22,22,22,22,22,22,22,22,22,22,22,22,22,22,22,22,22,22,22},
 {0,4,8,12,16,16,17,17,18,18,19,19,19,19,20,20,20,20,20,21,21,21,21,21,21,22,22,22,22,22,22,22,22,22,23,23,23,23,23,23,23,23,23,23,23,23,24,24,24,24,24,24,24,24,24,24,24,24,24,24,24,24,25,25,25,25,25,25,25,25,25,25,25,25,25,25,25,25,25,25,25,25,25,26,26,26,26,26,26,26,26,26,26,26,26,26,26,26,26,26,26,26,26,26,26,26,26,26,26,26,26,26,26,27,27,27,27,27,27,27,27,27,27,27,27,27,27,27,27},
 {0,16,18,19,20,21,21,22,22,23,23,23,24,24,24,24,25,25,25,25,25,26,26,26,26,26,26,26,26,27,27,27,27,27,27,27,27,27,27,28,28,28,28,28,28,28,28,28,28,28,28,28,29,29,29,29,29,29,29,29,29,29,29,29,29,29,29,29,29,29,30,30,30,30,30,30,30,30,30,30,30,30,30,30,30,30,30,30,30,30,30,30,30,30,30,31,31,31,31,31,31,31,31,31,31,31,31,31,31,31,31,31,31,31,31,31,31,31,31,31,31,31,31,31,31,31,31,31,31}};

typedef const Params __attribute__((address_space(4)))* KParams;
struct OutRef { float* out; DI float* operator+(size_t o) const { return out + o; } };
struct PRef { KParams kp; float* out; };
#define XB_TMO      128
#define XB_XCNT(j)  (256  + 64 * (j))
#define XB_XSUB(j)  (1280 + 64 * (j))
#define XB_XGEN(j)  (2304 + 64 * (j))
#define XB_TOP      3328
#define XB_TOPGEN   3392
#define XCD_BAR_WORDS 3456
#define XB_SPIN_CAP (1u << 22)

__device__ __forceinline__ unsigned xb_ld(unsigned* p)              { return __hip_atomic_load(p, __ATOMIC_RELAXED, __HIP_MEMORY_SCOPE_AGENT); }
__device__ __forceinline__ unsigned xb_add(unsigned* p, unsigned v) { return __hip_atomic_fetch_add(p, v, __ATOMIC_RELAXED, __HIP_MEMORY_SCOPE_AGENT); }
__device__ __forceinline__ unsigned xb_xcc_id() { return (unsigned)__builtin_amdgcn_s_getreg((3 << 11) | 20) & 0xFu; }
#define XB_SPIN(cond, bar) do { unsigned _sp = 0; while (cond) { __builtin_amdgcn_s_sleep(1); \
    if ((++_sp & 255u) == 0u) { if (xb_ld(&(bar)[XB_TMO])) break; if (_sp > XB_SPIN_CAP) { atomicAdd(&(bar)[XB_TMO], 1u); break; } } } } while (0)

struct XcdBarrier {
    unsigned* bar; unsigned x;
    volatile LAS unsigned* st;
};

__device__ __forceinline__ XcdBarrier xcd_barrier_post(unsigned* bar, volatile LAS unsigned* st) {
    XcdBarrier b; b.bar = bar; b.x = xb_xcc_id(); b.st = st;
    if (threadIdx.x == 0) (void)xb_add(&bar[XB_XCNT(b.x)], 1u);
    return b;
}
__device__ __forceinline__ void xcd_barrier_complete(unsigned* bar, unsigned x, unsigned& nloc, unsigned& nx) {
    const unsigned G = gridDim.x * gridDim.y * gridDim.z;
    unsigned sum, cnt, mine, sp = 0u;
    for (;;) {
        sum = 0u; cnt = 0u; mine = 0u;
#pragma unroll
        for (unsigned j = 0; j < 16; ++j) { const unsigned c = xb_ld(&bar[XB_XCNT(j)]); sum += c; cnt += (c > 0u) ? 1u : 0u; mine = (j == x) ? c : mine; }
        if (sum == G) break;
        __builtin_amdgcn_s_sleep(1);
        if ((++sp & 255u) == 0u) { if (xb_ld(&bar[XB_TMO])) break; if (sp > XB_SPIN_CAP) { atomicAdd(&bar[XB_TMO], 1u); break; } }
    }
    nloc = mine > 0u ? mine : 1u; nx = cnt > 0u ? cnt : 1u;
}

__device__ __forceinline__ void xcd_barrier(const XcdBarrier& b) {
    asm volatile("s_waitcnt vmcnt(0)" ::: "memory");
    __syncthreads();
    if (threadIdx.x == 0) {
        unsigned* bar = b.bar;
        __builtin_amdgcn_s_waitcnt(0);
        unsigned nloc = b.st[0], nx = b.st[1];
        if (nloc == 0u) { xcd_barrier_complete(bar, b.x, nloc, nx); b.st[0] = nloc; b.st[1] = nx; }
        const unsigned old = xb_add(&bar[XB_XSUB(b.x)], 1u);
        const unsigned gen = old / nloc;
        if (old + 1u == (gen + 1u) * nloc) {
            __builtin_amdgcn_fence(__ATOMIC_RELEASE, "agent");
            asm volatile("s_waitcnt vmcnt(0)" ::: "memory");
            const unsigned og = xb_add(&bar[XB_TOP], 1u);
            const unsigned tg = og / nx;
            if (og + 1u == (tg + 1u) * nx) xb_add(&bar[XB_TOPGEN], 1u);
            else XB_SPIN(xb_ld(&bar[XB_TOPGEN]) == tg, bar);
            __builtin_amdgcn_fence(__ATOMIC_ACQUIRE, "agent");
            xb_add(&bar[XB_XGEN(b.x)], 1u);
            asm volatile("s_waitcnt vmcnt(0)" ::: "memory");
        } else {
            XB_SPIN(xb_ld(&bar[XB_XGEN(b.x)]) == gen, bar);
            __builtin_amdgcn_fence(__ATOMIC_ACQUIRE, "agent");
            asm volatile("s_waitcnt vmcnt(0)" ::: "memory");
        }
    }
    __syncthreads();
}

struct Ctx {
    PRef p; int tid, lane, wave, gw, ngw; LAS unsigned char* lds;
    DI const float* in(int i) const { return p.kp->in[i]; }
    template <class Tp> DI Tp* ws(size_t off) const { return (Tp*)(p.kp->ws + off); }
};

DI int rowmap(int n, int map) { return map == 0 ? n : (32 * (n >> 4) + (n & 15) + (map == 2 ? 16 : 0)); }
DI void transpose_item(const float* W, int K, int N, bf16_t* WT, int map, LAS float* scr, int item, int lane) {
    const int nblk = (N + 31) / 32, kb = item / nblk, nb = item % nblk, k0 = 64 * kb, n0 = 32 * nb;
    float wv[32];
#pragma unroll
    for (int i = 0; i < 32; ++i) { const int kk = 2 * i + (lane >> 5), n = n0 + (lane & 31); wv[i] = n < N ? W[(size_t)(k0 + kk) * N + n] : 0.f; }
#pragma unroll
    for (int i = 0; i < 32; ++i) scr[(2 * i + (lane >> 5)) * 33 + (lane & 31)] = wv[i];
    LDS_WAIT();
    const int c = lane & 7;
#pragma unroll
    for (int j = 0; j < 4; ++j) {
        const int nn = (lane >> 3) + 8 * j, n = n0 + nn; const LAS float* s = scr + (8 * c) * 33 + nn;
        u32x4 o; o.x = pk2(s[0], s[33]); o.y = pk2(s[66], s[99]); o.z = pk2(s[132], s[165]); o.w = pk2(s[198], s[231]);
        if (n < N) *(u32x4*)(WT + (size_t)rowmap(n, map) * K + k0 + 8 * c) = o;
    }
    LDS_WAIT();
}
DI void transpose_mat(const Ctx& c, const float* W, int K, int N, bf16_t* WT, int map, int gw0 = -1, int ngw0 = 0) {
    LAS float* scr = (LAS float*)(c.lds + c.wave * 8704);
    const int nit = (K / 64) * ((N + 31) / 32);
    const int g0 = gw0 < 0 ? c.gw : gw0, n0 = gw0 < 0 ? c.ngw : ngw0;
    for (int it = g0; it < nit; it += n0) transpose_item(W, K, N, WT, map, scr, it, c.lane);
}

DI void rowpass_row(const float* xrow, const bf16_t* gorow, const float* gpost, const float* gnext, float* xdst, bf16_t* hrow, float* yout, int lane) {
    f32x4 x[4]; float ss = 0.f;
    if (gorow) {
        f32x4 g[4];
#pragma unroll
        for (int j = 0; j < 4; ++j) { const u32x2 gv = *(const u32x2*)(gorow + 4 * lane + 256 * j); g[j] = (f32x4){bf2f((bf16_t)(gv.x & 0xffff)), bf2f((bf16_t)(gv.x >> 16)), bf2f((bf16_t)(gv.y & 0xffff)), bf2f((bf16_t)(gv.y >> 16))}; ss += g[j].x * g[j].x + g[j].y * g[j].y + g[j].z * g[j].z + g[j].w * g[j].w; }
        const float r = rsqrtf(wave_sum(ss) * (1.f / D) + EPS);
#pragma unroll
        for (int j = 0; j < 4; ++j) { const f32x4 w = *(const f32x4*)(gpost + 4 * lane + 256 * j); x[j] = *(const f32x4*)(xrow + 4 * lane + 256 * j) + g[j] * r * w; }
    } else {
#pragma unroll
        for (int j = 0; j < 4; ++j) x[j] = *(const f32x4*)(xrow + 4 * lane + 256 * j);
    }
    if (xdst) {
#pragma unroll
        for (int j = 0; j < 4; ++j) *(f32x4*)(xdst + 4 * lane + 256 * j) = x[j];
    }
    if (yout) {
#pragma unroll
        for (int j = 0; j < 4; ++j) *(f32x4*)(yout + 4 * lane + 256 * j) = x[j];
    }
    if (hrow) {
        float s2 = 0.f;
#pragma unroll
        for (int j = 0; j < 4; ++j) s2 += x[j].x * x[j].x + x[j].y * x[j].y + x[j].z * x[j].z + x[j].w * x[j].w;
        const float r2 = rsqrtf(wave_sum(s2) * (1.f / D) + EPS);
#pragma unroll
        for (int j = 0; j < 4; ++j) { const f32x4 w = *(const f32x4*)(gnext + 4 * lane + 256 * j); const f32x4 h = x[j] * r2 * w;
            u32x2 o; o.x = pk2(h.x, h.y); o.y = pk2(h.z, h.w); *(u32x2*)(hrow + 4 * lane + 256 * j) = o; }
    }
}
DI void rowpass_rows4(const float* xrow, const bf16_t* gorow, const float* gpost, const float* gnext, float* xdst, bf16_t* hrow, float* yout, int lane) {
    f32x4 x[4][4]; float ss[4] = {0.f, 0.f, 0.f, 0.f};
#pragma unroll
    for (int r = 0; r < 4; ++r)
#pragma unroll
        for (int j = 0; j < 4; ++j) x[r][j] = *(const f32x4*)(xrow + (size_t)r * D + 4 * lane + 256 * j);
    if (gorow) {
        u32x2 gv[4][4];
#pragma unroll
        for (int r = 0; r < 4; ++r)
#pragma unroll
            for (int j = 0; j < 4; ++j) gv[r][j] = *(const u32x2*)(gorow + (size_t)r * D + 4 * lane + 256 * j);
        f32x4 wp[4];
#pragma unroll
        for (int j = 0; j < 4; ++j) wp[j] = *(const f32x4*)(gpost + 4 * lane + 256 * j);
#pragma unroll
        for (int r = 0; r < 4; ++r)
#pragma unroll
            for (int j = 0; j < 4; ++j) { const float a = bf2f((bf16_t)(gv[r][j].x & 0xffff)), b2 = bf2f((bf16_t)(gv[r][j].x >> 16)), c2 = bf2f((bf16_t)(gv[r][j].y & 0xffff)), d2 = bf2f((bf16_t)(gv[r][j].y >> 16)); ss[r] += a * a + b2 * b2 + c2 * c2 + d2 * d2; }
#pragma unroll
        for (int o = 32; o >= 1; o >>= 1) { ss[0] += __shfl_xor(ss[0], o); ss[1] += __shfl_xor(ss[1], o); ss[2] += __shfl_xor(ss[2], o); ss[3] += __shfl_xor(ss[3], o); }
#pragma unroll
        for (int r = 0; r < 4; ++r) { const float rn = rsqrtf(ss[r] * (1.f / D) + EPS);
#pragma unroll
            for (int j = 0; j < 4; ++j) { const f32x4 g = (f32x4){bf2f((bf16_t)(gv[r][j].x & 0xffff)), bf2f((bf16_t)(gv[r][j].x >> 16)), bf2f((bf16_t)(gv[r][j].y & 0xffff)), bf2f((bf16_t)(gv[r][j].y >> 16))}; x[r][j] += g * rn * wp[j]; } }
    }
    if (xdst) {
#pragma unroll
        for (int r = 0; r < 4; ++r)
#pragma unroll
            for (int j = 0; j < 4; ++j) *(f32x4*)(xdst + (size_t)r * D + 4 * lane + 256 * j) = x[r][j];
    }
    if (yout) {
#pragma unroll
        for (int r = 0; r < 4; ++r)
#pragma unroll
            for (int j = 0; j < 4; ++j) *(f32x4*)(yout + (size_t)r * D + 4 * lane + 256 * j) = x[r][j];
    }
    if (hrow) {
        float s2[4];
#pragma unroll
        for (int r = 0; r < 4; ++r) { s2[r] = 0.f;
#pragma unroll
            for (int j = 0; j < 4; ++j) s2[r] += x[r][j].x * x[r][j].x + x[r][j].y * x[r][j].y + x[r][j].z * x[r][j].z + x[r][j].w * x[r][j].w; }
#pragma unroll
        for (int o = 32; o >= 1; o >>= 1) { s2[0] += __shfl_xor(s2[0], o); s2[1] += __shfl_xor(s2[1], o); s2[2] += __shfl_xor(s2[2], o); s2[3] += __shfl_xor(s2[3], o); }
        f32x4 wn[4];
#pragma unroll
        for (int j = 0; j < 4; ++j) wn[j] = *(const f32x4*)(gnext + 4 * lane + 256 * j);
#pragma unroll
        for (int r = 0; r < 4; ++r) { const float r2 = rsqrtf(s2[r] * (1.f / D) + EPS);
#pragma unroll
            for (int j = 0; j < 4; ++j) { const f32x4 h = x[r][j] * r2 * wn[j]; u32x2 o; o.x = pk2(h.x, h.y); o.y = pk2(h.z, h.w); *(u32x2*)(hrow + (size_t)r * D + 4 * lane + 256 * j) = o; } }
    }
}
DI void rowpass_phase(const Ctx& c, int mode, const float* gpost, const float* gnext, bool x_from_input) {
    float* X = c.ws<float>(W_X); const bf16_t* GO = c.ws<bf16_t>(W_GO); bf16_t* H = c.ws<bf16_t>(W_H);
    int lane_ = c.lane; asm volatile("" : "+v"(lane_));
    for (int row = T + c.gw; row < TT; row += c.ngw) {
        const float* xrow = x_from_input ? c.in(I_XS) + (size_t)(row - T) * D : X + (size_t)row * D;
        if (mode == 0) rowpass_row(xrow, nullptr, nullptr, gnext, nullptr, H + (size_t)row * D, nullptr, lane_);
        else if (mode == 1) rowpass_row(xrow, GO + (size_t)row * D, gpost, gnext, X + (size_t)row * D, H + (size_t)row * D, nullptr, lane_);
        else rowpass_row(xrow, GO + (size_t)row * D, gpost, nullptr, nullptr, nullptr, c.p.out + O_YS + (size_t)(row - T) * D, lane_);
    }
    for (int g4 = c.gw; g4 < T / 4; g4 += c.ngw) {
        const int row = 4 * g4;
        const float* xrow = x_from_input ? c.in(I_XP) + (size_t)row * D : X + (size_t)row * D;
        if (mode == 0) rowpass_rows4(xrow, nullptr, nullptr, gnext, nullptr, H + (size_t)row * D, nullptr, lane_);
        else if (mode == 1) rowpass_rows4(xrow, GO + (size_t)row * D, gpost, gnext, X + (size_t)row * D, H + (size_t)row * D, nullptr, lane_);
        else rowpass_rows4(xrow, GO + (size_t)row * D, gpost, nullptr, nullptr, nullptr, c.p.out + O_YP + (size_t)row * D, lane_);
    }
}

namespace pg8 {
#define PG8_LAS __attribute__((address_space(3)))
typedef unsigned short bf16_t;
typedef short bf16x8 __attribute__((ext_vector_type(8)));
typedef float f32x4 __attribute__((ext_vector_type(4)));
typedef unsigned u32x4 __attribute__((ext_vector_type(4)));
constexpr int BM = 256, BK = 64, HALF = 128, HTB = HALF * BK * 2  , STAGE_BYTES = 8 * HTB, NXCD = 8, WGM = 8;

__host__ __device__ __forceinline__ int lds_byte(int r, int c) { const int st = (r >> 4) * 2 + (c >> 5), rr = r & 15, cc = c & 31, ob = rr * 64 + cc * 2; return st * 1024 + (ob ^ (((ob >> 9) & 1) << 5)); }
__host__ __device__ __forceinline__ void stage_rc(int b, int& R, int& C) { const int st = b / 1024, sb = b % 1024, swz = sb ^ (((sb >> 9) & 1) << 5); R = (st >> 1) * 16 + swz / 64; C = (st & 1) * 32 + (swz % 64) / 2; }
__host__ __device__ __forceinline__ int perm32(int rho) { const int n = rho >> 4, i = rho & 15; return 8 * (i >> 2) + 4 * n + (i & 3); }

struct Unit { int pm, pn; };
struct Gemm { const bf16_t* A; const bf16_t* Bt; int M, N, K; };

struct StaticOrder {
    int nM, nN, nwg, G, c;
    __host__ __device__ void init(int M, int N, int G_, int c_) { nM = M / BM; nN = N / BM; nwg = nM * nN; G = G_; c = c_; }
    __host__ __device__ bool next(int i, Unit& u) const {
        const long L = (long)i * G + c; if (L >= nwg) return false;
        int wgid = (int)L; { const int q = nwg / NXCD, r = nwg % NXCD, xcd = wgid % NXCD, off = wgid / NXCD; wgid = (xcd < r ? xcd * (q + 1) : r * (q + 1) + (xcd - r) * q) + off; }
        const int nig = WGM * nN, gid = wgid / nig, fm = gid * WGM, gsz = (nM - fm) < WGM ? (nM - fm) : WGM;
        u.pm = fm + ((wgid % nig) % gsz); u.pn = (wgid % nig) / gsz; return true;
    }
    __device__ __forceinline__ void a_ready(const Unit&) const {}
    __device__ __forceinline__ void done(const Unit&) const {}
};
__device__ __forceinline__ unsigned cvt_pk_bf16(float lo, float hi) { unsigned r; asm volatile("v_cvt_pk_bf16_f32 %0, %1, %2" : "=v"(r) : "v"(lo), "v"(hi)); return r; }
typedef float f32x2 __attribute__((ext_vector_type(2)));
struct EpiF32 {
    static constexpr bool PERM = false, AFTER_DRAIN = false;
    float* C; int ldc; const float* bias;
    __device__ __forceinline__ void operator()(const f32x4 (&acc)[2][2][4][2], const Unit& u, int wr, int wc, int fr, int fq) const {
        const int row0 = u.pm * BM + wr * 64 + fr, col0 = u.pn * BM + wc * 32 + 4 * fq;
        f32x4 bv[2][2];
#pragma unroll
        for (int bj = 0; bj < 2; ++bj)
#pragma unroll
            for (int n = 0; n < 2; ++n) bv[bj][n] = bias ? *(const f32x4*)(bias + col0 + bj * HALF + n * 16) : (f32x4){0.f, 0.f, 0.f, 0.f};
#pragma unroll
        for (int ai = 0; ai < 2; ++ai)
#pragma unroll
            for (int m = 0; m < 4; ++m) { float* rowp = C + (size_t)(row0 + ai * HALF + m * 16) * ldc + col0;
#pragma unroll
                for (int bj = 0; bj < 2; ++bj)
#pragma unroll
                    for (int n = 0; n < 2; ++n) *(f32x4*)(rowp + bj * HALF + n * 16) = acc[ai][bj][m][n] + bv[bj][n]; }
    }
};
template <class Epi, class Sched, bool STAMP = false>
__device__ __forceinline__ void gemm_phase(PG8_LAS unsigned char* lds, const Gemm g, const Sched& S, const Epi& E, unsigned long long* stamps) {
    int tid_ = threadIdx.x; asm volatile("" : "+v"(tid_));
    const int tid = tid_, wid = __builtin_amdgcn_readfirstlane(tid >> 6), lane = tid & 63, wr = wid >> 2, wc = wid & 3, fr = lane & 15, fq = lane >> 4;
    const int K = g.K, nt = K / BK;
    int ts_lo = 0, ts_hi = 0, nts = 0; const unsigned long long rt_entry = STAMP ? (unsigned long long)wall_clock64() : 0ull;
#define PG8_STAMP() do { if (STAMP && wid == 0 && nts < 64) { const unsigned long long _c = (unsigned long long)clock64(); \
        ts_lo = (lane == nts) ? (int)(unsigned)_c : ts_lo; ts_hi = (lane == nts) ? (int)(unsigned)(_c >> 32) : ts_hi; ++nts; } } while (0)
    PG8_STAMP();
    unsigned voffA[2], voffB[2];
#pragma unroll
    for (int i = 0; i < 2; ++i) { int R, C; stage_rc(tid * 16 + i * 8192, R, C); const int Rb = Epi::PERM ? ((R & ~31) + perm32(R & 31)) : R;
        voffA[i] = (unsigned)(R * K + C) * 2u; voffB[i] = (unsigned)(Rb * K + C) * 2u; }
    const size_t kstep = (size_t)(BK * 2);
    const size_t hstep = (size_t)HALF * K * 2;
    const size_t tstep = 2 * hstep;
    const unsigned ldsw = (unsigned)wid * 1024u;
    const int aoff = lds_byte(wr * 64 + fr, fq * 8), boff = lds_byte(wc * 32 + fr, fq * 8);
#define PG8_SA(b, h) (((b) * 2 + (h)) * HTB)
#define PG8_SB(b, h) ((4 + (b) * 2 + (h)) * HTB)
#define PG8_STAGE(bufoff, gbase, voff) do { _Pragma("unroll") for (int _i = 0; _i < 2; ++_i) \
        __builtin_amdgcn_global_load_lds((const unsigned*)((const char*)(gbase) + (voff)[_i]), (PG8_LAS unsigned*)(lds + (bufoff) + ldsw + _i * 8192), 16, 0, 0); } while (0)
#define PG8_LDA(dst, b, h) do { _Pragma("unroll") for (int m = 0; m < 4; ++m) _Pragma("unroll") for (int k = 0; k < 2; ++k) dst[m][k] = *(const PG8_LAS bf16x8*)(lds + PG8_SA(b, h) + aoff + m * 2048 + k * 1024); } while (0)
#define PG8_LDB(dst, b, h) do { _Pragma("unroll") for (int n = 0; n < 2; ++n) _Pragma("unroll") for (int k = 0; k < 2; ++k) dst[n][k] = *(const PG8_LAS bf16x8*)(lds + PG8_SB(b, h) + boff + n * 2048 + k * 1024); } while (0)
#define PG8_MMA(ai, bj, At, Bt) do { __builtin_amdgcn_s_setprio(1); _Pragma("unroll") for (int m = 0; m < 4; ++m) _Pragma("unroll") for (int n = 0; n < 2; ++n) _Pragma("unroll") for (int k = 0; k < 2; ++k) \
        acc[ai][bj][m][n] = __builtin_amdgcn_mfma_f32_16x16x32_bf16(Bt[n][k], At[m][k], acc[ai][bj][m][n], 0, 0, 0); __builtin_amdgcn_s_setprio(0); } while (0)
#define PG8_WAIT_V(n) asm volatile("s_waitcnt vmcnt(" #n ")" ::: "memory")
#define PG8_WAIT_L(n) asm volatile("s_waitcnt lgkmcnt(" #n ")" ::: "memory")
#define PG8_BAR __builtin_amdgcn_s_barrier()
#define PG8_SCHED __builtin_amdgcn_sched_barrier(0)
    Unit cur, nxt; int ui = 0;
    if (!S.next(0, cur)) return;
    f32x4 acc[2][2][4][2];
#pragma unroll
    for (int a = 0; a < 2; ++a)
#pragma unroll
        for (int b = 0; b < 2; ++b)
#pragma unroll
            for (int m = 0; m < 4; ++m)
#pragma unroll
                for (int n = 0; n < 2; ++n) acc[a][b][m][n] = (f32x4){0.f, 0.f, 0.f, 0.f};
    bf16x8 At[4][2], B0[2][2], B1[2][2];
    const char* cA = (const char*)g.A + (size_t)cur.pm * tstep; const char* cB = (const char*)g.Bt + (size_t)cur.pn * tstep;
    S.a_ready(cur);
    PG8_STAGE(PG8_SB(0, 0), cB, voffB); PG8_STAGE(PG8_SA(0, 0), cA, voffA); PG8_STAGE(PG8_SB(0, 1), cB + hstep, voffB); PG8_STAGE(PG8_SA(0, 1), cA + hstep, voffA);
    if (wr == 1) PG8_BAR;
    PG8_WAIT_V(4); PG8_BAR;
    PG8_STAGE(PG8_SB(1, 0), cB + kstep, voffB); PG8_STAGE(PG8_SA(1, 0), cA + kstep, voffA); PG8_STAGE(PG8_SB(1, 1), cB + hstep + kstep, voffB);
    PG8_WAIT_V(6); PG8_BAR;
    PG8_STAMP();
    for (;;) {
        const bool has_next = S.next(ui + 1, nxt);
        const char* nA = has_next ? (const char*)g.A + (size_t)nxt.pm * tstep : cA; const char* nB = has_next ? (const char*)g.Bt + (size_t)nxt.pn * tstep : cB;
        for (int t = 0; t < nt; t += 2) {
            const bool last = (t == nt - 2);
            const char* a1 = cA + (size_t)(t + 1) * kstep;
            const char* a2 = last ? nA : cA + (size_t)(t + 2) * kstep; const char* b2 = last ? nB : cB + (size_t)(t + 2) * kstep;
            const char* a3 = a2 + kstep; const char* b3 = b2 + kstep;
            if (last && has_next) S.a_ready(nxt);
            PG8_LDB(B0, 0, 0); PG8_SCHED; PG8_LDA(At, 0, 0); PG8_STAGE(PG8_SA(1, 1), a1 + hstep, voffA);
            PG8_WAIT_L(8); PG8_BAR; PG8_WAIT_L(0); PG8_MMA(0, 0, At, B0); PG8_BAR; PG8_SCHED;
            PG8_LDB(B1, 0, 1); PG8_STAGE(PG8_SB(0, 0), b2, voffB);
            PG8_BAR; PG8_WAIT_L(0); PG8_MMA(0, 1, At, B1); PG8_BAR;
            PG8_LDA(At, 0, 1); PG8_STAGE(PG8_SA(0, 0), a2, voffA);
            PG8_BAR; PG8_WAIT_L(0); PG8_MMA(1, 0, At, B0); PG8_BAR; PG8_SCHED;
            PG8_STAGE(PG8_SB(0, 1), b2 + hstep, voffB);
            PG8_WAIT_V(6); PG8_BAR; PG8_MMA(1, 1, At, B1); PG8_BAR;
            PG8_LDB(B0, 1, 0); PG8_SCHED; PG8_LDA(At, 1, 0); PG8_STAGE(PG8_SA(0, 1), a2 + hstep, voffA);
            PG8_WAIT_L(8); PG8_BAR; PG8_WAIT_L(0); PG8_MMA(0, 0, At, B0); PG8_BAR; PG8_SCHED;
            PG8_LDB(B1, 1, 1); PG8_STAGE(PG8_SB(1, 0), b3, voffB);
            PG8_BAR; PG8_WAIT_L(0); PG8_MMA(0, 1, At, B1); PG8_BAR;
            PG8_LDA(At, 1, 1); PG8_STAGE(PG8_SA(1, 0), a3, voffA);
            PG8_BAR; PG8_WAIT_L(0); PG8_MMA(1, 0, At, B0); PG8_BAR; PG8_SCHED;
            PG8_STAGE(PG8_SB(1, 1), b3 + hstep, voffB);
            PG8_WAIT_V(6); PG8_BAR; PG8_MMA(1, 1, At, B1); PG8_BAR;
        }
        PG8_STAMP();
        if constexpr (!Epi::AFTER_DRAIN) { E(acc, cur, wr, wc, fr, fq); S.done(cur); }
        PG8_STAMP();
        if (!has_next) break;
#pragma unroll
        for (int a = 0; a < 2; ++a)
#pragma unroll
            for (int b = 0; b < 2; ++b)
#pragma unroll
                for (int m = 0; m < 4; ++m)
#pragma unroll
                    for (int n = 0; n < 2; ++n) acc[a][b][m][n] = (f32x4){0.f, 0.f, 0.f, 0.f};
        cur = nxt; cA = nA; cB = nB; ++ui;
    }
    PG8_WAIT_V(0);
    if (wr == 0) PG8_BAR;
    PG8_BAR;
    if constexpr (Epi::AFTER_DRAIN) { E.fused(acc, cur, wr, wc, fr, fq, lds, wid, lane); S.done(cur); }
    PG8_STAMP();
    if (STAMP && wid == 0) { stamps[lane] = lane < nts ? (((unsigned long long)(unsigned)ts_hi << 32) | (unsigned)ts_lo) : 0ull;
        if (lane == 62) stamps[62] = rt_entry; if (lane == 63) stamps[63] = (unsigned long long)wall_clock64(); }
#undef PG8_STAMP
#undef PG8_SA
#undef PG8_SB
#undef PG8_STAGE
#undef PG8_LDA
#undef PG8_LDB
#undef PG8_MMA
#undef PG8_WAIT_V
#undef PG8_WAIT_L
#undef PG8_BAR
#undef PG8_SCHED
}
}

namespace pg8 {
struct EpiBf16Plain {
    static constexpr bool PERM = false, AFTER_DRAIN = false;
    bf16_t* O; int ldc;
    __device__ __forceinline__ void operator()(const f32x4 (&acc)[2][2][4][2], const Unit& u, int wr, int wc, int fr, int fq) const {
        const int row0 = u.pm * BM + wr * 64 + fr, col0 = u.pn * BM + wc * 32 + 4 * fq;
#pragma unroll
        for (int ai = 0; ai < 2; ++ai)
#pragma unroll
            for (int m = 0; m < 4; ++m) { bf16_t* rowp = O + (size_t)(row0 + ai * HALF + m * 16) * ldc + col0;
#pragma unroll
                for (int bj = 0; bj < 2; ++bj)
#pragma unroll
                    for (int n = 0; n < 2; ++n) { const f32x4 v = acc[ai][bj][m][n]; unsigned long long w = (unsigned long long)cvt_pk_bf16(v[0], v[1]) | ((unsigned long long)cvt_pk_bf16(v[2], v[3]) << 32);
                        *(unsigned long long*)(rowp + bj * HALF + n * 16) = w; } }
    }
};
struct EpiBf16Perm {
    static constexpr bool PERM = true, AFTER_DRAIN = false;
    bf16_t* O; int ldc;
    __device__ __forceinline__ void operator()(const f32x4 (&acc)[2][2][4][2], const Unit& u, int wr, int wc, int fr, int fq) const {
        const int row0 = u.pm * BM + wr * 64 + fr, col0 = u.pn * BM + wc * 32 + 8 * fq;
#pragma unroll
        for (int ai = 0; ai < 2; ++ai)
#pragma unroll
            for (int m = 0; m < 4; ++m) { bf16_t* rowp = O + (size_t)(row0 + ai * HALF + m * 16) * ldc + col0;
#pragma unroll
                for (int bj = 0; bj < 2; ++bj) { const f32x4 v0 = acc[ai][bj][m][0], v1 = acc[ai][bj][m][1]; u32x4 w;
                    w.x = cvt_pk_bf16(v0[0], v0[1]); w.y = cvt_pk_bf16(v0[2], v0[3]); w.z = cvt_pk_bf16(v1[0], v1[1]); w.w = cvt_pk_bf16(v1[2], v1[3]);
                    *(u32x4*)(rowp + bj * HALF) = w; } }
    }
};
struct EpiSwiglu {
    static constexpr bool PERM = false, AFTER_DRAIN = false;
    bf16_t* O; int ldc;
    __device__ __forceinline__ void operator()(const f32x4 (&acc)[2][2][4][2], const Unit& u, int wr, int wc, int fr, int fq) const {
        const int row0 = u.pm * BM + wr * 64 + fr, col0 = u.pn * (BM / 2) + wc * 16 + 4 * fq;
#pragma unroll
        for (int ai = 0; ai < 2; ++ai)
#pragma unroll
            for (int m = 0; m < 4; ++m) { bf16_t* rowp = O + (size_t)(row0 + ai * HALF + m * 16) * ldc + col0;
#pragma unroll
                for (int bj = 0; bj < 2; ++bj) { const f32x4 g = acc[ai][bj][m][0], up = acc[ai][bj][m][1]; float h[4];
#pragma unroll
                    for (int e = 0; e < 4; ++e) h[e] = g[e] * __builtin_amdgcn_rcpf(1.f + __expf(-g[e])) * up[e];
                    unsigned long long w = (unsigned long long)cvt_pk_bf16(h[0], h[1]) | ((unsigned long long)cvt_pk_bf16(h[2], h[3]) << 32);
                    *(unsigned long long*)(rowp + bj * (HALF / 2)) = w; } }
    }
};
}

struct Epi { int mode; bf16_t* ob; float* of; int ldo; int main_cols; };
DI void gemm_simple(const Ctx& c, const bf16_t* A, int lda, int M, const bf16_t* Bt, int ldb, int N, int K, const Epi e) {
    const int mblk = (M + 63) / 64, nblk = (N + 31) / 32, nit = mblk * nblk;
    const int fr = c.lane & 15, fq = c.lane >> 4;
    for (int it = c.gw; it < nit; it += c.ngw) {
        const int mb = it / nblk, nb = it % nblk, m0 = mb * 64, n0 = nb * 32;
        const bf16_t* ap[4]; const bf16_t* bp[2];
#pragma unroll
        for (int m = 0; m < 4; ++m) { int r = m0 + 16 * m + fr; r = r < M ? r : M - 1; ap[m] = A + (size_t)r * lda + 8 * fq; }
#pragma unroll
        for (int n = 0; n < 2; ++n) { int r = n0 + 16 * n + fr; r = r < N ? r : N - 1; bp[n] = Bt + (size_t)r * ldb + 8 * fq; }
        f32x4 acc[4][2];
#pragma unroll
        for (int m = 0; m < 4; ++m)
#pragma unroll
            for (int n = 0; n < 2; ++n) acc[m][n] = (f32x4){0.f, 0.f, 0.f, 0.f};
#pragma unroll 2
        for (int k0 = 0; k0 < K; k0 += 32) {
            bf16x8 a[4], b[2];
#pragma unroll
            for (int m = 0; m < 4; ++m) a[m] = *(const bf16x8*)(ap[m] + k0);
#pragma unroll
            for (int n = 0; n < 2; ++n) b[n] = *(const bf16x8*)(bp[n] + k0);
#pragma unroll
            for (int m = 0; m < 4; ++m)
#pragma unroll
                for (int n = 0; n < 2; ++n) acc[m][n] = __builtin_amdgcn_mfma_f32_16x16x32_bf16(b[n], a[m], acc[m][n], 0, 0, 0);
        }
#pragma unroll
        for (int m = 0; m < 4; ++m) {
            const int row = m0 + 16 * m + fr; if (row >= M) continue;
            if (e.mode == 2) {
                const f32x4 g = acc[m][0], u = acc[m][1]; u32x2 o;
                o.x = pk2(siluf(g.x) * u.x, siluf(g.y) * u.y); o.y = pk2(siluf(g.z) * u.z, siluf(g.w) * u.w);
                *(u32x2*)(e.ob + (size_t)row * e.ldo + 16 * nb + 4 * fq) = o;
            } else {
#pragma unroll
                for (int n = 0; n < 2; ++n) {
                    const int col = n0 + 16 * n + 4 * fq; if (col >= N) continue;
                    const f32x4 v = acc[m][n];
                    if (e.mode == 1) *(f32x4*)(e.of + (size_t)row * e.ldo + col) = v;
                    else if (col < e.main_cols) { u32x2 o; o.x = pk2(v.x, v.y); o.y = pk2(v.z, v.w); *(u32x2*)(e.ob + (size_t)row * e.ldo + col) = o; }
                    else *(f32x4*)(e.of + (size_t)row * 32 + (col - e.main_cols)) = v;
                }
            }
        }
    }
}

DI void attn_wave(const Ctx& c, int li, int tok, int h, LAS float* pl  ) {
    const bf16_t* PROJ = c.ws<bf16_t>(W_PROJ); bf16_t* MIX = c.ws<bf16_t>(W_MIXED);
    const int lane = c.lane; const bool smp = tok >= T;
    const int b = smp ? tok - T : tok / SEQ, s = smp ? WIN : tok % SEQ;
    const float* ck = c.in(I_CK) + ((size_t)(li * NS + b) * WIN) * AW + h * AHD;
    const float* cv = c.in(I_CV) + ((size_t)(li * NS + b) * WIN) * AW + h * AHD;
    const bf16_t* prow0 = smp ? PROJ + (size_t)tok * HYB_MAIN : PROJ + (size_t)(b * SEQ) * HYB_MAIN;
    float q[64];
    { const bf16_t* qp = PROJ + (size_t)tok * HYB_MAIN + h * AHD;
#pragma unroll
      for (int j = 0; j < 8; ++j) { const u32x4 v = *(const u32x4*)(qp + 8 * j);
          q[8*j+0] = bf2f((bf16_t)(v.x & 0xffff)) * 0.125f; q[8*j+1] = bf2f((bf16_t)(v.x >> 16)) * 0.125f; q[8*j+2] = bf2f((bf16_t)(v.y & 0xffff)) * 0.125f; q[8*j+3] = bf2f((bf16_t)(v.y >> 16)) * 0.125f;
          q[8*j+4] = bf2f((bf16_t)(v.z & 0xffff)) * 0.125f; q[8*j+5] = bf2f((bf16_t)(v.z >> 16)) * 0.125f; q[8*j+6] = bf2f((bf16_t)(v.w & 0xffff)) * 0.125f; q[8*j+7] = bf2f((bf16_t)(v.w >> 16)) * 0.125f; } }
    const float* relb = c.in(I_RELB);
    float mx = -1e30f;
#pragma unroll 1
    for (int pat = 0; pat < 3; ++pat) {
        const int d = pat == 0 ? 1 : (pat == 1 ? 4 : 16);
#pragma unroll
        for (int rnd = 0; rnd < 3; ++rnd) {
            const int j = rnd * 64 + lane; float lg = -1e30f;
            if (j <= 128) {
                const int R = s - j * d;
                if (R >= 0) {
                    float acc = 0.f;
                    if (smp && R < WIN) { const float* kp = ck + (size_t)R * AW;
#pragma unroll
                        for (int e = 0; e < 16; ++e) { const f32x4 v = *(const f32x4*)(kp + 4 * e); acc += q[4*e] * v.x + q[4*e+1] * v.y + q[4*e+2] * v.z + q[4*e+3] * v.w; }
                    } else { const bf16_t* kp = (smp ? prow0 : prow0 + (size_t)R * HYB_MAIN) + AW + h * AHD;
#pragma unroll
                        for (int e = 0; e < 8; ++e) { const u32x4 v = *(const u32x4*)(kp + 8 * e);
                            acc += q[8*e] * bf2f((bf16_t)(v.x & 0xffff)) + q[8*e+1] * bf2f((bf16_t)(v.x >> 16)) + q[8*e+2] * bf2f((bf16_t)(v.y & 0xffff)) + q[8*e+3] * bf2f((bf16_t)(v.y >> 16))
                                 + q[8*e+4] * bf2f((bf16_t)(v.z & 0xffff)) + q[8*e+5] * bf2f((bf16_t)(v.z >> 16)) + q[8*e+6] * bf2f((bf16_t)(v.w & 0xffff)) + q[8*e+7] * bf2f((bf16_t)(v.w >> 16)); }
                    }
                    lg = acc + relb[c_bucket[pat][j] * AH + h];
                }
                pl[pat * 132 + j] = lg;
            }
            mx = fmaxf(mx, lg);
        }
    }
    mx = wave_max(mx);
    LDS_WAIT();
    float ssum = 0.f;
#pragma unroll 1
    for (int i = lane; i < 396; i += 64) { const int pat = i / 132, j = i % 132; if (j <= 128) { const float lg = pl[i]; const float pv = lg > -1e29f ? __expf(lg - mx) : 0.f; pl[i] = pv; ssum += pv; } }
    ssum = wave_sum(ssum);
    LDS_WAIT();
    {
        const int kg = lane >> 4, dc = lane & 15;
        f32x4 o4 = (f32x4){0.f, 0.f, 0.f, 0.f};
        if (smp) {
#pragma unroll 1
            for (int pat = 0; pat < 3; ++pat) {
                const int d = pat == 0 ? 1 : (pat == 1 ? 4 : 16);
                if (kg == 0) { const u32x2 vv = *(const u32x2*)(prow0 + 2 * AW + h * AHD + 4 * dc); const float pv = pl[pat * 132];
                    o4.x += pv * bf2f((bf16_t)(vv.x & 0xffff)); o4.y += pv * bf2f((bf16_t)(vv.x >> 16)); o4.z += pv * bf2f((bf16_t)(vv.y & 0xffff)); o4.w += pv * bf2f((bf16_t)(vv.y >> 16)); }
#pragma unroll 16
                for (int i4 = 0; i4 < 32; ++i4) { const int j = 1 + 4 * i4 + kg; const f32x4 vv = *(const f32x4*)(cv + (size_t)(WIN - j * d) * AW + 4 * dc); o4 += vv * pl[pat * 132 + j]; }
            }
        } else {
#pragma unroll 1
            for (int pat = 0; pat < 3; ++pat) {
                const int d = pat == 0 ? 1 : (pat == 1 ? 4 : 16);
                int jmax = s / d; jmax = jmax > 128 ? 128 : jmax;
#pragma unroll 4
                for (int j = kg; j <= jmax; j += 4) { const u32x2 vv = *(const u32x2*)(prow0 + (size_t)(s - j * d) * HYB_MAIN + 2 * AW + h * AHD + 4 * dc); const float pv = pl[pat * 132 + j];
                    o4.x += pv * bf2f((bf16_t)(vv.x & 0xffff)); o4.y += pv * bf2f((bf16_t)(vv.x >> 16)); o4.z += pv * bf2f((bf16_t)(vv.y & 0xffff)); o4.w += pv * bf2f((bf16_t)(vv.y >> 16)); }
            }
        }
#pragma unroll
        for (int e = 0; e < 4; ++e) { o4[e] += __shfl_xor(o4[e], 16); o4[e] += __shfl_xor(o4[e], 32); }
        const float inv = 1.f / ssum;
        if (kg == 0) { u32x2 o; o.x = pk2(o4.x * inv, o4.y * inv); o.y = pk2(o4.z * inv, o4.w * inv); *(u32x2*)(MIX + (size_t)tok * HYB_MIX + h * AHD + 4 * dc) = o; }
    }
    LDS_WAIT();
}

template <int MT>
DI void gemm_ksplit(const Ctx& c, const bf16_t* A, int lda, int M, const bf16_t* Bt, int ldb, int N, int K, const Epi e) {
    const int mblk = (M + 16 * MT - 1) / (16 * MT), nblk = (N + 31) / 32, nit = mblk * nblk;
    const int fr = c.lane & 15, fq = c.lane >> 4, kslice = K / 8, klo = c.wave * kslice;
    LAS float* part = (LAS float*)c.lds;
    for (int it = blockIdx.x; it < nit; it += gridDim.x) {
        const int mb = it / nblk, nb = it % nblk, m0 = mb * 16 * MT, n0 = nb * 32;
        const bf16_t* ap[MT]; const bf16_t* bp[2];
#pragma unroll
        for (int m = 0; m < MT; ++m) { int r = m0 + 16 * m + fr; r = r < M ? r : M - 1; ap[m] = A + (size_t)r * lda + klo + 8 * fq; }
#pragma unroll
        for (int n = 0; n < 2; ++n) { int r = n0 + 16 * n + fr; r = r < N ? r : N - 1; bp[n] = Bt + (size_t)r * ldb + klo + 8 * fq; }
        f32x4 acc[MT][2];
#pragma unroll
        for (int m = 0; m < MT; ++m)
#pragma unroll
            for (int n = 0; n < 2; ++n) acc[m][n] = (f32x4){0.f, 0.f, 0.f, 0.f};
#pragma unroll 4
        for (int k0 = 0; k0 < kslice; k0 += 32) {
            bf16x8 a[MT], b[2];
#pragma unroll
            for (int m = 0; m < MT; ++m) a[m] = *(const bf16x8*)(ap[m] + k0);
#pragma unroll
            for (int n = 0; n < 2; ++n) b[n] = *(const bf16x8*)(bp[n] + k0);
#pragma unroll
            for (int m = 0; m < MT; ++m)
#pragma unroll
                for (int n = 0; n < 2; ++n) acc[m][n] = __builtin_amdgcn_mfma_f32_16x16x32_bf16(b[n], a[m], acc[m][n], 0, 0, 0);
        }
        __syncthreads();
#pragma unroll
        for (int m = 0; m < MT; ++m)
#pragma unroll
            for (int n = 0; n < 2; ++n) *(LAS f32x4*)(part + ((c.wave * (MT * 2) + m * 2 + n) * 64 + c.lane) * 4) = acc[m][n];
        __syncthreads();
        if (c.wave < MT) {
            const int m = c.wave; f32x4 v[2];
#pragma unroll
            for (int n = 0; n < 2; ++n) { v[n] = (f32x4){0.f, 0.f, 0.f, 0.f};
#pragma unroll
                for (int w = 0; w < 8; ++w) v[n] += *(const LAS f32x4*)(part + ((w * (MT * 2) + m * 2 + n) * 64 + c.lane) * 4); }
            const int row = m0 + 16 * m + fr;
            if (row < M) {
                if (e.mode == 2) {
                    const f32x4 g = v[0], u = v[1]; u32x2 o;
                    o.x = pk2(siluf(g.x) * u.x, siluf(g.y) * u.y); o.y = pk2(siluf(g.z) * u.z, siluf(g.w) * u.w);
                    *(u32x2*)(e.ob + (size_t)row * e.ldo + 16 * nb + 4 * fq) = o;
                } else {
#pragma unroll
                    for (int n = 0; n < 2; ++n) {
                        const int col = n0 + 16 * n + 4 * fq; if (col >= N) continue;
                        if (e.mode == 1) *(f32x4*)(e.of + (size_t)row * e.ldo + col) = v[n];
                        else if (col < e.main_cols) { u32x2 o; o.x = pk2(v[n].x, v[n].y); o.y = pk2(v[n].z, v[n].w); *(u32x2*)(e.ob + (size_t)row * e.ldo + col) = o; }
                        else *(f32x4*)(e.of + (size_t)row * 32 + (col - e.main_cols)) = v[n];
                    }
                }
            }
        }
    }
    __syncthreads();
}

constexpr int AT_LDS = 1600;
struct AtStep { int d, u, kb, sh; const LAS float* tbp; };
DI AtStep at_step(int g, const LAS float* tb) {
    AtStep s;
    if (g < 12) { s.d = 1; s.u = 16; s.sh = 0; s.kb = -143 + 32 * g; s.tbp = tb; }
    else if (g < 18) { s.d = 4; s.u = 4; s.sh = 2; s.kb = -131 + 32 * (g - 12); s.tbp = tb + 132; }
    else if (g < 23) { s.d = 16; s.u = 1; s.sh = 4; s.kb = -144 + 32 * (g - 18); s.tbp = tb + 264; }
    else { s.d = 1; s.u = 0; s.sh = 0; s.kb = 100000; s.tbp = tb; }
    return s;
}
struct AtBuf { bf16x8 k[2][2]; bf16x8 v[2][2]; };
DI void at_load(AtBuf& bf, const bf16_t* qrow0, int P0, const AtStep st, int fr, int fq) {
#pragma unroll
    for (int kt = 0; kt < 2; ++kt) {
        int pos = P0 + st.d * (st.kb + 16 * kt + fr); pos = pos < 0 ? 0 : (pos > SEQ - 1 ? SEQ - 1 : pos);
        const bf16_t* rp = qrow0 + (size_t)pos * HYB_MAIN + 8 * fq;
        bf.k[kt][0] = *(const bf16x8*)(rp + AW); bf.k[kt][1] = *(const bf16x8*)(rp + AW + 32);
        bf.v[kt][0] = *(const bf16x8*)(rp + 2 * AW); bf.v[kt][1] = *(const bf16x8*)(rp + 2 * AW + 32);
    }
}
DI void attn_mfma_item(const Ctx& c, int li, int item) {
    const bf16_t* PROJ = c.ws<bf16_t>(W_PROJ); bf16_t* MIX = c.ws<bf16_t>(W_MIXED);
    int lane_ = c.lane; asm volatile("" : "+v"(lane_));
    const int lane = lane_, fr = lane & 15, fq = lane >> 4;
    const int qb = item & 255, h = (item >> 8) & 7, b = item >> 11, P0 = (qb >> 4) * 256 + (qb & 15);
    LAS float* tb = (LAS float*)(c.lds + c.wave * AT_LDS);
    { const float* relb = c.in(I_RELB);
#pragma unroll 1
      for (int i = lane; i < 396; i += 64) { const int pat = i / 132, j = i % 132; tb[i] = j <= 128 ? relb[c_bucket[pat][j] * AH + h] : 0.f; } }
    const bf16_t* qrow0 = PROJ + (size_t)(b * SEQ) * HYB_MAIN + h * AHD;
    bf16x8 qf[2], idf[2];
#pragma unroll
    for (int kd = 0; kd < 2; ++kd) qf[kd] = *(const bf16x8*)(qrow0 + (size_t)(P0 + 16 * fr) * HYB_MAIN + 32 * kd + 8 * fq);
#pragma unroll
    for (int hs = 0; hs < 2; ++hs)
#pragma unroll
        for (int e = 0; e < 8; ++e) idf[hs][e] = (8 * fq + e) == (16 * hs + fr) ? (short)0x3F80 : (short)0;
    float m = -1e30f, lsum = 0.f;
    f32x4 O[4];
#pragma unroll
    for (int dt = 0; dt < 4; ++dt) O[dt] = (f32x4){0.f, 0.f, 0.f, 0.f};
    AtBuf b0, b1, b2;
    at_load(b0, qrow0, P0, at_step(0, tb), fr, fq); at_load(b1, qrow0, P0, at_step(1, tb), fr, fq); at_load(b2, qrow0, P0, at_step(2, tb), fr, fq);
    LDS_WAIT();
#define AT_STEP(bf, g) do { \
        const AtStep st = at_step((g), tb); const int qi = st.u * fr; \
        f32x4 sc[2]; \
        _Pragma("unroll") for (int kt = 0; kt < 2; ++kt) { sc[kt] = (f32x4){0.f, 0.f, 0.f, 0.f}; \
            _Pragma("unroll") for (int kd = 0; kd < 2; ++kd) sc[kt] = __builtin_amdgcn_mfma_f32_16x16x32_bf16(bf.k[kt][kd], qf[kd], sc[kt], 0, 0, 0); } \
        f32x4 dv[2][4]; \
        _Pragma("unroll") for (int kt = 0; kt < 2; ++kt) _Pragma("unroll") for (int dt = 0; dt < 4; ++dt) \
            dv[kt][dt] = __builtin_amdgcn_mfma_f32_16x16x32_bf16(bf.v[kt][dt >> 1], idf[dt & 1], (f32x4){0.f, 0.f, 0.f, 0.f}, 0, 0, 0);     \
        const AtStep nx = at_step((g) + 3, tb); at_load(bf, qrow0, P0, nx, fr, fq);     \
        float tmax = -1e30f; bool ok[2][4]; \
        const int dbase = qi - st.kb - 4 * fq;                                 \
        int dmx = qi + (P0 >> st.sh); dmx = dmx > 128 ? 128 : dmx;                  \
        _Pragma("unroll") for (int kt = 0; kt < 2; ++kt) _Pragma("unroll") for (int r = 0; r < 4; ++r) { \
            const unsigned dist = (unsigned)(dbase - 16 * kt - r); const bool v = dist <= (unsigned)dmx; ok[kt][r] = v; \
            const unsigned di = dist > 128u ? 128u : dist; const float bias = *(const volatile LAS float*)(st.tbp + di); \
            const float lg = v ? sc[kt][r] * 0.125f + bias : -1e30f; sc[kt][r] = lg; tmax = fmaxf(tmax, lg); } \
        tmax = fmaxf(tmax, __shfl_xor(tmax, 16)); tmax = fmaxf(tmax, __shfl_xor(tmax, 32)); \
        const float mn = fmaxf(m, tmax), alpha = __expf(m - mn); m = mn; \
        float ps = 0.f; \
        _Pragma("unroll") for (int kt = 0; kt < 2; ++kt) _Pragma("unroll") for (int r = 0; r < 4; ++r) { const float pv = ok[kt][r] ? __expf(sc[kt][r] - mn) : 0.f; sc[kt][r] = pv; ps += pv; } \
        lsum = lsum * alpha + ps; \
        const bf16x8 pfrag = pack8(sc[0], sc[1]); \
        _Pragma("unroll") for (int dt = 0; dt < 4; ++dt) O[dt] = __builtin_amdgcn_mfma_f32_16x16x32_bf16(pack8(dv[0][dt], dv[1][dt]), pfrag, O[dt] * alpha, 0, 0, 0); } while (0)
#pragma unroll 1
    for (int g = 0; g < 24; g += 3) { AT_STEP(b0, g); AT_STEP(b1, g + 1); AT_STEP(b2, g + 2); }
#undef AT_STEP
    lsum += __shfl_xor(lsum, 16); lsum += __shfl_xor(lsum, 32);
    const float inv = 1.f / lsum;
    bf16_t* orow = MIX + (size_t)(b * SEQ + P0 + 16 * fr) * HYB_MIX + h * AHD;
#pragma unroll
    for (int dt = 0; dt < 4; ++dt) { u32x2 o; o.x = pk2(O[dt][0] * inv, O[dt][1] * inv); o.y = pk2(O[dt][2] * inv, O[dt][3] * inv); *(u32x2*)(orow + 16 * dt + 4 * fq) = o; }
    LDS_WAIT();
}

DI void unpack8(const u32x4 v, float* f) {
    f[0] = bf2f((bf16_t)(v.x & 0xffff)); f[1] = bf2f((bf16_t)(v.x >> 16)); f[2] = bf2f((bf16_t)(v.y & 0xffff)); f[3] = bf2f((bf16_t)(v.y >> 16));
    f[4] = bf2f((bf16_t)(v.z & 0xffff)); f[5] = bf2f((bf16_t)(v.z >> 16)); f[6] = bf2f((bf16_t)(v.w & 0xffff)); f[7] = bf2f((bf16_t)(v.w >> 16));
}
DI void load8f(const float* p, float* f) { const f32x4 a = *(const f32x4*)p, b = *(const f32x4*)(p + 4); f[0] = a.x; f[1] = a.y; f[2] = a.z; f[3] = a.w; f[4] = b.x; f[5] = b.y; f[6] = b.z; f[7] = b.w; }
DI void store8f(float* p, const float* f) { *(f32x4*)p = (f32x4){f[0], f[1], f[2], f[3]}; *(f32x4*)(p + 4) = (f32x4){f[4], f[5], f[6], f[7]}; }
DI void conv8(const bf16_t* prow, int ld, const float* st, int nch, const float* cw, int ch0, bool smp, int s, float* x1, float* x2, float* x3, float* y) {
    float x0[8], w[8];
    unpack8(*(const u32x4*)(prow + ch0), x3);
    if (smp) { load8f(st + ch0, x0); load8f(st + nch + ch0, x1); load8f(st + 2 * nch + ch0, x2); }
    else {
        const u32x4 z = (u32x4){0u, 0u, 0u, 0u};
        unpack8(s >= 1 ? *(const u32x4*)(prow + ch0 - ld) : z, x2); unpack8(s >= 2 ? *(const u32x4*)(prow + ch0 - 2 * ld) : z, x1); unpack8(s >= 3 ? *(const u32x4*)(prow + ch0 - 3 * ld) : z, x0);
    }
    load8f(cw + ch0, w);
#pragma unroll
    for (int e = 0; e < 8; ++e) y[e] = x0[e] * w[e];
    load8f(cw + nch + ch0, w);
#pragma unroll
    for (int e = 0; e < 8; ++e) y[e] += x1[e] * w[e];
    load8f(cw + 2 * nch + ch0, w);
#pragma unroll
    for (int e = 0; e < 8; ++e) y[e] += x2[e] * w[e];
    load8f(cw + 3 * nch + ch0, w);
#pragma unroll
    for (int e = 0; e < 8; ++e) y[e] += x3[e] * w[e];
}
DI void hyb_pre_token(const Ctx& c, int li, int tok) {
    const bf16_t* PROJ = c.ws<bf16_t>(W_PROJ); float* ACT = c.ws<float>(W_ACT); float* AUX = c.ws<float>(W_AUX); const float* EX = c.ws<float>(W_EXTRA);
    const int lane = c.lane; const bool smp = tok >= T; const int b = smp ? tok - T : tok / SEQ, s = smp ? 0 : tok % SEQ;
    const float* cw = c.in(I_SCW) + (size_t)li * 4 * SXBC; const float* cb = c.in(I_SCB) + (size_t)li * SXBC;
    const float* st = c.in(I_SCONV) + (size_t)(li * NS + b) * 3 * SXBC;
    const bf16_t* prow = PROJ + (size_t)tok * HYB_MAIN + 2560;
#pragma unroll 1
    for (int it = 0; it < 3; ++it) {
        const int ch0 = 512 * it + 8 * lane; float x1[8], x2[8], x3[8], y[8], bb[8];
        conv8(prow, HYB_MAIN, st, SXBC, cw, ch0, smp, s, x1, x2, x3, y);
        load8f(cb + ch0, bb);
#pragma unroll
        for (int e = 0; e < 8; ++e) y[e] = siluf(y[e] + bb[e]);
        store8f(ACT + (size_t)tok * 4096 + ch0, y);
        if (smp) { float* o = c.p.out + O_SSC + (size_t)(li * NS + b) * 3 * SXBC + ch0; store8f(o, x1); store8f(o + SXBC, x2); store8f(o + 2 * SXBC, x3); }
        else if (s >= SEQ - 3) store8f(c.p.out + O_PSC + ((size_t)(li * NB + b) * 3 + (s - (SEQ - 3))) * SXBC + ch0, x3);
    }
    if (lane < SH) AUX[(size_t)tok * 32 + lane] = softplusf_(EX[(size_t)tok * 32 + lane] + c.in(I_SDTB)[li * SH + lane]);
    if (smp || s >= SEQ - WIN) {
        float* ok = smp ? c.p.out + O_SK + ((size_t)(li * NS + b) * WIN + (WIN - 1)) * AW : c.p.out + O_PK + ((size_t)(li * NB + b) * WIN + (s - (SEQ - WIN))) * AW;
        float* ov = smp ? c.p.out + O_SV + ((size_t)(li * NS + b) * WIN + (WIN - 1)) * AW : c.p.out + O_PV + ((size_t)(li * NB + b) * WIN + (s - (SEQ - WIN))) * AW;
        const bf16_t* kr = PROJ + (size_t)tok * HYB_MAIN + AW;
        float f[8];
        unpack8(*(const u32x4*)(kr + 8 * lane), f); store8f(ok + 8 * lane, f);
        unpack8(*(const u32x4*)(kr + AW + 8 * lane), f); store8f(ov + 8 * lane, f);
    }
}

DI void attn_sample_wg(const Ctx& c, int li, int item) {
    const bf16_t* PROJ = c.ws<bf16_t>(W_PROJ); bf16_t* MIX = c.ws<bf16_t>(W_MIXED);
    const int lane = c.lane, w = c.wave, sb = item / AH, h = item % AH, tok = T + sb;
    const float* ck = c.in(I_CK) + ((size_t)(li * NS + sb) * WIN) * AW + h * AHD; const float* cv = c.in(I_CV) + ((size_t)(li * NS + sb) * WIN) * AW + h * AHD;
    const bf16_t* prow0 = PROJ + (size_t)tok * HYB_MAIN;
    LAS float* pw = (LAS float*)(c.lds + NWAVE * AT_LDS + w * 2048);
    const int f0 = 49 * w, nk = (387 - f0) < 49 ? (387 - f0) : 49;
    float q[64];
    { const bf16_t* qp = prow0 + h * AHD;
#pragma unroll
      for (int j = 0; j < 8; ++j) { float f[8]; unpack8(*(const u32x4*)(qp + 8 * j), f);
#pragma unroll
          for (int e = 0; e < 8; ++e) q[8 * j + e] = f[e] * 0.125f; } }
    float lg = -1e30f;
    if (lane < nk) {
        const int f = f0 + lane, pat = f / 129, jj = f % 129, d = pat == 0 ? 1 : (pat == 1 ? 4 : 16);
        float acc = 0.f;
        if (jj == 0) { const bf16_t* kp = prow0 + AW + h * AHD;
#pragma unroll
            for (int e = 0; e < 8; ++e) { float kf[8]; unpack8(*(const u32x4*)(kp + 8 * e), kf);
#pragma unroll
                for (int x = 0; x < 8; ++x) acc += q[8 * e + x] * kf[x]; }
        } else { const float* kp = ck + (size_t)(WIN - jj * d) * AW;
#pragma unroll
            for (int e = 0; e < 16; ++e) { const f32x4 v = *(const f32x4*)(kp + 4 * e); acc += q[4 * e] * v.x + q[4 * e + 1] * v.y + q[4 * e + 2] * v.z + q[4 * e + 3] * v.w; } }
        lg = acc + c.in(I_RELB)[c_bucket[pat][jj] * AH + h];
    }
    const float mw = wave_max(lg), pv = lane < nk ? __expf(lg - mw) : 0.f, lw = wave_sum(pv);
    pw[lane] = pv;
    LDS_WAIT();
    const int kg = lane >> 4, dc = lane & 15;
    f32x4 o4 = (f32x4){0.f, 0.f, 0.f, 0.f};
#pragma unroll
    for (int i = 0; i < 13; ++i) {
        const int idx = 4 * i + kg;
        if (idx < nk) {
            const int f = f0 + idx, pat = f / 129, jj = f % 129, d = pat == 0 ? 1 : (pat == 1 ? 4 : 16); const float p = pw[idx];
            if (jj == 0) { const u32x2 vv = *(const u32x2*)(prow0 + 2 * AW + h * AHD + 4 * dc);
                o4.x += p * bf2f((bf16_t)(vv.x & 0xffff)); o4.y += p * bf2f((bf16_t)(vv.x >> 16)); o4.z += p * bf2f((bf16_t)(vv.y & 0xffff)); o4.w += p * bf2f((bf16_t)(vv.y >> 16)); }
            else o4 += *(const f32x4*)(cv + (size_t)(WIN - jj * d) * AW + 4 * dc) * p;
        }
    }
#pragma unroll
    for (int e = 0; e < 4; ++e) { o4[e] += __shfl_xor(o4[e], 16); o4[e] += __shfl_xor(o4[e], 32); }
    if (kg == 0) *(LAS f32x4*)(pw + 64 + 4 * dc) = o4;
    if (lane == 0) { pw[128] = mw; pw[129] = lw; }
    __syncthreads();
    if (w == 0 && lane < 16) {
        const LAS float* base = (const LAS float*)(c.lds + NWAVE * AT_LDS);
        float M = -1e30f;
#pragma unroll
        for (int x = 0; x < 8; ++x) M = fmaxf(M, base[x * 512 + 128]);
        float L = 0.f; f32x4 o = (f32x4){0.f, 0.f, 0.f, 0.f};
#pragma unroll
        for (int x = 0; x < 8; ++x) { const float sc = __expf(base[x * 512 + 128] - M); L += base[x * 512 + 129] * sc; o += *(const LAS f32x4*)(base + x * 512 + 64 + 4 * lane) * sc; }
        const float inv = 1.f / L; u32x2 ov; ov.x = pk2(o.x * inv, o.y * inv); ov.y = pk2(o.z * inv, o.w * inv);
        *(u32x2*)(MIX + (size_t)tok * HYB_MIX + h * AHD + 4 * lane) = ov;
    }
    __syncthreads();
}

DI void ssd_wave(const Ctx& c, int li, int item) {
    const float* ACT = c.ws<float>(W_ACT); const float* AUX = c.ws<float>(W_AUX); float* Y = c.ws<float>(W_Y);
    const int lane = c.lane;
    const bool smp = item >= NB * SH * SP; const int it = smp ? item - NB * SH * SP : item;
    const int seq = it / (SH * SP), h = (it / SP) % SH, p = it % SP, g = h / (SH / SG);
    const int L = smp ? 1 : SEQ; const int tok0 = smp ? T + seq : seq * SEQ;
    const float Ah = -__expf(c.in(I_SALOG)[li * SH + h]), Dh = c.in(I_SD)[li * SH + h];
    float h0 = 0.f, h1 = 0.f;
    if (smp) { const float* s0 = c.in(I_SSM) + (((size_t)(li * NS + seq) * SH + h) * SP + p) * SN; h0 = s0[2 * lane]; h1 = s0[2 * lane + 1]; }
#pragma unroll 2
    for (int t = 0; t < L; ++t) {
        const float* a = ACT + (size_t)(tok0 + t) * 4096;
        const float dt = AUX[(size_t)(tok0 + t) * 32 + h], xv = a[h * SP + p];
        const float2 Bv = *(const float2*)(a + SDI + g * SN + 2 * lane), Cv = *(const float2*)(a + SDI + SG * SN + g * SN + 2 * lane);
        const float dec = __expf(dt * Ah), dx = dt * xv;
        h0 = h0 * dec + dx * Bv.x; h1 = h1 * dec + dx * Bv.y;
        const float y = wave_sum(h0 * Cv.x + h1 * Cv.y);
        if (lane == 0) Y[(size_t)(tok0 + t) * 2048 + h * SP + p] = y + Dh * xv;
    }
    float* so = smp ? c.p.out + O_SSS + (((size_t)(li * NS + seq) * SH + h) * SP + p) * SN : c.p.out + O_PSS + (((size_t)(li * NB + seq) * SH + h) * SP + p) * SN;
    *(float2*)(so + 2 * lane) = make_float2(h0, h1);
}
DI void ssd_sample_item(const Ctx& c, int li, int qitem) {
    const int item = qitem >> 2, pq = qitem & 3;
    const float* ACT = c.ws<float>(W_ACT); const float* AUX = c.ws<float>(W_AUX); float* Y = c.ws<float>(W_Y);
    const int lane = c.lane, seq = item / SH, h = item % SH, g = h / (SH / SG), tok = T + seq;
    const float Ah = -__expf(c.in(I_SALOG)[li * SH + h]), Dh = c.in(I_SD)[li * SH + h];
    const float* a = ACT + (size_t)tok * 4096;
    const float dt = AUX[(size_t)tok * 32 + h], dec = __expf(dt * Ah);
    const float2 Bv = *(const float2*)(a + SDI + g * SN + 2 * lane), Cv = *(const float2*)(a + SDI + SG * SN + g * SN + 2 * lane);
    const float* s0 = c.in(I_SSM) + ((size_t)(li * NS + seq) * SH + h) * SP * SN; float* so = c.p.out + O_SSS + ((size_t)(li * NS + seq) * SH + h) * SP * SN;
    const float xl = a[h * SP + lane];
    float ysum = 0.f;
#pragma unroll
    for (int pp = 0; pp < 16; ++pp) { const int p = 16 * pq + pp;
        const float2 hv = *(const float2*)(s0 + (size_t)p * SN + 2 * lane);
        const float dx = dt * __shfl(xl, p);
        const float h0 = hv.x * dec + dx * Bv.x, h1 = hv.y * dec + dx * Bv.y;
        *(float2*)(so + (size_t)p * SN + 2 * lane) = make_float2(h0, h1);
        const float y = wave_sum(h0 * Cv.x + h1 * Cv.y);
        ysum = lane == p ? y : ysum;
    }
    if ((lane >> 4) == pq) Y[(size_t)tok * 2048 + h * SP + lane] = ysum + Dh * xl;
}
DI void hyb_post_token(const Ctx& c, int li, int tok) {
    const bf16_t* PROJ = c.ws<bf16_t>(W_PROJ); const float* Y = c.ws<float>(W_Y); bf16_t* MIX = c.ws<bf16_t>(W_MIXED);
    const float* nw = c.in(I_SNW) + (size_t)li * SDI; const int lane = c.lane;
    float v[16]; float ss0 = 0.f, ss1 = 0.f;
#pragma unroll
    for (int j = 0; j < 16; ++j) { const int ch = lane + 64 * j; const float z = bf2f(PROJ[(size_t)tok * HYB_MAIN + 1536 + ch]); v[j] = Y[(size_t)tok * 2048 + ch] * siluf(z); if (j < 8) ss0 += v[j] * v[j]; else ss1 += v[j] * v[j]; }
    const float r0 = rsqrtf(wave_sum(ss0) * (1.f / 512.f) + EPS), r1 = rsqrtf(wave_sum(ss1) * (1.f / 512.f) + EPS);
#pragma unroll
    for (int j = 0; j < 16; ++j) { const int ch = lane + 64 * j; MIX[(size_t)tok * HYB_MIX + AW + ch] = f2bf(v[j] * (j < 8 ? r0 : r1) * nw[ch]); }
}


constexpr int SLD = 136;
constexpr int L_C = 0, L_B = 34816, L_XT = 69632, L_HS = 87040, L_CS = 104448, L_DT = 108544;
constexpr size_t W_ST = W_HID;
constexpr size_t W_DEC = W_HID + (size_t)NB * 32 * SH * SP * SN * 4;
constexpr int NCH = SEQ / 128;

DI void ssd_chunk_scalars(const Ctx& c, int li, int tok0, int g) {
    const float* AUX = c.ws<float>(W_AUX); LAS float* csS = (LAS float*)(c.lds + L_CS); LAS float* dtS = (LAS float*)(c.lds + L_DT);
    const int hh = c.wave, lane = c.lane, h = 8 * g + hh;
    const float Ah = -__expf(c.in(I_SALOG)[li * SH + h]);
    const float d0 = AUX[(size_t)(tok0 + lane) * 32 + h], d1 = AUX[(size_t)(tok0 + 64 + lane) * 32 + h];
    float s0 = d0 * Ah, s1 = d1 * Ah;
#pragma unroll
    for (int o = 1; o < 64; o <<= 1) { const float t0 = __shfl_up(s0, o), t1 = __shfl_up(s1, o); if (lane >= o) { s0 += t0; s1 += t1; } }
    s1 += __shfl(s0, 63);
    csS[lane * 8 + hh] = s0; csS[(64 + lane) * 8 + hh] = s1; dtS[lane * 8 + hh] = d0; dtS[(64 + lane) * 8 + hh] = d1;
}
DI void ssd_a_item(const Ctx& c, int li, int item) {
    int tid_o = c.tid; asm volatile("" : "+v"(tid_o));
    const int lane_o = tid_o & 63;
    const float* ACT = c.ws<float>(W_ACT); float* ST = c.ws<float>(W_ST); float* DEC = c.ws<float>(W_DEC);
    const int g = item & 1, ch = (item >> 1) % NCH, b = item / (2 * NCH), tok0 = b * SEQ + ch * 128;
    LAS bf16_t* BT = (LAS bf16_t*)(c.lds + L_B);
    const LAS float* csS = (const LAS float*)(c.lds + L_CS); const LAS float* dtS = (const LAS float*)(c.lds + L_DT);
    const int fr = lane_o & 15, fq = lane_o >> 4, w = c.wave, h = 8 * g + w;
    bf16x8 idf[2];
#pragma unroll
    for (int hs = 0; hs < 2; ++hs)
#pragma unroll
        for (int e = 0; e < 8; ++e) idf[hs][e] = (8 * fq + e) == (16 * hs + fr) ? (short)0x3F80 : (short)0;
    __syncthreads();
    ssd_chunk_scalars(c, li, tok0, g);
    {
        bf16x8 bfr[8];
#pragma unroll
        for (int jt = 0; jt < 8; ++jt) bfr[jt] = gfrag_f32(ACT + (size_t)(tok0 + 16 * jt + fr) * 4096 + SDI + g * SN + 32 * (w >> 1) + 8 * fq);
#pragma unroll
        for (int jt = 0; jt < 8; ++jt) { const f32x4 d = __builtin_amdgcn_mfma_f32_16x16x32_bf16(bfr[jt], idf[w & 1], (f32x4){0.f, 0.f, 0.f, 0.f}, 0, 0, 0);
            u32x2 o; o.x = pk2(d[0], d[1]); o.y = pk2(d[2], d[3]); *(LAS u32x2*)(BT + (16 * w + fr) * SLD + 16 * jt + 4 * fq) = o; }
    }
    bf16x8 xfr[8][2];
#pragma unroll
    for (int jt = 0; jt < 8; ++jt)
#pragma unroll
        for (int c2 = 0; c2 < 2; ++c2) xfr[jt][c2] = gfrag_f32(ACT + (size_t)(tok0 + 16 * jt + fr) * 4096 + h * SP + 32 * c2 + 8 * fq);
    __syncthreads();
    if (tid_o < 8) DEC[(size_t)(b * NCH + ch) * SH + 8 * g + tid_o] = __expf(csS[127 * 8 + tid_o]);
    const float csl = csS[127 * 8 + w];
    bf16x8 xwf[4][4];
#pragma unroll
    for (int ks = 0; ks < 4; ++ks) {
        f32x4 d[2][4];
#pragma unroll
        for (int j2 = 0; j2 < 2; ++j2) {
            const int jt = 2 * ks + j2; f32x4 we;
#pragma unroll
            for (int r = 0; r < 4; ++r) { const int j = 16 * jt + 4 * fq + r; we[r] = __expf(csl - csS[j * 8 + w]) * dtS[j * 8 + w]; }
#pragma unroll
            for (int pt = 0; pt < 4; ++pt) d[j2][pt] = __builtin_amdgcn_mfma_f32_16x16x32_bf16(xfr[jt][pt >> 1], idf[pt & 1], (f32x4){0.f, 0.f, 0.f, 0.f}, 0, 0, 0) * we;
        }
#pragma unroll
        for (int pt = 0; pt < 4; ++pt) xwf[pt][ks] = pack8(d[0][pt], d[1][pt]);
    }
#pragma unroll 1
    for (int nh = 0; nh < 2; ++nh) {
        f32x4 acc[4][4];
#pragma unroll
        for (int pt = 0; pt < 4; ++pt)
#pragma unroll
            for (int n4 = 0; n4 < 4; ++n4) acc[pt][n4] = (f32x4){0.f, 0.f, 0.f, 0.f};
#pragma unroll
        for (int ks = 0; ks < 4; ++ks)
#pragma unroll
            for (int n4 = 0; n4 < 4; ++n4) {
                const LAS bf16_t* bp = BT + (16 * (4 * nh + n4) + fr) * SLD + 32 * ks + 4 * fq;
                const bf16x8 bb = lds_frag2(bp, bp + 16);
#pragma unroll
                for (int pt = 0; pt < 4; ++pt) acc[pt][n4] = __builtin_amdgcn_mfma_f32_16x16x32_bf16(bb, xwf[pt][ks], acc[pt][n4], 0, 0, 0);
            }
#pragma unroll
        for (int pt = 0; pt < 4; ++pt) {
            float* so = ST + ((((size_t)(b * NCH + ch) * SH + h) * SP + 16 * pt + fr) * SN);
#pragma unroll
            for (int n4 = 0; n4 < 4; ++n4) *(f32x4*)(so + 16 * (4 * nh + n4) + 4 * fq) = acc[pt][n4];
        }
    }
}
DI void ssd_scan_phase(const Ctx& c, int li) {
    float* ST = c.ws<float>(W_ST); const float* DEC = c.ws<float>(W_DEC);
    for (int idx = blockIdx.x * NTHR + c.tid; idx < NB * SH * SP * SN / 4; idx += gridDim.x * NTHR) {
        const int n4 = idx & 31, p = (idx >> 5) & 63, h = (idx >> 11) & 15, b = idx >> 15;
        f32x4 hcur = (f32x4){0.f, 0.f, 0.f, 0.f};
#pragma unroll 8
        for (int ch = 0; ch < NCH; ++ch) {
            f32x4* a = (f32x4*)(ST + ((((size_t)(b * NCH + ch) * SH + h) * SP + p) * SN)) + n4;
            const f32x4 s = *a; const float d = DEC[(size_t)(b * NCH + ch) * SH + h];
            *a = hcur; hcur = hcur * d + s;
        }
        *((f32x4*)(c.p.out + O_PSS + ((((size_t)(li * NB + b) * SH + h) * SP + p) * SN)) + n4) = hcur;
    }
}
DI void ssd_b_item(const Ctx& c, int li, int item) {
    int tid_o = c.tid; asm volatile("" : "+v"(tid_o));
    const int lane_o = tid_o & 63;
    const float* ACT = c.ws<float>(W_ACT); const float* ST = c.ws<float>(W_ST); const bf16_t* PROJ = c.ws<bf16_t>(W_PROJ); bf16_t* MIX = c.ws<bf16_t>(W_MIXED);
    const int g = item & 1, ch = (item >> 1) % NCH, b = item / (2 * NCH), tok0 = b * SEQ + ch * 128;
    LAS bf16_t* CS_ = (LAS bf16_t*)(c.lds + L_C); LAS bf16_t* BS = (LAS bf16_t*)(c.lds + L_B); LAS bf16_t* XT = (LAS bf16_t*)(c.lds + L_XT); LAS bf16_t* HS = (LAS bf16_t*)(c.lds + L_HS);
    const LAS float* csS = (const LAS float*)(c.lds + L_CS); const LAS float* dtS = (const LAS float*)(c.lds + L_DT);
    const int fr = lane_o & 15, fq = lane_o >> 4, w = c.wave, irow = 16 * w + fr;
    __syncthreads();
    ssd_chunk_scalars(c, li, tok0, g);
#pragma unroll
    for (int it = 0; it < 8; ++it) { const int idx = it * NTHR + tid_o, i = idx >> 5, n4 = idx & 31;
        const f32x4 bv = *(const f32x4*)(ACT + (size_t)(tok0 + i) * 4096 + SDI + g * SN + 4 * n4), cv = *(const f32x4*)(ACT + (size_t)(tok0 + i) * 4096 + SDI + SG * SN + g * SN + 4 * n4);
        u32x2 o; o.x = pk2(bv.x, bv.y); o.y = pk2(bv.z, bv.w); *(LAS u32x2*)(BS + i * SLD + 4 * n4) = o;
        o.x = pk2(cv.x, cv.y); o.y = pk2(cv.z, cv.w); *(LAS u32x2*)(CS_ + i * SLD + 4 * n4) = o; }
    __syncthreads();
    f32x4 cb[8];
#pragma unroll
    for (int jt = 0; jt < 8; ++jt) cb[jt] = (f32x4){0.f, 0.f, 0.f, 0.f};
    bf16x8 cfrag[4];
#pragma unroll
    for (int ks = 0; ks < 4; ++ks) cfrag[ks] = lds_frag(CS_ + irow * SLD + 32 * ks + 8 * fq);
#pragma unroll
    for (int jt = 0; jt < 8; ++jt) if (jt <= w) {
#pragma unroll
        for (int ks = 0; ks < 4; ++ks) cb[jt] = __builtin_amdgcn_mfma_f32_16x16x32_bf16(lds_frag(BS + (16 * jt + fr) * SLD + 32 * ks + 8 * fq), cfrag[ks], cb[jt], 0, 0, 0);
    }
    float rowsq = 0.f;
    float xr[16]; f32x4 hr[4];
#pragma unroll
    for (int it = 0; it < 16; ++it) { const int idx = it * NTHR + tid_o, j = idx >> 6, p = idx & 63; xr[it] = ACT[(size_t)(tok0 + j) * 4096 + (8 * g) * SP + p]; }
#pragma unroll
    for (int it = 0; it < 4; ++it) { const int idx = it * NTHR + tid_o, p = idx >> 5, n4 = idx & 31; hr[it] = *((const f32x4*)(ST + ((((size_t)(b * NCH + ch) * SH + 8 * g) * SP + p) * SN)) + n4); }
#pragma unroll 1
    for (int hh = 0; hh < 8; ++hh) {
        const int h = 8 * g + hh; const float Dh = c.in(I_SD)[li * SH + h];
        int tw = tid_o; asm volatile("" : "+v"(tw));
#pragma unroll
        for (int it = 0; it < 16; ++it) { const int idx = it * NTHR + tw, j = idx >> 6, p = idx & 63; XT[p * SLD + j] = f2bf(xr[it]); }
#pragma unroll
        for (int it = 0; it < 4; ++it) { const int idx = it * NTHR + tw, p = idx >> 5, n4 = idx & 31; const f32x4 v = hr[it];
            u32x2 o; o.x = pk2(v.x, v.y); o.y = pk2(v.z, v.w); *(LAS u32x2*)(HS + p * SLD + 4 * n4) = o; }
        __syncthreads();
        if (hh + 1 < 8) {
            int tq = tid_o; asm volatile("" : "+v"(tq));
#pragma unroll
            for (int it = 0; it < 16; ++it) { const int idx = it * NTHR + tq, j = idx >> 6, p = idx & 63; xr[it] = ACT[(size_t)(tok0 + j) * 4096 + (h + 1) * SP + p]; }
#pragma unroll
            for (int it = 0; it < 4; ++it) { const int idx = it * NTHR + tq, p = idx >> 5, n4 = idx & 31; hr[it] = *((const f32x4*)(ST + ((((size_t)(b * NCH + ch) * SH + h + 1) * SP + p) * SN)) + n4); }
        }
        const float csi = csS[irow * 8 + hh];
        f32x4 xv4[4]; u32x2 zz4[4];
#pragma unroll
        for (int pt = 0; pt < 4; ++pt) { const int col = h * SP + 16 * pt + 4 * fq; xv4[pt] = *(const f32x4*)(ACT + (size_t)(tok0 + irow) * 4096 + col); zz4[pt] = *(const u32x2*)(PROJ + (size_t)(tok0 + irow) * HYB_MAIN + 1536 + col); }
        f32x4 ay[4], ah[4];
#pragma unroll
        for (int pt = 0; pt < 4; ++pt) { ay[pt] = (f32x4){0.f, 0.f, 0.f, 0.f}; ah[pt] = (f32x4){0.f, 0.f, 0.f, 0.f}; }
#pragma unroll
        for (int ks = 0; ks < 4; ++ks) {
#pragma unroll
            for (int pt = 0; pt < 4; ++pt) ah[pt] = __builtin_amdgcn_mfma_f32_16x16x32_bf16(lds_frag(HS + (16 * pt + fr) * SLD + 32 * ks + 8 * fq), cfrag[ks], ah[pt], 0, 0, 0);
            if (2 * ks <= w) {
                float mv[8];
#pragma unroll
                for (int e = 0; e < 8; ++e) {
                    const int j = 32 * ks + (e < 4 ? 4 * fq + e : 16 + 4 * fq + (e - 4));
                    const float cbv = e < 4 ? cb[2 * ks][e] : cb[2 * ks + 1][e - 4];
                    const float csj = *(const volatile LAS float*)(csS + j * 8 + hh), dtj = *(const volatile LAS float*)(dtS + j * 8 + hh);
                    mv[e] = j <= irow ? cbv * __expf(csi - csj) * dtj : 0.f;
                }
                u32x4 mp; mp.x = pk2(mv[0], mv[1]); mp.y = pk2(mv[2], mv[3]); mp.z = pk2(mv[4], mv[5]); mp.w = pk2(mv[6], mv[7]);
                const bf16x8 mfrag = __builtin_bit_cast(bf16x8, mp);
#pragma unroll
                for (int pt = 0; pt < 4; ++pt) ay[pt] = __builtin_amdgcn_mfma_f32_16x16x32_bf16(lds_frag2(XT + (16 * pt + fr) * SLD + 32 * ks + 4 * fq, XT + (16 * pt + fr) * SLD + 32 * ks + 16 + 4 * fq), mfrag, ay[pt], 0, 0, 0);
            }
        }
        const float ei = __expf(csi);
#pragma unroll
        for (int pt = 0; pt < 4; ++pt) {
            const int col = h * SP + 16 * pt + 4 * fq;
            const f32x4 xv = xv4[pt]; const u32x2 zz = zz4[pt];
            const float z0 = bf2f((bf16_t)(zz.x & 0xffff)), z1 = bf2f((bf16_t)(zz.x >> 16)), z2 = bf2f((bf16_t)(zz.y & 0xffff)), z3 = bf2f((bf16_t)(zz.y >> 16));
            const float y0 = (ay[pt][0] + ei * ah[pt][0] + Dh * xv.x) * siluf(z0), y1 = (ay[pt][1] + ei * ah[pt][1] + Dh * xv.y) * siluf(z1);
            const float y2 = (ay[pt][2] + ei * ah[pt][2] + Dh * xv.z) * siluf(z2), y3 = (ay[pt][3] + ei * ah[pt][3] + Dh * xv.w) * siluf(z3);
            rowsq += y0 * y0 + y1 * y1 + y2 * y2 + y3 * y3;
            u32x2 o; o.x = pk2(y0, y1); o.y = pk2(y2, y3); *(u32x2*)(MIX + (size_t)(tok0 + irow) * HYB_MIX + AW + col) = o;
        }
        __syncthreads();
    }
    rowsq += __shfl_xor(rowsq, 16); rowsq += __shfl_xor(rowsq, 32);
    const float rn = rsqrtf(rowsq * (1.f / 512.f) + EPS);
    const float* nw = c.in(I_SNW) + (size_t)li * SDI + g * 512;
    asm volatile("s_waitcnt vmcnt(0)" ::: "memory");
    bf16_t* mrow = MIX + (size_t)(tok0 + irow) * HYB_MIX + AW + g * 512 + fq * 128;
#pragma unroll 4
    for (int cc = 0; cc < 16; ++cc) {
        const u32x4 v = *(const u32x4*)(mrow + 8 * cc); const float* wv = nw + fq * 128 + 8 * cc; u32x4 o;
        o.x = pk2(bf2f((bf16_t)(v.x & 0xffff)) * rn * wv[0], bf2f((bf16_t)(v.x >> 16)) * rn * wv[1]); o.y = pk2(bf2f((bf16_t)(v.y & 0xffff)) * rn * wv[2], bf2f((bf16_t)(v.y >> 16)) * rn * wv[3]);
        o.z = pk2(bf2f((bf16_t)(v.z & 0xffff)) * rn * wv[4], bf2f((bf16_t)(v.z >> 16)) * rn * wv[5]); o.w = pk2(bf2f((bf16_t)(v.w & 0xffff)) * rn * wv[6], bf2f((bf16_t)(v.w >> 16)) * rn * wv[7]);
        *(u32x4*)(mrow + 8 * cc) = o;
    }
}

DI void gdn_pre_token(const Ctx& c, int li, int tok) {
    const bf16_t* PROJ = c.ws<bf16_t>(W_PROJ); bf16_t* ACTB = c.ws<bf16_t>(W_ACT); float* AUX = c.ws<float>(W_AUX); const float* EX = c.ws<float>(W_EXTRA);
    const int lane = c.lane; const bool smp = tok >= T; const int b = smp ? tok - T : tok / SEQ, s = smp ? 0 : tok % SEQ;
    const float* cw = c.in(I_GCW) + (size_t)li * 4 * GQKV;
    const float* st = c.in(I_GCONV) + (size_t)(li * NS + b) * 3 * GQKV;
    const bf16_t* prow = PROJ + (size_t)tok * GDN_MAIN;
#pragma unroll 1
    for (int it = 0; it < 8; ++it) {
        const int ch0 = 512 * it + 8 * lane; float x1[8], x2[8], x3[8], y[8];
        conv8(prow, GDN_MAIN, st, GQKV, cw, ch0, smp, s, x1, x2, x3, y);
        float ss = 0.f;
#pragma unroll
        for (int e = 0; e < 8; ++e) { y[e] = siluf(y[e]); ss += y[e] * y[e]; }
        if (it < 4) {
            ss += __shfl_xor(ss, 1); ss += __shfl_xor(ss, 2); ss += __shfl_xor(ss, 4); ss += __shfl_xor(ss, 8);
            const float r = rsqrtf(ss + EPS) * (it < 2 ? 0.08838834764831845f : 1.f);
#pragma unroll
            for (int e = 0; e < 8; ++e) y[e] *= r;
        }
        { u32x4 o; o.x = pk2(y[0], y[1]); o.y = pk2(y[2], y[3]); o.z = pk2(y[4], y[5]); o.w = pk2(y[6], y[7]); *(u32x4*)(ACTB + (size_t)tok * 4096 + ch0) = o; }
        if (smp) { float* o = c.p.out + O_SGC + (size_t)(li * NS + b) * 3 * GQKV + ch0; store8f(o, x1); store8f(o + GQKV, x2); store8f(o + 2 * GQKV, x3); }
        else if (s >= SEQ - 3) store8f(c.p.out + O_PGC + ((size_t)(li * NB + b) * 3 + (s - (SEQ - 3))) * GQKV + ch0, x3);
    }
    if (lane < GH) {
        AUX[(size_t)tok * 32 + lane] = sigmoidf_(EX[(size_t)tok * 32 + lane]);
        AUX[(size_t)tok * 32 + 16 + lane] = -__expf(c.in(I_GALOG)[li * GH + lane]) * softplusf_(EX[(size_t)tok * 32 + 16 + lane] + c.in(I_GDTB)[li * GH + lane]);
    }
}
DI void gdn_pre_range(const Ctx& c, int li, int item) {
    const bf16_t* PROJ = c.ws<bf16_t>(W_PROJ); bf16_t* ACTB = c.ws<bf16_t>(W_ACT); float* AUX = c.ws<float>(W_AUX); const float* EX = c.ws<float>(W_EXTRA);
    int lane_ = c.lane; asm volatile("" : "+v"(lane_));
    const int lane = lane_, it = item & 7, rg = item >> 3, tok0 = rg * 64, b = tok0 / SEQ, s0 = tok0 % SEQ, ch0 = 512 * it + 8 * lane;
    const float* cw = c.in(I_GCW) + (size_t)li * 4 * GQKV;
    float w0[8], w1[8], w2[8], w3[8], xa[8], xb[8], xc[8];
    load8f(cw + ch0, w0); load8f(cw + GQKV + ch0, w1); load8f(cw + 2 * GQKV + ch0, w2); load8f(cw + 3 * GQKV + ch0, w3);
    const bf16_t* prow = PROJ + (size_t)tok0 * GDN_MAIN + ch0;
    const u32x4 z4 = (u32x4){0u, 0u, 0u, 0u};
    unpack8(s0 >= 3 ? *(const u32x4*)(prow - 3 * GDN_MAIN) : z4, xa); unpack8(s0 >= 2 ? *(const u32x4*)(prow - 2 * GDN_MAIN) : z4, xb); unpack8(s0 >= 1 ? *(const u32x4*)(prow - GDN_MAIN) : z4, xc);
    const float qscale = it < 2 ? 0.08838834764831845f : 1.f;
    {
        const int col = lane & 31; const bool isg = col >= 16;
        const float gal = isg ? -__expf(c.in(I_GALOG)[li * GH + col - 16]) : 0.f, gdb = isg ? c.in(I_GDTB)[li * GH + col - 16] : 0.f;
#pragma unroll
        for (int k = 0; k < 4; ++k) { const int tok = tok0 + 8 * it + 2 * k + (lane >> 5); const float ev = EX[(size_t)tok * 32 + col];
            AUX[(size_t)tok * 32 + col] = isg ? gal * softplusf_(ev + gdb) : sigmoidf_(ev); }
    }
    u32x4 rawn[16];
#pragma unroll
    for (int j = 0; j < 16; ++j) rawn[j] = *(const u32x4*)(prow + (size_t)j * GDN_MAIN);
#pragma unroll 1
    for (int tb = 0; tb < 64; tb += 16) {
        u32x4 raw[16];
#pragma unroll
        for (int j = 0; j < 16; ++j) raw[j] = rawn[j];
        if (tb + 16 < 64) {
#pragma unroll
            for (int j = 0; j < 16; ++j) rawn[j] = *(const u32x4*)(prow + (size_t)(tb + 16 + j) * GDN_MAIN);
        }
#pragma unroll
        for (int j = 0; j < 16; ++j) {
            const int t = tb + j;
            float xd[8], y[8];
            unpack8(raw[j], xd);
            float ss = 0.f;
#pragma unroll
            for (int e = 0; e < 8; ++e) { y[e] = siluf(xa[e] * w0[e] + xb[e] * w1[e] + xc[e] * w2[e] + xd[e] * w3[e]); ss += y[e] * y[e]; }
            if (it < 4) {
                ss += __shfl_xor(ss, 1); ss += __shfl_xor(ss, 2); ss += __shfl_xor(ss, 4); ss += __shfl_xor(ss, 8);
                const float r = rsqrtf(ss + EPS) * qscale;
#pragma unroll
                for (int e = 0; e < 8; ++e) y[e] *= r;
            }
            { u32x4 o; o.x = pk2(y[0], y[1]); o.y = pk2(y[2], y[3]); o.z = pk2(y[4], y[5]); o.w = pk2(y[6], y[7]); *(u32x4*)(ACTB + (size_t)(tok0 + t) * 4096 + ch0) = o; }
            if (s0 + t >= SEQ - 3) store8f(c.p.out + O_PGC + ((size_t)(li * NB + b) * 3 + (s0 + t - (SEQ - 3))) * GQKV + ch0, xd);
#pragma unroll
            for (int e = 0; e < 8; ++e) { xa[e] = xb[e]; xb[e] = xc[e]; xc[e] = xd[e]; }
        }
    }
}
DI void gdn_seq_phase(const Ctx& c, int li, int first_item, int wg, int nwg) {
    const bf16_t* ACTB = c.ws<bf16_t>(W_ACT); const float* AUX = c.ws<float>(W_AUX); bf16_t* MIX = c.ws<bf16_t>(W_MIXED); const bf16_t* PROJ = c.ws<bf16_t>(W_PROJ);
    LAS float* red = (LAS float*)c.lds + 1024;
    const int slot = c.tid >> 8, t8 = c.tid & 255, col = t8 >> 1, half = t8 & 1;
    LAS float* kq = (LAS float*)c.lds + slot * 512;
    const int nslot = nwg * 2;
    for (int base = first_item; base < NB * GH + NS * GH; base += nslot) {
        const int item = base + wg * 2 + slot;
        const bool wg_prompt = (base + wg * 2) < NB * GH;
        const int L = wg_prompt ? SEQ : 1;
        const bool valid = item < NB * GH + NS * GH;
        const bool smp = item >= NB * GH; const int it = smp ? item - NB * GH : item;
        const int seq = valid ? it / GH : 0, vh = valid ? it % GH : 0, hq = vh >> 1;
        const int tok0 = smp ? T + seq : seq * SEQ;
        float S[64];
        if (valid && smp) { const float* s0 = c.in(I_GST) + ((size_t)(li * NS + seq) * GH + vh) * GDK * GDV + (size_t)(64 * half) * GDV + col;
#pragma unroll
            for (int k = 0; k < 64; ++k) S[k] = s0[(size_t)k * GDV]; }
        else {
#pragma unroll
            for (int k = 0; k < 64; ++k) S[k] = 0.f; }
        __syncthreads();
        for (int t = 0; t < L; ++t) {
            LAS float* cur = kq + (t & 1) * 256;
            const bf16_t* a = ACTB + (size_t)(tok0 + t) * 4096;
            cur[t8] = bf2f(a[(t8 < 128 ? 1024 : -128) + hq * 128 + t8]);
            const float vv = bf2f(a[2048 + vh * 128 + col]), beta = AUX[(size_t)(tok0 + t) * 32 + vh], eg = __expf(AUX[(size_t)(tok0 + t) * 32 + 16 + vh]);
            __syncthreads();
            const LAS float* kk = cur + 64 * half; const LAS float* qq = cur + 128 + 64 * half;
            float ks = 0.f;
#pragma unroll
            for (int k = 0; k < 64; k += 4) { const f32x4 kv = *(const LAS f32x4*)(kk + k); ks += kv.x * S[k] + kv.y * S[k + 1] + kv.z * S[k + 2] + kv.w * S[k + 3]; }
            ks += __shfl_xor(ks, 1);
            const float u = beta * (vv - eg * ks);
            asm volatile("" ::: "memory");
            float o = 0.f;
#pragma unroll
            for (int k = 0; k < 64; k += 4) { const f32x4 kv = *(const LAS f32x4*)(kk + k); const f32x4 qv = *(const LAS f32x4*)(qq + k);
                S[k] = eg * S[k] + kv.x * u; S[k + 1] = eg * S[k + 1] + kv.y * u; S[k + 2] = eg * S[k + 2] + kv.z * u; S[k + 3] = eg * S[k + 3] + kv.w * u;
                o += qv.x * S[k] + qv.y * S[k + 1] + qv.z * S[k + 2] + qv.w * S[k + 3]; }
            o += __shfl_xor(o, 1);
            { const float sq = wave_sum(half == 0 ? o * o : 0.f); if (c.lane == 0) red[slot * 4 + ((c.tid >> 6) & 3)] = sq; }
            __syncthreads();
            if (valid && half == 0) { const float tot = red[slot * 4] + red[slot * 4 + 1] + red[slot * 4 + 2] + red[slot * 4 + 3];
                const float z = bf2f(PROJ[(size_t)(tok0 + t) * GDN_MAIN + 4096 + vh * 128 + col]);
                MIX[(size_t)(tok0 + t) * GVW + vh * 128 + col] = f2bf(o * rsqrtf(tot * (1.f / 128.f) + EPS) * c.in(I_GNW)[li * GDV + col] * siluf(z)); }
        }
        if (valid) { float* so = (smp ? c.p.out + O_SGS + ((size_t)(li * NS + seq) * GH + vh) * GDK * GDV : c.p.out + O_PGS + ((size_t)(li * NB + seq) * GH + vh) * GDK * GDV) + (size_t)(64 * half) * GDV + col;
#pragma unroll
            for (int k = 0; k < 64; ++k) so[(size_t)k * GDV] = S[k]; }
        __syncthreads();
    }
}

constexpr size_t W_KCD = W_GO;
constexpr size_t W_U0 = W_HID;
constexpr size_t W_GC = W_HID + (size_t)67108864;
constexpr size_t W_E1 = W_GC + (size_t)T * 16 * 4;
constexpr size_t W_E2 = W_E1 + (size_t)T * 16 * 4;
constexpr size_t W_SS = W_E2 + (size_t)T * 16 * 4;
constexpr size_t W_QB = W_H;
constexpr size_t W_ATTG = W_Y;
constexpr size_t W_KT = W_Y + (size_t)33554432;
constexpr int GA_LDS = 20000;
constexpr int GCH = SEQ / 64;


DI void gdn_a_item(const Ctx& c, int li, int item) {
    const bf16_t* ACTB = c.ws<bf16_t>(W_ACT); const float* AUX = c.ws<float>(W_AUX);
    const int ch = item & (GCH - 1), vh = (item >> 6) & 15, b = item >> 10, hq = vh >> 1, tok0 = b * SEQ + ch * 64;
    int lane_ = c.lane; asm volatile("" : "+v"(lane_));
    const int lane = lane_, fr = lane & 15, fq = lane >> 4;
    LAS unsigned char* wl = c.lds + c.wave * GA_LDS;
    LAS float* As = (LAS float*)wl; LAS bf16_t* Ts = (LAS bf16_t*)wl; LAS bf16_t* KsT = (LAS bf16_t*)wl;
    LAS float* gcS = (LAS float*)(wl + 17408); LAS float* btS = gcS + 64; LAS float* beS = gcS + 128;
    bf16_t* KCDg = c.ws<bf16_t>(W_KCD) + (size_t)item * 8192; bf16_t* ATTg = c.ws<bf16_t>(W_ATTG) + (size_t)item * 4096; bf16_t* U0g = c.ws<bf16_t>(W_U0) + (size_t)item * 8192;
    const int qitem = (b * GQH + hq) * GCH + ch;
    { const float gi = AUX[(size_t)(tok0 + lane) * 32 + 16 + vh], bi = AUX[(size_t)(tok0 + lane) * 32 + vh];
      float gc = gi;
#pragma unroll
      for (int o = 1; o < 64; o <<= 1) { const float t = __shfl_up(gc, o); if (lane >= o) gc += t; }
      const float e1 = __expf(gc), gl_ = __shfl(gc, 63);
      gcS[lane] = gc; btS[lane] = bi; beS[lane] = bi * e1; c.ws<float>(W_GC)[(size_t)(tok0 + lane) * 16 + vh] = gc;
      c.ws<float>(W_E1)[(size_t)(tok0 + lane) * 16 + vh] = e1; c.ws<float>(W_E2)[(size_t)(tok0 + lane) * 16 + vh] = __expf(gl_ - gc); }
    LDS_WAIT();
    {
        bf16x8 kf[4][4], qfa[4][4];
#pragma unroll
        for (int t = 0; t < 4; ++t)
#pragma unroll
            for (int ks = 0; ks < 4; ++ks) { const bf16_t* rp = ACTB + (size_t)(tok0 + 16 * t + fr) * 4096 + hq * 128 + 32 * ks + 8 * fq; kf[t][ks] = *(const bf16x8*)(rp + 1024); qfa[t][ks] = *(const bf16x8*)rp; }
#pragma unroll
        for (int it = 0; it < 4; ++it) {
            const int i = 16 * it + fr; const float gci = gcS[i], bti = btS[i];
#pragma unroll
            for (int jt = 0; jt < 4; ++jt) {
                bf16_t* ap = ATTg + (unsigned)(i * 64 + 16 * jt + 4 * fq);
                if (jt > it) { *(unsigned long long*)ap = 0ull; continue; }
                f32x4 kk = (f32x4){0.f, 0.f, 0.f, 0.f}, qk = (f32x4){0.f, 0.f, 0.f, 0.f};
#pragma unroll
                for (int ks = 0; ks < 4; ++ks) { kk = __builtin_amdgcn_mfma_f32_16x16x32_bf16(kf[jt][ks], kf[it][ks], kk, 0, 0, 0); qk = __builtin_amdgcn_mfma_f32_16x16x32_bf16(kf[jt][ks], qfa[it][ks], qk, 0, 0, 0); }
                f32x4 av, tv;
#pragma unroll
                for (int r = 0; r < 4; ++r) { const int j = 16 * jt + 4 * fq + r; const float dec = __expf(gci - gcS[j]); av[r] = j < i ? bti * kk[r] * dec : 0.f; tv[r] = j <= i ? qk[r] * dec : 0.f; }
                *(LAS f32x4*)(As + i * 64 + 16 * jt + 4 * fq) = av;
                *(unsigned long long*)ap = (unsigned long long)pk2(tv[0], tv[1]) | ((unsigned long long)pk2(tv[2], tv[3]) << 32);
            }
        }
    }
    LDS_WAIT();
    float Tr[64];
#pragma unroll
    for (int i = 0; i < 64; ++i) {
        float acc = lane == i ? 1.f : 0.f;
#pragma unroll
        for (int j = 0; j < i; ++j) acc -= As[i * 64 + j] * Tr[j];
        Tr[i] = acc;
    }
    LDS_WAIT();
#pragma unroll
    for (int i = 0; i < 64; ++i) Ts[i * 72 + lane] = f2bf(Tr[i]);
    LDS_WAIT();
    {
        bf16x8 tfp[4][2], idf[2];
#pragma unroll
        for (int it = 0; it < 4; ++it)
#pragma unroll
            for (int ks = 0; ks < 2; ++ks) tfp[it][ks] = lds_frag2(Ts + (16 * it + fr) * 72 + 32 * ks + 4 * fq, Ts + (16 * it + fr) * 72 + 32 * ks + 16 + 4 * fq);
#pragma unroll
        for (int hs = 0; hs < 2; ++hs)
#pragma unroll
            for (int e = 0; e < 8; ++e) idf[hs][e] = (8 * fq + e) == (16 * hs + fr) ? (short)0x3F80 : (short)0;
        bf16_t* KTg = c.ws<bf16_t>(W_KT) + (size_t)qitem * 8192;
        const bool wr_k = (vh & 1) == 0;
        const bf16_t* AK = ACTB + (size_t)tok0 * 4096 + 1024 + hq * 128; const bf16_t* AV = ACTB + (size_t)tok0 * 4096 + 2048 + vh * 128;
        bf16x8 vfn[4], kfn[4];
#pragma unroll
        for (int t = 0; t < 4; ++t) { vfn[t] = *(const bf16x8*)(AV + (size_t)(16 * t + fr) * 4096 + 8 * fq); kfn[t] = *(const bf16x8*)(AK + (size_t)(16 * t + fr) * 4096 + 8 * fq); }
#pragma unroll 1
        for (int cc = 0; cc < 4; ++cc) {
            bf16x8 vf[4], kf2[4];
#pragma unroll
            for (int t = 0; t < 4; ++t) { vf[t] = vfn[t]; kf2[t] = kfn[t]; }
            if (cc + 1 < 4) {
#pragma unroll
                for (int t = 0; t < 4; ++t) { vfn[t] = *(const bf16x8*)(AV + (size_t)(16 * t + fr) * 4096 + 32 * (cc + 1) + 8 * fq); kfn[t] = *(const bf16x8*)(AK + (size_t)(16 * t + fr) * 4096 + 32 * (cc + 1) + 8 * fq); }
            }
#pragma unroll
            for (int hs = 0; hs < 2; ++hs) {
                const int nt = 2 * cc + hs;
                f32x4 dvv[4], dkk[4];
#pragma unroll
                for (int t = 0; t < 4; ++t) {
                    const f32x4 z = (f32x4){0.f, 0.f, 0.f, 0.f};
                    dvv[t] = __builtin_amdgcn_mfma_f32_16x16x32_bf16(vf[t], idf[hs], z, 0, 0, 0);
                    dkk[t] = __builtin_amdgcn_mfma_f32_16x16x32_bf16(kf2[t], idf[hs], z, 0, 0, 0);
                    if (wr_k) *(unsigned long long*)(KTg + (unsigned)((16 * nt + fr) * 64 + 16 * t + 4 * fq)) = (unsigned long long)pk2(dkk[t][0], dkk[t][1]) | ((unsigned long long)pk2(dkk[t][2], dkk[t][3]) << 32);
                    const f32x4 bt = *(const LAS f32x4*)(btS + 16 * t + 4 * fq), be = *(const LAS f32x4*)(beS + 16 * t + 4 * fq);
                    dvv[t] *= bt; dkk[t] *= be;
                }
                f32x4 au[4], ak[4];
#pragma unroll
                for (int it = 0; it < 4; ++it) { au[it] = (f32x4){0.f, 0.f, 0.f, 0.f}; ak[it] = (f32x4){0.f, 0.f, 0.f, 0.f}; }
#pragma unroll
                for (int ks = 0; ks < 2; ++ks) {
                    const bf16x8 vfrag = pack8(dvv[2 * ks], dvv[2 * ks + 1]), kfrag = pack8(dkk[2 * ks], dkk[2 * ks + 1]);
#pragma unroll
                    for (int it = 0; it < 4; ++it) { au[it] = __builtin_amdgcn_mfma_f32_16x16x32_bf16(tfp[it][ks], vfrag, au[it], 0, 0, 0);
                                                     ak[it] = __builtin_amdgcn_mfma_f32_16x16x32_bf16(kfrag, tfp[it][ks], ak[it], 0, 0, 0); }
                }
#pragma unroll
                for (int it = 0; it < 4; ++it) {
                    *(unsigned long long*)(U0g + (unsigned)(((nt * 4 + it) * 64 + lane) * 4)) = (unsigned long long)pk2(au[it][0], au[it][1]) | ((unsigned long long)pk2(au[it][2], au[it][3]) << 32);
                    *(unsigned long long*)(KCDg + (unsigned)((16 * it + fr) * 128 + 16 * nt + 4 * fq)) = (unsigned long long)pk2(ak[it][0], ak[it][1]) | ((unsigned long long)pk2(ak[it][2], ak[it][3]) << 32);
                }
            }
        }
    }
    LDS_WAIT();
}

constexpr int GS_KCD = 0, GS_QB = 17408, GS_ATT = 34816, GS_KT = 44032, GS_GC = 62464, GS_BUF = 62720;
DI bf16x8 fragA(const LAS unsigned char* p) { const u32x2 x = *(const volatile LAS u32x2*)p, y = *(const volatile LAS u32x2*)(p + 128);     u32x4 r; r.x = x.x; r.y = x.y; r.z = y.x; r.w = y.y; return __builtin_bit_cast(bf16x8, r); }
DI bf16x8 fragB(const LAS unsigned char* p) { const u32x2 x = *(const volatile LAS u32x2*)p, y = *(const volatile LAS u32x2*)(p + 256); u32x4 r; r.x = x.x; r.y = x.y; r.z = y.x; r.w = y.y; return __builtin_bit_cast(bf16x8, r); }
DI void gdn_scan_wg(const Ctx& c, int li, int bvh) {
    const int vh = bvh & 15, b = bvh >> 4, hq = vh >> 1, lane = c.lane, fr = lane & 15, fq = lane >> 4, w = c.wave, tid = c.tid;
    const bf16_t* KCDg = c.ws<bf16_t>(W_KCD) + (size_t)(bvh * GCH) * 8192; const bf16_t* ATTg = c.ws<bf16_t>(W_ATTG) + (size_t)(bvh * GCH) * 4096;
    const bf16_t* U0g = c.ws<bf16_t>(W_U0) + (size_t)(bvh * GCH) * 8192;
    const bf16_t* QBg = c.ws<bf16_t>(W_ACT) + (size_t)(b * SEQ) * 4096 + hq * 128; const bf16_t* KTg = c.ws<bf16_t>(W_KT) + (size_t)((b * GQH + hq) * GCH) * 8192;
    const float* GCg = c.ws<float>(W_GC); bf16_t* MIX = c.ws<bf16_t>(W_MIXED); const bf16_t* PROJ = c.ws<bf16_t>(W_PROJ);
    LAS float* OT = (LAS float*)(c.lds + 2 * GS_BUF);
    LAS float* nwS = OT + 64 * 132;
    if (tid < GDV) nwS[tid] = c.in(I_GNW)[li * GDV + tid];
#define GS_DMA(tn, bb) do { \
        LAS unsigned char* lb_ = c.lds + (bb) * GS_BUF; \
        _Pragma("unroll") for (int k = 0; k < 2; ++k) { const int p_ = 8 * k + w; \
            __builtin_amdgcn_global_load_lds((const unsigned*)(KCDg + (size_t)(tn) * 8192 + p_ * 512 + srcA), (LAS unsigned*)(lb_ + GS_KCD + p_ * 1088), 16, 0, 0); \
            __builtin_amdgcn_global_load_lds((const unsigned*)(QBg + (size_t)(tn) * (64 * 4096) + p_ * (4 * 4096) + srcQ), (LAS unsigned*)(lb_ + GS_QB + p_ * 1088), 16, 0, 0); \
            __builtin_amdgcn_global_load_lds((const unsigned*)(KTg + (size_t)(tn) * 8192 + p_ * 512 + srcB), (LAS unsigned*)(lb_ + GS_KT + p_ * 1152), 16, 0, 0); } \
        __builtin_amdgcn_global_load_lds((const unsigned*)(ATTg + (size_t)(tn) * 4096 + w * 512 + srcB), (LAS unsigned*)(lb_ + GS_ATT + w * 1152), 16, 0, 0); } while (0)
    const int srcA = (lane & 3) * 128 + 8 * (lane >> 2), srcQ = (lane & 3) * 4096 + 8 * (lane >> 2), srcB = (lane & 7) * 64 + 8 * (lane >> 3);
    const int offA = (fr >> 2) * 1088 + (fr & 3) * 16 + (fq >> 1) * 64 + 8 * (fq & 1), offB = (fr >> 3) * 1152 + (fr & 7) * 16 + (fq >> 1) * 128 + 8 * (fq & 1);
    f32x4 sacc[8];
#pragma unroll
    for (int t = 0; t < 8; ++t) sacc[t] = (f32x4){0.f, 0.f, 0.f, 0.f};
    __syncthreads();
    u32x2 u0n[4];
#pragma unroll
    for (int it = 0; it < 4; ++it) u0n[it] = *(const u32x2*)(U0g + ((size_t)(w * 4 + it) * 64 + lane) * 4);
    GS_DMA(0, 0);
    if (tid < 64) *(LAS float*)(c.lds + GS_GC + 4 * tid) = GCg[(size_t)(b * SEQ + tid) * 16 + vh];
    asm volatile("s_waitcnt vmcnt(0)" ::: "memory");
    __syncthreads();
#pragma unroll 1
    for (int t = 0; t < GCH; ++t) {
        const LAS unsigned char* buf = c.lds + (t & 1) * GS_BUF; LAS unsigned char* nbuf = c.lds + ((t + 1) & 1) * GS_BUF;
        const int tok0 = b * SEQ + t * 64;
        const bool more = t + 1 < GCH;
        u32x2 u0r[4];
#pragma unroll
        for (int it = 0; it < 4; ++it) u0r[it] = u0n[it];
        float gstg = 0.f;
        if (more) {
#pragma unroll
            for (int it = 0; it < 4; ++it) u0n[it] = *(const u32x2*)(U0g + (size_t)(t + 1) * 8192 + ((size_t)(w * 4 + it) * 64 + lane) * 4);
            if (tid < 64) gstg = GCg[(size_t)(tok0 + 64 + tid) * 16 + vh];
            GS_DMA(t + 1, (t + 1) & 1);
        }
        const LAS unsigned char* KCD = buf + GS_KCD; const LAS unsigned char* QB = buf + GS_QB; const LAS unsigned char* ATT = buf + GS_ATT; const LAS unsigned char* KT = buf + GS_KT;
        const LAS float* gcS = (const LAS float*)(buf + GS_GC);
        bf16x8 sfrag[4];
#pragma unroll
        for (int ks = 0; ks < 4; ++ks) sfrag[ks] = pack8(sacc[2 * ks], sacc[2 * ks + 1]);
        const float gl = gcS[63], egl = __expf(gl);
        bf16x8 ufrag[2], udfrag[2]; f32x4 ov[4];
#pragma unroll
        for (int hp = 0; hp < 2; ++hp) {
            f32x4 uu[2];
#pragma unroll
            for (int h2 = 0; h2 < 2; ++h2) {
                const int it = 2 * hp + h2;
                f32x4 ks_ = (f32x4){0.f, 0.f, 0.f, 0.f}, qs_ = (f32x4){0.f, 0.f, 0.f, 0.f};
#pragma unroll
                for (int ks = 0; ks < 4; ++ks) {
                    ks_ = __builtin_amdgcn_mfma_f32_16x16x32_bf16(fragA(KCD + offA + it * 4352 + ks * 256), sfrag[ks], ks_, 0, 0, 0);
                    qs_ = __builtin_amdgcn_mfma_f32_16x16x32_bf16(fragA(QB + offA + it * 4352 + ks * 256), sfrag[ks], qs_, 0, 0, 0);
                }
                const f32x4 gci = *(const LAS f32x4*)(gcS + 16 * it + 4 * fq);
                f32x4 u;
                u[0] = bf2f((bf16_t)(u0r[it].x & 0xffff)) - ks_[0]; u[1] = bf2f((bf16_t)(u0r[it].x >> 16)) - ks_[1]; u[2] = bf2f((bf16_t)(u0r[it].y & 0xffff)) - ks_[2]; u[3] = bf2f((bf16_t)(u0r[it].y >> 16)) - ks_[3];
                uu[h2] = u;
#pragma unroll
                for (int r = 0; r < 4; ++r) ov[it][r] = qs_[r] * __expf(gci[r]);
            }
            ufrag[hp] = pack8(uu[0], uu[1]);
            const f32x4 g0 = *(const LAS f32x4*)(gcS + 32 * hp + 4 * fq), g1 = *(const LAS f32x4*)(gcS + 32 * hp + 16 + 4 * fq);
            f32x4 d0, d1;
#pragma unroll
            for (int r = 0; r < 4; ++r) { d0[r] = uu[0][r] * __expf(gl - g0[r]); d1[r] = uu[1][r] * __expf(gl - g1[r]); }
            udfrag[hp] = pack8(d0, d1);
        }
#pragma unroll
        for (int it = 0; it < 4; ++it) {
            f32x4 au = ov[it];
#pragma unroll
            for (int ks = 0; ks < 2; ++ks) au = __builtin_amdgcn_mfma_f32_16x16x32_bf16(fragB(ATT + offB + it * 2304 + ks * 512), ufrag[ks], au, 0, 0, 0);
#pragma unroll
            for (int r = 0; r < 4; ++r) OT[(16 * it + 4 * fq + r) * 132 + 16 * w + fr] = au[r];
        }
        LDS_WAIT(); __builtin_amdgcn_s_barrier(); asm volatile("" ::: "memory");
        const int frow = tid >> 3, fc = tid & 7;
        const u32x4 zlo = *(const u32x4*)(PROJ + (size_t)(tok0 + frow) * GDN_MAIN + 4096 + vh * 128 + 16 * fc), zhi = *(const u32x4*)(PROJ + (size_t)(tok0 + frow) * GDN_MAIN + 4096 + vh * 128 + 16 * fc + 8);
#pragma unroll
        for (int tt = 0; tt < 8; ++tt) {
            f32x4 a = sacc[tt] * egl;
#pragma unroll
            for (int ks = 0; ks < 2; ++ks) a = __builtin_amdgcn_mfma_f32_16x16x32_bf16(fragB(KT + offB + tt * 2304 + ks * 512), udfrag[ks], a, 0, 0, 0);
            sacc[tt] = a;
        }
        {
            float ov16[16], zf[16];
#pragma unroll
            for (int q4 = 0; q4 < 4; ++q4) { const f32x4 v = *(const LAS f32x4*)(OT + frow * 132 + 16 * fc + 4 * q4); ov16[4 * q4] = v.x; ov16[4 * q4 + 1] = v.y; ov16[4 * q4 + 2] = v.z; ov16[4 * q4 + 3] = v.w; }
            float ss = 0.f;
#pragma unroll
            for (int e = 0; e < 16; ++e) ss += ov16[e] * ov16[e];
            ss += __shfl_xor(ss, 1); ss += __shfl_xor(ss, 2); ss += __shfl_xor(ss, 4);
            const float rn = rsqrtf(ss * (1.f / 128.f) + EPS);
            unpack8(zlo, zf); unpack8(zhi, zf + 8);
            float res[16];
#pragma unroll
            for (int e = 0; e < 16; ++e) res[e] = ov16[e] * rn * nwS[16 * fc + e] * siluf(zf[e]);
            u32x4 o0, o1; o0.x = pk2(res[0], res[1]); o0.y = pk2(res[2], res[3]); o0.z = pk2(res[4], res[5]); o0.w = pk2(res[6], res[7]);
            o1.x = pk2(res[8], res[9]); o1.y = pk2(res[10], res[11]); o1.z = pk2(res[12], res[13]); o1.w = pk2(res[14], res[15]);
            bf16_t* mp = MIX + (size_t)(tok0 + frow) * GVW + vh * 128 + 16 * fc;
            *(u32x4*)mp = o0; *(u32x4*)(mp + 8) = o1;
        }
        if (more && tid < 64) *(LAS float*)(nbuf + GS_GC + 4 * tid) = gstg;
        asm volatile("s_waitcnt vmcnt(0)" ::: "memory");
        __syncthreads();
    }
#undef GS_DMA
    float* so = c.p.out + O_PGS + ((size_t)(li * NB + b) * GH + vh) * GDK * GDV;
#pragma unroll
    for (int tt = 0; tt < 8; ++tt)
#pragma unroll
        for (int r = 0; r < 4; ++r) so[(size_t)(16 * tt + 4 * fq + r) * GDV + 16 * w + fr] = sacc[tt][r];
}


constexpr int G2_E1 = 62464, G2_E2 = 62720, G2_BUF = 62976, G2_OT = 2 * G2_BUF;
DI void gdn_scan2_wg(const Ctx& c, int li, int bvh, int hf) {
    const int vh = bvh & 15, b = bvh >> 4, hq = vh >> 1, lane = c.lane, fr = lane & 15, fq = lane >> 4, w = c.wave, tid = c.tid;
    const bf16_t* KCDg = c.ws<bf16_t>(W_KCD) + (size_t)(bvh * GCH) * 8192; const bf16_t* ATTg = c.ws<bf16_t>(W_ATTG) + (size_t)(bvh * GCH) * 4096;
    const bf16_t* U0g = c.ws<bf16_t>(W_U0) + (size_t)(bvh * GCH) * 8192;
    const bf16_t* QBg = c.ws<bf16_t>(W_ACT) + (size_t)(b * SEQ) * 4096 + hq * 128; const bf16_t* KTg = c.ws<bf16_t>(W_KT) + (size_t)((b * GQH + hq) * GCH) * 8192;
    const float* E1g = c.ws<float>(W_E1); const float* E2g = c.ws<float>(W_E2); float* SSg = c.ws<float>(W_SS); bf16_t* MIX = c.ws<bf16_t>(W_MIXED);
    LAS float* OT = (LAS float*)(c.lds + G2_OT);
    const bool comp = w < 4; const int hw = w - 4;
#define G2_DMA(tn, bb) do { \
        LAS unsigned char* lb_ = c.lds + (bb) * G2_BUF; \
        _Pragma("unroll") for (int k = 0; k < 4; ++k) { const int p_ = 4 * k + hw; \
            __builtin_amdgcn_global_load_lds((const unsigned*)(KCDg + (size_t)(tn) * 8192 + p_ * 512 + srcA), (LAS unsigned*)(lb_ + GS_KCD + p_ * 1088), 16, 0, 0); \
            __builtin_amdgcn_global_load_lds((const unsigned*)(QBg + (size_t)(tn) * (64 * 4096) + p_ * (4 * 4096) + srcQ), (LAS unsigned*)(lb_ + GS_QB + p_ * 1088), 16, 0, 0); \
            __builtin_amdgcn_global_load_lds((const unsigned*)(KTg + (size_t)(tn) * 8192 + p_ * 512 + srcB), (LAS unsigned*)(lb_ + GS_KT + p_ * 1152), 16, 0, 0); } \
        _Pragma("unroll") for (int k = 0; k < 2; ++k) { const int p_ = 4 * k + hw; \
            __builtin_amdgcn_global_load_lds((const unsigned*)(ATTg + (size_t)(tn) * 4096 + p_ * 512 + srcB), (LAS unsigned*)(lb_ + GS_ATT + p_ * 1152), 16, 0, 0); } } while (0)
#define G2_OUT(tp) do { \
        const int ht_ = tid - 256, row_ = ht_ >> 2, cq_ = ht_ & 3; const LAS float* op_ = OT + ((tp) & 1) * (64 * 68) + row_ * 68 + 16 * cq_; \
        const f32x4 a0 = *(const LAS f32x4*)op_, a1 = *(const LAS f32x4*)(op_ + 4), a2 = *(const LAS f32x4*)(op_ + 8), a3 = *(const LAS f32x4*)(op_ + 12); \
        float ss_ = a0.x * a0.x + a0.y * a0.y + a0.z * a0.z + a0.w * a0.w + a1.x * a1.x + a1.y * a1.y + a1.z * a1.z + a1.w * a1.w \
                  + a2.x * a2.x + a2.y * a2.y + a2.z * a2.z + a2.w * a2.w + a3.x * a3.x + a3.y * a3.y + a3.z * a3.z + a3.w * a3.w; \
        ss_ += __shfl_xor(ss_, 1); ss_ += __shfl_xor(ss_, 2); \
        const size_t tk_ = (size_t)(b * SEQ + (tp) * 64 + row_); \
        if (cq_ == 0) SSg[(tk_ * 16 + vh) * 2 + hf] = ss_; \
        u32x4 o0, o1; o0.x = pk2(a0.x, a0.y); o0.y = pk2(a0.z, a0.w); o0.z = pk2(a1.x, a1.y); o0.w = pk2(a1.z, a1.w); \
        o1.x = pk2(a2.x, a2.y); o1.y = pk2(a2.z, a2.w); o1.z = pk2(a3.x, a3.y); o1.w = pk2(a3.z, a3.w); \
        bf16_t* mp_ = MIX + tk_ * GVW + vh * 128 + 64 * hf + 16 * cq_; *(u32x4*)mp_ = o0; *(u32x4*)(mp_ + 8) = o1; } while (0)
    const int srcA = (lane & 3) * 128 + 8 * (lane >> 2), srcQ = (lane & 3) * 4096 + 8 * (lane >> 2), srcB = (lane & 7) * 64 + 8 * (lane >> 3);
    const int offA = (fr >> 2) * 1088 + (fr & 3) * 16 + (fq >> 1) * 64 + 8 * (fq & 1), offB = (fr >> 3) * 1152 + (fr & 7) * 16 + (fq >> 1) * 128 + 8 * (fq & 1);
    const int nt = 4 * hf + (w & 3);
    f32x4 sacc[8];
#pragma unroll
    for (int t = 0; t < 8; ++t) sacc[t] = (f32x4){0.f, 0.f, 0.f, 0.f};
    __syncthreads();
    u32x2 u0n[4];
#pragma unroll
    for (int it = 0; it < 4; ++it) u0n[it] = (u32x2){0u, 0u};
    if (comp) {
#pragma unroll
        for (int it = 0; it < 4; ++it) u0n[it] = *(const u32x2*)(U0g + ((size_t)(nt * 4 + it) * 64 + lane) * 4);
    } else {
        G2_DMA(0, 0);
        if (hw == 0) { *(LAS float*)(c.lds + G2_E1 + 4 * lane) = E1g[(size_t)(b * SEQ + lane) * 16 + vh]; *(LAS float*)(c.lds + G2_E2 + 4 * lane) = E2g[(size_t)(b * SEQ + lane) * 16 + vh]; }
    }
    asm volatile("s_waitcnt vmcnt(0)" ::: "memory");
    __syncthreads();
#pragma unroll 1
    for (int t = 0; t < GCH; ++t) {
        const LAS unsigned char* buf = c.lds + (t & 1) * G2_BUF; LAS unsigned char* nbuf = c.lds + ((t + 1) & 1) * G2_BUF;
        const int tok0 = b * SEQ + t * 64;
        const bool more = t + 1 < GCH;
        if (comp) {
            u32x2 u0r[4];
#pragma unroll
            for (int it = 0; it < 4; ++it) u0r[it] = u0n[it];
            if (more) {
#pragma unroll
                for (int it = 0; it < 4; ++it) u0n[it] = *(const u32x2*)(U0g + (size_t)(t + 1) * 8192 + ((size_t)(nt * 4 + it) * 64 + lane) * 4);
            }
            const LAS unsigned char* KCD = buf + GS_KCD; const LAS unsigned char* QB = buf + GS_QB; const LAS unsigned char* ATT = buf + GS_ATT; const LAS unsigned char* KT = buf + GS_KT;
            const LAS float* e1S = (const LAS float*)(buf + G2_E1); const LAS float* e2S = (const LAS float*)(buf + G2_E2);
            bf16x8 sfrag[4];
#pragma unroll
            for (int ks = 0; ks < 4; ++ks) sfrag[ks] = pack8(sacc[2 * ks], sacc[2 * ks + 1]);
            const float egl = e1S[63];
            bf16x8 ufrag[2], udfrag[2]; f32x4 ov[4];
#pragma unroll
            for (int hp = 0; hp < 2; ++hp) {
                f32x4 uu[2];
#pragma unroll
                for (int h2 = 0; h2 < 2; ++h2) {
                    const int it = 2 * hp + h2;
                    f32x4 ks_ = (f32x4){0.f, 0.f, 0.f, 0.f}, qs_ = (f32x4){0.f, 0.f, 0.f, 0.f};
#pragma unroll
                    for (int ks = 0; ks < 4; ++ks) {
                        ks_ = __builtin_amdgcn_mfma_f32_16x16x32_bf16(fragA(KCD + offA + it * 4352 + ks * 256), sfrag[ks], ks_, 0, 0, 0);
                        qs_ = __builtin_amdgcn_mfma_f32_16x16x32_bf16(fragA(QB + offA + it * 4352 + ks * 256), sfrag[ks], qs_, 0, 0, 0);
                    }
                    const f32x4 e1 = *(const LAS f32x4*)(e1S + 16 * it + 4 * fq);
                    f32x4 u;
                    u[0] = bf2f((bf16_t)(u0r[it].x & 0xffff)) - ks_[0]; u[1] = bf2f((bf16_t)(u0r[it].x >> 16)) - ks_[1]; u[2] = bf2f((bf16_t)(u0r[it].y & 0xffff)) - ks_[2]; u[3] = bf2f((bf16_t)(u0r[it].y >> 16)) - ks_[3];
                    uu[h2] = u; ov[it] = qs_ * e1;
                }
                ufrag[hp] = pack8(uu[0], uu[1]);
                const f32x4 g0 = *(const LAS f32x4*)(e2S + 32 * hp + 4 * fq), g1 = *(const LAS f32x4*)(e2S + 32 * hp + 16 + 4 * fq);
                udfrag[hp] = pack8(uu[0] * g0, uu[1] * g1);
            }
            LAS float* ot = OT + (t & 1) * (64 * 68);
#pragma unroll
            for (int it = 0; it < 4; ++it) {
                f32x4 au = ov[it];
#pragma unroll
                for (int ks = 0; ks < 2; ++ks) au = __builtin_amdgcn_mfma_f32_16x16x32_bf16(fragB(ATT + offB + it * 2304 + ks * 512), ufrag[ks], au, 0, 0, 0);
#pragma unroll
                for (int r = 0; r < 4; ++r) ot[(16 * it + 4 * fq + r) * 68 + 16 * (w & 3) + fr] = au[r];
            }
#pragma unroll
            for (int tt = 0; tt < 8; ++tt) {
                f32x4 a = sacc[tt] * egl;
#pragma unroll
                for (int ks = 0; ks < 2; ++ks) a = __builtin_amdgcn_mfma_f32_16x16x32_bf16(fragB(KT + offB + tt * 2304 + ks * 512), udfrag[ks], a, 0, 0, 0);
                sacc[tt] = a;
            }
        } else {
            float e1n = 0.f, e2n = 0.f;
            if (more) {
                G2_DMA(t + 1, (t + 1) & 1);
                if (hw == 0) { e1n = E1g[(size_t)(tok0 + 64 + lane) * 16 + vh]; e2n = E2g[(size_t)(tok0 + 64 + lane) * 16 + vh]; }
            }
            if (t > 0) G2_OUT(t - 1);
            if (more && hw == 0) { *(LAS float*)(nbuf + G2_E1 + 4 * lane) = e1n; *(LAS float*)(nbuf + G2_E2 + 4 * lane) = e2n; }
            asm volatile("s_waitcnt vmcnt(0)" ::: "memory");
        }
        __syncthreads();
    }
    if (!comp) G2_OUT(GCH - 1);
#undef G2_DMA
#undef G2_OUT
    if (comp) {
        float* so = c.p.out + O_PGS + ((size_t)(li * NB + b) * GH + vh) * GDK * GDV;
#pragma unroll
        for (int tt = 0; tt < 8; ++tt)
#pragma unroll
            for (int r = 0; r < 4; ++r) so[(size_t)(16 * tt + 4 * fq + r) * GDV + 16 * nt + fr] = sacc[tt][r];
    }
}
DI void gdn_norm_gate_token(const Ctx& c, int li, int tok) {
    const bf16_t* PROJ = c.ws<bf16_t>(W_PROJ); bf16_t* MIX = c.ws<bf16_t>(W_MIXED); const float* SSg = c.ws<float>(W_SS);
    const float* nw = c.in(I_GNW) + (size_t)li * GDV; const int lane = c.lane;
    u32x4 ov[4], zv[4]; float2 sv[4];
#pragma unroll
    for (int it = 0; it < 4; ++it) { const int ch0 = 512 * it + 8 * lane; ov[it] = *(const u32x4*)(MIX + (size_t)tok * GVW + ch0); zv[it] = *(const u32x4*)(PROJ + (size_t)tok * GDN_MAIN + 4096 + ch0);
        sv[it] = *(const float2*)(SSg + ((size_t)tok * 16 + (ch0 >> 7)) * 2); }
#pragma unroll
    for (int it = 0; it < 4; ++it) {
        const int ch0 = 512 * it + 8 * lane; float o[8], z[8], w8[8];
        unpack8(ov[it], o); unpack8(zv[it], z); load8f(nw + (ch0 & 127), w8);
        const float r = rsqrtf((sv[it].x + sv[it].y) * (1.f / 128.f) + EPS);
        u32x4 res; res.x = pk2(o[0] * r * w8[0] * siluf(z[0]), o[1] * r * w8[1] * siluf(z[1])); res.y = pk2(o[2] * r * w8[2] * siluf(z[2]), o[3] * r * w8[3] * siluf(z[3]));
        res.z = pk2(o[4] * r * w8[4] * siluf(z[4]), o[5] * r * w8[5] * siluf(z[5])); res.w = pk2(o[6] * r * w8[6] * siluf(z[6]), o[7] * r * w8[7] * siluf(z[7]));
        *(u32x4*)(MIX + (size_t)tok * GVW + ch0) = res;
    }
}

DI void gdn_post_token(const Ctx& c, int li, int tok) {
    const bf16_t* PROJ = c.ws<bf16_t>(W_PROJ); const float* Y = c.ws<float>(W_Y); bf16_t* MIX = c.ws<bf16_t>(W_MIXED);
    const float* nw = c.in(I_GNW) + (size_t)li * GDV; const int lane = c.lane;
#pragma unroll 1
    for (int it = 0; it < 4; ++it) {
        const int ch0 = 512 * it + 8 * lane; float o[8], z[8], w[8];
        load8f(Y + (size_t)tok * 2048 + ch0, o); unpack8(*(const u32x4*)(PROJ + (size_t)tok * GDN_MAIN + 4096 + ch0), z); load8f(nw + (ch0 & 127), w);
        float ss = 0.f;
#pragma unroll
        for (int e = 0; e < 8; ++e) ss += o[e] * o[e];
        ss += __shfl_xor(ss, 1); ss += __shfl_xor(ss, 2); ss += __shfl_xor(ss, 4); ss += __shfl_xor(ss, 8);
        const float r = rsqrtf(ss * (1.f / 128.f) + EPS);
        u32x4 ov; ov.x = pk2(o[0] * r * w[0] * siluf(z[0]), o[1] * r * w[1] * siluf(z[1])); ov.y = pk2(o[2] * r * w[2] * siluf(z[2]), o[3] * r * w[3] * siluf(z[3]));
        ov.z = pk2(o[4] * r * w[4] * siluf(z[4]), o[5] * r * w[5] * siluf(z[5])); ov.w = pk2(o[6] * r * w[6] * siluf(z[6]), o[7] * r * w[7] * siluf(z[7]));
        *(u32x4*)(MIX + (size_t)tok * GVW + ch0) = ov;
    }
}

DI void cache_copy(const Ctx& c, int wg, int nwg, int part) {
    const size_t gt = (size_t)wg * NTHR + c.tid, gn = (size_t)nwg * NTHR;
    const size_t per = (size_t)(WIN - 1) * AW / 4, tot = (size_t)2 * NS * per, cut = tot / 2, lo = part ? cut : 0, hi = part ? tot : cut;
#pragma unroll 8
    for (size_t i = lo + gt; i < hi; i += gn) { const size_t sq = i / per, r = i % per;
        ((f32x4*)(c.p.out + O_SK + sq * WIN * AW))[r] = ((const f32x4*)(c.in(I_CK) + sq * WIN * AW + AW))[r];
        ((f32x4*)(c.p.out + O_SV + sq * WIN * AW))[r] = ((const f32x4*)(c.in(I_CV) + sq * WIN * AW + AW))[r]; }
}
DI void weights_half(const Ctx& c, int half, int gw0, int ngw0) {
    const int i = half;
    transpose_mat(c, c.in(I_WHIN) + (size_t)i * D * HYB_IN, D, HYB_IN, c.ws<bf16_t>(W_HIN) + (size_t)i * HYB_IN * D, 0, gw0, ngw0);
    transpose_mat(c, c.in(I_WHOUT) + (size_t)i * HYB_MIX * D, HYB_MIX, D, c.ws<bf16_t>(W_HOUT) + (size_t)i * D * HYB_MIX, 0, gw0, ngw0);
    transpose_mat(c, c.in(I_WGIN) + (size_t)i * D * GDN_IN, D, GDN_IN, c.ws<bf16_t>(W_GIN) + (size_t)i * GDN_IN * D, 0, gw0, ngw0);
    transpose_mat(c, c.in(I_WGOUT) + (size_t)i * GVW * D, GVW, D, c.ws<bf16_t>(W_GOUT) + (size_t)i * D * GVW, 0, gw0, ngw0);
    for (int l = 2 * half; l < 2 * half + 2; ++l) {
        transpose_mat(c, c.in(I_WFG) + (size_t)l * D * FF, D, FF, c.ws<bf16_t>(W_GU) + (size_t)l * 2 * FF * D, 1, gw0, ngw0);
        transpose_mat(c, c.in(I_WFU) + (size_t)l * D * FF, D, FF, c.ws<bf16_t>(W_GU) + (size_t)l * 2 * FF * D, 2, gw0, ngw0);
        transpose_mat(c, c.in(I_WFD) + (size_t)l * FF * D, FF, D, c.ws<bf16_t>(W_DN) + (size_t)l * D * FF, 0, gw0, ngw0);
    }
}
constexpr int PH_PER_LAYER = 10, N_PHASES = 1 + 2 * 10 + 2 * 9;
DI void phase_decode(int ph, int& l, int& sp) {
    int q = ph - 1; l = 0; if (q >= 10) { q -= 10; l = 1; if (q >= 9) { q -= 9; l = 2; if (q >= 10) { q -= 10; l = 3; } } }
    sp = (l & 1) ? (q >= 2 ? q + 1 : q) : q;
}
#ifndef ONLY
#define ONLY -1
#endif
#define EN(x) (ONLY < 0 || ONLY == (x))
DI void run_phase(const Ctx& c, int ph) {
    if (ph == 0) { if (!EN(0)) return;
        weights_half(c, 0, -1, 0); weights_half(c, 1, -1, 0);
        rowpass_phase(c, 0, nullptr, c.in(I_NMPRE), true);
        return;
    }
    int l, sp; phase_decode(ph, l, sp); const int li = l >> 1; const bool hyb = (l & 1) == 0;
    bf16_t* H = c.ws<bf16_t>(W_H); bf16_t* PROJ = c.ws<bf16_t>(W_PROJ); bf16_t* MIX = c.ws<bf16_t>(W_MIXED); bf16_t* GO = c.ws<bf16_t>(W_GO); bf16_t* HID = c.ws<bf16_t>(W_HID);
    switch (sp) {
    case 0: {
        if (!EN(1)) break;
        const bf16_t* Wt = hyb ? c.ws<bf16_t>(W_HIN) + (size_t)li * HYB_IN * D : c.ws<bf16_t>(W_GIN) + (size_t)li * GDN_IN * D;
        const int nmain = hyb ? HYB_MAIN : GDN_MAIN, nall = hyb ? HYB_IN : GDN_IN;
        { pg8::Gemm g{H, Wt, T, nmain, D}; pg8::StaticOrder S; S.init(T, nmain, gridDim.x, blockIdx.x); pg8::EpiBf16Perm E{PROJ, nmain};
          pg8::gemm_phase<pg8::EpiBf16Perm, pg8::StaticOrder>(c.lds, g, S, E, nullptr); }
        { Epi e{0, PROJ, c.ws<float>(W_EXTRA), nmain, 0}; gemm_ksplit<4>(c, H, D, T, Wt + (size_t)nmain * D, D, nall - nmain, D, e); }
        { Epi e{0, PROJ + (size_t)T * nmain, c.ws<float>(W_EXTRA) + (size_t)T * 32, nmain, nmain}; gemm_ksplit<2>(c, H + (size_t)T * D, D, NS, Wt, D, nall, D, e); }
    } break;
    case 1: {
        if (hyb) {
            if (EN(2)) { if (c.wave == 0) for (int tok = T + blockIdx.x; tok < TT; tok += gridDim.x) hyb_pre_token(c, li, tok);
                         for (int tok = c.gw; tok < T; tok += c.ngw) hyb_pre_token(c, li, tok); }
            LAS float* pl = (LAS float*)(c.lds + NWAVE * AT_LDS + c.wave * 2048);
            if (EN(3)) { for (int it = blockIdx.x; it < NS * AH; it += gridDim.x) attn_sample_wg(c, li, it);
                         { const int vwg = (blockIdx.x & 7) * (gridDim.x >> 3) + (blockIdx.x >> 3), vgw = ((gridDim.x & 7) == 0 ? vwg : (int)blockIdx.x) * NWAVE + c.wave;
                           for (int it = vgw; it < NB * AH * 256; it += c.ngw) attn_mfma_item(c, li, it); } }
        } else { if (EN(4)) {
            if (c.wave == 0) for (int tok = T + blockIdx.x; tok < TT; tok += gridDim.x) gdn_pre_token(c, li, tok);
            for (int rg = blockIdx.x; rg < T / 64; rg += gridDim.x) {
                gdn_pre_range(c, li, rg * 8 + c.wave);
                asm volatile("s_waitcnt vmcnt(0)" ::: "memory"); __syncthreads();
                const int bb = rg >> 6, ch = rg & 63;
#pragma unroll 1
                for (int k2 = 0; k2 < 2; ++k2) gdn_a_item(c, li, ((bb * GH + 2 * c.wave + k2) << 6) + ch);
                __syncthreads();
            } } }
    } break;
    case 2: {
        if (hyb) { if (EN(5)) { for (int it = blockIdx.x; it < NB * NCH * 2; it += gridDim.x) ssd_a_item(c, li, it);
                                for (int it = c.gw; it < NS * SH * 4; it += c.ngw) ssd_sample_item(c, li, it); } }
        else { }
    } break;
    case 3: {
        if (hyb) { if (EN(7)) { ssd_scan_phase(c, li); if (c.wave == 0) for (int tok = T + blockIdx.x; tok < TT; tok += gridDim.x) hyb_post_token(c, li, tok); } }
        else { if (EN(8)) {
            constexpr int NSW = 2 * NB * GH;
            if ((int)blockIdx.x < NSW) gdn_scan2_wg(c, li, ((blockIdx.x >> 4) << 3) + (blockIdx.x & 7), (blockIdx.x >> 3) & 1);
            else { const int wg = blockIdx.x - NSW, nwg = gridDim.x - NSW;
                gdn_seq_phase(c, li, NB * GH, wg, nwg);
                cache_copy(c, wg, nwg, l == 1 ? 0 : 1);
                } } }
    } break;
    case 4: {
        if (hyb) { if (EN(14)) for (int it = blockIdx.x; it < NB * NCH * 2; it += gridDim.x) ssd_b_item(c, li, it); }
        else { if (EN(15)) for (int tok = c.gw; tok < T; tok += c.ngw) gdn_norm_gate_token(c, li, tok); }
    } break;
    case 5: {
        if (!EN(9)) break;
        const bf16_t* Wt = hyb ? c.ws<bf16_t>(W_HOUT) + (size_t)li * D * HYB_MIX : c.ws<bf16_t>(W_GOUT) + (size_t)li * D * GVW; const int kk = hyb ? HYB_MIX : GVW;
        { pg8::Gemm g{MIX, Wt, T, D, kk}; pg8::StaticOrder S; S.init(T, D, gridDim.x, blockIdx.x); pg8::EpiBf16Perm E{GO, D};
          pg8::gemm_phase<pg8::EpiBf16Perm, pg8::StaticOrder>(c.lds, g, S, E, nullptr); }
        { Epi e{0, GO + (size_t)T * D, nullptr, D, D}; gemm_ksplit<2>(c, MIX + (size_t)T * kk, kk, NS, Wt, kk, D, kk, e); }
    } break;
    case 6: if (EN(10)) rowpass_phase(c, 1, c.in(I_NMPOST) + (size_t)l * D, c.in(I_NFPRE) + (size_t)l * D, l == 0); break;
    case 7: if (EN(11)) { const bf16_t* Wt = c.ws<bf16_t>(W_GU) + (size_t)l * 2 * FF * D;
        { pg8::Gemm g{H, Wt, T, 2 * FF, D}; pg8::StaticOrder S; S.init(T, 2 * FF, gridDim.x, blockIdx.x); pg8::EpiSwiglu E{HID, FF};
          pg8::gemm_phase<pg8::EpiSwiglu, pg8::StaticOrder>(c.lds, g, S, E, nullptr); }
        { Epi e{2, HID + (size_t)T * FF, nullptr, FF, 0}; gemm_ksplit<2>(c, H + (size_t)T * D, D, NS, Wt, D, 2 * FF, D, e); } } break;
    case 8: if (EN(12)) { const bf16_t* Wt = c.ws<bf16_t>(W_DN) + (size_t)l * D * FF;
        { pg8::Gemm g{HID, Wt, T, D, FF}; pg8::StaticOrder S; S.init(T, D, gridDim.x, blockIdx.x); pg8::EpiBf16Perm E{GO, D};
          pg8::gemm_phase<pg8::EpiBf16Perm, pg8::StaticOrder>(c.lds, g, S, E, nullptr); }
        { Epi e{0, GO + (size_t)T * D, nullptr, D, D}; gemm_ksplit<2>(c, HID + (size_t)T * FF, FF, NS, Wt, FF, D, FF, e); } } break;
    case 9: if (EN(13)) rowpass_phase(c, l == DEPTH - 1 ? 2 : 1, c.in(I_NFPOST) + (size_t)l * D, l == DEPTH - 1 ? nullptr : c.in(I_NMPRE) + (size_t)(l + 1) * D, false); break;
    default: break;
    }
}

extern __shared__ __attribute__((aligned(16))) unsigned char g_shm[];
__global__ void __launch_bounds__(NTHR, 2) mega(Params p) {
    cg::grid_group grid = cg::this_grid();
    volatile LAS unsigned* bst = (volatile LAS unsigned*)((LAS unsigned char*)g_shm + LDS_BYTES - 16);
    if (threadIdx.x == 0) { bst[0] = 0u; bst[1] = 0u; bst[2] = 0u; bst[3] = 0u; }
    __syncthreads();
    const XcdBarrier xb = xcd_barrier_post((unsigned*)p.ws, bst);
    for (int ph = p.ph_lo; ph < p.ph_hi; ++ph) {
        int tid_ = threadIdx.x; asm volatile("" : "+v"(tid_));
        Ctx c; c.p.kp = (KParams)__builtin_amdgcn_kernarg_segment_ptr(); c.p.out = c.p.kp->out; c.tid = tid_; c.lane = tid_ & 63; c.wave = __builtin_amdgcn_readfirstlane(tid_ >> 6);
        c.gw = blockIdx.x * NWAVE + c.wave; c.ngw = gridDim.x * NWAVE; c.lds = (LAS unsigned char*)g_shm;
        run_phase(c, ph);
#ifdef PROBE_MASK
        { int l_ = 0, sp_ = 0; if (ph > 0) phase_decode(ph, l_, sp_); const int bit = ph == 0 ? 20 : sp_ + 10 * (l_ & 1);
          if ((PROBE_MASK >> bit) & 1) { xcd_barrier(xb); run_phase(c, ph); } }
#endif
        if (ph + 1 < p.ph_hi) { if (ph == p.ph_lo) grid.sync(); else xcd_barrier(xb); }
    }
}

extern "C" void kernel_launch(void* const* d_in, const int* in_sizes, int n_in, void* d_out, int out_size, void* d_ws, size_t ws_size, hipStream_t stream) {
    static int grid = 0;
    if (!grid) {
        int dev = 0, cus = 0, per = 0; hipGetDevice(&dev); hipDeviceGetAttribute(&cus, hipDeviceAttributeMultiprocessorCount, dev);
        hipFuncSetAttribute((const void*)mega, hipFuncAttributeMaxDynamicSharedMemorySize, LDS_BYTES);
        hipOccupancyMaxActiveBlocksPerMultiprocessor(&per, (const void*)mega, NTHR, LDS_BYTES);
        if (n_in != 30 || (size_t)out_size != O_END || ws_size < W_END) fprintf(stderr, "kernel_launch: unexpected shapes n_in %d out %d (want %zu) ws %zu (want %zu)\n", n_in, out_size, (size_t)O_END, ws_size, (size_t)W_END);
        if (per < 1) fprintf(stderr, "kernel_launch: occupancy query says %d blocks per CU\n", per);
        grid = cus;
    }
    hipMemsetAsync(d_ws, 0, 16384, stream);
    Params p{}; for (int i = 0; i < 30; ++i) p.in[i] = (const float*)d_in[i];
    p.out = (float*)d_out; p.ws = (unsigned char*)d_ws; p.ph_lo = 0; p.ph_hi = N_PHASES;
    void* args[] = {&p};
    hipError_t e = hipLaunchCooperativeKernel((const void*)mega, dim3(grid), dim3(NTHR), args, LDS_BYTES, stream);
    if (e != hipSuccess) fprintf(stderr, "kernel_launch: cooperative launch failed: %s\n", hipGetErrorString(e));
}
```

```cpp
#include <hip/hip_runtime.h>
#include <hip/hip_cooperative_groups.h>
#include <cstdio>
#include <cstdint>
namespace cg = cooperative_groups;

#define DI __device__ __forceinline__
#define LAS __attribute__((address_space(3)))
typedef unsigned short bf16_t;
typedef short bf16x8 __attribute__((ext_vector_type(8)));
typedef float f32x4 __attribute__((ext_vector_type(4)));
typedef unsigned u32x2 __attribute__((ext_vector_type(2)));
typedef unsigned u32x4 __attribute__((ext_vector_type(4)));

constexpr int D = 1024, NB = 4, SEQ = 4096, T = NB * SEQ, NS = 32, TT = T + NS, DEPTH = 4;
constexpr int AH = 8, AHD = 64, AW = 512, WIN = 2048;
constexpr int SH = 16, SP = 64, SN = 128, SG = 2, SDI = 1024, SXBC = 1536;
constexpr int HYB_IN = 4112, HYB_MAIN = 4096, HYB_MIX = 1536;
constexpr int GH = 16, GQH = 8, GDK = 128, GDV = 128, GQKV = 4096, GVW = 2048, GDN_IN = 6176, GDN_MAIN = 6144;
constexpr int FF = 2816;
constexpr float EPS = 1e-6f;
constexpr int NTHR = 512, NWAVE = 8, LDS_BYTES = 163840;

enum { I_XP = 0, I_XS, I_CK, I_CV, I_SCONV, I_SSM, I_GCONV, I_GST, I_RELB, I_NMPRE, I_NMPOST, I_NFPRE, I_NFPOST, I_WHIN, I_SCW, I_SCB, I_SDTB, I_SALOG, I_SD, I_SNW,
       I_WHOUT, I_WGIN, I_GCW, I_GDTB, I_GALOG, I_GNW, I_WGOUT, I_WFG, I_WFU, I_WFD };

constexpr size_t O_YP = 0;
constexpr size_t O_YS = O_YP + (size_t)T * D;
constexpr size_t O_PK = O_YS + (size_t)NS * D;
constexpr size_t O_PV = O_PK + (size_t)2 * NB * WIN * AW;
constexpr size_t O_PSC = O_PV + (size_t)2 * NB * WIN * AW;
constexpr size_t O_PSS = O_PSC + (size_t)2 * NB * 3 * SXBC;
constexpr size_t O_PGC = O_PSS + (size_t)2 * NB * SH * SP * SN;
constexpr size_t O_PGS = O_PGC + (size_t)2 * NB * 3 * GQKV;
constexpr size_t O_SK = O_PGS + (size_t)2 * NB * GH * GDK * GDV;
constexpr size_t O_SV = O_SK + (size_t)2 * NS * WIN * AW;
constexpr size_t O_SSC = O_SV + (size_t)2 * NS * WIN * AW;
constexpr size_t O_SSS = O_SSC + (size_t)2 * NS * 3 * SXBC;
constexpr size_t O_SGC = O_SSS + (size_t)2 * NS * SH * SP * SN;
constexpr size_t O_SGS = O_SGC + (size_t)2 * NS * 3 * GQKV;
constexpr size_t O_END = O_SGS + (size_t)2 * NS * GH * GDK * GDV;

constexpr size_t al256(size_t x) { return (x + 255) & ~(size_t)255; }
constexpr size_t W_CTL = 0;
constexpr size_t W_HIN = 65536;
constexpr size_t W_HOUT = al256(W_HIN + (size_t)2 * HYB_IN * D * 2);
constexpr size_t W_GIN = al256(W_HOUT + (size_t)2 * D * HYB_MIX * 2);
constexpr size_t W_GOUT = al256(W_GIN + (size_t)2 * GDN_IN * D * 2);
constexpr size_t W_GU = al256(W_GOUT + (size_t)2 * D * GVW * 2);
constexpr size_t W_DN = al256(W_GU + (size_t)4 * 2 * FF * D * 2);
constexpr size_t W_X = al256(W_DN + (size_t)4 * D * FF * 2);
constexpr size_t W_H = al256(W_X + (size_t)TT * D * 4);
constexpr size_t W_PROJ = al256(W_H + (size_t)TT * D * 2);
constexpr size_t W_EXTRA = al256(W_PROJ + (size_t)TT * GDN_MAIN * 2);
constexpr size_t W_MIXED = al256(W_EXTRA + (size_t)TT * 32 * 4);
constexpr size_t W_GO = al256(W_MIXED + (size_t)TT * GVW * 2);
constexpr size_t W_HID = al256(W_GO + (size_t)TT * D * 4);
constexpr size_t W_ACT = al256(W_HID + (size_t)TT * FF * 2);
constexpr size_t W_AUX = al256(W_ACT + (size_t)TT * 4096 * 4);
constexpr size_t W_Y = al256(W_AUX + (size_t)TT * 32 * 4);
constexpr size_t W_END = al256(W_Y + (size_t)TT * 2048 * 4);

struct Params { const float* in[30]; float* out; unsigned char* ws; int ph_lo, ph_hi; };

DI float bf2f(bf16_t b) { return __uint_as_float(((unsigned)b) << 16); }
DI bf16_t f2bf(float x) { const __bf16 b = (__bf16)x; return __builtin_bit_cast(bf16_t, b); }
typedef float f32x2_ __attribute__((ext_vector_type(2))); typedef __bf16 bf16x2_ __attribute__((ext_vector_type(2)));
DI unsigned pk2(float lo, float hi) { const f32x2_ v = {lo, hi}; return __builtin_bit_cast(unsigned, __builtin_convertvector(v, bf16x2_)); }
DI float wave_sum(float v) {
#pragma unroll
    for (int o = 32; o >= 1; o >>= 1) v += __shfl_xor(v, o);
    return v;
}
DI float wave_max(float v) {
#pragma unroll
    for (int o = 32; o >= 1; o >>= 1) v = fmaxf(v, __shfl_xor(v, o));
    return v;
}
DI float siluf(float x) { return x * __builtin_amdgcn_rcpf(1.f + __expf(-x)); }
DI float sigmoidf_(float x) { return __builtin_amdgcn_rcpf(1.f + __expf(-x)); }
DI float softplusf_(float x) { return fmaxf(x, 0.f) + __logf(1.f + __expf(-fabsf(x))); }
#define LDS_WAIT() asm volatile("s_waitcnt lgkmcnt(0)" ::: "memory")
DI bf16x8 lds_frag(const LAS bf16_t* p) { return *(const LAS bf16x8*)p; }
DI bf16x8 lds_frag2(const LAS bf16_t* p0, const LAS bf16_t* p1) {
    const u32x2 a = *(const LAS u32x2*)p0, b = *(const LAS u32x2*)p1; u32x4 r; r.x = a.x; r.y = a.y; r.z = b.x; r.w = b.y; return __builtin_bit_cast(bf16x8, r);
}
DI bf16x8 pack8(const f32x4 a, const f32x4 b) { u32x4 r; r.x = pk2(a.x, a.y); r.y = pk2(a.z, a.w); r.z = pk2(b.x, b.y); r.w = pk2(b.z, b.w); return __builtin_bit_cast(bf16x8, r); }
DI bf16x8 gfrag_f32(const float* p) { return pack8(*(const f32x4*)p, *(const f32x4*)(p + 4)); }

__device__ const unsigned char c_bucket[3][129] = {
 {0,1,2,3,4,5,6,7,8,9,10,11,12,13,14,15,16,16,16,16,16,16,17,17,17,17,17,17,17,17,18,18,18,18,18,18,18,18,18,18,19,19,19,19,19,19,19,19,19,19,19,19,19,19,20,20,20,20,20,20,20,20,20,20,20,20,20,20,20,20,20,20,20,21,21,21,21,21,21,21,21,21,21,21,21,21,21,21,21,21,21,21,21,21,21,21,21,21,21,22,22,22,22,22,22,22,22,22,22,22,22,22,22,22,22,22,22,22,22,22,22,22,22,22,22,22,22,22,22},
 {0,4,8,12,16,16,17,17,18,18,19,19,19,19,20,20,20,20,20,21,21,21,21,21,21,22,22,22,22,22,22,22,22,22,23,23,23,23,23,23,23,23,23,23,23,23,24,24,24,24,24,24,24,24,24,24,24,24,24,24,24,24,25,25,25,25,25,25,25,25,25,25,25,25,25,25,25,25,25,25,25,25,25,26,26,26,26,26,26,26,26,26,26,26,26,26,26,26,26,26,26,26,26,26,26,26,26,26,26,26,26,26,26,27,27,27,27,27,27,27,27,27,27,27,27,27,27,27,27},
 {0,16,18,19,20,21,21,22,22,23,23,23,24,24,24,24,25,25,25,25,25,26,26,26,26,26,26,26,26,27,27,27,27,27,27,27,27,27,27,28,28,28,28,28,28,28,28,28,28,28,28,28,29,29,29,29,29,29,29,29,29,29,29,29,29,29,29,29,29,29,30,30,30,30,30,30,30,30,30,30,30,30,30,30,30,30,30,30,30,30,30,30,30,30,30,31,31,31,31,31,31,31,31,31,31,31,31,31,31,31,31,31,31,31,31,31,31,31,31,31,31,31,31,31,31,31,31,31,31}};

typedef const Params __attribute__((address_space(4)))* KParams;
struct OutRef { float* out; DI float* operator+(size_t o) const { return out + o; } };
struct PRef { KParams kp; float* out; };
#define XB_TMO      128
#define XB_XCNT(j)  (256  + 64 * (j))
#define XB_XSUB(j)  (1280 + 64 * (j))
#define XB_XGEN(j)  (2304 + 64 * (j))
#define XB_TOP      3328
#define XB_TOPGEN   3392
#define XCD_BAR_WORDS 3456
#define XB_SPIN_CAP (1u << 22)

__device__ __forceinline__ unsigned xb_ld(unsigned* p)              { return __hip_atomic_load(p, __ATOMIC_RELAXED, __HIP_MEMORY_SCOPE_AGENT); }
__device__ __forceinline__ unsigned xb_add(unsigned* p, unsigned v) { return __hip_atomic_fetch_add(p, v, __ATOMIC_RELAXED, __HIP_MEMORY_SCOPE_AGENT); }
__device__ __forceinline__ unsigned xb_xcc_id() { return (unsigned)__builtin_amdgcn_s_getreg((3 << 11) | 20) & 0xFu; }
#define XB_SPIN(cond, bar) do { unsigned _sp = 0; while (cond) { __builtin_amdgcn_s_sleep(1); \
    if ((++_sp & 255u) == 0u) { if (xb_ld(&(bar)[XB_TMO])) break; if (_sp > XB_SPIN_CAP) { atomicAdd(&(bar)[XB_TMO], 1u); break; } } } } while (0)

struct XcdBarrier {
    unsigned* bar; unsigned x;
    volatile LAS unsigned* st;
};

__device__ __forceinline__ XcdBarrier xcd_barrier_post(unsigned* bar, volatile LAS unsigned* st) {
    XcdBarrier b; b.bar = bar; b.x = xb_xcc_id(); b.st = st;
    if (threadIdx.x == 0) (void)xb_add(&bar[XB_XCNT(b.x)], 1u);
    return b;
}
__device__ __forceinline__ void xcd_barrier_complete(unsigned* bar, unsigned x, unsigned& nloc, unsigned& nx) {
    const unsigned G = gridDim.x * gridDim.y * gridDim.z;
    unsigned sum, cnt, mine, sp = 0u;
    for (;;) {
        sum = 0u; cnt = 0u; mine = 0u;
#pragma unroll
        for (unsigned j = 0; j < 16; ++j) { const unsigned c = xb_ld(&bar[XB_XCNT(j)]); sum += c; cnt += (c > 0u) ? 1u : 0u; mine = (j == x) ? c : mine; }
        if (sum == G) break;
        __builtin_amdgcn_s_sleep(1);
        if ((++sp & 255u) == 0u) { if (xb_ld(&bar[XB_TMO])) break; if (sp > XB_SPIN_CAP) { atomicAdd(&bar[XB_TMO], 1u); break; } }
    }
    nloc = mine > 0u ? mine : 1u; nx = cnt > 0u ? cnt : 1u;
}

__device__ __forceinline__ void xcd_barrier(const XcdBarrier& b) {
    asm volatile("s_waitcnt vmcnt(0)" ::: "memory");
    __syncthreads();
    if (threadIdx.x == 0) {
        unsigned* bar = b.bar;
        __builtin_amdgcn_s_waitcnt(0);
        unsigned nloc = b.st[0], nx = b.st[1];
        if (nloc == 0u) { xcd_barrier_complete(bar, b.x, nloc, nx); b.st[0] = nloc; b.st[1] = nx; }
        const unsigned old = xb_add(&bar[XB_XSUB(b.x)], 1u);
        const unsigned gen = old / nloc;
        if (old + 1u == (gen + 1u) * nloc) {
            __builtin_amdgcn_fence(__ATOMIC_RELEASE, "agent");
            asm volatile("s_waitcnt vmcnt(0)" ::: "memory");
            const unsigned og = xb_add(&bar[XB_TOP], 1u);
            const unsigned tg = og / nx;
            if (og + 1u == (tg + 1u) * nx) xb_add(&bar[XB_TOPGEN], 1u);
            else XB_SPIN(xb_ld(&bar[XB_TOPGEN]) == tg, bar);
            __builtin_amdgcn_fence(__ATOMIC_ACQUIRE, "agent");
            xb_add(&bar[XB_XGEN(b.x)], 1u);
            asm volatile("s_waitcnt vmcnt(0)" ::: "memory");
        } else {
            XB_SPIN(xb_ld(&bar[XB_XGEN(b.x)]) == gen, bar);
            __builtin_amdgcn_fence(__ATOMIC_ACQUIRE, "agent");
            asm volatile("s_waitcnt vmcnt(0)" ::: "memory");
        }
    }
    __syncthreads();
}

struct Ctx {
    PRef p; int tid, lane, wave, gw, ngw; LAS unsigned char* lds;
    DI const float* in(int i) const { return p.kp->in[i]; }
    template <class Tp> DI Tp* ws(size_t off) const { return (Tp*)(p.kp->ws + off); }
};

DI int rowmap(int n, int map) { return map == 0 ? n : (32 * (n >> 4) + (n & 15) + (map == 2 ? 16 : 0)); }
DI void transpose_item(const float* W, int K, int N, bf16_t* WT, int map, LAS float* scr, int item, int lane) {
    const int nblk = (N + 31) / 32, kb = item / nblk, nb = item % nblk, k0 = 64 * kb, n0 = 32 * nb;
    float wv[32];
#pragma unroll
    for (int i = 0; i < 32; ++i) { const int kk = 2 * i + (lane >> 5), n = n0 + (lane & 31); wv[i] = n < N ? W[(size_t)(k0 + kk) * N + n] : 0.f; }
#pragma unroll
    for (int i = 0; i < 32; ++i) scr[(2 * i + (lane >> 5)) * 33 + (lane & 31)] = wv[i];
    LDS_WAIT();
    const int c = lane & 7;
#pragma unroll
    for (int j = 0; j < 4; ++j) {
        const int nn = (lane >> 3) + 8 * j, n = n0 + nn; const LAS float* s = scr + (8 * c) * 33 + nn;
        u32x4 o; o.x = pk2(s[0], s[33]); o.y = pk2(s[66], s[99]); o.z = pk2(s[132], s[165]); o.w = pk2(s[198], s[231]);
        if (n < N) *(u32x4*)(WT + (size_t)rowmap(n, map) * K + k0 + 8 * c) = o;
    }
    LDS_WAIT();
}
DI void transpose_mat(const Ctx& c, const float* W, int K, int N, bf16_t* WT, int map, int gw0 = -1, int ngw0 = 0) {
    LAS float* scr = (LAS float*)(c.lds + c.wave * 8704);
    const int nit = (K / 64) * ((N + 31) / 32);
    const int g0 = gw0 < 0 ? c.gw : gw0, n0 = gw0 < 0 ? c.ngw : ngw0;
    for (int it = g0; it < nit; it += n0) transpose_item(W, K, N, WT, map, scr, it, c.lane);
}

DI void rowpass_row(const float* xrow, const bf16_t* gorow, const float* gpost, const float* gnext, float* xdst, bf16_t* hrow, float* yout, int lane) {
    f32x4 x[4]; float ss = 0.f;
    if (gorow) {
        f32x4 g[4];
#pragma unroll
        for (int j = 0; j < 4; ++j) { const u32x2 gv = *(const u32x2*)(gorow + 4 * lane + 256 * j); g[j] = (f32x4){bf2f((bf16_t)(gv.x & 0xffff)), bf2f((bf16_t)(gv.x >> 16)), bf2f((bf16_t)(gv.y & 0xffff)), bf2f((bf16_t)(gv.y >> 16))}; ss += g[j].x * g[j].x + g[j].y * g[j].y + g[j].z * g[j].z + g[j].w * g[j].w; }
        const float r = rsqrtf(wave_sum(ss) * (1.f / D) + EPS);
#pragma unroll
        for (int j = 0; j < 4; ++j) { const f32x4 w = *(const f32x4*)(gpost + 4 * lane + 256 * j); x[j] = *(const f32x4*)(xrow + 4 * lane + 256 * j) + g[j] * r * w; }
    } else {
#pragma unroll
        for (int j = 0; j < 4; ++j) x[j] = *(const f32x4*)(xrow + 4 * lane + 256 * j);
    }
    if (xdst) {
#pragma unroll
        for (int j = 0; j < 4; ++j) *(f32x4*)(xdst + 4 * lane + 256 * j) = x[j];
    }
    if (yout) {
#pragma unroll
        for (int j = 0; j < 4; ++j) *(f32x4*)(yout + 4 * lane + 256 * j) = x[j];
    }
    if (hrow) {
        float s2 = 0.f;
#pragma unroll
        for (int j = 0; j < 4; ++j) s2 += x[j].x * x[j].x + x[j].y * x[j].y + x[j].z * x[j].z + x[j].w * x[j].w;
        const float r2 = rsqrtf(wave_sum(s2) * (1.f / D) + EPS);
#pragma unroll
        for (int j = 0; j < 4; ++j) { const f32x4 w = *(const f32x4*)(gnext + 4 * lane + 256 * j); const f32x4 h = x[j] * r2 * w;
            u32x2 o; o.x = pk2(h.x, h.y); o.y = pk2(h.z, h.w); *(u32x2*)(hrow + 4 * lane + 256 * j) = o; }
    }
}
DI void rowpass_rows4(const float* xrow, const bf16_t* gorow, const float* gpost, const float* gnext, float* xdst, bf16_t* hrow, float* yout, int lane) {
    f32x4 x[4][4]; float ss[4] = {0.f, 0.f, 0.f, 0.f};
#pragma unroll
    for (int r = 0; r < 4; ++r)
#pragma unroll
        for (int j = 0; j < 4; ++j) x[r][j] = *(const f32x4*)(xrow + (size_t)r * D + 4 * lane + 256 * j);
    if (gorow) {
        u32x2 gv[4][4];
#pragma unroll
        for (int r = 0; r < 4; ++r)
#pragma unroll
            for (int j = 0; j < 4; ++j) gv[r][j] = *(const u32x2*)(gorow + (size_t)r * D + 4 * lane + 256 * j);
        f32x4 wp[4];
#pragma unroll
        for (int j = 0; j < 4; ++j) wp[j] = *(const f32x4*)(gpost + 4 * lane + 256 * j);
#pragma unroll
        for (int r = 0; r < 4; ++r)
#pragma unroll
            for (int j = 0; j < 4; ++j) { const float a = bf2f((bf16_t)(gv[r][j].x & 0xffff)), b2 = bf2f((bf16_t)(gv[r][j].x >> 16)), c2 = bf2f((bf16_t)(gv[r][j].y & 0xffff)), d2 = bf2f((bf16_t)(gv[r][j].y >> 16)); ss[r] += a * a + b2 * b2 + c2 * c2 + d2 * d2; }
#pragma unroll
        for (int o = 32; o >= 1; o >>= 1) { ss[0] += __shfl_xor(ss[0], o); ss[1] += __shfl_xor(ss[1], o); ss[2] += __shfl_xor(ss[2], o); ss[3] += __shfl_xor(ss[3], o); }
#pragma unroll
        for (int r = 0; r < 4; ++r) { const float rn = rsqrtf(ss[r] * (1.f / D) + EPS);
#pragma unroll
            for (int j = 0; j < 4; ++j) { const f32x4 g = (f32x4){bf2f((bf16_t)(gv[r][j].x & 0xffff)), bf2f((bf16_t)(gv[r][j].x >> 16)), bf2f((bf16_t)(gv[r][j].y & 0xffff)), bf2f((bf16_t)(gv[r][j].y >> 16))}; x[r][j] += g * rn * wp[j]; } }
    }
    if (xdst) {
#pragma unroll
        for (int r = 0; r < 4; ++r)
#pragma unroll
            for (int j = 0; j < 4; ++j) *(f32x4*)(xdst + (size_t)r * D + 4 * lane + 256 * j) = x[r][j];
    }
    if (yout) {
#pragma unroll
        for (int r = 0; r < 4; ++r)
#pragma unroll
            for (int j = 0; j < 4; ++j) *(f32x4*)(yout + (size_t)r * D + 4 * lane + 256 * j) = x[r][j];
    }
    if (hrow) {
        float s2[4];
#pragma unroll
        for (int r = 0; r < 4; ++r) { s2[r] = 0.f;
#pragma unroll
            for (int j = 0; j < 4; ++j) s2[r] += x[r][j].x * x[r][j].x + x[r][j].y * x[r][j].y + x[r][j].z * x[r][j].z + x[r][j].w * x[r][j].w; }
#pragma unroll
        for (int o = 32; o >= 1; o >>= 1) { s2[0] += __shfl_xor(s2[0], o); s2[1] += __shfl_xor(s2[1], o); s2[2] += __shfl_xor(s2[2], o); s2[3] += __shfl_xor(s2[3], o); }
        f32x4 wn[4];
#pragma unroll
        for (int j = 0; j < 4; ++j) wn[j] = *(const f32x4*)(gnext + 4 * lane + 256 * j);
#pragma unroll
        for (int r = 0; r < 4; ++r) { const float r2 = rsqrtf(s2[r] * (1.f / D) + EPS);
#pragma unroll
            for (int j = 0; j < 4; ++j) { const f32x4 h = x[r][j] * r2 * wn[j]; u32x2 o; o.x = pk2(h.x, h.y); o.y = pk2(h.z, h.w); *(u32x2*)(hrow + (size_t)r * D + 4 * lane + 256 * j) = o; } }
    }
}
DI void rowpass_phase(const Ctx& c, int mode, const float* gpost, const float* gnext, bool x_from_input) {
    float* X = c.ws<float>(W_X); const bf16_t* GO = c.ws<bf16_t>(W_GO); bf16_t* H = c.ws<bf16_t>(W_H);
    int lane_ = c.lane; asm volatile("" : "+v"(lane_));
    for (int row = T + c.gw; row < TT; row += c.ngw) {
        const float* xrow = x_from_input ? c.in(I_XS) + (size_t)(row - T) * D : X + (size_t)row * D;
        if (mode == 0) rowpass_row(xrow, nullptr, nullptr, gnext, nullptr, H + (size_t)row * D, nullptr, lane_);
        else if (mode == 1) rowpass_row(xrow, GO + (size_t)row * D, gpost, gnext, X + (size_t)row * D, H + (size_t)row * D, nullptr, lane_);
        else rowpass_row(xrow, GO + (size_t)row * D, gpost, nullptr, nullptr, nullptr, c.p.out + O_YS + (size_t)(row - T) * D, lane_);
    }
    for (int g4 = c.gw; g4 < T / 4; g4 += c.ngw) {
        const int row = 4 * g4;
        const float* xrow = x_from_input ? c.in(I_XP) + (size_t)row * D : X + (size_t)row * D;
        if (mode == 0) rowpass_rows4(xrow, nullptr, nullptr, gnext, nullptr, H + (size_t)row * D, nullptr, lane_);
        else if (mode == 1) rowpass_rows4(xrow, GO + (size_t)row * D, gpost, gnext, X + (size_t)row * D, H + (size_t)row * D, nullptr, lane_);
        else rowpass_rows4(xrow, GO + (size_t)row * D, gpost, nullptr, nullptr, nullptr, c.p.out + O_YP + (size_t)row * D, lane_);
    }
}

namespace pg8 {
#define PG8_LAS __attribute__((address_space(3)))
typedef unsigned short bf16_t;
typedef short bf16x8 __attribute__((ext_vector_type(8)));
typedef float f32x4 __attribute__((ext_vector_type(4)));
typedef unsigned u32x4 __attribute__((ext_vector_type(4)));
constexpr int BM = 256, BK = 64, HALF = 128, HTB = HALF * BK * 2  , STAGE_BYTES = 8 * HTB, NXCD = 8, WGM = 8;

__host__ __device__ __forceinline__ int lds_byte(int r, int c) { const int st = (r >> 4) * 2 + (c >> 5), rr = r & 15, cc = c & 31, ob = rr * 64 + cc * 2; return st * 1024 + (ob ^ (((ob >> 9) & 1) << 5)); }
__host__ __device__ __forceinline__ void stage_rc(int b, int& R, int& C) { const int st = b / 1024, sb = b % 1024, swz = sb ^ (((sb >> 9) & 1) << 5); R = (st >> 1) * 16 + swz / 64; C = (st & 1) * 32 + (swz % 64) / 2; }
__host__ __device__ __forceinline__ int perm32(int rho) { const int n = rho >> 4, i = rho & 15; return 8 * (i >> 2) + 4 * n + (i & 3); }

struct Unit { int pm, pn; };
struct Gemm { const bf16_t* A; const bf16_t* Bt; int M, N, K; };

struct StaticOrder {
    int nM, nN, nwg, G, c;
    __host__ __device__ void init(int M, int N, int G_, int c_) { nM = M / BM; nN = N / BM; nwg = nM * nN; G = G_; c = c_; }
    __host__ __device__ bool next(int i, Unit& u) const {
        const long L = (long)i * G + c; if (L >= nwg) return false;
        int wgid = (int)L; { const int q = nwg / NXCD, r = nwg % NXCD, xcd = wgid % NXCD, off = wgid / NXCD; wgid = (xcd < r ? xcd * (q + 1) : r * (q + 1) + (xcd - r) * q) + off; }
        const int nig = WGM * nN, gid = wgid / nig, fm = gid * WGM, gsz = (nM - fm) < WGM ? (nM - fm) : WGM;
        u.pm = fm + ((wgid % nig) % gsz); u.pn = (wgid % nig) / gsz; return true;
    }
    __device__ __forceinline__ void a_ready(const Unit&) const {}
    __device__ __forceinline__ void done(const Unit&) const {}
};
__device__ __forceinline__ unsigned cvt_pk_bf16(float lo, float hi) { unsigned r; asm volatile("v_cvt_pk_bf16_f32 %0, %1, %2" : "=v"(r) : "v"(lo), "v"(hi)); return r; }
typedef float f32x2 __attribute__((ext_vector_type(2)));
struct EpiF32 {
    static constexpr bool PERM = false, AFTER_DRAIN = false;
    float* C; int ldc; const float* bias;
    __device__ __forceinline__ void operator()(const f32x4 (&acc)[2][2][4][2], const Unit& u, int wr, int wc, int fr, int fq) const {
        const int row0 = u.pm * BM + wr * 64 + fr, col0 = u.pn * BM + wc * 32 + 4 * fq;
        f32x4 bv[2][2];
#pragma unroll
        for (int bj = 0; bj < 2; ++bj)
#pragma unroll
            for (int n = 0; n < 2; ++n) bv[bj][n] = bias ? *(const f32x4*)(bias + col0 + bj * HALF + n * 16) : (f32x4){0.f, 0.f, 0.f, 0.f};
#pragma unroll
        for (int ai = 0; ai < 2; ++ai)
#pragma unroll
            for (int m = 0; m < 4; ++m) { float* rowp = C + (size_t)(row0 + ai * HALF + m * 16) * ldc + col0;
#pragma unroll
                for (int bj = 0; bj < 2; ++bj)
#pragma unroll
                    for (int n = 0; n < 2; ++n) *(f32x4*)(rowp + bj * HALF + n * 16) = acc[ai][bj][m][n] + bv[bj][n]; }
    }
};
template <class Epi, class Sched, bool STAMP = false>
__device__ __forceinline__ void gemm_phase(PG8_LAS unsigned char* lds, const Gemm g, const Sched& S, const Epi& E, unsigned long long* stamps) {
    int tid_ = threadIdx.x; asm volatile("" : "+v"(tid_));
    const int tid = tid_, wid = __builtin_amdgcn_readfirstlane(tid >> 6), lane = tid & 63, wr = wid >> 2, wc = wid & 3, fr = lane & 15, fq = lane >> 4;
    const int K = g.K, nt = K / BK;
    int ts_lo = 0, ts_hi = 0, nts = 0; const unsigned long long rt_entry = STAMP ? (unsigned long long)wall_clock64() : 0ull;
#define PG8_STAMP() do { if (STAMP && wid == 0 && nts < 64) { const unsigned long long _c = (unsigned long long)clock64(); \
        ts_lo = (lane == nts) ? (int)(unsigned)_c : ts_lo; ts_hi = (lane == nts) ? (int)(unsigned)(_c >> 32) : ts_hi; ++nts; } } while (0)
    PG8_STAMP();
    unsigned voffA[2], voffB[2];
#pragma unroll
    for (int i = 0; i < 2; ++i) { int R, C; stage_rc(tid * 16 + i * 8192, R, C); const int Rb = Epi::PERM ? ((R & ~31) + perm32(R & 31)) : R;
        voffA[i] = (unsigned)(R * K + C) * 2u; voffB[i] = (unsigned)(Rb * K + C) * 2u; }
    const size_t kstep = (size_t)(BK * 2);
    const size_t hstep = (size_t)HALF * K * 2;
    const size_t tstep = 2 * hstep;
    const unsigned ldsw = (unsigned)wid * 1024u;
    const int aoff = lds_byte(wr * 64 + fr, fq * 8), boff = lds_byte(wc * 32 + fr, fq * 8);
#define PG8_SA(b, h) (((b) * 2 + (h)) * HTB)
#define PG8_SB(b, h) ((4 + (b) * 2 + (h)) * HTB)
#define PG8_STAGE(bufoff, gbase, voff) do { _Pragma("unroll") for (int _i = 0; _i < 2; ++_i) \
        __builtin_amdgcn_global_load_lds((const unsigned*)((const char*)(gbase) + (voff)[_i]), (PG8_LAS unsigned*)(lds + (bufoff) + ldsw + _i * 8192), 16, 0, 0); } while (0)
#define PG8_LDA(dst, b, h) do { _Pragma("unroll") for (int m = 0; m < 4; ++m) _Pragma("unroll") for (int k = 0; k < 2; ++k) dst[m][k] = *(const PG8_LAS bf16x8*)(lds + PG8_SA(b, h) + aoff + m * 2048 + k * 1024); } while (0)
#define PG8_LDB(dst, b, h) do { _Pragma("unroll") for (int n = 0; n < 2; ++n) _Pragma("unroll") for (int k = 0; k < 2; ++k) dst[n][k] = *(const PG8_LAS bf16x8*)(lds + PG8_SB(b, h) + boff + n * 2048 + k * 1024); } while (0)
#define PG8_MMA(ai, bj, At, Bt) do { __builtin_amdgcn_s_setprio(1); _Pragma("unroll") for (int m = 0; m < 4; ++m) _Pragma("unroll") for (int n = 0; n < 2; ++n) _Pragma("unroll") for (int k = 0; k < 2; ++k) \
        acc[ai][bj][m][n] = __builtin_amdgcn_mfma_f32_16x16x32_bf16(Bt[n][k], At[m][k], acc[ai][bj][m][n], 0, 0, 0); __builtin_amdgcn_s_setprio(0); } while (0)
#define PG8_WAIT_V(n) asm volatile("s_waitcnt vmcnt(" #n ")" ::: "memory")
#define PG8_WAIT_L(n) asm volatile("s_waitcnt lgkmcnt(" #n ")" ::: "memory")
#define PG8_BAR __builtin_amdgcn_s_barrier()
#define PG8_SCHED __builtin_amdgcn_sched_barrier(0)
    Unit cur, nxt; int ui = 0;
    if (!S.next(0, cur)) return;
    f32x4 acc[2][2][4][2];
#pragma unroll
    for (int a = 0; a < 2; ++a)
#pragma unroll
        for (int b = 0; b < 2; ++b)
#pragma unroll
            for (int m = 0; m < 4; ++m)
#pragma unroll
                for (int n = 0; n < 2; ++n) acc[a][b][m][n] = (f32x4){0.f, 0.f, 0.f, 0.f};
    bf16x8 At[4][2], B0[2][2], B1[2][2];
    const char* cA = (const char*)g.A + (size_t)cur.pm * tstep; const char* cB = (const char*)g.Bt + (size_t)cur.pn * tstep;
    S.a_ready(cur);
    PG8_STAGE(PG8_SB(0, 0), cB, voffB); PG8_STAGE(PG8_SA(0, 0), cA, voffA); PG8_STAGE(PG8_SB(0, 1), cB + hstep, voffB); PG8_STAGE(PG8_SA(0, 1), cA + hstep, voffA);
    if (wr == 1) PG8_BAR;
    PG8_WAIT_V(4); PG8_BAR;
    PG8_STAGE(PG8_SB(1, 0), cB + kstep, voffB); PG8_STAGE(PG8_SA(1, 0), cA + kstep, voffA); PG8_STAGE(PG8_SB(1, 1), cB + hstep + kstep, voffB);
    PG8_WAIT_V(6); PG8_BAR;
    PG8_STAMP();
    for (;;) {
        const bool has_next = S.next(ui + 1, nxt);
        const char* nA = has_next ? (const char*)g.A + (size_t)nxt.pm * tstep : cA; const char* nB = has_next ? (const char*)g.Bt + (size_t)nxt.pn * tstep : cB;
        for (int t = 0; t < nt; t += 2) {
            const bool last = (t == nt - 2);
            const char* a1 = cA + (size_t)(t + 1) * kstep;
            const char* a2 = last ? nA : cA + (size_t)(t + 2) * kstep; const char* b2 = last ? nB : cB + (size_t)(t + 2) * kstep;
            const char* a3 = a2 + kstep; const char* b3 = b2 + kstep;
            if (last && has_next) S.a_ready(nxt);
            PG8_LDB(B0, 0, 0); PG8_SCHED; PG8_LDA(At, 0, 0); PG8_STAGE(PG8_SA(1, 1), a1 + hstep, voffA);
            PG8_WAIT_L(8); PG8_BAR; PG8_WAIT_L(0); PG8_MMA(0, 0, At, B0); PG8_BAR; PG8_SCHED;
            PG8_LDB(B1, 0, 1); PG8_STAGE(PG8_SB(0, 0), b2, voffB);
            PG8_BAR; PG8_WAIT_L(0); PG8_MMA(0, 1, At, B1); PG8_BAR;
            PG8_LDA(At, 0, 1); PG8_STAGE(PG8_SA(0, 0), a2, voffA);
            PG8_BAR; PG8_WAIT_L(0); PG8_MMA(1, 0, At, B0); PG8_BAR; PG8_SCHED;
            PG8_STAGE(PG8_SB(0, 1), b2 + hstep, voffB);
            PG8_WAIT_V(6); PG8_BAR; PG8_MMA(1, 1, At, B1); PG8_BAR;
            PG8_LDB(B0, 1, 0); PG8_SCHED; PG8_LDA(At, 1, 0); PG8_STAGE(PG8_SA(0, 1), a2 + hstep, voffA);
            PG8_WAIT_L(8); PG8_BAR; PG8_WAIT_L(0); PG8_MMA(0, 0, At, B0); PG8_BAR; PG8_SCHED;
            PG8_LDB(B1, 1, 1); PG8_STAGE(PG8_SB(1, 0), b3, voffB);
            PG8_BAR; PG8_WAIT_L(0); PG8_MMA(0, 1, At, B1); PG8_BAR;
            PG8_LDA(At, 1, 1); PG8_STAGE(PG8_SA(1, 0), a3, voffA);
            PG8_BAR; PG8_WAIT_L(0); PG8_MMA(1, 0, At, B0); PG8_BAR; PG8_SCHED;
            PG8_STAGE(PG8_SB(1, 1), b3 + hstep, voffB);
            PG8_WAIT_V(6); PG8_BAR; PG8_MMA(1, 1, At, B1); PG8_BAR;
        }
        PG8_STAMP();
        if constexpr (!Epi::AFTER_DRAIN) { E(acc, cur, wr, wc, fr, fq); S.done(cur); }
        PG8_STAMP();
        if (!has_next) break;
#pragma unroll
        for (int a = 0; a < 2; ++a)
#pragma unroll
            for (int b = 0; b < 2; ++b)
#pragma unroll
                for (int m = 0; m < 4; ++m)
#pragma unroll
                    for (int n = 0; n < 2; ++n) acc[a][b][m][n] = (f32x4){0.f, 0.f, 0.f, 0.f};
        cur = nxt; cA = nA; cB = nB; ++ui;
    }
    PG8_WAIT_V(0);
    if (wr == 0) PG8_BAR;
    PG8_BAR;
    if constexpr (Epi::AFTER_DRAIN) { E.fused(acc, cur, wr, wc, fr, fq, lds, wid, lane); S.done(cur); }
    PG8_STAMP();
    if (STAMP && wid == 0) { stamps[lane] = lane < nts ? (((unsigned long long)(unsigned)ts_hi << 32) | (unsigned)ts_lo) : 0ull;
        if (lane == 62) stamps[62] = rt_entry; if (lane == 63) stamps[63] = (unsigned long long)wall_clock64(); }
#undef PG8_STAMP
#undef PG8_SA
#undef PG8_SB
#undef PG8_STAGE
#undef PG8_LDA
#undef PG8_LDB
#undef PG8_MMA
#undef PG8_WAIT_V
#undef PG8_WAIT_L
#undef PG8_BAR
#undef PG8_SCHED
}
}

namespace pg8 {
struct EpiBf16Plain {
    static constexpr bool PERM = false, AFTER_DRAIN = false;
    bf16_t* O; int ldc;
    __device__ __forceinline__ void operator()(const f32x4 (&acc)[2][2][4][2], const Unit& u, int wr, int wc, int fr, int fq) const {
        const int row0 = u.pm * BM + wr * 64 + fr, col0 = u.pn * BM + wc * 32 + 4 * fq;
#pragma unroll
        for (int ai = 0; ai < 2; ++ai)
#pragma unroll
            for (int m = 0; m < 4; ++m) { bf16_t* rowp = O + (size_t)(row0 + ai * HALF + m * 16) * ldc + col0;
#pragma unroll
                for (int bj = 0; bj < 2; ++bj)
#pragma unroll
                    for (int n = 0; n < 2; ++n) { const f32x4 v = acc[ai][bj][m][n]; unsigned long long w = (unsigned long long)cvt_pk_bf16(v[0], v[1]) | ((unsigned long long)cvt_pk_bf16(v[2], v[3]) << 32);
                        *(unsigned long long*)(rowp + bj * HALF + n * 16) = w; } }
    }
};
struct EpiBf16Perm {
    static constexpr bool PERM = true, AFTER_DRAIN = false;
    bf16_t* O; int ldc;
    __device__ __forceinline__ void operator()(const f32x4 (&acc)[2][2][4][2], const Unit& u, int wr, int wc, int fr, int fq) const {
        const int row0 = u.pm * BM + wr * 64 + fr, col0 = u.pn * BM + wc * 32 + 8 * fq;
#pragma unroll
        for (int ai = 0; ai < 2; ++ai)
#pragma unroll
            for (int m = 0; m < 4; ++m) { bf16_t* rowp = O + (size_t)(row0 + ai * HALF + m * 16) * ldc + col0;
#pragma unroll
                for (int bj = 0; bj < 2; ++bj) { const f32x4 v0 = acc[ai][bj][m][0], v1 = acc[ai][bj][m][1]; u32x4 w;
                    w.x = cvt_pk_bf16(v0[0], v0[1]); w.y = cvt_pk_bf16(v0[2], v0[3]); w.z = cvt_pk_bf16(v1[0], v1[1]); w.w = cvt_pk_bf16(v1[2], v1[3]);
                    *(u32x4*)(rowp + bj * HALF) = w; } }
    }
};
struct EpiSwiglu {
    static constexpr bool PERM = false, AFTER_DRAIN = false;
    bf16_t* O; int ldc;
    __device__ __forceinline__ void operator()(const f32x4 (&acc)[2][2][4][2], const Unit& u, int wr, int wc, int fr, int fq) const {
        const int row0 = u.pm * BM + wr * 64 + fr, col0 = u.pn * (BM / 2) + wc * 16 + 4 * fq;
#pragma unroll
        for (int ai = 0; ai < 2; ++ai)
#pragma unroll
            for (int m = 0; m < 4; ++m) { bf16_t* rowp = O + (size_t)(row0 + ai * HALF + m * 16) * ldc + col0;
#pragma unroll
                for (int bj = 0; bj < 2; ++bj) { const f32x4 g = acc[ai][bj][m][0], up = acc[ai][bj][m][1]; float h[4];
#pragma unroll
                    for (int e = 0; e < 4; ++e) h[e] = g[e] * __builtin_amdgcn_rcpf(1.f + __expf(-g[e])) * up[e];
                    unsigned long long w = (unsigned long long)cvt_pk_bf16(h[0], h[1]) | ((unsigned long long)cvt_pk_bf16(h[2], h[3]) << 32);
                    *(unsigned long long*)(rowp + bj * (HALF / 2)) = w; } }
    }
};
}

struct Epi { int mode; bf16_t* ob; float* of; int ldo; int main_cols; };
DI void gemm_simple(const Ctx& c, const bf16_t* A, int lda, int M, const bf16_t* Bt, int ldb, int N, int K, const Epi e) {
    const int mblk = (M + 63) / 64, nblk = (N + 31) / 32, nit = mblk * nblk;
    const int fr = c.lane & 15, fq = c.lane >> 4;
    for (int it = c.gw; it < nit; it += c.ngw) {
        const int mb = it / nblk, nb = it % nblk, m0 = mb * 64, n0 = nb * 32;
        const bf16_t* ap[4]; const bf16_t* bp[2];
#pragma unroll
        for (int m = 0; m < 4; ++m) { int r = m0 + 16 * m + fr; r = r < M ? r : M - 1; ap[m] = A + (size_t)r * lda + 8 * fq; }
#pragma unroll
        for (int n = 0; n < 2; ++n) { int r = n0 + 16 * n + fr; r = r < N ? r : N - 1; bp[n] = Bt + (size_t)r * ldb + 8 * fq; }
        f32x4 acc[4][2];
#pragma unroll
        for (int m = 0; m < 4; ++m)
#pragma unroll
            for (int n = 0; n < 2; ++n) acc[m][n] = (f32x4){0.f, 0.f, 0.f, 0.f};
#pragma unroll 2
        for (int k0 = 0; k0 < K; k0 += 32) {
            bf16x8 a[4], b[2];
#pragma unroll
            for (int m = 0; m < 4; ++m) a[m] = *(const bf16x8*)(ap[m] + k0);
#pragma unroll
            for (int n = 0; n < 2; ++n) b[n] = *(const bf16x8*)(bp[n] + k0);
#pragma unroll
            for (int m = 0; m < 4; ++m)
#pragma unroll
                for (int n = 0; n < 2; ++n) acc[m][n] = __builtin_amdgcn_mfma_f32_16x16x32_bf16(b[n], a[m], acc[m][n], 0, 0, 0);
        }
#pragma unroll
        for (int m = 0; m < 4; ++m) {
            const int row = m0 + 16 * m + fr; if (row >= M) continue;
            if (e.mode == 2) {
                const f32x4 g = acc[m][0], u = acc[m][1]; u32x2 o;
                o.x = pk2(siluf(g.x) * u.x, siluf(g.y) * u.y); o.y = pk2(siluf(g.z) * u.z, siluf(g.w) * u.w);
                *(u32x2*)(e.ob + (size_t)row * e.ldo + 16 * nb + 4 * fq) = o;
            } else {
#pragma unroll
                for (int n = 0; n < 2; ++n) {
                    const int col = n0 + 16 * n + 4 * fq; if (col >= N) continue;
                    const f32x4 v = acc[m][n];
                    if (e.mode == 1) *(f32x4*)(e.of + (size_t)row * e.ldo + col) = v;
                    else if (col < e.main_cols) { u32x2 o; o.x = pk2(v.x, v.y); o.y = pk2(v.z, v.w); *(u32x2*)(e.ob + (size_t)row * e.ldo + col) = o; }
                    else *(f32x4*)(e.of + (size_t)row * 32 + (col - e.main_cols)) = v;
                }
            }
        }
    }
}

DI void attn_wave(const Ctx& c, int li, int tok, int h, LAS float* pl  ) {
    const bf16_t* PROJ = c.ws<bf16_t>(W_PROJ); bf16_t* MIX = c.ws<bf16_t>(W_MIXED);
    const int lane = c.lane; const bool smp = tok >= T;
    const int b = smp ? tok - T : tok / SEQ, s = smp ? WIN : tok % SEQ;
    const float* ck = c.in(I_CK) + ((size_t)(li * NS + b) * WIN) * AW + h * AHD;
    const float* cv = c.in(I_CV) + ((size_t)(li * NS + b) * WIN) * AW + h * AHD;
    const bf16_t* prow0 = smp ? PROJ + (size_t)tok * HYB_MAIN : PROJ + (size_t)(b * SEQ) * HYB_MAIN;
    float q[64];
    { const bf16_t* qp = PROJ + (size_t)tok * HYB_MAIN + h * AHD;
#pragma unroll
      for (int j = 0; j < 8; ++j) { const u32x4 v = *(const u32x4*)(qp + 8 * j);
          q[8*j+0] = bf2f((bf16_t)(v.x & 0xffff)) * 0.125f; q[8*j+1] = bf2f((bf16_t)(v.x >> 16)) * 0.125f; q[8*j+2] = bf2f((bf16_t)(v.y & 0xffff)) * 0.125f; q[8*j+3] = bf2f((bf16_t)(v.y >> 16)) * 0.125f;
          q[8*j+4] = bf2f((bf16_t)(v.z & 0xffff)) * 0.125f; q[8*j+5] = bf2f((bf16_t)(v.z >> 16)) * 0.125f; q[8*j+6] = bf2f((bf16_t)(v.w & 0xffff)) * 0.125f; q[8*j+7] = bf2f((bf16_t)(v.w >> 16)) * 0.125f; } }
    const float* relb = c.in(I_RELB);
    float mx = -1e30f;
#pragma unroll 1
    for (int pat = 0; pat < 3; ++pat) {
        const int d = pat == 0 ? 1 : (pat == 1 ? 4 : 16);
#pragma unroll
        for (int rnd = 0; rnd < 3; ++rnd) {
            const int j = rnd * 64 + lane; float lg = -1e30f;
            if (j <= 128) {
                const int R = s - j * d;
                if (R >= 0) {
                    float acc = 0.f;
                    if (smp && R < WIN) { const float* kp = ck + (size_t)R * AW;
#pragma unroll
                        for (int e = 0; e < 16; ++e) { const f32x4 v = *(const f32x4*)(kp + 4 * e); acc += q[4*e] * v.x + q[4*e+1] * v.y + q[4*e+2] * v.z + q[4*e+3] * v.w; }
                    } else { const bf16_t* kp = (smp ? prow0 : prow0 + (size_t)R * HYB_MAIN) + AW + h * AHD;
#pragma unroll
                        for (int e = 0; e < 8; ++e) { const u32x4 v = *(const u32x4*)(kp + 8 * e);
                            acc += q[8*e] * bf2f((bf16_t)(v.x & 0xffff)) + q[8*e+1] * bf2f((bf16_t)(v.x >> 16)) + q[8*e+2] * bf2f((bf16_t)(v.y & 0xffff)) + q[8*e+3] * bf2f((bf16_t)(v.y >> 16))
                                 + q[8*e+4] * bf2f((bf16_t)(v.z & 0xffff)) + q[8*e+5] * bf2f((bf16_t)(v.z >> 16)) + q[8*e+6] * bf2f((bf16_t)(v.w & 0xffff)) + q[8*e+7] * bf2f((bf16_t)(v.w >> 16)); }
                    }
                    lg = acc + relb[c_bucket[pat][j] * AH + h];
                }
                pl[pat * 132 + j] = lg;
            }
            mx = fmaxf(mx, lg);
        }
    }
    mx = wave_max(mx);
    LDS_WAIT();
    float ssum = 0.f;
#pragma unroll 1
    for (int i = lane; i < 396; i += 64) { const int pat = i / 132, j = i % 132; if (j <= 128) { const float lg = pl[i]; const float pv = lg > -1e29f ? __expf(lg - mx) : 0.f; pl[i] = pv; ssum += pv; } }
    ssum = wave_sum(ssum);
    LDS_WAIT();
    {
        const int kg = lane >> 4, dc = lane & 15;
        f32x4 o4 = (f32x4){0.f, 0.f, 0.f, 0.f};
        if (smp) {
#pragma unroll 1
            for (int pat = 0; pat < 3; ++pat) {
                const int d = pat == 0 ? 1 : (pat == 1 ? 4 : 16);
                if (kg == 0) { const u32x2 vv = *(const u32x2*)(prow0 + 2 * AW + h * AHD + 4 * dc); const float pv = pl[pat * 132];
                    o4.x += pv * bf2f((bf16_t)(vv.x & 0xffff)); o4.y += pv * bf2f((bf16_t)(vv.x >> 16)); o4.z += pv * bf2f((bf16_t)(vv.y & 0xffff)); o4.w += pv * bf2f((bf16_t)(vv.y >> 16)); }
#pragma unroll 16
                for (int i4 = 0; i4 < 32; ++i4) { const int j = 1 + 4 * i4 + kg; const f32x4 vv = *(const f32x4*)(cv + (size_t)(WIN - j * d) * AW + 4 * dc); o4 += vv * pl[pat * 132 + j]; }
            }
        } else {
#pragma unroll 1
            for (int pat = 0; pat < 3; ++pat) {
                const int d = pat == 0 ? 1 : (pat == 1 ? 4 : 16);
                int jmax = s / d; jmax = jmax > 128 ? 128 : jmax;
#pragma unroll 4
                for (int j = kg; j <= jmax; j += 4) { const u32x2 vv = *(const u32x2*)(prow0 + (size_t)(s - j * d) * HYB_MAIN + 2 * AW + h * AHD + 4 * dc); const float pv = pl[pat * 132 + j];
                    o4.x += pv * bf2f((bf16_t)(vv.x & 0xffff)); o4.y += pv * bf2f((bf16_t)(vv.x >> 16)); o4.z += pv * bf2f((bf16_t)(vv.y & 0xffff)); o4.w += pv * bf2f((bf16_t)(vv.y >> 16)); }
            }
        }
#pragma unroll
        for (int e = 0; e < 4; ++e) { o4[e] += __shfl_xor(o4[e], 16); o4[e] += __shfl_xor(o4[e], 32); }
        const float inv = 1.f / ssum;
        if (kg == 0) { u32x2 o; o.x = pk2(o4.x * inv, o4.y * inv); o.y = pk2(o4.z * inv, o4.w * inv); *(u32x2*)(MIX + (size_t)tok * HYB_MIX + h * AHD + 4 * dc) = o; }
    }
    LDS_WAIT();
}

template <int MT>
DI void gemm_ksplit(const Ctx& c, const bf16_t* A, int lda, int M, const bf16_t* Bt, int ldb, int N, int K, const Epi e) {
    const int mblk = (M + 16 * MT - 1) / (16 * MT), nblk = (N + 31) / 32, nit = mblk * nblk;
    const int fr = c.lane & 15, fq = c.lane >> 4, kslice = K / 8, klo = c.wave * kslice;
    LAS float* part = (LAS float*)c.lds;
    for (int it = blockIdx.x; it < nit; it += gridDim.x) {
        const int mb = it / nblk, nb = it % nblk, m0 = mb * 16 * MT, n0 = nb * 32;
        const bf16_t* ap[MT]; const bf16_t* bp[2];
#pragma unroll
        for (int m = 0; m < MT; ++m) { int r = m0 + 16 * m + fr; r = r < M ? r : M - 1; ap[m] = A + (size_t)r * lda + klo + 8 * fq; }
#pragma unroll
        for (int n = 0; n < 2; ++n) { int r = n0 + 16 * n + fr; r = r < N ? r : N - 1; bp[n] = Bt + (size_t)r * ldb + klo + 8 * fq; }
        f32x4 acc[MT][2];
#pragma unroll
        for (int m = 0; m < MT; ++m)
#pragma unroll
            for (int n = 0; n < 2; ++n) acc[m][n] = (f32x4){0.f, 0.f, 0.f, 0.f};
#pragma unroll 4
        for (int k0 = 0; k0 < kslice; k0 += 32) {
            bf16x8 a[MT], b[2];
#pragma unroll
            for (int m = 0; m < MT; ++m) a[m] = *(const bf16x8*)(ap[m] + k0);
#pragma unroll
            for (int n = 0; n < 2; ++n) b[n] = *(const bf16x8*)(bp[n] + k0);
#pragma unroll
            for (int m = 0; m < MT; ++m)
#pragma unroll
                for (int n = 0; n < 2; ++n) acc[m][n] = __builtin_amdgcn_mfma_f32_16x16x32_bf16(b[n], a[m], acc[m][n], 0, 0, 0);
        }
        __syncthreads();
#pragma unroll
        for (int m = 0; m < MT; ++m)
#pragma unroll
            for (int n = 0; n < 2; ++n) *(LAS f32x4*)(part + ((c.wave * (MT * 2) + m * 2 + n) * 64 + c.lane) * 4) = acc[m][n];
        __syncthreads();
        if (c.wave < MT) {
            const int m = c.wave; f32x4 v[2];
#pragma unroll
            for (int n = 0; n < 2; ++n) { v[n] = (f32x4){0.f, 0.f, 0.f, 0.f};
#pragma unroll
                for (int w = 0; w < 8; ++w) v[n] += *(const LAS f32x4*)(part + ((w * (MT * 2) + m * 2 + n) * 64 + c.lane) * 4); }
            const int row = m0 + 16 * m + fr;
            if (row < M) {
                if (e.mode == 2) {
                    const f32x4 g = v[0], u = v[1]; u32x2 o;
                    o.x = pk2(siluf(g.x) * u.x, siluf(g.y) * u.y); o.y = pk2(siluf(g.z) * u.z, siluf(g.w) * u.w);
                    *(u32x2*)(e.ob + (size_t)row * e.ldo + 16 * nb + 4 * fq) = o;
                } else {
#pragma unroll
                    for (int n = 0; n < 2; ++n) {
                        const int col = n0 + 16 * n + 4 * fq; if (col >= N) continue;
                        if (e.mode == 1) *(f32x4*)(e.of + (size_t)row * e.ldo + col) = v[n];
                        else if (col < e.main_cols) { u32x2 o; o.x = pk2(v[n].x, v[n].y); o.y = pk2(v[n].z, v[n].w); *(u32x2*)(e.ob + (size_t)row * e.ldo + col) = o; }
                        else *(f32x4*)(e.of + (size_t)row * 32 + (col - e.main_cols)) = v[n];
                    }
                }
            }
        }
    }
    __syncthreads();
}

constexpr int AT_LDS = 1600;
struct AtStep { int d, u, kb, sh; const LAS float* tbp; };
DI AtStep at_step(int g, const LAS float* tb) {
    AtStep s;
    if (g < 12) { s.d = 1; s.u = 16; s.sh = 0; s.kb = -143 + 32 * g; s.tbp = tb; }
    else if (g < 18) { s.d = 4; s.u = 4; s.sh = 2; s.kb = -131 + 32 * (g - 12); s.tbp = tb + 132; }
    else if (g < 23) { s.d = 16; s.u = 1; s.sh = 4; s.kb = -144 + 32 * (g - 18); s.tbp = tb + 264; }
    else { s.d = 1; s.u = 0; s.sh = 0; s.kb = 100000; s.tbp = tb; }
    return s;
}
struct AtBuf { bf16x8 k[2][2]; bf16x8 v[2][2]; };
DI void at_load(AtBuf& bf, const bf16_t* qrow0, int P0, const AtStep st, int fr, int fq) {
#pragma unroll
    for (int kt = 0; kt < 2; ++kt) {
        int pos = P0 + st.d * (st.kb + 16 * kt + fr); pos = pos < 0 ? 0 : (pos > SEQ - 1 ? SEQ - 1 : pos);
        const bf16_t* rp = qrow0 + (size_t)pos * HYB_MAIN + 8 * fq;
        bf.k[kt][0] = *(const bf16x8*)(rp + AW); bf.k[kt][1] = *(const bf16x8*)(rp + AW + 32);
        bf.v[kt][0] = *(const bf16x8*)(rp + 2 * AW); bf.v[kt][1] = *(const bf16x8*)(rp + 2 * AW + 32);
    }
}
DI void attn_mfma_item(const Ctx& c, int li, int item, int& tb_head) {
    const bf16_t* PROJ = c.ws<bf16_t>(W_PROJ); bf16_t* MIX = c.ws<bf16_t>(W_MIXED);
    int lane_ = c.lane; asm volatile("" : "+v"(lane_));
    const int lane = lane_, fr = lane & 15, fq = lane >> 4;
    const int qb = item & 255, h = (item >> 8) & 7, b = item >> 11, P0 = (qb >> 4) * 256 + (qb & 15);
    LAS float* tb = (LAS float*)(c.lds + c.wave * AT_LDS);
    if (h != tb_head) { const float* relb = c.in(I_RELB); tb_head = h;
#pragma unroll
      for (int k7 = 0; k7 < 7; ++k7) { const int i = lane + 64 * k7; if (i < 396) { const int pat = i / 132, j = i % 132; tb[i] = j <= 128 ? relb[c_bucket[pat][j] * AH + h] : 0.f; } } }
    const bf16_t* qrow0 = PROJ + (size_t)(b * SEQ) * HYB_MAIN + h * AHD;
    bf16x8 qf[2], idf[2];
#pragma unroll
    for (int kd = 0; kd < 2; ++kd) qf[kd] = *(const bf16x8*)(qrow0 + (size_t)(P0 + 16 * fr) * HYB_MAIN + 32 * kd + 8 * fq);
#pragma unroll
    for (int hs = 0; hs < 2; ++hs)
#pragma unroll
        for (int e = 0; e < 8; ++e) idf[hs][e] = (8 * fq + e) == (16 * hs + fr) ? (short)0x3F80 : (short)0;
    float m = -1e30f, lsum = 0.f;
    f32x4 O[4];
#pragma unroll
    for (int dt = 0; dt < 4; ++dt) O[dt] = (f32x4){0.f, 0.f, 0.f, 0.f};
    AtBuf b0, b1, b2;
    at_load(b0, qrow0, P0, at_step(0, tb), fr, fq); at_load(b1, qrow0, P0, at_step(1, tb), fr, fq); at_load(b2, qrow0, P0, at_step(2, tb), fr, fq);
    LDS_WAIT();
#define AT_STEP(bf, g) do { \
        const AtStep st = at_step((g), tb); const int qi = st.u * fr; \
        f32x4 sc[2]; \
        _Pragma("unroll") for (int kt = 0; kt < 2; ++kt) { sc[kt] = (f32x4){0.f, 0.f, 0.f, 0.f}; \
            _Pragma("unroll") for (int kd = 0; kd < 2; ++kd) sc[kt] = __builtin_amdgcn_mfma_f32_16x16x32_bf16(bf.k[kt][kd], qf[kd], sc[kt], 0, 0, 0); } \
        f32x4 dv[2][4]; \
        _Pragma("unroll") for (int kt = 0; kt < 2; ++kt) _Pragma("unroll") for (int dt = 0; dt < 4; ++dt) \
            dv[kt][dt] = __builtin_amdgcn_mfma_f32_16x16x32_bf16(bf.v[kt][dt >> 1], idf[dt & 1], (f32x4){0.f, 0.f, 0.f, 0.f}, 0, 0, 0);     \
        const AtStep nx = at_step((g) + 3, tb); at_load(bf, qrow0, P0, nx, fr, fq);     \
        float tmax = -1e30f; bool ok[2][4]; \
        const int dbase = qi - st.kb - 4 * fq;                                 \
        int dmx = qi + (P0 >> st.sh); dmx = dmx > 128 ? 128 : dmx;                  \
        _Pragma("unroll") for (int kt = 0; kt < 2; ++kt) _Pragma("unroll") for (int r = 0; r < 4; ++r) { \
            const unsigned dist = (unsigned)(dbase - 16 * kt - r); const bool v = dist <= (unsigned)dmx; ok[kt][r] = v; \
            const unsigned di = dist > 128u ? 128u : dist; const float bias = *(const volatile LAS float*)(st.tbp + di); \
            const float lg = v ? sc[kt][r] * 0.125f + bias : -1e30f; sc[kt][r] = lg; tmax = fmaxf(tmax, lg); } \
        tmax = fmaxf(tmax, __shfl_xor(tmax, 16)); tmax = fmaxf(tmax, __shfl_xor(tmax, 32)); \
        const float mn = fmaxf(m, tmax), alpha = __expf(m - mn); m = mn; \
        float ps = 0.f; \
        _Pragma("unroll") for (int kt = 0; kt < 2; ++kt) _Pragma("unroll") for (int r = 0; r < 4; ++r) { const float pv = ok[kt][r] ? __expf(sc[kt][r] - mn) : 0.f; sc[kt][r] = pv; ps += pv; } \
        lsum = lsum * alpha + ps; \
        const bf16x8 pfrag = pack8(sc[0], sc[1]); \
        _Pragma("unroll") for (int dt = 0; dt < 4; ++dt) O[dt] = __builtin_amdgcn_mfma_f32_16x16x32_bf16(pack8(dv[0][dt], dv[1][dt]), pfrag, O[dt] * alpha, 0, 0, 0); } while (0)
#pragma unroll 1
    for (int g = 0; g < 24; g += 3) { AT_STEP(b0, g); AT_STEP(b1, g + 1); AT_STEP(b2, g + 2); }
#undef AT_STEP
    lsum += __shfl_xor(lsum, 16); lsum += __shfl_xor(lsum, 32);
    const float inv = 1.f / lsum;
    bf16_t* orow = MIX + (size_t)(b * SEQ + P0 + 16 * fr) * HYB_MIX + h * AHD;
#pragma unroll
    for (int dt = 0; dt < 4; ++dt) { u32x2 o; o.x = pk2(O[dt][0] * inv, O[dt][1] * inv); o.y = pk2(O[dt][2] * inv, O[dt][3] * inv); *(u32x2*)(orow + 16 * dt + 4 * fq) = o; }
    LDS_WAIT();
}

DI void unpack8(const u32x4 v, float* f) {
    f[0] = bf2f((bf16_t)(v.x & 0xffff)); f[1] = bf2f((bf16_t)(v.x >> 16)); f[2] = bf2f((bf16_t)(v.y & 0xffff)); f[3] = bf2f((bf16_t)(v.y >> 16));
    f[4] = bf2f((bf16_t)(v.z & 0xffff)); f[5] = bf2f((bf16_t)(v.z >> 16)); f[6] = bf2f((bf16_t)(v.w & 0xffff)); f[7] = bf2f((bf16_t)(v.w >> 16));
}
DI void load8f(const float* p, float* f) { const f32x4 a = *(const f32x4*)p, b = *(const f32x4*)(p + 4); f[0] = a.x; f[1] = a.y; f[2] = a.z; f[3] = a.w; f[4] = b.x; f[5] = b.y; f[6] = b.z; f[7] = b.w; }
DI void store8f(float* p, const float* f) { *(f32x4*)p = (f32x4){f[0], f[1], f[2], f[3]}; *(f32x4*)(p + 4) = (f32x4){f[4], f[5], f[6], f[7]}; }
DI void conv8(const bf16_t* prow, int ld, const float* st, int nch, const float* cw, int ch0, bool smp, int s, float* x1, float* x2, float* x3, float* y) {
    float x0[8], w[8];
    unpack8(*(const u32x4*)(prow + ch0), x3);
    if (smp) { load8f(st + ch0, x0); load8f(st + nch + ch0, x1); load8f(st + 2 * nch + ch0, x2); }
    else {
        const u32x4 z = (u32x4){0u, 0u, 0u, 0u};
        unpack8(s >= 1 ? *(const u32x4*)(prow + ch0 - ld) : z, x2); unpack8(s >= 2 ? *(const u32x4*)(prow + ch0 - 2 * ld) : z, x1); unpack8(s >= 3 ? *(const u32x4*)(prow + ch0 - 3 * ld) : z, x0);
    }
    load8f(cw + ch0, w);
#pragma unroll
    for (int e = 0; e < 8; ++e) y[e] = x0[e] * w[e];
    load8f(cw + nch + ch0, w);
#pragma unroll
    for (int e = 0; e < 8; ++e) y[e] += x1[e] * w[e];
    load8f(cw + 2 * nch + ch0, w);
#pragma unroll
    for (int e = 0; e < 8; ++e) y[e] += x2[e] * w[e];
    load8f(cw + 3 * nch + ch0, w);
#pragma unroll
    for (int e = 0; e < 8; ++e) y[e] += x3[e] * w[e];
}
DI void hyb_pre_token(const Ctx& c, int li, int tok) {
    const bf16_t* PROJ = c.ws<bf16_t>(W_PROJ); float* ACT = c.ws<float>(W_ACT); float* AUX = c.ws<float>(W_AUX); const float* EX = c.ws<float>(W_EXTRA);
    const int lane = c.lane; const bool smp = tok >= T; const int b = smp ? tok - T : tok / SEQ, s = smp ? 0 : tok % SEQ;
    const float* cw = c.in(I_SCW) + (size_t)li * 4 * SXBC; const float* cb = c.in(I_SCB) + (size_t)li * SXBC;
    const float* st = c.in(I_SCONV) + (size_t)(li * NS + b) * 3 * SXBC;
    const bf16_t* prow = PROJ + (size_t)tok * HYB_MAIN + 2560;
#pragma unroll 1
    for (int it = 0; it < 3; ++it) {
        const int ch0 = 512 * it + 8 * lane; float x1[8], x2[8], x3[8], y[8], bb[8];
        conv8(prow, HYB_MAIN, st, SXBC, cw, ch0, smp, s, x1, x2, x3, y);
        load8f(cb + ch0, bb);
#pragma unroll
        for (int e = 0; e < 8; ++e) y[e] = siluf(y[e] + bb[e]);
        store8f(ACT + (size_t)tok * 4096 + ch0, y);
        if (smp) { float* o = c.p.out + O_SSC + (size_t)(li * NS + b) * 3 * SXBC + ch0; store8f(o, x1); store8f(o + SXBC, x2); store8f(o + 2 * SXBC, x3); }
        else if (s >= SEQ - 3) store8f(c.p.out + O_PSC + ((size_t)(li * NB + b) * 3 + (s - (SEQ - 3))) * SXBC + ch0, x3);
    }
    if (lane < SH) AUX[(size_t)tok * 32 + lane] = softplusf_(EX[(size_t)tok * 32 + lane] + c.in(I_SDTB)[li * SH + lane]);
    if (smp || s >= SEQ - WIN) {
        float* ok = smp ? c.p.out + O_SK + ((size_t)(li * NS + b) * WIN + (WIN - 1)) * AW : c.p.out + O_PK + ((size_t)(li * NB + b) * WIN + (s - (SEQ - WIN))) * AW;
        float* ov = smp ? c.p.out + O_SV + ((size_t)(li * NS + b) * WIN + (WIN - 1)) * AW : c.p.out + O_PV + ((size_t)(li * NB + b) * WIN + (s - (SEQ - WIN))) * AW;
        const bf16_t* kr = PROJ + (size_t)tok * HYB_MAIN + AW;
        float f[8];
        unpack8(*(const u32x4*)(kr + 8 * lane), f); store8f(ok + 8 * lane, f);
        unpack8(*(const u32x4*)(kr + AW + 8 * lane), f); store8f(ov + 8 * lane, f);
    }
}

DI void attn_sample_wg(const Ctx& c, int li, int item) {
    const bf16_t* PROJ = c.ws<bf16_t>(W_PROJ); bf16_t* MIX = c.ws<bf16_t>(W_MIXED);
    const int lane = c.lane, w = c.wave, sb = item / AH, h = item % AH, tok = T + sb;
    const float* ck = c.in(I_CK) + ((size_t)(li * NS + sb) * WIN) * AW + h * AHD; const float* cv = c.in(I_CV) + ((size_t)(li * NS + sb) * WIN) * AW + h * AHD;
    const bf16_t* prow0 = PROJ + (size_t)tok * HYB_MAIN;
    LAS float* pw = (LAS float*)(c.lds + NWAVE * AT_LDS + w * 2048);
    const int f0 = 49 * w, nk = (387 - f0) < 49 ? (387 - f0) : 49;
    float q[64];
    { const bf16_t* qp = prow0 + h * AHD;
#pragma unroll
      for (int j = 0; j < 8; ++j) { float f[8]; unpack8(*(const u32x4*)(qp + 8 * j), f);
#pragma unroll
          for (int e = 0; e < 8; ++e) q[8 * j + e] = f[e] * 0.125f; } }
    float lg = -1e30f;
    if (lane < nk) {
        const int f = f0 + lane, pat = f / 129, jj = f % 129, d = pat == 0 ? 1 : (pat == 1 ? 4 : 16);
        float acc = 0.f;
        if (jj == 0) { const bf16_t* kp = prow0 + AW + h * AHD;
#pragma unroll
            for (int e = 0; e < 8; ++e) { float kf[8]; unpack8(*(const u32x4*)(kp + 8 * e), kf);
#pragma unroll
                for (int x = 0; x < 8; ++x) acc += q[8 * e + x] * kf[x]; }
        } else { const float* kp = ck + (size_t)(WIN - jj * d) * AW;
#pragma unroll
            for (int e = 0; e < 16; ++e) { const f32x4 v = *(const f32x4*)(kp + 4 * e); acc += q[4 * e] * v.x + q[4 * e + 1] * v.y + q[4 * e + 2] * v.z + q[4 * e + 3] * v.w; } }
        lg = acc + c.in(I_RELB)[c_bucket[pat][jj] * AH + h];
    }
    const float mw = wave_max(lg), pv = lane < nk ? __expf(lg - mw) : 0.f, lw = wave_sum(pv);
    pw[lane] = pv;
    LDS_WAIT();
    const int kg = lane >> 4, dc = lane & 15;
    f32x4 o4 = (f32x4){0.f, 0.f, 0.f, 0.f};
#pragma unroll
    for (int i = 0; i < 13; ++i) {
        const int idx = 4 * i + kg;
        if (idx < nk) {
            const int f = f0 + idx, pat = f / 129, jj = f % 129, d = pat == 0 ? 1 : (pat == 1 ? 4 : 16); const float p = pw[idx];
            if (jj == 0) { const u32x2 vv = *(const u32x2*)(prow0 + 2 * AW + h * AHD + 4 * dc);
                o4.x += p * bf2f((bf16_t)(vv.x & 0xffff)); o4.y += p * bf2f((bf16_t)(vv.x >> 16)); o4.z += p * bf2f((bf16_t)(vv.y & 0xffff)); o4.w += p * bf2f((bf16_t)(vv.y >> 16)); }
            else o4 += *(const f32x4*)(cv + (size_t)(WIN - jj * d) * AW + 4 * dc) * p;
        }
    }
#pragma unroll
    for (int e = 0; e < 4; ++e) { o4[e] += __shfl_xor(o4[e], 16); o4[e] += __shfl_xor(o4[e], 32); }
    if (kg == 0) *(LAS f32x4*)(pw + 64 + 4 * dc) = o4;
    if (lane == 0) { pw[128] = mw; pw[129] = lw; }
    __syncthreads();
    if (w == 0 && lane < 16) {
        const LAS float* base = (const LAS float*)(c.lds + NWAVE * AT_LDS);
        float M = -1e30f;
#pragma unroll
        for (int x = 0; x < 8; ++x) M = fmaxf(M, base[x * 512 + 128]);
        float L = 0.f; f32x4 o = (f32x4){0.f, 0.f, 0.f, 0.f};
#pragma unroll
        for (int x = 0; x < 8; ++x) { const float sc = __expf(base[x * 512 + 128] - M); L += base[x * 512 + 129] * sc; o += *(const LAS f32x4*)(base + x * 512 + 64 + 4 * lane) * sc; }
        const float inv = 1.f / L; u32x2 ov; ov.x = pk2(o.x * inv, o.y * inv); ov.y = pk2(o.z * inv, o.w * inv);
        *(u32x2*)(MIX + (size_t)tok * HYB_MIX + h * AHD + 4 * lane) = ov;
    }
    __syncthreads();
}

DI void ssd_wave(const Ctx& c, int li, int item) {
    const float* ACT = c.ws<float>(W_ACT); const float* AUX = c.ws<float>(W_AUX); float* Y = c.ws<float>(W_Y);
    const int lane = c.lane;
    const bool smp = item >= NB * SH * SP; const int it = smp ? item - NB * SH * SP : item;
    const int seq = it / (SH * SP), h = (it / SP) % SH, p = it % SP, g = h / (SH / SG);
    const int L = smp ? 1 : SEQ; const int tok0 = smp ? T + seq : seq * SEQ;
    const float Ah = -__expf(c.in(I_SALOG)[li * SH + h]), Dh = c.in(I_SD)[li * SH + h];
    float h0 = 0.f, h1 = 0.f;
    if (smp) { const float* s0 = c.in(I_SSM) + (((size_t)(li * NS + seq) * SH + h) * SP + p) * SN; h0 = s0[2 * lane]; h1 = s0[2 * lane + 1]; }
#pragma unroll 2
    for (int t = 0; t < L; ++t) {
        const float* a = ACT + (size_t)(tok0 + t) * 4096;
        const float dt = AUX[(size_t)(tok0 + t) * 32 + h], xv = a[h * SP + p];
        const float2 Bv = *(const float2*)(a + SDI + g * SN + 2 * lane), Cv = *(const float2*)(a + SDI + SG * SN + g * SN + 2 * lane);
        const float dec = __expf(dt * Ah), dx = dt * xv;
        h0 = h0 * dec + dx * Bv.x; h1 = h1 * dec + dx * Bv.y;
        const float y = wave_sum(h0 * Cv.x + h1 * Cv.y);
        if (lane == 0) Y[(size_t)(tok0 + t) * 2048 + h * SP + p] = y + Dh * xv;
    }
    float* so = smp ? c.p.out + O_SSS + (((size_t)(li * NS + seq) * SH + h) * SP + p) * SN : c.p.out + O_PSS + (((size_t)(li * NB + seq) * SH + h) * SP + p) * SN;
    *(float2*)(so + 2 * lane) = make_float2(h0, h1);
}
DI void ssd_sample_item(const Ctx& c, int li, int qitem) {
    const int item = qitem >> 2, pq = qitem & 3;
    const float* ACT = c.ws<float>(W_ACT); const float* AUX = c.ws<float>(W_AUX); float* Y = c.ws<float>(W_Y);
    const int lane = c.lane, seq = item / SH, h = item % SH, g = h / (SH / SG), tok = T + seq;
    const float Ah = -__expf(c.in(I_SALOG)[li * SH + h]), Dh = c.in(I_SD)[li * SH + h];
    const float* a = ACT + (size_t)tok * 4096;
    const float dt = AUX[(size_t)tok * 32 + h], dec = __expf(dt * Ah);
    const float2 Bv = *(const float2*)(a + SDI + g * SN + 2 * lane), Cv = *(const float2*)(a + SDI + SG * SN + g * SN + 2 * lane);
    const float* s0 = c.in(I_SSM) + ((size_t)(li * NS + seq) * SH + h) * SP * SN; float* so = c.p.out + O_SSS + ((size_t)(li * NS + seq) * SH + h) * SP * SN;
    const float xl = a[h * SP + lane];
    float ysum = 0.f;
#pragma unroll
    for (int pp = 0; pp < 16; ++pp) { const int p = 16 * pq + pp;
        const float2 hv = *(const float2*)(s0 + (size_t)p * SN + 2 * lane);
        const float dx = dt * __shfl(xl, p);
        const float h0 = hv.x * dec + dx * Bv.x, h1 = hv.y * dec + dx * Bv.y;
        *(float2*)(so + (size_t)p * SN + 2 * lane) = make_float2(h0, h1);
        const float y = wave_sum(h0 * Cv.x + h1 * Cv.y);
        ysum = lane == p ? y : ysum;
    }
    if ((lane >> 4) == pq) Y[(size_t)tok * 2048 + h * SP + lane] = ysum + Dh * xl;
}
DI void hyb_post_token(const Ctx& c, int li, int tok) {
    const bf16_t* PROJ = c.ws<bf16_t>(W_PROJ); const float* Y = c.ws<float>(W_Y); bf16_t* MIX = c.ws<bf16_t>(W_MIXED);
    const float* nw = c.in(I_SNW) + (size_t)li * SDI; const int lane = c.lane;
    float v[16]; float ss0 = 0.f, ss1 = 0.f;
#pragma unroll
    for (int j = 0; j < 16; ++j) { const int ch = lane + 64 * j; const float z = bf2f(PROJ[(size_t)tok * HYB_MAIN + 1536 + ch]); v[j] = Y[(size_t)tok * 2048 + ch] * siluf(z); if (j < 8) ss0 += v[j] * v[j]; else ss1 += v[j] * v[j]; }
    const float r0 = rsqrtf(wave_sum(ss0) * (1.f / 512.f) + EPS), r1 = rsqrtf(wave_sum(ss1) * (1.f / 512.f) + EPS);
#pragma unroll
    for (int j = 0; j < 16; ++j) { const int ch = lane + 64 * j; MIX[(size_t)tok * HYB_MIX + AW + ch] = f2bf(v[j] * (j < 8 ? r0 : r1) * nw[ch]); }
}


constexpr int SLD = 136;
constexpr int L_C = 0, L_B = 34816, L_XT = 69632, L_HS = 87040, L_CS = 104448, L_DT = 108544;
constexpr size_t W_ST = W_HID;
constexpr size_t W_DEC = W_HID + (size_t)NB * 32 * SH * SP * SN * 4;
constexpr int NCH = SEQ / 128;

DI void ssd_chunk_scalars(const Ctx& c, int li, int tok0, int g) {
    const float* AUX = c.ws<float>(W_AUX); LAS float* csS = (LAS float*)(c.lds + L_CS); LAS float* dtS = (LAS float*)(c.lds + L_DT);
    const int hh = c.wave, lane = c.lane, h = 8 * g + hh;
    const float Ah = -__expf(c.in(I_SALOG)[li * SH + h]);
    const float d0 = AUX[(size_t)(tok0 + lane) * 32 + h], d1 = AUX[(size_t)(tok0 + 64 + lane) * 32 + h];
    float s0 = d0 * Ah, s1 = d1 * Ah;
#pragma unroll
    for (int o = 1; o < 64; o <<= 1) { const float t0 = __shfl_up(s0, o), t1 = __shfl_up(s1, o); if (lane >= o) { s0 += t0; s1 += t1; } }
    s1 += __shfl(s0, 63);
    csS[lane * 8 + hh] = s0; csS[(64 + lane) * 8 + hh] = s1; dtS[lane * 8 + hh] = d0; dtS[(64 + lane) * 8 + hh] = d1;
}
DI void ssd_a_item(const Ctx& c, int li, int item) {
    int tid_o = c.tid; asm volatile("" : "+v"(tid_o));
    const int lane_o = tid_o & 63;
    const float* ACT = c.ws<float>(W_ACT); float* ST = c.ws<float>(W_ST); float* DEC = c.ws<float>(W_DEC);
    const int g = item & 1, ch = (item >> 1) % NCH, b = item / (2 * NCH), tok0 = b * SEQ + ch * 128;
    LAS bf16_t* BT = (LAS bf16_t*)(c.lds + L_B);
    const LAS float* csS = (const LAS float*)(c.lds + L_CS); const LAS float* dtS = (const LAS float*)(c.lds + L_DT);
    const int fr = lane_o & 15, fq = lane_o >> 4, w = c.wave, h = 8 * g + w;
    bf16x8 idf[2];
#pragma unroll
    for (int hs = 0; hs < 2; ++hs)
#pragma unroll
        for (int e = 0; e < 8; ++e) idf[hs][e] = (8 * fq + e) == (16 * hs + fr) ? (short)0x3F80 : (short)0;
    __syncthreads();
    ssd_chunk_scalars(c, li, tok0, g);
    {
        bf16x8 bfr[8];
#pragma unroll
        for (int jt = 0; jt < 8; ++jt) bfr[jt] = gfrag_f32(ACT + (size_t)(tok0 + 16 * jt + fr) * 4096 + SDI + g * SN + 32 * (w >> 1) + 8 * fq);
#pragma unroll
        for (int jt = 0; jt < 8; ++jt) { const f32x4 d = __builtin_amdgcn_mfma_f32_16x16x32_bf16(bfr[jt], idf[w & 1], (f32x4){0.f, 0.f, 0.f, 0.f}, 0, 0, 0);
            u32x2 o; o.x = pk2(d[0], d[1]); o.y = pk2(d[2], d[3]); *(LAS u32x2*)(BT + (16 * w + fr) * SLD + 16 * jt + 4 * fq) = o; }
    }
    bf16x8 xfr[8][2];
#pragma unroll
    for (int jt = 0; jt < 8; ++jt)
#pragma unroll
        for (int c2 = 0; c2 < 2; ++c2) xfr[jt][c2] = gfrag_f32(ACT + (size_t)(tok0 + 16 * jt + fr) * 4096 + h * SP + 32 * c2 + 8 * fq);
    __syncthreads();
    if (tid_o < 8) DEC[(size_t)(b * NCH + ch) * SH + 8 * g + tid_o] = __expf(csS[127 * 8 + tid_o]);
    const float csl = csS[127 * 8 + w];
    bf16x8 xwf[4][4];
#pragma unroll
    for (int ks = 0; ks < 4; ++ks) {
        f32x4 d[2][4];
#pragma unroll
        for (int j2 = 0; j2 < 2; ++j2) {
            const int jt = 2 * ks + j2; f32x4 we;
#pragma unroll
            for (int r = 0; r < 4; ++r) { const int j = 16 * jt + 4 * fq + r; we[r] = __expf(csl - csS[j * 8 + w]) * dtS[j * 8 + w]; }
#pragma unroll
            for (int pt = 0; pt < 4; ++pt) d[j2][pt] = __builtin_amdgcn_mfma_f32_16x16x32_bf16(xfr[jt][pt >> 1], idf[pt & 1], (f32x4){0.f, 0.f, 0.f, 0.f}, 0, 0, 0) * we;
        }
#pragma unroll
        for (int pt = 0; pt < 4; ++pt) xwf[pt][ks] = pack8(d[0][pt], d[1][pt]);
    }
#pragma unroll 1
    for (int nh = 0; nh < 2; ++nh) {
        f32x4 acc[4][4];
#pragma unroll
        for (int pt = 0; pt < 4; ++pt)
#pragma unroll
            for (int n4 = 0; n4 < 4; ++n4) acc[pt][n4] = (f32x4){0.f, 0.f, 0.f, 0.f};
#pragma unroll
        for (int ks = 0; ks < 4; ++ks)
#pragma unroll
            for (int n4 = 0; n4 < 4; ++n4) {
                const LAS bf16_t* bp = BT + (16 * (4 * nh + n4) + fr) * SLD + 32 * ks + 4 * fq;
                const bf16x8 bb = lds_frag2(bp, bp + 16);
#pragma unroll
                for (int pt = 0; pt < 4; ++pt) acc[pt][n4] = __builtin_amdgcn_mfma_f32_16x16x32_bf16(bb, xwf[pt][ks], acc[pt][n4], 0, 0, 0);
            }
#pragma unroll
        for (int pt = 0; pt < 4; ++pt) {
            float* so = ST + ((((size_t)(b * NCH + ch) * SH + h) * SP + 16 * pt + fr) * SN);
#pragma unroll
            for (int n4 = 0; n4 < 4; ++n4) *(f32x4*)(so + 16 * (4 * nh + n4) + 4 * fq) = acc[pt][n4];
        }
    }
}
DI void ssd_scan_phase(const Ctx& c, int li) {
    float* ST = c.ws<float>(W_ST); const float* DEC = c.ws<float>(W_DEC);
    for (int idx = blockIdx.x * NTHR + c.tid; idx < NB * SH * SP * SN / 4; idx += gridDim.x * NTHR) {
        const int n4 = idx & 31, p = (idx >> 5) & 63, h = (idx >> 11) & 15, b = idx >> 15;
        f32x4 hcur = (f32x4){0.f, 0.f, 0.f, 0.f};
#pragma unroll 8
        for (int ch = 0; ch < NCH; ++ch) {
            f32x4* a = (f32x4*)(ST + ((((size_t)(b * NCH + ch) * SH + h) * SP + p) * SN)) + n4;
            const f32x4 s = *a; const float d = DEC[(size_t)(b * NCH + ch) * SH + h];
            *a = hcur; hcur = hcur * d + s;
        }
        *((f32x4*)(c.p.out + O_PSS + ((((size_t)(li * NB + b) * SH + h) * SP + p) * SN)) + n4) = hcur;
    }
}
DI void ssd_b_item(const Ctx& c, int li, int item) {
    int tid_o = c.tid; asm volatile("" : "+v"(tid_o));
    const int lane_o = tid_o & 63;
    const float* ACT = c.ws<float>(W_ACT); const float* ST = c.ws<float>(W_ST); const bf16_t* PROJ = c.ws<bf16_t>(W_PROJ); bf16_t* MIX = c.ws<bf16_t>(W_MIXED);
    const int g = item & 1, ch = (item >> 1) % NCH, b = item / (2 * NCH), tok0 = b * SEQ + ch * 128;
    LAS bf16_t* CS_ = (LAS bf16_t*)(c.lds + L_C); LAS bf16_t* BS = (LAS bf16_t*)(c.lds + L_B); LAS bf16_t* XT = (LAS bf16_t*)(c.lds + L_XT); LAS bf16_t* HS = (LAS bf16_t*)(c.lds + L_HS);
    const LAS float* csS = (const LAS float*)(c.lds + L_CS); const LAS float* dtS = (const LAS float*)(c.lds + L_DT);
    const int fr = lane_o & 15, fq = lane_o >> 4, w = c.wave, irow = 16 * w + fr;
    __syncthreads();
    ssd_chunk_scalars(c, li, tok0, g);
#pragma unroll
    for (int it = 0; it < 8; ++it) { const int idx = it * NTHR + tid_o, i = idx >> 5, n4 = idx & 31;
        const f32x4 bv = *(const f32x4*)(ACT + (size_t)(tok0 + i) * 4096 + SDI + g * SN + 4 * n4), cv = *(const f32x4*)(ACT + (size_t)(tok0 + i) * 4096 + SDI + SG * SN + g * SN + 4 * n4);
        u32x2 o; o.x = pk2(bv.x, bv.y); o.y = pk2(bv.z, bv.w); *(LAS u32x2*)(BS + i * SLD + 4 * n4) = o;
        o.x = pk2(cv.x, cv.y); o.y = pk2(cv.z, cv.w); *(LAS u32x2*)(CS_ + i * SLD + 4 * n4) = o; }
    __syncthreads();
    f32x4 cb[8];
#pragma unroll
    for (int jt = 0; jt < 8; ++jt) cb[jt] = (f32x4){0.f, 0.f, 0.f, 0.f};
    bf16x8 cfrag[4];
#pragma unroll
    for (int ks = 0; ks < 4; ++ks) cfrag[ks] = lds_frag(CS_ + irow * SLD + 32 * ks + 8 * fq);
#pragma unroll
    for (int jt = 0; jt < 8; ++jt) if (jt <= w) {
#pragma unroll
        for (int ks = 0; ks < 4; ++ks) cb[jt] = __builtin_amdgcn_mfma_f32_16x16x32_bf16(lds_frag(BS + (16 * jt + fr) * SLD + 32 * ks + 8 * fq), cfrag[ks], cb[jt], 0, 0, 0);
    }
    float rowsq = 0.f;
    float xr[16]; f32x4 hr[4];
#pragma unroll
    for (int it = 0; it < 16; ++it) { const int idx = it * NTHR + tid_o, j = idx >> 6, p = idx & 63; xr[it] = ACT[(size_t)(tok0 + j) * 4096 + (8 * g) * SP + p]; }
#pragma unroll
    for (int it = 0; it < 4; ++it) { const int idx = it * NTHR + tid_o, p = idx >> 5, n4 = idx & 31; hr[it] = *((const f32x4*)(ST + ((((size_t)(b * NCH + ch) * SH + 8 * g) * SP + p) * SN)) + n4); }
#pragma unroll 1
    for (int hh = 0; hh < 8; ++hh) {
        const int h = 8 * g + hh; const float Dh = c.in(I_SD)[li * SH + h];
        int tw = tid_o; asm volatile("" : "+v"(tw));
#pragma unroll
        for (int it = 0; it < 16; ++it) { const int idx = it * NTHR + tw, j = idx >> 6, p = idx & 63; XT[p * SLD + j] = f2bf(xr[it]); }
#pragma unroll
        for (int it = 0; it < 4; ++it) { const int idx = it * NTHR + tw, p = idx >> 5, n4 = idx & 31; const f32x4 v = hr[it];
            u32x2 o; o.x = pk2(v.x, v.y); o.y = pk2(v.z, v.w); *(LAS u32x2*)(HS + p * SLD + 4 * n4) = o; }
        __syncthreads();
        if (hh + 1 < 8) {
            int tq = tid_o; asm volatile("" : "+v"(tq));
#pragma unroll
            for (int it = 0; it < 16; ++it) { const int idx = it * NTHR + tq, j = idx >> 6, p = idx & 63; xr[it] = ACT[(size_t)(tok0 + j) * 4096 + (h + 1) * SP + p]; }
#pragma unroll
            for (int it = 0; it < 4; ++it) { const int idx = it * NTHR + tq, p = idx >> 5, n4 = idx & 31; hr[it] = *((const f32x4*)(ST + ((((size_t)(b * NCH + ch) * SH + h + 1) * SP + p) * SN)) + n4); }
        }
        const float csi = csS[irow * 8 + hh];
        f32x4 xv4[4]; u32x2 zz4[4];
#pragma unroll
        for (int pt = 0; pt < 4; ++pt) { const int col = h * SP + 16 * pt + 4 * fq; xv4[pt] = *(const f32x4*)(ACT + (size_t)(tok0 + irow) * 4096 + col); zz4[pt] = *(const u32x2*)(PROJ + (size_t)(tok0 + irow) * HYB_MAIN + 1536 + col); }
        f32x4 ay[4], ah[4];
#pragma unroll
        for (int pt = 0; pt < 4; ++pt) { ay[pt] = (f32x4){0.f, 0.f, 0.f, 0.f}; ah[pt] = (f32x4){0.f, 0.f, 0.f, 0.f}; }
#pragma unroll
        for (int ks = 0; ks < 4; ++ks) {
#pragma unroll
            for (int pt = 0; pt < 4; ++pt) ah[pt] = __builtin_amdgcn_mfma_f32_16x16x32_bf16(lds_frag(HS + (16 * pt + fr) * SLD + 32 * ks + 8 * fq), cfrag[ks], ah[pt], 0, 0, 0);
            if (2 * ks <= w) {
                float mv[8];
#pragma unroll
                for (int e = 0; e < 8; ++e) {
                    const int j = 32 * ks + (e < 4 ? 4 * fq + e : 16 + 4 * fq + (e - 4));
                    const float cbv = e < 4 ? cb[2 * ks][e] : cb[2 * ks + 1][e - 4];
                    const float csj = *(const volatile LAS float*)(csS + j * 8 + hh), dtj = *(const volatile LAS float*)(dtS + j * 8 + hh);
                    mv[e] = j <= irow ? cbv * __expf(csi - csj) * dtj : 0.f;
                }
                u32x4 mp; mp.x = pk2(mv[0], mv[1]); mp.y = pk2(mv[2], mv[3]); mp.z = pk2(mv[4], mv[5]); mp.w = pk2(mv[6], mv[7]);
                const bf16x8 mfrag = __builtin_bit_cast(bf16x8, mp);
#pragma unroll
                for (int pt = 0; pt < 4; ++pt) ay[pt] = __builtin_amdgcn_mfma_f32_16x16x32_bf16(lds_frag2(XT + (16 * pt + fr) * SLD + 32 * ks + 4 * fq, XT + (16 * pt + fr) * SLD + 32 * ks + 16 + 4 * fq), mfrag, ay[pt], 0, 0, 0);
            }
        }
        const float ei = __expf(csi);
#pragma unroll
        for (int pt = 0; pt < 4; ++pt) {
            const int col = h * SP + 16 * pt + 4 * fq;
            const f32x4 xv = xv4[pt]; const u32x2 zz = zz4[pt];
            const float z0 = bf2f((bf16_t)(zz.x & 0xffff)), z1 = bf2f((bf16_t)(zz.x >> 16)), z2 = bf2f((bf16_t)(zz.y & 0xffff)), z3 = bf2f((bf16_t)(zz.y >> 16));
            const float y0 = (ay[pt][0] + ei * ah[pt][0] + Dh * xv.x) * siluf(z0), y1 = (ay[pt][1] + ei * ah[pt][1] + Dh * xv.y) * siluf(z1);
            const float y2 = (ay[pt][2] + ei * ah[pt][2] + Dh * xv.z) * siluf(z2), y3 = (ay[pt][3] + ei * ah[pt][3] + Dh * xv.w) * siluf(z3);
            rowsq += y0 * y0 + y1 * y1 + y2 * y2 + y3 * y3;
            u32x2 o; o.x = pk2(y0, y1); o.y = pk2(y2, y3); *(u32x2*)(MIX + (size_t)(tok0 + irow) * HYB_MIX + AW + col) = o;
        }
        __syncthreads();
    }
    rowsq += __shfl_xor(rowsq, 16); rowsq += __shfl_xor(rowsq, 32);
    const float rn = rsqrtf(rowsq * (1.f / 512.f) + EPS);
    const float* nw = c.in(I_SNW) + (size_t)li * SDI + g * 512;
    asm volatile("s_waitcnt vmcnt(0)" ::: "memory");
    bf16_t* mrow = MIX + (size_t)(tok0 + irow) * HYB_MIX + AW + g * 512 + fq * 128;
#pragma unroll 4
    for (int cc = 0; cc < 16; ++cc) {
        const u32x4 v = *(const u32x4*)(mrow + 8 * cc); const float* wv = nw + fq * 128 + 8 * cc; u32x4 o;
        o.x = pk2(bf2f((bf16_t)(v.x & 0xffff)) * rn * wv[0], bf2f((bf16_t)(v.x >> 16)) * rn * wv[1]); o.y = pk2(bf2f((bf16_t)(v.y & 0xffff)) * rn * wv[2], bf2f((bf16_t)(v.y >> 16)) * rn * wv[3]);
        o.z = pk2(bf2f((bf16_t)(v.z & 0xffff)) * rn * wv[4], bf2f((bf16_t)(v.z >> 16)) * rn * wv[5]); o.w = pk2(bf2f((bf16_t)(v.w & 0xffff)) * rn * wv[6], bf2f((bf16_t)(v.w >> 16)) * rn * wv[7]);
        *(u32x4*)(mrow + 8 * cc) = o;
    }
}

DI void gdn_pre_token(const Ctx& c, int li, int tok) {
    const bf16_t* PROJ = c.ws<bf16_t>(W_PROJ); bf16_t* ACTB = c.ws<bf16_t>(W_ACT); float* AUX = c.ws<float>(W_AUX); const float* EX = c.ws<float>(W_EXTRA);
    const int lane = c.lane; const bool smp = tok >= T; const int b = smp ? tok - T : tok / SEQ, s = smp ? 0 : tok % SEQ;
    const float* cw = c.in(I_GCW) + (size_t)li * 4 * GQKV;
    const float* st = c.in(I_GCONV) + (size_t)(li * NS + b) * 3 * GQKV;
    const bf16_t* prow = PROJ + (size_t)tok * GDN_MAIN;
#pragma unroll 1
    for (int it = 0; it < 8; ++it) {
        const int ch0 = 512 * it + 8 * lane; float x1[8], x2[8], x3[8], y[8];
        conv8(prow, GDN_MAIN, st, GQKV, cw, ch0, smp, s, x1, x2, x3, y);
        float ss = 0.f;
#pragma unroll
        for (int e = 0; e < 8; ++e) { y[e] = siluf(y[e]); ss += y[e] * y[e]; }
        if (it < 4) {
            ss += __shfl_xor(ss, 1); ss += __shfl_xor(ss, 2); ss += __shfl_xor(ss, 4); ss += __shfl_xor(ss, 8);
            const float r = rsqrtf(ss + EPS) * (it < 2 ? 0.08838834764831845f : 1.f);
#pragma unroll
            for (int e = 0; e < 8; ++e) y[e] *= r;
        }
        { u32x4 o; o.x = pk2(y[0], y[1]); o.y = pk2(y[2], y[3]); o.z = pk2(y[4], y[5]); o.w = pk2(y[6], y[7]); *(u32x4*)(ACTB + (size_t)tok * 4096 + ch0) = o; }
        if (smp) { float* o = c.p.out + O_SGC + (size_t)(li * NS + b) * 3 * GQKV + ch0; store8f(o, x1); store8f(o + GQKV, x2); store8f(o + 2 * GQKV, x3); }
        else if (s >= SEQ - 3) store8f(c.p.out + O_PGC + ((size_t)(li * NB + b) * 3 + (s - (SEQ - 3))) * GQKV + ch0, x3);
    }
    if (lane < GH) {
        AUX[(size_t)tok * 32 + lane] = sigmoidf_(EX[(size_t)tok * 32 + lane]);
        AUX[(size_t)tok * 32 + 16 + lane] = -__expf(c.in(I_GALOG)[li * GH + lane]) * softplusf_(EX[(size_t)tok * 32 + 16 + lane] + c.in(I_GDTB)[li * GH + lane]);
    }
}
DI void gdn_pre_range(const Ctx& c, int li, int item) {
    const bf16_t* PROJ = c.ws<bf16_t>(W_PROJ); bf16_t* ACTB = c.ws<bf16_t>(W_ACT); float* AUX = c.ws<float>(W_AUX); const float* EX = c.ws<float>(W_EXTRA);
    int lane_ = c.lane; asm volatile("" : "+v"(lane_));
    const int lane = lane_, it = item & 7, rg = item >> 3, tok0 = rg * 64, b = tok0 / SEQ, s0 = tok0 % SEQ, ch0 = 512 * it + 8 * lane;
    const float* cw = c.in(I_GCW) + (size_t)li * 4 * GQKV;
    float w0[8], w1[8], w2[8], w3[8], xa[8], xb[8], xc[8];
    load8f(cw + ch0, w0); load8f(cw + GQKV + ch0, w1); load8f(cw + 2 * GQKV + ch0, w2); load8f(cw + 3 * GQKV + ch0, w3);
    const bf16_t* prow = PROJ + (size_t)tok0 * GDN_MAIN + ch0;
    const u32x4 z4 = (u32x4){0u, 0u, 0u, 0u};
    unpack8(s0 >= 3 ? *(const u32x4*)(prow - 3 * GDN_MAIN) : z4, xa); unpack8(s0 >= 2 ? *(const u32x4*)(prow - 2 * GDN_MAIN) : z4, xb); unpack8(s0 >= 1 ? *(const u32x4*)(prow - GDN_MAIN) : z4, xc);
    const float qscale = it < 2 ? 0.08838834764831845f : 1.f;
    {
        const int col = lane & 31; const bool isg = col >= 16;
        const float gal = isg ? -__expf(c.in(I_GALOG)[li * GH + col - 16]) : 0.f, gdb = isg ? c.in(I_GDTB)[li * GH + col - 16] : 0.f;
#pragma unroll
        for (int k = 0; k < 4; ++k) { const int tok = tok0 + 8 * it + 2 * k + (lane >> 5); const float ev = EX[(size_t)tok * 32 + col];
            AUX[(size_t)tok * 32 + col] = isg ? gal * softplusf_(ev + gdb) : sigmoidf_(ev); }
    }
    u32x4 rawn[16];
#pragma unroll
    for (int j = 0; j < 16; ++j) rawn[j] = *(const u32x4*)(prow + (size_t)j * GDN_MAIN);
#pragma unroll 1
    for (int tb = 0; tb < 64; tb += 16) {
        u32x4 raw[16];
#pragma unroll
        for (int j = 0; j < 16; ++j) raw[j] = rawn[j];
        if (tb + 16 < 64) {
#pragma unroll
            for (int j = 0; j < 16; ++j) rawn[j] = *(const u32x4*)(prow + (size_t)(tb + 16 + j) * GDN_MAIN);
        }
#pragma unroll
        for (int j = 0; j < 16; ++j) {
            const int t = tb + j;
            float xd[8], y[8];
            unpack8(raw[j], xd);
            float ss = 0.f;
#pragma unroll
            for (int e = 0; e < 8; ++e) { y[e] = siluf(xa[e] * w0[e] + xb[e] * w1[e] + xc[e] * w2[e] + xd[e] * w3[e]); ss += y[e] * y[e]; }
            if (it < 4) {
                ss += __shfl_xor(ss, 1); ss += __shfl_xor(ss, 2); ss += __shfl_xor(ss, 4); ss += __shfl_xor(ss, 8);
                const float r = rsqrtf(ss + EPS) * qscale;
#pragma unroll
                for (int e = 0; e < 8; ++e) y[e] *= r;
            }
            { u32x4 o; o.x = pk2(y[0], y[1]); o.y = pk2(y[2], y[3]); o.z = pk2(y[4], y[5]); o.w = pk2(y[6], y[7]); *(u32x4*)(ACTB + (size_t)(tok0 + t) * 4096 + ch0) = o; }
            if (s0 + t >= SEQ - 3) store8f(c.p.out + O_PGC + ((size_t)(li * NB + b) * 3 + (s0 + t - (SEQ - 3))) * GQKV + ch0, xd);
#pragma unroll
            for (int e = 0; e < 8; ++e) { xa[e] = xb[e]; xb[e] = xc[e]; xc[e] = xd[e]; }
        }
    }
}
DI void gdn_seq_phase(const Ctx& c, int li, int first_item, int wg, int nwg) {
    const bf16_t* ACTB = c.ws<bf16_t>(W_ACT); const float* AUX = c.ws<float>(W_AUX); bf16_t* MIX = c.ws<bf16_t>(W_MIXED); const bf16_t* PROJ = c.ws<bf16_t>(W_PROJ);
    LAS float* red = (LAS float*)c.lds + 1024;
    const int slot = c.tid >> 8, t8 = c.tid & 255, col = t8 >> 1, half = t8 & 1;
    LAS float* kq = (LAS float*)c.lds + slot * 512;
    const int nslot = nwg * 2;
    for (int base = first_item; base < NB * GH + NS * GH; base += nslot) {
        const int item = base + wg * 2 + slot;
        const bool wg_prompt = (base + wg * 2) < NB * GH;
        const int L = wg_prompt ? SEQ : 1;
        const bool valid = item < NB * GH + NS * GH;
        const bool smp = item >= NB * GH; const int it = smp ? item - NB * GH : item;
        const int seq = valid ? it / GH : 0, vh = valid ? it % GH : 0, hq = vh >> 1;
        const int tok0 = smp ? T + seq : seq * SEQ;
        float S[64];
        if (valid && smp) { const float* s0 = c.in(I_GST) + ((size_t)(li * NS + seq) * GH + vh) * GDK * GDV + (size_t)(64 * half) * GDV + col;
#pragma unroll
            for (int k = 0; k < 64; ++k) S[k] = s0[(size_t)k * GDV]; }
        else {
#pragma unroll
            for (int k = 0; k < 64; ++k) S[k] = 0.f; }
        __syncthreads();
        for (int t = 0; t < L; ++t) {
            LAS float* cur = kq + (t & 1) * 256;
            const bf16_t* a = ACTB + (size_t)(tok0 + t) * 4096;
            cur[t8] = bf2f(a[(t8 < 128 ? 1024 : -128) + hq * 128 + t8]);
            const float vv = bf2f(a[2048 + vh * 128 + col]), beta = AUX[(size_t)(tok0 + t) * 32 + vh], eg = __expf(AUX[(size_t)(tok0 + t) * 32 + 16 + vh]);
            __syncthreads();
            const LAS float* kk = cur + 64 * half; const LAS float* qq = cur + 128 + 64 * half;
            float ks = 0.f;
#pragma unroll
            for (int k = 0; k < 64; k += 4) { const f32x4 kv = *(const LAS f32x4*)(kk + k); ks += kv.x * S[k] + kv.y * S[k + 1] + kv.z * S[k + 2] + kv.w * S[k + 3]; }
            ks += __shfl_xor(ks, 1);
            const float u = beta * (vv - eg * ks);
            asm volatile("" ::: "memory");
            float o = 0.f;
#pragma unroll
            for (int k = 0; k < 64; k += 4) { const f32x4 kv = *(const LAS f32x4*)(kk + k); const f32x4 qv = *(const LAS f32x4*)(qq + k);
                S[k] = eg * S[k] + kv.x * u; S[k + 1] = eg * S[k + 1] + kv.y * u; S[k + 2] = eg * S[k + 2] + kv.z * u; S[k + 3] = eg * S[k + 3] + kv.w * u;
                o += qv.x * S[k] + qv.y * S[k + 1] + qv.z * S[k + 2] + qv.w * S[k + 3]; }
            o += __shfl_xor(o, 1);
            { const float sq = wave_sum(half == 0 ? o * o : 0.f); if (c.lane == 0) red[slot * 4 + ((c.tid >> 6) & 3)] = sq; }
            __syncthreads();
            if (valid && half == 0) { const float tot = red[slot * 4] + red[slot * 4 + 1] + red[slot * 4 + 2] + red[slot * 4 + 3];
                const float z = bf2f(PROJ[(size_t)(tok0 + t) * GDN_MAIN + 4096 + vh * 128 + col]);
                MIX[(size_t)(tok0 + t) * GVW + vh * 128 + col] = f2bf(o * rsqrtf(tot * (1.f / 128.f) + EPS) * c.in(I_GNW)[li * GDV + col] * siluf(z)); }
        }
        if (valid) { float* so = (smp ? c.p.out + O_SGS + ((size_t)(li * NS + seq) * GH + vh) * GDK * GDV : c.p.out + O_PGS + ((size_t)(li * NB + seq) * GH + vh) * GDK * GDV) + (size_t)(64 * half) * GDV + col;
#pragma unroll
            for (int k = 0; k < 64; ++k) so[(size_t)k * GDV] = S[k]; }
        __syncthreads();
    }
}

constexpr size_t W_KCD = W_GO;
constexpr size_t W_U0 = W_HID;
constexpr size_t W_GC = W_HID + (size_t)67108864;
constexpr size_t W_E1 = W_GC + (size_t)T * 16 * 4;
constexpr size_t W_E2 = W_E1 + (size_t)T * 16 * 4;
constexpr size_t W_SS = W_E2 + (size_t)T * 16 * 4;
constexpr size_t W_QB = W_H;
constexpr size_t W_ATTG = W_Y;
constexpr size_t W_KT = W_Y + (size_t)33554432;
constexpr int GA_LDS = 20000;
constexpr int GCH = SEQ / 64;


DI void gdn_a_item(const Ctx& c, int li, int item) {
    const bf16_t* ACTB = c.ws<bf16_t>(W_ACT); const float* AUX = c.ws<float>(W_AUX);
    const int ch = item & (GCH - 1), vh = (item >> 6) & 15, b = item >> 10, hq = vh >> 1, tok0 = b * SEQ + ch * 64;
    int lane_ = c.lane; asm volatile("" : "+v"(lane_));
    const int lane = lane_, fr = lane & 15, fq = lane >> 4;
    LAS unsigned char* wl = c.lds + c.wave * GA_LDS;
    LAS float* As = (LAS float*)wl; LAS bf16_t* Ts = (LAS bf16_t*)wl; LAS bf16_t* KsT = (LAS bf16_t*)wl;
    LAS float* gcS = (LAS float*)(wl + 17408); LAS float* btS = gcS + 64; LAS float* beS = gcS + 128;
    bf16_t* KCDg = c.ws<bf16_t>(W_KCD) + (size_t)item * 8192; bf16_t* ATTg = c.ws<bf16_t>(W_ATTG) + (size_t)item * 4096; bf16_t* U0g = c.ws<bf16_t>(W_U0) + (size_t)item * 8192;
    const int qitem = (b * GQH + hq) * GCH + ch;
    { const float gi = AUX[(size_t)(tok0 + lane) * 32 + 16 + vh], bi = AUX[(size_t)(tok0 + lane) * 32 + vh];
      float gc = gi;
#pragma unroll
      for (int o = 1; o < 64; o <<= 1) { const float t = __shfl_up(gc, o); if (lane >= o) gc += t; }
      const float e1 = __expf(gc), gl_ = __shfl(gc, 63);
      gcS[lane] = gc; btS[lane] = bi; beS[lane] = bi * e1; c.ws<float>(W_GC)[(size_t)(tok0 + lane) * 16 + vh] = gc;
      c.ws<float>(W_E1)[(size_t)(tok0 + lane) * 16 + vh] = e1; c.ws<float>(W_E2)[(size_t)(tok0 + lane) * 16 + vh] = __expf(gl_ - gc); }
    LDS_WAIT();
    {
        bf16x8 kf[4][4], qfa[4][4];
#pragma unroll
        for (int t = 0; t < 4; ++t)
#pragma unroll
            for (int ks = 0; ks < 4; ++ks) { const bf16_t* rp = ACTB + (size_t)(tok0 + 16 * t + fr) * 4096 + hq * 128 + 32 * ks + 8 * fq; kf[t][ks] = *(const bf16x8*)(rp + 1024); qfa[t][ks] = *(const bf16x8*)rp; }
#pragma unroll
        for (int it = 0; it < 4; ++it) {
            const int i = 16 * it + fr; const float gci = gcS[i], bti = btS[i];
#pragma unroll
            for (int jt = 0; jt < 4; ++jt) {
                bf16_t* ap = ATTg + (unsigned)(i * 64 + 16 * jt + 4 * fq);
                if (jt > it) { *(unsigned long long*)ap = 0ull; continue; }
                f32x4 kk = (f32x4){0.f, 0.f, 0.f, 0.f}, qk = (f32x4){0.f, 0.f, 0.f, 0.f};
#pragma unroll
                for (int ks = 0; ks < 4; ++ks) { kk = __builtin_amdgcn_mfma_f32_16x16x32_bf16(kf[jt][ks], kf[it][ks], kk, 0, 0, 0); qk = __builtin_amdgcn_mfma_f32_16x16x32_bf16(kf[jt][ks], qfa[it][ks], qk, 0, 0, 0); }
                f32x4 av, tv;
#pragma unroll
                for (int r = 0; r < 4; ++r) { const int j = 16 * jt + 4 * fq + r; const float dec = __expf(gci - gcS[j]); av[r] = j < i ? bti * kk[r] * dec : 0.f; tv[r] = j <= i ? qk[r] * dec : 0.f; }
                *(LAS f32x4*)(As + i * 64 + 16 * jt + 4 * fq) = av;
                *(unsigned long long*)ap = (unsigned long long)pk2(tv[0], tv[1]) | ((unsigned long long)pk2(tv[2], tv[3]) << 32);
            }
        }
    }
    LDS_WAIT();
    float Tr[64];
#pragma unroll
    for (int i = 0; i < 64; ++i) {
        float acc = lane == i ? 1.f : 0.f;
#pragma unroll
        for (int j = 0; j < i; ++j) acc -= As[i * 64 + j] * Tr[j];
        Tr[i] = acc;
    }
    LDS_WAIT();
#pragma unroll
    for (int i = 0; i < 64; ++i) Ts[i * 72 + lane] = f2bf(Tr[i]);
    LDS_WAIT();
    {
        bf16x8 tfp[4][2], idf[2];
#pragma unroll
        for (int it = 0; it < 4; ++it)
#pragma unroll
            for (int ks = 0; ks < 2; ++ks) tfp[it][ks] = lds_frag2(Ts + (16 * it + fr) * 72 + 32 * ks + 4 * fq, Ts + (16 * it + fr) * 72 + 32 * ks + 16 + 4 * fq);
#pragma unroll
        for (int hs = 0; hs < 2; ++hs)
#pragma unroll
            for (int e = 0; e < 8; ++e) idf[hs][e] = (8 * fq + e) == (16 * hs + fr) ? (short)0x3F80 : (short)0;
        bf16_t* KTg = c.ws<bf16_t>(W_KT) + (size_t)qitem * 8192;
        const bool wr_k = (vh & 1) == 0;
        const bf16_t* AK = ACTB + (size_t)tok0 * 4096 + 1024 + hq * 128; const bf16_t* AV = ACTB + (size_t)tok0 * 4096 + 2048 + vh * 128;
        bf16x8 vfn[4], kfn[4];
#pragma unroll
        for (int t = 0; t < 4; ++t) { vfn[t] = *(const bf16x8*)(AV + (size_t)(16 * t + fr) * 4096 + 8 * fq); kfn[t] = *(const bf16x8*)(AK + (size_t)(16 * t + fr) * 4096 + 8 * fq); }
#pragma unroll 1
        for (int cc = 0; cc < 4; ++cc) {
            bf16x8 vf[4], kf2[4];
#pragma unroll
            for (int t = 0; t < 4; ++t) { vf[t] = vfn[t]; kf2[t] = kfn[t]; }
            if (cc + 1 < 4) {
#pragma unroll
                for (int t = 0; t < 4; ++t) { vfn[t] = *(const bf16x8*)(AV + (size_t)(16 * t + fr) * 4096 + 32 * (cc + 1) + 8 * fq); kfn[t] = *(const bf16x8*)(AK + (size_t)(16 * t + fr) * 4096 + 32 * (cc + 1) + 8 * fq); }
            }
#pragma unroll
            for (int hs = 0; hs < 2; ++hs) {
                const int nt = 2 * cc + hs;
                f32x4 dvv[4], dkk[4];
#pragma unroll
                for (int t = 0; t < 4; ++t) {
                    const f32x4 z = (f32x4){0.f, 0.f, 0.f, 0.f};
                    dvv[t] = __builtin_amdgcn_mfma_f32_16x16x32_bf16(vf[t], idf[hs], z, 0, 0, 0);
                    dkk[t] = __builtin_amdgcn_mfma_f32_16x16x32_bf16(kf2[t], idf[hs], z, 0, 0, 0);
                    if (wr_k) *(unsigned long long*)(KTg + (unsigned)((16 * nt + fr) * 64 + 16 * t + 4 * fq)) = (unsigned long long)pk2(dkk[t][0], dkk[t][1]) | ((unsigned long long)pk2(dkk[t][2], dkk[t][3]) << 32);
                    const f32x4 bt = *(const LAS f32x4*)(btS + 16 * t + 4 * fq), be = *(const LAS f32x4*)(beS + 16 * t + 4 * fq);
                    dvv[t] *= bt; dkk[t] *= be;
                }
                f32x4 au[4], ak[4];
#pragma unroll
                for (int it = 0; it < 4; ++it) { au[it] = (f32x4){0.f, 0.f, 0.f, 0.f}; ak[it] = (f32x4){0.f, 0.f, 0.f, 0.f}; }
#pragma unroll
                for (int ks = 0; ks < 2; ++ks) {
                    const bf16x8 vfrag = pack8(dvv[2 * ks], dvv[2 * ks + 1]), kfrag = pack8(dkk[2 * ks], dkk[2 * ks + 1]);
#pragma unroll
                    for (int it = 0; it < 4; ++it) { au[it] = __builtin_amdgcn_mfma_f32_16x16x32_bf16(tfp[it][ks], vfrag, au[it], 0, 0, 0);
                                                     ak[it] = __builtin_amdgcn_mfma_f32_16x16x32_bf16(kfrag, tfp[it][ks], ak[it], 0, 0, 0); }
                }
#pragma unroll
                for (int it = 0; it < 4; ++it) {
                    *(unsigned long long*)(U0g + (unsigned)(((nt * 4 + it) * 64 + lane) * 4)) = (unsigned long long)pk2(au[it][0], au[it][1]) | ((unsigned long long)pk2(au[it][2], au[it][3]) << 32);
                    *(unsigned long long*)(KCDg + (unsigned)((16 * it + fr) * 128 + 16 * nt + 4 * fq)) = (unsigned long long)pk2(ak[it][0], ak[it][1]) | ((unsigned long long)pk2(ak[it][2], ak[it][3]) << 32);
                }
            }
        }
    }
    LDS_WAIT();
}

constexpr int GS_KCD = 0, GS_QB = 17408, GS_ATT = 34816, GS_KT = 44032, GS_GC = 62464, GS_BUF = 62720;
DI bf16x8 fragA(const LAS unsigned char* p) { const u32x2 x = *(const volatile LAS u32x2*)p, y = *(const volatile LAS u32x2*)(p + 128);     u32x4 r; r.x = x.x; r.y = x.y; r.z = y.x; r.w = y.y; return __builtin_bit_cast(bf16x8, r); }
DI bf16x8 fragB(const LAS unsigned char* p) { const u32x2 x = *(const volatile LAS u32x2*)p, y = *(const volatile LAS u32x2*)(p + 256); u32x4 r; r.x = x.x; r.y = x.y; r.z = y.x; r.w = y.y; return __builtin_bit_cast(bf16x8, r); }
DI void gdn_scan_wg(const Ctx& c, int li, int bvh) {
    const int vh = bvh & 15, b = bvh >> 4, hq = vh >> 1, lane = c.lane, fr = lane & 15, fq = lane >> 4, w = c.wave, tid = c.tid;
    const bf16_t* KCDg = c.ws<bf16_t>(W_KCD) + (size_t)(bvh * GCH) * 8192; const bf16_t* ATTg = c.ws<bf16_t>(W_ATTG) + (size_t)(bvh * GCH) * 4096;
    const bf16_t* U0g = c.ws<bf16_t>(W_U0) + (size_t)(bvh * GCH) * 8192;
    const bf16_t* QBg = c.ws<bf16_t>(W_ACT) + (size_t)(b * SEQ) * 4096 + hq * 128; const bf16_t* KTg = c.ws<bf16_t>(W_KT) + (size_t)((b * GQH + hq) * GCH) * 8192;
    const float* GCg = c.ws<float>(W_GC); bf16_t* MIX = c.ws<bf16_t>(W_MIXED); const bf16_t* PROJ = c.ws<bf16_t>(W_PROJ);
    LAS float* OT = (LAS float*)(c.lds + 2 * GS_BUF);
    LAS float* nwS = OT + 64 * 132;
    if (tid < GDV) nwS[tid] = c.in(I_GNW)[li * GDV + tid];
#define GS_DMA(tn, bb) do { \
        LAS unsigned char* lb_ = c.lds + (bb) * GS_BUF; \
        _Pragma("unroll") for (int k = 0; k < 2; ++k) { const int p_ = 8 * k + w; \
            __builtin_amdgcn_global_load_lds((const unsigned*)(KCDg + (size_t)(tn) * 8192 + p_ * 512 + srcA), (LAS unsigned*)(lb_ + GS_KCD + p_ * 1088), 16, 0, 0); \
            __builtin_amdgcn_global_load_lds((const unsigned*)(QBg + (size_t)(tn) * (64 * 4096) + p_ * (4 * 4096) + srcQ), (LAS unsigned*)(lb_ + GS_QB + p_ * 1088), 16, 0, 0); \
            __builtin_amdgcn_global_load_lds((const unsigned*)(KTg + (size_t)(tn) * 8192 + p_ * 512 + srcB), (LAS unsigned*)(lb_ + GS_KT + p_ * 1152), 16, 0, 0); } \
        __builtin_amdgcn_global_load_lds((const unsigned*)(ATTg + (size_t)(tn) * 4096 + w * 512 + srcB), (LAS unsigned*)(lb_ + GS_ATT + w * 1152), 16, 0, 0); } while (0)
    const int srcA = (lane & 3) * 128 + 8 * (lane >> 2), srcQ = (lane & 3) * 4096 + 8 * (lane >> 2), srcB = (lane & 7) * 64 + 8 * (lane >> 3);
    const int offA = (fr >> 2) * 1088 + (fr & 3) * 16 + (fq >> 1) * 64 + 8 * (fq & 1), offB = (fr >> 3) * 1152 + (fr & 7) * 16 + (fq >> 1) * 128 + 8 * (fq & 1);
    f32x4 sacc[8];
#pragma unroll
    for (int t = 0; t < 8; ++t) sacc[t] = (f32x4){0.f, 0.f, 0.f, 0.f};
    __syncthreads();
    u32x2 u0n[4];
#pragma unroll
    for (int it = 0; it < 4; ++it) u0n[it] = *(const u32x2*)(U0g + ((size_t)(w * 4 + it) * 64 + lane) * 4);
    GS_DMA(0, 0);
    if (tid < 64) *(LAS float*)(c.lds + GS_GC + 4 * tid) = GCg[(size_t)(b * SEQ + tid) * 16 + vh];
    asm volatile("s_waitcnt vmcnt(0)" ::: "memory");
    __syncthreads();
#pragma unroll 1
    for (int t = 0; t < GCH; ++t) {
        const LAS unsigned char* buf = c.lds + (t & 1) * GS_BUF; LAS unsigned char* nbuf = c.lds + ((t + 1) & 1) * GS_BUF;
        const int tok0 = b * SEQ + t * 64;
        const bool more = t + 1 < GCH;
        u32x2 u0r[4];
#pragma unroll
        for (int it = 0; it < 4; ++it) u0r[it] = u0n[it];
        float gstg = 0.f;
        if (more) {
#pragma unroll
            for (int it = 0; it < 4; ++it) u0n[it] = *(const u32x2*)(U0g + (size_t)(t + 1) * 8192 + ((size_t)(w * 4 + it) * 64 + lane) * 4);
            if (tid < 64) gstg = GCg[(size_t)(tok0 + 64 + tid) * 16 + vh];
            GS_DMA(t + 1, (t + 1) & 1);
        }
        const LAS unsigned char* KCD = buf + GS_KCD; const LAS unsigned char* QB = buf + GS_QB; const LAS unsigned char* ATT = buf + GS_ATT; const LAS unsigned char* KT = buf + GS_KT;
        const LAS float* gcS = (const LAS float*)(buf + GS_GC);
        bf16x8 sfrag[4];
#pragma unroll
        for (int ks = 0; ks < 4; ++ks) sfrag[ks] = pack8(sacc[2 * ks], sacc[2 * ks + 1]);
        const float gl = gcS[63], egl = __expf(gl);
        bf16x8 ufrag[2], udfrag[2]; f32x4 ov[4];
#pragma unroll
        for (int hp = 0; hp < 2; ++hp) {
            f32x4 uu[2];
#pragma unroll
            for (int h2 = 0; h2 < 2; ++h2) {
                const int it = 2 * hp + h2;
                f32x4 ks_ = (f32x4){0.f, 0.f, 0.f, 0.f}, qs_ = (f32x4){0.f, 0.f, 0.f, 0.f};
#pragma unroll
                for (int ks = 0; ks < 4; ++ks) {
                    ks_ = __builtin_amdgcn_mfma_f32_16x16x32_bf16(fragA(KCD + offA + it * 4352 + ks * 256), sfrag[ks], ks_, 0, 0, 0);
                    qs_ = __builtin_amdgcn_mfma_f32_16x16x32_bf16(fragA(QB + offA + it * 4352 + ks * 256), sfrag[ks], qs_, 0, 0, 0);
                }
                const f32x4 gci = *(const LAS f32x4*)(gcS + 16 * it + 4 * fq);
                f32x4 u;
                u[0] = bf2f((bf16_t)(u0r[it].x & 0xffff)) - ks_[0]; u[1] = bf2f((bf16_t)(u0r[it].x >> 16)) - ks_[1]; u[2] = bf2f((bf16_t)(u0r[it].y & 0xffff)) - ks_[2]; u[3] = bf2f((bf16_t)(u0r[it].y >> 16)) - ks_[3];
                uu[h2] = u;
#pragma unroll
                for (int r = 0; r < 4; ++r) ov[it][r] = qs_[r] * __expf(gci[r]);
            }
            ufrag[hp] = pack8(uu[0], uu[1]);
            const f32x4 g0 = *(const LAS f32x4*)(gcS + 32 * hp + 4 * fq), g1 = *(const LAS f32x4*)(gcS + 32 * hp + 16 + 4 * fq);
            f32x4 d0, d1;
#pragma unroll
            for (int r = 0; r < 4; ++r) { d0[r] = uu[0][r] * __expf(gl - g0[r]); d1[r] = uu[1][r] * __expf(gl - g1[r]); }
            udfrag[hp] = pack8(d0, d1);
        }
#pragma unroll
        for (int it = 0; it < 4; ++it) {
            f32x4 au = ov[it];
#pragma unroll
            for (int ks = 0; ks < 2; ++ks) au = __builtin_amdgcn_mfma_f32_16x16x32_bf16(fragB(ATT + offB + it * 2304 + ks * 512), ufrag[ks], au, 0, 0, 0);
#pragma unroll
            for (int r = 0; r < 4; ++r) OT[(16 * it + 4 * fq + r) * 132 + 16 * w + fr] = au[r];
        }
        LDS_WAIT(); __builtin_amdgcn_s_barrier(); asm volatile("" ::: "memory");
        const int frow = tid >> 3, fc = tid & 7;
        const u32x4 zlo = *(const u32x4*)(PROJ + (size_t)(tok0 + frow) * GDN_MAIN + 4096 + vh * 128 + 16 * fc), zhi = *(const u32x4*)(PROJ + (size_t)(tok0 + frow) * GDN_MAIN + 4096 + vh * 128 + 16 * fc + 8);
#pragma unroll
        for (int tt = 0; tt < 8; ++tt) {
            f32x4 a = sacc[tt] * egl;
#pragma unroll
            for (int ks = 0; ks < 2; ++ks) a = __builtin_amdgcn_mfma_f32_16x16x32_bf16(fragB(KT + offB + tt * 2304 + ks * 512), udfrag[ks], a, 0, 0, 0);
            sacc[tt] = a;
        }
        {
            float ov16[16], zf[16];
#pragma unroll
            for (int q4 = 0; q4 < 4; ++q4) { const f32x4 v = *(const LAS f32x4*)(OT + frow * 132 + 16 * fc + 4 * q4); ov16[4 * q4] = v.x; ov16[4 * q4 + 1] = v.y; ov16[4 * q4 + 2] = v.z; ov16[4 * q4 + 3] = v.w; }
            float ss = 0.f;
#pragma unroll
            for (int e = 0; e < 16; ++e) ss += ov16[e] * ov16[e];
            ss += __shfl_xor(ss, 1); ss += __shfl_xor(ss, 2); ss += __shfl_xor(ss, 4);
            const float rn = rsqrtf(ss * (1.f / 128.f) + EPS);
            unpack8(zlo, zf); unpack8(zhi, zf + 8);
            float res[16];
#pragma unroll
            for (int e = 0; e < 16; ++e) res[e] = ov16[e] * rn * nwS[16 * fc + e] * siluf(zf[e]);
            u32x4 o0, o1; o0.x = pk2(res[0], res[1]); o0.y = pk2(res[2], res[3]); o0.z = pk2(res[4], res[5]); o0.w = pk2(res[6], res[7]);
            o1.x = pk2(res[8], res[9]); o1.y = pk2(res[10], res[11]); o1.z = pk2(res[12], res[13]); o1.w = pk2(res[14], res[15]);
            bf16_t* mp = MIX + (size_t)(tok0 + frow) * GVW + vh * 128 + 16 * fc;
            *(u32x4*)mp = o0; *(u32x4*)(mp + 8) = o1;
        }
        if (more && tid < 64) *(LAS float*)(nbuf + GS_GC + 4 * tid) = gstg;
        asm volatile("s_waitcnt vmcnt(0)" ::: "memory");
        __syncthreads();
    }
#undef GS_DMA
    float* so = c.p.out + O_PGS + ((size_t)(li * NB + b) * GH + vh) * GDK * GDV;
#pragma unroll
    for (int tt = 0; tt < 8; ++tt)
#pragma unroll
        for (int r = 0; r < 4; ++r) so[(size_t)(16 * tt + 4 * fq + r) * GDV + 16 * w + fr] = sacc[tt][r];
}


constexpr int G2_E1 = 62464, G2_E2 = 62720, G2_BUF = 62976, G2_OT = 2 * G2_BUF;
DI void gdn_scan2_wg(const Ctx& c, int li, int bvh, int hf) {
    const int vh = bvh & 15, b = bvh >> 4, hq = vh >> 1, lane = c.lane, fr = lane & 15, fq = lane >> 4, w = c.wave, tid = c.tid;
    const bf16_t* KCDg = c.ws<bf16_t>(W_KCD) + (size_t)(bvh * GCH) * 8192; const bf16_t* ATTg = c.ws<bf16_t>(W_ATTG) + (size_t)(bvh * GCH) * 4096;
    const bf16_t* U0g = c.ws<bf16_t>(W_U0) + (size_t)(bvh * GCH) * 8192;
    const bf16_t* QBg = c.ws<bf16_t>(W_ACT) + (size_t)(b * SEQ) * 4096 + hq * 128; const bf16_t* KTg = c.ws<bf16_t>(W_KT) + (size_t)((b * GQH + hq) * GCH) * 8192;
    const float* E1g = c.ws<float>(W_E1); const float* E2g = c.ws<float>(W_E2); float* SSg = c.ws<float>(W_SS); bf16_t* MIX = c.ws<bf16_t>(W_MIXED);
    LAS float* OT = (LAS float*)(c.lds + G2_OT);
    const bool comp = w < 4; const int hw = w - 4;
#define G2_DMA(tn, bb) do { \
        LAS unsigned char* lb_ = c.lds + (bb) * G2_BUF; \
        _Pragma("unroll") for (int k = 0; k < 4; ++k) { const int p_ = 4 * k + hw; \
            __builtin_amdgcn_global_load_lds((const unsigned*)(KCDg + (size_t)(tn) * 8192 + p_ * 512 + srcA), (LAS unsigned*)(lb_ + GS_KCD + p_ * 1088), 16, 0, 0); \
            __builtin_amdgcn_global_load_lds((const unsigned*)(QBg + (size_t)(tn) * (64 * 4096) + p_ * (4 * 4096) + srcQ), (LAS unsigned*)(lb_ + GS_QB + p_ * 1088), 16, 0, 0); \
            __builtin_amdgcn_global_load_lds((const unsigned*)(KTg + (size_t)(tn) * 8192 + p_ * 512 + srcB), (LAS unsigned*)(lb_ + GS_KT + p_ * 1152), 16, 0, 0); } \
        _Pragma("unroll") for (int k = 0; k < 2; ++k) { const int p_ = 4 * k + hw; \
            __builtin_amdgcn_global_load_lds((const unsigned*)(ATTg + (size_t)(tn) * 4096 + p_ * 512 + srcB), (LAS unsigned*)(lb_ + GS_ATT + p_ * 1152), 16, 0, 0); } } while (0)
#define G2_OUT(tp) do { \
        const int ht_ = tid - 256, row_ = ht_ >> 2, cq_ = ht_ & 3; const LAS float* op_ = OT + ((tp) & 1) * (64 * 68) + row_ * 68 + 16 * cq_; \
        const f32x4 a0 = *(const LAS f32x4*)op_, a1 = *(const LAS f32x4*)(op_ + 4), a2 = *(const LAS f32x4*)(op_ + 8), a3 = *(const LAS f32x4*)(op_ + 12); \
        float ss_ = a0.x * a0.x + a0.y * a0.y + a0.z * a0.z + a0.w * a0.w + a1.x * a1.x + a1.y * a1.y + a1.z * a1.z + a1.w * a1.w \
                  + a2.x * a2.x + a2.y * a2.y + a2.z * a2.z + a2.w * a2.w + a3.x * a3.x + a3.y * a3.y + a3.z * a3.z + a3.w * a3.w; \
        ss_ += __shfl_xor(ss_, 1); ss_ += __shfl_xor(ss_, 2); \
        const size_t tk_ = (size_t)(b * SEQ + (tp) * 64 + row_); \
        if (cq_ == 0) SSg[(tk_ * 16 + vh) * 2 + hf] = ss_; \
        u32x4 o0, o1; o0.x = pk2(a0.x, a0.y); o0.y = pk2(a0.z, a0.w); o0.z = pk2(a1.x, a1.y); o0.w = pk2(a1.z, a1.w); \
        o1.x = pk2(a2.x, a2.y); o1.y = pk2(a2.z, a2.w); o1.z = pk2(a3.x, a3.y); o1.w = pk2(a3.z, a3.w); \
        bf16_t* mp_ = MIX + tk_ * GVW + vh * 128 + 64 * hf + 16 * cq_; *(u32x4*)mp_ = o0; *(u32x4*)(mp_ + 8) = o1; } while (0)
    const int srcA = (lane & 3) * 128 + 8 * (lane >> 2), srcQ = (lane & 3) * 4096 + 8 * (lane >> 2), srcB = (lane & 7) * 64 + 8 * (lane >> 3);
    const int offA = (fr >> 2) * 1088 + (fr & 3) * 16 + (fq >> 1) * 64 + 8 * (fq & 1), offB = (fr >> 3) * 1152 + (fr & 7) * 16 + (fq >> 1) * 128 + 8 * (fq & 1);
    const int nt = 4 * hf + (w & 3);
    f32x4 sacc[8];
#pragma unroll
    for (int t = 0; t < 8; ++t) sacc[t] = (f32x4){0.f, 0.f, 0.f, 0.f};
    __syncthreads();
    u32x2 u0n[4];
#pragma unroll
    for (int it = 0; it < 4; ++it) u0n[it] = (u32x2){0u, 0u};
    if (comp) {
#pragma unroll
        for (int it = 0; it < 4; ++it) u0n[it] = *(const u32x2*)(U0g + ((size_t)(nt * 4 + it) * 64 + lane) * 4);
    } else {
        G2_DMA(0, 0);
        if (hw == 0) { *(LAS float*)(c.lds + G2_E1 + 4 * lane) = E1g[(size_t)(b * SEQ + lane) * 16 + vh]; *(LAS float*)(c.lds + G2_E2 + 4 * lane) = E2g[(size_t)(b * SEQ + lane) * 16 + vh]; }
    }
    asm volatile("s_waitcnt vmcnt(0)" ::: "memory");
    __syncthreads();
#pragma unroll 1
    for (int t = 0; t < GCH; ++t) {
        const LAS unsigned char* buf = c.lds + (t & 1) * G2_BUF; LAS unsigned char* nbuf = c.lds + ((t + 1) & 1) * G2_BUF;
        const int tok0 = b * SEQ + t * 64;
        const bool more = t + 1 < GCH;
        if (comp) {
            u32x2 u0r[4];
#pragma unroll
            for (int it = 0; it < 4; ++it) u0r[it] = u0n[it];
            if (more) {
#pragma unroll
                for (int it = 0; it < 4; ++it) u0n[it] = *(const u32x2*)(U0g + (size_t)(t + 1) * 8192 + ((size_t)(nt * 4 + it) * 64 + lane) * 4);
            }
            const LAS unsigned char* KCD = buf + GS_KCD; const LAS unsigned char* QB = buf + GS_QB; const LAS unsigned char* ATT = buf + GS_ATT; const LAS unsigned char* KT = buf + GS_KT;
            const LAS float* e1S = (const LAS float*)(buf + G2_E1); const LAS float* e2S = (const LAS float*)(buf + G2_E2);
            bf16x8 sfrag[4];
#pragma unroll
            for (int ks = 0; ks < 4; ++ks) sfrag[ks] = pack8(sacc[2 * ks], sacc[2 * ks + 1]);
            const float egl = e1S[63];
            bf16x8 ufrag[2], udfrag[2]; f32x4 ov[4];
#pragma unroll
            for (int hp = 0; hp < 2; ++hp) {
                f32x4 uu[2];
#pragma unroll
                for (int h2 = 0; h2 < 2; ++h2) {
                    const int it = 2 * hp + h2;
                    f32x4 ks_ = (f32x4){0.f, 0.f, 0.f, 0.f}, qs_ = (f32x4){0.f, 0.f, 0.f, 0.f};
#pragma unroll
                    for (int ks = 0; ks < 4; ++ks) {
                        ks_ = __builtin_amdgcn_mfma_f32_16x16x32_bf16(fragA(KCD + offA + it * 4352 + ks * 256), sfrag[ks], ks_, 0, 0, 0);
                        qs_ = __builtin_amdgcn_mfma_f32_16x16x32_bf16(fragA(QB + offA + it * 4352 + ks * 256), sfrag[ks], qs_, 0, 0, 0);
                    }
                    const f32x4 e1 = *(const LAS f32x4*)(e1S + 16 * it + 4 * fq);
                    f32x4 u;
                    u[0] = bf2f((bf16_t)(u0r[it].x & 0xffff)) - ks_[0]; u[1] = bf2f((bf16_t)(u0r[it].x >> 16)) - ks_[1]; u[2] = bf2f((bf16_t)(u0r[it].y & 0xffff)) - ks_[2]; u[3] = bf2f((bf16_t)(u0r[it].y >> 16)) - ks_[3];
                    uu[h2] = u; ov[it] = qs_ * e1;
                }
                ufrag[hp] = pack8(uu[0], uu[1]);
                const f32x4 g0 = *(const LAS f32x4*)(e2S + 32 * hp + 4 * fq), g1 = *(const LAS f32x4*)(e2S + 32 * hp + 16 + 4 * fq);
                udfrag[hp] = pack8(uu[0] * g0, uu[1] * g1);
            }
            LAS float* ot = OT + (t & 1) * (64 * 68);
#pragma unroll
            for (int it = 0; it < 4; ++it) {
                f32x4 au = ov[it];
#pragma unroll
                for (int ks = 0; ks < 2; ++ks) au = __builtin_amdgcn_mfma_f32_16x16x32_bf16(fragB(ATT + offB + it * 2304 + ks * 512), ufrag[ks], au, 0, 0, 0);
#pragma unroll
                for (int r = 0; r < 4; ++r) ot[(16 * it + 4 * fq + r) * 68 + 16 * (w & 3) + fr] = au[r];
            }
#pragma unroll
            for (int tt = 0; tt < 8; ++tt) {
                f32x4 a = sacc[tt] * egl;
#pragma unroll
                for (int ks = 0; ks < 2; ++ks) a = __builtin_amdgcn_mfma_f32_16x16x32_bf16(fragB(KT + offB + tt * 2304 + ks * 512), udfrag[ks], a, 0, 0, 0);
                sacc[tt] = a;
            }
        } else {
            float e1n = 0.f, e2n = 0.f;
            if (more) {
                G2_DMA(t + 1, (t + 1) & 1);
                if (hw == 0) { e1n = E1g[(size_t)(tok0 + 64 + lane) * 16 + vh]; e2n = E2g[(size_t)(tok0 + 64 + lane) * 16 + vh]; }
            }
            if (t > 0) G2_OUT(t - 1);
            if (more && hw == 0) { *(LAS float*)(nbuf + G2_E1 + 4 * lane) = e1n; *(LAS float*)(nbuf + G2_E2 + 4 * lane) = e2n; }
            asm volatile("s_waitcnt vmcnt(0)" ::: "memory");
        }
        __syncthreads();
    }
    if (!comp) G2_OUT(GCH - 1);
#undef G2_DMA
#undef G2_OUT
    if (comp) {
        float* so = c.p.out + O_PGS + ((size_t)(li * NB + b) * GH + vh) * GDK * GDV;
#pragma unroll
        for (int tt = 0; tt < 8; ++tt)
#pragma unroll
            for (int r = 0; r < 4; ++r) so[(size_t)(16 * tt + 4 * fq + r) * GDV + 16 * nt + fr] = sacc[tt][r];
    }
}
DI void gdn_norm_gate_token(const Ctx& c, int li, int tok) {
    const bf16_t* PROJ = c.ws<bf16_t>(W_PROJ); bf16_t* MIX = c.ws<bf16_t>(W_MIXED); const float* SSg = c.ws<float>(W_SS);
    const float* nw = c.in(I_GNW) + (size_t)li * GDV; const int lane = c.lane;
    u32x4 ov[4], zv[4]; float2 sv[4];
#pragma unroll
    for (int it = 0; it < 4; ++it) { const int ch0 = 512 * it + 8 * lane; ov[it] = *(const u32x4*)(MIX + (size_t)tok * GVW + ch0); zv[it] = *(const u32x4*)(PROJ + (size_t)tok * GDN_MAIN + 4096 + ch0);
        sv[it] = *(const float2*)(SSg + ((size_t)tok * 16 + (ch0 >> 7)) * 2); }
#pragma unroll
    for (int it = 0; it < 4; ++it) {
        const int ch0 = 512 * it + 8 * lane; float o[8], z[8], w8[8];
        unpack8(ov[it], o); unpack8(zv[it], z); load8f(nw + (ch0 & 127), w8);
        const float r = rsqrtf((sv[it].x + sv[it].y) * (1.f / 128.f) + EPS);
        u32x4 res; res.x = pk2(o[0] * r * w8[0] * siluf(z[0]), o[1] * r * w8[1] * siluf(z[1])); res.y = pk2(o[2] * r * w8[2] * siluf(z[2]), o[3] * r * w8[3] * siluf(z[3]));
        res.z = pk2(o[4] * r * w8[4] * siluf(z[4]), o[5] * r * w8[5] * siluf(z[5])); res.w = pk2(o[6] * r * w8[6] * siluf(z[6]), o[7] * r * w8[7] * siluf(z[7]));
        *(u32x4*)(MIX + (size_t)tok * GVW + ch0) = res;
    }
}

DI void gdn_post_token(const Ctx& c, int li, int tok) {
    const bf16_t* PROJ = c.ws<bf16_t>(W_PROJ); const float* Y = c.ws<float>(W_Y); bf16_t* MIX = c.ws<bf16_t>(W_MIXED);
    const float* nw = c.in(I_GNW) + (size_t)li * GDV; const int lane = c.lane;
#pragma unroll 1
    for (int it = 0; it < 4; ++it) {
        const int ch0 = 512 * it + 8 * lane; float o[8], z[8], w[8];
        load8f(Y + (size_t)tok * 2048 + ch0, o); unpack8(*(const u32x4*)(PROJ + (size_t)tok * GDN_MAIN + 4096 + ch0), z); load8f(nw + (ch0 & 127), w);
        float ss = 0.f;
#pragma unroll
        for (int e = 0; e < 8; ++e) ss += o[e] * o[e];
        ss += __shfl_xor(ss, 1); ss += __shfl_xor(ss, 2); ss += __shfl_xor(ss, 4); ss += __shfl_xor(ss, 8);
        const float r = rsqrtf(ss * (1.f / 128.f) + EPS);
        u32x4 ov; ov.x = pk2(o[0] * r * w[0] * siluf(z[0]), o[1] * r * w[1] * siluf(z[1])); ov.y = pk2(o[2] * r * w[2] * siluf(z[2]), o[3] * r * w[3] * siluf(z[3]));
        ov.z = pk2(o[4] * r * w[4] * siluf(z[4]), o[5] * r * w[5] * siluf(z[5])); ov.w = pk2(o[6] * r * w[6] * siluf(z[6]), o[7] * r * w[7] * siluf(z[7]));
        *(u32x4*)(MIX + (size_t)tok * GVW + ch0) = ov;
    }
}

DI void cache_copy(const Ctx& c, int wg, int nwg, int part) {
    const size_t gt = (size_t)wg * NTHR + c.tid, gn = (size_t)nwg * NTHR;
    const size_t per = (size_t)(WIN - 1) * AW / 4, tot = (size_t)2 * NS * per, cut = tot / 2, lo = part ? cut : 0, hi = part ? tot : cut;
#pragma unroll 8
    for (size_t i = lo + gt; i < hi; i += gn) { const size_t sq = i / per, r = i % per;
        ((f32x4*)(c.p.out + O_SK + sq * WIN * AW))[r] = ((const f32x4*)(c.in(I_CK) + sq * WIN * AW + AW))[r];
        ((f32x4*)(c.p.out + O_SV + sq * WIN * AW))[r] = ((const f32x4*)(c.in(I_CV) + sq * WIN * AW + AW))[r]; }
}
DI void weights_half(const Ctx& c, int half, int gw0, int ngw0) {
    const int i = half;
    transpose_mat(c, c.in(I_WHIN) + (size_t)i * D * HYB_IN, D, HYB_IN, c.ws<bf16_t>(W_HIN) + (size_t)i * HYB_IN * D, 0, gw0, ngw0);
    transpose_mat(c, c.in(I_WHOUT) + (size_t)i * HYB_MIX * D, HYB_MIX, D, c.ws<bf16_t>(W_HOUT) + (size_t)i * D * HYB_MIX, 0, gw0, ngw0);
    transpose_mat(c, c.in(I_WGIN) + (size_t)i * D * GDN_IN, D, GDN_IN, c.ws<bf16_t>(W_GIN) + (size_t)i * GDN_IN * D, 0, gw0, ngw0);
    transpose_mat(c, c.in(I_WGOUT) + (size_t)i * GVW * D, GVW, D, c.ws<bf16_t>(W_GOUT) + (size_t)i * D * GVW, 0, gw0, ngw0);
    for (int l = 2 * half; l < 2 * half + 2; ++l) {
        transpose_mat(c, c.in(I_WFG) + (size_t)l * D * FF, D, FF, c.ws<bf16_t>(W_GU) + (size_t)l * 2 * FF * D, 1, gw0, ngw0);
        transpose_mat(c, c.in(I_WFU) + (size_t)l * D * FF, D, FF, c.ws<bf16_t>(W_GU) + (size_t)l * 2 * FF * D, 2, gw0, ngw0);
        transpose_mat(c, c.in(I_WFD) + (size_t)l * FF * D, FF, D, c.ws<bf16_t>(W_DN) + (size_t)l * D * FF, 0, gw0, ngw0);
    }
}
constexpr int PH_PER_LAYER = 10, N_PHASES = 1 + 2 * 10 + 2 * 9;
DI void phase_decode(int ph, int& l, int& sp) {
    int q = ph - 1; l = 0; if (q >= 10) { q -= 10; l = 1; if (q >= 9) { q -= 9; l = 2; if (q >= 10) { q -= 10; l = 3; } } }
    sp = (l & 1) ? (q >= 2 ? q + 1 : q) : q;
}
#ifndef ONLY
#define ONLY -1
#endif
#define EN(x) (ONLY < 0 || ONLY == (x))
DI void run_phase(const Ctx& c, int ph) {
    if (ph == 0) { if (!EN(0)) return;
        weights_half(c, 0, -1, 0); weights_half(c, 1, -1, 0);
        rowpass_phase(c, 0, nullptr, c.in(I_NMPRE), true);
        return;
    }
    int l, sp; phase_decode(ph, l, sp); const int li = l >> 1; const bool hyb = (l & 1) == 0;
    bf16_t* H = c.ws<bf16_t>(W_H); bf16_t* PROJ = c.ws<bf16_t>(W_PROJ); bf16_t* MIX = c.ws<bf16_t>(W_MIXED); bf16_t* GO = c.ws<bf16_t>(W_GO); bf16_t* HID = c.ws<bf16_t>(W_HID);
    switch (sp) {
    case 0: {
        if (!EN(1)) break;
        const bf16_t* Wt = hyb ? c.ws<bf16_t>(W_HIN) + (size_t)li * HYB_IN * D : c.ws<bf16_t>(W_GIN) + (size_t)li * GDN_IN * D;
        const int nmain = hyb ? HYB_MAIN : GDN_MAIN, nall = hyb ? HYB_IN : GDN_IN;
        { pg8::Gemm g{H, Wt, T, nmain, D}; pg8::StaticOrder S; S.init(T, nmain, gridDim.x, blockIdx.x); pg8::EpiBf16Perm E{PROJ, nmain};
          pg8::gemm_phase<pg8::EpiBf16Perm, pg8::StaticOrder>(c.lds, g, S, E, nullptr); }
        { Epi e{0, PROJ, c.ws<float>(W_EXTRA), nmain, 0}; gemm_ksplit<4>(c, H, D, T, Wt + (size_t)nmain * D, D, nall - nmain, D, e); }
        { Epi e{0, PROJ + (size_t)T * nmain, c.ws<float>(W_EXTRA) + (size_t)T * 32, nmain, nmain}; gemm_ksplit<2>(c, H + (size_t)T * D, D, NS, Wt, D, nall, D, e); }
    } break;
    case 1: {
        if (hyb) {
            if (EN(2)) { if (c.wave == 0) for (int tok = T + blockIdx.x; tok < TT; tok += gridDim.x) hyb_pre_token(c, li, tok);
                         for (int tok = c.gw; tok < T; tok += c.ngw) hyb_pre_token(c, li, tok); }
            LAS float* pl = (LAS float*)(c.lds + NWAVE * AT_LDS + c.wave * 2048);
            if (EN(3)) { for (int it = blockIdx.x; it < NS * AH; it += gridDim.x) attn_sample_wg(c, li, it);
                         { const int vwg = (blockIdx.x & 7) * (gridDim.x >> 3) + (blockIdx.x >> 3), vgw = ((gridDim.x & 7) == 0 ? vwg : (int)blockIdx.x) * NWAVE + c.wave;
                           int tb_head = -1;
                           for (int it = vgw; it < NB * AH * 256; it += c.ngw) attn_mfma_item(c, li, it, tb_head); } }
        } else { if (EN(4)) {
            if (c.wave == 0) for (int tok = T + blockIdx.x; tok < TT; tok += gridDim.x) gdn_pre_token(c, li, tok);
            for (int rg = blockIdx.x; rg < T / 64; rg += gridDim.x) {
                gdn_pre_range(c, li, rg * 8 + c.wave);
                asm volatile("s_waitcnt vmcnt(0)" ::: "memory"); __syncthreads();
                const int bb = rg >> 6, ch = rg & 63;
#pragma unroll 1
                for (int k2 = 0; k2 < 2; ++k2) gdn_a_item(c, li, ((bb * GH + 2 * c.wave + k2) << 6) + ch);
                __syncthreads();
            } } }
    } break;
    case 2: {
        if (hyb) { if (EN(5)) { for (int it = blockIdx.x; it < NB * NCH * 2; it += gridDim.x) ssd_a_item(c, li, it);
                                for (int it = c.gw; it < NS * SH * 4; it += c.ngw) ssd_sample_item(c, li, it); } }
        else { }
    } break;
    case 3: {
        if (hyb) { if (EN(7)) { ssd_scan_phase(c, li); if (c.wave == 0) for (int tok = T + blockIdx.x; tok < TT; tok += gridDim.x) hyb_post_token(c, li, tok); } }
        else { if (EN(8)) {
            constexpr int NSW = 2 * NB * GH;
            if ((int)blockIdx.x < NSW) gdn_scan2_wg(c, li, ((blockIdx.x >> 4) << 3) + (blockIdx.x & 7), (blockIdx.x >> 3) & 1);
            else { const int wg = blockIdx.x - NSW, nwg = gridDim.x - NSW;
                gdn_seq_phase(c, li, NB * GH, wg, nwg);
                cache_copy(c, wg, nwg, l == 1 ? 0 : 1);
                } } }
    } break;
    case 4: {
        if (hyb) { if (EN(14)) for (int it = blockIdx.x; it < NB * NCH * 2; it += gridDim.x) ssd_b_item(c, li, it); }
        else { if (EN(15)) for (int tok = c.gw; tok < T; tok += c.ngw) gdn_norm_gate_token(c, li, tok); }
    } break;
    case 5: {
        if (!EN(9)) break;
        const bf16_t* Wt = hyb ? c.ws<bf16_t>(W_HOUT) + (size_t)li * D * HYB_MIX : c.ws<bf16_t>(W_GOUT) + (size_t)li * D * GVW; const int kk = hyb ? HYB_MIX : GVW;
        { pg8::Gemm g{MIX, Wt, T, D, kk}; pg8::StaticOrder S; S.init(T, D, gridDim.x, blockIdx.x); pg8::EpiBf16Perm E{GO, D};
          pg8::gemm_phase<pg8::EpiBf16Perm, pg8::StaticOrder>(c.lds, g, S, E, nullptr); }
        { Epi e{0, GO + (size_t)T * D, nullptr, D, D}; gemm_ksplit<2>(c, MIX + (size_t)T * kk, kk, NS, Wt, kk, D, kk, e); }
    } break;
    case 6: if (EN(10)) rowpass_phase(c, 1, c.in(I_NMPOST) + (size_t)l * D, c.in(I_NFPRE) + (size_t)l * D, l == 0); break;
    case 7: if (EN(11)) { const bf16_t* Wt = c.ws<bf16_t>(W_GU) + (size_t)l * 2 * FF * D;
        { pg8::Gemm g{H, Wt, T, 2 * FF, D}; pg8::StaticOrder S; S.init(T, 2 * FF, gridDim.x, blockIdx.x); pg8::EpiSwiglu E{HID, FF};
          pg8::gemm_phase<pg8::EpiSwiglu, pg8::StaticOrder>(c.lds, g, S, E, nullptr); }
        { Epi e{2, HID + (size_t)T * FF, nullptr, FF, 0}; gemm_ksplit<2>(c, H + (size_t)T * D, D, NS, Wt, D, 2 * FF, D, e); } } break;
    case 8: if (EN(12)) { const bf16_t* Wt = c.ws<bf16_t>(W_DN) + (size_t)l * D * FF;
        { pg8::Gemm g{HID, Wt, T, D, FF}; pg8::StaticOrder S; S.init(T, D, gridDim.x, blockIdx.x); pg8::EpiBf16Perm E{GO, D};
          pg8::gemm_phase<pg8::EpiBf16Perm, pg8::StaticOrder>(c.lds, g, S, E, nullptr); }
        { Epi e{0, GO + (size_t)T * D, nullptr, D, D}; gemm_ksplit<2>(c, HID + (size_t)T * FF, FF, NS, Wt, FF, D, FF, e); } } break;
    case 9: if (EN(13)) rowpass_phase(c, l == DEPTH - 1 ? 2 : 1, c.in(I_NFPOST) + (size_t)l * D, l == DEPTH - 1 ? nullptr : c.in(I_NMPRE) + (size_t)(l + 1) * D, false); break;
    default: break;
    }
}

extern __shared__ __attribute__((aligned(16))) unsigned char g_shm[];
__global__ void __launch_bounds__(NTHR, 2) mega(Params p) {
    cg::grid_group grid = cg::this_grid();
    volatile LAS unsigned* bst = (volatile LAS unsigned*)((LAS unsigned char*)g_shm + LDS_BYTES - 16);
    if (threadIdx.x == 0) { bst[0] = 0u; bst[1] = 0u; bst[2] = 0u; bst[3] = 0u; }
    __syncthreads();
    const XcdBarrier xb = xcd_barrier_post((unsigned*)p.ws, bst);
    for (int ph = p.ph_lo; ph < p.ph_hi; ++ph) {
        int tid_ = threadIdx.x; asm volatile("" : "+v"(tid_));
        Ctx c; c.p.kp = (KParams)__builtin_amdgcn_kernarg_segment_ptr(); c.p.out = c.p.kp->out; c.tid = tid_; c.lane = tid_ & 63; c.wave = __builtin_amdgcn_readfirstlane(tid_ >> 6);
        c.gw = blockIdx.x * NWAVE + c.wave; c.ngw = gridDim.x * NWAVE; c.lds = (LAS unsigned char*)g_shm;
        run_phase(c, ph);
#ifdef PROBE_MASK
        { int l_ = 0, sp_ = 0; if (ph > 0) phase_decode(ph, l_, sp_); const int bit = ph == 0 ? 20 : sp_ + 10 * (l_ & 1);
          if ((PROBE_MASK >> bit) & 1) { xcd_barrier(xb); run_phase(c, ph); } }
#endif
        if (ph + 1 < p.ph_hi) { if (ph == p.ph_lo) grid.sync(); else xcd_barrier(xb); }
    }
}

extern "C" void kernel_launch(void* const* d_in, const int* in_sizes, int n_in, void* d_out, int out_size, void* d_ws, size_t ws_size, hipStream_t stream) {
    static int grid = 0;
    if (!grid) {
        int dev = 0, cus = 0, per = 0; hipGetDevice(&dev); hipDeviceGetAttribute(&cus, hipDeviceAttributeMultiprocessorCount, dev);
        hipFuncSetAttribute((const void*)mega, hipFuncAttributeMaxDynamicSharedMemorySize, LDS_BYTES);
        hipOccupancyMaxActiveBlocksPerMultiprocessor(&per, (const void*)mega, NTHR, LDS_BYTES);
        if (n_in != 30 || (size_t)out_size != O_END || ws_size < W_END) fprintf(stderr, "kernel_launch: unexpected shapes n_in %d out %d (want %zu) ws %zu (want %zu)\n", n_in, out_size, (size_t)O_END, ws_size, (size_t)W_END);
        if (per < 1) fprintf(stderr, "kernel_launch: occupancy query says %d blocks per CU\n", per);
        grid = cus;
    }
    hipMemsetAsync(d_ws, 0, 16384, stream);
    Params p{}; for (int i = 0; i < 30; ++i) p.in[i] = (const float*)d_in[i];
    p.out = (float*)d_out; p.ws = (unsigned char*)d_ws; p.ph_lo = 0; p.ph_hi = N_PHASES;
    void* args[] = {&p};
    hipError_t e = hipLaunchCooperativeKernel((const void*)mega, dim3(grid), dim3(NTHR), args, LDS_BYTES, stream);
    if (e != hipSuccess) fprintf(stderr, "kernel_launch: cooperative launch failed: %s\n", hipGetErrorString(e));
}
```
